# Optimizing an MI355X kernel written in HIP

```python
import jax
import jax.numpy as jnp
from jax import lax
import numpy as np

D_MODEL = 1024
BATCH = 16
SEQ = 2048
DEPTH = 1

CHUNK = 64
GM_WIDTH = D_MODEL // 2
GM_HEADS = 4
GM_HEAD_DIM = GM_WIDTH // GM_HEADS
GM_CHUNK = 128
MLA_HEADS = 4
QK_NOPE_DIM = 128
QK_ROPE_DIM = 64
V_HEAD_DIM = (D_MODEL - GM_WIDTH) // MLA_HEADS
Q_LORA_RANK = 3 * D_MODEL // 8
KV_LORA_RANK = D_MODEL // 4
ROPE_THETA = 10000.0
Q_BLOCK = 128
MIX_WIDTH = GM_WIDTH + MLA_HEADS * V_HEAD_DIM
IN_WIDTH = 2 * GM_WIDTH + Q_LORA_RANK + KV_LORA_RANK + QK_ROPE_DIM
N_GROUPS = 4
EXPERTS_PER_GROUP = 8
N_EXPERTS = N_GROUPS * EXPERTS_PER_GROUP
TOP_K = 2
EXPERT_FF = D_MODEL // 4
MOE_BLOCK = 128
ALPHA = (2 * DEPTH) ** 0.25
BETA = (8 * DEPTH) ** -0.25
MAX_POS_OFFSET = 4096

kernel_name = 'hybrid_gmlp_mla_hmoe_deepnorm'


def layer_norm(x, g, b, eps=1e-5):
    xf = x.astype(jnp.float32)
    mu = jnp.mean(xf, axis=-1, keepdims=True)
    var = jnp.mean(jnp.square(xf - mu), axis=-1, keepdims=True)
    return ((xf - mu) * lax.rsqrt(var + eps) * g + b).astype(x.dtype)


def rms_norm(x, g, eps=1e-6):
    xf = x.astype(jnp.float32)
    return (xf * lax.rsqrt(jnp.mean(jnp.square(xf), axis=-1, keepdims=True) + eps) * g).astype(x.dtype)


def rope_tables(positions):
    inv_freq = ROPE_THETA ** (-jnp.arange(0, QK_ROPE_DIM, 2, dtype=jnp.float32) / QK_ROPE_DIM)
    ang = positions.astype(jnp.float32)[..., None] * inv_freq
    return jnp.cos(ang), jnp.sin(ang)


def apply_rope(x, cos, sin):
    half = x.shape[-1] // 2
    xf = x.astype(jnp.float32)
    x1, x2 = xf[..., :half], xf[..., half:]
    return jnp.concatenate([x1 * cos - x2 * sin, x2 * cos + x1 * sin], axis=-1).astype(x.dtype)


def spatial_gating(u, v, ln_g, ln_b, w_s, b_s):
    B, S, _ = u.shape
    v = v.reshape(B, S, GM_HEADS, GM_HEAD_DIM)
    v = layer_norm(v, ln_g.reshape(GM_HEADS, GM_HEAD_DIM), ln_b.reshape(GM_HEADS, GM_HEAD_DIM))
    v = v.reshape(B, S // GM_CHUNK, GM_CHUNK, GM_HEADS, GM_HEAD_DIM)
    frame_chunk = jnp.arange(GM_CHUNK) // CHUNK
    allowed = frame_chunk[None, :] <= frame_chunk[:, None]
    w_masked = jnp.where(allowed[None], w_s, jnp.zeros((), w_s.dtype))
    f = jnp.einsum('hij,bnjhc->bnihc', w_masked, v) + b_s.T[None, None, :, :, None]
    return u * f.reshape(B, S, GM_WIDTH)


def mla_attention(q_nope, q_rope, k_nope, k_rope, v):
    B, S, H, _ = q_nope.shape
    nb = S // Q_BLOCK
    scale = (QK_NOPE_DIM + QK_ROPE_DIM) ** -0.5
    key_chunk = jnp.arange(S) // CHUNK
    qn = q_nope.reshape(B, nb, Q_BLOCK, H, QK_NOPE_DIM).transpose(1, 0, 2, 3, 4)
    qr = q_rope.reshape(B, nb, Q_BLOCK, H, QK_ROPE_DIM).transpose(1, 0, 2, 3, 4)

    def one_block(args):
        qn_b, qr_b, bi = args
        q_chunk = (bi * Q_BLOCK + jnp.arange(Q_BLOCK)) // CHUNK
        s = (jnp.einsum('bqhd,bkhd->bhqk', qn_b, k_nope)
             + jnp.einsum('bqhr,bkr->bhqk', qr_b, k_rope)).astype(jnp.float32) * scale
        allowed = key_chunk[None, :] <= q_chunk[:, None]
        s = jnp.where(allowed[None, None], s, jnp.float32(-1e30))
        p = jax.nn.softmax(s, axis=-1).astype(v.dtype)
        return jnp.einsum('bhqk,bkhd->bqhd', p, v)

    o = lax.map(one_block, (qn, qr, jnp.arange(nb)))
    return o.transpose(1, 0, 2, 3, 4).reshape(B, S, H * V_HEAD_DIM)


def token_mixer(h, cos, sin, w_in, gm_ln_g, gm_ln_b, w_spatial, b_spatial,
                q_norm_g, w_uq, kv_norm_g, w_ukv, w_out):
    B, S, _ = h.shape
    z = jnp.einsum('bsd,de->bse', h, w_in)
    o1 = GM_WIDTH
    o2 = 2 * GM_WIDTH
    o3 = o2 + Q_LORA_RANK
    o4 = o3 + KV_LORA_RANK
    out_a = spatial_gating(jax.nn.gelu(z[..., :o1]), jax.nn.gelu(z[..., o1:o2]),
                           gm_ln_g, gm_ln_b, w_spatial, b_spatial)
    q = jnp.einsum('bsr,re->bse', rms_norm(z[..., o2:o3], q_norm_g), w_uq)
    q = q.reshape(B, S, MLA_HEADS, QK_NOPE_DIM + QK_ROPE_DIM)
    q_nope = q[..., :QK_NOPE_DIM]
    q_rope = apply_rope(q[..., QK_NOPE_DIM:], cos[:, :, None, :], sin[:, :, None, :])
    kv = jnp.einsum('bsr,re->bse', rms_norm(z[..., o3:o4], kv_norm_g), w_ukv)
    kv = kv.reshape(B, S, MLA_HEADS, QK_NOPE_DIM + V_HEAD_DIM)
    k_nope = kv[..., :QK_NOPE_DIM]
    v = kv[..., QK_NOPE_DIM:]
    k_rope = apply_rope(z[..., o4:], cos, sin)
    out_b = mla_attention(q_nope, q_rope, k_nope, k_rope, v)
    mix = jnp.concatenate([out_a, out_b], axis=-1)
    return jnp.einsum('bse,ed->bsd', mix, w_out)


def hierarchical_moe(h, w_router_group, b_router_group, w_router_expert, b_router_expert,
                     w_gate, w_up, w_down):
    B, S, D = h.shape
    T = B * S
    xf = h.reshape(T, D)
    xr = xf.astype(jnp.float32)
    tok_idx = jnp.arange(T)
    g_logits = xr @ w_router_group.astype(jnp.float32) + b_router_group.astype(jnp.float32)
    g_prob = jax.nn.softmax(g_logits, axis=-1)
    g_top = jnp.argmax(g_logits, axis=-1)
    p_group = g_prob[tok_idx, g_top]
    e_logits = (xr @ w_router_expert.astype(jnp.float32)
                + b_router_expert.astype(jnp.float32)).reshape(T, N_GROUPS, EXPERTS_PER_GROUP)
    e_in_group = e_logits[tok_idx, g_top]
    top_val, top_idx = lax.top_k(e_in_group, TOP_K)
    gates = p_group[:, None] * jax.nn.softmax(top_val, axis=-1)
    expert_id = g_top[:, None] * EXPERTS_PER_GROUP + top_idx
    TK = T * TOP_K
    flat_e = expert_id.reshape(TK)
    order = jnp.argsort(flat_e)
    sorted_e = flat_e[order]
    counts = jnp.bincount(flat_e, length=N_EXPERTS)
    padded = (counts + MOE_BLOCK - 1) // MOE_BLOCK * MOE_BLOCK
    pad_end = jnp.cumsum(padded)
    pad_start = pad_end - padded
    cnt_start = jnp.cumsum(counts) - counts
    dest = pad_start[sorted_e] + jnp.arange(TK) - cnt_start[sorted_e]
    n_rows = TK + N_EXPERTS * MOE_BLOCK
    n_blocks = n_rows // MOE_BLOCK
    src_tok = order // TOP_K
    buf = jnp.zeros((n_rows, D), h.dtype).at[dest].set(xf[src_tok])
    blk_expert = jnp.minimum(jnp.searchsorted(pad_end, jnp.arange(n_blocks) * MOE_BLOCK, side='right'),
                             N_EXPERTS - 1)

    def expert_block(args):
        xb, e = args
        return (jax.nn.silu(xb @ w_gate[e]) * (xb @ w_up[e])) @ w_down[e]

    out = lax.map(expert_block, (buf.reshape(n_blocks, MOE_BLOCK, D), blk_expert)).reshape(n_rows, D)
    contrib = out[dest] * gates.reshape(TK)[order][:, None].astype(out.dtype)
    y = jax.ops.segment_sum(contrib, src_tok, num_segments=T)
    return y.reshape(B, S, D)


def setup_inputs(seed: int = 0) -> dict:
    key = jax.random.key(seed)
    ks = iter(jax.random.split(key, 26))
    L = DEPTH
    f32 = jnp.float32

    def nrm(shape, scale):
        return jax.random.normal(next(ks), shape, f32) * scale

    def gain(shape):
        return 1.0 + 0.02 * jax.random.normal(next(ks), shape, f32)

    x = jax.random.normal(next(ks), (BATCH, SEQ, D_MODEL), f32)
    offsets = jax.random.randint(next(ks), (BATCH, 1), 0, MAX_POS_OFFSET, dtype=jnp.int32)
    positions = offsets + jnp.arange(SEQ, dtype=jnp.int32)[None, :]
    return {
        'x': x,
        'positions': positions,
        'ln0_g': gain((D_MODEL,)),
        'ln0_b': nrm((D_MODEL,), 0.02),
        'w_in': nrm((L, D_MODEL, IN_WIDTH), D_MODEL ** -0.5),
        'gm_ln_g': gain((L, GM_WIDTH)),
        'gm_ln_b': nrm((L, GM_WIDTH), 0.02),
        'w_spatial': nrm((L, GM_HEADS, GM_CHUNK, GM_CHUNK), 0.5 * GM_CHUNK ** -0.5),
        'b_spatial': gain((L, GM_HEADS, GM_CHUNK)),
        'q_norm_g': gain((L, Q_LORA_RANK)),
        'w_uq': nrm((L, Q_LORA_RANK, MLA_HEADS * (QK_NOPE_DIM + QK_ROPE_DIM)), Q_LORA_RANK ** -0.5),
        'kv_norm_g': gain((L, KV_LORA_RANK)),
        'w_ukv': nrm((L, KV_LORA_RANK, MLA_HEADS * (QK_NOPE_DIM + V_HEAD_DIM)), KV_LORA_RANK ** -0.5),
        'w_out': nrm((L, MIX_WIDTH, D_MODEL), BETA * MIX_WIDTH ** -0.5),
        'ln1_g': gain((L, D_MODEL)),
        'ln1_b': nrm((L, D_MODEL), 0.02),
        'w_router_group': nrm((L, D_MODEL, N_GROUPS), D_MODEL ** -0.5),
        'b_router_group': nrm((L, N_GROUPS), 0.01),
        'w_router_expert': nrm((L, D_MODEL, N_EXPERTS), D_MODEL ** -0.5),
        'b_router_expert': nrm((L, N_EXPERTS), 0.01),
        'w_gate': nrm((L, N_EXPERTS, D_MODEL, EXPERT_FF), D_MODEL ** -0.5),
        'w_up': nrm((L, N_EXPERTS, D_MODEL, EXPERT_FF), D_MODEL ** -0.5),
        'w_down': nrm((L, N_EXPERTS, EXPERT_FF, D_MODEL), BETA * EXPERT_FF ** -0.5),
        'ln2_g': gain((L, D_MODEL)),
        'ln2_b': nrm((L, D_MODEL), 0.02),
    }


def reference(x, positions, ln0_g, ln0_b, w_in, gm_ln_g, gm_ln_b, w_spatial, b_spatial,
              q_norm_g, w_uq, kv_norm_g, w_ukv, w_out, ln1_g, ln1_b,
              w_router_group, b_router_group, w_router_expert, b_router_expert,
              w_gate, w_up, w_down, ln2_g, ln2_b):
    cos, sin = rope_tables(positions)
    h = layer_norm(x, ln0_g, ln0_b)
    for l in range(DEPTH):
        mix = token_mixer(h, cos, sin, w_in[l], gm_ln_g[l], gm_ln_b[l], w_spatial[l], b_spatial[l],
                          q_norm_g[l], w_uq[l], kv_norm_g[l], w_ukv[l], w_out[l])
        h = layer_norm(ALPHA * h + mix, ln1_g[l], ln1_b[l])
        ffn = hierarchical_moe(h, w_router_group[l], b_router_group[l], w_router_expert[l],
                               b_router_expert[l], w_gate[l], w_up[l], w_down[l])
        h = layer_norm(ALPHA * h + ffn, ln2_g[l], ln2_b[l])
    return h
```

```cpp
#include <hip/hip_runtime.h>
#include <stdint.h>
#include <cstdio>

#define LAS __attribute__((address_space(3)))
typedef unsigned short bf16_t;
typedef short bf16x8 __attribute__((ext_vector_type(8)));
typedef float f32x4 __attribute__((ext_vector_type(4)));
typedef float f32x16 __attribute__((ext_vector_type(16)));
typedef unsigned u32x2 __attribute__((ext_vector_type(2)));
typedef unsigned u32x4 __attribute__((ext_vector_type(4)));

constexpr int T_TOK = 32768, DM = 1024, SEQ = 2048, NBATCH = 16;
constexpr int ZN = 1792;
constexpr int NEXP = 32, FF = 256;
constexpr int LIST_CAP = 32768;
constexpr float ALPHA = 1.189207115002721f;
constexpr float QSCALE = 0.07216878364870322f * 1.4426950408889634f;

struct Params {
    const float* x; const int* pos; const float *ln0_g, *ln0_b, *w_in, *gm_g, *gm_b, *w_sp, *b_sp, *qn_g, *w_uq, *kvn_g, *w_ukv, *w_out, *ln1_g, *ln1_b,
        *w_rg, *b_rg, *w_re, *b_re, *w_gate, *w_up, *w_down, *ln2_g, *ln2_b;
    float* out;
    bf16_t *WinT, *WuqT, *WukvT, *WoutT, *WguT, *WdT;
    bf16_t* hbuf; float2* rope;
    bf16_t *zu, *zv, *zq, *zkv, *krope, *Q, *Kn, *Vt, *mix;
    float *rsq, *rskv;
    int* cnt; int* list; float* gates; bf16_t* H; bf16_t* contrib;
    unsigned* bar;
};

__device__ __forceinline__ unsigned pk2(float lo, float hi) { unsigned r; asm volatile("v_cvt_pk_bf16_f32 %0, %1, %2" : "=v"(r) : "v"(lo), "v"(hi)); return r; }
__device__ __forceinline__ bf16_t f2bf(float f) { return (bf16_t)(pk2(f, 0.f) & 0xffffu); }
__device__ __forceinline__ float bf2f(bf16_t h) { return __uint_as_float(((unsigned)h) << 16); }
__device__ __forceinline__ float bflo(unsigned u) { return __uint_as_float(u << 16); }
__device__ __forceinline__ float bfhi(unsigned u) { return __uint_as_float(u & 0xffff0000u); }
__device__ __forceinline__ void st4(bf16_t* p, f32x4 v) { u32x2 w; w.x = pk2(v[0], v[1]); w.y = pk2(v[2], v[3]); *(u32x2*)p = w; }
__device__ __forceinline__ float wave_sum(float v) {
#pragma unroll
    for (int o = 1; o < 64; o <<= 1) v += __shfl_xor(v, o);
    return v;
}
__device__ __forceinline__ float gelu_tanh(float x) {
    const float u = x + 0.044715f * x * x * x;
    const float e = __builtin_amdgcn_exp2f(-2.f * 0.7978845608028654f * 1.4426950408889634f * u);
    return x * __builtin_amdgcn_rcpf(1.f + e);
}
__device__ __forceinline__ float silu_f(float x) { return x * __builtin_amdgcn_rcpf(1.f + __builtin_amdgcn_exp2f(-1.4426950408889634f * x)); }
__device__ __forceinline__ int perm16(int k) { return 8 * ((k >> 2) & 1) + (k & 3) + 4 * (k >> 3); }

struct AMap {
    const bf16_t* base; int ld; const int* list; int nvalid;
    __device__ __forceinline__ const bf16_t* row(int r) const {
        if (list) { const int a = list[r < nvalid ? r : 0]; return base + (size_t)(a >> 1) * ld; }
        return base + (size_t)r * ld;
    }
};

struct EpiZ {
    bf16_t *zu, *zv, *zq, *zkv, *krope; const float2* rope; int row0, col0;
    __device__ __forceinline__ void half(int row, int c, f32x4 v) const {
        if (c < 1024) {
            f32x4 g; g[0] = gelu_tanh(v[0]); g[1] = gelu_tanh(v[1]); g[2] = gelu_tanh(v[2]); g[3] = gelu_tanh(v[3]);
            if (c < 512) st4(zu + (size_t)row * 512 + c, g); else st4(zv + (size_t)row * 512 + (c - 512), g);
        } else if (c < 1408) st4(zq + (size_t)row * 384 + (c - 1024), v);
        else if (c < 1664) st4(zkv + (size_t)row * 256 + (c - 1408), v);
        else if (c < 1728) {
            const int i0 = (c - 1664) >> 1;
            const float2 cs0 = rope[(size_t)row * 32 + i0], cs1 = rope[(size_t)row * 32 + i0 + 1];
            bf16_t* kr = krope + (size_t)row * 64;
            kr[i0] = f2bf(v[0] * cs0.x - v[1] * cs0.y); kr[i0 + 32] = f2bf(v[1] * cs0.x + v[0] * cs0.y);
            kr[i0 + 1] = f2bf(v[2] * cs1.x - v[3] * cs1.y); kr[i0 + 33] = f2bf(v[3] * cs1.x + v[2] * cs1.y);
        }
    }
    __device__ __forceinline__ void operator()(int r, int c32, int fq, f32x4 a, f32x4 b) const { const int row = row0 + r, c = col0 + c32 + 4 * fq; half(row, c, a); half(row, c + 16, b); }
};
struct EpiQ {
    bf16_t* Q; const float2* rope; const float* rs; int rs0; int row0, col0;
    __device__ __forceinline__ void half(int row, int c, f32x4 v, float sc) const {
        const int h = c / 192, d = c - h * 192, b = row >> 11, s = row & 2047;
        bf16_t* q = Q + ((size_t)((b * 4 + h) * SEQ + s)) * 192;
        v = v * sc;
        if (d < 128) st4(q + d, v);
        else {
            const int i0 = (d - 128) >> 1;
            const float2 cs0 = rope[(size_t)row * 32 + i0], cs1 = rope[(size_t)row * 32 + i0 + 1];
            q[128 + i0] = f2bf(v[0] * cs0.x - v[1] * cs0.y); q[160 + i0] = f2bf(v[1] * cs0.x + v[0] * cs0.y);
            q[129 + i0] = f2bf(v[2] * cs1.x - v[3] * cs1.y); q[161 + i0] = f2bf(v[3] * cs1.x + v[2] * cs1.y);
        }
    }
    __device__ __forceinline__ void operator()(int r, int c32, int fq, f32x4 a, f32x4 b) const {
        const int row = row0 + r, c = col0 + c32 + 4 * fq; const float sc = rs[row - rs0] * QSCALE; half(row, c, a, sc); half(row, c + 16, b, sc); }
};
struct EpiKV {
    bf16_t *Kn, *Vt; const float* rs; int rs0; int row0, col0;
    __device__ __forceinline__ void half(int row, int c, f32x4 v, float sc) const {
        const int h = c >> 8, e = c & 255, b = row >> 11, s = row & 2047;
        v = v * sc;
        if (e < 128) st4(Kn + ((size_t)((b * 4 + h) * SEQ + s)) * 128 + e, v);
        else {
            bf16_t* vt = Vt + ((size_t)((b * 4 + h) * 128 + (e - 128))) * SEQ + (s & ~15) + perm16(s & 15);
            vt[0] = f2bf(v[0]); vt[SEQ] = f2bf(v[1]); vt[2 * SEQ] = f2bf(v[2]); vt[3 * SEQ] = f2bf(v[3]);
        }
    }
    __device__ __forceinline__ void operator()(int r, int c32, int fq, f32x4 a, f32x4 b) const {
        const int row = row0 + r, c = col0 + c32 + 4 * fq; const float sc = rs[row - rs0]; half(row, c, a, sc); half(row, c + 16, b, sc); }
};
struct EpiY {
    bf16_t* hb; int row0, col0;
    __device__ __forceinline__ void half(int row, int c, f32x4 v) const {
        bf16_t* p = hb + (size_t)row * DM + c; const u32x2 h = *(const u32x2*)p;
        v[0] += ALPHA * bflo(h.x); v[1] += ALPHA * bfhi(h.x); v[2] += ALPHA * bflo(h.y); v[3] += ALPHA * bfhi(h.y);
        st4(p, v);
    }
    __device__ __forceinline__ void operator()(int r, int c32, int fq, f32x4 a, f32x4 b) const { const int row = row0 + r, c = col0 + c32 + 4 * fq; half(row, c, a); half(row, c + 16, b); }
};
struct EpiH {
    bf16_t* H; int hrow0, col0;
    __device__ __forceinline__ void operator()(int r, int c32, int fq, f32x4 a, f32x4 b) const {
        const int hid = ((col0 + c32) >> 5) * 16 + 4 * fq;
        f32x4 o; o[0] = silu_f(a[0]) * b[0]; o[1] = silu_f(a[1]) * b[1]; o[2] = silu_f(a[2]) * b[2]; o[3] = silu_f(a[3]) * b[3];
        st4(H + (size_t)(hrow0 + r) * FF + hid, o);
    }
};
struct EpiC {
    bf16_t* contrib; const int* list; const float* gates; int nvalid; int col0;
    __device__ __forceinline__ void operator()(int r, int c32, int fq, f32x4 a, f32x4 b) const {
        if (r >= nvalid) return;
        const int aid = list[r]; const float g = gates[aid];
        bf16_t* p = contrib + (size_t)aid * DM + col0 + c32 + 4 * fq;
        st4(p, a * g); st4(p + 16, b * g);
    }
};

template <class EP> struct Unit { AMap am; const bf16_t* bt; int K; EP ep; };

__device__ __forceinline__ bool moe_unit(const int* cnt, int u, int ncol, int& e, int& rt, int& ct, int& padrow) {
    int acc = 0;
    for (e = 0; e < NEXP; ++e) {
        const int t = (cnt[e] + 255) >> 8;
        if (u < (acc + t) * ncol) { const int w = u - acc * ncol; rt = w / ncol; ct = w - rt * ncol; padrow = (acc + rt) * 256; return true; }
        acc += t;
    }
    return false;
}

struct PhZ { Params p; typedef EpiZ EP; static constexpr int NU = 128 * 7;
    __device__ __forceinline__ bool unit(int u, Unit<EP>& o) const { const int pm = u / 7, pn = u - pm * 7;
        o.am = AMap{p.hbuf + (size_t)pm * 256 * DM, DM, nullptr, 256}; o.bt = p.WinT + (size_t)pn * 256 * DM; o.K = DM;
        o.ep = EpiZ{p.zu, p.zv, p.zq, p.zkv, p.krope, p.rope, pm * 256, pn * 256}; return true; } };
struct PhQ { Params p; const float* rs; typedef EpiQ EP; static constexpr int NU = 128 * 3;
    __device__ __forceinline__ bool unit(int u, Unit<EP>& o) const { const int pm = u / 3, pn = u - pm * 3;
        o.am = AMap{p.zq + (size_t)pm * 256 * 384, 384, nullptr, 256}; o.bt = p.WuqT + (size_t)pn * 256 * 384; o.K = 384;
        o.ep = EpiQ{p.Q, p.rope, rs, 0, pm * 256, pn * 256}; return true; } };
struct PhKV { Params p; const float* rs; typedef EpiKV EP; static constexpr int NU = 128 * 4;
    __device__ __forceinline__ bool unit(int u, Unit<EP>& o) const { const int pm = u >> 2, pn = u & 3;
        o.am = AMap{p.zkv + (size_t)pm * 256 * 256, 256, nullptr, 256}; o.bt = p.WukvT + (size_t)pn * 256 * 256; o.K = 256;
        o.ep = EpiKV{p.Kn, p.Vt, rs, 0, pm * 256, pn * 256}; return true; } };
struct PhY { Params p; typedef EpiY EP; static constexpr int NU = 128 * 4;
    __device__ __forceinline__ bool unit(int u, Unit<EP>& o) const { const int pm = u >> 2, pn = u & 3;
        o.am = AMap{p.mix + (size_t)pm * 256 * DM, DM, nullptr, 256}; o.bt = p.WoutT + (size_t)pn * 256 * DM; o.K = DM;
        o.ep = EpiY{p.hbuf, pm * 256, pn * 256}; return true; } };
struct PhH { Params p; typedef EpiH EP; static constexpr int NU = 288 * 2;
    __device__ __forceinline__ bool unit(int u, Unit<EP>& o) const { int e, rt, ct, pr; if (!moe_unit(p.cnt, u, 2, e, rt, ct, pr)) return false;
        const int nv = min(256, p.cnt[e] - rt * 256);
        o.am = AMap{p.hbuf, DM, p.list + (size_t)e * LIST_CAP + rt * 256, nv}; o.bt = p.WguT + ((size_t)e * 512 + ct * 256) * DM; o.K = DM;
        o.ep = EpiH{p.H, pr, ct * 256}; return true; } };
struct PhC { Params p; typedef EpiC EP; static constexpr int NU = 288 * 4;
    __device__ __forceinline__ bool unit(int u, Unit<EP>& o) const { int e, rt, ct, pr; if (!moe_unit(p.cnt, u, 4, e, rt, ct, pr)) return false;
        const int nv = min(256, p.cnt[e] - rt * 256);
        o.am = AMap{p.H + (size_t)pr * FF, FF, nullptr, 256}; o.bt = p.WdT + ((size_t)e * DM + ct * 256) * FF; o.K = FF;
        o.ep = EpiC{p.contrib, p.list + (size_t)e * LIST_CAP + rt * 256, p.gates, nv, ct * 256}; return true; } };

__device__ __forceinline__ void wtile(const float* s0, const float* s1, int ldsrc, bf16_t* dst, int K, int k0, int n0, int mode, const float* kscale, float* tile, int tid, int nthr) {
    for (int idx = tid; idx < 4096; idx += nthr) {
        const int kk = idx >> 6, n = n0 + (idx & 63);
        const float* s = s0; int col = n;
        if (mode == 1) { if (n >= 1728) col = -1; else if (n >= 1664) { const int i = (n - 1664) >> 1, pp = (n - 1664) & 1; col = 1664 + i + 32 * pp; } }
        else if (mode == 2) { const int h = n / 192, d = n - h * 192; if (d >= 128) { const int i = (d - 128) >> 1, pp = (d - 128) & 1; col = h * 192 + 128 + i + 32 * pp; } }
        else if (mode == 3) { const int G = n >> 5, r = n & 31; col = 16 * G + (r & 15); s = (r < 16) ? s0 : s1; }
        float v = 0.f;
        if (col >= 0) { v = s[(size_t)(k0 + kk) * ldsrc + col]; if (kscale) v *= kscale[k0 + kk]; }
        tile[kk * 65 + (idx & 63)] = v;
    }
    __syncthreads();
    for (int idx = tid; idx < 4096; idx += nthr) {
        const int nn = idx >> 6, kk = idx & 63;
        dst[(size_t)(n0 + nn) * K + k0 + kk] = f2bf(tile[kk * 65 + nn]);
    }
    __syncthreads();
}
constexpr int J_IN = 28 * 16, J_UQ = 12 * 6, J_UKV = 16 * 4, J_OUT = 16 * 16, J_GU = 32 * 8 * 16, J_DN = 32 * 16 * 4;
constexpr int J_TOTAL = J_IN + J_UQ + J_UKV + J_OUT + J_GU + J_DN;
__device__ __forceinline__ void prep_wjob(const Params& p, int job, float* tile, int tid, int nthr) {
    if (job < J_IN) { const int nb = job >> 4, kb = job & 15; wtile(p.w_in, nullptr, 1728, p.WinT, 1024, kb * 64, nb * 64, 1, nullptr, tile, tid, nthr); return; } job -= J_IN;
    if (job < J_UQ) { const int nb = job / 6, kb = job - nb * 6; wtile(p.w_uq, nullptr, 768, p.WuqT, 384, kb * 64, nb * 64, 2, p.qn_g, tile, tid, nthr); return; } job -= J_UQ;
    if (job < J_UKV) { const int nb = job >> 2, kb = job & 3; wtile(p.w_ukv, nullptr, 1024, p.WukvT, 256, kb * 64, nb * 64, 0, p.kvn_g, tile, tid, nthr); return; } job -= J_UKV;
    if (job < J_OUT) { const int nb = job >> 4, kb = job & 15; wtile(p.w_out, nullptr, 1024, p.WoutT, 1024, kb * 64, nb * 64, 0, nullptr, tile, tid, nthr); return; } job -= J_OUT;
    if (job < J_GU) { const int e = job >> 7, r = job & 127, nb = r >> 4, kb = r & 15;
        wtile(p.w_gate + (size_t)e * 1024 * 256, p.w_up + (size_t)e * 1024 * 256, 256, p.WguT + (size_t)e * 512 * 1024, 1024, kb * 64, nb * 64, 3, nullptr, tile, tid, nthr); return; } job -= J_GU;
    { const int e = job >> 6, r = job & 63, nb = r >> 2, kb = r & 3;
        wtile(p.w_down + (size_t)e * 256 * 1024, nullptr, 1024, p.WdT + (size_t)e * 1024 * 256, 256, kb * 64, nb * 64, 0, nullptr, tile, tid, nthr); }
}
__device__ __forceinline__ void ln0_row(const float* xr, const float* g, const float* b, bf16_t* orow, int lane) {
    f32x4 v[4]; float s = 0.f;
#pragma unroll
    for (int j = 0; j < 4; ++j) { v[j] = *(const f32x4*)(xr + 256 * j + 4 * lane); s += (v[j][0] + v[j][1]) + (v[j][2] + v[j][3]); }
    const float mean = wave_sum(s) * (1.f / 1024.f); float s2 = 0.f;
#pragma unroll
    for (int j = 0; j < 4; ++j) { v[j] = v[j] - mean; s2 += (v[j][0] * v[j][0] + v[j][1] * v[j][1]) + (v[j][2] * v[j][2] + v[j][3] * v[j][3]); }
    const float rstd = 1.f / sqrtf(wave_sum(s2) * (1.f / 1024.f) + 1e-5f);
#pragma unroll
    for (int j = 0; j < 4; ++j) { const f32x4 gg = *(const f32x4*)(g + 256 * j + 4 * lane), bb = *(const f32x4*)(b + 256 * j + 4 * lane);
        st4(orow + 256 * j + 4 * lane, v[j] * rstd * gg + bb); }
}
__device__ __forceinline__ void rope_entry(const Params& p, int idx) {
    const int t = idx >> 5, i = idx & 31;
    const float inv = powf(10000.f, -(float)(2 * i) / 64.f);
    const float ang = (float)p.pos[t] * inv;
    p.rope[idx] = make_float2(cosf(ang), sinf(ang));
}

__device__ __forceinline__ void router_token(const Params& p, int t, int lane, const float* wr  ) {
    bf16_t* hr = p.hbuf + (size_t)t * DM;
    f32x4 v[4]; float s = 0.f;
#pragma unroll
    for (int j = 0; j < 4; ++j) { const u32x2 w = *(const u32x2*)(hr + 256 * j + 4 * lane); v[j][0] = bflo(w.x); v[j][1] = bfhi(w.x); v[j][2] = bflo(w.y); v[j][3] = bfhi(w.y);
        s += (v[j][0] + v[j][1]) + (v[j][2] + v[j][3]); }
    const float mean = wave_sum(s) * (1.f / 1024.f); float s2 = 0.f;
#pragma unroll
    for (int j = 0; j < 4; ++j) { v[j] = v[j] - mean; s2 += (v[j][0] * v[j][0] + v[j][1] * v[j][1]) + (v[j][2] * v[j][2] + v[j][3] * v[j][3]); }
    const float rstd = 1.f / sqrtf(wave_sum(s2) * (1.f / 1024.f) + 1e-5f);
#pragma unroll
    for (int j = 0; j < 4; ++j) { const f32x4 gg = *(const f32x4*)(p.ln1_g + 256 * j + 4 * lane), bb = *(const f32x4*)(p.ln1_b + 256 * j + 4 * lane);
        v[j] = v[j] * rstd * gg + bb; st4(hr + 256 * j + 4 * lane, v[j]); }
    float lg[36];
#pragma unroll
    for (int o = 0; o < 36; ++o) { float a = 0.f;
#pragma unroll
        for (int j = 0; j < 4; ++j) { const f32x4 w = *(const f32x4*)(wr + o * 1024 + 256 * j + 4 * lane); a += (v[j][0] * w[0] + v[j][1] * w[1]) + (v[j][2] * w[2] + v[j][3] * w[3]); }
        lg[o] = wave_sum(a); }
#pragma unroll
    for (int o = 0; o < 4; ++o) lg[o] += p.b_rg[o];
#pragma unroll
    for (int o = 0; o < 32; ++o) lg[4 + o] += p.b_re[o];
    int g = 0; float gm = lg[0];
#pragma unroll
    for (int i = 1; i < 4; ++i) if (lg[i] > gm) { gm = lg[i]; g = i; }
    float se = 0.f;
#pragma unroll
    for (int i = 0; i < 4; ++i) se += expf(lg[i] - gm);
    const float pg = 1.f / se;
    float ev[8];
#pragma unroll
    for (int e = 0; e < 8; ++e) ev[e] = g == 0 ? lg[4 + e] : g == 1 ? lg[12 + e] : g == 2 ? lg[20 + e] : lg[28 + e];
    int i1 = 0; float v1 = ev[0];
#pragma unroll
    for (int e = 1; e < 8; ++e) if (ev[e] > v1) { v1 = ev[e]; i1 = e; }
    int i2 = -1; float v2 = -3.0e38f;
#pragma unroll
    for (int e = 0; e < 8; ++e) if (e != i1 && ev[e] > v2) { v2 = ev[e]; i2 = e; }
    const float d = expf(v2 - v1), g1 = pg / (1.f + d), g2 = pg * d / (1.f + d);
    if (lane < 2) {
        const int ex = g * 8 + (lane == 0 ? i1 : i2), aid = 2 * t + lane;
        const int slot = atomicAdd(p.cnt + ex, 1);
        p.list[(size_t)ex * LIST_CAP + slot] = aid;
        p.gates[aid] = lane == 0 ? g1 : g2;
    }
}
__device__ __forceinline__ void final_token(const Params& p, int t, int lane) {
    const bf16_t* hr = p.hbuf + (size_t)t * DM; const bf16_t* c0 = p.contrib + (size_t)(2 * t) * DM; const bf16_t* c1 = c0 + DM;
    f32x4 v[4]; float s = 0.f;
#pragma unroll
    for (int j = 0; j < 4; ++j) { const int o = 256 * j + 4 * lane; const u32x2 w = *(const u32x2*)(hr + o), a = *(const u32x2*)(c0 + o), b = *(const u32x2*)(c1 + o);
        v[j][0] = ALPHA * bflo(w.x) + bflo(a.x) + bflo(b.x); v[j][1] = ALPHA * bfhi(w.x) + bfhi(a.x) + bfhi(b.x);
        v[j][2] = ALPHA * bflo(w.y) + bflo(a.y) + bflo(b.y); v[j][3] = ALPHA * bfhi(w.y) + bfhi(a.y) + bfhi(b.y);
        s += (v[j][0] + v[j][1]) + (v[j][2] + v[j][3]); }
    const float mean = wave_sum(s) * (1.f / 1024.f); float s2 = 0.f;
#pragma unroll
    for (int j = 0; j < 4; ++j) { v[j] = v[j] - mean; s2 += (v[j][0] * v[j][0] + v[j][1] * v[j][1]) + (v[j][2] * v[j][2] + v[j][3] * v[j][3]); }
    const float rstd = 1.f / sqrtf(wave_sum(s2) * (1.f / 1024.f) + 1e-5f);
#pragma unroll
    for (int j = 0; j < 4; ++j) { const int o = 256 * j + 4 * lane; const f32x4 gg = *(const f32x4*)(p.ln2_g + o), bb = *(const f32x4*)(p.ln2_b + o);
        *(f32x4*)(p.out + (size_t)t * DM + o) = v[j] * rstd * gg + bb; }
}

__global__ __launch_bounds__(256) void nk_prep_w(Params p) { __shared__ float tile[64 * 65]; prep_wjob(p, blockIdx.x, tile, threadIdx.x, 256); }
__global__ __launch_bounds__(256) void nk_ln0(Params p) { const int t = blockIdx.x * 4 + (threadIdx.x >> 6); ln0_row(p.x + (size_t)t * DM, p.ln0_g, p.ln0_b, p.hbuf + (size_t)t * DM, threadIdx.x & 63); }
__global__ __launch_bounds__(256) void nk_rope(Params p) { rope_entry(p, blockIdx.x * 256 + threadIdx.x); if (blockIdx.x == 0 && threadIdx.x < NEXP) p.cnt[threadIdx.x] = 0; }
__global__ __launch_bounds__(256) void nk_rowscale(Params p) {
    const int t = blockIdx.x * 4 + (threadIdx.x >> 6), lane = threadIdx.x & 63;
    float s = 0.f; for (int i = lane; i < 384; i += 64) { const float v = bf2f(p.zq[(size_t)t * 384 + i]); s += v * v; }
    s = wave_sum(s); float s2 = 0.f; for (int i = lane; i < 256; i += 64) { const float v = bf2f(p.zkv[(size_t)t * 256 + i]); s2 += v * v; }
    s2 = wave_sum(s2);
    if (lane == 0) { p.rsq[t] = 1.f / sqrtf(s * (1.f / 384.f) + 1e-6f); p.rskv[t] = 1.f / sqrtf(s2 * (1.f / 256.f) + 1e-6f); }
}
template <class PH> __global__ __launch_bounds__(256) void nk_gemm(PH ph) {
    Unit<typename PH::EP> u; if (!ph.unit(blockIdx.x, u)) return;
    const int wave = threadIdx.x >> 6, lane = threadIdx.x & 63, fr = lane & 15, fq = lane >> 4;
    const int task = blockIdx.y * 4 + wave, rb = task >> 3, cg = task & 7;
    const bf16_t* arow = u.am.row(rb * 16 + fr);
    const bf16_t* b0 = u.bt + (size_t)(cg * 32 + fr) * u.K; const bf16_t* b1 = b0 + (size_t)16 * u.K;
    f32x4 acc0 = {0.f, 0.f, 0.f, 0.f}, acc1 = {0.f, 0.f, 0.f, 0.f};
    for (int k = 0; k < u.K; k += 32) {
        const bf16x8 a = *(const bf16x8*)(arow + k + 8 * fq), x0 = *(const bf16x8*)(b0 + k + 8 * fq), x1 = *(const bf16x8*)(b1 + k + 8 * fq);
        acc0 = __builtin_amdgcn_mfma_f32_16x16x32_bf16(x0, a, acc0, 0, 0, 0);
        acc1 = __builtin_amdgcn_mfma_f32_16x16x32_bf16(x1, a, acc1, 0, 0, 0);
    }
    u.ep(rb * 16 + fr, cg * 32, fq, acc0, acc1);
}
__global__ __launch_bounds__(256) void nk_gmlp(Params p) {
    extern __shared__ float sm[];
    const int unit = blockIdx.x, h = unit & 3, bn = unit >> 2, row0 = bn * 128;
    const int wave = threadIdx.x >> 6, lane = threadIdx.x & 63;
    for (int j = wave; j < 128; j += 4) {
        const bf16_t* vr = p.zv + (size_t)(row0 + j) * 512 + h * 128;
        const float a = bf2f(vr[lane]), b = bf2f(vr[lane + 64]);
        const float mean = wave_sum(a + b) * (1.f / 128.f); const float da = a - mean, db = b - mean;
        const float rstd = 1.f / sqrtf(wave_sum(da * da + db * db) * (1.f / 128.f) + 1e-5f);
        sm[j * 129 + lane] = da * rstd * p.gm_g[h * 128 + lane] + p.gm_b[h * 128 + lane];
        sm[j * 129 + lane + 64] = db * rstd * p.gm_g[h * 128 + lane + 64] + p.gm_b[h * 128 + lane + 64];
    }
    __syncthreads();
    for (int idx = threadIdx.x; idx < 16384; idx += 256) {
        const int i = idx >> 7, c = idx & 127; const int jn = i < 64 ? 64 : 128;
        const float* w = p.w_sp + ((size_t)h * 128 + i) * 128; float f = p.b_sp[h * 128 + i];
        for (int j = 0; j < jn; ++j) f += w[j] * sm[j * 129 + c];
        const float u = bf2f(p.zu[(size_t)(row0 + i) * 512 + h * 128 + c]);
        p.mix[(size_t)(row0 + i) * DM + h * 128 + c] = f2bf(u * f);
    }
}
__global__ __launch_bounds__(256) void nk_attn(Params p) {
    extern __shared__ float sm[];
    float* Qs = sm; float* Ks = Qs + 64 * 192; float* Ss = Ks + 64 * 193; float* Vs = Ss + 64 * 65;
    const int qc = blockIdx.x & 31, bh = blockIdx.x >> 5, b = bh >> 2, h = bh & 3, tid = threadIdx.x, q = tid >> 2, sub = tid & 3;
    for (int idx = tid; idx < 64 * 192; idx += 256) { const int r = idx / 192, d = idx - r * 192; Qs[idx] = bf2f(p.Q[((size_t)bh * SEQ + qc * 64 + r) * 192 + d]); }
    float O[32]; float m = -INFINITY, l = 0.f;
#pragma unroll
    for (int j = 0; j < 32; ++j) O[j] = 0.f;
    for (int kt = 0; kt <= qc; ++kt) {
        __syncthreads();
        for (int idx = tid; idx < 64 * 192; idx += 256) { const int r = idx / 192, d = idx - r * 192; const int key = kt * 64 + r;
            Ks[r * 193 + d] = d < 128 ? bf2f(p.Kn[((size_t)bh * SEQ + key) * 128 + d]) : bf2f(p.krope[((size_t)b * SEQ + key) * 64 + d - 128]); }
        for (int idx = tid; idx < 64 * 128; idx += 256) { const int r = idx >> 7, dv = idx & 127; const int key = kt * 64 + r;
            Vs[r * 128 + dv] = bf2f(p.Vt[((size_t)bh * 128 + dv) * SEQ + (key & ~15) + perm16(key & 15)]); }
        __syncthreads();
        for (int kk = 0; kk < 16; ++kk) { const int key = sub * 16 + kk; float s = 0.f;
            for (int d = 0; d < 192; ++d) s += Qs[q * 192 + d] * Ks[key * 193 + d];
            Ss[q * 65 + key] = s; }
        __syncthreads();
        float mt = -INFINITY; for (int k = 0; k < 64; ++k) mt = fmaxf(mt, Ss[q * 65 + k]);
        const float mn = fmaxf(m, mt), alpha = exp2f(m - mn); m = mn; l *= alpha;
#pragma unroll
        for (int j = 0; j < 32; ++j) O[j] *= alpha;
        for (int k = 0; k < 64; ++k) { const float pk = exp2f(Ss[q * 65 + k] - mn); l += pk;
#pragma unroll
            for (int j = 0; j < 32; ++j) O[j] += pk * Vs[k * 128 + sub * 32 + j]; }
    }
    const float inv = 1.f / l; bf16_t* o = p.mix + ((size_t)b * SEQ + qc * 64 + q) * DM + 512 + h * 128 + sub * 32;
#pragma unroll
    for (int j = 0; j < 32; ++j) o[j] = f2bf(O[j] * inv);
}
__global__ __launch_bounds__(256) void nk_router(Params p) {
    const int t = blockIdx.x * 4 + (threadIdx.x >> 6);
    router_token(p, t, threadIdx.x & 63, (const float*)p.H);
}
__global__ __launch_bounds__(256) void nk_router_prep(Params p) {
    const int idx = blockIdx.x * 256 + threadIdx.x; if (idx >= 36 * 1024) return;
    const int o = idx >> 10, k = idx & 1023;
    ((float*)p.H)[idx] = o < 4 ? p.w_rg[k * 4 + o] : p.w_re[k * 32 + (o - 4)];
}
__global__ __launch_bounds__(256) void nk_final(Params p) { final_token(p, blockIdx.x * 4 + (threadIdx.x >> 6), threadIdx.x & 63); }

static size_t carve(size_t& off, size_t bytes) { const size_t o = off; off += (bytes + 255) & ~(size_t)255; return o; }
extern "C" void kernel_launch(void* const* d_in, const int* in_sizes, int n_in, void* d_out, int out_size, void* d_ws, size_t ws_size, hipStream_t stream) {
    Params p{};
    p.x = (const float*)d_in[0]; p.pos = (const int*)d_in[1]; p.ln0_g = (const float*)d_in[2]; p.ln0_b = (const float*)d_in[3]; p.w_in = (const float*)d_in[4];
    p.gm_g = (const float*)d_in[5]; p.gm_b = (const float*)d_in[6]; p.w_sp = (const float*)d_in[7]; p.b_sp = (const float*)d_in[8]; p.qn_g = (const float*)d_in[9];
    p.w_uq = (const float*)d_in[10]; p.kvn_g = (const float*)d_in[11]; p.w_ukv = (const float*)d_in[12]; p.w_out = (const float*)d_in[13]; p.ln1_g = (const float*)d_in[14];
    p.ln1_b = (const float*)d_in[15]; p.w_rg = (const float*)d_in[16]; p.b_rg = (const float*)d_in[17]; p.w_re = (const float*)d_in[18]; p.b_re = (const float*)d_in[19];
    p.w_gate = (const float*)d_in[20]; p.w_up = (const float*)d_in[21]; p.w_down = (const float*)d_in[22]; p.ln2_g = (const float*)d_in[23]; p.ln2_b = (const float*)d_in[24];
    p.out = (float*)d_out;
    char* ws = (char*)d_ws; size_t off = 0;
    p.bar = (unsigned*)(ws + carve(off, 16384));
    p.cnt = (int*)(ws + carve(off, 1024));
    p.WinT = (bf16_t*)(ws + carve(off, (size_t)ZN * 1024 * 2)); p.WuqT = (bf16_t*)(ws + carve(off, 768 * 384 * 2)); p.WukvT = (bf16_t*)(ws + carve(off, 1024 * 256 * 2));
    p.WoutT = (bf16_t*)(ws + carve(off, 1024 * 1024 * 2)); p.WguT = (bf16_t*)(ws + carve(off, (size_t)32 * 512 * 1024 * 2)); p.WdT = (bf16_t*)(ws + carve(off, (size_t)32 * 1024 * 256 * 2));
    p.hbuf = (bf16_t*)(ws + carve(off, (size_t)T_TOK * DM * 2)); p.rope = (float2*)(ws + carve(off, (size_t)T_TOK * 32 * 8));
    p.list = (int*)(ws + carve(off, (size_t)NEXP * LIST_CAP * 4)); p.gates = (float*)(ws + carve(off, (size_t)T_TOK * 2 * 4));
    p.rsq = (float*)(ws + carve(off, T_TOK * 4)); p.rskv = (float*)(ws + carve(off, T_TOK * 4));
    const size_t stage0 = off;
    p.zu = (bf16_t*)(ws + carve(off, (size_t)T_TOK * 512 * 2)); p.zv = (bf16_t*)(ws + carve(off, (size_t)T_TOK * 512 * 2));
    p.zq = (bf16_t*)(ws + carve(off, (size_t)T_TOK * 384 * 2)); p.zkv = (bf16_t*)(ws + carve(off, (size_t)T_TOK * 256 * 2)); p.krope = (bf16_t*)(ws + carve(off, (size_t)T_TOK * 64 * 2));
    p.Q = (bf16_t*)(ws + carve(off, (size_t)T_TOK * 768 * 2)); p.Kn = (bf16_t*)(ws + carve(off, (size_t)T_TOK * 512 * 2)); p.Vt = (bf16_t*)(ws + carve(off, (size_t)T_TOK * 512 * 2));
    p.mix = (bf16_t*)(ws + carve(off, (size_t)T_TOK * DM * 2));
    const size_t stage_end = off;
    size_t o2 = stage0; p.contrib = (bf16_t*)(ws + carve(o2, (size_t)T_TOK * 2 * DM * 2)); p.H = (bf16_t*)(ws + carve(o2, (size_t)(65536 + 8192) * FF * 2));
    if (o2 > stage_end || stage_end > ws_size) { fprintf(stderr, "kernel_launch: workspace too small (%zu needed, %zu given)\n", stage_end, ws_size); return; }

    static bool attr = false;
    if (!attr) { attr = true;
        hipFuncSetAttribute((const void*)nk_gmlp, hipFuncAttributeMaxDynamicSharedMemorySize, 128 * 129 * 4);
        hipFuncSetAttribute((const void*)nk_attn, hipFuncAttributeMaxDynamicSharedMemorySize, (64 * 192 + 64 * 193 + 64 * 65 + 64 * 128) * 4); }
    nk_prep_w<<<J_TOTAL, 256, 0, stream>>>(p);
    nk_ln0<<<T_TOK / 4, 256, 0, stream>>>(p);
    nk_rope<<<T_TOK * 32 / 256, 256, 0, stream>>>(p);
    nk_gemm<PhZ><<<dim3(PhZ::NU, 32), 256, 0, stream>>>(PhZ{p});
    nk_rowscale<<<T_TOK / 4, 256, 0, stream>>>(p);
    nk_gemm<PhQ><<<dim3(PhQ::NU, 32), 256, 0, stream>>>(PhQ{p, p.rsq});
    nk_gemm<PhKV><<<dim3(PhKV::NU, 32), 256, 0, stream>>>(PhKV{p, p.rskv});
    nk_gmlp<<<T_TOK / 128 * 4, 256, 128 * 129 * 4, stream>>>(p);
    nk_attn<<<64 * 32, 256, (64 * 192 + 64 * 193 + 64 * 65 + 64 * 128) * 4, stream>>>(p);
    nk_gemm<PhY><<<dim3(PhY::NU, 32), 256, 0, stream>>>(PhY{p});
    nk_router_prep<<<144, 256, 0, stream>>>(p);
    nk_router<<<T_TOK / 4, 256, 0, stream>>>(p);
    nk_gemm<PhH><<<dim3(PhH::NU, 32), 256, 0, stream>>>(PhH{p});
    nk_gemm<PhC><<<dim3(PhC::NU, 32), 256, 0, stream>>>(PhC{p});
    nk_final<<<T_TOK / 4, 256, 0, stream>>>(p);
}
```

```cpp
#include <hip/hip_runtime.h>
#define P2VAR 0
#include <stdint.h>
#include <cstdio>

#define LAS __attribute__((address_space(3)))
typedef unsigned short bf16_t;
typedef short bf16x8 __attribute__((ext_vector_type(8)));
typedef float f32x4 __attribute__((ext_vector_type(4)));
typedef float f32x16 __attribute__((ext_vector_type(16)));
typedef unsigned u32x2 __attribute__((ext_vector_type(2)));
typedef unsigned u32x4 __attribute__((ext_vector_type(4)));

constexpr int T_TOK = 32768, DM = 1024, SEQ = 2048, NBATCH = 16;
constexpr int ZN = 1792;
constexpr int NEXP = 32, FF = 256;
constexpr int LIST_CAP = 32768;
constexpr float ALPHA = 1.189207115002721f;
constexpr float QSCALE = 0.07216878364870322f * 1.4426950408889634f;

struct Params {
    const float* x; const int* pos; const float *ln0_g, *ln0_b, *w_in, *gm_g, *gm_b, *w_sp, *b_sp, *qn_g, *w_uq, *kvn_g, *w_ukv, *w_out, *ln1_g, *ln1_b,
        *w_rg, *b_rg, *w_re, *b_re, *w_gate, *w_up, *w_down, *ln2_g, *ln2_b;
    float* out;
    bf16_t *WinT, *WuqT, *WukvT, *WoutT, *WguT, *WdT;
    bf16_t* hbuf; float2* rope;
    bf16_t *zu, *zv, *zq, *zkv, *krope, *Q, *Kn, *Vt, *mix;
    float *rsq, *rskv;
    int* cnt; int* list; float* gates; bf16_t* H; bf16_t* contrib;
    unsigned* bar;
};

__device__ __forceinline__ unsigned pk2(float lo, float hi) { unsigned r; asm volatile("v_cvt_pk_bf16_f32 %0, %1, %2" : "=v"(r) : "v"(lo), "v"(hi)); return r; }
__device__ __forceinline__ bf16_t f2bf(float f) { return (bf16_t)(pk2(f, 0.f) & 0xffffu); }
__device__ __forceinline__ float bf2f(bf16_t h) { return __uint_as_float(((unsigned)h) << 16); }
__device__ __forceinline__ float bflo(unsigned u) { return __uint_as_float(u << 16); }
__device__ __forceinline__ float bfhi(unsigned u) { return __uint_as_float(u & 0xffff0000u); }
__device__ __forceinline__ void st4(bf16_t* p, f32x4 v) { u32x2 w; w.x = pk2(v[0], v[1]); w.y = pk2(v[2], v[3]); *(u32x2*)p = w; }
__device__ __forceinline__ float wave_sum(float v) {
#pragma unroll
    for (int o = 1; o < 64; o <<= 1) v += __shfl_xor(v, o);
    return v;
}
__device__ __forceinline__ float gelu_tanh(float x) {
    const float u = x + 0.044715f * x * x * x;
    const float e = __builtin_amdgcn_exp2f(-2.f * 0.7978845608028654f * 1.4426950408889634f * u);
    return x * __builtin_amdgcn_rcpf(1.f + e);
}
__device__ __forceinline__ float silu_f(float x) { return x * __builtin_amdgcn_rcpf(1.f + __builtin_amdgcn_exp2f(-1.4426950408889634f * x)); }
__device__ __forceinline__ int perm16(int k) { return 8 * ((k >> 2) & 1) + (k & 3) + 4 * (k >> 3); }

struct AMap {
    const bf16_t* base; int ld; const int* list; int nvalid;
    __device__ __forceinline__ const bf16_t* row(int r) const {
        if (list) { const int a = list[r < nvalid ? r : 0]; return base + (size_t)(a >> 1) * ld; }
        return base + (size_t)r * ld;
    }
};

struct EpiZ {
    bf16_t *zu, *zv, *zq, *zkv, *krope; const float2* rope; int row0, col0;
    __device__ __forceinline__ void half(int row, int c, f32x4 v) const {
        if (c < 1024) {
            f32x4 g; g[0] = gelu_tanh(v[0]); g[1] = gelu_tanh(v[1]); g[2] = gelu_tanh(v[2]); g[3] = gelu_tanh(v[3]);
            if (c < 512) st4(zu + (size_t)row * 512 + c, g); else st4(zv + (size_t)row * 512 + (c - 512), g);
        } else if (c < 1408) st4(zq + (size_t)row * 384 + (c - 1024), v);
        else if (c < 1664) st4(zkv + (size_t)row * 256 + (c - 1408), v);
        else if (c < 1728) {
            const int i0 = (c - 1664) >> 1;
            const float2 cs0 = rope[(size_t)row * 32 + i0], cs1 = rope[(size_t)row * 32 + i0 + 1];
            bf16_t* kr = krope + (size_t)row * 64;
            kr[i0] = f2bf(v[0] * cs0.x - v[1] * cs0.y); kr[i0 + 32] = f2bf(v[1] * cs0.x + v[0] * cs0.y);
            kr[i0 + 1] = f2bf(v[2] * cs1.x - v[3] * cs1.y); kr[i0 + 33] = f2bf(v[3] * cs1.x + v[2] * cs1.y);
        }
    }
    __device__ __forceinline__ void operator()(int r, int c32, int fq, f32x4 a, f32x4 b) const { const int row = row0 + r, c = col0 + c32 + 4 * fq; half(row, c, a); half(row, c + 16, b); }
};
struct EpiQ {
    bf16_t* Q; const float2* rope; const float* rs; int rs0; int row0, col0;
    __device__ __forceinline__ void half(int row, int c, f32x4 v, float sc) const {
        const int h = c / 192, d = c - h * 192, b = row >> 11, s = row & 2047;
        bf16_t* q = Q + ((size_t)((b * 4 + h) * SEQ + s)) * 192;
        v = v * sc;
        if (d < 128) st4(q + d, v);
        else {
            const int i0 = (d - 128) >> 1;
            const float2 cs0 = rope[(size_t)row * 32 + i0], cs1 = rope[(size_t)row * 32 + i0 + 1];
            q[128 + i0] = f2bf(v[0] * cs0.x - v[1] * cs0.y); q[160 + i0] = f2bf(v[1] * cs0.x + v[0] * cs0.y);
            q[129 + i0] = f2bf(v[2] * cs1.x - v[3] * cs1.y); q[161 + i0] = f2bf(v[3] * cs1.x + v[2] * cs1.y);
        }
    }
    __device__ __forceinline__ void operator()(int r, int c32, int fq, f32x4 a, f32x4 b) const {
        const int row = row0 + r, c = col0 + c32 + 4 * fq; const float sc = rs[row - rs0] * QSCALE; half(row, c, a, sc); half(row, c + 16, b, sc); }
};
struct EpiKV {
    bf16_t *Kn, *Vt; const float* rs; int rs0; int row0, col0;
    __device__ __forceinline__ void half(int row, int c, f32x4 v, float sc) const {
        const int h = c >> 8, e = c & 255, b = row >> 11, s = row & 2047;
        v = v * sc;
        if (e < 128) st4(Kn + ((size_t)((b * 4 + h) * SEQ + s)) * 128 + e, v);
        else {
            bf16_t* vt = Vt + ((size_t)((b * 4 + h) * 128 + (e - 128))) * SEQ + (s & ~15) + perm16(s & 15);
            vt[0] = f2bf(v[0]); vt[SEQ] = f2bf(v[1]); vt[2 * SEQ] = f2bf(v[2]); vt[3 * SEQ] = f2bf(v[3]);
        }
    }
    __device__ __forceinline__ void operator()(int r, int c32, int fq, f32x4 a, f32x4 b) const {
        const int row = row0 + r, c = col0 + c32 + 4 * fq; const float sc = rs[row - rs0]; half(row, c, a, sc); half(row, c + 16, b, sc); }
};
struct EpiY {
    bf16_t* hb; int row0, col0;
    __device__ __forceinline__ void half(int row, int c, f32x4 v) const {
        bf16_t* p = hb + (size_t)row * DM + c; const u32x2 h = *(const u32x2*)p;
        v[0] += ALPHA * bflo(h.x); v[1] += ALPHA * bfhi(h.x); v[2] += ALPHA * bflo(h.y); v[3] += ALPHA * bfhi(h.y);
        st4(p, v);
    }
    __device__ __forceinline__ void operator()(int r, int c32, int fq, f32x4 a, f32x4 b) const { const int row = row0 + r, c = col0 + c32 + 4 * fq; half(row, c, a); half(row, c + 16, b); }
};
struct EpiH {
    bf16_t* H; int hrow0, col0;
    __device__ __forceinline__ void operator()(int r, int c32, int fq, f32x4 a, f32x4 b) const {
        const int hid = ((col0 + c32) >> 5) * 16 + 4 * fq;
        f32x4 o; o[0] = silu_f(a[0]) * b[0]; o[1] = silu_f(a[1]) * b[1]; o[2] = silu_f(a[2]) * b[2]; o[3] = silu_f(a[3]) * b[3];
        st4(H + (size_t)(hrow0 + r) * FF + hid, o);
    }
};
struct EpiC {
    bf16_t* contrib; const int* list; const float* gates; int nvalid; int col0;
    __device__ __forceinline__ void operator()(int r, int c32, int fq, f32x4 a, f32x4 b) const {
        if (r >= nvalid) return;
        const int aid = list[r]; const float g = gates[aid];
        bf16_t* p = contrib + (size_t)aid * DM + col0 + c32 + 4 * fq;
        st4(p, a * g); st4(p + 16, b * g);
    }
};

template <class EP> struct Unit { AMap am; const bf16_t* bt; int K; EP ep; };

__device__ __forceinline__ bool moe_unit(const int* cnt, int u, int ncol, int& e, int& rt, int& ct, int& padrow) {
    int acc = 0;
    for (e = 0; e < NEXP; ++e) {
        const int t = (cnt[e] + 255) >> 8;
        if (u < (acc + t) * ncol) { const int w = u - acc * ncol; rt = w / ncol; ct = w - rt * ncol; padrow = (acc + rt) * 256; return true; }
        acc += t;
    }
    return false;
}

struct PhZ { Params p; typedef EpiZ EP; static constexpr int NU = 128 * 7;
    __device__ __forceinline__ bool unit(int u, Unit<EP>& o) const { const int pm = u / 7, pn = u - pm * 7;
        o.am = AMap{p.hbuf + (size_t)pm * 256 * DM, DM, nullptr, 256}; o.bt = p.WinT + (size_t)pn * 256 * DM; o.K = DM;
        o.ep = EpiZ{p.zu, p.zv, p.zq, p.zkv, p.krope, p.rope, pm * 256, pn * 256}; return true; } };
struct PhQ { Params p; const float* rs; typedef EpiQ EP; static constexpr int NU = 128 * 3;
    __device__ __forceinline__ bool unit(int u, Unit<EP>& o) const { const int pm = u / 3, pn = u - pm * 3;
        o.am = AMap{p.zq + (size_t)pm * 256 * 384, 384, nullptr, 256}; o.bt = p.WuqT + (size_t)pn * 256 * 384; o.K = 384;
        o.ep = EpiQ{p.Q, p.rope, rs, 0, pm * 256, pn * 256}; return true; } };
struct PhKV { Params p; const float* rs; typedef EpiKV EP; static constexpr int NU = 128 * 4;
    __device__ __forceinline__ bool unit(int u, Unit<EP>& o) const { const int pm = u >> 2, pn = u & 3;
        o.am = AMap{p.zkv + (size_t)pm * 256 * 256, 256, nullptr, 256}; o.bt = p.WukvT + (size_t)pn * 256 * 256; o.K = 256;
        o.ep = EpiKV{p.Kn, p.Vt, rs, 0, pm * 256, pn * 256}; return true; } };
struct PhY { Params p; typedef EpiY EP; static constexpr int NU = 128 * 4;
    __device__ __forceinline__ bool unit(int u, Unit<EP>& o) const { const int pm = u >> 2, pn = u & 3;
        o.am = AMap{p.mix + (size_t)pm * 256 * DM, DM, nullptr, 256}; o.bt = p.WoutT + (size_t)pn * 256 * DM; o.K = DM;
        o.ep = EpiY{p.hbuf, pm * 256, pn * 256}; return true; } };
struct PhH { Params p; typedef EpiH EP; static constexpr int NU = 288 * 2;
    __device__ __forceinline__ bool unit(int u, Unit<EP>& o) const { int e, rt, ct, pr; if (!moe_unit(p.cnt, u, 2, e, rt, ct, pr)) return false;
        const int nv = min(256, p.cnt[e] - rt * 256);
        o.am = AMap{p.hbuf, DM, p.list + (size_t)e * LIST_CAP + rt * 256, nv}; o.bt = p.WguT + ((size_t)e * 512 + ct * 256) * DM; o.K = DM;
        o.ep = EpiH{p.H, pr, ct * 256}; return true; } };
struct PhC { Params p; typedef EpiC EP; static constexpr int NU = 288 * 4;
    __device__ __forceinline__ bool unit(int u, Unit<EP>& o) const { int e, rt, ct, pr; if (!moe_unit(p.cnt, u, 4, e, rt, ct, pr)) return false;
        const int nv = min(256, p.cnt[e] - rt * 256);
        o.am = AMap{p.H + (size_t)pr * FF, FF, nullptr, 256}; o.bt = p.WdT + ((size_t)e * DM + ct * 256) * FF; o.K = FF;
        o.ep = EpiC{p.contrib, p.list + (size_t)e * LIST_CAP + rt * 256, p.gates, nv, ct * 256}; return true; } };

__device__ __forceinline__ void wtile(const float* s0, const float* s1, int ldsrc, bf16_t* dst, int K, int k0, int n0, int mode, const float* kscale, float* tile, int tid, int nthr) {
    for (int idx = tid; idx < 4096; idx += nthr) {
        const int kk = idx >> 6, n = n0 + (idx & 63);
        const float* s = s0; int col = n;
        if (mode == 1) { if (n >= 1728) col = -1; else if (n >= 1664) { const int i = (n - 1664) >> 1, pp = (n - 1664) & 1; col = 1664 + i + 32 * pp; } }
        else if (mode == 2) { const int h = n / 192, d = n - h * 192; if (d >= 128) { const int i = (d - 128) >> 1, pp = (d - 128) & 1; col = h * 192 + 128 + i + 32 * pp; } }
        else if (mode == 3) { const int G = n >> 5, r = n & 31; col = 16 * G + (r & 15); s = (r < 16) ? s0 : s1; }
        float v = 0.f;
        if (col >= 0) { v = s[(size_t)(k0 + kk) * ldsrc + col]; if (kscale) v *= kscale[k0 + kk]; }
        tile[kk * 65 + (idx & 63)] = v;
    }
    __syncthreads();
    for (int idx = tid; idx < 4096; idx += nthr) {
        const int nn = idx >> 6, kk = idx & 63;
        dst[(size_t)(n0 + nn) * K + k0 + kk] = f2bf(tile[kk * 65 + nn]);
    }
    __syncthreads();
}
constexpr int J_IN = 28 * 16, J_UQ = 12 * 6, J_UKV = 16 * 4, J_OUT = 16 * 16, J_GU = 32 * 8 * 16, J_DN = 32 * 16 * 4;
constexpr int J_TOTAL = J_IN + J_UQ + J_UKV + J_OUT + J_GU + J_DN;
__device__ __forceinline__ void prep_wjob(const Params& p, int job, float* tile, int tid, int nthr) {
    if (job < J_IN) { const int nb = job >> 4, kb = job & 15; wtile(p.w_in, nullptr, 1728, p.WinT, 1024, kb * 64, nb * 64, 1, nullptr, tile, tid, nthr); return; } job -= J_IN;
    if (job < J_UQ) { const int nb = job / 6, kb = job - nb * 6; wtile(p.w_uq, nullptr, 768, p.WuqT, 384, kb * 64, nb * 64, 2, p.qn_g, tile, tid, nthr); return; } job -= J_UQ;
    if (job < J_UKV) { const int nb = job >> 2, kb = job & 3; wtile(p.w_ukv, nullptr, 1024, p.WukvT, 256, kb * 64, nb * 64, 0, p.kvn_g, tile, tid, nthr); return; } job -= J_UKV;
    if (job < J_OUT) { const int nb = job >> 4, kb = job & 15; wtile(p.w_out, nullptr, 1024, p.WoutT, 1024, kb * 64, nb * 64, 0, nullptr, tile, tid, nthr); return; } job -= J_OUT;
    if (job < J_GU) { const int e = job >> 7, r = job & 127, nb = r >> 4, kb = r & 15;
        wtile(p.w_gate + (size_t)e * 1024 * 256, p.w_up + (size_t)e * 1024 * 256, 256, p.WguT + (size_t)e * 512 * 1024, 1024, kb * 64, nb * 64, 3, nullptr, tile, tid, nthr); return; } job -= J_GU;
    { const int e = job >> 6, r = job & 63, nb = r >> 2, kb = r & 3;
        wtile(p.w_down + (size_t)e * 256 * 1024, nullptr, 1024, p.WdT + (size_t)e * 1024 * 256, 256, kb * 64, nb * 64, 0, nullptr, tile, tid, nthr); }
}
__device__ __forceinline__ void ln0_row(const float* xr, const float* g, const float* b, bf16_t* orow, int lane) {
    f32x4 v[4]; float s = 0.f;
#pragma unroll
    for (int j = 0; j < 4; ++j) { v[j] = *(const f32x4*)(xr + 256 * j + 4 * lane); s += (v[j][0] + v[j][1]) + (v[j][2] + v[j][3]); }
    const float mean = wave_sum(s) * (1.f / 1024.f); float s2 = 0.f;
#pragma unroll
    for (int j = 0; j < 4; ++j) { v[j] = v[j] - mean; s2 += (v[j][0] * v[j][0] + v[j][1] * v[j][1]) + (v[j][2] * v[j][2] + v[j][3] * v[j][3]); }
    const float rstd = 1.f / sqrtf(wave_sum(s2) * (1.f / 1024.f) + 1e-5f);
#pragma unroll
    for (int j = 0; j < 4; ++j) { const f32x4 gg = *(const f32x4*)(g + 256 * j + 4 * lane), bb = *(const f32x4*)(b + 256 * j + 4 * lane);
        st4(orow + 256 * j + 4 * lane, v[j] * rstd * gg + bb); }
}
__device__ __forceinline__ void rope_entry(const Params& p, int idx) {
    const int t = idx >> 5, i = idx & 31;
    const float inv = powf(10000.f, -(float)(2 * i) / 64.f);
    const float ang = (float)p.pos[t] * inv;
    p.rope[idx] = make_float2(cosf(ang), sinf(ang));
}

__device__ __forceinline__ void router_token(const Params& p, int t, int lane, const float* wr  , int wstride) {
    bf16_t* hr = p.hbuf + (size_t)t * DM;
    f32x4 v[4]; float s = 0.f;
#pragma unroll
    for (int j = 0; j < 4; ++j) { const u32x2 w = *(const u32x2*)(hr + 256 * j + 4 * lane); v[j][0] = bflo(w.x); v[j][1] = bfhi(w.x); v[j][2] = bflo(w.y); v[j][3] = bfhi(w.y);
        s += (v[j][0] + v[j][1]) + (v[j][2] + v[j][3]); }
    const float mean = wave_sum(s) * (1.f / 1024.f); float s2 = 0.f;
#pragma unroll
    for (int j = 0; j < 4; ++j) { v[j] = v[j] - mean; s2 += (v[j][0] * v[j][0] + v[j][1] * v[j][1]) + (v[j][2] * v[j][2] + v[j][3] * v[j][3]); }
    const float rstd = 1.f / sqrtf(wave_sum(s2) * (1.f / 1024.f) + 1e-5f);
#pragma unroll
    for (int j = 0; j < 4; ++j) { const f32x4 gg = *(const f32x4*)(p.ln1_g + 256 * j + 4 * lane), bb = *(const f32x4*)(p.ln1_b + 256 * j + 4 * lane);
        v[j] = v[j] * rstd * gg + bb; st4(hr + 256 * j + 4 * lane, v[j]); }
    float lg[36];
#pragma unroll
    for (int o = 0; o < 36; ++o) { float a = 0.f;
#pragma unroll
        for (int j = 0; j < 4; ++j) { const f32x4 w = *(const f32x4*)(wr + o * wstride + 256 * j + 4 * lane); a += (v[j][0] * w[0] + v[j][1] * w[1]) + (v[j][2] * w[2] + v[j][3] * w[3]); }
        lg[o] = wave_sum(a); }
#pragma unroll
    for (int o = 0; o < 4; ++o) lg[o] += p.b_rg[o];
#pragma unroll
    for (int o = 0; o < 32; ++o) lg[4 + o] += p.b_re[o];
    int g = 0; float gm = lg[0];
#pragma unroll
    for (int i = 1; i < 4; ++i) if (lg[i] > gm) { gm = lg[i]; g = i; }
    float se = 0.f;
#pragma unroll
    for (int i = 0; i < 4; ++i) se += expf(lg[i] - gm);
    const float pg = 1.f / se;
    float ev[8];
#pragma unroll
    for (int e = 0; e < 8; ++e) ev[e] = g == 0 ? lg[4 + e] : g == 1 ? lg[12 + e] : g == 2 ? lg[20 + e] : lg[28 + e];
    int i1 = 0; float v1 = ev[0];
#pragma unroll
    for (int e = 1; e < 8; ++e) if (ev[e] > v1) { v1 = ev[e]; i1 = e; }
    int i2 = -1; float v2 = -3.0e38f;
#pragma unroll
    for (int e = 0; e < 8; ++e) if (e != i1 && ev[e] > v2) { v2 = ev[e]; i2 = e; }
    const float d = expf(v2 - v1), g1 = pg / (1.f + d), g2 = pg * d / (1.f + d);
    if (lane < 2) {
        const int ex = g * 8 + (lane == 0 ? i1 : i2), aid = 2 * t + lane;
        const int slot = atomicAdd(p.cnt + ex, 1);
        p.list[(size_t)ex * LIST_CAP + slot] = aid;
        p.gates[aid] = lane == 0 ? g1 : g2;
    }
}
__device__ __forceinline__ void final_token(const Params& p, int t, int lane) {
    const bf16_t* hr = p.hbuf + (size_t)t * DM; const bf16_t* c0 = p.contrib + (size_t)(2 * t) * DM; const bf16_t* c1 = c0 + DM;
    f32x4 v[4]; float s = 0.f;
#pragma unroll
    for (int j = 0; j < 4; ++j) { const int o = 256 * j + 4 * lane; const u32x2 w = *(const u32x2*)(hr + o), a = *(const u32x2*)(c0 + o), b = *(const u32x2*)(c1 + o);
        v[j][0] = ALPHA * bflo(w.x) + bflo(a.x) + bflo(b.x); v[j][1] = ALPHA * bfhi(w.x) + bfhi(a.x) + bfhi(b.x);
        v[j][2] = ALPHA * bflo(w.y) + bflo(a.y) + bflo(b.y); v[j][3] = ALPHA * bfhi(w.y) + bfhi(a.y) + bfhi(b.y);
        s += (v[j][0] + v[j][1]) + (v[j][2] + v[j][3]); }
    const float mean = wave_sum(s) * (1.f / 1024.f); float s2 = 0.f;
#pragma unroll
    for (int j = 0; j < 4; ++j) { v[j] = v[j] - mean; s2 += (v[j][0] * v[j][0] + v[j][1] * v[j][1]) + (v[j][2] * v[j][2] + v[j][3] * v[j][3]); }
    const float rstd = 1.f / sqrtf(wave_sum(s2) * (1.f / 1024.f) + 1e-5f);
#pragma unroll
    for (int j = 0; j < 4; ++j) { const int o = 256 * j + 4 * lane; const f32x4 gg = *(const f32x4*)(p.ln2_g + o), bb = *(const f32x4*)(p.ln2_b + o);
        *(f32x4*)(p.out + (size_t)t * DM + o) = v[j] * rstd * gg + bb; }
}

__global__ __launch_bounds__(256) void nk_prep_w(Params p) { __shared__ float tile[64 * 65]; prep_wjob(p, blockIdx.x, tile, threadIdx.x, 256); }
__global__ __launch_bounds__(256) void nk_ln0(Params p) { const int t = blockIdx.x * 4 + (threadIdx.x >> 6); ln0_row(p.x + (size_t)t * DM, p.ln0_g, p.ln0_b, p.hbuf + (size_t)t * DM, threadIdx.x & 63); }
__global__ __launch_bounds__(256) void nk_rope(Params p) { rope_entry(p, blockIdx.x * 256 + threadIdx.x); if (blockIdx.x == 0 && threadIdx.x < NEXP) p.cnt[threadIdx.x] = 0; }
__global__ __launch_bounds__(256) void nk_rowscale(Params p) {
    const int t = blockIdx.x * 4 + (threadIdx.x >> 6), lane = threadIdx.x & 63;
    float s = 0.f; for (int i = lane; i < 384; i += 64) { const float v = bf2f(p.zq[(size_t)t * 384 + i]); s += v * v; }
    s = wave_sum(s); float s2 = 0.f; for (int i = lane; i < 256; i += 64) { const float v = bf2f(p.zkv[(size_t)t * 256 + i]); s2 += v * v; }
    s2 = wave_sum(s2);
    if (lane == 0) { p.rsq[t] = 1.f / sqrtf(s * (1.f / 384.f) + 1e-6f); p.rskv[t] = 1.f / sqrtf(s2 * (1.f / 256.f) + 1e-6f); }
}
template <class PH> __global__ __launch_bounds__(256) void nk_gemm(PH ph) {
    Unit<typename PH::EP> u; if (!ph.unit(blockIdx.x, u)) return;
    const int wave = threadIdx.x >> 6, lane = threadIdx.x & 63, fr = lane & 15, fq = lane >> 4;
    const int task = blockIdx.y * 4 + wave, rb = task >> 3, cg = task & 7;
    const bf16_t* arow = u.am.row(rb * 16 + fr);
    const bf16_t* b0 = u.bt + (size_t)(cg * 32 + fr) * u.K; const bf16_t* b1 = b0 + (size_t)16 * u.K;
    f32x4 acc0 = {0.f, 0.f, 0.f, 0.f}, acc1 = {0.f, 0.f, 0.f, 0.f};
    for (int k = 0; k < u.K; k += 32) {
        const bf16x8 a = *(const bf16x8*)(arow + k + 8 * fq), x0 = *(const bf16x8*)(b0 + k + 8 * fq), x1 = *(const bf16x8*)(b1 + k + 8 * fq);
        acc0 = __builtin_amdgcn_mfma_f32_16x16x32_bf16(x0, a, acc0, 0, 0, 0);
        acc1 = __builtin_amdgcn_mfma_f32_16x16x32_bf16(x1, a, acc1, 0, 0, 0);
    }
    u.ep(rb * 16 + fr, cg * 32, fq, acc0, acc1);
}
__global__ __launch_bounds__(256) void nk_gmlp(Params p) {
    extern __shared__ float sm[];
    const int unit = blockIdx.x, h = unit & 3, bn = unit >> 2, row0 = bn * 128;
    const int wave = threadIdx.x >> 6, lane = threadIdx.x & 63;
    for (int j = wave; j < 128; j += 4) {
        const bf16_t* vr = p.zv + (size_t)(row0 + j) * 512 + h * 128;
        const float a = bf2f(vr[lane]), b = bf2f(vr[lane + 64]);
        const float mean = wave_sum(a + b) * (1.f / 128.f); const float da = a - mean, db = b - mean;
        const float rstd = 1.f / sqrtf(wave_sum(da * da + db * db) * (1.f / 128.f) + 1e-5f);
        sm[j * 129 + lane] = da * rstd * p.gm_g[h * 128 + lane] + p.gm_b[h * 128 + lane];
        sm[j * 129 + lane + 64] = db * rstd * p.gm_g[h * 128 + lane + 64] + p.gm_b[h * 128 + lane + 64];
    }
    __syncthreads();
    for (int idx = threadIdx.x; idx < 16384; idx += 256) {
        const int i = idx >> 7, c = idx & 127; const int jn = i < 64 ? 64 : 128;
        const float* w = p.w_sp + ((size_t)h * 128 + i) * 128; float f = p.b_sp[h * 128 + i];
        for (int j = 0; j < jn; ++j) f += w[j] * sm[j * 129 + c];
        const float u = bf2f(p.zu[(size_t)(row0 + i) * 512 + h * 128 + c]);
        p.mix[(size_t)(row0 + i) * DM + h * 128 + c] = f2bf(u * f);
    }
}
__global__ __launch_bounds__(256) void nk_attn(Params p) {
    extern __shared__ float sm[];
    float* Qs = sm; float* Ks = Qs + 64 * 192; float* Ss = Ks + 64 * 193; float* Vs = Ss + 64 * 65;
    const int qc = blockIdx.x & 31, bh = blockIdx.x >> 5, b = bh >> 2, h = bh & 3, tid = threadIdx.x, q = tid >> 2, sub = tid & 3;
    for (int idx = tid; idx < 64 * 192; idx += 256) { const int r = idx / 192, d = idx - r * 192; Qs[idx] = bf2f(p.Q[((size_t)bh * SEQ + qc * 64 + r) * 192 + d]); }
    float O[32]; float m = -INFINITY, l = 0.f;
#pragma unroll
    for (int j = 0; j < 32; ++j) O[j] = 0.f;
    for (int kt = 0; kt <= qc; ++kt) {
        __syncthreads();
        for (int idx = tid; idx < 64 * 192; idx += 256) { const int r = idx / 192, d = idx - r * 192; const int key = kt * 64 + r;
            Ks[r * 193 + d] = d < 128 ? bf2f(p.Kn[((size_t)bh * SEQ + key) * 128 + d]) : bf2f(p.krope[((size_t)b * SEQ + key) * 64 + d - 128]); }
        for (int idx = tid; idx < 64 * 128; idx += 256) { const int r = idx >> 7, dv = idx & 127; const int key = kt * 64 + r;
            Vs[r * 128 + dv] = bf2f(p.Vt[((size_t)bh * 128 + dv) * SEQ + (key & ~15) + perm16(key & 15)]); }
        __syncthreads();
        for (int kk = 0; kk < 16; ++kk) { const int key = sub * 16 + kk; float s = 0.f;
            for (int d = 0; d < 192; ++d) s += Qs[q * 192 + d] * Ks[key * 193 + d];
            Ss[q * 65 + key] = s; }
        __syncthreads();
        float mt = -INFINITY; for (int k = 0; k < 64; ++k) mt = fmaxf(mt, Ss[q * 65 + k]);
        const float mn = fmaxf(m, mt), alpha = exp2f(m - mn); m = mn; l *= alpha;
#pragma unroll
        for (int j = 0; j < 32; ++j) O[j] *= alpha;
        for (int k = 0; k < 64; ++k) { const float pk = exp2f(Ss[q * 65 + k] - mn); l += pk;
#pragma unroll
            for (int j = 0; j < 32; ++j) O[j] += pk * Vs[k * 128 + sub * 32 + j]; }
    }
    const float inv = 1.f / l; bf16_t* o = p.mix + ((size_t)b * SEQ + qc * 64 + q) * DM + 512 + h * 128 + sub * 32;
#pragma unroll
    for (int j = 0; j < 32; ++j) o[j] = f2bf(O[j] * inv);
}
__global__ __launch_bounds__(256) void nk_router(Params p) {
    const int t = blockIdx.x * 4 + (threadIdx.x >> 6);
    router_token(p, t, threadIdx.x & 63, (const float*)p.H, 1024);
}
__global__ __launch_bounds__(256) void nk_router_prep(Params p) {
    const int idx = blockIdx.x * 256 + threadIdx.x; if (idx >= 36 * 1024) return;
    const int o = idx >> 10, k = idx & 1023;
    ((float*)p.H)[idx] = o < 4 ? p.w_rg[k * 4 + o] : p.w_re[k * 32 + (o - 4)];
}
__global__ __launch_bounds__(256) void nk_final(Params p) { final_token(p, blockIdx.x * 4 + (threadIdx.x >> 6), threadIdx.x & 63); }

constexpr int LDS_BYTES = 152 * 1024, LDS_RS = 150 * 1024, LDS_XB = 151 * 1024;
constexpr int NTHR = 512;

#define XB_TMO      128
#define XB_XCNT(j)  (256  + 64 * (j))
#define XB_XSUB(j)  (1280 + 64 * (j))
#define XB_XGEN(j)  (2304 + 64 * (j))
#define XB_TOP      3328
#define XB_TOPGEN   3392
#define XCD_BAR_WORDS 3456
#define XB_SPIN_CAP (1u << 20)
__device__ __forceinline__ unsigned xb_ld(unsigned* p) { return __hip_atomic_load(p, __ATOMIC_RELAXED, __HIP_MEMORY_SCOPE_AGENT); }
__device__ __forceinline__ unsigned xb_add(unsigned* p, unsigned v) { return __hip_atomic_fetch_add(p, v, __ATOMIC_RELAXED, __HIP_MEMORY_SCOPE_AGENT); }
__device__ __forceinline__ unsigned xb_xcc_id() { return (unsigned)__builtin_amdgcn_s_getreg((3 << 11) | 20) & 0xFu; }
#define XB_SPIN(cond, bar) do { unsigned _sp = 0; while (cond) { __builtin_amdgcn_s_sleep(1); \
    if ((++_sp & 255u) == 0u) { if (xb_ld(&(bar)[XB_TMO])) break; if (_sp > XB_SPIN_CAP) { atomicAdd(&(bar)[XB_TMO], 1u); break; } } } } while (0)
struct XcdBarrier { unsigned* bar; unsigned x; volatile LAS unsigned* st; };
__device__ __forceinline__ XcdBarrier xcd_barrier_post(unsigned* bar, volatile LAS unsigned* st) {
    XcdBarrier b; b.bar = bar; b.x = xb_xcc_id(); b.st = st;
    if (threadIdx.x == 0) (void)xb_add(&bar[XB_XCNT(b.x)], 1u);
    return b;
}
__device__ __forceinline__ void xcd_barrier_complete(unsigned* bar, unsigned x, unsigned& nloc, unsigned& nx) {
    const unsigned G = gridDim.x * gridDim.y * gridDim.z;
    unsigned sum, cnt, mine, sp = 0u;
    for (;;) {
        sum = 0u; cnt = 0u; mine = 0u;
#pragma unroll
        for (unsigned j = 0; j < 16; ++j) { const unsigned c = xb_ld(&bar[XB_XCNT(j)]); sum += c; cnt += (c > 0u) ? 1u : 0u; mine = (j == x) ? c : mine; }
        if (sum == G) break;
        __builtin_amdgcn_s_sleep(1);
        if ((++sp & 255u) == 0u) { if (xb_ld(&bar[XB_TMO])) break; if (sp > XB_SPIN_CAP) { atomicAdd(&bar[XB_TMO], 1u); break; } }
    }
    nloc = mine > 0u ? mine : 1u; nx = cnt > 0u ? cnt : 1u;
}
__device__ __forceinline__ void xcd_barrier(const XcdBarrier& b) {
    asm volatile("s_waitcnt vmcnt(0)" ::: "memory");
    __syncthreads();
    if (threadIdx.x == 0) {
        unsigned* bar = b.bar;
        __builtin_amdgcn_s_waitcnt(0);
        unsigned nloc = b.st[0], nx = b.st[1];
        if (nloc == 0u) { xcd_barrier_complete(bar, b.x, nloc, nx); b.st[0] = nloc; b.st[1] = nx; }
        const unsigned old = xb_add(&bar[XB_XSUB(b.x)], 1u);
        const unsigned gen = old / nloc;
        if (old + 1u == (gen + 1u) * nloc) {
            __builtin_amdgcn_fence(__ATOMIC_RELEASE, "agent");
            asm volatile("s_waitcnt vmcnt(0)" ::: "memory");
            const unsigned og = xb_add(&bar[XB_TOP], 1u);
            const unsigned tg = og / nx;
            if (og + 1u == (tg + 1u) * nx) xb_add(&bar[XB_TOPGEN], 1u);
            else XB_SPIN(xb_ld(&bar[XB_TOPGEN]) == tg, bar);
            __builtin_amdgcn_fence(__ATOMIC_ACQUIRE, "agent");
            xb_add(&bar[XB_XGEN(b.x)], 1u);
            asm volatile("s_waitcnt vmcnt(0)" ::: "memory");
        } else {
            XB_SPIN(xb_ld(&bar[XB_XGEN(b.x)]) == gen, bar);
            __builtin_amdgcn_fence(__ATOMIC_ACQUIRE, "agent");
            asm volatile("s_waitcnt vmcnt(0)" ::: "memory");
        }
    }
    __syncthreads();
}

constexpr int BK = 64, HALF = 128, HT = HALF * BK;
__device__ __forceinline__ int lds_byte(int r, int c) { const int st = (r >> 4) * 2 + (c >> 5), rr = r & 15, cc = c & 31, ob = rr * 64 + cc * 2; return st * 1024 + (ob ^ (((ob >> 9) & 1) << 5)); }
__device__ __forceinline__ void stage_rc(int b, int& R, int& C) { const int st = b / 1024, sb = b % 1024, swz = sb ^ (((sb >> 9) & 1) << 5); R = (st >> 1) * 16 + swz / 64; C = (st & 1) * 32 + (swz % 64) / 2; }

template <class EP>
__device__ __forceinline__ void gemm256(const Unit<EP>& u, LAS unsigned char* lds) {
    int tid = threadIdx.x; asm volatile("" : "+v"(tid));
    const int K = u.K, nt = K / BK;
    const int wid = __builtin_amdgcn_readfirstlane(tid >> 6), lane = tid & 63, wr = wid >> 2, wc = wid & 3, fr = lane & 15, fq = lane >> 4;
    unsigned voffA[2][2], voffB[2];
    const char* gA = (const char*)u.am.base; const char* gB = (const char*)u.bt;
#pragma unroll
    for (int i = 0; i < 2; ++i) { int R, C; stage_rc(tid * 16 + i * 8192, R, C);
        voffB[i] = (unsigned)(R * K + C) * 2u;
        if (u.am.list) { const int a0 = u.am.list[R < u.am.nvalid ? R : 0], a1 = u.am.list[R + HALF < u.am.nvalid ? R + HALF : 0];
            voffA[0][i] = ((unsigned)(a0 >> 1) * (unsigned)u.am.ld + (unsigned)C) * 2u; voffA[1][i] = ((unsigned)(a1 >> 1) * (unsigned)u.am.ld + (unsigned)C) * 2u; }
        else { voffA[0][i] = (unsigned)(R * u.am.ld + C) * 2u; voffA[1][i] = (unsigned)((R + HALF) * u.am.ld + C) * 2u; } }
    const size_t hstepB = (size_t)HALF * K * 2;
    const unsigned ldsw = (unsigned)wid * 1024u;
    const int aoff = lds_byte(wr * 64 + fr, fq * 8), boff = lds_byte(wc * 32 + fr, fq * 8);
    #define SA(b,h) (((b)*2+(h))*HT*2)
    #define SB(b,h) ((4+(b)*2+(h))*HT*2)
    #define STAGE_A(bufoff,h,kt) do{ _Pragma("unroll") for(int _i=0;_i<2;++_i) { asm volatile("" : "+v"(voffA[h][_i])); \
        __builtin_amdgcn_global_load_lds((const unsigned*)(gA+(size_t)(kt)*(BK*2)+voffA[h][_i]),(LAS unsigned*)(lds+(bufoff)+ldsw+_i*8192),16,0,0);} }while(0)
    #define STAGE_B(bufoff,h,kt) do{ _Pragma("unroll") for(int _i=0;_i<2;++_i) { asm volatile("" : "+v"(voffB[_i])); \
        __builtin_amdgcn_global_load_lds((const unsigned*)(gB+(size_t)(h)*hstepB+(size_t)(kt)*(BK*2)+voffB[_i]),(LAS unsigned*)(lds+(bufoff)+ldsw+_i*8192),16,0,0);} }while(0)
    #define LDA(dst,b,h) _Pragma("unroll") for(int m=0;m<4;++m) _Pragma("unroll") for(int k=0;k<2;++k) \
        dst[m][k]=*(const LAS bf16x8*)(lds+SA(b,h)+aoff+m*2048+k*1024)
    #define LDB(dst,b,h) _Pragma("unroll") for(int n=0;n<2;++n) _Pragma("unroll") for(int k=0;k<2;++k) \
        dst[n][k]=*(const LAS bf16x8*)(lds+SB(b,h)+boff+n*2048+k*1024)
    #define MMA(ai,bj,At_,Bt_) do{__builtin_amdgcn_s_setprio(1); \
        _Pragma("unroll") for(int m=0;m<4;++m) _Pragma("unroll") for(int n=0;n<2;++n) _Pragma("unroll") for(int k=0;k<2;++k) \
          acc[ai][bj][m][n]=__builtin_amdgcn_mfma_f32_16x16x32_bf16(Bt_[n][k],At_[m][k],acc[ai][bj][m][n],0,0,0); \
        __builtin_amdgcn_s_setprio(0);}while(0)
    #define WAIT_V(n) asm volatile("s_waitcnt vmcnt(" #n ")":::"memory")
    #define WAIT_L(n) asm volatile("s_waitcnt lgkmcnt(" #n ")":::"memory")
    #define BAR __builtin_amdgcn_s_barrier()
    #define SCHED __builtin_amdgcn_sched_barrier(0)

    f32x4 acc[2][2][4][2];
#pragma unroll
    for (int a = 0; a < 2; ++a)
#pragma unroll
        for (int b = 0; b < 2; ++b)
#pragma unroll
            for (int m = 0; m < 4; ++m)
#pragma unroll
                for (int n = 0; n < 2; ++n) acc[a][b][m][n] = (f32x4){0.f, 0.f, 0.f, 0.f};
    bf16x8 At[4][2], B0[2][2], B1[2][2];
    STAGE_B(SB(0,0),0,0); STAGE_A(SA(0,0),0,0);
    STAGE_B(SB(0,1),1,0); STAGE_A(SA(0,1),1,0);
    if (wr == 1) BAR;
    WAIT_V(4); BAR;
    STAGE_B(SB(1,0),0,1); STAGE_A(SA(1,0),0,1); STAGE_B(SB(1,1),1,1);
    WAIT_V(6); BAR;
    for (int t = 0; t < nt - 2; t += 2) {
        LDB(B0,0,0); SCHED; LDA(At,0,0); STAGE_A(SA(1,1),1,t+1);
        WAIT_L(8); BAR; WAIT_L(0); MMA(0,0,At,B0); BAR; SCHED;
        LDB(B1,0,1); STAGE_B(SB(0,0),0,t+2);
        BAR; WAIT_L(0); MMA(0,1,At,B1); BAR;
        LDA(At,0,1); STAGE_A(SA(0,0),0,t+2);
        BAR; WAIT_L(0); MMA(1,0,At,B0); BAR; SCHED;
        STAGE_B(SB(0,1),1,t+2);
        WAIT_V(6); BAR; MMA(1,1,At,B1); BAR;
        LDB(B0,1,0); SCHED; LDA(At,1,0); STAGE_A(SA(0,1),1,t+2);
        WAIT_L(8); BAR; WAIT_L(0); MMA(0,0,At,B0); BAR; SCHED;
        LDB(B1,1,1); STAGE_B(SB(1,0),0,t+3);
        BAR; WAIT_L(0); MMA(0,1,At,B1); BAR;
        LDA(At,1,1); STAGE_A(SA(1,0),0,t+3);
        BAR; WAIT_L(0); MMA(1,0,At,B0); BAR; SCHED;
        STAGE_B(SB(1,1),1,t+3);
        WAIT_V(6); BAR; MMA(1,1,At,B1); BAR;
    }
    { LDB(B0,0,0); LDA(At,0,0); STAGE_A(SA(1,1),1,nt-1);
      BAR; WAIT_L(0); MMA(0,0,At,B0); BAR;
      LDB(B1,0,1); BAR; WAIT_L(0); MMA(0,1,At,B1); BAR;
      LDA(At,0,1); WAIT_V(4); BAR; WAIT_L(0); MMA(1,0,At,B0); MMA(1,1,At,B1); BAR; }
    { LDB(B0,1,0); LDA(At,1,0); WAIT_V(2); BAR; WAIT_L(0); MMA(0,0,At,B0); BAR;
      LDB(B1,1,1); WAIT_V(0); BAR; WAIT_L(0); MMA(0,1,At,B1); BAR;
      LDA(At,1,1); BAR; WAIT_L(0); MMA(1,0,At,B0); MMA(1,1,At,B1); BAR; }
    if (wr == 0) BAR;
#pragma unroll
    for (int ai = 0; ai < 2; ++ai)
#pragma unroll
        for (int bj = 0; bj < 2; ++bj)
#pragma unroll
            for (int m = 0; m < 4; ++m) u.ep(ai * HALF + wr * 64 + m * 16 + fr, bj * HALF + wc * 32, fq, acc[ai][bj][m][0], acc[ai][bj][m][1]);
    __syncthreads();
    #undef SA
    #undef SB
    #undef STAGE_A
    #undef STAGE_B
    #undef LDA
    #undef LDB
    #undef MMA
}

__device__ __forceinline__ void rs_table(const bf16_t* A, int K, float* tab) {
    int tid = threadIdx.x; asm volatile("" : "+v"(tid));
    const int r = tid >> 1, hf = tid & 1, n = K >> 1;
    const bf16_t* a = A + (size_t)r * K + hf * n; float s = 0.f;
    for (int i = 0; i < n; i += 8) { const u32x4 w = *(const u32x4*)(a + i);
        const float a0 = bflo(w.x), a1 = bfhi(w.x), a2 = bflo(w.y), a3 = bfhi(w.y), a4 = bflo(w.z), a5 = bfhi(w.z), a6 = bflo(w.w), a7 = bfhi(w.w);
        s += (a0 * a0 + a1 * a1) + (a2 * a2 + a3 * a3) + (a4 * a4 + a5 * a5) + (a6 * a6 + a7 * a7); }
    s += __shfl_xor(s, 1);
    if (hf == 0) tab[r] = 1.f / sqrtf(s / (float)K + 1e-6f);
}

__device__ __forceinline__ void gmlp_phase(const Params& p, char* shm) {
    int tid = threadIdx.x; asm volatile("" : "+v"(tid));
    const int wid = __builtin_amdgcn_readfirstlane(tid >> 6), lane = tid & 63, fr = lane & 15, fq = lane >> 4;
    const int h = blockIdx.x & 3, iabs = 16 * wid + fr;
    bf16x8 wf[4];
#pragma unroll
    for (int ks = 0; ks < 4; ++ks) {
        const float* w = p.w_sp + ((size_t)h * 128 + iabs) * 128 + 32 * ks + 8 * fq;
        const f32x4 w0 = *(const f32x4*)w, w1 = *(const f32x4*)(w + 4);
        const bool ok = (ks >> 1) <= (iabs >> 6);
        u32x4 pk; pk.x = pk2(w0[0], w0[1]); pk.y = pk2(w0[2], w0[3]); pk.z = pk2(w1[0], w1[1]); pk.w = pk2(w1[2], w1[3]);
        if (!ok) pk = (u32x4){0u, 0u, 0u, 0u};
        wf[ks] = __builtin_bit_cast(bf16x8, pk);
    }
    const float bias = p.b_sp[h * 128 + iabs];
    const int nks = (wid < 4) ? 2 : 4;
    const int j = tid >> 2, part = tid & 3;
    for (int u = blockIdx.x; u < (T_TOK / 128) * 4; u += gridDim.x) {
        const int bn = u >> 2, row0 = bn * 128;
        {
            const bf16_t* vr = p.zv + (size_t)(row0 + j) * 512 + h * 128 + part * 32;
            float v[32];
#pragma unroll
            for (int q = 0; q < 4; ++q) { const u32x4 w = *(const u32x4*)(vr + 8 * q);
                v[8 * q + 0] = bflo(w.x); v[8 * q + 1] = bfhi(w.x); v[8 * q + 2] = bflo(w.y); v[8 * q + 3] = bfhi(w.y);
                v[8 * q + 4] = bflo(w.z); v[8 * q + 5] = bfhi(w.z); v[8 * q + 6] = bflo(w.w); v[8 * q + 7] = bfhi(w.w); }
            float s = 0.f;
#pragma unroll
            for (int e = 0; e < 32; ++e) s += v[e];
            s += __shfl_xor(s, 1); s += __shfl_xor(s, 2);
            const float mean = s * (1.f / 128.f); float s2 = 0.f;
#pragma unroll
            for (int e = 0; e < 32; ++e) { v[e] -= mean; s2 += v[e] * v[e]; }
            s2 += __shfl_xor(s2, 1); s2 += __shfl_xor(s2, 2);
            const float rstd = 1.f / sqrtf(s2 * (1.f / 128.f) + 1e-5f);
            const float* gg = p.gm_g + h * 128 + part * 32; const float* bb = p.gm_b + h * 128 + part * 32;
#pragma unroll
            for (int e = 0; e < 32; ++e) *(bf16_t*)(shm + (part * 32 + e) * 272 + j * 2) = f2bf(v[e] * rstd * gg[e] + bb[e]);
        }
        __syncthreads();
        f32x4 acc[8];
#pragma unroll
        for (int cb = 0; cb < 8; ++cb) acc[cb] = (f32x4){0.f, 0.f, 0.f, 0.f};
#pragma unroll
        for (int ks = 0; ks < 4; ++ks) if (ks < nks) {
#pragma unroll
            for (int cb = 0; cb < 8; ++cb) { const bf16x8 a = *(const bf16x8*)(shm + (16 * cb + fr) * 272 + (32 * ks + 8 * fq) * 2);
                acc[cb] = __builtin_amdgcn_mfma_f32_16x16x32_bf16(a, wf[ks], acc[cb], 0, 0, 0); }
        }
        const bf16_t* ur = p.zu + (size_t)(row0 + iabs) * 512 + h * 128 + 4 * fq;
        bf16_t* orow = p.mix + (size_t)(row0 + iabs) * DM + h * 128 + 4 * fq;
#pragma unroll
        for (int cb = 0; cb < 8; ++cb) { const u32x2 uw = *(const u32x2*)(ur + 16 * cb); f32x4 o;
            o[0] = bflo(uw.x) * (acc[cb][0] + bias); o[1] = bfhi(uw.x) * (acc[cb][1] + bias); o[2] = bflo(uw.y) * (acc[cb][2] + bias); o[3] = bfhi(uw.y) * (acc[cb][3] + bias);
            st4(orow + 16 * cb, o); }
        __syncthreads();
    }
}

constexpr int KT_STRIDE = 400, VT_STRIDE = 144, KT_BYTES = 64 * KT_STRIDE, ATT_STAGE = KT_BYTES + 128 * VT_STRIDE;
__device__ __forceinline__ void attn_block(const Params& p, char* shm, int bh, int qb) {
    int tid = threadIdx.x; asm volatile("" : "+v"(tid));
    const int wid = __builtin_amdgcn_readfirstlane(tid >> 6), lane = tid & 63, r = lane & 31, hh = lane >> 5;
    const int b = bh >> 2, h = bh & 3, q0 = qb * 256, ntile = 4 * qb + 4, nw = 4 * qb + (wid >> 1) + 1;
    bf16x8 qf[12];
    { const bf16_t* qp = p.Q + ((size_t)bh * SEQ + q0 + 32 * wid + r) * 192 + 8 * hh;
#pragma unroll
      for (int s = 0; s < 12; ++s) qf[s] = *(const bf16x8*)(qp + 16 * s); }
    f32x16 O[4];
#pragma unroll
    for (int d = 0; d < 4; ++d)
#pragma unroll
        for (int t = 0; t < 16; ++t) O[d][t] = 0.f;
    float m = -INFINITY, l = 0.f;
    const bf16_t* kn_src = p.Kn + ((size_t)bh * SEQ + (tid >> 4)) * 128 + (tid & 15) * 8;
    const bf16_t* kr_src = p.krope + ((size_t)b * SEQ + (tid >> 3)) * 64 + (tid & 7) * 8;
    const bf16_t* vt_src = p.Vt + ((size_t)bh * 128 + (tid >> 3)) * SEQ + (tid & 7) * 8;
    const int kn_dst = (tid >> 4) * KT_STRIDE + (tid & 15) * 16, kr_dst = (tid >> 3) * KT_STRIDE + 256 + (tid & 7) * 16, vt_dst = KT_BYTES + (tid >> 3) * VT_STRIDE + (tid & 7) * 16;
    u32x4 g0, g1, g2, g3, g4;
    #define ATT_LOAD(kt) do { g0 = *(const u32x4*)(kn_src + (size_t)(kt) * 64 * 128); g1 = *(const u32x4*)(kn_src + (size_t)((kt) * 64 + 32) * 128); \
        g2 = *(const u32x4*)(kr_src + (size_t)(kt) * 64 * 64); g3 = *(const u32x4*)(vt_src + (kt) * 64); g4 = *(const u32x4*)(vt_src + (size_t)64 * SEQ + (kt) * 64); } while (0)
    #define ATT_WRITE(buf) do { char* _s = shm + (buf) * ATT_STAGE; *(u32x4*)(_s + kn_dst) = g0; *(u32x4*)(_s + kn_dst + 32 * KT_STRIDE) = g1; *(u32x4*)(_s + kr_dst) = g2; \
        *(u32x4*)(_s + vt_dst) = g3; *(u32x4*)(_s + vt_dst + 64 * VT_STRIDE) = g4; } while (0)
    ATT_LOAD(0); ATT_WRITE(0);
    __syncthreads();
    for (int kt = 0; kt < ntile; ++kt) {
        const bool more = kt + 1 < ntile;
        if (more) ATT_LOAD(kt + 1);
        if (kt < nw) {
            const char* ks = shm + (kt & 1) * ATT_STAGE; const char* vs = ks + KT_BYTES;
            f32x16 S0, S1;
#pragma unroll
            for (int t = 0; t < 16; ++t) { S0[t] = 0.f; S1[t] = 0.f; }
#pragma unroll
            for (int s = 0; s < 12; ++s) {
                const bf16x8 k0 = *(const bf16x8*)(ks + r * KT_STRIDE + (16 * s + 8 * hh) * 2), k1 = *(const bf16x8*)(ks + (32 + r) * KT_STRIDE + (16 * s + 8 * hh) * 2);
                S0 = __builtin_amdgcn_mfma_f32_32x32x16_bf16(k0, qf[s], S0, 0, 0, 0);
                S1 = __builtin_amdgcn_mfma_f32_32x32x16_bf16(k1, qf[s], S1, 0, 0, 0);
            }
            float mt = fmaxf(S0[0], S1[0]);
#pragma unroll
            for (int t = 1; t < 16; ++t) mt = fmaxf(mt, fmaxf(S0[t], S1[t]));
            mt = fmaxf(mt, __shfl_xor(mt, 32));
            const float mn = fmaxf(m, mt), alpha = __builtin_amdgcn_exp2f(m - mn); m = mn;
            float ls = 0.f;
#pragma unroll
            for (int t = 0; t < 16; ++t) { S0[t] = __builtin_amdgcn_exp2f(S0[t] - mn); S1[t] = __builtin_amdgcn_exp2f(S1[t] - mn); ls += S0[t] + S1[t]; }
            l = l * alpha + ls;
#pragma unroll
            for (int d = 0; d < 4; ++d)
#pragma unroll
                for (int t = 0; t < 16; ++t) O[d][t] *= alpha;
            bf16x8 pf[4];
#pragma unroll
            for (int s = 0; s < 2; ++s) {
                u32x4 a, c; a.x = pk2(S0[8 * s + 0], S0[8 * s + 1]); a.y = pk2(S0[8 * s + 2], S0[8 * s + 3]); a.z = pk2(S0[8 * s + 4], S0[8 * s + 5]); a.w = pk2(S0[8 * s + 6], S0[8 * s + 7]);
                c.x = pk2(S1[8 * s + 0], S1[8 * s + 1]); c.y = pk2(S1[8 * s + 2], S1[8 * s + 3]); c.z = pk2(S1[8 * s + 4], S1[8 * s + 5]); c.w = pk2(S1[8 * s + 6], S1[8 * s + 7]);
                pf[s] = __builtin_bit_cast(bf16x8, a); pf[2 + s] = __builtin_bit_cast(bf16x8, c);
            }
#pragma unroll
            for (int k4 = 0; k4 < 4; ++k4)
#pragma unroll
                for (int d = 0; d < 4; ++d) { const bf16x8 vf = *(const bf16x8*)(vs + (32 * d + r) * VT_STRIDE + (16 * k4 + 8 * hh) * 2);
                    O[d] = __builtin_amdgcn_mfma_f32_32x32x16_bf16(vf, pf[k4], O[d], 0, 0, 0); }
        }
        if (more) ATT_WRITE((kt + 1) & 1);
        __syncthreads();
    }
    #undef ATT_LOAD
    #undef ATT_WRITE
    l += __shfl_xor(l, 32);
    const float inv = 1.f / l;
    bf16_t* o = p.mix + ((size_t)b * SEQ + q0 + 32 * wid + r) * DM + 512 + h * 128 + 4 * hh;
#pragma unroll
    for (int d = 0; d < 4; ++d)
#pragma unroll
        for (int g = 0; g < 4; ++g) { f32x4 v; v[0] = O[d][4 * g] * inv; v[1] = O[d][4 * g + 1] * inv; v[2] = O[d][4 * g + 2] * inv; v[3] = O[d][4 * g + 3] * inv; st4(o + 32 * d + 8 * g, v); }
}

template <class PH> __device__ __forceinline__ void gemm_phase(const PH& ph, LAS unsigned char* shm) {
    for (int u = blockIdx.x;; u += gridDim.x) { Unit<typename PH::EP> un; if (u >= PH::NU || !ph.unit(u, un)) break; gemm256(un, shm); }
}
template <int LO, int HI>
__global__ __launch_bounds__(512, 2) void mega(Params p) {
    extern __shared__ __attribute__((aligned(16))) unsigned char lds_raw[];
    LAS unsigned char* shm = (LAS unsigned char*)lds_raw;
    char* smc = (char*)lds_raw;
    const int tid = threadIdx.x, wid = tid >> 6, lane = tid & 63, nblk = gridDim.x;
    XcdBarrier xb;
    if (LO != HI) {
        if (tid == 0) { ((volatile LAS unsigned*)(smc + LDS_XB))[0] = 0u; ((volatile LAS unsigned*)(smc + LDS_XB))[1] = 0u; }
        __syncthreads();
        xb = xcd_barrier_post(p.bar, (volatile LAS unsigned*)(smc + LDS_XB));
    }
    #define SEAM(ph) if (LO <= (ph) && HI > (ph)) xcd_barrier(xb)
    if (LO <= 0 && HI >= 0) {
        for (int job = blockIdx.x; job < J_TOTAL; job += nblk) prep_wjob(p, job, (float*)smc, tid, NTHR);
        for (int t = blockIdx.x * 8 + wid; t < T_TOK; t += nblk * 8) ln0_row(p.x + (size_t)t * DM, p.ln0_g, p.ln0_b, p.hbuf + (size_t)t * DM, lane);
        for (int i = blockIdx.x * NTHR + tid; i < T_TOK * 32; i += nblk * NTHR) rope_entry(p, i);
        if (blockIdx.x == 0 && tid < NEXP) p.cnt[tid] = 0;
    }
    SEAM(0);
    if (LO <= 1 && HI >= 1) gemm_phase(PhZ{p}, shm);
    SEAM(1);
    if (LO <= 2 && HI >= 2) {
        float* tab = (float*)(smc + LDS_RS);
#if !defined(P2VAR) || P2VAR == 0 || P2VAR == 1
        for (int u = blockIdx.x; u < PhQ::NU + PhKV::NU; u += nblk) {
            if (u < PhQ::NU) { Unit<EpiQ> un; PhQ{p, tab}.unit(u, un); rs_table(un.am.base, 384, tab); un.ep.rs0 = un.ep.row0; gemm256(un, shm); }
            else { Unit<EpiKV> un; PhKV{p, tab}.unit(u - PhQ::NU, un); rs_table(un.am.base, 256, tab); un.ep.rs0 = un.ep.row0; gemm256(un, shm); }
        }
#endif
#if !defined(P2VAR) || P2VAR == 0 || P2VAR == 2
        gmlp_phase(p, smc);
#endif
    }
    SEAM(2);
    if (LO <= 3 && HI >= 3) {
        for (int u = blockIdx.x; u < 256; u += nblk) { const int bh = u >> 2, pr = u & 3; attn_block(p, smc, bh, 7 - pr); attn_block(p, smc, bh, pr); }
    }
    SEAM(3);
    if (LO <= 4 && HI >= 4) gemm_phase(PhY{p}, shm);
    SEAM(4);
    if (LO <= 5 && HI >= 5) {
        float* wr = (float*)smc;
        for (int i = tid; i < 36 * 1024; i += NTHR) { float v; int o, k;
            if (i < 4096) { k = i >> 2; o = i & 3; v = p.w_rg[i]; } else { const int i2 = i - 4096; k = i2 >> 5; o = 4 + (i2 & 31); v = p.w_re[i2]; }
            wr[o * 1028 + k] = v; }
        __syncthreads();
        for (int t = blockIdx.x * 8 + wid; t < T_TOK; t += nblk * 8) router_token(p, t, lane, wr, 1028);
        __syncthreads();
    }
    SEAM(5);
    if (LO <= 6 && HI >= 6) gemm_phase(PhH{p}, shm);
    SEAM(6);
    if (LO <= 7 && HI >= 7) gemm_phase(PhC{p}, shm);
    SEAM(7);
    if (LO <= 8 && HI >= 8) { for (int t = blockIdx.x * 8 + wid; t < T_TOK; t += nblk * 8) final_token(p, t, lane); }
    #undef SEAM
}
#ifndef MODE
#define MODE 1
#endif
#ifndef FASTMASK
#define FASTMASK 0x1ff
#endif
static size_t carve(size_t& off, size_t bytes) { const size_t o = off; off += (bytes + 255) & ~(size_t)255; return o; }
template <int PH> static void launch_fast(const Params& p, int grid, hipStream_t stream) { hipLaunchKernelGGL((mega<PH, PH>), dim3(grid), dim3(NTHR), LDS_BYTES, stream, p); }
extern "C" void kernel_launch(void* const* d_in, const int* in_sizes, int n_in, void* d_out, int out_size, void* d_ws, size_t ws_size, hipStream_t stream) {
    Params p{};
    p.x = (const float*)d_in[0]; p.pos = (const int*)d_in[1]; p.ln0_g = (const float*)d_in[2]; p.ln0_b = (const float*)d_in[3]; p.w_in = (const float*)d_in[4];
    p.gm_g = (const float*)d_in[5]; p.gm_b = (const float*)d_in[6]; p.w_sp = (const float*)d_in[7]; p.b_sp = (const float*)d_in[8]; p.qn_g = (const float*)d_in[9];
    p.w_uq = (const float*)d_in[10]; p.kvn_g = (const float*)d_in[11]; p.w_ukv = (const float*)d_in[12]; p.w_out = (const float*)d_in[13]; p.ln1_g = (const float*)d_in[14];
    p.ln1_b = (const float*)d_in[15]; p.w_rg = (const float*)d_in[16]; p.b_rg = (const float*)d_in[17]; p.w_re = (const float*)d_in[18]; p.b_re = (const float*)d_in[19];
    p.w_gate = (const float*)d_in[20]; p.w_up = (const float*)d_in[21]; p.w_down = (const float*)d_in[22]; p.ln2_g = (const float*)d_in[23]; p.ln2_b = (const float*)d_in[24];
    p.out = (float*)d_out;
    char* ws = (char*)d_ws; size_t off = 0;
    p.bar = (unsigned*)(ws + carve(off, 16384));
    p.cnt = (int*)(ws + carve(off, 1024));
    p.WinT = (bf16_t*)(ws + carve(off, (size_t)ZN * 1024 * 2)); p.WuqT = (bf16_t*)(ws + carve(off, 768 * 384 * 2)); p.WukvT = (bf16_t*)(ws + carve(off, 1024 * 256 * 2));
    p.WoutT = (bf16_t*)(ws + carve(off, 1024 * 1024 * 2)); p.WguT = (bf16_t*)(ws + carve(off, (size_t)32 * 512 * 1024 * 2)); p.WdT = (bf16_t*)(ws + carve(off, (size_t)32 * 1024 * 256 * 2));
    p.hbuf = (bf16_t*)(ws + carve(off, (size_t)T_TOK * DM * 2)); p.rope = (float2*)(ws + carve(off, (size_t)T_TOK * 32 * 8));
    p.list = (int*)(ws + carve(off, (size_t)NEXP * LIST_CAP * 4)); p.gates = (float*)(ws + carve(off, (size_t)T_TOK * 2 * 4));
    p.rsq = (float*)(ws + carve(off, T_TOK * 4)); p.rskv = (float*)(ws + carve(off, T_TOK * 4));
    const size_t stage0 = off;
    p.zu = (bf16_t*)(ws + carve(off, (size_t)T_TOK * 512 * 2)); p.zv = (bf16_t*)(ws + carve(off, (size_t)T_TOK * 512 * 2));
    p.zq = (bf16_t*)(ws + carve(off, (size_t)T_TOK * 384 * 2)); p.zkv = (bf16_t*)(ws + carve(off, (size_t)T_TOK * 256 * 2)); p.krope = (bf16_t*)(ws + carve(off, (size_t)T_TOK * 64 * 2));
    p.Q = (bf16_t*)(ws + carve(off, (size_t)T_TOK * 768 * 2)); p.Kn = (bf16_t*)(ws + carve(off, (size_t)T_TOK * 512 * 2)); p.Vt = (bf16_t*)(ws + carve(off, (size_t)T_TOK * 512 * 2));
    p.mix = (bf16_t*)(ws + carve(off, (size_t)T_TOK * DM * 2));
    const size_t stage_end = off;
    size_t o2 = stage0; p.contrib = (bf16_t*)(ws + carve(o2, (size_t)T_TOK * 2 * DM * 2)); p.H = (bf16_t*)(ws + carve(o2, (size_t)(65536 + 8192) * FF * 2));
    if (o2 > stage_end || stage_end > ws_size) { fprintf(stderr, "kernel_launch: workspace too small (%zu needed, %zu given)\n", stage_end, ws_size); return; }

    static int grid = 0;
    if (!grid) {
        int dev = 0, cus = 0; (void)hipGetDevice(&dev); (void)hipDeviceGetAttribute(&cus, hipDeviceAttributeMultiprocessorCount, dev);
        grid = cus > 0 ? (cus / 8) * 8 : 256;
        (void)hipFuncSetAttribute((const void*)nk_gmlp, hipFuncAttributeMaxDynamicSharedMemorySize, 128 * 129 * 4);
        (void)hipFuncSetAttribute((const void*)nk_attn, hipFuncAttributeMaxDynamicSharedMemorySize, (64 * 192 + 64 * 193 + 64 * 65 + 64 * 128) * 4);
        (void)hipFuncSetAttribute((const void*)mega<0, 8>, hipFuncAttributeMaxDynamicSharedMemorySize, LDS_BYTES);
#if MODE == 2
        (void)hipFuncSetAttribute((const void*)mega<0, 0>, hipFuncAttributeMaxDynamicSharedMemorySize, LDS_BYTES);
        (void)hipFuncSetAttribute((const void*)mega<1, 1>, hipFuncAttributeMaxDynamicSharedMemorySize, LDS_BYTES);
        (void)hipFuncSetAttribute((const void*)mega<2, 2>, hipFuncAttributeMaxDynamicSharedMemorySize, LDS_BYTES);
        (void)hipFuncSetAttribute((const void*)mega<3, 3>, hipFuncAttributeMaxDynamicSharedMemorySize, LDS_BYTES);
        (void)hipFuncSetAttribute((const void*)mega<4, 4>, hipFuncAttributeMaxDynamicSharedMemorySize, LDS_BYTES);
        (void)hipFuncSetAttribute((const void*)mega<5, 5>, hipFuncAttributeMaxDynamicSharedMemorySize, LDS_BYTES);
        (void)hipFuncSetAttribute((const void*)mega<6, 6>, hipFuncAttributeMaxDynamicSharedMemorySize, LDS_BYTES);
        (void)hipFuncSetAttribute((const void*)mega<7, 7>, hipFuncAttributeMaxDynamicSharedMemorySize, LDS_BYTES);
        (void)hipFuncSetAttribute((const void*)mega<8, 8>, hipFuncAttributeMaxDynamicSharedMemorySize, LDS_BYTES);
#endif
    }
#if MODE == 1
    (void)hipMemsetAsync(p.bar, 0, XCD_BAR_WORDS * 4, stream);
    hipLaunchKernelGGL((mega<0, 8>), dim3(grid), dim3(NTHR), LDS_BYTES, stream, p);
#else
    const unsigned fm = (MODE == 2) ? (unsigned)(FASTMASK) : 0u;
    if (fm & 1) launch_fast<0>(p, grid, stream); else { nk_prep_w<<<J_TOTAL, 256, 0, stream>>>(p); nk_ln0<<<T_TOK / 4, 256, 0, stream>>>(p); nk_rope<<<T_TOK * 32 / 256, 256, 0, stream>>>(p); }
    if (fm & 2) launch_fast<1>(p, grid, stream); else nk_gemm<PhZ><<<dim3(PhZ::NU, 32), 256, 0, stream>>>(PhZ{p});
#if defined(P2VAR) && P2VAR == 1
    launch_fast<2>(p, grid, stream); nk_gmlp<<<T_TOK / 128 * 4, 256, 128 * 129 * 4, stream>>>(p);
#elif defined(P2VAR) && P2VAR == 2
    nk_rowscale<<<T_TOK / 4, 256, 0, stream>>>(p); nk_gemm<PhQ><<<dim3(PhQ::NU, 32), 256, 0, stream>>>(PhQ{p, p.rsq});
    nk_gemm<PhKV><<<dim3(PhKV::NU, 32), 256, 0, stream>>>(PhKV{p, p.rskv}); launch_fast<2>(p, grid, stream);
#else
    if (fm & 4) launch_fast<2>(p, grid, stream); else { nk_rowscale<<<T_TOK / 4, 256, 0, stream>>>(p); nk_gemm<PhQ><<<dim3(PhQ::NU, 32), 256, 0, stream>>>(PhQ{p, p.rsq});
        nk_gemm<PhKV><<<dim3(PhKV::NU, 32), 256, 0, stream>>>(PhKV{p, p.rskv}); nk_gmlp<<<T_TOK / 128 * 4, 256, 128 * 129 * 4, stream>>>(p); }
#endif
    if (fm & 8) launch_fast<3>(p, grid, stream); else nk_attn<<<64 * 32, 256, (64 * 192 + 64 * 193 + 64 * 65 + 64 * 128) * 4, stream>>>(p);
    if (fm & 16) launch_fast<4>(p, grid, stream); else nk_gemm<PhY><<<dim3(PhY::NU, 32), 256, 0, stream>>>(PhY{p});
    if (fm & 32) launch_fast<5>(p, grid, stream); else { nk_router_prep<<<144, 256, 0, stream>>>(p); nk_router<<<T_TOK / 4, 256, 0, stream>>>(p); }
    if (fm & 64) launch_fast<6>(p, grid, stream); else nk_gemm<PhH><<<dim3(PhH::NU, 32), 256, 0, stream>>>(PhH{p});
    if (fm & 128) launch_fast<7>(p, grid, stream); else nk_gemm<PhC><<<dim3(PhC::NU, 32), 256, 0, stream>>>(PhC{p});
    if (fm & 256) launch_fast<8>(p, grid, stream); else nk_final<<<T_TOK / 4, 256, 0, stream>>>(p);
#endif
}
```

```cpp
#include <hip/hip_runtime.h>
#define P2VAR 0
#define REPMASK 0x0
#define DUPMASK 0x0
#include <stdint.h>
#include <cstdio>

#define LAS __attribute__((address_space(3)))
typedef unsigned short bf16_t;
typedef short bf16x8 __attribute__((ext_vector_type(8)));
typedef float f32x4 __attribute__((ext_vector_type(4)));
typedef float f32x16 __attribute__((ext_vector_type(16)));
typedef unsigned u32x2 __attribute__((ext_vector_type(2)));
typedef unsigned u32x4 __attribute__((ext_vector_type(4)));

constexpr int T_TOK = 32768, DM = 1024, SEQ = 2048, NBATCH = 16;
constexpr int ZN = 1792;
constexpr int NEXP = 32, FF = 256;
constexpr int LIST_CAP = 32768;
constexpr float ALPHA = 1.189207115002721f;
constexpr float QSCALE = 0.07216878364870322f * 1.4426950408889634f;

struct Params {
    const float* x; const int* pos; const float *ln0_g, *ln0_b, *w_in, *gm_g, *gm_b, *w_sp, *b_sp, *qn_g, *w_uq, *kvn_g, *w_ukv, *w_out, *ln1_g, *ln1_b,
        *w_rg, *b_rg, *w_re, *b_re, *w_gate, *w_up, *w_down, *ln2_g, *ln2_b;
    float* out;
    bf16_t *WinT, *WuqT, *WukvT, *WoutT, *WguT, *WdT;
    bf16_t* hbuf; float2* rope;
    bf16_t *zu, *zv, *zq, *zkv, *krope, *Q, *Kn, *Vt, *mix;
    float *rsq, *rskv;
    int* cnt; int* list; float* gates; bf16_t* H; bf16_t* contrib;
    bf16_t* WrT; int* cntb; int* listb;
    unsigned* bar;
};

__device__ __forceinline__ unsigned pk2(float lo, float hi) { unsigned r; asm volatile("v_cvt_pk_bf16_f32 %0, %1, %2" : "=v"(r) : "v"(lo), "v"(hi)); return r; }
__device__ __forceinline__ bf16_t f2bf(float f) { return (bf16_t)(pk2(f, 0.f) & 0xffffu); }
__device__ __forceinline__ float bf2f(bf16_t h) { return __uint_as_float(((unsigned)h) << 16); }
__device__ __forceinline__ float bflo(unsigned u) { return __uint_as_float(u << 16); }
__device__ __forceinline__ float bfhi(unsigned u) { return __uint_as_float(u & 0xffff0000u); }
__device__ __forceinline__ void st4(bf16_t* p, f32x4 v) { u32x2 w; w.x = pk2(v[0], v[1]); w.y = pk2(v[2], v[3]); *(u32x2*)p = w; }
__device__ __forceinline__ float wave_sum(float v) {
#pragma unroll
    for (int o = 1; o < 64; o <<= 1) v += __shfl_xor(v, o);
    return v;
}
__device__ __forceinline__ float gelu_tanh(float x) {
    const float u = x + 0.044715f * x * x * x;
    const float e = __builtin_amdgcn_exp2f(-2.f * 0.7978845608028654f * 1.4426950408889634f * u);
    return x * __builtin_amdgcn_rcpf(1.f + e);
}
__device__ __forceinline__ float silu_f(float x) { return x * __builtin_amdgcn_rcpf(1.f + __builtin_amdgcn_exp2f(-1.4426950408889634f * x)); }
__device__ __forceinline__ int perm16(int k) { return 8 * ((k >> 2) & 1) + (k & 3) + 4 * (k >> 3); }

struct AMap {
    const bf16_t* base; int ld; const int* list; int nvalid;
    __device__ __forceinline__ const bf16_t* row(int r) const {
        if (list) { const int a = list[r < nvalid ? r : 0]; return base + (size_t)(a >> 1) * ld; }
        return base + (size_t)r * ld;
    }
};

struct EpiZ {
    bf16_t *zu, *zv, *zq, *zkv, *krope; const float2* rope; int row0, col0;
    __device__ __forceinline__ void half(int row, int c, f32x4 v) const {
        if (c < 1024) {
            f32x4 g; g[0] = gelu_tanh(v[0]); g[1] = gelu_tanh(v[1]); g[2] = gelu_tanh(v[2]); g[3] = gelu_tanh(v[3]);
            if (c < 512) st4(zu + (size_t)row * 512 + c, g); else st4(zv + (size_t)row * 512 + (c - 512), g);
        } else if (c < 1408) st4(zq + (size_t)row * 384 + (c - 1024), v);
        else if (c < 1664) st4(zkv + (size_t)row * 256 + (c - 1408), v);
        else if (c < 1728) {
            const int i0 = (c - 1664) >> 1;
            const float2 cs0 = rope[(size_t)row * 32 + i0], cs1 = rope[(size_t)row * 32 + i0 + 1];
            bf16_t* kr = krope + (size_t)row * 64;
            kr[i0] = f2bf(v[0] * cs0.x - v[1] * cs0.y); kr[i0 + 32] = f2bf(v[1] * cs0.x + v[0] * cs0.y);
            kr[i0 + 1] = f2bf(v[2] * cs1.x - v[3] * cs1.y); kr[i0 + 33] = f2bf(v[3] * cs1.x + v[2] * cs1.y);
        }
    }
    __device__ __forceinline__ void operator()(int r, int c32, int fq, f32x4 a, f32x4 b) const { const int row = row0 + r, c = col0 + c32 + 4 * fq; half(row, c, a); half(row, c + 16, b); }
};
struct EpiQ {
    bf16_t* Q; const float2* rope; const float* rs; int rs0; int row0, col0;
    __device__ __forceinline__ void half(int row, int c, f32x4 v, float sc) const {
        const int h = c / 192, d = c - h * 192, b = row >> 11, s = row & 2047;
        bf16_t* q = Q + ((size_t)((b * 4 + h) * SEQ + s)) * 192;
        v = v * sc;
        if (d < 128) st4(q + d, v);
        else {
            const int i0 = (d - 128) >> 1;
            const float2 cs0 = rope[(size_t)row * 32 + i0], cs1 = rope[(size_t)row * 32 + i0 + 1];
            q[128 + i0] = f2bf(v[0] * cs0.x - v[1] * cs0.y); q[160 + i0] = f2bf(v[1] * cs0.x + v[0] * cs0.y);
            q[129 + i0] = f2bf(v[2] * cs1.x - v[3] * cs1.y); q[161 + i0] = f2bf(v[3] * cs1.x + v[2] * cs1.y);
        }
    }
    __device__ __forceinline__ void operator()(int r, int c32, int fq, f32x4 a, f32x4 b) const {
        const int row = row0 + r, c = col0 + c32 + 4 * fq; const float sc = rs[row - rs0] * QSCALE; half(row, c, a, sc); half(row, c + 16, b, sc); }
};
struct EpiKV {
    bf16_t *Kn, *Vt; const float* rs; int rs0; int row0, col0;
    __device__ __forceinline__ void half(int row, int c, f32x4 v, float sc) const {
        const int h = c >> 8, e = c & 255, b = row >> 11, s = row & 2047;
        v = v * sc;
        if (e < 128) st4(Kn + ((size_t)((b * 4 + h) * SEQ + s)) * 128 + e, v);
        else {
            bf16_t* vt = Vt + ((size_t)((b * 4 + h) * 128 + (e - 128))) * SEQ + (s & ~15) + perm16(s & 15);
            vt[0] = f2bf(v[0]); vt[SEQ] = f2bf(v[1]); vt[2 * SEQ] = f2bf(v[2]); vt[3 * SEQ] = f2bf(v[3]);
        }
    }
    __device__ __forceinline__ void operator()(int r, int c32, int fq, f32x4 a, f32x4 b) const {
        const int row = row0 + r, c = col0 + c32 + 4 * fq; const float sc = rs[row - rs0]; half(row, c, a, sc); half(row, c + 16, b, sc); }
};
struct EpiY {
    bf16_t* hb; int row0, col0;
    __device__ __forceinline__ void half(int row, int c, f32x4 v) const {
        bf16_t* p = hb + (size_t)row * DM + c; const u32x2 h = *(const u32x2*)p;
        v[0] += ALPHA * bflo(h.x); v[1] += ALPHA * bfhi(h.x); v[2] += ALPHA * bflo(h.y); v[3] += ALPHA * bfhi(h.y);
        st4(p, v);
    }
    __device__ __forceinline__ void operator()(int r, int c32, int fq, f32x4 a, f32x4 b) const { const int row = row0 + r, c = col0 + c32 + 4 * fq; half(row, c, a); half(row, c + 16, b); }
};
struct EpiH {
    bf16_t* H; int hrow0, col0;
    __device__ __forceinline__ void operator()(int r, int c32, int fq, f32x4 a, f32x4 b) const {
        const int hid = ((col0 + c32) >> 5) * 16 + 4 * fq;
        f32x4 o; o[0] = silu_f(a[0]) * b[0]; o[1] = silu_f(a[1]) * b[1]; o[2] = silu_f(a[2]) * b[2]; o[3] = silu_f(a[3]) * b[3];
        st4(H + (size_t)(hrow0 + r) * FF + hid, o);
    }
};
struct EpiC {
    bf16_t* contrib; const int* list; const float* gates; int nvalid; int col0;
    __device__ __forceinline__ void operator()(int r, int c32, int fq, f32x4 a, f32x4 b) const {
        if (r >= nvalid) return;
        const int aid = list[r]; const float g = gates[aid];
        bf16_t* p = contrib + (size_t)aid * DM + col0 + c32 + 4 * fq;
        st4(p, a * g); st4(p + 16, b * g);
    }
};

template <class EP> struct Unit { AMap am; const bf16_t* bt; int K; EP ep; };

__device__ __forceinline__ bool moe_unit(const int* cnt, int u, int ncol, int& e, int& rt, int& ct, int& padrow) {
    int acc = 0;
    for (e = 0; e < NEXP; ++e) {
        const int t = (cnt[e] + 255) >> 8;
        if (u < (acc + t) * ncol) { const int w = u - acc * ncol; rt = w / ncol; ct = w - rt * ncol; padrow = (acc + rt) * 256; return true; }
        acc += t;
    }
    return false;
}

struct PhZ { Params p; typedef EpiZ EP; static constexpr int NU = 128 * 7;
    __device__ __forceinline__ bool unit(int u, Unit<EP>& o) const { const int pm = u / 7, pn = u - pm * 7;
        o.am = AMap{p.hbuf + (size_t)pm * 256 * DM, DM, nullptr, 256}; o.bt = p.WinT + (size_t)pn * 256 * DM; o.K = DM;
        o.ep = EpiZ{p.zu, p.zv, p.zq, p.zkv, p.krope, p.rope, pm * 256, pn * 256}; return true; } };
struct PhQ { Params p; const float* rs; typedef EpiQ EP; static constexpr int NU = 128 * 3;
    __device__ __forceinline__ bool unit(int u, Unit<EP>& o) const { const int pm = u / 3, pn = u - pm * 3;
        o.am = AMap{p.zq + (size_t)pm * 256 * 384, 384, nullptr, 256}; o.bt = p.WuqT + (size_t)pn * 256 * 384; o.K = 384;
        o.ep = EpiQ{p.Q, p.rope, rs, 0, pm * 256, pn * 256}; return true; } };
struct PhKV { Params p; const float* rs; typedef EpiKV EP; static constexpr int NU = 128 * 4;
    __device__ __forceinline__ bool unit(int u, Unit<EP>& o) const { const int pm = u >> 2, pn = u & 3;
        o.am = AMap{p.zkv + (size_t)pm * 256 * 256, 256, nullptr, 256}; o.bt = p.WukvT + (size_t)pn * 256 * 256; o.K = 256;
        o.ep = EpiKV{p.Kn, p.Vt, rs, 0, pm * 256, pn * 256}; return true; } };
struct PhY { Params p; typedef EpiY EP; static constexpr int NU = 128 * 4;
    __device__ __forceinline__ bool unit(int u, Unit<EP>& o) const { const int pm = u >> 2, pn = u & 3;
        o.am = AMap{p.mix + (size_t)pm * 256 * DM, DM, nullptr, 256}; o.bt = p.WoutT + (size_t)pn * 256 * DM; o.K = DM;
        o.ep = EpiY{p.hbuf, pm * 256, pn * 256}; return true; } };
struct PhH { Params p; typedef EpiH EP; static constexpr int NU = 288 * 2;
    __device__ __forceinline__ bool unit(int u, Unit<EP>& o) const { int e, rt, ct, pr; if (!moe_unit(p.cnt, u, 2, e, rt, ct, pr)) return false;
        const int nv = min(256, p.cnt[e] - rt * 256);
        o.am = AMap{p.hbuf, DM, p.list + (size_t)e * LIST_CAP + rt * 256, nv}; o.bt = p.WguT + ((size_t)e * 512 + ct * 256) * DM; o.K = DM;
        o.ep = EpiH{p.H, pr, ct * 256}; return true; } };
struct PhC { Params p; typedef EpiC EP; static constexpr int NU = 288 * 4;
    __device__ __forceinline__ bool unit(int u, Unit<EP>& o) const { int e, rt, ct, pr; if (!moe_unit(p.cnt, u, 4, e, rt, ct, pr)) return false;
        const int nv = min(256, p.cnt[e] - rt * 256);
        o.am = AMap{p.H + (size_t)pr * FF, FF, nullptr, 256}; o.bt = p.WdT + ((size_t)e * DM + ct * 256) * FF; o.K = FF;
        o.ep = EpiC{p.contrib, p.list + (size_t)e * LIST_CAP + rt * 256, p.gates, nv, ct * 256}; return true; } };

__device__ __forceinline__ void wtile(const float* s0, const float* s1, int ldsrc, bf16_t* dst, int K, int k0, int n0, int mode, const float* kscale, float* tile, int tid, int nthr) {
    for (int idx = tid; idx < 4096; idx += nthr) {
        const int kk = idx >> 6, n = n0 + (idx & 63);
        const float* s = s0; int col = n;
        if (mode == 1) { if (n >= 1728) col = -1; else if (n >= 1664) { const int i = (n - 1664) >> 1, pp = (n - 1664) & 1; col = 1664 + i + 32 * pp; } }
        else if (mode == 2) { const int h = n / 192, d = n - h * 192; if (d >= 128) { const int i = (d - 128) >> 1, pp = (d - 128) & 1; col = h * 192 + 128 + i + 32 * pp; } }
        else if (mode == 3) { const int G = n >> 5, r = n & 31; col = 16 * G + (r & 15); s = (r < 16) ? s0 : s1; }
        float v = 0.f;
        if (col >= 0) { v = s[(size_t)(k0 + kk) * ldsrc + col]; if (kscale) v *= kscale[k0 + kk]; }
        tile[kk * 65 + (idx & 63)] = v;
    }
    __syncthreads();
    for (int idx = tid; idx < 4096; idx += nthr) {
        const int nn = idx >> 6, kk = idx & 63;
        dst[(size_t)(n0 + nn) * K + k0 + kk] = f2bf(tile[kk * 65 + nn]);
    }
    __syncthreads();
}
constexpr int J_IN = 28 * 16, J_UQ = 12 * 6, J_UKV = 16 * 4, J_OUT = 16 * 16, J_GU = 32 * 8 * 16, J_DN = 32 * 16 * 4;
constexpr int J_TOTAL = J_IN + J_UQ + J_UKV + J_OUT + J_GU + J_DN;
__device__ __forceinline__ void prep_wjob(const Params& p, int job, float* tile, int tid, int nthr) {
    if (job < J_IN) { const int nb = job >> 4, kb = job & 15; wtile(p.w_in, nullptr, 1728, p.WinT, 1024, kb * 64, nb * 64, 1, nullptr, tile, tid, nthr); return; } job -= J_IN;
    if (job < J_UQ) { const int nb = job / 6, kb = job - nb * 6; wtile(p.w_uq, nullptr, 768, p.WuqT, 384, kb * 64, nb * 64, 2, p.qn_g, tile, tid, nthr); return; } job -= J_UQ;
    if (job < J_UKV) { const int nb = job >> 2, kb = job & 3; wtile(p.w_ukv, nullptr, 1024, p.WukvT, 256, kb * 64, nb * 64, 0, p.kvn_g, tile, tid, nthr); return; } job -= J_UKV;
    if (job < J_OUT) { const int nb = job >> 4, kb = job & 15; wtile(p.w_out, nullptr, 1024, p.WoutT, 1024, kb * 64, nb * 64, 0, nullptr, tile, tid, nthr); return; } job -= J_OUT;
    if (job < J_GU) { const int e = job >> 7, r = job & 127, nb = r >> 4, kb = r & 15;
        wtile(p.w_gate + (size_t)e * 1024 * 256, p.w_up + (size_t)e * 1024 * 256, 256, p.WguT + (size_t)e * 512 * 1024, 1024, kb * 64, nb * 64, 3, nullptr, tile, tid, nthr); return; } job -= J_GU;
    { const int e = job >> 6, r = job & 63, nb = r >> 2, kb = r & 3;
        wtile(p.w_down + (size_t)e * 256 * 1024, nullptr, 1024, p.WdT + (size_t)e * 1024 * 256, 256, kb * 64, nb * 64, 0, nullptr, tile, tid, nthr); }
}
__device__ __forceinline__ void ln0_row(const float* xr, const float* g, const float* b, bf16_t* orow, int lane) {
    f32x4 v[4]; float s = 0.f;
#pragma unroll
    for (int j = 0; j < 4; ++j) { v[j] = *(const f32x4*)(xr + 256 * j + 4 * lane); s += (v[j][0] + v[j][1]) + (v[j][2] + v[j][3]); }
    const float mean = wave_sum(s) * (1.f / 1024.f); float s2 = 0.f;
#pragma unroll
    for (int j = 0; j < 4; ++j) { v[j] = v[j] - mean; s2 += (v[j][0] * v[j][0] + v[j][1] * v[j][1]) + (v[j][2] * v[j][2] + v[j][3] * v[j][3]); }
    const float rstd = 1.f / sqrtf(wave_sum(s2) * (1.f / 1024.f) + 1e-5f);
#pragma unroll
    for (int j = 0; j < 4; ++j) { const f32x4 gg = *(const f32x4*)(g + 256 * j + 4 * lane), bb = *(const f32x4*)(b + 256 * j + 4 * lane);
        st4(orow + 256 * j + 4 * lane, v[j] * rstd * gg + bb); }
}
__device__ __forceinline__ void rope_entry(const Params& p, int idx) {
    const int t = idx >> 5, i = idx & 31;
    const float inv = powf(10000.f, -(float)(2 * i) / 64.f);
    const float ang = (float)p.pos[t] * inv;
    p.rope[idx] = make_float2(cosf(ang), sinf(ang));
}

__device__ __forceinline__ void router_token(const Params& p, int t, int lane, const float* wr  , int wstride) {
    bf16_t* hr = p.hbuf + (size_t)t * DM;
    f32x4 v[4]; float s = 0.f;
#pragma unroll
    for (int j = 0; j < 4; ++j) { const u32x2 w = *(const u32x2*)(hr + 256 * j + 4 * lane); v[j][0] = bflo(w.x); v[j][1] = bfhi(w.x); v[j][2] = bflo(w.y); v[j][3] = bfhi(w.y);
        s += (v[j][0] + v[j][1]) + (v[j][2] + v[j][3]); }
    const float mean = wave_sum(s) * (1.f / 1024.f); float s2 = 0.f;
#pragma unroll
    for (int j = 0; j < 4; ++j) { v[j] = v[j] - mean; s2 += (v[j][0] * v[j][0] + v[j][1] * v[j][1]) + (v[j][2] * v[j][2] + v[j][3] * v[j][3]); }
    const float rstd = 1.f / sqrtf(wave_sum(s2) * (1.f / 1024.f) + 1e-5f);
#pragma unroll
    for (int j = 0; j < 4; ++j) { const f32x4 gg = *(const f32x4*)(p.ln1_g + 256 * j + 4 * lane), bb = *(const f32x4*)(p.ln1_b + 256 * j + 4 * lane);
        v[j] = v[j] * rstd * gg + bb; st4(hr + 256 * j + 4 * lane, v[j]); }
    float lg[36];
#pragma unroll
    for (int o = 0; o < 36; ++o) { float a = 0.f;
#pragma unroll
        for (int j = 0; j < 4; ++j) { const f32x4 w = *(const f32x4*)(wr + o * wstride + 256 * j + 4 * lane); a += (v[j][0] * w[0] + v[j][1] * w[1]) + (v[j][2] * w[2] + v[j][3] * w[3]); }
        lg[o] = wave_sum(a); }
#pragma unroll
    for (int o = 0; o < 4; ++o) lg[o] += p.b_rg[o];
#pragma unroll
    for (int o = 0; o < 32; ++o) lg[4 + o] += p.b_re[o];
    int g = 0; float gm = lg[0];
#pragma unroll
    for (int i = 1; i < 4; ++i) if (lg[i] > gm) { gm = lg[i]; g = i; }
    float se = 0.f;
#pragma unroll
    for (int i = 0; i < 4; ++i) se += expf(lg[i] - gm);
    const float pg = 1.f / se;
    float ev[8];
#pragma unroll
    for (int e = 0; e < 8; ++e) ev[e] = g == 0 ? lg[4 + e] : g == 1 ? lg[12 + e] : g == 2 ? lg[20 + e] : lg[28 + e];
    int i1 = 0; float v1 = ev[0];
#pragma unroll
    for (int e = 1; e < 8; ++e) if (ev[e] > v1) { v1 = ev[e]; i1 = e; }
    int i2 = -1; float v2 = -3.0e38f;
#pragma unroll
    for (int e = 0; e < 8; ++e) if (e != i1 && ev[e] > v2) { v2 = ev[e]; i2 = e; }
    const float d = expf(v2 - v1), g1 = pg / (1.f + d), g2 = pg * d / (1.f + d);
    if (lane < 2) {
        const int ex = g * 8 + (lane == 0 ? i1 : i2), aid = 2 * t + lane;
        const int slot = atomicAdd(p.cnt + ex, 1);
        p.list[(size_t)ex * LIST_CAP + slot] = aid;
        p.gates[aid] = lane == 0 ? g1 : g2;
    }
}
__device__ __forceinline__ void final_token(const Params& p, int t, int lane) {
    const bf16_t* hr = p.hbuf + (size_t)t * DM; const bf16_t* c0 = p.contrib + (size_t)(2 * t) * DM; const bf16_t* c1 = c0 + DM;
    f32x4 v[4]; float s = 0.f;
#pragma unroll
    for (int j = 0; j < 4; ++j) { const int o = 256 * j + 4 * lane; const u32x2 w = *(const u32x2*)(hr + o), a = *(const u32x2*)(c0 + o), b = *(const u32x2*)(c1 + o);
        v[j][0] = ALPHA * bflo(w.x) + bflo(a.x) + bflo(b.x); v[j][1] = ALPHA * bfhi(w.x) + bfhi(a.x) + bfhi(b.x);
        v[j][2] = ALPHA * bflo(w.y) + bflo(a.y) + bflo(b.y); v[j][3] = ALPHA * bfhi(w.y) + bfhi(a.y) + bfhi(b.y);
        s += (v[j][0] + v[j][1]) + (v[j][2] + v[j][3]); }
    const float mean = wave_sum(s) * (1.f / 1024.f); float s2 = 0.f;
#pragma unroll
    for (int j = 0; j < 4; ++j) { v[j] = v[j] - mean; s2 += (v[j][0] * v[j][0] + v[j][1] * v[j][1]) + (v[j][2] * v[j][2] + v[j][3] * v[j][3]); }
    const float rstd = 1.f / sqrtf(wave_sum(s2) * (1.f / 1024.f) + 1e-5f);
#pragma unroll
    for (int j = 0; j < 4; ++j) { const int o = 256 * j + 4 * lane; const f32x4 gg = *(const f32x4*)(p.ln2_g + o), bb = *(const f32x4*)(p.ln2_b + o);
        *(f32x4*)(p.out + (size_t)t * DM + o) = v[j] * rstd * gg + bb; }
}

__global__ __launch_bounds__(256) void nk_prep_w(Params p) { __shared__ float tile[64 * 65]; prep_wjob(p, blockIdx.x, tile, threadIdx.x, 256); }
__global__ __launch_bounds__(256) void nk_ln0(Params p) { const int t = blockIdx.x * 4 + (threadIdx.x >> 6); ln0_row(p.x + (size_t)t * DM, p.ln0_g, p.ln0_b, p.hbuf + (size_t)t * DM, threadIdx.x & 63); }
__global__ __launch_bounds__(256) void nk_rope(Params p) { rope_entry(p, blockIdx.x * 256 + threadIdx.x); if (blockIdx.x == 0 && threadIdx.x < NEXP) p.cnt[threadIdx.x] = 0; }
__global__ __launch_bounds__(256) void nk_rowscale(Params p) {
    const int t = blockIdx.x * 4 + (threadIdx.x >> 6), lane = threadIdx.x & 63;
    float s = 0.f; for (int i = lane; i < 384; i += 64) { const float v = bf2f(p.zq[(size_t)t * 384 + i]); s += v * v; }
    s = wave_sum(s); float s2 = 0.f; for (int i = lane; i < 256; i += 64) { const float v = bf2f(p.zkv[(size_t)t * 256 + i]); s2 += v * v; }
    s2 = wave_sum(s2);
    if (lane == 0) { p.rsq[t] = 1.f / sqrtf(s * (1.f / 384.f) + 1e-6f); p.rskv[t] = 1.f / sqrtf(s2 * (1.f / 256.f) + 1e-6f); }
}
template <class PH> __global__ __launch_bounds__(256) void nk_gemm(PH ph) {
    Unit<typename PH::EP> u; if (!ph.unit(blockIdx.x, u)) return;
    const int wave = threadIdx.x >> 6, lane = threadIdx.x & 63, fr = lane & 15, fq = lane >> 4;
    const int task = blockIdx.y * 4 + wave, rb = task >> 3, cg = task & 7;
    const bf16_t* arow = u.am.row(rb * 16 + fr);
    const bf16_t* b0 = u.bt + (size_t)(cg * 32 + fr) * u.K; const bf16_t* b1 = b0 + (size_t)16 * u.K;
    f32x4 acc0 = {0.f, 0.f, 0.f, 0.f}, acc1 = {0.f, 0.f, 0.f, 0.f};
    for (int k = 0; k < u.K; k += 32) {
        const bf16x8 a = *(const bf16x8*)(arow + k + 8 * fq), x0 = *(const bf16x8*)(b0 + k + 8 * fq), x1 = *(const bf16x8*)(b1 + k + 8 * fq);
        acc0 = __builtin_amdgcn_mfma_f32_16x16x32_bf16(x0, a, acc0, 0, 0, 0);
        acc1 = __builtin_amdgcn_mfma_f32_16x16x32_bf16(x1, a, acc1, 0, 0, 0);
    }
    u.ep(rb * 16 + fr, cg * 32, fq, acc0, acc1);
}
__global__ __launch_bounds__(256) void nk_gmlp(Params p) {
    extern __shared__ float sm[];
    const int unit = blockIdx.x, h = unit & 3, bn = unit >> 2, row0 = bn * 128;
    const int wave = threadIdx.x >> 6, lane = threadIdx.x & 63;
    for (int j = wave; j < 128; j += 4) {
        const bf16_t* vr = p.zv + (size_t)(row0 + j) * 512 + h * 128;
        const float a = bf2f(vr[lane]), b = bf2f(vr[lane + 64]);
        const float mean = wave_sum(a + b) * (1.f / 128.f); const float da = a - mean, db = b - mean;
        const float rstd = 1.f / sqrtf(wave_sum(da * da + db * db) * (1.f / 128.f) + 1e-5f);
        sm[j * 129 + lane] = da * rstd * p.gm_g[h * 128 + lane] + p.gm_b[h * 128 + lane];
        sm[j * 129 + lane + 64] = db * rstd * p.gm_g[h * 128 + lane + 64] + p.gm_b[h * 128 + lane + 64];
    }
    __syncthreads();
    for (int idx = threadIdx.x; idx < 16384; idx += 256) {
        const int i = idx >> 7, c = idx & 127; const int jn = i < 64 ? 64 : 128;
        const float* w = p.w_sp + ((size_t)h * 128 + i) * 128; float f = p.b_sp[h * 128 + i];
        for (int j = 0; j < jn; ++j) f += w[j] * sm[j * 129 + c];
        const float u = bf2f(p.zu[(size_t)(row0 + i) * 512 + h * 128 + c]);
        p.mix[(size_t)(row0 + i) * DM + h * 128 + c] = f2bf(u * f);
    }
}
__global__ __launch_bounds__(256) void nk_attn(Params p) {
    extern __shared__ float sm[];
    float* Qs = sm; float* Ks = Qs + 64 * 192; float* Ss = Ks + 64 * 193; float* Vs = Ss + 64 * 65;
    const int qc = blockIdx.x & 31, bh = blockIdx.x >> 5, b = bh >> 2, h = bh & 3, tid = threadIdx.x, q = tid >> 2, sub = tid & 3;
    for (int idx = tid; idx < 64 * 192; idx += 256) { const int r = idx / 192, d = idx - r * 192; Qs[idx] = bf2f(p.Q[((size_t)bh * SEQ + qc * 64 + r) * 192 + d]); }
    float O[32]; float m = -INFINITY, l = 0.f;
#pragma unroll
    for (int j = 0; j < 32; ++j) O[j] = 0.f;
    for (int kt = 0; kt <= qc; ++kt) {
        __syncthreads();
        for (int idx = tid; idx < 64 * 192; idx += 256) { const int r = idx / 192, d = idx - r * 192; const int key = kt * 64 + r;
            Ks[r * 193 + d] = d < 128 ? bf2f(p.Kn[((size_t)bh * SEQ + key) * 128 + d]) : bf2f(p.krope[((size_t)b * SEQ + key) * 64 + d - 128]); }
        for (int idx = tid; idx < 64 * 128; idx += 256) { const int r = idx >> 7, dv = idx & 127; const int key = kt * 64 + r;
            Vs[r * 128 + dv] = bf2f(p.Vt[((size_t)bh * 128 + dv) * SEQ + (key & ~15) + perm16(key & 15)]); }
        __syncthreads();
        for (int kk = 0; kk < 16; ++kk) { const int key = sub * 16 + kk; float s = 0.f;
            for (int d = 0; d < 192; ++d) s += Qs[q * 192 + d] * Ks[key * 193 + d];
            Ss[q * 65 + key] = s; }
        __syncthreads();
        float mt = -INFINITY; for (int k = 0; k < 64; ++k) mt = fmaxf(mt, Ss[q * 65 + k]);
        const float mn = fmaxf(m, mt), alpha = exp2f(m - mn); m = mn; l *= alpha;
#pragma unroll
        for (int j = 0; j < 32; ++j) O[j] *= alpha;
        for (int k = 0; k < 64; ++k) { const float pk = exp2f(Ss[q * 65 + k] - mn); l += pk;
#pragma unroll
            for (int j = 0; j < 32; ++j) O[j] += pk * Vs[k * 128 + sub * 32 + j]; }
    }
    const float inv = 1.f / l; bf16_t* o = p.mix + ((size_t)b * SEQ + qc * 64 + q) * DM + 512 + h * 128 + sub * 32;
#pragma unroll
    for (int j = 0; j < 32; ++j) o[j] = f2bf(O[j] * inv);
}
__global__ __launch_bounds__(256) void nk_router(Params p) {
    const int t = blockIdx.x * 4 + (threadIdx.x >> 6);
    router_token(p, t, threadIdx.x & 63, (const float*)p.H, 1024);
}
__global__ __launch_bounds__(256) void nk_router_prep(Params p) {
    const int idx = blockIdx.x * 256 + threadIdx.x; if (idx >= 36 * 1024) return;
    const int o = idx >> 10, k = idx & 1023;
    ((float*)p.H)[idx] = o < 4 ? p.w_rg[k * 4 + o] : p.w_re[k * 32 + (o - 4)];
}
__global__ __launch_bounds__(256) void nk_final(Params p) { final_token(p, blockIdx.x * 4 + (threadIdx.x >> 6), threadIdx.x & 63); }

constexpr int LDS_BYTES = 152 * 1024, LDS_RS = 150 * 1024, LDS_XB = 151 * 1024;
constexpr int LDS_PRE = 128 * 1024, LDS_TOT = 144 * 1024, LDS_SEG = LDS_TOT + 256, LDS_AID = LDS_SEG + 2048;
constexpr int LDS_RW = 0, LDS_LCNT = 144 * 1024 + 512;
constexpr int NTHR = 512;

#define XB_TMO      128
#define XB_XCNT(j)  (256  + 64 * (j))
#define XB_XSUB(j)  (1280 + 64 * (j))
#define XB_XGEN(j)  (2304 + 64 * (j))
#define XB_TOP      3328
#define XB_TOPGEN   3392
#define XCD_BAR_WORDS 3456
#define XB_SPIN_CAP (1u << 20)
__device__ __forceinline__ unsigned xb_ld(unsigned* p) { return __hip_atomic_load(p, __ATOMIC_RELAXED, __HIP_MEMORY_SCOPE_AGENT); }
__device__ __forceinline__ unsigned xb_add(unsigned* p, unsigned v) { return __hip_atomic_fetch_add(p, v, __ATOMIC_RELAXED, __HIP_MEMORY_SCOPE_AGENT); }
__device__ __forceinline__ unsigned xb_xcc_id() { return (unsigned)__builtin_amdgcn_s_getreg((3 << 11) | 20) & 0xFu; }
#define XB_SPIN(cond, bar) do { unsigned _sp = 0; while (cond) { __builtin_amdgcn_s_sleep(1); \
    if ((++_sp & 255u) == 0u) { if (xb_ld(&(bar)[XB_TMO])) break; if (_sp > XB_SPIN_CAP) { atomicAdd(&(bar)[XB_TMO], 1u); break; } } } } while (0)
struct XcdBarrier { unsigned* bar; unsigned x; volatile LAS unsigned* st; };
__device__ __forceinline__ XcdBarrier xcd_barrier_post(unsigned* bar, volatile LAS unsigned* st) {
    XcdBarrier b; b.bar = bar; b.x = xb_xcc_id(); b.st = st;
    if (threadIdx.x == 0) (void)xb_add(&bar[XB_XCNT(b.x)], 1u);
    return b;
}
__device__ __forceinline__ void xcd_barrier_complete(unsigned* bar, unsigned x, unsigned& nloc, unsigned& nx) {
    const unsigned G = gridDim.x * gridDim.y * gridDim.z;
    unsigned sum, cnt, mine, sp = 0u;
    for (;;) {
        sum = 0u; cnt = 0u; mine = 0u;
#pragma unroll
        for (unsigned j = 0; j < 16; ++j) { const unsigned c = xb_ld(&bar[XB_XCNT(j)]); sum += c; cnt += (c > 0u) ? 1u : 0u; mine = (j == x) ? c : mine; }
        if (sum == G) break;
        __builtin_amdgcn_s_sleep(1);
        if ((++sp & 255u) == 0u) { if (xb_ld(&bar[XB_TMO])) break; if (sp > XB_SPIN_CAP) { atomicAdd(&bar[XB_TMO], 1u); break; } }
    }
    nloc = mine > 0u ? mine : 1u; nx = cnt > 0u ? cnt : 1u;
}
__device__ __forceinline__ void xcd_barrier(const XcdBarrier& b) {
    asm volatile("s_waitcnt vmcnt(0)" ::: "memory");
    __syncthreads();
    if (threadIdx.x == 0) {
        unsigned* bar = b.bar;
        __builtin_amdgcn_s_waitcnt(0);
        unsigned nloc = b.st[0], nx = b.st[1];
        if (nloc == 0u) { xcd_barrier_complete(bar, b.x, nloc, nx); b.st[0] = nloc; b.st[1] = nx; }
        const unsigned old = xb_add(&bar[XB_XSUB(b.x)], 1u);
        const unsigned gen = old / nloc;
        if (old + 1u == (gen + 1u) * nloc) {
            __builtin_amdgcn_fence(__ATOMIC_RELEASE, "agent");
            asm volatile("s_waitcnt vmcnt(0)" ::: "memory");
            const unsigned og = xb_add(&bar[XB_TOP], 1u);
            const unsigned tg = og / nx;
            if (og + 1u == (tg + 1u) * nx) xb_add(&bar[XB_TOPGEN], 1u);
            else XB_SPIN(xb_ld(&bar[XB_TOPGEN]) == tg, bar);
            __builtin_amdgcn_fence(__ATOMIC_ACQUIRE, "agent");
            xb_add(&bar[XB_XGEN(b.x)], 1u);
            asm volatile("s_waitcnt vmcnt(0)" ::: "memory");
        } else {
            XB_SPIN(xb_ld(&bar[XB_XGEN(b.x)]) == gen, bar);
            __builtin_amdgcn_fence(__ATOMIC_ACQUIRE, "agent");
            asm volatile("s_waitcnt vmcnt(0)" ::: "memory");
        }
    }
    __syncthreads();
}

constexpr int BK = 64, HALF = 128, HT = HALF * BK;
__device__ __forceinline__ int lds_byte(int r, int c) { const int st = (r >> 4) * 2 + (c >> 5), rr = r & 15, cc = c & 31, ob = rr * 64 + cc * 2; return st * 1024 + (ob ^ (((ob >> 9) & 1) << 5)); }
__device__ __forceinline__ void stage_rc(int b, int& R, int& C) { const int st = b / 1024, sb = b % 1024, swz = sb ^ (((sb >> 9) & 1) << 5); R = (st >> 1) * 16 + swz / 64; C = (st & 1) * 32 + (swz % 64) / 2; }

template <class EP>
__device__ __forceinline__ void gemm256(const Unit<EP>& u, LAS unsigned char* lds) {
    int tid = threadIdx.x; asm volatile("" : "+v"(tid));
    const int K = u.K, nt = K / BK;
    const int wid = __builtin_amdgcn_readfirstlane(tid >> 6), lane = tid & 63, wr = wid >> 2, wc = wid & 3, fr = lane & 15, fq = lane >> 4;
    unsigned voffA[2][2], voffB[2];
    const char* gA = (const char*)u.am.base; const char* gB = (const char*)u.bt;
#pragma unroll
    for (int i = 0; i < 2; ++i) { int R, C; stage_rc(tid * 16 + i * 8192, R, C);
        voffB[i] = (unsigned)(R * K + C) * 2u;
        if (u.am.list) { const int a0 = u.am.list[R < u.am.nvalid ? R : 0], a1 = u.am.list[R + HALF < u.am.nvalid ? R + HALF : 0];
            voffA[0][i] = ((unsigned)(a0 >> 1) * (unsigned)u.am.ld + (unsigned)C) * 2u; voffA[1][i] = ((unsigned)(a1 >> 1) * (unsigned)u.am.ld + (unsigned)C) * 2u; }
        else { voffA[0][i] = (unsigned)(R * u.am.ld + C) * 2u; voffA[1][i] = (unsigned)((R + HALF) * u.am.ld + C) * 2u; } }
    const size_t hstepB = (size_t)HALF * K * 2;
    const unsigned ldsw = (unsigned)wid * 1024u;
    const int aoff = lds_byte(wr * 64 + fr, fq * 8), boff = lds_byte(wc * 32 + fr, fq * 8);
    #define SA(b,h) (((b)*2+(h))*HT*2)
    #define SB(b,h) ((4+(b)*2+(h))*HT*2)
    #define STAGE_A(bufoff,h,kt) do{ _Pragma("unroll") for(int _i=0;_i<2;++_i) { asm volatile("" : "+v"(voffA[h][_i])); \
        __builtin_amdgcn_global_load_lds((const unsigned*)(gA+(size_t)(kt)*(BK*2)+voffA[h][_i]),(LAS unsigned*)(lds+(bufoff)+ldsw+_i*8192),16,0,0);} }while(0)
    #define STAGE_B(bufoff,h,kt) do{ _Pragma("unroll") for(int _i=0;_i<2;++_i) { asm volatile("" : "+v"(voffB[_i])); \
        __builtin_amdgcn_global_load_lds((const unsigned*)(gB+(size_t)(h)*hstepB+(size_t)(kt)*(BK*2)+voffB[_i]),(LAS unsigned*)(lds+(bufoff)+ldsw+_i*8192),16,0,0);} }while(0)
    #define LDA(dst,b,h) _Pragma("unroll") for(int m=0;m<4;++m) _Pragma("unroll") for(int k=0;k<2;++k) \
        dst[m][k]=*(const LAS bf16x8*)(lds+SA(b,h)+aoff+m*2048+k*1024)
    #define LDB(dst,b,h) _Pragma("unroll") for(int n=0;n<2;++n) _Pragma("unroll") for(int k=0;k<2;++k) \
        dst[n][k]=*(const LAS bf16x8*)(lds+SB(b,h)+boff+n*2048+k*1024)
    #define MMA(ai,bj,At_,Bt_) do{__builtin_amdgcn_s_setprio(1); \
        _Pragma("unroll") for(int m=0;m<4;++m) _Pragma("unroll") for(int n=0;n<2;++n) _Pragma("unroll") for(int k=0;k<2;++k) \
          acc[ai][bj][m][n]=__builtin_amdgcn_mfma_f32_16x16x32_bf16(Bt_[n][k],At_[m][k],acc[ai][bj][m][n],0,0,0); \
        __builtin_amdgcn_s_setprio(0);}while(0)
    #define WAIT_V(n) asm volatile("s_waitcnt vmcnt(" #n ")":::"memory")
    #define WAIT_L(n) asm volatile("s_waitcnt lgkmcnt(" #n ")":::"memory")
    #define BAR __builtin_amdgcn_s_barrier()
    #define SCHED __builtin_amdgcn_sched_barrier(0)

    f32x4 acc[2][2][4][2];
#pragma unroll
    for (int a = 0; a < 2; ++a)
#pragma unroll
        for (int b = 0; b < 2; ++b)
#pragma unroll
            for (int m = 0; m < 4; ++m)
#pragma unroll
                for (int n = 0; n < 2; ++n) acc[a][b][m][n] = (f32x4){0.f, 0.f, 0.f, 0.f};
    bf16x8 At[4][2], B0[2][2], B1[2][2];
    STAGE_B(SB(0,0),0,0); STAGE_A(SA(0,0),0,0);
    STAGE_B(SB(0,1),1,0); STAGE_A(SA(0,1),1,0);
    if (wr == 1) BAR;
    WAIT_V(4); BAR;
    STAGE_B(SB(1,0),0,1); STAGE_A(SA(1,0),0,1); STAGE_B(SB(1,1),1,1);
    WAIT_V(6); BAR;
    for (int t = 0; t < nt - 2; t += 2) {
        LDB(B0,0,0); SCHED; LDA(At,0,0); STAGE_A(SA(1,1),1,t+1);
        WAIT_L(8); BAR; WAIT_L(0); MMA(0,0,At,B0); BAR; SCHED;
        LDB(B1,0,1); STAGE_B(SB(0,0),0,t+2);
        BAR; WAIT_L(0); MMA(0,1,At,B1); BAR;
        LDA(At,0,1); STAGE_A(SA(0,0),0,t+2);
        BAR; WAIT_L(0); MMA(1,0,At,B0); BAR; SCHED;
        STAGE_B(SB(0,1),1,t+2);
        WAIT_V(6); BAR; MMA(1,1,At,B1); BAR;
        LDB(B0,1,0); SCHED; LDA(At,1,0); STAGE_A(SA(0,1),1,t+2);
        WAIT_L(8); BAR; WAIT_L(0); MMA(0,0,At,B0); BAR; SCHED;
        LDB(B1,1,1); STAGE_B(SB(1,0),0,t+3);
        BAR; WAIT_L(0); MMA(0,1,At,B1); BAR;
        LDA(At,1,1); STAGE_A(SA(1,0),0,t+3);
        BAR; WAIT_L(0); MMA(1,0,At,B0); BAR; SCHED;
        STAGE_B(SB(1,1),1,t+3);
        WAIT_V(6); BAR; MMA(1,1,At,B1); BAR;
    }
    { LDB(B0,0,0); LDA(At,0,0); STAGE_A(SA(1,1),1,nt-1);
      BAR; WAIT_L(0); MMA(0,0,At,B0); BAR;
      LDB(B1,0,1); BAR; WAIT_L(0); MMA(0,1,At,B1); BAR;
      LDA(At,0,1); WAIT_V(4); BAR; WAIT_L(0); MMA(1,0,At,B0); MMA(1,1,At,B1); BAR; }
    { LDB(B0,1,0); LDA(At,1,0); WAIT_V(2); BAR; WAIT_L(0); MMA(0,0,At,B0); BAR;
      LDB(B1,1,1); WAIT_V(0); BAR; WAIT_L(0); MMA(0,1,At,B1); BAR;
      LDA(At,1,1); BAR; WAIT_L(0); MMA(1,0,At,B0); MMA(1,1,At,B1); BAR; }
    if (wr == 0) BAR;
#pragma unroll
    for (int ai = 0; ai < 2; ++ai)
#pragma unroll
        for (int bj = 0; bj < 2; ++bj)
#pragma unroll
            for (int m = 0; m < 4; ++m) { u.ep(ai * HALF + wr * 64 + m * 16 + fr, bj * HALF + wc * 32, fq, acc[ai][bj][m][0], acc[ai][bj][m][1]); if (m & 1) SCHED; }
    __syncthreads();
    #undef SA
    #undef SB
    #undef STAGE_A
    #undef STAGE_B
    #undef LDA
    #undef LDB
    #undef MMA
}

__device__ __forceinline__ void rs_table(const bf16_t* A, int K, float* tab) {
    int tid = threadIdx.x; asm volatile("" : "+v"(tid));
    const int r = tid >> 1, hf = tid & 1, n = K >> 1;
    const bf16_t* a = A + (size_t)r * K + hf * n; float s = 0.f;
    for (int i = 0; i < n; i += 8) { const u32x4 w = *(const u32x4*)(a + i);
        const float a0 = bflo(w.x), a1 = bfhi(w.x), a2 = bflo(w.y), a3 = bfhi(w.y), a4 = bflo(w.z), a5 = bfhi(w.z), a6 = bflo(w.w), a7 = bfhi(w.w);
        s += (a0 * a0 + a1 * a1) + (a2 * a2 + a3 * a3) + (a4 * a4 + a5 * a5) + (a6 * a6 + a7 * a7); }
    s += __shfl_xor(s, 1);
    if (hf == 0) tab[r] = 1.f / sqrtf(s / (float)K + 1e-6f);
}

__device__ __forceinline__ void gmlp_phase(const Params& p, char* shm) {
    int tid = threadIdx.x; asm volatile("" : "+v"(tid));
    const int wid = __builtin_amdgcn_readfirstlane(tid >> 6), lane = tid & 63, fr = lane & 15, fq = lane >> 4;
    const int h = blockIdx.x & 3, iabs = 16 * wid + fr;
    bf16x8 wf[4];
#pragma unroll
    for (int ks = 0; ks < 4; ++ks) {
        const float* w = p.w_sp + ((size_t)h * 128 + iabs) * 128 + 32 * ks + 8 * fq;
        const f32x4 w0 = *(const f32x4*)w, w1 = *(const f32x4*)(w + 4);
        const bool ok = (ks >> 1) <= (iabs >> 6);
        u32x4 pk; pk.x = pk2(w0[0], w0[1]); pk.y = pk2(w0[2], w0[3]); pk.z = pk2(w1[0], w1[1]); pk.w = pk2(w1[2], w1[3]);
        if (!ok) pk = (u32x4){0u, 0u, 0u, 0u};
        wf[ks] = __builtin_bit_cast(bf16x8, pk);
    }
    const float bias = p.b_sp[h * 128 + iabs];
    const int nks = (wid < 4) ? 2 : 4;
    const int j = tid >> 2, part = tid & 3;
    for (int u = blockIdx.x; u < (T_TOK / 128) * 4; u += gridDim.x) {
        const int bn = u >> 2, row0 = bn * 128;
        {
            const bf16_t* vr = p.zv + (size_t)(row0 + j) * 512 + h * 128 + part * 32;
            float v[32];
#pragma unroll
            for (int q = 0; q < 4; ++q) { const u32x4 w = *(const u32x4*)(vr + 8 * q);
                v[8 * q + 0] = bflo(w.x); v[8 * q + 1] = bfhi(w.x); v[8 * q + 2] = bflo(w.y); v[8 * q + 3] = bfhi(w.y);
                v[8 * q + 4] = bflo(w.z); v[8 * q + 5] = bfhi(w.z); v[8 * q + 6] = bflo(w.w); v[8 * q + 7] = bfhi(w.w); }
            float s = 0.f;
#pragma unroll
            for (int e = 0; e < 32; ++e) s += v[e];
            s += __shfl_xor(s, 1); s += __shfl_xor(s, 2);
            const float mean = s * (1.f / 128.f); float s2 = 0.f;
#pragma unroll
            for (int e = 0; e < 32; ++e) { v[e] -= mean; s2 += v[e] * v[e]; }
            s2 += __shfl_xor(s2, 1); s2 += __shfl_xor(s2, 2);
            const float rstd = 1.f / sqrtf(s2 * (1.f / 128.f) + 1e-5f);
            const float* gg = p.gm_g + h * 128 + part * 32; const float* bb = p.gm_b + h * 128 + part * 32;
#pragma unroll
            for (int e = 0; e < 32; ++e) *(bf16_t*)(shm + (part * 32 + e) * 272 + j * 2) = f2bf(v[e] * rstd * gg[e] + bb[e]);
        }
        __syncthreads();
        f32x4 acc[8];
#pragma unroll
        for (int cb = 0; cb < 8; ++cb) acc[cb] = (f32x4){0.f, 0.f, 0.f, 0.f};
#pragma unroll
        for (int ks = 0; ks < 4; ++ks) if (ks < nks) {
#pragma unroll
            for (int cb = 0; cb < 8; ++cb) { const bf16x8 a = *(const bf16x8*)(shm + (16 * cb + fr) * 272 + (32 * ks + 8 * fq) * 2);
                acc[cb] = __builtin_amdgcn_mfma_f32_16x16x32_bf16(a, wf[ks], acc[cb], 0, 0, 0); }
        }
        const bf16_t* ur = p.zu + (size_t)(row0 + iabs) * 512 + h * 128 + 4 * fq;
        bf16_t* orow = p.mix + (size_t)(row0 + iabs) * DM + h * 128 + 4 * fq;
#pragma unroll
        for (int cb = 0; cb < 8; ++cb) { const u32x2 uw = *(const u32x2*)(ur + 16 * cb); f32x4 o;
            o[0] = bflo(uw.x) * (acc[cb][0] + bias); o[1] = bfhi(uw.x) * (acc[cb][1] + bias); o[2] = bflo(uw.y) * (acc[cb][2] + bias); o[3] = bfhi(uw.y) * (acc[cb][3] + bias);
            st4(orow + 16 * cb, o); }
        __syncthreads();
    }
}

constexpr int KT_STRIDE = 400, VT_STRIDE = 144, KT_BYTES = 64 * KT_STRIDE, ATT_STAGE = KT_BYTES + 128 * VT_STRIDE;
__device__ __forceinline__ void attn_block(const Params& p, char* shm, int bh, int qb) {
    int tid = threadIdx.x; asm volatile("" : "+v"(tid));
    const int wid = __builtin_amdgcn_readfirstlane(tid >> 6), lane = tid & 63, r = lane & 31, hh = lane >> 5;
    const int b = bh >> 2, h = bh & 3, q0 = qb * 256, ntile = 4 * qb + 4, nw = 4 * qb + (wid >> 1) + 1;
    bf16x8 qf[12];
    { const bf16_t* qp = p.Q + ((size_t)bh * SEQ + q0 + 32 * wid + r) * 192 + 8 * hh;
#pragma unroll
      for (int s = 0; s < 12; ++s) qf[s] = *(const bf16x8*)(qp + 16 * s); }
    f32x16 O[4];
#pragma unroll
    for (int d = 0; d < 4; ++d)
#pragma unroll
        for (int t = 0; t < 16; ++t) O[d][t] = 0.f;
    float m = -INFINITY, l = 0.f;
    const bf16_t* kn_src = p.Kn + ((size_t)bh * SEQ + (tid >> 4)) * 128 + (tid & 15) * 8;
    const bf16_t* kr_src = p.krope + ((size_t)b * SEQ + (tid >> 3)) * 64 + (tid & 7) * 8;
    const bf16_t* vt_src = p.Vt + ((size_t)bh * 128 + (tid >> 3)) * SEQ + (tid & 7) * 8;
    const int kn_dst = (tid >> 4) * KT_STRIDE + (tid & 15) * 16, kr_dst = (tid >> 3) * KT_STRIDE + 256 + (tid & 7) * 16, vt_dst = KT_BYTES + (tid >> 3) * VT_STRIDE + (tid & 7) * 16;
    u32x4 g0, g1, g2, g3, g4;
    #define ATT_LOAD(kt) do { g0 = *(const u32x4*)(kn_src + (size_t)(kt) * 64 * 128); g1 = *(const u32x4*)(kn_src + (size_t)((kt) * 64 + 32) * 128); \
        g2 = *(const u32x4*)(kr_src + (size_t)(kt) * 64 * 64); g3 = *(const u32x4*)(vt_src + (kt) * 64); g4 = *(const u32x4*)(vt_src + (size_t)64 * SEQ + (kt) * 64); } while (0)
    #define ATT_WRITE(buf) do { char* _s = shm + (buf) * ATT_STAGE; *(u32x4*)(_s + kn_dst) = g0; *(u32x4*)(_s + kn_dst + 32 * KT_STRIDE) = g1; *(u32x4*)(_s + kr_dst) = g2; \
        *(u32x4*)(_s + vt_dst) = g3; *(u32x4*)(_s + vt_dst + 64 * VT_STRIDE) = g4; } while (0)
    ATT_LOAD(0); ATT_WRITE(0);
    __syncthreads();
    for (int kt = 0; kt < ntile; ++kt) {
        const bool more = kt + 1 < ntile;
        if (more) ATT_LOAD(kt + 1);
        if (kt < nw) {
            const char* ks = shm + (kt & 1) * ATT_STAGE; const char* vs = ks + KT_BYTES;
            f32x16 S0, S1;
#pragma unroll
            for (int t = 0; t < 16; ++t) { S0[t] = 0.f; S1[t] = 0.f; }
#pragma unroll
            for (int s = 0; s < 12; ++s) {
                const bf16x8 k0 = *(const bf16x8*)(ks + r * KT_STRIDE + (16 * s + 8 * hh) * 2), k1 = *(const bf16x8*)(ks + (32 + r) * KT_STRIDE + (16 * s + 8 * hh) * 2);
                S0 = __builtin_amdgcn_mfma_f32_32x32x16_bf16(k0, qf[s], S0, 0, 0, 0);
                S1 = __builtin_amdgcn_mfma_f32_32x32x16_bf16(k1, qf[s], S1, 0, 0, 0);
            }
            float mt = fmaxf(S0[0], S1[0]);
#pragma unroll
            for (int t = 1; t < 16; ++t) mt = fmaxf(mt, fmaxf(S0[t], S1[t]));
            mt = fmaxf(mt, __shfl_xor(mt, 32));
            const float mn = fmaxf(m, mt), alpha = __builtin_amdgcn_exp2f(m - mn); m = mn;
            float ls = 0.f;
#pragma unroll
            for (int t = 0; t < 16; ++t) { S0[t] = __builtin_amdgcn_exp2f(S0[t] - mn); S1[t] = __builtin_amdgcn_exp2f(S1[t] - mn); ls += S0[t] + S1[t]; }
            l = l * alpha + ls;
#pragma unroll
            for (int d = 0; d < 4; ++d)
#pragma unroll
                for (int t = 0; t < 16; ++t) O[d][t] *= alpha;
            bf16x8 pf[4];
#pragma unroll
            for (int s = 0; s < 2; ++s) {
                u32x4 a, c; a.x = pk2(S0[8 * s + 0], S0[8 * s + 1]); a.y = pk2(S0[8 * s + 2], S0[8 * s + 3]); a.z = pk2(S0[8 * s + 4], S0[8 * s + 5]); a.w = pk2(S0[8 * s + 6], S0[8 * s + 7]);
                c.x = pk2(S1[8 * s + 0], S1[8 * s + 1]); c.y = pk2(S1[8 * s + 2], S1[8 * s + 3]); c.z = pk2(S1[8 * s + 4], S1[8 * s + 5]); c.w = pk2(S1[8 * s + 6], S1[8 * s + 7]);
                pf[s] = __builtin_bit_cast(bf16x8, a); pf[2 + s] = __builtin_bit_cast(bf16x8, c);
            }
#pragma unroll
            for (int k4 = 0; k4 < 4; ++k4)
#pragma unroll
                for (int d = 0; d < 4; ++d) { const bf16x8 vf = *(const bf16x8*)(vs + (32 * d + r) * VT_STRIDE + (16 * k4 + 8 * hh) * 2);
                    O[d] = __builtin_amdgcn_mfma_f32_32x32x16_bf16(vf, pf[k4], O[d], 0, 0, 0); }
        }
        if (more) ATT_WRITE((kt + 1) & 1);
        __syncthreads();
    }
    #undef ATT_LOAD
    #undef ATT_WRITE
    l += __shfl_xor(l, 32);
    const float inv = 1.f / l;
    bf16_t* o = p.mix + ((size_t)b * SEQ + q0 + 32 * wid + r) * DM + 512 + h * 128 + 4 * hh;
#pragma unroll
    for (int d = 0; d < 4; ++d)
#pragma unroll
        for (int g = 0; g < 4; ++g) { f32x4 v; v[0] = O[d][4 * g] * inv; v[1] = O[d][4 * g + 1] * inv; v[2] = O[d][4 * g + 2] * inv; v[3] = O[d][4 * g + 3] * inv; st4(o + 32 * d + 8 * g, v); }
}


__device__ __forceinline__ void router_tile(const Params& p, char* smc, int tb) {
    int tid = threadIdx.x; asm volatile("" : "+v"(tid));
    const int wid = __builtin_amdgcn_readfirstlane(tid >> 6), lane = tid & 63, fr = lane & 15, fq = lane >> 4;
    int* lcnt = (int*)(smc + LDS_LCNT);
    for (int i = tid; i < 2 * 36 * 128; i += NTHR) { const int img = i / (36 * 128), rem = i - img * 36 * 128, o = rem >> 7, ch = rem & 127;
        const u32x4 w = *(const u32x4*)(p.WrT + (size_t)img * 36864 + o * 1024 + ch * 8);
        *(u32x4*)(smc + LDS_RW + img * 73728 + o * 2048 + ((ch ^ (o & 15)) << 4)) = w; }
    if (tid < NEXP) lcnt[tid] = 0;
    __syncthreads();
    const int tok = tb * 128 + wid * 16 + fr;
    bf16_t* hr = p.hbuf + (size_t)tok * DM + 8 * fq;
    float s = 0.f, s2 = 0.f;
#pragma unroll 8
    for (int ks = 0; ks < 32; ++ks) { const u32x4 y = *(const u32x4*)(hr + 32 * ks);
        const float a0 = bflo(y.x), a1 = bfhi(y.x), a2 = bflo(y.y), a3 = bfhi(y.y), a4 = bflo(y.z), a5 = bfhi(y.z), a6 = bflo(y.w), a7 = bfhi(y.w);
        s += ((a0 + a1) + (a2 + a3)) + ((a4 + a5) + (a6 + a7)); s2 += ((a0 * a0 + a1 * a1) + (a2 * a2 + a3 * a3)) + ((a4 * a4 + a5 * a5) + (a6 * a6 + a7 * a7)); }
    s += __shfl_xor(s, 16); s += __shfl_xor(s, 32); s2 += __shfl_xor(s2, 16); s2 += __shfl_xor(s2, 32);
    const float mean = s * (1.f / 1024.f), var = fmaxf(s2 * (1.f / 1024.f) - mean * mean, 0.f), rstd = 1.f / sqrtf(var + 1e-5f);
    const int o0 = fr < 4 ? fr : 3, o1 = 4 + fr, o2 = 20 + fr;
    const int w0 = o0 * 2048, w1 = o1 * 2048, w2 = o2 * 2048, x0 = o0 & 15, x1 = o1 & 15, x2 = o2 & 15;
    f32x4 acc0 = {0.f, 0.f, 0.f, 0.f}, acc1 = acc0, acc2 = acc0;
    const float* lg_ = p.ln1_g + 8 * fq; const float* lb_ = p.ln1_b + 8 * fq;
#pragma unroll 4
    for (int ks = 0; ks < 32; ++ks) {
        const f32x4 g0 = *(const f32x4*)(lg_ + 32 * ks), g1 = *(const f32x4*)(lg_ + 32 * ks + 4), b0 = *(const f32x4*)(lb_ + 32 * ks), b1 = *(const f32x4*)(lb_ + 32 * ks + 4);
        const u32x4 yy = *(const u32x4*)(hr + 32 * ks);
        float h[8];
        h[0] = (bflo(yy.x) - mean) * rstd * g0[0] + b0[0]; h[1] = (bfhi(yy.x) - mean) * rstd * g0[1] + b0[1]; h[2] = (bflo(yy.y) - mean) * rstd * g0[2] + b0[2]; h[3] = (bfhi(yy.y) - mean) * rstd * g0[3] + b0[3];
        h[4] = (bflo(yy.z) - mean) * rstd * g1[0] + b1[0]; h[5] = (bfhi(yy.z) - mean) * rstd * g1[1] + b1[1]; h[6] = (bflo(yy.w) - mean) * rstd * g1[2] + b1[2]; h[7] = (bfhi(yy.w) - mean) * rstd * g1[3] + b1[3];
        u32x4 hi, lo; hi.x = pk2(h[0], h[1]); hi.y = pk2(h[2], h[3]); hi.z = pk2(h[4], h[5]); hi.w = pk2(h[6], h[7]);
        *(u32x4*)(hr + 32 * ks) = hi;
        lo.x = pk2(h[0] - bflo(hi.x), h[1] - bfhi(hi.x)); lo.y = pk2(h[2] - bflo(hi.y), h[3] - bfhi(hi.y)); lo.z = pk2(h[4] - bflo(hi.z), h[5] - bfhi(hi.z)); lo.w = pk2(h[6] - bflo(hi.w), h[7] - bfhi(hi.w));
        const bf16x8 hh = __builtin_bit_cast(bf16x8, hi), hl = __builtin_bit_cast(bf16x8, lo);
        const int ch = 4 * ks + fq;
        const bf16x8 a0h = *(const bf16x8*)(smc + LDS_RW + w0 + ((ch ^ x0) << 4)), a0l = *(const bf16x8*)(smc + LDS_RW + 73728 + w0 + ((ch ^ x0) << 4));
        const bf16x8 a1h = *(const bf16x8*)(smc + LDS_RW + w1 + ((ch ^ x1) << 4)), a1l = *(const bf16x8*)(smc + LDS_RW + 73728 + w1 + ((ch ^ x1) << 4));
        const bf16x8 a2h = *(const bf16x8*)(smc + LDS_RW + w2 + ((ch ^ x2) << 4)), a2l = *(const bf16x8*)(smc + LDS_RW + 73728 + w2 + ((ch ^ x2) << 4));
        acc0 = __builtin_amdgcn_mfma_f32_16x16x32_bf16(a0h, hh, acc0, 0, 0, 0); acc0 = __builtin_amdgcn_mfma_f32_16x16x32_bf16(a0h, hl, acc0, 0, 0, 0); acc0 = __builtin_amdgcn_mfma_f32_16x16x32_bf16(a0l, hh, acc0, 0, 0, 0);
        acc1 = __builtin_amdgcn_mfma_f32_16x16x32_bf16(a1h, hh, acc1, 0, 0, 0); acc1 = __builtin_amdgcn_mfma_f32_16x16x32_bf16(a1h, hl, acc1, 0, 0, 0); acc1 = __builtin_amdgcn_mfma_f32_16x16x32_bf16(a1l, hh, acc1, 0, 0, 0);
        acc2 = __builtin_amdgcn_mfma_f32_16x16x32_bf16(a2h, hh, acc2, 0, 0, 0); acc2 = __builtin_amdgcn_mfma_f32_16x16x32_bf16(a2h, hl, acc2, 0, 0, 0); acc2 = __builtin_amdgcn_mfma_f32_16x16x32_bf16(a2l, hh, acc2, 0, 0, 0);
    }
    __syncthreads();
    float* sc = (float*)(smc + LDS_RW) + wid * (16 * 40) + fr * 40;
    if (fq == 0) { sc[0] = acc0[0]; sc[1] = acc0[1]; sc[2] = acc0[2]; sc[3] = acc0[3]; }
    *(f32x4*)(sc + 4 + 4 * fq) = acc1; *(f32x4*)(sc + 20 + 4 * fq) = acc2;
    __syncthreads();
    if (lane < 16) {
        const float* lr = (const float*)(smc + LDS_RW) + wid * (16 * 40) + lane * 40;
        float lg[36];
#pragma unroll
        for (int o = 0; o < 36; o += 4) { const f32x4 v = *(const f32x4*)(lr + o); lg[o] = v[0]; lg[o + 1] = v[1]; lg[o + 2] = v[2]; lg[o + 3] = v[3]; }
#pragma unroll
        for (int o = 0; o < 4; ++o) lg[o] += p.b_rg[o];
#pragma unroll
        for (int o = 0; o < 32; ++o) lg[4 + o] += p.b_re[o];
        int g = 0; float gm = lg[0];
#pragma unroll
        for (int i = 1; i < 4; ++i) if (lg[i] > gm) { gm = lg[i]; g = i; }
        float se = 0.f;
#pragma unroll
        for (int i = 0; i < 4; ++i) se += expf(lg[i] - gm);
        const float pg = 1.f / se;
        float ev[8];
#pragma unroll
        for (int e = 0; e < 8; ++e) ev[e] = g == 0 ? lg[4 + e] : g == 1 ? lg[12 + e] : g == 2 ? lg[20 + e] : lg[28 + e];
        int i1 = 0; float v1 = ev[0];
#pragma unroll
        for (int e = 1; e < 8; ++e) if (ev[e] > v1) { v1 = ev[e]; i1 = e; }
        int i2 = -1; float v2 = -3.0e38f;
#pragma unroll
        for (int e = 0; e < 8; ++e) if (e != i1 && ev[e] > v2) { v2 = ev[e]; i2 = e; }
        const float d = expf(v2 - v1), g1 = pg / (1.f + d), g2 = pg * d / (1.f + d);
        const int t = tb * 128 + wid * 16 + lane, e1 = g * 8 + i1, e2 = g * 8 + i2;
        const int s1 = atomicAdd(lcnt + e1, 1), s2_ = atomicAdd(lcnt + e2, 1);
        p.listb[((size_t)tb * NEXP + e1) * 256 + s1] = 2 * t; p.listb[((size_t)tb * NEXP + e2) * 256 + s2_] = 2 * t + 1;
        p.gates[2 * t] = g1; p.gates[2 * t + 1] = g2;
    }
    __syncthreads();
    if (tid < NEXP) p.cntb[tb * NEXP + tid] = lcnt[tid];
    __syncthreads();
}
__device__ __forceinline__ void moe_tables(const Params& p, char* smc) {
    int tid = threadIdx.x; asm volatile("" : "+v"(tid));
    const int e = tid & 31, seg = tid >> 5;
    unsigned short* pre = (unsigned short*)(smc + LDS_PRE); int* tot = (int*)(smc + LDS_TOT); int* segtot = (int*)(smc + LDS_SEG);
    int c[16]; int run = 0;
#pragma unroll
    for (int i = 0; i < 16; ++i) c[i] = p.cntb[(16 * seg + i) * NEXP + e];
#pragma unroll
    for (int i = 0; i < 16; ++i) { const int v = c[i]; c[i] = run; run += v; }
    segtot[seg * 32 + e] = run;
    __syncthreads();
    int base = 0, all = 0;
#pragma unroll
    for (int s = 0; s < 16; ++s) { const int v = segtot[s * 32 + e]; base += (s < seg) ? v : 0; all += v; }
#pragma unroll
    for (int i = 0; i < 16; ++i) pre[e * 256 + 16 * seg + i] = (unsigned short)(base + c[i]);
    if (seg == 0) tot[e] = all;
    __syncthreads();
}

template <class PH> __device__ __forceinline__ void gemm_phase(const PH& ph, LAS unsigned char* shm) {
    for (int u = blockIdx.x;; u += gridDim.x) { Unit<typename PH::EP> un; if (u >= PH::NU || !ph.unit(u, un)) break; gemm256(un, shm); }
}
typedef const __attribute__((address_space(4))) Params* KParams;
__device__ __forceinline__ Params ldp() {
#if defined(__HIP_DEVICE_COMPILE__)
    KParams q = (KParams)__builtin_amdgcn_kernarg_segment_ptr(); asm volatile("" : "+s"(q)); return *q;
#else
    return Params{};
#endif
}
template <int LO, int HI>
__global__ __launch_bounds__(512, 2) void mega(Params p_arg_unused) {
    extern __shared__ __attribute__((aligned(16))) unsigned char lds_raw[];
    LAS unsigned char* shm = (LAS unsigned char*)lds_raw;
    char* smc = (char*)lds_raw;
    const int nblk = gridDim.x;
    #define PHASE_IDS int tid = threadIdx.x; asm volatile("" : "+v"(tid)); const int wid = __builtin_amdgcn_readfirstlane(tid >> 6), lane = tid & 63; (void)wid; (void)lane
    XcdBarrier xb;
    if (LO != HI) {
        if (threadIdx.x == 0) { ((volatile LAS unsigned*)(smc + LDS_XB))[0] = 0u; ((volatile LAS unsigned*)(smc + LDS_XB))[1] = 0u; }
        __syncthreads();
        { const Params p = ldp(); xb = xcd_barrier_post(p.bar, (volatile LAS unsigned*)(smc + LDS_XB)); }
    }
    #define SEAM(ph) if (LO <= (ph) && HI > (ph)) xcd_barrier(xb)
#ifndef REPMASK
#define REPMASK 0
#endif
    #define NREP(k) ((((REPMASK) >> (k)) & 1) ? 2 : 1)
    #define REPEAT(k) for (int rep_ = 0; rep_ < NREP(k); ++rep_, (rep_ < NREP(k) ? xcd_barrier(xb) : (void)0))
    if (LO <= 0 && HI >= 0) REPEAT(0) {
        const Params p = ldp(); PHASE_IDS;
        for (int job = blockIdx.x; job < J_TOTAL; job += nblk) prep_wjob(p, job, (float*)smc, tid, NTHR);
        for (int t = blockIdx.x * 8 + wid; t < T_TOK; t += nblk * 8) ln0_row(p.x + (size_t)t * DM, p.ln0_g, p.ln0_b, p.hbuf + (size_t)t * DM, lane);
        for (int i = blockIdx.x * NTHR + tid; i < T_TOK * 32; i += nblk * NTHR) rope_entry(p, i);
        for (int i = blockIdx.x * NTHR + tid; i < 36 * 1024; i += nblk * NTHR) { const int o = i >> 10, k = i & 1023; const float w = o < 4 ? p.w_rg[k * 4 + o] : p.w_re[k * 32 + (o - 4)];
            const bf16_t hi = f2bf(w); p.WrT[i] = hi; p.WrT[36864 + i] = f2bf(w - bf2f(hi)); }
    }
    SEAM(0);
    if (LO <= 1 && HI >= 1) REPEAT(1) gemm_phase(PhZ{ldp()}, shm);
    SEAM(1);
    if (LO <= 2 && HI >= 2) REPEAT(2) {
        const Params p = ldp();
        float* tab = (float*)(smc + LDS_RS);
#if !defined(P2VAR) || P2VAR == 0 || P2VAR == 1
        for (int u = blockIdx.x; u < PhQ::NU + PhKV::NU; u += nblk) {
            if (u < PhQ::NU) { Unit<EpiQ> un; PhQ{p, tab}.unit(u, un); rs_table(un.am.base, 384, tab); un.ep.rs0 = un.ep.row0; gemm256(un, shm); }
            else { Unit<EpiKV> un; PhKV{p, tab}.unit(u - PhQ::NU, un); rs_table(un.am.base, 256, tab); un.ep.rs0 = un.ep.row0; gemm256(un, shm); }
        }
#endif
#if !defined(P2VAR) || P2VAR == 0 || P2VAR == 2
        gmlp_phase(p, smc);
#endif
    }
    SEAM(2);
    if (LO <= 3 && HI >= 3) REPEAT(3) {
        const Params p = ldp();
        for (int u = blockIdx.x; u < 256; u += nblk) { const int bh = u >> 2, pr = u & 3; attn_block(p, smc, bh, 7 - pr); attn_block(p, smc, bh, pr); }
    }
    SEAM(3);
    if (LO <= 4 && HI >= 4) gemm_phase(PhY{ldp()}, shm);
    SEAM(4);
    if (LO <= 5 && HI >= 5) {
        const Params p = ldp();
        for (int tb = blockIdx.x; tb < T_TOK / 128; tb += nblk) router_tile(p, smc, tb);
    }
    SEAM(5);
    if (LO <= 6 && HI >= 6) REPEAT(6) {
        const Params p = ldp(); PHASE_IDS;
        moe_tables(p, smc);
        const int* tot = (const int*)(smc + LDS_TOT); int* aid_tab = (int*)(smc + LDS_AID); const unsigned short* pre = (const unsigned short*)(smc + LDS_PRE);
        if (blockIdx.x == 0 && tid < NEXP) p.cnt[tid] = tot[tid];
        for (int u = blockIdx.x;; u += nblk) {
            int e, rt, ct, pr; if (!moe_unit(tot, u, 2, e, rt, ct, pr)) break;
            const int te = tot[e], nv = min(256, te - rt * 256);
            if (tid < 256) { const int g = rt * 256 + tid; int aid = 0;
                if (g < te) { int lo = 0, hi = 256;
#pragma unroll
                    for (int it = 0; it < 8; ++it) { const int mid = (lo + hi) >> 1; if ((int)pre[e * 256 + mid] <= g) lo = mid; else hi = mid; }
                    aid = p.listb[((size_t)lo * NEXP + e) * 256 + (g - (int)pre[e * 256 + lo])];
                    if (ct == 0) p.list[(size_t)e * LIST_CAP + g] = aid; }
                aid_tab[tid] = aid; }
            __syncthreads();
            Unit<EpiH> un; un.am = AMap{p.hbuf, DM, aid_tab, nv}; un.bt = p.WguT + ((size_t)e * 512 + ct * 256) * DM; un.K = DM; un.ep = EpiH{p.H, pr, ct * 256};
            gemm256(un, shm);
        }
    }
    SEAM(6);
    if (LO <= 7 && HI >= 7) REPEAT(7) gemm_phase(PhC{ldp()}, shm);
    SEAM(7);
    if (LO <= 8 && HI >= 8) REPEAT(8) { const Params p = ldp(); PHASE_IDS; for (int t = blockIdx.x * 8 + wid; t < T_TOK; t += nblk * 8) final_token(p, t, lane); }
    #undef SEAM
}
#ifndef MODE
#ifndef MODE
#define MODE 1
#endif
#endif
#ifndef FASTMASK
#define FASTMASK 0x1ff
#endif
static size_t carve(size_t& off, size_t bytes) { const size_t o = off; off += (bytes + 255) & ~(size_t)255; return o; }
#ifndef DUPMASK
#define DUPMASK 0
#endif
template <int PH> static void launch_fast(const Params& p, int grid, hipStream_t stream) { hipLaunchKernelGGL((mega<PH, PH>), dim3(grid), dim3(NTHR), LDS_BYTES, stream, p);
    if ((DUPMASK >> PH) & 1) hipLaunchKernelGGL((mega<PH, PH>), dim3(grid), dim3(NTHR), LDS_BYTES, stream, p); }
extern "C" void kernel_launch(void* const* d_in, const int* in_sizes, int n_in, void* d_out, int out_size, void* d_ws, size_t ws_size, hipStream_t stream) {
    Params p{};
    p.x = (const float*)d_in[0]; p.pos = (const int*)d_in[1]; p.ln0_g = (const float*)d_in[2]; p.ln0_b = (const float*)d_in[3]; p.w_in = (const float*)d_in[4];
    p.gm_g = (const float*)d_in[5]; p.gm_b = (const float*)d_in[6]; p.w_sp = (const float*)d_in[7]; p.b_sp = (const float*)d_in[8]; p.qn_g = (const float*)d_in[9];
    p.w_uq = (const float*)d_in[10]; p.kvn_g = (const float*)d_in[11]; p.w_ukv = (const float*)d_in[12]; p.w_out = (const float*)d_in[13]; p.ln1_g = (const float*)d_in[14];
    p.ln1_b = (const float*)d_in[15]; p.w_rg = (const float*)d_in[16]; p.b_rg = (const float*)d_in[17]; p.w_re = (const float*)d_in[18]; p.b_re = (const float*)d_in[19];
    p.w_gate = (const float*)d_in[20]; p.w_up = (const float*)d_in[21]; p.w_down = (const float*)d_in[22]; p.ln2_g = (const float*)d_in[23]; p.ln2_b = (const float*)d_in[24];
    p.out = (float*)d_out;
    char* ws = (char*)d_ws; size_t off = 0;
    p.bar = (unsigned*)(ws + carve(off, 16384));
    p.cnt = (int*)(ws + carve(off, 1024));
    p.WinT = (bf16_t*)(ws + carve(off, (size_t)ZN * 1024 * 2)); p.WuqT = (bf16_t*)(ws + carve(off, 768 * 384 * 2)); p.WukvT = (bf16_t*)(ws + carve(off, 1024 * 256 * 2));
    p.WoutT = (bf16_t*)(ws + carve(off, 1024 * 1024 * 2)); p.WguT = (bf16_t*)(ws + carve(off, (size_t)32 * 512 * 1024 * 2)); p.WdT = (bf16_t*)(ws + carve(off, (size_t)32 * 1024 * 256 * 2));
    p.hbuf = (bf16_t*)(ws + carve(off, (size_t)T_TOK * DM * 2)); p.rope = (float2*)(ws + carve(off, (size_t)T_TOK * 32 * 8));
    p.list = (int*)(ws + carve(off, (size_t)NEXP * LIST_CAP * 4)); p.gates = (float*)(ws + carve(off, (size_t)T_TOK * 2 * 4));
    p.WrT = (bf16_t*)(ws + carve(off, 2 * 36 * 1024 * 2)); p.cntb = (int*)(ws + carve(off, 256 * NEXP * 4)); p.listb = (int*)(ws + carve(off, (size_t)256 * NEXP * 256 * 4));
    p.rsq = (float*)(ws + carve(off, T_TOK * 4)); p.rskv = (float*)(ws + carve(off, T_TOK * 4));
    const size_t stage0 = off;
    p.zu = (bf16_t*)(ws + carve(off, (size_t)T_TOK * 512 * 2)); p.zv = (bf16_t*)(ws + carve(off, (size_t)T_TOK * 512 * 2));
    p.zq = (bf16_t*)(ws + carve(off, (size_t)T_TOK * 384 * 2)); p.zkv = (bf16_t*)(ws + carve(off, (size_t)T_TOK * 256 * 2)); p.krope = (bf16_t*)(ws + carve(off, (size_t)T_TOK * 64 * 2));
    p.Q = (bf16_t*)(ws + carve(off, (size_t)T_TOK * 768 * 2)); p.Kn = (bf16_t*)(ws + carve(off, (size_t)T_TOK * 512 * 2)); p.Vt = (bf16_t*)(ws + carve(off, (size_t)T_TOK * 512 * 2));
    p.mix = (bf16_t*)(ws + carve(off, (size_t)T_TOK * DM * 2));
    const size_t stage_end = off;
    size_t o2 = stage0; p.contrib = (bf16_t*)(ws + carve(o2, (size_t)T_TOK * 2 * DM * 2)); p.H = (bf16_t*)(ws + carve(o2, (size_t)(65536 + 8192) * FF * 2));
    if (o2 > stage_end || stage_end > ws_size) { fprintf(stderr, "kernel_launch: workspace too small (%zu needed, %zu given)\n", stage_end, ws_size); return; }

    static int grid = 0;
    if (!grid) {
        int dev = 0, cus = 0; (void)hipGetDevice(&dev); (void)hipDeviceGetAttribute(&cus, hipDeviceAttributeMultiprocessorCount, dev);
        grid = cus > 0 ? (cus / 8) * 8 : 256;
        (void)hipFuncSetAttribute((const void*)nk_gmlp, hipFuncAttributeMaxDynamicSharedMemorySize, 128 * 129 * 4);
        (void)hipFuncSetAttribute((const void*)nk_attn, hipFuncAttributeMaxDynamicSharedMemorySize, (64 * 192 + 64 * 193 + 64 * 65 + 64 * 128) * 4);
        (void)hipFuncSetAttribute((const void*)mega<0, 8>, hipFuncAttributeMaxDynamicSharedMemorySize, LDS_BYTES);
#if MODE == 2
        (void)hipFuncSetAttribute((const void*)mega<0, 0>, hipFuncAttributeMaxDynamicSharedMemorySize, LDS_BYTES);
        (void)hipFuncSetAttribute((const void*)mega<1, 1>, hipFuncAttributeMaxDynamicSharedMemorySize, LDS_BYTES);
        (void)hipFuncSetAttribute((const void*)mega<2, 2>, hipFuncAttributeMaxDynamicSharedMemorySize, LDS_BYTES);
        (void)hipFuncSetAttribute((const void*)mega<3, 3>, hipFuncAttributeMaxDynamicSharedMemorySize, LDS_BYTES);
        (void)hipFuncSetAttribute((const void*)mega<4, 4>, hipFuncAttributeMaxDynamicSharedMemorySize, LDS_BYTES);
        (void)hipFuncSetAttribute((const void*)mega<5, 5>, hipFuncAttributeMaxDynamicSharedMemorySize, LDS_BYTES);
        (void)hipFuncSetAttribute((const void*)mega<6, 6>, hipFuncAttributeMaxDynamicSharedMemorySize, LDS_BYTES);
        (void)hipFuncSetAttribute((const void*)mega<7, 7>, hipFuncAttributeMaxDynamicSharedMemorySize, LDS_BYTES);
        (void)hipFuncSetAttribute((const void*)mega<8, 8>, hipFuncAttributeMaxDynamicSharedMemorySize, LDS_BYTES);
#endif
    }
#if MODE == 1
    (void)hipMemsetAsync(p.bar, 0, XCD_BAR_WORDS * 4, stream);
    hipLaunchKernelGGL((mega<0, 8>), dim3(grid), dim3(NTHR), LDS_BYTES, stream, p);
#else
    const unsigned fm = (MODE == 2) ? (unsigned)(FASTMASK) : 0u;
    if (fm & 1) launch_fast<0>(p, grid, stream); else { nk_prep_w<<<J_TOTAL, 256, 0, stream>>>(p); nk_ln0<<<T_TOK / 4, 256, 0, stream>>>(p); nk_rope<<<T_TOK * 32 / 256, 256, 0, stream>>>(p); }
    if (fm & 2) launch_fast<1>(p, grid, stream); else nk_gemm<PhZ><<<dim3(PhZ::NU, 32), 256, 0, stream>>>(PhZ{p});
#if defined(P2VAR) && P2VAR == 1
    launch_fast<2>(p, grid, stream); nk_gmlp<<<T_TOK / 128 * 4, 256, 128 * 129 * 4, stream>>>(p);
#elif defined(P2VAR) && P2VAR == 2
    nk_rowscale<<<T_TOK / 4, 256, 0, stream>>>(p); nk_gemm<PhQ><<<dim3(PhQ::NU, 32), 256, 0, stream>>>(PhQ{p, p.rsq});
    nk_gemm<PhKV><<<dim3(PhKV::NU, 32), 256, 0, stream>>>(PhKV{p, p.rskv}); launch_fast<2>(p, grid, stream);
#else
    if (fm & 4) launch_fast<2>(p, grid, stream); else { nk_rowscale<<<T_TOK / 4, 256, 0, stream>>>(p); nk_gemm<PhQ><<<dim3(PhQ::NU, 32), 256, 0, stream>>>(PhQ{p, p.rsq});
        nk_gemm<PhKV><<<dim3(PhKV::NU, 32), 256, 0, stream>>>(PhKV{p, p.rskv}); nk_gmlp<<<T_TOK / 128 * 4, 256, 128 * 129 * 4, stream>>>(p); }
#endif
    if (fm & 8) launch_fast<3>(p, grid, stream); else nk_attn<<<64 * 32, 256, (64 * 192 + 64 * 193 + 64 * 65 + 64 * 128) * 4, stream>>>(p);
    if (fm & 16) launch_fast<4>(p, grid, stream); else nk_gemm<PhY><<<dim3(PhY::NU, 32), 256, 0, stream>>>(PhY{p});
    if (fm & 32) launch_fast<5>(p, grid, stream); else { nk_router_prep<<<144, 256, 0, stream>>>(p); nk_router<<<T_TOK / 4, 256, 0, stream>>>(p); }
    if (fm & 64) launch_fast<6>(p, grid, stream); else nk_gemm<PhH><<<dim3(PhH::NU, 32), 256, 0, stream>>>(PhH{p});
    if (fm & 128) launch_fast<7>(p, grid, stream); else nk_gemm<PhC><<<dim3(PhC::NU, 32), 256, 0, stream>>>(PhC{p});
    if (fm & 256) launch_fast<8>(p, grid, stream); else nk_final<<<T_TOK / 4, 256, 0, stream>>>(p);
#endif
}
```

```cpp
#include <hip/hip_runtime.h>
#define P2VAR 0
#define REPMASK 0x0
#define DUPMASK 0x0
#define TIMEPH -1
#define KREP 1
#define XPROBE 0
#define P0REP 0
#define WPROBE 0
#define ATTPROBE 0
#define JIT_LN0 0
#define MERGE67 1
#define GMLP_FUSED 1
#define ZLAYOUT2 1
#define KVCHAIN 0
#include <stdint.h>
#include <cstdio>

#define LAS __attribute__((address_space(3)))
typedef unsigned short bf16_t;
typedef short bf16x8 __attribute__((ext_vector_type(8)));
typedef float f32x4 __attribute__((ext_vector_type(4)));
typedef float f32x16 __attribute__((ext_vector_type(16)));
typedef unsigned u32x2 __attribute__((ext_vector_type(2)));
typedef unsigned u32x4 __attribute__((ext_vector_type(4)));

constexpr int T_TOK = 32768, DM = 1024, SEQ = 2048, NBATCH = 16;
constexpr int ZN = 1792;
constexpr int NEXP = 32, FF = 256;
constexpr int LIST_CAP = 32768;
constexpr float ALPHA = 1.189207115002721f;
constexpr float QSCALE = 0.07216878364870322f * 1.4426950408889634f;

struct Params {
    const float* x; const int* pos; const float *ln0_g, *ln0_b, *w_in, *gm_g, *gm_b, *w_sp, *b_sp, *qn_g, *w_uq, *kvn_g, *w_ukv, *w_out, *ln1_g, *ln1_b,
        *w_rg, *b_rg, *w_re, *b_re, *w_gate, *w_up, *w_down, *ln2_g, *ln2_b;
    float* out;
    bf16_t *WinT, *WuqT, *WukvT, *WoutT, *WguT, *WdT;
    bf16_t* hbuf; float2* rope;
    bf16_t *zu, *zv, *zq, *zkv, *krope, *Q, *Kn, *Vt, *mix;
    float *rsq, *rskv;
    int* cnt; int* list; float* gates; bf16_t* H; bf16_t* contrib;
    bf16_t* WrT; int* cntb; int* listb;
    unsigned* bar;
};

__device__ __forceinline__ unsigned pk2(float lo, float hi) { unsigned r; asm volatile("v_cvt_pk_bf16_f32 %0, %1, %2" : "=v"(r) : "v"(lo), "v"(hi)); return r; }
__device__ __forceinline__ bf16_t f2bf(float f) { return (bf16_t)(pk2(f, 0.f) & 0xffffu); }
__device__ __forceinline__ float bf2f(bf16_t h) { return __uint_as_float(((unsigned)h) << 16); }
__device__ __forceinline__ float bflo(unsigned u) { return __uint_as_float(u << 16); }
__device__ __forceinline__ float bfhi(unsigned u) { return __uint_as_float(u & 0xffff0000u); }
__device__ __forceinline__ void st4(bf16_t* p, f32x4 v) { u32x2 w; w.x = pk2(v[0], v[1]); w.y = pk2(v[2], v[3]); *(u32x2*)p = w; }
__device__ __forceinline__ void st4wt(bf16_t* p, f32x4 v) { const unsigned lo = pk2(v[0], v[1]), hi = pk2(v[2], v[3]);
    __hip_atomic_store((unsigned long long*)p, ((unsigned long long)hi << 32) | lo, __ATOMIC_RELAXED, __HIP_MEMORY_SCOPE_AGENT); }
__device__ __forceinline__ float shx(float v, int mask) { int l = threadIdx.x; asm volatile("" : "+v"(l)); const int idx = ((l ^ mask) & 63) << 2; return __int_as_float(__builtin_amdgcn_ds_bpermute(idx, __float_as_int(v))); }
__device__ __forceinline__ float wave_sum(float v) {
#pragma unroll
    for (int o = 1; o < 64; o <<= 1) v += shx(v, o);
    return v;
}
__device__ __forceinline__ float gelu_tanh(float x) {
    const float u = x + 0.044715f * x * x * x;
    const float e = __builtin_amdgcn_exp2f(-2.f * 0.7978845608028654f * 1.4426950408889634f * u);
    return x * __builtin_amdgcn_rcpf(1.f + e);
}
__device__ __forceinline__ float silu_f(float x) { return x * __builtin_amdgcn_rcpf(1.f + __builtin_amdgcn_exp2f(-1.4426950408889634f * x)); }
__device__ __forceinline__ int perm16(int k) { return 8 * ((k >> 2) & 1) + (k & 3) + 4 * (k >> 3); }

struct AMap {
    const bf16_t* base; int ld; const int* list; int nvalid;
    __device__ __forceinline__ const bf16_t* row(int r) const {
        if (list) { const int a = list[r < nvalid ? r : 0]; return base + (size_t)(a >> 1) * ld; }
        return base + (size_t)r * ld;
    }
};

struct EpiZ {
    bf16_t *zu, *zv, *zq, *zkv, *krope; const float2* rope; int row0, col0;
    __device__ __forceinline__ void rope_store(int row, int c, f32x4 v, float2 cs0, float2 cs1) const {
        const int i0 = (c - 1664) >> 1; bf16_t* kr = krope + (size_t)row * 64;
        kr[i0] = f2bf(v[0] * cs0.x - v[1] * cs0.y); kr[i0 + 32] = f2bf(v[1] * cs0.x + v[0] * cs0.y);
        kr[i0 + 1] = f2bf(v[2] * cs1.x - v[3] * cs1.y); kr[i0 + 33] = f2bf(v[3] * cs1.x + v[2] * cs1.y);
    }
    __device__ __forceinline__ void plain(int row, int c, f32x4 v) const {
        if (c < 1024) {
            f32x4 g; g[0] = gelu_tanh(v[0]); g[1] = gelu_tanh(v[1]); g[2] = gelu_tanh(v[2]); g[3] = gelu_tanh(v[3]);
            if (c < 512) st4(zu + (size_t)row * 512 + c, g); else st4(zv + (size_t)row * 512 + (c - 512), g);
        }
#if ZLAYOUT2
        else if (c < 1280) st4(zkv + (size_t)row * 256 + (c - 1024), v);
        else if (c < 1536) st4(zq + (size_t)row * 384 + (c - 1280), v);
        else if (c < 1664) st4(zq + (size_t)row * 384 + 256 + (c - 1536), v);
#else
        else if (c < 1408) st4(zq + (size_t)row * 384 + (c - 1024), v);
        else if (c < 1664) st4(zkv + (size_t)row * 256 + (c - 1408), v);
#endif
    }
    __device__ __forceinline__ void half(int row, int c, f32x4 v) const {
        if (c < 1664) plain(row, c, v);
        else if (c < 1728) { const int i0 = (c - 1664) >> 1; rope_store(row, c, v, rope[(size_t)row * 32 + i0], rope[(size_t)row * 32 + i0 + 1]); }
    }
    __device__ __forceinline__ void operator()(int r, int c32, int fq, f32x4 a, f32x4 b) const { const int row = row0 + r, c = col0 + c32 + 4 * fq; half(row, c, a); half(row, c + 16, b); }
    struct Ctx { float2 cs[4]; }; static constexpr int BATCH4 = 1;
    __device__ __forceinline__ bool is_rope(int c32) const { const int c = col0 + c32 + HALF_COLS; return c >= 1664 && c < 1728; }
    static constexpr int HALF_COLS = 128;
    __device__ __forceinline__ Ctx pre(int r, int c32, int fq) const { Ctx x;
        if (is_rope(c32)) { const int i0 = (col0 + c32 + 128 + 4 * fq - 1664) >> 1; const float2* rp = rope + (size_t)(row0 + r) * 32 + i0; x.cs[0] = rp[0]; x.cs[1] = rp[1]; x.cs[2] = rp[8]; x.cs[3] = rp[9]; }
        else { x.cs[0] = x.cs[1] = x.cs[2] = x.cs[3] = make_float2(0.f, 0.f); }
        return x; }
    __device__ __forceinline__ void post(int r, int c32, int fq, const Ctx& x, f32x4 a0, f32x4 b0, f32x4 a1, f32x4 b1) const {
        const int row = row0 + r, c = col0 + c32 + 4 * fq;
        plain(row, c, a0); plain(row, c + 16, b0);
        if (is_rope(c32)) { rope_store(row, c + 128, a1, x.cs[0], x.cs[1]); rope_store(row, c + 144, b1, x.cs[2], x.cs[3]); }
        else if (c + 128 < 1664) { plain(row, c + 128, a1); plain(row, c + 144, b1); }
    }
};
struct EpiQ {
    bf16_t* Q; const float* rs; int rs0; int row0, col0;
    __device__ __forceinline__ void half(int row, int c, f32x4 v, float sc) const {
        const int h = c / 192, d = c - h * 192, b = row >> 11, s = row & 2047;
        st4(Q + ((size_t)((b * 4 + h) * SEQ + s)) * 192 + d, v * sc);
    }
    __device__ __forceinline__ void operator()(int r, int c32, int fq, f32x4 a, f32x4 b) const {
        const int row = row0 + r, c = col0 + c32 + 4 * fq; const float sc = rs[row - rs0] * QSCALE; half(row, c, a, sc); half(row, c + 16, b, sc); }
    struct Ctx { float sc; };
    __device__ __forceinline__ Ctx pre(int r, int c32, int fq) const { Ctx x; x.sc = rs[row0 + r - rs0] * QSCALE; return x; }
    __device__ __forceinline__ void post(int r, int c32, int fq, const Ctx& x, f32x4 a0, f32x4 b0, f32x4 a1, f32x4 b1) const {
        const int row = row0 + r, c = col0 + c32 + 4 * fq; half(row, c, a0, x.sc); half(row, c + 16, b0, x.sc); half(row, c + 128, a1, x.sc); half(row, c + 144, b1, x.sc); }
};
struct EpiKV {
    bf16_t *Kn, *Vt; const float* rs; int rs0; int row0, col0;
    __device__ __forceinline__ void half(int row, int c, f32x4 v, float sc) const {
        const int h = c >> 8, e = c & 255, b = row >> 11, s = row & 2047;
        v = v * sc;
        if (e < 128) st4(Kn + ((size_t)((b * 4 + h) * SEQ + s)) * 128 + e, v);
        else {
            bf16_t* vt = Vt + ((size_t)((b * 4 + h) * 128 + (e - 128))) * SEQ + (s & ~15) + perm16(s & 15);
            vt[0] = f2bf(v[0]); vt[SEQ] = f2bf(v[1]); vt[2 * SEQ] = f2bf(v[2]); vt[3 * SEQ] = f2bf(v[3]);
        }
    }
    __device__ __forceinline__ void operator()(int r, int c32, int fq, f32x4 a, f32x4 b) const {
        const int row = row0 + r, c = col0 + c32 + 4 * fq; const float sc = rs[row - rs0]; half(row, c, a, sc); half(row, c + 16, b, sc); }
    struct Ctx { float sc; };
    __device__ __forceinline__ Ctx pre(int r, int c32, int fq) const { Ctx x; x.sc = rs[row0 + r - rs0]; return x; }
    __device__ __forceinline__ void post(int r, int c32, int fq, const Ctx& x, f32x4 a0, f32x4 b0, f32x4 a1, f32x4 b1) const {
        const int row = row0 + r, c = col0 + c32 + 4 * fq; half(row, c, a0, x.sc); half(row, c + 16, b0, x.sc); half(row, c + 128, a1, x.sc); half(row, c + 144, b1, x.sc); }
};
struct EpiY {
    bf16_t* hb; int row0, col0;
    __device__ __forceinline__ void fin(bf16_t* p, u32x2 h, f32x4 v) const {
        v[0] += ALPHA * bflo(h.x); v[1] += ALPHA * bfhi(h.x); v[2] += ALPHA * bflo(h.y); v[3] += ALPHA * bfhi(h.y); st4(p, v); }
    __device__ __forceinline__ void half(int row, int c, f32x4 v) const { bf16_t* p = hb + (size_t)row * DM + c; fin(p, *(const u32x2*)p, v); }
    __device__ __forceinline__ void operator()(int r, int c32, int fq, f32x4 a, f32x4 b) const { const int row = row0 + r, c = col0 + c32 + 4 * fq; half(row, c, a); half(row, c + 16, b); }
    struct Ctx { u32x2 h[4]; };
    __device__ __forceinline__ Ctx pre(int r, int c32, int fq) const { Ctx x; const bf16_t* p = hb + (size_t)(row0 + r) * DM + col0 + c32 + 4 * fq;
        x.h[0] = *(const u32x2*)p; x.h[1] = *(const u32x2*)(p + 16); x.h[2] = *(const u32x2*)(p + 128); x.h[3] = *(const u32x2*)(p + 144); return x; }
    __device__ __forceinline__ void post(int r, int c32, int fq, const Ctx& x, f32x4 a0, f32x4 b0, f32x4 a1, f32x4 b1) const {
        bf16_t* p = hb + (size_t)(row0 + r) * DM + col0 + c32 + 4 * fq; fin(p, x.h[0], a0); fin(p + 16, x.h[1], b0); fin(p + 128, x.h[2], a1); fin(p + 144, x.h[3], b1); }
};
struct EpiH {
    bf16_t* H; int hrow0, col0; bool wt;
    __device__ __forceinline__ void operator()(int r, int c32, int fq, f32x4 a, f32x4 b) const {
        const int hid = ((col0 + c32) >> 5) * 16 + 4 * fq;
        f32x4 o; o[0] = silu_f(a[0]) * b[0]; o[1] = silu_f(a[1]) * b[1]; o[2] = silu_f(a[2]) * b[2]; o[3] = silu_f(a[3]) * b[3];
        if (wt) st4wt(H + (size_t)(hrow0 + r) * FF + hid, o); else st4(H + (size_t)(hrow0 + r) * FF + hid, o);
    }
    struct Ctx { int dummy; };
    __device__ __forceinline__ Ctx pre(int, int, int) const { Ctx x; x.dummy = 0; return x; }
    __device__ __forceinline__ void post(int r, int c32, int fq, const Ctx&, f32x4 a0, f32x4 b0, f32x4 a1, f32x4 b1) const { (*this)(r, c32, fq, a0, b0); (*this)(r, c32 + 128, fq, a1, b1); }
};
struct EpiC {
    bf16_t* contrib; const int* list; const float* gates; int nvalid; int col0;
    __device__ __forceinline__ void operator()(int r, int c32, int fq, f32x4 a, f32x4 b) const {
        if (r >= nvalid) return;
        const int aid = list[r]; const float g = gates[aid];
        char* p = (char*)contrib + ((unsigned)aid * (unsigned)(DM * 2) + (unsigned)((col0 + c32 + 4 * fq) * 2));
        u32x2 w; w.x = pk2(a[0] * g, a[1] * g); w.y = pk2(a[2] * g, a[3] * g); *(u32x2*)p = w;
        w.x = pk2(b[0] * g, b[1] * g); w.y = pk2(b[2] * g, b[3] * g); *(u32x2*)(p + 32) = w;
    }
    struct Ctx { int aid; float g; };
    __device__ __forceinline__ Ctx pre(int r, int, int) const { Ctx x; x.aid = r < nvalid ? list[r] : -1; x.g = 0.f; return x; }
    __device__ __forceinline__ void pre2(Ctx& x) const { if (x.aid >= 0) x.g = gates[x.aid]; }
    __device__ __forceinline__ void post(int r, int c32, int fq, const Ctx& x, f32x4 a0, f32x4 b0, f32x4 a1, f32x4 b1) const {
        if (x.aid < 0) return;
        const float g = x.g;
        char* p = (char*)contrib + ((unsigned)x.aid * (unsigned)(DM * 2) + (unsigned)((col0 + c32 + 4 * fq) * 2));
        u32x2 w; w.x = pk2(a0[0] * g, a0[1] * g); w.y = pk2(a0[2] * g, a0[3] * g); *(u32x2*)p = w;
        w.x = pk2(b0[0] * g, b0[1] * g); w.y = pk2(b0[2] * g, b0[3] * g); *(u32x2*)(p + 32) = w;
        w.x = pk2(a1[0] * g, a1[1] * g); w.y = pk2(a1[2] * g, a1[3] * g); *(u32x2*)(p + 256) = w;
        w.x = pk2(b1[0] * g, b1[1] * g); w.y = pk2(b1[2] * g, b1[3] * g); *(u32x2*)(p + 288) = w;
    }
};

template <class EP> struct Unit { AMap am; const bf16_t* bt; int K; EP ep; };

__device__ __forceinline__ bool moe_unit(const int* cnt, int u, int ncol, int& e, int& rt, int& ct, int& padrow) {
    int acc = 0, fe = -1, facc = 0;
#pragma unroll 4
    for (int i = 0; i < NEXP; ++i) {
        const int t = (cnt[i] + 255) >> 8;
        if (fe < 0 && u < (acc + t) * ncol) { fe = i; facc = acc; }
        acc += t;
    }
    fe = __builtin_amdgcn_readfirstlane(fe); facc = __builtin_amdgcn_readfirstlane(facc);
    if (fe < 0) return false;
    const int w = u - facc * ncol; e = fe; rt = w / ncol; ct = w - rt * ncol; padrow = (facc + rt) * 256;
    return true;
}

struct PhZ { Params p; typedef EpiZ EP; static constexpr int NU = 128 * 7;
    __device__ __forceinline__ bool unit(int u, Unit<EP>& o) const { const int pm = u / 7, pn = u - pm * 7;
        o.am = AMap{p.hbuf + (size_t)pm * 256 * DM, DM, nullptr, 256}; o.bt = p.WinT + (size_t)pn * 256 * DM; o.K = DM;
        o.ep = EpiZ{p.zu, p.zv, p.zq, p.zkv, p.krope, p.rope, pm * 256, pn * 256}; return true; } };
struct PhQ { Params p; const float* rs; typedef EpiQ EP; static constexpr int NU = 128 * 3;
    __device__ __forceinline__ bool unit(int u, Unit<EP>& o) const { const int pm = u / 3, pn = u - pm * 3;
        o.am = AMap{p.zq + (size_t)pm * 256 * 384, 384, nullptr, 256}; o.bt = p.WuqT + (size_t)pn * 256 * 384; o.K = 384;
        o.ep = EpiQ{p.Q, rs, 0, pm * 256, pn * 256}; return true; } };
struct PhKV { Params p; const float* rs; typedef EpiKV EP; static constexpr int NU = 128 * 4;
    __device__ __forceinline__ bool unit(int u, Unit<EP>& o) const { const int pm = u >> 2, pn = u & 3;
        o.am = AMap{p.zkv + (size_t)pm * 256 * 256, 256, nullptr, 256}; o.bt = p.WukvT + (size_t)pn * 256 * 256; o.K = 256;
        o.ep = EpiKV{p.Kn, p.Vt, rs, 0, pm * 256, pn * 256}; return true; } };
struct PhY { Params p; typedef EpiY EP; static constexpr int NU = 128 * 4;
    __device__ __forceinline__ bool unit(int u, Unit<EP>& o) const { const int pm = u >> 2, pn = u & 3;
        o.am = AMap{p.mix + (size_t)pm * 256 * DM, DM, nullptr, 256}; o.bt = p.WoutT + (size_t)pn * 256 * DM; o.K = DM;
        o.ep = EpiY{p.hbuf, pm * 256, pn * 256}; return true; } };
struct PhH { Params p; typedef EpiH EP; static constexpr int NU = 288 * 2;
    __device__ __forceinline__ bool unit(int u, Unit<EP>& o) const { int e, rt, ct, pr; if (!moe_unit(p.cnt, u, 2, e, rt, ct, pr)) return false;
        const int nv = __builtin_amdgcn_readfirstlane(min(256, p.cnt[e] - rt * 256));
        o.am = AMap{p.hbuf, DM, p.list + (size_t)e * LIST_CAP + rt * 256, nv}; o.bt = p.WguT + ((size_t)e * 512 + ct * 256) * DM; o.K = DM;
        o.ep = EpiH{p.H, pr, ct * 256, false}; return true; } };
struct PhC { Params p; typedef EpiC EP; static constexpr int NU = 288 * 4;
    __device__ __forceinline__ bool unit(int u, Unit<EP>& o) const { int e, rt, ct, pr; if (!moe_unit(p.cnt, u, 4, e, rt, ct, pr)) return false;
        const int nv = __builtin_amdgcn_readfirstlane(min(256, p.cnt[e] - rt * 256));
        o.am = AMap{p.H + (size_t)pr * FF, FF, nullptr, 256}; o.bt = p.WdT + ((size_t)e * DM + ct * 256) * FF; o.K = FF;
        o.ep = EpiC{p.contrib, p.list + (size_t)e * LIST_CAP + rt * 256, p.gates, nv, ct * 256}; return true; } };


template <int XMODE> struct EpiProbe {
    const bf16_t* hb; bf16_t* ob; int row0, col0;
    __device__ __forceinline__ void operator()(int, int, int, f32x4, f32x4) const {}
    struct Ctx { u32x2 h[4]; };
    __device__ __forceinline__ Ctx pre(int r, int c32, int fq) const { Ctx x; const bf16_t* p = hb + (size_t)(row0 + r) * DM + col0 + c32 + 4 * fq;
        if (XMODE == 1) { x.h[0] = *(const u32x2*)p; x.h[1] = *(const u32x2*)(p + 16); x.h[2] = *(const u32x2*)(p + 128); x.h[3] = *(const u32x2*)(p + 144); }
        else { x.h[0] = x.h[1] = x.h[2] = x.h[3] = (u32x2){0u, 0u}; }
        return x; }
    __device__ __forceinline__ void fin(bf16_t* p, u32x2 h, f32x4 v) const {
        v[0] += ALPHA * bflo(h.x); v[1] += ALPHA * bfhi(h.x); v[2] += ALPHA * bflo(h.y); v[3] += ALPHA * bfhi(h.y); st4(p, v); }
    __device__ __forceinline__ void post(int r, int c32, int fq, const Ctx& x, f32x4 a0, f32x4 b0, f32x4 a1, f32x4 b1) const {
        if (XMODE == 2) { asm volatile("" :: "v"(a0), "v"(b0), "v"(a1), "v"(b1)); return; }
        if (XMODE == 4) {
            bf16_t* q = ob + (size_t)(row0 + r) * DM + col0 + (c32 >> 5) * 64 + 16 * fq; u32x4 w0, w1;
            w0.x = pk2(a0[0], a0[1]); w0.y = pk2(a0[2], a0[3]); w0.z = pk2(b0[0], b0[1]); w0.w = pk2(b0[2], b0[3]);
            w1.x = pk2(a1[0], a1[1]); w1.y = pk2(a1[2], a1[3]); w1.z = pk2(b1[0], b1[1]); w1.w = pk2(b1[2], b1[3]);
            *(u32x4*)q = w0; *(u32x4*)(q + 8) = w1; return; }
        bf16_t* p = ob + (size_t)(row0 + r) * DM + col0 + c32 + 4 * fq; fin(p, x.h[0], a0); fin(p + 16, x.h[1], b0); fin(p + 128, x.h[2], a1); fin(p + 144, x.h[3], b1); }
};
template <int XMODE> struct PhYp { Params p; typedef EpiProbe<XMODE> EP; static constexpr int NU = 128 * 4;
    __device__ __forceinline__ bool unit(int u, Unit<EP>& o) const { const int pm = u >> 2, pn = u & 3;
        o.am = AMap{p.mix + (size_t)pm * 256 * DM, DM, nullptr, 256}; o.bt = p.WoutT + (size_t)pn * 256 * DM; o.K = DM;
        o.ep = EP{p.hbuf, p.contrib, pm * 256, pn * 256}; return true; } };

__device__ __forceinline__ void wtile(const float* s0, const float* s1, int ldsrc, bf16_t* dst, int K, int k0, int n0, int mode, const float* kscale, float* tile, int tid, int nthr) {
    for (int idx = tid; idx < 4096; idx += nthr) {
        const int kk = idx >> 6, n = n0 + (idx & 63);
        const float* s = s0; int col = n;
        if (mode == 1) { if (n >= 1728) col = -1; else if (n >= 1664) { const int i = (n - 1664) >> 1, pp = (n - 1664) & 1; col = 1664 + i + 32 * pp; } }
        else if (mode == 2) { const int h = n / 192, d = n - h * 192; if (d >= 128) { const int i = (d - 128) >> 1, pp = (d - 128) & 1; col = h * 192 + 128 + i + 32 * pp; } }
        else if (mode == 3) { const int G = n >> 5, r = n & 31; col = 16 * G + (r & 15); s = (r < 16) ? s0 : s1; }
        float v = 0.f;
        if (col >= 0) { v = s[(size_t)(k0 + kk) * ldsrc + col]; if (kscale) v *= kscale[k0 + kk]; }
        tile[kk * 65 + (idx & 63)] = v;
    }
    __syncthreads();
    for (int idx = tid; idx < 4096; idx += nthr) {
        const int nn = idx >> 6, kk = idx & 63;
        dst[(size_t)(n0 + nn) * K + k0 + kk] = f2bf(tile[kk * 65 + nn]);
    }
    __syncthreads();
}
constexpr int J_IN = 28 * 16, J_UQ = 12 * 6, J_UKV = 16 * 4, J_OUT = 16 * 16, J_GU = 32 * 8 * 16, J_DN = 32 * 16 * 4;
constexpr int J_TOTAL = J_IN + J_UQ + J_UKV + J_OUT + J_GU + J_DN;
__device__ __forceinline__ void prep_wjob(const Params& p, int job, float* tile, int tid, int nthr) {
    if (job < J_IN) { const int nb = job >> 4, kb = job & 15; wtile(p.w_in, nullptr, 1728, p.WinT, 1024, kb * 64, nb * 64, 1, nullptr, tile, tid, nthr); return; } job -= J_IN;
    if (job < J_UQ) { const int nb = job / 6, kb = job - nb * 6; wtile(p.w_uq, nullptr, 768, p.WuqT, 384, kb * 64, nb * 64, 0, p.qn_g, tile, tid, nthr); return; } job -= J_UQ;
    if (job < J_UKV) { const int nb = job >> 2, kb = job & 3; wtile(p.w_ukv, nullptr, 1024, p.WukvT, 256, kb * 64, nb * 64, 0, p.kvn_g, tile, tid, nthr); return; } job -= J_UKV;
    if (job < J_OUT) { const int nb = job >> 4, kb = job & 15; wtile(p.w_out, nullptr, 1024, p.WoutT, 1024, kb * 64, nb * 64, 0, nullptr, tile, tid, nthr); return; } job -= J_OUT;
    if (job < J_GU) { const int e = job >> 7, r = job & 127, nb = r >> 4, kb = r & 15;
        wtile(p.w_gate + (size_t)e * 1024 * 256, p.w_up + (size_t)e * 1024 * 256, 256, p.WguT + (size_t)e * 512 * 1024, 1024, kb * 64, nb * 64, 3, nullptr, tile, tid, nthr); return; } job -= J_GU;
    { const int e = job >> 6, r = job & 63, nb = r >> 2, kb = r & 3;
        wtile(p.w_down + (size_t)e * 256 * 1024, nullptr, 1024, p.WdT + (size_t)e * 1024 * 256, 256, kb * 64, nb * 64, 0, nullptr, tile, tid, nthr); }
}
__device__ __forceinline__ void ln0_row(const float* xr, const float* g, const float* b, bf16_t* orow, int lane) {
    f32x4 v[4]; float s = 0.f;
#pragma unroll
    for (int j = 0; j < 4; ++j) { v[j] = *(const f32x4*)(xr + 256 * j + 4 * lane); s += (v[j][0] + v[j][1]) + (v[j][2] + v[j][3]); }
    const float mean = wave_sum(s) * (1.f / 1024.f); float s2 = 0.f;
#pragma unroll
    for (int j = 0; j < 4; ++j) { v[j] = v[j] - mean; s2 += (v[j][0] * v[j][0] + v[j][1] * v[j][1]) + (v[j][2] * v[j][2] + v[j][3] * v[j][3]); }
    const float rstd = 1.f / sqrtf(wave_sum(s2) * (1.f / 1024.f) + 1e-5f);
#pragma unroll
    for (int j = 0; j < 4; ++j) { const f32x4 gg = *(const f32x4*)(g + 256 * j + 4 * lane), bb = *(const f32x4*)(b + 256 * j + 4 * lane);
        st4(orow + 256 * j + 4 * lane, v[j] * rstd * gg + bb); }
}
__device__ __forceinline__ void rope_entry(const Params& p, int idx) {
    const int t = idx >> 5, i = idx & 31;
    const float inv = powf(10000.f, -(float)(2 * i) / 64.f);
    const float ang = (float)p.pos[t] * inv;
    p.rope[idx] = make_float2(cosf(ang), sinf(ang));
}

__device__ __forceinline__ void router_token(const Params& p, int t, int lane, const float* wr  , int wstride) {
    bf16_t* hr = p.hbuf + (size_t)t * DM;
    f32x4 v[4]; float s = 0.f;
#pragma unroll
    for (int j = 0; j < 4; ++j) { const u32x2 w = *(const u32x2*)(hr + 256 * j + 4 * lane); v[j][0] = bflo(w.x); v[j][1] = bfhi(w.x); v[j][2] = bflo(w.y); v[j][3] = bfhi(w.y);
        s += (v[j][0] + v[j][1]) + (v[j][2] + v[j][3]); }
    const float mean = wave_sum(s) * (1.f / 1024.f); float s2 = 0.f;
#pragma unroll
    for (int j = 0; j < 4; ++j) { v[j] = v[j] - mean; s2 += (v[j][0] * v[j][0] + v[j][1] * v[j][1]) + (v[j][2] * v[j][2] + v[j][3] * v[j][3]); }
    const float rstd = 1.f / sqrtf(wave_sum(s2) * (1.f / 1024.f) + 1e-5f);
#pragma unroll
    for (int j = 0; j < 4; ++j) { const f32x4 gg = *(const f32x4*)(p.ln1_g + 256 * j + 4 * lane), bb = *(const f32x4*)(p.ln1_b + 256 * j + 4 * lane);
        v[j] = v[j] * rstd * gg + bb; st4(hr + 256 * j + 4 * lane, v[j]); }
    float lg[36];
#pragma unroll
    for (int o = 0; o < 36; ++o) { float a = 0.f;
#pragma unroll
        for (int j = 0; j < 4; ++j) { const f32x4 w = *(const f32x4*)(wr + o * wstride + 256 * j + 4 * lane); a += (v[j][0] * w[0] + v[j][1] * w[1]) + (v[j][2] * w[2] + v[j][3] * w[3]); }
        lg[o] = wave_sum(a); }
#pragma unroll
    for (int o = 0; o < 4; ++o) lg[o] += p.b_rg[o];
#pragma unroll
    for (int o = 0; o < 32; ++o) lg[4 + o] += p.b_re[o];
    int g = 0; float gm = lg[0];
#pragma unroll
    for (int i = 1; i < 4; ++i) if (lg[i] > gm) { gm = lg[i]; g = i; }
    float se = 0.f;
#pragma unroll
    for (int i = 0; i < 4; ++i) se += expf(lg[i] - gm);
    const float pg = 1.f / se;
    float ev[8];
#pragma unroll
    for (int e = 0; e < 8; ++e) ev[e] = g == 0 ? lg[4 + e] : g == 1 ? lg[12 + e] : g == 2 ? lg[20 + e] : lg[28 + e];
    int i1 = 0; float v1 = ev[0];
#pragma unroll
    for (int e = 1; e < 8; ++e) if (ev[e] > v1) { v1 = ev[e]; i1 = e; }
    int i2 = -1; float v2 = -3.0e38f;
#pragma unroll
    for (int e = 0; e < 8; ++e) if (e != i1 && ev[e] > v2) { v2 = ev[e]; i2 = e; }
    const float d = expf(v2 - v1), g1 = pg / (1.f + d), g2 = pg * d / (1.f + d);
    if (lane < 2) {
        const int ex = g * 8 + (lane == 0 ? i1 : i2), aid = 2 * t + lane;
        const int slot = atomicAdd(p.cnt + ex, 1);
        p.list[(size_t)ex * LIST_CAP + slot] = aid;
        p.gates[aid] = lane == 0 ? g1 : g2;
    }
}
__device__ __forceinline__ void final_token(const Params& p, int t, int lane) {
    const bf16_t* hr = p.hbuf + (size_t)t * DM; const bf16_t* c0 = p.contrib + (size_t)(2 * t) * DM; const bf16_t* c1 = c0 + DM;
    f32x4 v[4]; float s = 0.f;
#pragma unroll
    for (int j = 0; j < 4; ++j) { const int o = 256 * j + 4 * lane; const u32x2 w = *(const u32x2*)(hr + o), a = *(const u32x2*)(c0 + o), b = *(const u32x2*)(c1 + o);
        v[j][0] = ALPHA * bflo(w.x) + bflo(a.x) + bflo(b.x); v[j][1] = ALPHA * bfhi(w.x) + bfhi(a.x) + bfhi(b.x);
        v[j][2] = ALPHA * bflo(w.y) + bflo(a.y) + bflo(b.y); v[j][3] = ALPHA * bfhi(w.y) + bfhi(a.y) + bfhi(b.y);
        s += (v[j][0] + v[j][1]) + (v[j][2] + v[j][3]); }
    const float mean = wave_sum(s) * (1.f / 1024.f); float s2 = 0.f;
#pragma unroll
    for (int j = 0; j < 4; ++j) { v[j] = v[j] - mean; s2 += (v[j][0] * v[j][0] + v[j][1] * v[j][1]) + (v[j][2] * v[j][2] + v[j][3] * v[j][3]); }
    const float rstd = 1.f / sqrtf(wave_sum(s2) * (1.f / 1024.f) + 1e-5f);
#pragma unroll
    for (int j = 0; j < 4; ++j) { const int o = 256 * j + 4 * lane; const f32x4 gg = *(const f32x4*)(p.ln2_g + o), bb = *(const f32x4*)(p.ln2_b + o);
        *(f32x4*)(p.out + (size_t)t * DM + o) = v[j] * rstd * gg + bb; }
}

__global__ __launch_bounds__(256) void nk_prep_w(Params p) { __shared__ float tile[64 * 65]; prep_wjob(p, blockIdx.x, tile, threadIdx.x, 256); }
__global__ __launch_bounds__(256) void nk_ln0(Params p) { const int t = blockIdx.x * 4 + (threadIdx.x >> 6); ln0_row(p.x + (size_t)t * DM, p.ln0_g, p.ln0_b, p.hbuf + (size_t)t * DM, threadIdx.x & 63); }
__global__ __launch_bounds__(256) void nk_rope(Params p) { rope_entry(p, blockIdx.x * 256 + threadIdx.x); if (blockIdx.x == 0 && threadIdx.x < NEXP) p.cnt[threadIdx.x] = 0; }
__global__ __launch_bounds__(256) void nk_rowscale(Params p) {
    const int t = blockIdx.x * 4 + (threadIdx.x >> 6), lane = threadIdx.x & 63;
    float s = 0.f; for (int i = lane; i < 384; i += 64) { const float v = bf2f(p.zq[(size_t)t * 384 + i]); s += v * v; }
    s = wave_sum(s); float s2 = 0.f; for (int i = lane; i < 256; i += 64) { const float v = bf2f(p.zkv[(size_t)t * 256 + i]); s2 += v * v; }
    s2 = wave_sum(s2);
    if (lane == 0) { p.rsq[t] = 1.f / sqrtf(s * (1.f / 384.f) + 1e-6f); p.rskv[t] = 1.f / sqrtf(s2 * (1.f / 256.f) + 1e-6f); }
}
template <class PH> __global__ __launch_bounds__(256) void nk_gemm(PH ph) {
    Unit<typename PH::EP> u; if (!ph.unit(blockIdx.x, u)) return;
    const int wave = threadIdx.x >> 6, lane = threadIdx.x & 63, fr = lane & 15, fq = lane >> 4;
    const int task = blockIdx.y * 4 + wave, rb = task >> 3, cg = task & 7;
    const bf16_t* arow = u.am.row(rb * 16 + fr);
    const bf16_t* b0 = u.bt + (size_t)(cg * 32 + fr) * u.K; const bf16_t* b1 = b0 + (size_t)16 * u.K;
    f32x4 acc0 = {0.f, 0.f, 0.f, 0.f}, acc1 = {0.f, 0.f, 0.f, 0.f};
    for (int k = 0; k < u.K; k += 32) {
        const bf16x8 a = *(const bf16x8*)(arow + k + 8 * fq), x0 = *(const bf16x8*)(b0 + k + 8 * fq), x1 = *(const bf16x8*)(b1 + k + 8 * fq);
        acc0 = __builtin_amdgcn_mfma_f32_16x16x32_bf16(x0, a, acc0, 0, 0, 0);
        acc1 = __builtin_amdgcn_mfma_f32_16x16x32_bf16(x1, a, acc1, 0, 0, 0);
    }
    u.ep(rb * 16 + fr, cg * 32, fq, acc0, acc1);
}
__global__ __launch_bounds__(256) void nk_gmlp(Params p) {
    extern __shared__ float sm[];
    const int unit = blockIdx.x, h = unit & 3, bn = unit >> 2, row0 = bn * 128;
    const int wave = threadIdx.x >> 6, lane = threadIdx.x & 63;
    for (int j = wave; j < 128; j += 4) {
        const bf16_t* vr = p.zv + (size_t)(row0 + j) * 512 + h * 128;
        const float a = bf2f(vr[lane]), b = bf2f(vr[lane + 64]);
        const float mean = wave_sum(a + b) * (1.f / 128.f); const float da = a - mean, db = b - mean;
        const float rstd = 1.f / sqrtf(wave_sum(da * da + db * db) * (1.f / 128.f) + 1e-5f);
        sm[j * 129 + lane] = da * rstd * p.gm_g[h * 128 + lane] + p.gm_b[h * 128 + lane];
        sm[j * 129 + lane + 64] = db * rstd * p.gm_g[h * 128 + lane + 64] + p.gm_b[h * 128 + lane + 64];
    }
    __syncthreads();
    for (int idx = threadIdx.x; idx < 16384; idx += 256) {
        const int i = idx >> 7, c = idx & 127; const int jn = i < 64 ? 64 : 128;
        const float* w = p.w_sp + ((size_t)h * 128 + i) * 128; float f = p.b_sp[h * 128 + i];
        for (int j = 0; j < jn; ++j) f += w[j] * sm[j * 129 + c];
        const float u = bf2f(p.zu[(size_t)(row0 + i) * 512 + h * 128 + c]);
        p.mix[(size_t)(row0 + i) * DM + h * 128 + c] = f2bf(u * f);
    }
}
__global__ __launch_bounds__(256) void nk_attn(Params p) {
    extern __shared__ float sm[];
    float* Qs = sm; float* Ks = Qs + 64 * 192; float* Ss = Ks + 64 * 193; float* Vs = Ss + 64 * 65;
    const int qc = blockIdx.x & 31, bh = blockIdx.x >> 5, b = bh >> 2, h = bh & 3, tid = threadIdx.x, q = tid >> 2, sub = tid & 3;
    for (int idx = tid; idx < 64 * 192; idx += 256) { const int r = idx / 192, d = idx - r * 192; Qs[idx] = bf2f(p.Q[((size_t)bh * SEQ + qc * 64 + r) * 192 + d]); }
    __syncthreads();
    for (int idx = tid; idx < 64 * 32; idx += 256) { const int r = idx >> 5, i = idx & 31; const float2 cs = p.rope[((size_t)b * SEQ + qc * 64 + r) * 32 + i];
        const float x1 = Qs[r * 192 + 128 + i], x2 = Qs[r * 192 + 160 + i]; Qs[r * 192 + 128 + i] = x1 * cs.x - x2 * cs.y; Qs[r * 192 + 160 + i] = x2 * cs.x + x1 * cs.y; }
    float O[32]; float m = -INFINITY, l = 0.f;
#pragma unroll
    for (int j = 0; j < 32; ++j) O[j] = 0.f;
    for (int kt = 0; kt <= qc; ++kt) {
        __syncthreads();
        for (int idx = tid; idx < 64 * 192; idx += 256) { const int r = idx / 192, d = idx - r * 192; const int key = kt * 64 + r;
            Ks[r * 193 + d] = d < 128 ? bf2f(p.Kn[((size_t)bh * SEQ + key) * 128 + d]) : bf2f(p.krope[((size_t)b * SEQ + key) * 64 + d - 128]); }
        for (int idx = tid; idx < 64 * 128; idx += 256) { const int r = idx >> 7, dv = idx & 127; const int key = kt * 64 + r;
            Vs[r * 128 + dv] = bf2f(p.Vt[((size_t)bh * 128 + dv) * SEQ + (key & ~15) + perm16(key & 15)]); }
        __syncthreads();
        for (int kk = 0; kk < 16; ++kk) { const int key = sub * 16 + kk; float s = 0.f;
            for (int d = 0; d < 192; ++d) s += Qs[q * 192 + d] * Ks[key * 193 + d];
            Ss[q * 65 + key] = s; }
        __syncthreads();
        float mt = -INFINITY; for (int k = 0; k < 64; ++k) mt = fmaxf(mt, Ss[q * 65 + k]);
        const float mn = fmaxf(m, mt), alpha = exp2f(m - mn); m = mn; l *= alpha;
#pragma unroll
        for (int j = 0; j < 32; ++j) O[j] *= alpha;
        for (int k = 0; k < 64; ++k) { const float pk = exp2f(Ss[q * 65 + k] - mn); l += pk;
#pragma unroll
            for (int j = 0; j < 32; ++j) O[j] += pk * Vs[k * 128 + sub * 32 + j]; }
    }
    const float inv = 1.f / l; bf16_t* o = p.mix + ((size_t)b * SEQ + qc * 64 + q) * DM + 512 + h * 128 + sub * 32;
#pragma unroll
    for (int j = 0; j < 32; ++j) o[j] = f2bf(O[j] * inv);
}
__global__ __launch_bounds__(256) void nk_router(Params p) {
    const int t = blockIdx.x * 4 + (threadIdx.x >> 6);
    router_token(p, t, threadIdx.x & 63, (const float*)p.H, 1024);
}
__global__ __launch_bounds__(256) void nk_router_prep(Params p) {
    const int idx = blockIdx.x * 256 + threadIdx.x; if (idx >= 36 * 1024) return;
    const int o = idx >> 10, k = idx & 1023;
    ((float*)p.H)[idx] = o < 4 ? p.w_rg[k * 4 + o] : p.w_re[k * 32 + (o - 4)];
}
__global__ __launch_bounds__(256) void nk_final(Params p) { final_token(p, blockIdx.x * 4 + (threadIdx.x >> 6), threadIdx.x & 63); }

constexpr int LDS_BYTES = 152 * 1024, LDS_RS = 150 * 1024, LDS_XB = 151 * 1024;
constexpr int LDS_PRE = 128 * 1024, LDS_TOT = 144 * 1024, LDS_SEG = LDS_TOT + 256, LDS_AID = LDS_SEG + 2048;
constexpr int LDS_RW = 0, LDS_LCNT = 144 * 1024 + 512;
constexpr int NTHR = 512;

#define XB_TMO      128
#define XB_XCNT(j)  (256  + 64 * (j))
#define XB_XSUB(j)  (1280 + 64 * (j))
#define XB_XGEN(j)  (2304 + 64 * (j))
#define XB_TOP      3328
#define XB_TOPGEN   3392
#define XCD_BAR_WORDS 3456
#define XB_SPIN_CAP (1u << 20)
__device__ __forceinline__ unsigned xb_ld(unsigned* p) { return __hip_atomic_load(p, __ATOMIC_RELAXED, __HIP_MEMORY_SCOPE_AGENT); }
__device__ __forceinline__ unsigned xb_add(unsigned* p, unsigned v) { return __hip_atomic_fetch_add(p, v, __ATOMIC_RELAXED, __HIP_MEMORY_SCOPE_AGENT); }
__device__ __forceinline__ unsigned xb_xcc_id() { return (unsigned)__builtin_amdgcn_s_getreg((3 << 11) | 20) & 0xFu; }
#define XB_SPIN(cond, bar) do { unsigned _sp = 0; while (cond) { __builtin_amdgcn_s_sleep(1); \
    if ((++_sp & 255u) == 0u) { if (xb_ld(&(bar)[XB_TMO])) break; if (_sp > XB_SPIN_CAP) { atomicAdd(&(bar)[XB_TMO], 1u); break; } } } } while (0)
struct XcdBarrier { unsigned* bar; unsigned x; volatile LAS unsigned* st; };
__device__ __forceinline__ XcdBarrier xcd_barrier_post(unsigned* bar, volatile LAS unsigned* st) {
    XcdBarrier b; b.bar = bar; b.x = xb_xcc_id(); b.st = st;
    if (threadIdx.x == 0) (void)xb_add(&bar[XB_XCNT(b.x)], 1u);
    return b;
}
__device__ __forceinline__ void xcd_barrier_complete(unsigned* bar, unsigned x, unsigned& nloc, unsigned& nx) {
    const unsigned G = gridDim.x * gridDim.y * gridDim.z;
    unsigned sum, cnt, mine, sp = 0u;
    for (;;) {
        sum = 0u; cnt = 0u; mine = 0u;
#pragma unroll
        for (unsigned j = 0; j < 16; ++j) { const unsigned c = xb_ld(&bar[XB_XCNT(j)]); sum += c; cnt += (c > 0u) ? 1u : 0u; mine = (j == x) ? c : mine; }
        if (sum == G) break;
        __builtin_amdgcn_s_sleep(1);
        if ((++sp & 255u) == 0u) { if (xb_ld(&bar[XB_TMO])) break; if (sp > XB_SPIN_CAP) { atomicAdd(&bar[XB_TMO], 1u); break; } }
    }
    nloc = mine > 0u ? mine : 1u; nx = cnt > 0u ? cnt : 1u;
}
__device__ __forceinline__ void xcd_barrier(const XcdBarrier& b) {
    asm volatile("s_waitcnt vmcnt(0)" ::: "memory");
    __syncthreads();
    if (threadIdx.x == 0) {
        unsigned* bar = b.bar;
        __builtin_amdgcn_s_waitcnt(0);
        unsigned nloc = b.st[0], nx = b.st[1];
        if (nloc == 0u) { xcd_barrier_complete(bar, b.x, nloc, nx); b.st[0] = nloc; b.st[1] = nx; }
        const unsigned old = xb_add(&bar[XB_XSUB(b.x)], 1u);
        const unsigned gen = old / nloc;
        if (old + 1u == (gen + 1u) * nloc) {
            __builtin_amdgcn_fence(__ATOMIC_RELEASE, "agent");
            asm volatile("s_waitcnt vmcnt(0)" ::: "memory");
            const unsigned og = xb_add(&bar[XB_TOP], 1u);
            const unsigned tg = og / nx;
            if (og + 1u == (tg + 1u) * nx) xb_add(&bar[XB_TOPGEN], 1u);
            else XB_SPIN(xb_ld(&bar[XB_TOPGEN]) == tg, bar);
            __builtin_amdgcn_fence(__ATOMIC_ACQUIRE, "agent");
            xb_add(&bar[XB_XGEN(b.x)], 1u);
            asm volatile("s_waitcnt vmcnt(0)" ::: "memory");
        } else {
            XB_SPIN(xb_ld(&bar[XB_XGEN(b.x)]) == gen, bar);
            __builtin_amdgcn_fence(__ATOMIC_ACQUIRE, "agent");
            asm volatile("s_waitcnt vmcnt(0)" ::: "memory");
        }
    }
    __syncthreads();
}

constexpr int BK = 64, HALF = 128, HT = HALF * BK;
__device__ __forceinline__ int lds_byte(int r, int c) { const int st = (r >> 4) * 2 + (c >> 5), rr = r & 15, cc = c & 31, ob = rr * 64 + cc * 2; return st * 1024 + (ob ^ (((ob >> 9) & 1) << 5)); }
__device__ __forceinline__ void stage_rc(int b, int& R, int& C) { const int st = b / 1024, sb = b % 1024, swz = sb ^ (((sb >> 9) & 1) << 5); R = (st >> 1) * 16 + swz / 64; C = (st & 1) * 32 + (swz % 64) / 2; }

template <class PH> struct HasNext { template <class T> static char test(decltype(&T::next)); template <class T> static long test(...); static constexpr bool value = sizeof(test<PH>(nullptr)) == 1; };
template <class PH> struct HasDone { template <class T> static char test(decltype(&T::done)); template <class T> static long test(...); static constexpr bool value = sizeof(test<PH>(nullptr)) == 1; };
template <class EP> struct HasPre2 { template <class T> static char test(decltype(&T::pre2)); template <class T> static long test(...); static constexpr bool value = sizeof(test<EP>(nullptr)) == 1; };
template <class EP> struct IsBatch4 { template <class T> static char test(decltype(&T::BATCH4)); template <class T> static long test(...); static constexpr bool value = sizeof(test<EP>(nullptr)) == 1; };
template <class EP> __device__ __forceinline__ void run_epilogue(const EP& ep, const f32x4 (&acc)[2][2][4][2], int wr, int wc, int fr, int fq) {
    int rb = wr * 64 + fr, fq_ = fq; asm volatile("" : "+v"(rb), "+v"(fq_));
    if constexpr (IsBatch4<EP>::value) {
#pragma unroll
        for (int ai = 0; ai < 2; ++ai) {
            typename EP::Ctx cx[4];
#pragma unroll
            for (int m = 0; m < 4; ++m) cx[m] = ep.pre(ai * HALF + m * 16 + rb, wc * 32, fq_);
            if constexpr (HasPre2<EP>::value) {
#pragma unroll
                for (int m = 0; m < 4; ++m) ep.pre2(cx[m]);
            }
#pragma unroll
            for (int m = 0; m < 4; ++m) ep.post(ai * HALF + m * 16 + rb, wc * 32, fq_, cx[m], acc[ai][0][m][0], acc[ai][0][m][1], acc[ai][1][m][0], acc[ai][1][m][1]);
        }
    } else {
        typename EP::Ctx cx[8];
#pragma unroll
        for (int i = 0; i < 8; ++i) cx[i] = ep.pre((i >> 2) * HALF + (i & 3) * 16 + rb, wc * 32, fq_);
        if constexpr (HasPre2<EP>::value) {
#pragma unroll
            for (int i = 0; i < 8; ++i) ep.pre2(cx[i]);
        }
#pragma unroll
        for (int i = 0; i < 8; ++i) ep.post((i >> 2) * HALF + (i & 3) * 16 + rb, wc * 32, fq_, cx[i], acc[i >> 2][0][i & 3][0], acc[i >> 2][0][i & 3][1], acc[i >> 2][1][i & 3][0], acc[i >> 2][1][i & 3][1]);
    }
}
struct GmArgs { const float *gm_g, *gm_b, *w_sp, *b_sp; bf16_t* mix; int row0, h; };
__device__ __forceinline__ void gmlp_epilogue(f32x4 (&acc)[2][2][4][2], const GmArgs& g, char* lds, int wr, int wc, int fr, int fq) {
    typedef float f32x2 __attribute__((ext_vector_type(2)));
    f32x2* P = (f32x2*)lds;
    char* vT = lds + 8192;
#pragma unroll
    for (int ai = 0; ai < 2; ++ai)
#pragma unroll
        for (int bj = 0; bj < 2; ++bj)
#pragma unroll
            for (int m = 0; m < 4; ++m)
#pragma unroll
                for (int n = 0; n < 2; ++n)
#pragma unroll
                    for (int t = 0; t < 4; ++t) acc[ai][bj][m][n][t] = gelu_tanh(acc[ai][bj][m][n][t]);
#pragma unroll
    for (int ai = 0; ai < 2; ++ai)
#pragma unroll
        for (int m = 0; m < 4; ++m) { float s = 0.f, q = 0.f;
#pragma unroll
            for (int n = 0; n < 2; ++n)
#pragma unroll
                for (int t = 0; t < 4; ++t) { const float x = acc[ai][1][m][n][t]; s += x; q += x * x; }
            s += shx(s, 16); s += shx(s, 32); q += shx(q, 16); q += shx(q, 32);
            if (fq == 0) P[(ai * 128 + wr * 64 + m * 16 + fr) * 4 + wc] = (f32x2){s, q}; }
    __syncthreads();
    const int c0 = wc * 32 + 4 * fq;
    f32x4 gg[2], bb[2];
#pragma unroll
    for (int n = 0; n < 2; ++n) { gg[n] = *(const f32x4*)(g.gm_g + g.h * 128 + c0 + 16 * n); bb[n] = *(const f32x4*)(g.gm_b + g.h * 128 + c0 + 16 * n); }
#pragma unroll
    for (int ai = 0; ai < 2; ++ai)
#pragma unroll
        for (int m = 0; m < 4; ++m) { const int row = ai * 128 + wr * 64 + m * 16 + fr, j = wr * 64 + m * 16 + fr;
            const f32x2 p0 = P[row * 4 + 0], p1 = P[row * 4 + 1], p2 = P[row * 4 + 2], p3 = P[row * 4 + 3];
            const float mean = ((p0.x + p1.x) + (p2.x + p3.x)) * (1.f / 128.f), var = fmaxf(((p0.y + p1.y) + (p2.y + p3.y)) * (1.f / 128.f) - mean * mean, 0.f), rstd = 1.f / sqrtf(var + 1e-5f);
#pragma unroll
            for (int n = 0; n < 2; ++n)
#pragma unroll
                for (int t = 0; t < 4; ++t) *(bf16_t*)(vT + ai * (128 * 272) + (c0 + 16 * n + t) * 272 + j * 2) = f2bf((acc[ai][1][m][n][t] - mean) * rstd * gg[n][t] + bb[n][t]); }
    __syncthreads();
    const int nks = (wr == 0) ? 2 : 4;
#pragma unroll
    for (int m = 0; m < 4; ++m) {
        const int i = wr * 64 + m * 16 + fr;
        bf16x8 wf[4];
#pragma unroll
        for (int ks = 0; ks < 4; ++ks) { u32x4 pk = {0u, 0u, 0u, 0u};
            if (ks < nks) { const float* w = g.w_sp + ((size_t)g.h * 128 + i) * 128 + 32 * ks + 8 * fq; const f32x4 w0 = *(const f32x4*)w, w1 = *(const f32x4*)(w + 4);
                pk.x = pk2(w0[0], w0[1]); pk.y = pk2(w0[2], w0[3]); pk.z = pk2(w1[0], w1[1]); pk.w = pk2(w1[2], w1[3]); }
            wf[ks] = __builtin_bit_cast(bf16x8, pk); }
        const float bias = g.b_sp[g.h * 128 + i];
#pragma unroll
        for (int ai = 0; ai < 2; ++ai)
#pragma unroll
            for (int n = 0; n < 2; ++n) { f32x4 f = {0.f, 0.f, 0.f, 0.f};
#pragma unroll
                for (int ks = 0; ks < 4; ++ks) if (ks < nks) { const bf16x8 a = *(const bf16x8*)(vT + ai * (128 * 272) + (wc * 32 + n * 16 + fr) * 272 + (32 * ks + 8 * fq) * 2);
                    f = __builtin_amdgcn_mfma_f32_16x16x32_bf16(a, wf[ks], f, 0, 0, 0); }
                const f32x4 uu = acc[ai][0][m][n]; f32x4 o; o[0] = uu[0] * (f[0] + bias); o[1] = uu[1] * (f[1] + bias); o[2] = uu[2] * (f[2] + bias); o[3] = uu[3] * (f[3] + bias);
                st4(g.mix + (size_t)(g.row0 + ai * 128 + i) * DM + g.h * 128 + wc * 32 + n * 16 + 4 * fq, o); } }
}
struct KvArgs { bf16_t* zkv; float* tab; int row0; };
__device__ __forceinline__ void kvlat_epilogue(const f32x4 (&acc)[2][2][4][2], const KvArgs& g, char* lds, int wr, int wc, int fr, int fq) {
    float* P = (float*)lds;
#pragma unroll
    for (int ai = 0; ai < 2; ++ai)
#pragma unroll
        for (int m = 0; m < 4; ++m) { float q = 0.f; const int row = ai * 128 + wr * 64 + m * 16 + fr;
#pragma unroll
            for (int bj = 0; bj < 2; ++bj)
#pragma unroll
                for (int n = 0; n < 2; ++n) { const f32x4 x = acc[ai][bj][m][n]; q += (x[0] * x[0] + x[1] * x[1]) + (x[2] * x[2] + x[3] * x[3]);
                    st4(g.zkv + (size_t)(g.row0 + row) * 256 + bj * 128 + wc * 32 + n * 16 + 4 * fq, x); }
            q += shx(q, 16); q += shx(q, 32);
            if (fq == 0) P[row * 4 + wc] = q; }
    __syncthreads();
    if (threadIdx.x < 256) { const f32x4 s = *(const f32x4*)(P + threadIdx.x * 4); g.tab[threadIdx.x] = 1.f / sqrtf(((s[0] + s[1]) + (s[2] + s[3])) * (1.f / 256.f) + 1e-6f); }
    asm volatile("s_waitcnt vmcnt(0)" ::: "memory");
}
template <class EP, int EK = 0>
__device__ __forceinline__ void gemm256(const Unit<EP>& u, LAS unsigned char* lds, const GmArgs* gm = nullptr, const KvArgs* kv = nullptr) {
    int tid = threadIdx.x; asm volatile("" : "+v"(tid));
    const int K = u.K, nt = K / BK;
    const int wid = __builtin_amdgcn_readfirstlane(tid >> 6), lane = tid & 63, wr = wid >> 2, wc = wid & 3, fr = lane & 15, fq = lane >> 4;
    unsigned voffA[2][2], voffB[2];
    const char* gA = (const char*)u.am.base; const char* gB = (const char*)u.bt;
#pragma unroll
    for (int i = 0; i < 2; ++i) { int R, C; stage_rc(tid * 16 + i * 8192, R, C);
        voffB[i] = (unsigned)(R * K + C) * 2u;
        if (u.am.list) { const int a0 = u.am.list[R < u.am.nvalid ? R : 0], a1 = u.am.list[R + HALF < u.am.nvalid ? R + HALF : 0];
            voffA[0][i] = ((unsigned)(a0 >> 1) * (unsigned)u.am.ld + (unsigned)C) * 2u; voffA[1][i] = ((unsigned)(a1 >> 1) * (unsigned)u.am.ld + (unsigned)C) * 2u; }
        else { voffA[0][i] = (unsigned)(R * u.am.ld + C) * 2u; voffA[1][i] = (unsigned)((R + HALF) * u.am.ld + C) * 2u; } }
    const size_t hstepB = (size_t)HALF * K * 2;
    const unsigned ldsw = (unsigned)wid * 1024u;
    const int aoff = lds_byte(wr * 64 + fr, fq * 8), boff = lds_byte(wc * 32 + fr, fq * 8);
    #define SA(b,h) (((b)*2+(h))*HT*2)
    #define SB(b,h) ((4+(b)*2+(h))*HT*2)
    #define STAGE_A(bufoff,h,kt) do{ _Pragma("unroll") for(int _i=0;_i<2;++_i) { asm volatile("" : "+v"(voffA[h][_i])); \
        __builtin_amdgcn_global_load_lds((const unsigned*)(gA+(size_t)(kt)*(BK*2)+voffA[h][_i]),(LAS unsigned*)(lds+(bufoff)+ldsw+_i*8192),16,0,0);} }while(0)
    #define STAGE_B(bufoff,h,kt) do{ _Pragma("unroll") for(int _i=0;_i<2;++_i) { asm volatile("" : "+v"(voffB[_i])); \
        __builtin_amdgcn_global_load_lds((const unsigned*)(gB+(size_t)(h)*hstepB+(size_t)(kt)*(BK*2)+voffB[_i]),(LAS unsigned*)(lds+(bufoff)+ldsw+_i*8192),16,0,0);} }while(0)
    #define LDA(dst,b,h) _Pragma("unroll") for(int m=0;m<4;++m) _Pragma("unroll") for(int k=0;k<2;++k) \
        dst[m][k]=*(const LAS bf16x8*)(lds+SA(b,h)+aoff+m*2048+k*1024)
    #define LDB(dst,b,h) _Pragma("unroll") for(int n=0;n<2;++n) _Pragma("unroll") for(int k=0;k<2;++k) \
        dst[n][k]=*(const LAS bf16x8*)(lds+SB(b,h)+boff+n*2048+k*1024)
    #define MMA(ai,bj,At_,Bt_) do{__builtin_amdgcn_s_setprio(1); \
        _Pragma("unroll") for(int m=0;m<4;++m) _Pragma("unroll") for(int n=0;n<2;++n) _Pragma("unroll") for(int k=0;k<2;++k) \
          acc[ai][bj][m][n]=__builtin_amdgcn_mfma_f32_16x16x32_bf16(Bt_[n][k],At_[m][k],acc[ai][bj][m][n],0,0,0); \
        __builtin_amdgcn_s_setprio(0);}while(0)
    #define WAIT_V(n) asm volatile("s_waitcnt vmcnt(" #n ")":::"memory")
    #define WAIT_L(n) asm volatile("s_waitcnt lgkmcnt(" #n ")":::"memory")
    #define BAR __builtin_amdgcn_s_barrier()
    #define SCHED __builtin_amdgcn_sched_barrier(0)

    f32x4 acc[2][2][4][2];
#pragma unroll
    for (int a = 0; a < 2; ++a)
#pragma unroll
        for (int b = 0; b < 2; ++b)
#pragma unroll
            for (int m = 0; m < 4; ++m)
#pragma unroll
                for (int n = 0; n < 2; ++n) acc[a][b][m][n] = (f32x4){0.f, 0.f, 0.f, 0.f};
    bf16x8 At[4][2], B0[2][2], B1[2][2];
    STAGE_B(SB(0,0),0,0); STAGE_A(SA(0,0),0,0);
    STAGE_B(SB(0,1),1,0); STAGE_A(SA(0,1),1,0);
    if (wr == 1) BAR;
    WAIT_V(4); BAR;
    STAGE_B(SB(1,0),0,1); STAGE_A(SA(1,0),0,1); STAGE_B(SB(1,1),1,1);
    WAIT_V(6); BAR;
    for (int t = 0; t < nt - 2; t += 2) {
        LDB(B0,0,0); SCHED; LDA(At,0,0); STAGE_A(SA(1,1),1,t+1);
        WAIT_L(8); BAR; WAIT_L(0); MMA(0,0,At,B0); BAR; SCHED;
        LDB(B1,0,1); STAGE_B(SB(0,0),0,t+2);
        BAR; WAIT_L(0); MMA(0,1,At,B1); BAR;
        LDA(At,0,1); STAGE_A(SA(0,0),0,t+2);
        BAR; WAIT_L(0); MMA(1,0,At,B0); BAR; SCHED;
        STAGE_B(SB(0,1),1,t+2);
        WAIT_V(6); BAR; MMA(1,1,At,B1); BAR;
        LDB(B0,1,0); SCHED; LDA(At,1,0); STAGE_A(SA(0,1),1,t+2);
        WAIT_L(8); BAR; WAIT_L(0); MMA(0,0,At,B0); BAR; SCHED;
        LDB(B1,1,1); STAGE_B(SB(1,0),0,t+3);
        BAR; WAIT_L(0); MMA(0,1,At,B1); BAR;
        LDA(At,1,1); STAGE_A(SA(1,0),0,t+3);
        BAR; WAIT_L(0); MMA(1,0,At,B0); BAR; SCHED;
        STAGE_B(SB(1,1),1,t+3);
        WAIT_V(6); BAR; MMA(1,1,At,B1); BAR;
    }
    { LDB(B0,0,0); LDA(At,0,0); STAGE_A(SA(1,1),1,nt-1);
      BAR; WAIT_L(0); MMA(0,0,At,B0); BAR;
      LDB(B1,0,1); BAR; WAIT_L(0); MMA(0,1,At,B1); BAR;
      LDA(At,0,1); WAIT_V(4); BAR; WAIT_L(0); MMA(1,0,At,B0); MMA(1,1,At,B1); BAR; }
    { LDB(B0,1,0); LDA(At,1,0); WAIT_V(2); BAR; WAIT_L(0); MMA(0,0,At,B0); BAR;
      LDB(B1,1,1); WAIT_V(0); BAR; WAIT_L(0); MMA(0,1,At,B1); BAR;
      LDA(At,1,1); BAR; WAIT_L(0); MMA(1,0,At,B0); MMA(1,1,At,B1); BAR; }
    if (wr == 0) BAR;
    if constexpr (EK == 1) { __syncthreads(); gmlp_epilogue(acc, *gm, (char*)lds, wr, wc, fr, fq); } else if constexpr (EK == 2) { __syncthreads(); kvlat_epilogue(acc, *kv, (char*)lds, wr, wc, fr, fq); } else run_epilogue(u.ep, acc, wr, wc, fr, fq);
    __syncthreads();
    #undef SA
    #undef SB
    #undef STAGE_A
    #undef STAGE_B
    #undef LDA
    #undef LDB
    #undef MMA
}


template <class PH>
__device__ __forceinline__ void gemm_stream(const PH& ph, LAS unsigned char* lds, int u0, int ustride) {
    typedef Unit<typename PH::EP> U;
    int tid = threadIdx.x; asm volatile("" : "+v"(tid));
    const int wid = __builtin_amdgcn_readfirstlane(tid >> 6), lane = tid & 63, wr = wid >> 2, wc = wid & 3, fr = lane & 15, fq = lane >> 4;
    int u = u0;
    U cu; if (u >= PH::NU || !ph.unit(u, cu)) return;
    const int K = cu.K, nt = K / BK;
    int R0, C0, R1, C1; stage_rc(tid * 16, R0, C0); stage_rc(tid * 16 + 8192, R1, C1);
    unsigned voffB0 = (unsigned)(R0 * K + C0) * 2u, voffB1 = (unsigned)(R1 * K + C1) * 2u;
    #define VOFFA(am, o00, o01, o10, o11) do { \
        if ((am).list) { const int n_ = (am).nvalid; const int a00 = (am).list[R0 < n_ ? R0 : 0], a01 = (am).list[R1 < n_ ? R1 : 0], a10 = (am).list[R0 + HALF < n_ ? R0 + HALF : 0], a11 = (am).list[R1 + HALF < n_ ? R1 + HALF : 0]; \
            o00 = ((unsigned)(a00 >> 1) * (unsigned)(am).ld + (unsigned)C0) * 2u; o01 = ((unsigned)(a01 >> 1) * (unsigned)(am).ld + (unsigned)C1) * 2u; \
            o10 = ((unsigned)(a10 >> 1) * (unsigned)(am).ld + (unsigned)C0) * 2u; o11 = ((unsigned)(a11 >> 1) * (unsigned)(am).ld + (unsigned)C1) * 2u; } \
        else { o00 = (unsigned)(R0 * (am).ld + C0) * 2u; o01 = (unsigned)(R1 * (am).ld + C1) * 2u; o10 = (unsigned)((R0 + HALF) * (am).ld + C0) * 2u; o11 = (unsigned)((R1 + HALF) * (am).ld + C1) * 2u; } } while (0)
    unsigned va00, va01, va10, va11; VOFFA(cu.am, va00, va01, va10, va11);
    const char* cA = (const char*)cu.am.base; const char* cB = (const char*)cu.bt;
    const size_t hstepB = (size_t)HALF * K * 2, kstep = BK * 2;
    const unsigned ldsw = (unsigned)wid * 1024u;
    const int aoff = lds_byte(wr * 64 + fr, fq * 8), boff = lds_byte(wc * 32 + fr, fq * 8);
    #define SA(b,h) (((b)*2+(h))*HT*2)
    #define SB(b,h) ((4+(b)*2+(h))*HT*2)
    #define STG(bufoff, gbase, o0, o1) do { asm volatile("" : "+v"(o0)); asm volatile("" : "+v"(o1)); \
        __builtin_amdgcn_global_load_lds((const unsigned*)((gbase) + (o0)), (LAS unsigned*)(lds + (bufoff) + ldsw), 16, 0, 0); \
        __builtin_amdgcn_global_load_lds((const unsigned*)((gbase) + (o1)), (LAS unsigned*)(lds + (bufoff) + ldsw + 8192), 16, 0, 0); } while (0)
    #define LDA(dst,b,h) _Pragma("unroll") for(int m=0;m<4;++m) _Pragma("unroll") for(int k=0;k<2;++k) \
        dst[m][k]=*(const LAS bf16x8*)(lds+SA(b,h)+aoff+m*2048+k*1024)
    #define LDB(dst,b,h) _Pragma("unroll") for(int n=0;n<2;++n) _Pragma("unroll") for(int k=0;k<2;++k) \
        dst[n][k]=*(const LAS bf16x8*)(lds+SB(b,h)+boff+n*2048+k*1024)
    #define MMA(ai,bj,At_,Bt_) do{__builtin_amdgcn_s_setprio(1); \
        _Pragma("unroll") for(int m=0;m<4;++m) _Pragma("unroll") for(int n=0;n<2;++n) _Pragma("unroll") for(int k=0;k<2;++k) \
          acc[ai][bj][m][n]=__builtin_amdgcn_mfma_f32_16x16x32_bf16(Bt_[n][k],At_[m][k],acc[ai][bj][m][n],0,0,0); \
        __builtin_amdgcn_s_setprio(0);}while(0)
    f32x4 acc[2][2][4][2];
    #define ZERO_ACC _Pragma("unroll") for (int a = 0; a < 2; ++a) _Pragma("unroll") for (int b = 0; b < 2; ++b) _Pragma("unroll") for (int m = 0; m < 4; ++m) _Pragma("unroll") for (int n = 0; n < 2; ++n) acc[a][b][m][n] = (f32x4){0.f, 0.f, 0.f, 0.f}
    bf16x8 At[4][2], B0[2][2], B1[2][2];
#ifndef SP2
#define SP2 0
#endif
#if SP2
    STG(SB(0,0), cB, voffB0, voffB1); STG(SB(0,1), cB + hstepB, voffB0, voffB1); STG(SA(0,0), cA, va00, va01); STG(SA(0,1), cA, va10, va11);
    if (wr == 1) BAR;
    WAIT_V(2); BAR;
#else
    STG(SB(0,0), cB, voffB0, voffB1); STG(SA(0,0), cA, va00, va01); STG(SB(0,1), cB + hstepB, voffB0, voffB1); STG(SA(0,1), cA, va10, va11);
    if (wr == 1) BAR;
    WAIT_V(4); BAR;
#endif
    STG(SB(1,0), cB + kstep, voffB0, voffB1); STG(SA(1,0), cA + kstep, va00, va01); STG(SB(1,1), cB + hstepB + kstep, voffB0, voffB1);
    WAIT_V(6); BAR;
    for (;;) {
        U nx; int un; if constexpr (HasNext<PH>::value) un = ph.next(wr); else un = u + ustride;
        const bool has_next = (un < PH::NU) && ph.unit(un, nx);
        unsigned na00 = va00, na01 = va01, na10 = va10, na11 = va11; const char* nA = cA; const char* nB = cB;
        if (has_next) { VOFFA(nx.am, na00, na01, na10, na11); nA = (const char*)nx.am.base; nB = (const char*)nx.bt; }
        ZERO_ACC;
#if SP2
        #define KBODY(a1_, a2_, b2_, X00, X01, X10, X11) do { \
            const char* a3_ = (a2_) + kstep; const char* b3_ = (b2_) + kstep; \
            LDB(B0,0,0); LDB(B1,0,1); SCHED; LDA(At,0,0); STG(SA(1,1), a1_, va10, va11); \
            WAIT_V(8); WAIT_L(0); BAR; MMA(0,0,At,B0); MMA(0,1,At,B1); BAR; SCHED; \
            LDA(At,0,1); STG(SB(0,0), b2_, voffB0, voffB1); STG(SB(0,1), (b2_) + hstepB, voffB0, voffB1); STG(SA(0,0), a2_, X00, X01); \
            WAIT_V(8); WAIT_L(0); BAR; MMA(1,0,At,B0); MMA(1,1,At,B1); BAR; SCHED; \
            LDB(B0,1,0); LDB(B1,1,1); SCHED; LDA(At,1,0); STG(SA(0,1), a2_, X10, X11); \
            WAIT_V(8); WAIT_L(0); BAR; MMA(0,0,At,B0); MMA(0,1,At,B1); BAR; SCHED; \
            LDA(At,1,1); STG(SB(1,0), b3_, voffB0, voffB1); STG(SB(1,1), (b3_) + hstepB, voffB0, voffB1); STG(SA(1,0), a3_, X00, X01); \
            WAIT_V(8); WAIT_L(0); BAR; MMA(1,0,At,B0); MMA(1,1,At,B1); BAR; SCHED; } while (0)
#else
        #define KBODY(a1_, a2_, b2_, X00, X01, X10, X11) do { \
            const char* a3_ = (a2_) + kstep; const char* b3_ = (b2_) + kstep; \
            LDB(B0,0,0); SCHED; LDA(At,0,0); STG(SA(1,1), a1_, va10, va11); \
            WAIT_L(8); BAR; WAIT_L(0); MMA(0,0,At,B0); BAR; SCHED; \
            LDB(B1,0,1); STG(SB(0,0), b2_, voffB0, voffB1); \
            BAR; WAIT_L(0); MMA(0,1,At,B1); BAR; \
            LDA(At,0,1); STG(SA(0,0), a2_, X00, X01); \
            BAR; WAIT_L(0); MMA(1,0,At,B0); BAR; SCHED; \
            STG(SB(0,1), (b2_) + hstepB, voffB0, voffB1); \
            WAIT_V(6); BAR; MMA(1,1,At,B1); BAR; \
            LDB(B0,1,0); SCHED; LDA(At,1,0); STG(SA(0,1), a2_, X10, X11); \
            WAIT_L(8); BAR; WAIT_L(0); MMA(0,0,At,B0); BAR; SCHED; \
            LDB(B1,1,1); STG(SB(1,0), b3_, voffB0, voffB1); \
            BAR; WAIT_L(0); MMA(0,1,At,B1); BAR; \
            LDA(At,1,1); STG(SA(1,0), a3_, X00, X01); \
            BAR; WAIT_L(0); MMA(1,0,At,B0); BAR; SCHED; \
            STG(SB(1,1), (b3_) + hstepB, voffB0, voffB1); \
            WAIT_V(6); BAR; MMA(1,1,At,B1); BAR; } while (0)
#endif
#ifndef KREP
#define KREP 1
#endif
        for (int t = 0; t < nt * KREP - 2; t += 2) { const int t1 = (KREP > 1) ? (t + 1) % nt : t + 1, t2 = (KREP > 1) ? (t + 2) % nt : t + 2;
            const char* a1 = cA + (size_t)t1 * kstep; const char* a2 = cA + (size_t)t2 * kstep; const char* b2 = cB + (size_t)t2 * kstep;
            KBODY(a1, a2, b2, va00, va01, va10, va11); }
        { const char* a1 = cA + (size_t)(nt - 1) * kstep; KBODY(a1, nA, nB, na00, na01, na10, na11); }
        if (KREP > 1) {
#pragma unroll
            for (int a = 0; a < 2; ++a)
#pragma unroll
                for (int b = 0; b < 2; ++b)
#pragma unroll
                    for (int m = 0; m < 4; ++m)
#pragma unroll
                        for (int n = 0; n < 2; ++n) acc[a][b][m][n] = acc[a][b][m][n] * (1.0f / KREP); }
        #undef KBODY
        run_epilogue(cu.ep, acc, wr, wc, fr, fq);
        if constexpr (HasDone<PH>::value) ph.done(cu, wr);
        if (!has_next) break;
        cu = nx; va00 = na00; va01 = na01; va10 = na10; va11 = na11; cA = nA; cB = nB; u = un;
    }
    WAIT_V(0);
    if (wr == 0) BAR;
    BAR;
    __syncthreads();
    #undef SA
    #undef SB
    #undef STG
    #undef LDA
    #undef LDB
    #undef MMA
    #undef ZERO_ACC
    #undef VOFFA
}

__device__ __forceinline__ void witem(const float* s0, const float* s1, int ldsrc, bf16_t* dst, int K, int k0, int n0, int mode, const float* kscale, float* scr, int lane) {
    const int n = n0 + (lane & 31);
    const float* s = s0; int col = n;
    if (mode == 1) { if (n >= 1728) col = -1; else if (n >= 1664) { const int i = (n - 1664) >> 1, pp = (n - 1664) & 1; col = 1664 + i + 32 * pp; }
        else if (GMLP_FUSED && n < 1024) { const int t = n >> 8, w = n & 255; col = w < 128 ? t * 128 + w : 512 + t * 128 + (w - 128); }
        else if (ZLAYOUT2 && n >= 1024) { col = n < 1280 ? 1408 + (n - 1024) : n < 1536 ? 1024 + (n - 1280) : 1280 + (n - 1536); } }
    else if (mode == 2) { const int h = n / 192, d = n - h * 192; if (d >= 128) { const int i = (d - 128) >> 1, pp = (d - 128) & 1; col = h * 192 + 128 + i + 32 * pp; } }
    else if (mode == 3) { const int G = n >> 5, r = n & 31; col = 16 * G + (r & 15); s = (r < 16) ? s0 : s1; }
    const float* sp = s + (size_t)(k0 + (lane >> 5)) * ldsrc + (col < 0 ? 0 : col);
    float v[32];
#pragma unroll
    for (int i = 0; i < 32; ++i) v[i] = sp[(size_t)(2 * i) * ldsrc];
    if (kscale) {
#pragma unroll
        for (int i = 0; i < 32; ++i) v[i] *= kscale[k0 + 2 * i + (lane >> 5)];
    }
    if (col < 0) {
#pragma unroll
        for (int i = 0; i < 32; ++i) v[i] = 0.f;
    }
#pragma unroll
    for (int i = 0; i < 32; ++i) scr[(2 * i + (lane >> 5)) * 33 + (lane & 31)] = v[i];
    asm volatile("s_waitcnt lgkmcnt(0)" ::: "memory");
    const int c = lane & 7;
#pragma unroll
    for (int j = 0; j < 4; ++j) { const int nn = (lane >> 3) + 8 * j; const float* q = scr + (8 * c) * 33 + nn;
        u32x4 o; o.x = pk2(q[0], q[33]); o.y = pk2(q[2 * 33], q[3 * 33]); o.z = pk2(q[4 * 33], q[5 * 33]); o.w = pk2(q[6 * 33], q[7 * 33]);
        *(u32x4*)(dst + (size_t)(n0 + nn) * K + k0 + 8 * c) = o; }
    asm volatile("s_waitcnt lgkmcnt(0)" ::: "memory");
}
constexpr int I_IN = 16 * 56, I_UQ = 6 * 24, I_UKV = 4 * 32, I_OUT = 16 * 32, I_GU = 32 * 16 * 16, I_DN = 32 * 4 * 32;
constexpr int I_TOTAL = I_IN + I_UQ + I_UKV + I_OUT + I_GU + I_DN, I_EARLY = I_IN + I_UQ + I_UKV + I_OUT;
__device__ __forceinline__ void prep_witem(const Params& p, int it, float* scr, int lane) {
    if (it < I_IN) { const int kb = it / 56, nb = it - kb * 56; witem(p.w_in, nullptr, 1728, p.WinT, 1024, kb * 64, nb * 32, 1, nullptr, scr, lane); return; } it -= I_IN;
    if (it < I_UQ) { const int kb = it / 24, nb = it - kb * 24; witem(p.w_uq, nullptr, 768, p.WuqT, 384, kb * 64, nb * 32, 0, p.qn_g, scr, lane); return; } it -= I_UQ;
    if (it < I_UKV) { const int kb = it >> 5, nb = it & 31; witem(p.w_ukv, nullptr, 1024, p.WukvT, 256, kb * 64, nb * 32, 0, p.kvn_g, scr, lane); return; } it -= I_UKV;
    if (it < I_OUT) { const int kb = it >> 5, nb = it & 31; witem(p.w_out, nullptr, 1024, p.WoutT, 1024, kb * 64, nb * 32, 0, nullptr, scr, lane); return; } it -= I_OUT;
    if (it < I_GU) { const int e = it >> 8, r = it & 255, kb = r >> 4, nb = r & 15;
        witem(p.w_gate + (size_t)e * 1024 * 256, p.w_up + (size_t)e * 1024 * 256, 256, p.WguT + (size_t)e * 512 * 1024, 1024, kb * 64, nb * 32, 3, nullptr, scr, lane); return; } it -= I_GU;
    { const int e = it >> 7, r = it & 127, kb = r >> 5, nb = r & 31;
        witem(p.w_down + (size_t)e * 256 * 1024, nullptr, 1024, p.WdT + (size_t)e * 1024 * 256, 256, kb * 64, nb * 32, 0, nullptr, scr, lane); }
}
template <bool WT> __device__ __forceinline__ void ln0_row4(const float* x, size_t rstride, const float* g, const float* b, bf16_t* o, int lane) {
    f32x4 v[4][4]; float s[4], q[4];
#pragma unroll
    for (int r = 0; r < 4; ++r)
#pragma unroll
        for (int j = 0; j < 4; ++j) v[r][j] = *(const f32x4*)(x + r * rstride + 256 * j + 4 * lane);
#pragma unroll
    for (int r = 0; r < 4; ++r) { s[r] = 0.f; q[r] = 0.f;
#pragma unroll
        for (int j = 0; j < 4; ++j) { s[r] += (v[r][j][0] + v[r][j][1]) + (v[r][j][2] + v[r][j][3]);
            q[r] += (v[r][j][0] * v[r][j][0] + v[r][j][1] * v[r][j][1]) + (v[r][j][2] * v[r][j][2] + v[r][j][3] * v[r][j][3]); } }
#pragma unroll
    for (int o2 = 1; o2 < 64; o2 <<= 1) {
#pragma unroll
        for (int r = 0; r < 4; ++r) { s[r] += shx(s[r], o2); q[r] += shx(q[r], o2); } }
    f32x4 gg[4], bb[4];
#pragma unroll
    for (int j = 0; j < 4; ++j) { gg[j] = *(const f32x4*)(g + 256 * j + 4 * lane); bb[j] = *(const f32x4*)(b + 256 * j + 4 * lane); }
#pragma unroll
    for (int r = 0; r < 4; ++r) { const float mean = s[r] * (1.f / 1024.f), var = fmaxf(q[r] * (1.f / 1024.f) - mean * mean, 0.f), rstd = 1.f / sqrtf(var + 1e-5f);
#pragma unroll
        for (int j = 0; j < 4; ++j) { if (WT) st4wt(o + r * rstride + 256 * j + 4 * lane, (v[r][j] - mean) * rstd * gg[j] + bb[j]); else st4(o + r * rstride + 256 * j + 4 * lane, (v[r][j] - mean) * rstd * gg[j] + bb[j]); } }
}
__device__ __forceinline__ void ln0_row1_wt(const float* xr, const float* g, const float* b, bf16_t* orow, int lane) {
    f32x4 v[4]; float s = 0.f, q = 0.f;
#pragma unroll
    for (int j = 0; j < 4; ++j) { v[j] = *(const f32x4*)(xr + 256 * j + 4 * lane); s += (v[j][0] + v[j][1]) + (v[j][2] + v[j][3]); q += (v[j][0] * v[j][0] + v[j][1] * v[j][1]) + (v[j][2] * v[j][2] + v[j][3] * v[j][3]); }
#pragma unroll
    for (int o2 = 1; o2 < 64; o2 <<= 1) { s += shx(s, o2); q += shx(q, o2); }
    const float mean = s * (1.f / 1024.f), var = fmaxf(q * (1.f / 1024.f) - mean * mean, 0.f), rstd = 1.f / sqrtf(var + 1e-5f);
#pragma unroll
    for (int j = 0; j < 4; ++j) { const f32x4 gg = *(const f32x4*)(g + 256 * j + 4 * lane), bb = *(const f32x4*)(b + 256 * j + 4 * lane); st4wt(orow + 256 * j + 4 * lane, (v[j] - mean) * rstd * gg + bb); }
}

template <int K> __device__ __forceinline__ void rs_table(const bf16_t* A, float* tab) {
    int tid = threadIdx.x; asm volatile("" : "+v"(tid));
    const int r = tid >> 1, hf = tid & 1; constexpr int n = K >> 1;
    const bf16_t* a = A + (size_t)r * K + hf * n; float s = 0.f;
    u32x4 w[n / 8];
#pragma unroll
    for (int i = 0; i < n / 8; ++i) w[i] = *(const u32x4*)(a + 8 * i);
#pragma unroll
    for (int i = 0; i < n / 8; ++i) { const float a0 = bflo(w[i].x), a1 = bfhi(w[i].x), a2 = bflo(w[i].y), a3 = bfhi(w[i].y), a4 = bflo(w[i].z), a5 = bfhi(w[i].z), a6 = bflo(w[i].w), a7 = bfhi(w[i].w);
        s += (a0 * a0 + a1 * a1) + (a2 * a2 + a3 * a3) + (a4 * a4 + a5 * a5) + (a6 * a6 + a7 * a7); }
    s += shx(s, 1);
    if (hf == 0) tab[r] = 1.f / sqrtf(s / (float)K + 1e-6f);
}

__device__ __forceinline__ void gmlp_phase(const Params& p, char* shm, int vcu) {
    int tid = threadIdx.x; asm volatile("" : "+v"(tid));
    const int wid = __builtin_amdgcn_readfirstlane(tid >> 6), lane = tid & 63, fr = lane & 15, fq = lane >> 4;
    const int h = vcu & 3, iabs = 16 * wid + fr;
    bf16x8 wf[4];
#pragma unroll
    for (int ks = 0; ks < 4; ++ks) {
        const float* w = p.w_sp + ((size_t)h * 128 + iabs) * 128 + 32 * ks + 8 * fq;
        const f32x4 w0 = *(const f32x4*)w, w1 = *(const f32x4*)(w + 4);
        const bool ok = (ks >> 1) <= (iabs >> 6);
        u32x4 pk; pk.x = pk2(w0[0], w0[1]); pk.y = pk2(w0[2], w0[3]); pk.z = pk2(w1[0], w1[1]); pk.w = pk2(w1[2], w1[3]);
        if (!ok) pk = (u32x4){0u, 0u, 0u, 0u};
        wf[ks] = __builtin_bit_cast(bf16x8, pk);
    }
    const float bias = p.b_sp[h * 128 + iabs];
    const int nks = (wid < 4) ? 2 : 4;
    const int j = tid >> 2, part = tid & 3;
    const int nb_ = gridDim.x, nrem = 896 % nb_, ng = (nb_ == 256) ? ((vcu >= nrem) ? 5 : 3) : -1;
    for (int gi = 0;; ++gi) {
        int u;
        if (ng < 0) { u = vcu + gi * nb_; if (u >= (T_TOK / 128) * 4) break; }
        else { if (gi >= ng) break; u = gi < 3 ? vcu + gi * 256 : 768 + (vcu - 128) + 128 * (gi - 3); }
        const int bn = u >> 2, row0 = bn * 128;
        {
            const bf16_t* vr = p.zv + (size_t)(row0 + j) * 512 + h * 128 + part * 32;
            float v[32];
#pragma unroll
            for (int q = 0; q < 4; ++q) { const u32x4 w = *(const u32x4*)(vr + 8 * q);
                v[8 * q + 0] = bflo(w.x); v[8 * q + 1] = bfhi(w.x); v[8 * q + 2] = bflo(w.y); v[8 * q + 3] = bfhi(w.y);
                v[8 * q + 4] = bflo(w.z); v[8 * q + 5] = bfhi(w.z); v[8 * q + 6] = bflo(w.w); v[8 * q + 7] = bfhi(w.w); }
            float s = 0.f;
#pragma unroll
            for (int e = 0; e < 32; ++e) s += v[e];
            s += shx(s, 1); s += shx(s, 2);
            const float mean = s * (1.f / 128.f); float s2 = 0.f;
#pragma unroll
            for (int e = 0; e < 32; ++e) { v[e] -= mean; s2 += v[e] * v[e]; }
            s2 += shx(s2, 1); s2 += shx(s2, 2);
            const float rstd = 1.f / sqrtf(s2 * (1.f / 128.f) + 1e-5f);
            const float* gg = p.gm_g + h * 128 + part * 32; const float* bb = p.gm_b + h * 128 + part * 32;
#pragma unroll
            for (int e = 0; e < 32; ++e) *(bf16_t*)(shm + (part * 32 + e) * 272 + j * 2) = f2bf(v[e] * rstd * gg[e] + bb[e]);
        }
        __syncthreads();
        f32x4 acc[8];
#pragma unroll
        for (int cb = 0; cb < 8; ++cb) acc[cb] = (f32x4){0.f, 0.f, 0.f, 0.f};
#pragma unroll
        for (int ks = 0; ks < 4; ++ks) if (ks < nks) {
#pragma unroll
            for (int cb = 0; cb < 8; ++cb) { const bf16x8 a = *(const bf16x8*)(shm + (16 * cb + fr) * 272 + (32 * ks + 8 * fq) * 2);
                acc[cb] = __builtin_amdgcn_mfma_f32_16x16x32_bf16(a, wf[ks], acc[cb], 0, 0, 0); }
        }
        const bf16_t* ur = p.zu + (size_t)(row0 + iabs) * 512 + h * 128 + 4 * fq;
        bf16_t* orow = p.mix + (size_t)(row0 + iabs) * DM + h * 128 + 4 * fq;
#pragma unroll
        for (int cb = 0; cb < 8; ++cb) { const u32x2 uw = *(const u32x2*)(ur + 16 * cb); f32x4 o;
            o[0] = bflo(uw.x) * (acc[cb][0] + bias); o[1] = bfhi(uw.x) * (acc[cb][1] + bias); o[2] = bflo(uw.y) * (acc[cb][2] + bias); o[3] = bfhi(uw.y) * (acc[cb][3] + bias);
            st4(orow + 16 * cb, o); }
        __syncthreads();
    }
}

constexpr int KT_STRIDE = 400, VT_STRIDE = 144, KT_BYTES = 64 * KT_STRIDE, ATT_STAGE = KT_BYTES + 128 * VT_STRIDE;
template <int AMODE> __device__ __forceinline__ void attn_block(const Params& p, char* shm, int bh, int qb, bf16_t* outbuf) {
    int tid = threadIdx.x; asm volatile("" : "+v"(tid));
    const int wid = __builtin_amdgcn_readfirstlane(tid >> 6), lane = tid & 63, r = lane & 31, hh = lane >> 5;
    const int b = bh >> 2, h = bh & 3, q0 = qb * 256, ntile = 4 * qb + 4, nw = 4 * qb + (wid >> 1) + 1;
    bf16x8 qf[12];
    { const bf16_t* qp = p.Q + ((size_t)bh * SEQ + q0 + 32 * wid + r) * 192 + 8 * hh;
#pragma unroll
      for (int s = 0; s < 12; ++s) qf[s] = *(const bf16x8*)(qp + 16 * s);
      const float2* rp = p.rope + ((size_t)b * SEQ + q0 + 32 * wid + r) * 32 + 8 * hh;
#pragma unroll
      for (int s = 0; s < 2; ++s) { u32x4 x1 = __builtin_bit_cast(u32x4, qf[8 + s]), x2 = __builtin_bit_cast(u32x4, qf[10 + s]); float a[8], c2[8];
          a[0] = bflo(x1.x); a[1] = bfhi(x1.x); a[2] = bflo(x1.y); a[3] = bfhi(x1.y); a[4] = bflo(x1.z); a[5] = bfhi(x1.z); a[6] = bflo(x1.w); a[7] = bfhi(x1.w);
          c2[0] = bflo(x2.x); c2[1] = bfhi(x2.x); c2[2] = bflo(x2.y); c2[3] = bfhi(x2.y); c2[4] = bflo(x2.z); c2[5] = bfhi(x2.z); c2[6] = bflo(x2.w); c2[7] = bfhi(x2.w);
          float o1[8], o2[8];
#pragma unroll
          for (int j = 0; j < 8; ++j) { const float2 cs = rp[16 * s + j]; o1[j] = a[j] * cs.x - c2[j] * cs.y; o2[j] = c2[j] * cs.x + a[j] * cs.y; }
          x1.x = pk2(o1[0], o1[1]); x1.y = pk2(o1[2], o1[3]); x1.z = pk2(o1[4], o1[5]); x1.w = pk2(o1[6], o1[7]);
          x2.x = pk2(o2[0], o2[1]); x2.y = pk2(o2[2], o2[3]); x2.z = pk2(o2[4], o2[5]); x2.w = pk2(o2[6], o2[7]);
          qf[8 + s] = __builtin_bit_cast(bf16x8, x1); qf[10 + s] = __builtin_bit_cast(bf16x8, x2); } }
    f32x16 O[4];
#pragma unroll
    for (int d = 0; d < 4; ++d)
#pragma unroll
        for (int t = 0; t < 16; ++t) O[d][t] = 0.f;
    float m = -INFINITY, l = 0.f;
    const bf16_t* kn_src = p.Kn + ((size_t)bh * SEQ + (tid >> 4)) * 128 + (tid & 15) * 8;
    const bf16_t* kr_src = p.krope + ((size_t)b * SEQ + (tid >> 3)) * 64 + (tid & 7) * 8;
    const bf16_t* vt_src = p.Vt + ((size_t)bh * 128 + (tid >> 3)) * SEQ + (tid & 7) * 8;
    const int kn_dst = (tid >> 4) * KT_STRIDE + (tid & 15) * 16, kr_dst = (tid >> 3) * KT_STRIDE + 256 + (tid & 7) * 16, vt_dst = KT_BYTES + (tid >> 3) * VT_STRIDE + (tid & 7) * 16;
    u32x4 g0, g1, g2, g3, g4;
    #define ATT_LOAD(kt) do { g0 = *(const u32x4*)(kn_src + (size_t)(kt) * 64 * 128); g1 = *(const u32x4*)(kn_src + (size_t)((kt) * 64 + 32) * 128); \
        g2 = *(const u32x4*)(kr_src + (size_t)(kt) * 64 * 64); g3 = *(const u32x4*)(vt_src + (kt) * 64); g4 = *(const u32x4*)(vt_src + (size_t)64 * SEQ + (kt) * 64); } while (0)
    #define ATT_WRITE(buf) do { char* _s = shm + (buf) * ATT_STAGE; *(u32x4*)(_s + kn_dst) = g0; *(u32x4*)(_s + kn_dst + 32 * KT_STRIDE) = g1; *(u32x4*)(_s + kr_dst) = g2; \
        *(u32x4*)(_s + vt_dst) = g3; *(u32x4*)(_s + vt_dst + 64 * VT_STRIDE) = g4; } while (0)
    ATT_LOAD(0); ATT_WRITE(0);
    __syncthreads();
    for (int kt = 0; kt < ntile; ++kt) {
        const bool more = kt + 1 < ntile;
        if (more) ATT_LOAD(kt + 1);
        if (kt < nw) {
            const char* ks = shm + (kt & 1) * ATT_STAGE; const char* vs = ks + KT_BYTES;
            f32x16 S0, S1;
#pragma unroll
            for (int t = 0; t < 16; ++t) { S0[t] = 0.f; S1[t] = 0.f; }
            if (AMODE != 4 && AMODE != 5) {
            __builtin_amdgcn_s_setprio(1);
#pragma unroll
            for (int s = 0; s < 12; ++s) {
                const bf16x8 k0 = *(const bf16x8*)(ks + r * KT_STRIDE + (16 * s + 8 * hh) * 2), k1 = *(const bf16x8*)(ks + (32 + r) * KT_STRIDE + (16 * s + 8 * hh) * 2);
                S0 = __builtin_amdgcn_mfma_f32_32x32x16_bf16(k0, qf[s], S0, 0, 0, 0);
                S1 = __builtin_amdgcn_mfma_f32_32x32x16_bf16(k1, qf[s], S1, 0, 0, 0);
            }
            __builtin_amdgcn_s_setprio(0);
            } else { asm volatile("" : "+v"(S0), "+v"(S1)); }
            float mt = fmaxf(S0[0], S1[0]);
#pragma unroll
            for (int t = 1; t < 16; ++t) mt = fmaxf(mt, fmaxf(S0[t], S1[t]));
            mt = fmaxf(mt, shx(mt, 32));
            if (AMODE == 2 || AMODE == 5) { m = 0.f; l = 1.f; asm volatile("" : "+v"(S0), "+v"(S1)); } else {
            if (!__all(mt - m <= 8.0f)) {
                const float mn = fmaxf(m, mt), alpha = __builtin_amdgcn_exp2f(m - mn); m = mn; l *= alpha;
#pragma unroll
                for (int d = 0; d < 4; ++d)
#pragma unroll
                    for (int t = 0; t < 16; ++t) O[d][t] *= alpha;
            }
            float ls = 0.f;
#pragma unroll
            for (int t = 0; t < 16; ++t) { S0[t] = __builtin_amdgcn_exp2f(S0[t] - m); S1[t] = __builtin_amdgcn_exp2f(S1[t] - m); ls += S0[t] + S1[t]; }
            l += ls; }
            bf16x8 pf[4];
#pragma unroll
            for (int s = 0; s < 2; ++s) {
                u32x4 a, c; a.x = pk2(S0[8 * s + 0], S0[8 * s + 1]); a.y = pk2(S0[8 * s + 2], S0[8 * s + 3]); a.z = pk2(S0[8 * s + 4], S0[8 * s + 5]); a.w = pk2(S0[8 * s + 6], S0[8 * s + 7]);
                c.x = pk2(S1[8 * s + 0], S1[8 * s + 1]); c.y = pk2(S1[8 * s + 2], S1[8 * s + 3]); c.z = pk2(S1[8 * s + 4], S1[8 * s + 5]); c.w = pk2(S1[8 * s + 6], S1[8 * s + 7]);
                pf[s] = __builtin_bit_cast(bf16x8, a); pf[2 + s] = __builtin_bit_cast(bf16x8, c);
            }
            if (AMODE == 3 || AMODE == 5) { asm volatile("" :: "v"(pf[0]), "v"(pf[1]), "v"(pf[2]), "v"(pf[3])); } else {
            __builtin_amdgcn_s_setprio(1);
#pragma unroll
            for (int k4 = 0; k4 < 4; ++k4)
#pragma unroll
                for (int d = 0; d < 4; ++d) { const bf16x8 vf = *(const bf16x8*)(vs + (32 * d + r) * VT_STRIDE + (16 * k4 + 8 * hh) * 2);
                    O[d] = __builtin_amdgcn_mfma_f32_32x32x16_bf16(vf, pf[k4], O[d], 0, 0, 0); }
            __builtin_amdgcn_s_setprio(0); }
        }
        if (more) ATT_WRITE((kt + 1) & 1);
        __syncthreads();
    }
    #undef ATT_LOAD
    #undef ATT_WRITE
    l += shx(l, 32);
    const float inv = 1.f / l;
    bf16_t* o = outbuf + ((size_t)b * SEQ + q0 + 32 * wid + r) * DM + 512 + h * 128 + 4 * hh;
#pragma unroll
    for (int d = 0; d < 4; ++d)
#pragma unroll
        for (int g = 0; g < 4; ++g) { f32x4 v; v[0] = O[d][4 * g] * inv; v[1] = O[d][4 * g + 1] * inv; v[2] = O[d][4 * g + 2] * inv; v[3] = O[d][4 * g + 3] * inv; st4(o + 32 * d + 8 * g, v); }
}


__device__ __forceinline__ void router_tile(const Params& p, char* smc, int tb) {
    int tid = threadIdx.x; asm volatile("" : "+v"(tid));
    const int wid = __builtin_amdgcn_readfirstlane(tid >> 6), lane = tid & 63, fr = lane & 15, fq = lane >> 4;
    int* lcnt = (int*)(smc + LDS_LCNT);
    for (int i = tid; i < 2 * 36 * 128; i += NTHR) { const int img = i / (36 * 128), rem = i - img * 36 * 128, o = rem >> 7, ch = rem & 127;
        const u32x4 w = *(const u32x4*)(p.WrT + (size_t)img * 36864 + o * 1024 + ch * 8);
        *(u32x4*)(smc + LDS_RW + img * 73728 + o * 2048 + ((ch ^ (o & 15)) << 4)) = w; }
    if (tid < NEXP) lcnt[tid] = 0;
    __syncthreads();
    const int tok = tb * 128 + wid * 16 + fr;
    bf16_t* hr = p.hbuf + (size_t)tok * DM + 8 * fq;
    float s = 0.f, s2 = 0.f;
#pragma unroll 8
    for (int ks = 0; ks < 32; ++ks) { const u32x4 y = *(const u32x4*)(hr + 32 * ks);
        const float a0 = bflo(y.x), a1 = bfhi(y.x), a2 = bflo(y.y), a3 = bfhi(y.y), a4 = bflo(y.z), a5 = bfhi(y.z), a6 = bflo(y.w), a7 = bfhi(y.w);
        s += ((a0 + a1) + (a2 + a3)) + ((a4 + a5) + (a6 + a7)); s2 += ((a0 * a0 + a1 * a1) + (a2 * a2 + a3 * a3)) + ((a4 * a4 + a5 * a5) + (a6 * a6 + a7 * a7)); }
    s += shx(s, 16); s += shx(s, 32); s2 += shx(s2, 16); s2 += shx(s2, 32);
    const float mean = s * (1.f / 1024.f), var = fmaxf(s2 * (1.f / 1024.f) - mean * mean, 0.f), rstd = 1.f / sqrtf(var + 1e-5f);
    const int o0 = fr < 4 ? fr : 3, o1 = 4 + fr, o2 = 20 + fr;
    const int w0 = o0 * 2048, w1 = o1 * 2048, w2 = o2 * 2048, x0 = o0 & 15, x1 = o1 & 15, x2 = o2 & 15;
    f32x4 acc0 = {0.f, 0.f, 0.f, 0.f}, acc1 = acc0, acc2 = acc0;
    const float* lg_ = p.ln1_g + 8 * fq; const float* lb_ = p.ln1_b + 8 * fq;
#pragma unroll 4
    for (int ks = 0; ks < 32; ++ks) {
        const f32x4 g0 = *(const f32x4*)(lg_ + 32 * ks), g1 = *(const f32x4*)(lg_ + 32 * ks + 4), b0 = *(const f32x4*)(lb_ + 32 * ks), b1 = *(const f32x4*)(lb_ + 32 * ks + 4);
        const u32x4 yy = *(const u32x4*)(hr + 32 * ks);
        float h[8];
        h[0] = (bflo(yy.x) - mean) * rstd * g0[0] + b0[0]; h[1] = (bfhi(yy.x) - mean) * rstd * g0[1] + b0[1]; h[2] = (bflo(yy.y) - mean) * rstd * g0[2] + b0[2]; h[3] = (bfhi(yy.y) - mean) * rstd * g0[3] + b0[3];
        h[4] = (bflo(yy.z) - mean) * rstd * g1[0] + b1[0]; h[5] = (bfhi(yy.z) - mean) * rstd * g1[1] + b1[1]; h[6] = (bflo(yy.w) - mean) * rstd * g1[2] + b1[2]; h[7] = (bfhi(yy.w) - mean) * rstd * g1[3] + b1[3];
        u32x4 hi, lo; hi.x = pk2(h[0], h[1]); hi.y = pk2(h[2], h[3]); hi.z = pk2(h[4], h[5]); hi.w = pk2(h[6], h[7]);
        *(u32x4*)(hr + 32 * ks) = hi;
        lo.x = pk2(h[0] - bflo(hi.x), h[1] - bfhi(hi.x)); lo.y = pk2(h[2] - bflo(hi.y), h[3] - bfhi(hi.y)); lo.z = pk2(h[4] - bflo(hi.z), h[5] - bfhi(hi.z)); lo.w = pk2(h[6] - bflo(hi.w), h[7] - bfhi(hi.w));
        const bf16x8 hh = __builtin_bit_cast(bf16x8, hi), hl = __builtin_bit_cast(bf16x8, lo);
        const int ch = 4 * ks + fq;
        const bf16x8 a0h = *(const bf16x8*)(smc + LDS_RW + w0 + ((ch ^ x0) << 4)), a0l = *(const bf16x8*)(smc + LDS_RW + 73728 + w0 + ((ch ^ x0) << 4));
        const bf16x8 a1h = *(const bf16x8*)(smc + LDS_RW + w1 + ((ch ^ x1) << 4)), a1l = *(const bf16x8*)(smc + LDS_RW + 73728 + w1 + ((ch ^ x1) << 4));
        const bf16x8 a2h = *(const bf16x8*)(smc + LDS_RW + w2 + ((ch ^ x2) << 4)), a2l = *(const bf16x8*)(smc + LDS_RW + 73728 + w2 + ((ch ^ x2) << 4));
        acc0 = __builtin_amdgcn_mfma_f32_16x16x32_bf16(a0h, hh, acc0, 0, 0, 0); acc0 = __builtin_amdgcn_mfma_f32_16x16x32_bf16(a0h, hl, acc0, 0, 0, 0); acc0 = __builtin_amdgcn_mfma_f32_16x16x32_bf16(a0l, hh, acc0, 0, 0, 0);
        acc1 = __builtin_amdgcn_mfma_f32_16x16x32_bf16(a1h, hh, acc1, 0, 0, 0); acc1 = __builtin_amdgcn_mfma_f32_16x16x32_bf16(a1h, hl, acc1, 0, 0, 0); acc1 = __builtin_amdgcn_mfma_f32_16x16x32_bf16(a1l, hh, acc1, 0, 0, 0);
        acc2 = __builtin_amdgcn_mfma_f32_16x16x32_bf16(a2h, hh, acc2, 0, 0, 0); acc2 = __builtin_amdgcn_mfma_f32_16x16x32_bf16(a2h, hl, acc2, 0, 0, 0); acc2 = __builtin_amdgcn_mfma_f32_16x16x32_bf16(a2l, hh, acc2, 0, 0, 0);
    }
    __syncthreads();
    float* sc = (float*)(smc + LDS_RW) + wid * (16 * 40) + fr * 40;
    if (fq == 0) { sc[0] = acc0[0]; sc[1] = acc0[1]; sc[2] = acc0[2]; sc[3] = acc0[3]; }
    *(f32x4*)(sc + 4 + 4 * fq) = acc1; *(f32x4*)(sc + 20 + 4 * fq) = acc2;
    __syncthreads();
    if (lane < 16) {
        const float* lr = (const float*)(smc + LDS_RW) + wid * (16 * 40) + lane * 40;
        float lg[36];
#pragma unroll
        for (int o = 0; o < 36; o += 4) { const f32x4 v = *(const f32x4*)(lr + o); lg[o] = v[0]; lg[o + 1] = v[1]; lg[o + 2] = v[2]; lg[o + 3] = v[3]; }
#pragma unroll
        for (int o = 0; o < 4; ++o) lg[o] += p.b_rg[o];
#pragma unroll
        for (int o = 0; o < 32; ++o) lg[4 + o] += p.b_re[o];
        int g = 0; float gm = lg[0];
#pragma unroll
        for (int i = 1; i < 4; ++i) if (lg[i] > gm) { gm = lg[i]; g = i; }
        float se = 0.f;
#pragma unroll
        for (int i = 0; i < 4; ++i) se += expf(lg[i] - gm);
        const float pg = 1.f / se;
        float ev[8];
#pragma unroll
        for (int e = 0; e < 8; ++e) ev[e] = g == 0 ? lg[4 + e] : g == 1 ? lg[12 + e] : g == 2 ? lg[20 + e] : lg[28 + e];
        int i1 = 0; float v1 = ev[0];
#pragma unroll
        for (int e = 1; e < 8; ++e) if (ev[e] > v1) { v1 = ev[e]; i1 = e; }
        int i2 = -1; float v2 = -3.0e38f;
#pragma unroll
        for (int e = 0; e < 8; ++e) if (e != i1 && ev[e] > v2) { v2 = ev[e]; i2 = e; }
        const float d = expf(v2 - v1), g1 = pg / (1.f + d), g2 = pg * d / (1.f + d);
        const int t = tb * 128 + wid * 16 + lane, e1 = g * 8 + i1, e2 = g * 8 + i2;
        const int s1 = atomicAdd(lcnt + e1, 1), s2_ = atomicAdd(lcnt + e2, 1);
        p.listb[((size_t)tb * NEXP + e1) * 256 + s1] = 2 * t; p.listb[((size_t)tb * NEXP + e2) * 256 + s2_] = 2 * t + 1;
        p.gates[2 * t] = g1; p.gates[2 * t + 1] = g2;
    }
    __syncthreads();
    if (tid < NEXP) p.cntb[tb * NEXP + tid] = lcnt[tid];
    __syncthreads();
}
__device__ __forceinline__ void moe_tables(const Params& p, char* smc) {
    int tid = threadIdx.x; asm volatile("" : "+v"(tid));
    const int e = tid & 31, seg = tid >> 5;
    unsigned short* pre = (unsigned short*)(smc + LDS_PRE); int* tot = (int*)(smc + LDS_TOT); int* segtot = (int*)(smc + LDS_SEG);
    int c[16]; int run = 0;
#pragma unroll
    for (int i = 0; i < 16; ++i) c[i] = p.cntb[(16 * seg + i) * NEXP + e];
#pragma unroll
    for (int i = 0; i < 16; ++i) { const int v = c[i]; c[i] = run; run += v; }
    segtot[seg * 32 + e] = run;
    __syncthreads();
    int base = 0, all = 0;
#pragma unroll
    for (int s = 0; s < 16; ++s) { const int v = segtot[s * 32 + e]; base += (s < seg) ? v : 0; all += v; }
#pragma unroll
    for (int i = 0; i < 16; ++i) pre[e * 256 + 16 * seg + i] = (unsigned short)(base + c[i]);
    if (seg == 0) tot[e] = all;
    __syncthreads();
}

template <class PH> __device__ __forceinline__ void gemm_phase(const PH& ph, LAS unsigned char* shm, int vcu) {
#if defined(NOSTREAM)
    for (int u = vcu;; u += gridDim.x) { Unit<typename PH::EP> un; if (u >= PH::NU || !ph.unit(u, un)) break; gemm256(un, shm); }
#else
    gemm_stream(ph, shm, vcu, gridDim.x);
#endif
}

struct PhKVc { Params p; const float* tab; int pm; typedef EpiKV EP; static constexpr int NU = 4;
    __device__ __forceinline__ bool unit(int pn, Unit<EP>& o) const {
        o.am = AMap{p.zkv + (size_t)pm * 256 * 256, 256, nullptr, 256}; o.bt = p.WukvT + (size_t)pn * 256 * 256; o.K = 256;
        o.ep = EpiKV{p.Kn, p.Vt, tab, pm * 256, pm * 256, pn * 256}; return true; } };
struct PhZ2 { Params p; typedef EpiZ EP; static constexpr int NU = 128 * 2;
    __device__ __forceinline__ bool unit(int v, Unit<EP>& o) const { const int pm = v >> 1, pn = 5 + (v & 1);
        o.am = AMap{p.hbuf + (size_t)pm * 256 * DM, DM, nullptr, 256}; o.bt = p.WinT + (size_t)pn * 256 * DM; o.K = DM;
        o.ep = EpiZ{p.zu, p.zv, p.zq, p.zkv, p.krope, p.rope, pm * 256, pn * 256}; return true; } };
struct PhZ3 { Params p; typedef EpiZ EP; static constexpr int NU = 128 * 3;
    __device__ __forceinline__ bool unit(int v, Unit<EP>& o) const { const int pm = v / 3, pn = 4 + (v - pm * 3);
        o.am = AMap{p.hbuf + (size_t)pm * 256 * DM, DM, nullptr, 256}; o.bt = p.WinT + (size_t)pn * 256 * DM; o.K = DM;
        o.ep = EpiZ{p.zu, p.zv, p.zq, p.zkv, p.krope, p.rope, pm * 256, pn * 256}; return true; } };
struct PhQs { Params p; const float* tab; int u0, ustride; typedef EpiQ EP; static constexpr int NU = 128 * 3;
    __device__ __forceinline__ bool unit(int u, Unit<EP>& o) const { const int pm = u / 3, pn = u - pm * 3, slot = (u - u0) / ustride;
        o.am = AMap{p.zq + (size_t)pm * 256 * 384, 384, nullptr, 256}; o.bt = p.WuqT + (size_t)pn * 256 * 384; o.K = 384;
        o.ep = EpiQ{p.Q, tab + slot * 256, pm * 256, pm * 256, pn * 256}; return true; } };
struct PhKVs { Params p; const float* tab; int u0, ustride; typedef EpiKV EP; static constexpr int NU = 128 * 3 + 128 * 4;
    __device__ __forceinline__ bool unit(int u, Unit<EP>& o) const { const int v = u - 384, pm = v >> 2, pn = v & 3, slot = (u - u0) / ustride;
        o.am = AMap{p.zkv + (size_t)pm * 256 * 256, 256, nullptr, 256}; o.bt = p.WukvT + (size_t)pn * 256 * 256; o.K = 256;
        o.ep = EpiKV{p.Kn, p.Vt, tab + slot * 256, pm * 256, pm * 256, pn * 256}; return true; } };
struct PhHs { Params p; const int* tot; const int* aid_tab; int u0, ustride; typedef EpiH EP; static constexpr int NU = 288 * 2;
    __device__ __forceinline__ bool unit(int u, Unit<EP>& o) const { int e, rt, ct, pr; if (!moe_unit(tot, u, 2, e, rt, ct, pr)) return false;
        const int nv = __builtin_amdgcn_readfirstlane(min(256, tot[e] - rt * 256)), slot = (u - u0) / ustride;
        o.am = AMap{p.hbuf, DM, aid_tab + slot * 256, nv}; o.bt = p.WguT + ((size_t)e * 512 + ct * 256) * DM; o.K = DM;
        o.ep = EpiH{p.H, pr, ct * 256, MERGE67 != 0}; return true; }
    __device__ __forceinline__ void done(const Unit<EP>& cu, int wr) const {
        asm volatile("s_waitcnt vmcnt(0)" ::: "memory");
        if (wr == 0) __builtin_amdgcn_s_barrier();
        __builtin_amdgcn_s_barrier();
        if (threadIdx.x == 0) __hip_atomic_fetch_add(hready + (cu.ep.hrow0 >> 8), 1u, __ATOMIC_RELAXED, __HIP_MEMORY_SCOPE_AGENT);
        if (wr == 1) __builtin_amdgcn_s_barrier();
    }
    unsigned* hready; };
struct PhCs { Params p; const int* tot; unsigned* hready; int u0; unsigned* queue; volatile int* slot; typedef EpiC EP; static constexpr int NU = 288 * 4;
    __device__ __forceinline__ int take(bool stagger, int wr) const {
        if (stagger && wr == 0) __builtin_amdgcn_s_barrier();
        if (threadIdx.x == 0) slot[0] = (int)__hip_atomic_fetch_add(queue, 1u, __ATOMIC_RELAXED, __HIP_MEMORY_SCOPE_AGENT);
        __builtin_amdgcn_s_barrier();
        const int t = __builtin_amdgcn_readfirstlane(slot[0]);
        __builtin_amdgcn_s_barrier();
        if (stagger && wr == 1) __builtin_amdgcn_s_barrier();
        return t;
    }
    __device__ __forceinline__ int next(int wr) const { return take(true, wr); }
    __device__ __forceinline__ bool unit(int u, Unit<EP>& o) const { int e, rt, ct, pr; if (!moe_unit(tot, u, 4, e, rt, ct, pr)) return false;
        const int wr = __builtin_amdgcn_readfirstlane((int)threadIdx.x >> 8);
        if (u != u0 && wr == 0) __builtin_amdgcn_s_barrier();
        if (threadIdx.x == 0) { unsigned sp = 0; unsigned* w = hready + (pr >> 8);
            while (__hip_atomic_load(w, __ATOMIC_RELAXED, __HIP_MEMORY_SCOPE_AGENT) < 2u) { __builtin_amdgcn_s_sleep(2); if (++sp > (1u << 20)) break; }
            __builtin_amdgcn_fence(__ATOMIC_ACQUIRE, "agent");
            asm volatile("s_waitcnt vmcnt(0)" ::: "memory"); }
        __builtin_amdgcn_s_barrier();
        if (u != u0 && wr == 1) __builtin_amdgcn_s_barrier();
        const int nv = __builtin_amdgcn_readfirstlane(min(256, tot[e] - rt * 256));
        o.am = AMap{p.H + (size_t)pr * FF, FF, nullptr, 256}; o.bt = p.WdT + ((size_t)e * DM + ct * 256) * FF; o.K = FF;
        o.ep = EpiC{p.contrib, p.list + (size_t)e * LIST_CAP + rt * 256, p.gates, nv, ct * 256}; return true; } };


struct PhZj { Params p; int u0; unsigned* cnt; typedef EpiZ EP; static constexpr int NU = 128 * 7;
    __device__ __forceinline__ void chunk(int u) const {
        int tid = threadIdx.x; asm volatile("" : "+v"(tid));
        const int wid = __builtin_amdgcn_readfirstlane(tid >> 6), lane = tid & 63;
        const int pm = u / 7, pn = u - pm * 7, r0 = pm * 256 + pn * 36 + (pn < 4 ? pn : 4), n = pn < 4 ? 37 : 36;
        ln0_row4<true>(p.x + (size_t)(r0 + wid) * DM, (size_t)8 * DM, p.ln0_g, p.ln0_b, p.hbuf + (size_t)(r0 + wid) * DM, lane);
        if (32 + wid < n) ln0_row1_wt(p.x + (size_t)(r0 + 32 + wid) * DM, p.ln0_g, p.ln0_b, p.hbuf + (size_t)(r0 + 32 + wid) * DM, lane);
        asm volatile("s_waitcnt vmcnt(0)" ::: "memory");
        __syncthreads();
        if (tid == 0) {
            __hip_atomic_fetch_add(cnt + pm, 1u, __ATOMIC_RELAXED, __HIP_MEMORY_SCOPE_AGENT);
            unsigned sp = 0;
            while (__hip_atomic_load(cnt + pm, __ATOMIC_RELAXED, __HIP_MEMORY_SCOPE_AGENT) < 7u) { __builtin_amdgcn_s_sleep(2); if (++sp > (1u << 18)) break; }
            __builtin_amdgcn_fence(__ATOMIC_ACQUIRE, "agent");
            asm volatile("s_waitcnt vmcnt(0)" ::: "memory");
        }
        __syncthreads();
    }
    __device__ __forceinline__ bool unit(int u, Unit<EP>& o) const {
        if (u != u0) {
            const int wr = __builtin_amdgcn_readfirstlane((int)threadIdx.x >> 8);
            if (wr == 0) __builtin_amdgcn_s_barrier();
            chunk(u);
            if (wr == 1) __builtin_amdgcn_s_barrier();
        }
        const int pm = u / 7, pn = u - pm * 7;
        o.am = AMap{p.hbuf + (size_t)pm * 256 * DM, DM, nullptr, 256}; o.bt = p.WinT + (size_t)pn * 256 * DM; o.K = DM;
        o.ep = EpiZ{p.zu, p.zv, p.zq, p.zkv, p.krope, p.rope, pm * 256, pn * 256}; return true; } };

typedef const __attribute__((address_space(4))) Params* KParams;
__device__ __forceinline__ Params ldp() {
#if defined(__HIP_DEVICE_COMPILE__)
    KParams q = (KParams)__builtin_amdgcn_kernarg_segment_ptr(); asm volatile("" : "+s"(q)); return *q;
#else
    return Params{};
#endif
}
template <int LO, int HI>
__global__ __launch_bounds__(512, 2) void mega(Params p_arg_unused) {
    extern __shared__ __attribute__((aligned(16))) unsigned char lds_raw[];
    LAS unsigned char* shm = (LAS unsigned char*)lds_raw;
    char* smc = (char*)lds_raw;
    const int nblk = gridDim.x;
    const int vcu = (nblk % 8 == 0) ? (int)(blockIdx.x % 8) * (nblk / 8) + (int)(blockIdx.x / 8) : (int)blockIdx.x;
    #define PHASE_IDS int tid = threadIdx.x; asm volatile("" : "+v"(tid)); const int wid = __builtin_amdgcn_readfirstlane(tid >> 6), lane = tid & 63; (void)wid; (void)lane
    XcdBarrier xb;
    if (LO != HI) {
        if (threadIdx.x == 0) { ((volatile LAS unsigned*)(smc + LDS_XB))[0] = 0u; ((volatile LAS unsigned*)(smc + LDS_XB))[1] = 0u; }
        __syncthreads();
        { const Params p = ldp(); xb = xcd_barrier_post(p.bar, (volatile LAS unsigned*)(smc + LDS_XB)); }
    }
#ifndef TIMEPH
#define TIMEPH -1
#endif
    unsigned long long ts0_ = 0, ts1_ = 0;
    #define TSTAMP(k) do { if (TIMEPH >= 0) { if ((k) == TIMEPH) ts0_ = __builtin_amdgcn_s_memrealtime(); if ((k) == TIMEPH + 1) ts1_ = __builtin_amdgcn_s_memrealtime(); } } while (0)
    #define SEAM(ph) do { if (LO <= (ph) && HI > (ph)) xcd_barrier(xb); TSTAMP((ph) + 1); } while (0)
    TSTAMP(0);
#ifndef REPMASK
#define REPMASK 0
#endif
    #define NREP(k) ((((REPMASK) >> (k)) & 1) ? 2 : 1)
    #define REPEAT(k) for (int rep_ = 0; rep_ < NREP(k); ++rep_, (rep_ < NREP(k) ? xcd_barrier(xb) : (void)0))
    if (LO <= 0 && HI >= 0) REPEAT(0) {
        const Params p = ldp(); PHASE_IDS;
        { float* scr = (float*)(smc + wid * (64 * 33 * 4)); const int gw = blockIdx.x * 8 + wid, ngw = nblk * 8;
#ifndef P0REP
#define P0REP 0
#endif
          for (int rep = 0; rep < ((P0REP & 1) ? 2 : 1); ++rep)
          for (int it = gw; it < I_EARLY; it += ngw) prep_witem(p, it, scr, lane);
#if !JIT_LN0
          for (int t = gw; t < T_TOK / 4; t += ngw) ln0_row4<false>(p.x + (size_t)t * DM, (size_t)(T_TOK / 4) * DM, p.ln0_g, p.ln0_b, p.hbuf + (size_t)t * DM, lane);
#endif
          }
        for (int rep = 0; rep < ((P0REP & 4) ? 2 : 1); ++rep)
        { const int i0 = blockIdx.x * NTHR + tid; const float inv = powf(10000.f, -(float)(2 * (i0 & 31)) / 64.f);
          for (int i = i0; i < T_TOK * 32; i += nblk * NTHR) { const float ang = (float)p.pos[i >> 5] * inv; p.rope[i] = make_float2(cosf(ang), sinf(ang)); } }
        for (int i = blockIdx.x * NTHR + tid; i < 36 * 1024; i += nblk * NTHR) { const int o = i >> 10, k = i & 1023; const float w = o < 4 ? p.w_rg[k * 4 + o] : p.w_re[k * 32 + (o - 4)];
            const bf16_t hi = f2bf(w); p.WrT[i] = hi; p.WrT[36864 + i] = f2bf(w - bf2f(hi)); }
    }
    SEAM(0);
    if (LO <= 1 && HI >= 1) REPEAT(1) {
#if GMLP_FUSED && KVCHAIN
        { { const Params p = ldp(); gemm_stream(PhZ2{p}, shm, vcu, nblk); }
          for (;;) {
              int t;
              { const Params p = ldp(); PHASE_IDS; volatile int* slot = (volatile int*)(smc + LDS_AID);
                if (tid == 0) slot[0] = (int)__hip_atomic_fetch_add(p.bar + 3584, 1u, __ATOMIC_RELAXED, __HIP_MEMORY_SCOPE_AGENT);
                __syncthreads();
                t = __builtin_amdgcn_readfirstlane(slot[0]);
                __syncthreads(); }
              if (t >= 128 + 512 + 128) break;
              if (t < 128) { const Params p = ldp(); const int pm = t; float* tab = (float*)(smc + LDS_PRE);
                  Unit<EpiZ> un; un.am = AMap{p.hbuf + (size_t)pm * 256 * DM, DM, nullptr, 256}; un.bt = p.WinT + (size_t)4 * 256 * DM; un.K = DM; un.ep = EpiZ{p.zu, p.zv, p.zq, p.zkv, p.krope, p.rope, pm * 256, 4 * 256};
                  const KvArgs kv{p.zkv, tab, pm * 256};
                  gemm256<EpiZ, 2>(un, shm, nullptr, &kv);
                  gemm_stream(PhKVc{p, tab, pm}, shm, 0, 1);
              } else if (t < 128 + 512) { const Params p = ldp(); const int w = t - 128, pm = w >> 2, h = w & 3;
                  Unit<EpiZ> un; un.am = AMap{p.hbuf + (size_t)pm * 256 * DM, DM, nullptr, 256}; un.bt = p.WinT + (size_t)h * 256 * DM; un.K = DM; un.ep = EpiZ{p.zu, p.zv, p.zq, p.zkv, p.krope, p.rope, pm * 256, h * 256};
                  const GmArgs gm{p.gm_g, p.gm_b, p.w_sp, p.b_sp, p.mix, pm * 256, h};
                  gemm256<EpiZ, 1>(un, shm, &gm);
              } else { const Params p = ldp(); PHASE_IDS; const int ch = t - 640; float* scr = (float*)(smc + wid * (64 * 33 * 4));
                  for (int k = wid; k < 96; k += 8) prep_witem(p, I_EARLY + ch * 96 + k, scr, lane);
                  __syncthreads(); }
          } }
#elif GMLP_FUSED
        { const Params p = ldp(); PHASE_IDS;
          gemm_stream(PhZ3{p}, shm, vcu, nblk);
          if (PhZ3::NU % nblk != 0 && vcu >= PhZ3::NU % nblk) { float* scr = (float*)(smc + wid * (64 * 33 * 4)); const int nlate = nblk - (PhZ3::NU % nblk), gw = (vcu - PhZ3::NU % nblk) * 8 + wid, ngw = nlate * 8;
              for (int it = I_EARLY + gw; it < I_TOTAL; it += ngw) prep_witem(p, it, scr, lane); }
          else if (PhZ3::NU % nblk == 0) { float* scr = (float*)(smc + wid * (64 * 33 * 4)); for (int it = I_EARLY + vcu * 8 + wid; it < I_TOTAL; it += nblk * 8) prep_witem(p, it, scr, lane); }
          __syncthreads();
          for (int w = vcu; w < 512; w += nblk) { const int pm = w >> 2, h = w & 3;
              Unit<EpiZ> un; un.am = AMap{p.hbuf + (size_t)pm * 256 * DM, DM, nullptr, 256}; un.bt = p.WinT + (size_t)h * 256 * DM; un.K = DM; un.ep = EpiZ{p.zu, p.zv, p.zq, p.zkv, p.krope, p.rope, pm * 256, h * 256};
              const GmArgs gm{p.gm_g, p.gm_b, p.w_sp, p.b_sp, p.mix, pm * 256, h};
              gemm256<EpiZ, 1>(un, shm, &gm); } }
#else
#if JIT_LN0
        { const Params p = ldp(); PhZj ph{p, vcu, p.bar + 3520}; ph.chunk(vcu); gemm_stream(ph, shm, vcu, nblk); }
#else
        gemm_phase(PhZ{ldp()}, shm, vcu);
#endif
        { const Params p = ldp(); PHASE_IDS; const int nlate = nblk - (PhZ::NU % nblk);
          if (PhZ::NU % nblk != 0 && vcu >= PhZ::NU % nblk) { float* scr = (float*)(smc + wid * (64 * 33 * 4)); const int gw = (vcu - PhZ::NU % nblk) * 8 + wid, ngw = nlate * 8;
              for (int it = I_EARLY + gw; it < I_TOTAL; it += ngw) prep_witem(p, it, scr, lane); }
          else if (PhZ::NU % nblk == 0) { float* scr = (float*)(smc + wid * (64 * 33 * 4)); for (int it = I_EARLY + vcu * 8 + wid; it < I_TOTAL; it += nblk * 8) prep_witem(p, it, scr, lane); } }
#endif
    }
    SEAM(1);
    if (LO <= 2 && HI >= 2) REPEAT(2) {
        const Params p = ldp();
        float* tab = (float*)(smc + LDS_PRE);
#if KVCHAIN
        { int slot = 0;
          for (int u = vcu; u < PhQs::NU; u += nblk, ++slot) rs_table<384>(p.zq + (size_t)(u / 3) * 256 * 384, tab + slot * 256); }
        __syncthreads();
        gemm_stream(PhQs{p, tab, vcu, nblk}, shm, vcu, nblk);
#else
        { int slot = 0;
          for (int u = vcu; u < PhKVs::NU; u += nblk, ++slot) {
              if (u < PhQs::NU) rs_table<384>(p.zq + (size_t)(u / 3) * 256 * 384, tab + slot * 256); else rs_table<256>(p.zkv + (size_t)((u - 384) >> 2) * 256 * 256, tab + slot * 256); } }
        __syncthreads();
        gemm_stream(PhQs{p, tab, vcu, nblk}, shm, vcu, nblk);
        { const int i0 = vcu >= PhQs::NU ? 0 : (PhQs::NU - vcu + nblk - 1) / nblk; gemm_stream(PhKVs{p, tab, vcu, nblk}, shm, vcu + i0 * nblk, nblk); }
#endif
#if !GMLP_FUSED
        gmlp_phase(p, smc, vcu);
#endif
    }
    SEAM(2);
    if (LO <= 3 && HI >= 3) REPEAT(3) {
        const Params p = ldp();
#ifndef ATTPROBE
#define ATTPROBE 0
#endif
        for (int u = vcu; u < 256; u += nblk) { const int bh = u >> 2, pr = u & 3; attn_block<0>(p, smc, bh, 7 - pr, p.mix); attn_block<0>(p, smc, bh, pr, p.mix); }
    }
    SEAM(3);
    if (LO <= 4 && HI >= 4) {
#if XPROBE > 0
        gemm_phase(PhYp<XPROBE>{ldp()}, shm, vcu); xcd_barrier(xb);
#endif
#ifndef WARM4
#define WARM4 0
#endif
        if (WARM4) { const Params p = ldp(); PHASE_IDS;
            for (int u = vcu; u < 512; u += nblk) { const char* a = (const char*)(p.mix + (size_t)(u >> 2) * 256 * DM); unsigned acc_ = 0;
#pragma unroll
                for (int i = 0; i < 8; ++i) acc_ += *(const unsigned*)(a + ((size_t)(i * 512 + tid) << 7));
                asm volatile("" :: "v"(acc_)); } }
        gemm_phase(PhY{ldp()}, shm, vcu);
    }
    SEAM(4);
    if (LO <= 5 && HI >= 5) {
        const Params p = ldp();
        for (int tb = blockIdx.x; tb < T_TOK / 128; tb += nblk) router_tile(p, smc, tb);
    }
    SEAM(5);
    if (LO <= 6 && HI >= 6) REPEAT(6) {
        const Params p = ldp(); PHASE_IDS;
        moe_tables(p, smc);
        const int* tot = (const int*)(smc + LDS_TOT); int* aid_tab = (int*)(smc + LDS_AID); const unsigned short* pre = (const unsigned short*)(smc + LDS_PRE);
        if (blockIdx.x == 0 && tid < NEXP) p.cnt[tid] = tot[tid];
        { int slot = 0;
          for (int u = vcu; slot < 3; u += nblk, ++slot) {
              int e, rt, ct, pr; if (!moe_unit(tot, u, 2, e, rt, ct, pr)) break;
              const int te = tot[e];
              if (tid < 256) { const int g = rt * 256 + tid; int aid = 0;
                  if (g < te) { int lo = 0, hi = 256;
#pragma unroll
                      for (int it = 0; it < 8; ++it) { const int mid = (lo + hi) >> 1; if ((int)pre[e * 256 + mid] <= g) lo = mid; else hi = mid; }
                      aid = p.listb[((size_t)lo * NEXP + e) * 256 + (g - (int)pre[e * 256 + lo])];
                      if (ct == 0) { if (MERGE67) __hip_atomic_store(p.list + (size_t)e * LIST_CAP + g, aid, __ATOMIC_RELAXED, __HIP_MEMORY_SCOPE_AGENT); else p.list[(size_t)e * LIST_CAP + g] = aid; } }
                  aid_tab[slot * 256 + tid] = aid; } } }
        __syncthreads();
        gemm_stream(PhHs{p, tot, aid_tab, vcu, nblk, p.bar + 3712}, shm, vcu, nblk);
#if MERGE67
        { PhCs pc{p, tot, p.bar + 3712, 0, p.bar + 3648, (volatile int*)(smc + LDS_AID)}; pc.u0 = pc.take(false, 0); gemm_stream(pc, shm, pc.u0, nblk); }
#endif
    }
#if !MERGE67
    SEAM(6);
#else
    TSTAMP(7);
#endif
    if (!MERGE67 && LO <= 7 && HI >= 7) REPEAT(7) {
        Params p = ldp(); PHASE_IDS;
        int* tot = (int*)(smc + LDS_TOT);
        if (tid < NEXP) tot[tid] = p.cnt[tid];
        __syncthreads();
        p.cnt = tot;
        gemm_phase(PhC{p}, shm, vcu);
    }
    SEAM(7);
#ifndef WPROBE
#define WPROBE 0
#endif
    if (WPROBE > 0 && LO <= 8 && HI >= 8 && LO != HI) {
        const Params p = ldp(); PHASE_IDS;
        const int wr = wid >> 2, wc = wid & 3, fr = lane & 15, fq = lane >> 4;
        for (int u = vcu; u < 512; u += nblk) { const int pm = u >> 2, pn = u & 3;
            bf16_t* base = p.mix + (size_t)pm * 256 * DM + pn * 256;
#pragma unroll
            for (int ai = 0; ai < 2; ++ai)
#pragma unroll
                for (int m = 0; m < 4; ++m) { bf16_t* rowp = base + (size_t)(ai * 128 + wr * 64 + m * 16 + fr) * DM;
                    if (WPROBE == 1) { const u32x2 z = {0u, 0u};
                        *(u32x2*)(rowp + wc * 32 + 4 * fq) = z; *(u32x2*)(rowp + wc * 32 + 16 + 4 * fq) = z; *(u32x2*)(rowp + 128 + wc * 32 + 4 * fq) = z; *(u32x2*)(rowp + 128 + wc * 32 + 16 + 4 * fq) = z; }
                    else { const u32x4 z = {0u, 0u, 0u, 0u}; *(u32x4*)(rowp + wc * 64 + 16 * fq) = z; *(u32x4*)(rowp + wc * 64 + 16 * fq + 8) = z; } } }
        xcd_barrier(xb);
    }
    if (LO <= 8 && HI >= 8) REPEAT(8) { const Params p = ldp(); PHASE_IDS; for (int t = blockIdx.x * 8 + wid; t < T_TOK; t += nblk * 8) final_token(p, t, lane); }
    if (TIMEPH >= 0 && LO != HI) {
        xcd_barrier(xb); TSTAMP(9);
        if (blockIdx.x == 0 && threadIdx.x < 64) { const Params p = ldp(); const float dv = (float)(ts1_ - ts0_) * 6.0e-5f; for (int i = threadIdx.x; i < 4096; i += 64) p.out[i] = dv; }
    }
    #undef SEAM
}

#if ATTPROBE > 0
__global__ __launch_bounds__(512, 2) void attn_probe_kernel(Params p) {
    extern __shared__ __attribute__((aligned(16))) unsigned char lds_raw[];
    char* smc = (char*)lds_raw; const int nblk = gridDim.x;
    const int vcu = (nblk % 8 == 0) ? (int)(blockIdx.x % 8) * (nblk / 8) + (int)(blockIdx.x / 8) : (int)blockIdx.x;
    for (int u = vcu; u < 256; u += nblk) { const int bh = u >> 2, pr = u & 3; attn_block<ATTPROBE>(p, smc, bh, 7 - pr, (bf16_t*)p.out); attn_block<ATTPROBE>(p, smc, bh, pr, (bf16_t*)p.out); }
}
#endif
#ifndef MODE
#ifndef MODE
#define MODE 1
#endif
#endif
#ifndef FASTMASK
#define FASTMASK 0x1ff
#endif
static size_t carve(size_t& off, size_t bytes) { const size_t o = off; off += (bytes + 255) & ~(size_t)255; return o; }
#ifndef DUPMASK
#define DUPMASK 0
#endif
template <int PH> static void launch_fast(const Params& p, int grid, hipStream_t stream) { hipLaunchKernelGGL((mega<PH, PH>), dim3(grid), dim3(NTHR), LDS_BYTES, stream, p);
    if ((DUPMASK >> PH) & 1) hipLaunchKernelGGL((mega<PH, PH>), dim3(grid), dim3(NTHR), LDS_BYTES, stream, p); }
extern "C" void kernel_launch(void* const* d_in, const int* in_sizes, int n_in, void* d_out, int out_size, void* d_ws, size_t ws_size, hipStream_t stream) {
    Params p{};
    p.x = (const float*)d_in[0]; p.pos = (const int*)d_in[1]; p.ln0_g = (const float*)d_in[2]; p.ln0_b = (const float*)d_in[3]; p.w_in = (const float*)d_in[4];
    p.gm_g = (const float*)d_in[5]; p.gm_b = (const float*)d_in[6]; p.w_sp = (const float*)d_in[7]; p.b_sp = (const float*)d_in[8]; p.qn_g = (const float*)d_in[9];
    p.w_uq = (const float*)d_in[10]; p.kvn_g = (const float*)d_in[11]; p.w_ukv = (const float*)d_in[12]; p.w_out = (const float*)d_in[13]; p.ln1_g = (const float*)d_in[14];
    p.ln1_b = (const float*)d_in[15]; p.w_rg = (const float*)d_in[16]; p.b_rg = (const float*)d_in[17]; p.w_re = (const float*)d_in[18]; p.b_re = (const float*)d_in[19];
    p.w_gate = (const float*)d_in[20]; p.w_up = (const float*)d_in[21]; p.w_down = (const float*)d_in[22]; p.ln2_g = (const float*)d_in[23]; p.ln2_b = (const float*)d_in[24];
    p.out = (float*)d_out;
    char* ws = (char*)d_ws; size_t off = 0;
    p.bar = (unsigned*)(ws + carve(off, 16384));
    p.cnt = (int*)(ws + carve(off, 1024));
    p.WinT = (bf16_t*)(ws + carve(off, (size_t)ZN * 1024 * 2)); p.WuqT = (bf16_t*)(ws + carve(off, 768 * 384 * 2)); p.WukvT = (bf16_t*)(ws + carve(off, 1024 * 256 * 2));
    p.WoutT = (bf16_t*)(ws + carve(off, 1024 * 1024 * 2)); p.WguT = (bf16_t*)(ws + carve(off, (size_t)32 * 512 * 1024 * 2)); p.WdT = (bf16_t*)(ws + carve(off, (size_t)32 * 1024 * 256 * 2));
    p.hbuf = (bf16_t*)(ws + carve(off, (size_t)T_TOK * DM * 2)); p.rope = (float2*)(ws + carve(off, (size_t)T_TOK * 32 * 8));
    p.list = (int*)(ws + carve(off, (size_t)NEXP * LIST_CAP * 4)); p.gates = (float*)(ws + carve(off, (size_t)T_TOK * 2 * 4));
    p.WrT = (bf16_t*)(ws + carve(off, 2 * 36 * 1024 * 2)); p.cntb = (int*)(ws + carve(off, 256 * NEXP * 4)); p.listb = (int*)(ws + carve(off, (size_t)256 * NEXP * 256 * 4));
    p.rsq = (float*)(ws + carve(off, T_TOK * 4)); p.rskv = (float*)(ws + carve(off, T_TOK * 4));
    const size_t stage0 = off;
    p.zu = (bf16_t*)(ws + carve(off, (size_t)T_TOK * 512 * 2)); p.zv = (bf16_t*)(ws + carve(off, (size_t)T_TOK * 512 * 2));
    p.zq = (bf16_t*)(ws + carve(off, (size_t)T_TOK * 384 * 2)); p.zkv = (bf16_t*)(ws + carve(off, (size_t)T_TOK * 256 * 2)); p.krope = (bf16_t*)(ws + carve(off, (size_t)T_TOK * 64 * 2));
    p.Q = (bf16_t*)(ws + carve(off, (size_t)T_TOK * 768 * 2)); p.Kn = (bf16_t*)(ws + carve(off, (size_t)T_TOK * 512 * 2)); p.Vt = (bf16_t*)(ws + carve(off, (size_t)T_TOK * 512 * 2));
    p.mix = (bf16_t*)(ws + carve(off, (size_t)T_TOK * DM * 2));
    const size_t stage_end = off;
    size_t o2 = stage0; p.contrib = (bf16_t*)(ws + carve(o2, (size_t)T_TOK * 2 * DM * 2)); p.H = (bf16_t*)(ws + carve(o2, (size_t)(65536 + 8192) * FF * 2));
    if (o2 > stage_end || stage_end > ws_size) { fprintf(stderr, "kernel_launch: workspace too small (%zu needed, %zu given)\n", stage_end, ws_size); return; }

    static int grid = 0;
    if (!grid) {
        int dev = 0, cus = 0; (void)hipGetDevice(&dev); (void)hipDeviceGetAttribute(&cus, hipDeviceAttributeMultiprocessorCount, dev);
        grid = cus > 0 ? (cus / 8) * 8 : 256;
        (void)hipFuncSetAttribute((const void*)nk_gmlp, hipFuncAttributeMaxDynamicSharedMemorySize, 128 * 129 * 4);
        (void)hipFuncSetAttribute((const void*)nk_attn, hipFuncAttributeMaxDynamicSharedMemorySize, (64 * 192 + 64 * 193 + 64 * 65 + 64 * 128) * 4);
        (void)hipFuncSetAttribute((const void*)mega<0, 8>, hipFuncAttributeMaxDynamicSharedMemorySize, LDS_BYTES);
#if MODE == 2
        (void)hipFuncSetAttribute((const void*)mega<0, 0>, hipFuncAttributeMaxDynamicSharedMemorySize, LDS_BYTES);
        (void)hipFuncSetAttribute((const void*)mega<1, 1>, hipFuncAttributeMaxDynamicSharedMemorySize, LDS_BYTES);
        (void)hipFuncSetAttribute((const void*)mega<2, 2>, hipFuncAttributeMaxDynamicSharedMemorySize, LDS_BYTES);
        (void)hipFuncSetAttribute((const void*)mega<3, 3>, hipFuncAttributeMaxDynamicSharedMemorySize, LDS_BYTES);
        (void)hipFuncSetAttribute((const void*)mega<4, 4>, hipFuncAttributeMaxDynamicSharedMemorySize, LDS_BYTES);
        (void)hipFuncSetAttribute((const void*)mega<5, 5>, hipFuncAttributeMaxDynamicSharedMemorySize, LDS_BYTES);
        (void)hipFuncSetAttribute((const void*)mega<6, 6>, hipFuncAttributeMaxDynamicSharedMemorySize, LDS_BYTES);
        (void)hipFuncSetAttribute((const void*)mega<7, 7>, hipFuncAttributeMaxDynamicSharedMemorySize, LDS_BYTES);
        (void)hipFuncSetAttribute((const void*)mega<8, 8>, hipFuncAttributeMaxDynamicSharedMemorySize, LDS_BYTES);
#endif
    }
#if MODE == 1
    (void)hipMemsetAsync(p.bar, 0, 16384, stream);
    hipLaunchKernelGGL((mega<0, 8>), dim3(grid), dim3(NTHR), LDS_BYTES, stream, p);
#else
    const unsigned fm = (MODE == 2) ? (unsigned)(FASTMASK) : 0u;
    if (fm & 1) launch_fast<0>(p, grid, stream); else { nk_prep_w<<<J_TOTAL, 256, 0, stream>>>(p); nk_ln0<<<T_TOK / 4, 256, 0, stream>>>(p); nk_rope<<<T_TOK * 32 / 256, 256, 0, stream>>>(p); }
    if (fm & 2) launch_fast<1>(p, grid, stream); else nk_gemm<PhZ><<<dim3(PhZ::NU, 32), 256, 0, stream>>>(PhZ{p});
#if defined(P2VAR) && P2VAR == 1
    launch_fast<2>(p, grid, stream); nk_gmlp<<<T_TOK / 128 * 4, 256, 128 * 129 * 4, stream>>>(p);
#elif defined(P2VAR) && P2VAR == 2
    nk_rowscale<<<T_TOK / 4, 256, 0, stream>>>(p); nk_gemm<PhQ><<<dim3(PhQ::NU, 32), 256, 0, stream>>>(PhQ{p, p.rsq});
    nk_gemm<PhKV><<<dim3(PhKV::NU, 32), 256, 0, stream>>>(PhKV{p, p.rskv}); launch_fast<2>(p, grid, stream);
#else
    if (fm & 4) launch_fast<2>(p, grid, stream); else { nk_rowscale<<<T_TOK / 4, 256, 0, stream>>>(p); nk_gemm<PhQ><<<dim3(PhQ::NU, 32), 256, 0, stream>>>(PhQ{p, p.rsq});
        nk_gemm<PhKV><<<dim3(PhKV::NU, 32), 256, 0, stream>>>(PhKV{p, p.rskv}); nk_gmlp<<<T_TOK / 128 * 4, 256, 128 * 129 * 4, stream>>>(p); }
#endif
#if ATTPROBE > 0
    { static bool a2 = false; if (!a2) { a2 = true; (void)hipFuncSetAttribute((const void*)attn_probe_kernel, hipFuncAttributeMaxDynamicSharedMemorySize, LDS_BYTES); }
      hipLaunchKernelGGL(attn_probe_kernel, dim3(grid), dim3(NTHR), LDS_BYTES, stream, p); }
#endif
    if (fm & 8) launch_fast<3>(p, grid, stream); else nk_attn<<<64 * 32, 256, (64 * 192 + 64 * 193 + 64 * 65 + 64 * 128) * 4, stream>>>(p);
    if (fm & 16) launch_fast<4>(p, grid, stream); else nk_gemm<PhY><<<dim3(PhY::NU, 32), 256, 0, stream>>>(PhY{p});
    if (fm & 32) launch_fast<5>(p, grid, stream); else { nk_router_prep<<<144, 256, 0, stream>>>(p); nk_router<<<T_TOK / 4, 256, 0, stream>>>(p); }
    if (fm & 64) launch_fast<6>(p, grid, stream); else nk_gemm<PhH><<<dim3(PhH::NU, 32), 256, 0, stream>>>(PhH{p});
    if (fm & 128) launch_fast<7>(p, grid, stream); else nk_gemm<PhC><<<dim3(PhC::NU, 32), 256, 0, stream>>>(PhC{p});
    if (fm & 256) launch_fast<8>(p, grid, stream); else nk_final<<<T_TOK / 4, 256, 0, stream>>>(p);
#endif
}
```

```cpp
#include <hip/hip_runtime.h>
#define P2VAR 0
#define REPMASK 0x0
#define DUPMASK 0x0
#define TIMEPH -1
#define KREP 1
#define XPROBE 0
#define P0REP 0
#define WPROBE 0
#define ATTPROBE 0
#define JIT_LN0 0
#define MERGE67 1
#define GMLP_FUSED 1
#define ZLAYOUT2 1
#define KVCHAIN 0
#define YSTAT 1
#include <stdint.h>
#include <cstdio>

#define LAS __attribute__((address_space(3)))
typedef unsigned short bf16_t;
typedef short bf16x8 __attribute__((ext_vector_type(8)));
typedef float f32x4 __attribute__((ext_vector_type(4)));
typedef float f32x16 __attribute__((ext_vector_type(16)));
typedef unsigned u32x2 __attribute__((ext_vector_type(2)));
typedef unsigned u32x4 __attribute__((ext_vector_type(4)));

constexpr int T_TOK = 32768, DM = 1024, SEQ = 2048, NBATCH = 16;
constexpr int ZN = 1792;
constexpr int NEXP = 32, FF = 256;
constexpr int LIST_CAP = 32768;
constexpr float ALPHA = 1.189207115002721f;
constexpr float QSCALE = 0.07216878364870322f * 1.4426950408889634f;

struct Params {
    const float* x; const int* pos; const float *ln0_g, *ln0_b, *w_in, *gm_g, *gm_b, *w_sp, *b_sp, *qn_g, *w_uq, *kvn_g, *w_ukv, *w_out, *ln1_g, *ln1_b,
        *w_rg, *b_rg, *w_re, *b_re, *w_gate, *w_up, *w_down, *ln2_g, *ln2_b;
    float* out;
    bf16_t *WinT, *WuqT, *WukvT, *WoutT, *WguT, *WdT;
    bf16_t* hbuf; float2* rope;
    bf16_t *zu, *zv, *zq, *zkv, *krope, *Q, *Kn, *Vt, *mix;
    float *rsq, *rskv;
    int* cnt; int* list; float* gates; bf16_t* H; bf16_t* contrib;
    float* ystat;
    bf16_t* WrT; int* cntb; int* listb;
    unsigned* bar;
};

__device__ __forceinline__ unsigned pk2(float lo, float hi) { unsigned r; asm volatile("v_cvt_pk_bf16_f32 %0, %1, %2" : "=v"(r) : "v"(lo), "v"(hi)); return r; }
__device__ __forceinline__ bf16_t f2bf(float f) { return (bf16_t)(pk2(f, 0.f) & 0xffffu); }
__device__ __forceinline__ float bf2f(bf16_t h) { return __uint_as_float(((unsigned)h) << 16); }
__device__ __forceinline__ float bflo(unsigned u) { return __uint_as_float(u << 16); }
__device__ __forceinline__ float bfhi(unsigned u) { return __uint_as_float(u & 0xffff0000u); }
__device__ __forceinline__ void st4(bf16_t* p, f32x4 v) { u32x2 w; w.x = pk2(v[0], v[1]); w.y = pk2(v[2], v[3]); *(u32x2*)p = w; }
__device__ __forceinline__ void st4wt(bf16_t* p, f32x4 v) { const unsigned lo = pk2(v[0], v[1]), hi = pk2(v[2], v[3]);
    __hip_atomic_store((unsigned long long*)p, ((unsigned long long)hi << 32) | lo, __ATOMIC_RELAXED, __HIP_MEMORY_SCOPE_AGENT); }
__device__ __forceinline__ float shx(float v, int mask) { int l = threadIdx.x; asm volatile("" : "+v"(l)); const int idx = ((l ^ mask) & 63) << 2; return __int_as_float(__builtin_amdgcn_ds_bpermute(idx, __float_as_int(v))); }
__device__ __forceinline__ float wave_sum(float v) {
#pragma unroll
    for (int o = 1; o < 64; o <<= 1) v += shx(v, o);
    return v;
}
__device__ __forceinline__ float gelu_tanh(float x) {
    const float u = x + 0.044715f * x * x * x;
    const float e = __builtin_amdgcn_exp2f(-2.f * 0.7978845608028654f * 1.4426950408889634f * u);
    return x * __builtin_amdgcn_rcpf(1.f + e);
}
__device__ __forceinline__ float silu_f(float x) { return x * __builtin_amdgcn_rcpf(1.f + __builtin_amdgcn_exp2f(-1.4426950408889634f * x)); }
__device__ __forceinline__ int perm16(int k) { return 8 * ((k >> 2) & 1) + (k & 3) + 4 * (k >> 3); }

struct AMap {
    const bf16_t* base; int ld; const int* list; int nvalid;
    __device__ __forceinline__ const bf16_t* row(int r) const {
        if (list) { const int a = list[r < nvalid ? r : 0]; return base + (size_t)(a >> 1) * ld; }
        return base + (size_t)r * ld;
    }
};

struct EpiZ {
    bf16_t *zu, *zv, *zq, *zkv, *krope; const float2* rope; int row0, col0;
    __device__ __forceinline__ void rope_store(int row, int c, f32x4 v, float2 cs0, float2 cs1) const {
        const int i0 = (c - 1664) >> 1; bf16_t* kr = krope + (size_t)row * 64;
        kr[i0] = f2bf(v[0] * cs0.x - v[1] * cs0.y); kr[i0 + 32] = f2bf(v[1] * cs0.x + v[0] * cs0.y);
        kr[i0 + 1] = f2bf(v[2] * cs1.x - v[3] * cs1.y); kr[i0 + 33] = f2bf(v[3] * cs1.x + v[2] * cs1.y);
    }
    __device__ __forceinline__ void plain(int row, int c, f32x4 v) const {
        if (c < 1024) {
            f32x4 g; g[0] = gelu_tanh(v[0]); g[1] = gelu_tanh(v[1]); g[2] = gelu_tanh(v[2]); g[3] = gelu_tanh(v[3]);
            if (c < 512) st4(zu + (size_t)row * 512 + c, g); else st4(zv + (size_t)row * 512 + (c - 512), g);
        }
#if ZLAYOUT2
        else if (c < 1280) st4(zkv + (size_t)row * 256 + (c - 1024), v);
        else if (c < 1536) st4(zq + (size_t)row * 384 + (c - 1280), v);
        else if (c < 1664) st4(zq + (size_t)row * 384 + 256 + (c - 1536), v);
#else
        else if (c < 1408) st4(zq + (size_t)row * 384 + (c - 1024), v);
        else if (c < 1664) st4(zkv + (size_t)row * 256 + (c - 1408), v);
#endif
    }
    __device__ __forceinline__ void half(int row, int c, f32x4 v) const {
        if (c < 1664) plain(row, c, v);
        else if (c < 1728) { const int i0 = (c - 1664) >> 1; rope_store(row, c, v, rope[(size_t)row * 32 + i0], rope[(size_t)row * 32 + i0 + 1]); }
    }
    __device__ __forceinline__ void operator()(int r, int c32, int fq, f32x4 a, f32x4 b) const { const int row = row0 + r, c = col0 + c32 + 4 * fq; half(row, c, a); half(row, c + 16, b); }
    struct Ctx { float2 cs[4]; }; static constexpr int BATCH4 = 1;
    __device__ __forceinline__ bool is_rope(int c32) const { const int c = col0 + c32 + HALF_COLS; return c >= 1664 && c < 1728; }
    static constexpr int HALF_COLS = 128;
    __device__ __forceinline__ Ctx pre(int r, int c32, int fq) const { Ctx x;
        if (is_rope(c32)) { const int i0 = (col0 + c32 + 128 + 4 * fq - 1664) >> 1; const float2* rp = rope + (size_t)(row0 + r) * 32 + i0; x.cs[0] = rp[0]; x.cs[1] = rp[1]; x.cs[2] = rp[8]; x.cs[3] = rp[9]; }
        else { x.cs[0] = x.cs[1] = x.cs[2] = x.cs[3] = make_float2(0.f, 0.f); }
        return x; }
    __device__ __forceinline__ void post(int r, int c32, int fq, const Ctx& x, f32x4 a0, f32x4 b0, f32x4 a1, f32x4 b1) const {
        const int row = row0 + r, c = col0 + c32 + 4 * fq;
        plain(row, c, a0); plain(row, c + 16, b0);
        if (is_rope(c32)) { rope_store(row, c + 128, a1, x.cs[0], x.cs[1]); rope_store(row, c + 144, b1, x.cs[2], x.cs[3]); }
        else if (c + 128 < 1664) { plain(row, c + 128, a1); plain(row, c + 144, b1); }
    }
};
struct EpiQ {
    bf16_t* Q; const float* rs; int rs0; int row0, col0;
    __device__ __forceinline__ void half(int row, int c, f32x4 v, float sc) const {
        const int h = c / 192, d = c - h * 192, b = row >> 11, s = row & 2047;
        st4(Q + ((size_t)((b * 4 + h) * SEQ + s)) * 192 + d, v * sc);
    }
    __device__ __forceinline__ void operator()(int r, int c32, int fq, f32x4 a, f32x4 b) const {
        const int row = row0 + r, c = col0 + c32 + 4 * fq; const float sc = rs[row - rs0] * QSCALE; half(row, c, a, sc); half(row, c + 16, b, sc); }
    struct Ctx { float sc; };
    __device__ __forceinline__ Ctx pre(int r, int c32, int fq) const { Ctx x; x.sc = rs[row0 + r - rs0] * QSCALE; return x; }
    __device__ __forceinline__ void post(int r, int c32, int fq, const Ctx& x, f32x4 a0, f32x4 b0, f32x4 a1, f32x4 b1) const {
        const int row = row0 + r, c = col0 + c32 + 4 * fq; half(row, c, a0, x.sc); half(row, c + 16, b0, x.sc); half(row, c + 128, a1, x.sc); half(row, c + 144, b1, x.sc); }
};
struct EpiKV {
    bf16_t *Kn, *Vt; const float* rs; int rs0; int row0, col0;
    __device__ __forceinline__ void half(int row, int c, f32x4 v, float sc) const {
        const int h = c >> 8, e = c & 255, b = row >> 11, s = row & 2047;
        v = v * sc;
        if (e < 128) st4(Kn + ((size_t)((b * 4 + h) * SEQ + s)) * 128 + e, v);
        else {
            bf16_t* vt = Vt + ((size_t)((b * 4 + h) * 128 + (e - 128))) * SEQ + (s & ~15) + perm16(s & 15);
            vt[0] = f2bf(v[0]); vt[SEQ] = f2bf(v[1]); vt[2 * SEQ] = f2bf(v[2]); vt[3 * SEQ] = f2bf(v[3]);
        }
    }
    __device__ __forceinline__ void operator()(int r, int c32, int fq, f32x4 a, f32x4 b) const {
        const int row = row0 + r, c = col0 + c32 + 4 * fq; const float sc = rs[row - rs0]; half(row, c, a, sc); half(row, c + 16, b, sc); }
    struct Ctx { float sc; };
    __device__ __forceinline__ Ctx pre(int r, int c32, int fq) const { Ctx x; x.sc = rs[row0 + r - rs0]; return x; }
    __device__ __forceinline__ void post(int r, int c32, int fq, const Ctx& x, f32x4 a0, f32x4 b0, f32x4 a1, f32x4 b1) const {
        const int row = row0 + r, c = col0 + c32 + 4 * fq; half(row, c, a0, x.sc); half(row, c + 16, b0, x.sc); half(row, c + 128, a1, x.sc); half(row, c + 144, b1, x.sc); }
};
struct EpiY {
    bf16_t* hb; int row0, col0; float* ystat;
    __device__ __forceinline__ void fin(bf16_t* p, u32x2 h, f32x4 v) const {
        v[0] += ALPHA * bflo(h.x); v[1] += ALPHA * bfhi(h.x); v[2] += ALPHA * bflo(h.y); v[3] += ALPHA * bfhi(h.y); st4(p, v); }
    __device__ __forceinline__ void fin2(bf16_t* p, u32x2 h, f32x4 v, float& s, float& q) const {
        v[0] += ALPHA * bflo(h.x); v[1] += ALPHA * bfhi(h.x); v[2] += ALPHA * bflo(h.y); v[3] += ALPHA * bfhi(h.y); st4(p, v);
        s += (v[0] + v[1]) + (v[2] + v[3]); q += (v[0] * v[0] + v[1] * v[1]) + (v[2] * v[2] + v[3] * v[3]); }
    __device__ __forceinline__ void half(int row, int c, f32x4 v) const { bf16_t* p = hb + (size_t)row * DM + c; fin(p, *(const u32x2*)p, v); }
    __device__ __forceinline__ void operator()(int r, int c32, int fq, f32x4 a, f32x4 b) const { const int row = row0 + r, c = col0 + c32 + 4 * fq; half(row, c, a); half(row, c + 16, b); }
    struct Ctx { u32x2 h[4]; }; static constexpr int BATCH4 = 1;
    __device__ __forceinline__ Ctx pre(int r, int c32, int fq) const { Ctx x; const bf16_t* p = hb + (size_t)(row0 + r) * DM + col0 + c32 + 4 * fq;
        x.h[0] = *(const u32x2*)p; x.h[1] = *(const u32x2*)(p + 16); x.h[2] = *(const u32x2*)(p + 128); x.h[3] = *(const u32x2*)(p + 144); return x; }
    __device__ __forceinline__ void post(int r, int c32, int fq, const Ctx& x, f32x4 a0, f32x4 b0, f32x4 a1, f32x4 b1) const {
        bf16_t* p = hb + (size_t)(row0 + r) * DM + col0 + c32 + 4 * fq;
        if (ystat) { float s = 0.f, q = 0.f; fin2(p, x.h[0], a0, s, q); fin2(p + 16, x.h[1], b0, s, q); fin2(p + 128, x.h[2], a1, s, q); fin2(p + 144, x.h[3], b1, s, q);
            s += shx(s, 16); s += shx(s, 32); q += shx(q, 16); q += shx(q, 32);
            if (fq == 0) { typedef float f32x2 __attribute__((ext_vector_type(2))); *(f32x2*)(ystat + ((size_t)(row0 + r) * 16 + (col0 >> 6) + (c32 >> 5)) * 2) = (f32x2){s, q}; } }
        else { fin(p, x.h[0], a0); fin(p + 16, x.h[1], b0); fin(p + 128, x.h[2], a1); fin(p + 144, x.h[3], b1); } }
};
struct EpiH {
    bf16_t* H; int hrow0, col0; bool wt;
    __device__ __forceinline__ void operator()(int r, int c32, int fq, f32x4 a, f32x4 b) const {
        const int hid = ((col0 + c32) >> 5) * 16 + 4 * fq;
        f32x4 o; o[0] = silu_f(a[0]) * b[0]; o[1] = silu_f(a[1]) * b[1]; o[2] = silu_f(a[2]) * b[2]; o[3] = silu_f(a[3]) * b[3];
        if (wt) st4wt(H + (size_t)(hrow0 + r) * FF + hid, o); else st4(H + (size_t)(hrow0 + r) * FF + hid, o);
    }
    struct Ctx { int dummy; };
    __device__ __forceinline__ Ctx pre(int, int, int) const { Ctx x; x.dummy = 0; return x; }
    __device__ __forceinline__ void post(int r, int c32, int fq, const Ctx&, f32x4 a0, f32x4 b0, f32x4 a1, f32x4 b1) const { (*this)(r, c32, fq, a0, b0); (*this)(r, c32 + 128, fq, a1, b1); }
};
struct EpiC {
    bf16_t* contrib; const int* list; const float* gates; int nvalid; int col0;
    __device__ __forceinline__ void operator()(int r, int c32, int fq, f32x4 a, f32x4 b) const {
        if (r >= nvalid) return;
        const int aid = list[r]; const float g = gates[aid];
        char* p = (char*)contrib + ((unsigned)aid * (unsigned)(DM * 2) + (unsigned)((col0 + c32 + 4 * fq) * 2));
        u32x2 w; w.x = pk2(a[0] * g, a[1] * g); w.y = pk2(a[2] * g, a[3] * g); *(u32x2*)p = w;
        w.x = pk2(b[0] * g, b[1] * g); w.y = pk2(b[2] * g, b[3] * g); *(u32x2*)(p + 32) = w;
    }
    struct Ctx { int aid; float g; };
    __device__ __forceinline__ Ctx pre(int r, int, int) const { Ctx x; x.aid = r < nvalid ? list[r] : -1; x.g = 0.f; return x; }
    __device__ __forceinline__ void pre2(Ctx& x) const { if (x.aid >= 0) x.g = gates[x.aid]; }
    __device__ __forceinline__ void post(int r, int c32, int fq, const Ctx& x, f32x4 a0, f32x4 b0, f32x4 a1, f32x4 b1) const {
        if (x.aid < 0) return;
        const float g = x.g;
        char* p = (char*)contrib + ((unsigned)x.aid * (unsigned)(DM * 2) + (unsigned)((col0 + c32 + 4 * fq) * 2));
        u32x2 w; w.x = pk2(a0[0] * g, a0[1] * g); w.y = pk2(a0[2] * g, a0[3] * g); *(u32x2*)p = w;
        w.x = pk2(b0[0] * g, b0[1] * g); w.y = pk2(b0[2] * g, b0[3] * g); *(u32x2*)(p + 32) = w;
        w.x = pk2(a1[0] * g, a1[1] * g); w.y = pk2(a1[2] * g, a1[3] * g); *(u32x2*)(p + 256) = w;
        w.x = pk2(b1[0] * g, b1[1] * g); w.y = pk2(b1[2] * g, b1[3] * g); *(u32x2*)(p + 288) = w;
    }
};

template <class EP> struct Unit { AMap am; const bf16_t* bt; int K; EP ep; };

__device__ __forceinline__ bool moe_unit(const int* cnt, int u, int ncol, int& e, int& rt, int& ct, int& padrow) {
    int acc = 0, fe = -1, facc = 0;
#pragma unroll 4
    for (int i = 0; i < NEXP; ++i) {
        const int t = (cnt[i] + 255) >> 8;
        if (fe < 0 && u < (acc + t) * ncol) { fe = i; facc = acc; }
        acc += t;
    }
    fe = __builtin_amdgcn_readfirstlane(fe); facc = __builtin_amdgcn_readfirstlane(facc);
    if (fe < 0) return false;
    const int w = u - facc * ncol; e = fe; rt = w / ncol; ct = w - rt * ncol; padrow = (facc + rt) * 256;
    return true;
}

struct PhZ { Params p; typedef EpiZ EP; static constexpr int NU = 128 * 7;
    __device__ __forceinline__ bool unit(int u, Unit<EP>& o) const { const int pm = u / 7, pn = u - pm * 7;
        o.am = AMap{p.hbuf + (size_t)pm * 256 * DM, DM, nullptr, 256}; o.bt = p.WinT + (size_t)pn * 256 * DM; o.K = DM;
        o.ep = EpiZ{p.zu, p.zv, p.zq, p.zkv, p.krope, p.rope, pm * 256, pn * 256}; return true; } };
struct PhQ { Params p; const float* rs; typedef EpiQ EP; static constexpr int NU = 128 * 3;
    __device__ __forceinline__ bool unit(int u, Unit<EP>& o) const { const int pm = u / 3, pn = u - pm * 3;
        o.am = AMap{p.zq + (size_t)pm * 256 * 384, 384, nullptr, 256}; o.bt = p.WuqT + (size_t)pn * 256 * 384; o.K = 384;
        o.ep = EpiQ{p.Q, rs, 0, pm * 256, pn * 256}; return true; } };
struct PhKV { Params p; const float* rs; typedef EpiKV EP; static constexpr int NU = 128 * 4;
    __device__ __forceinline__ bool unit(int u, Unit<EP>& o) const { const int pm = u >> 2, pn = u & 3;
        o.am = AMap{p.zkv + (size_t)pm * 256 * 256, 256, nullptr, 256}; o.bt = p.WukvT + (size_t)pn * 256 * 256; o.K = 256;
        o.ep = EpiKV{p.Kn, p.Vt, rs, 0, pm * 256, pn * 256}; return true; } };
struct PhY { Params p; typedef EpiY EP; static constexpr int NU = 128 * 4;
    __device__ __forceinline__ bool unit(int u, Unit<EP>& o) const { const int pm = u >> 2, pn = u & 3;
        o.am = AMap{p.mix + (size_t)pm * 256 * DM, DM, nullptr, 256}; o.bt = p.WoutT + (size_t)pn * 256 * DM; o.K = DM;
        o.ep = EpiY{p.hbuf, pm * 256, pn * 256, YSTAT ? p.ystat : nullptr}; return true; } };
struct PhH { Params p; typedef EpiH EP; static constexpr int NU = 288 * 2;
    __device__ __forceinline__ bool unit(int u, Unit<EP>& o) const { int e, rt, ct, pr; if (!moe_unit(p.cnt, u, 2, e, rt, ct, pr)) return false;
        const int nv = __builtin_amdgcn_readfirstlane(min(256, p.cnt[e] - rt * 256));
        o.am = AMap{p.hbuf, DM, p.list + (size_t)e * LIST_CAP + rt * 256, nv}; o.bt = p.WguT + ((size_t)e * 512 + ct * 256) * DM; o.K = DM;
        o.ep = EpiH{p.H, pr, ct * 256, false}; return true; } };
struct PhC { Params p; typedef EpiC EP; static constexpr int NU = 288 * 4;
    __device__ __forceinline__ bool unit(int u, Unit<EP>& o) const { int e, rt, ct, pr; if (!moe_unit(p.cnt, u, 4, e, rt, ct, pr)) return false;
        const int nv = __builtin_amdgcn_readfirstlane(min(256, p.cnt[e] - rt * 256));
        o.am = AMap{p.H + (size_t)pr * FF, FF, nullptr, 256}; o.bt = p.WdT + ((size_t)e * DM + ct * 256) * FF; o.K = FF;
        o.ep = EpiC{p.contrib, p.list + (size_t)e * LIST_CAP + rt * 256, p.gates, nv, ct * 256}; return true; } };


template <int XMODE> struct EpiProbe {
    const bf16_t* hb; bf16_t* ob; int row0, col0;
    __device__ __forceinline__ void operator()(int, int, int, f32x4, f32x4) const {}
    struct Ctx { u32x2 h[4]; };
    __device__ __forceinline__ Ctx pre(int r, int c32, int fq) const { Ctx x; const bf16_t* p = hb + (size_t)(row0 + r) * DM + col0 + c32 + 4 * fq;
        if (XMODE == 1) { x.h[0] = *(const u32x2*)p; x.h[1] = *(const u32x2*)(p + 16); x.h[2] = *(const u32x2*)(p + 128); x.h[3] = *(const u32x2*)(p + 144); }
        else { x.h[0] = x.h[1] = x.h[2] = x.h[3] = (u32x2){0u, 0u}; }
        return x; }
    __device__ __forceinline__ void fin(bf16_t* p, u32x2 h, f32x4 v) const {
        v[0] += ALPHA * bflo(h.x); v[1] += ALPHA * bfhi(h.x); v[2] += ALPHA * bflo(h.y); v[3] += ALPHA * bfhi(h.y); st4(p, v); }
    __device__ __forceinline__ void post(int r, int c32, int fq, const Ctx& x, f32x4 a0, f32x4 b0, f32x4 a1, f32x4 b1) const {
        if (XMODE == 2) { asm volatile("" :: "v"(a0), "v"(b0), "v"(a1), "v"(b1)); return; }
        if (XMODE == 4) {
            bf16_t* q = ob + (size_t)(row0 + r) * DM + col0 + (c32 >> 5) * 64 + 16 * fq; u32x4 w0, w1;
            w0.x = pk2(a0[0], a0[1]); w0.y = pk2(a0[2], a0[3]); w0.z = pk2(b0[0], b0[1]); w0.w = pk2(b0[2], b0[3]);
            w1.x = pk2(a1[0], a1[1]); w1.y = pk2(a1[2], a1[3]); w1.z = pk2(b1[0], b1[1]); w1.w = pk2(b1[2], b1[3]);
            *(u32x4*)q = w0; *(u32x4*)(q + 8) = w1; return; }
        bf16_t* p = ob + (size_t)(row0 + r) * DM + col0 + c32 + 4 * fq; fin(p, x.h[0], a0); fin(p + 16, x.h[1], b0); fin(p + 128, x.h[2], a1); fin(p + 144, x.h[3], b1); }
};
template <int XMODE> struct PhYp { Params p; typedef EpiProbe<XMODE> EP; static constexpr int NU = 128 * 4;
    __device__ __forceinline__ bool unit(int u, Unit<EP>& o) const { const int pm = u >> 2, pn = u & 3;
        o.am = AMap{p.mix + (size_t)pm * 256 * DM, DM, nullptr, 256}; o.bt = p.WoutT + (size_t)pn * 256 * DM; o.K = DM;
        o.ep = EP{p.hbuf, p.contrib, pm * 256, pn * 256}; return true; } };

__device__ __forceinline__ void wtile(const float* s0, const float* s1, int ldsrc, bf16_t* dst, int K, int k0, int n0, int mode, const float* kscale, float* tile, int tid, int nthr) {
    for (int idx = tid; idx < 4096; idx += nthr) {
        const int kk = idx >> 6, n = n0 + (idx & 63);
        const float* s = s0; int col = n;
        if (mode == 1) { if (n >= 1728) col = -1; else if (n >= 1664) { const int i = (n - 1664) >> 1, pp = (n - 1664) & 1; col = 1664 + i + 32 * pp; } }
        else if (mode == 2) { const int h = n / 192, d = n - h * 192; if (d >= 128) { const int i = (d - 128) >> 1, pp = (d - 128) & 1; col = h * 192 + 128 + i + 32 * pp; } }
        else if (mode == 3) { const int G = n >> 5, r = n & 31; col = 16 * G + (r & 15); s = (r < 16) ? s0 : s1; }
        float v = 0.f;
        if (col >= 0) { v = s[(size_t)(k0 + kk) * ldsrc + col]; if (kscale) v *= kscale[k0 + kk]; }
        tile[kk * 65 + (idx & 63)] = v;
    }
    __syncthreads();
    for (int idx = tid; idx < 4096; idx += nthr) {
        const int nn = idx >> 6, kk = idx & 63;
        dst[(size_t)(n0 + nn) * K + k0 + kk] = f2bf(tile[kk * 65 + nn]);
    }
    __syncthreads();
}
constexpr int J_IN = 28 * 16, J_UQ = 12 * 6, J_UKV = 16 * 4, J_OUT = 16 * 16, J_GU = 32 * 8 * 16, J_DN = 32 * 16 * 4;
constexpr int J_TOTAL = J_IN + J_UQ + J_UKV + J_OUT + J_GU + J_DN;
__device__ __forceinline__ void prep_wjob(const Params& p, int job, float* tile, int tid, int nthr) {
    if (job < J_IN) { const int nb = job >> 4, kb = job & 15; wtile(p.w_in, nullptr, 1728, p.WinT, 1024, kb * 64, nb * 64, 1, nullptr, tile, tid, nthr); return; } job -= J_IN;
    if (job < J_UQ) { const int nb = job / 6, kb = job - nb * 6; wtile(p.w_uq, nullptr, 768, p.WuqT, 384, kb * 64, nb * 64, 0, p.qn_g, tile, tid, nthr); return; } job -= J_UQ;
    if (job < J_UKV) { const int nb = job >> 2, kb = job & 3; wtile(p.w_ukv, nullptr, 1024, p.WukvT, 256, kb * 64, nb * 64, 0, p.kvn_g, tile, tid, nthr); return; } job -= J_UKV;
    if (job < J_OUT) { const int nb = job >> 4, kb = job & 15; wtile(p.w_out, nullptr, 1024, p.WoutT, 1024, kb * 64, nb * 64, 0, nullptr, tile, tid, nthr); return; } job -= J_OUT;
    if (job < J_GU) { const int e = job >> 7, r = job & 127, nb = r >> 4, kb = r & 15;
        wtile(p.w_gate + (size_t)e * 1024 * 256, p.w_up + (size_t)e * 1024 * 256, 256, p.WguT + (size_t)e * 512 * 1024, 1024, kb * 64, nb * 64, 3, nullptr, tile, tid, nthr); return; } job -= J_GU;
    { const int e = job >> 6, r = job & 63, nb = r >> 2, kb = r & 3;
        wtile(p.w_down + (size_t)e * 256 * 1024, nullptr, 1024, p.WdT + (size_t)e * 1024 * 256, 256, kb * 64, nb * 64, 0, nullptr, tile, tid, nthr); }
}
__device__ __forceinline__ void ln0_row(const float* xr, const float* g, const float* b, bf16_t* orow, int lane) {
    f32x4 v[4]; float s = 0.f;
#pragma unroll
    for (int j = 0; j < 4; ++j) { v[j] = *(const f32x4*)(xr + 256 * j + 4 * lane); s += (v[j][0] + v[j][1]) + (v[j][2] + v[j][3]); }
    const float mean = wave_sum(s) * (1.f / 1024.f); float s2 = 0.f;
#pragma unroll
    for (int j = 0; j < 4; ++j) { v[j] = v[j] - mean; s2 += (v[j][0] * v[j][0] + v[j][1] * v[j][1]) + (v[j][2] * v[j][2] + v[j][3] * v[j][3]); }
    const float rstd = 1.f / sqrtf(wave_sum(s2) * (1.f / 1024.f) + 1e-5f);
#pragma unroll
    for (int j = 0; j < 4; ++j) { const f32x4 gg = *(const f32x4*)(g + 256 * j + 4 * lane), bb = *(const f32x4*)(b + 256 * j + 4 * lane);
        st4(orow + 256 * j + 4 * lane, v[j] * rstd * gg + bb); }
}
__device__ __forceinline__ void rope_entry(const Params& p, int idx) {
    const int t = idx >> 5, i = idx & 31;
    const float inv = powf(10000.f, -(float)(2 * i) / 64.f);
    const float ang = (float)p.pos[t] * inv;
    p.rope[idx] = make_float2(cosf(ang), sinf(ang));
}

__device__ __forceinline__ void router_token(const Params& p, int t, int lane, const float* wr  , int wstride) {
    bf16_t* hr = p.hbuf + (size_t)t * DM;
    f32x4 v[4]; float s = 0.f;
#pragma unroll
    for (int j = 0; j < 4; ++j) { const u32x2 w = *(const u32x2*)(hr + 256 * j + 4 * lane); v[j][0] = bflo(w.x); v[j][1] = bfhi(w.x); v[j][2] = bflo(w.y); v[j][3] = bfhi(w.y);
        s += (v[j][0] + v[j][1]) + (v[j][2] + v[j][3]); }
    const float mean = wave_sum(s) * (1.f / 1024.f); float s2 = 0.f;
#pragma unroll
    for (int j = 0; j < 4; ++j) { v[j] = v[j] - mean; s2 += (v[j][0] * v[j][0] + v[j][1] * v[j][1]) + (v[j][2] * v[j][2] + v[j][3] * v[j][3]); }
    const float rstd = 1.f / sqrtf(wave_sum(s2) * (1.f / 1024.f) + 1e-5f);
#pragma unroll
    for (int j = 0; j < 4; ++j) { const f32x4 gg = *(const f32x4*)(p.ln1_g + 256 * j + 4 * lane), bb = *(const f32x4*)(p.ln1_b + 256 * j + 4 * lane);
        v[j] = v[j] * rstd * gg + bb; st4(hr + 256 * j + 4 * lane, v[j]); }
    float lg[36];
#pragma unroll
    for (int o = 0; o < 36; ++o) { float a = 0.f;
#pragma unroll
        for (int j = 0; j < 4; ++j) { const f32x4 w = *(const f32x4*)(wr + o * wstride + 256 * j + 4 * lane); a += (v[j][0] * w[0] + v[j][1] * w[1]) + (v[j][2] * w[2] + v[j][3] * w[3]); }
        lg[o] = wave_sum(a); }
#pragma unroll
    for (int o = 0; o < 4; ++o) lg[o] += p.b_rg[o];
#pragma unroll
    for (int o = 0; o < 32; ++o) lg[4 + o] += p.b_re[o];
    int g = 0; float gm = lg[0];
#pragma unroll
    for (int i = 1; i < 4; ++i) if (lg[i] > gm) { gm = lg[i]; g = i; }
    float se = 0.f;
#pragma unroll
    for (int i = 0; i < 4; ++i) se += expf(lg[i] - gm);
    const float pg = 1.f / se;
    float ev[8];
#pragma unroll
    for (int e = 0; e < 8; ++e) ev[e] = g == 0 ? lg[4 + e] : g == 1 ? lg[12 + e] : g == 2 ? lg[20 + e] : lg[28 + e];
    int i1 = 0; float v1 = ev[0];
#pragma unroll
    for (int e = 1; e < 8; ++e) if (ev[e] > v1) { v1 = ev[e]; i1 = e; }
    int i2 = -1; float v2 = -3.0e38f;
#pragma unroll
    for (int e = 0; e < 8; ++e) if (e != i1 && ev[e] > v2) { v2 = ev[e]; i2 = e; }
    const float d = expf(v2 - v1), g1 = pg / (1.f + d), g2 = pg * d / (1.f + d);
    if (lane < 2) {
        const int ex = g * 8 + (lane == 0 ? i1 : i2), aid = 2 * t + lane;
        const int slot = atomicAdd(p.cnt + ex, 1);
        p.list[(size_t)ex * LIST_CAP + slot] = aid;
        p.gates[aid] = lane == 0 ? g1 : g2;
    }
}
__device__ __forceinline__ void final_token(const Params& p, int t, int lane) {
    const bf16_t* hr = p.hbuf + (size_t)t * DM; const bf16_t* c0 = p.contrib + (size_t)(2 * t) * DM; const bf16_t* c1 = c0 + DM;
    f32x4 v[4]; float s = 0.f;
#pragma unroll
    for (int j = 0; j < 4; ++j) { const int o = 256 * j + 4 * lane; const u32x2 w = *(const u32x2*)(hr + o), a = *(const u32x2*)(c0 + o), b = *(const u32x2*)(c1 + o);
        v[j][0] = ALPHA * bflo(w.x) + bflo(a.x) + bflo(b.x); v[j][1] = ALPHA * bfhi(w.x) + bfhi(a.x) + bfhi(b.x);
        v[j][2] = ALPHA * bflo(w.y) + bflo(a.y) + bflo(b.y); v[j][3] = ALPHA * bfhi(w.y) + bfhi(a.y) + bfhi(b.y);
        s += (v[j][0] + v[j][1]) + (v[j][2] + v[j][3]); }
    const float mean = wave_sum(s) * (1.f / 1024.f); float s2 = 0.f;
#pragma unroll
    for (int j = 0; j < 4; ++j) { v[j] = v[j] - mean; s2 += (v[j][0] * v[j][0] + v[j][1] * v[j][1]) + (v[j][2] * v[j][2] + v[j][3] * v[j][3]); }
    const float rstd = 1.f / sqrtf(wave_sum(s2) * (1.f / 1024.f) + 1e-5f);
#pragma unroll
    for (int j = 0; j < 4; ++j) { const int o = 256 * j + 4 * lane; const f32x4 gg = *(const f32x4*)(p.ln2_g + o), bb = *(const f32x4*)(p.ln2_b + o);
        *(f32x4*)(p.out + (size_t)t * DM + o) = v[j] * rstd * gg + bb; }
}


__device__ __forceinline__ void final_token2(const Params& p, int t0, int t1, int lane) {
    f32x4 v[2][4]; float s[2] = {0.f, 0.f}, q[2] = {0.f, 0.f};
    u32x2 w[2][4], a[2][4], b[2][4];
#pragma unroll
    for (int k = 0; k < 2; ++k) { const int t = k ? t1 : t0; const bf16_t* hr = p.hbuf + (size_t)t * DM; const bf16_t* c0 = p.contrib + (size_t)(2 * t) * DM; const bf16_t* c1 = c0 + DM;
#pragma unroll
        for (int j = 0; j < 4; ++j) { const int o = 256 * j + 4 * lane; w[k][j] = *(const u32x2*)(hr + o); a[k][j] = *(const u32x2*)(c0 + o); b[k][j] = *(const u32x2*)(c1 + o); } }
#pragma unroll
    for (int k = 0; k < 2; ++k)
#pragma unroll
        for (int j = 0; j < 4; ++j) {
            v[k][j][0] = ALPHA * bflo(w[k][j].x) + bflo(a[k][j].x) + bflo(b[k][j].x); v[k][j][1] = ALPHA * bfhi(w[k][j].x) + bfhi(a[k][j].x) + bfhi(b[k][j].x);
            v[k][j][2] = ALPHA * bflo(w[k][j].y) + bflo(a[k][j].y) + bflo(b[k][j].y); v[k][j][3] = ALPHA * bfhi(w[k][j].y) + bfhi(a[k][j].y) + bfhi(b[k][j].y);
            s[k] += (v[k][j][0] + v[k][j][1]) + (v[k][j][2] + v[k][j][3]);
            q[k] += (v[k][j][0] * v[k][j][0] + v[k][j][1] * v[k][j][1]) + (v[k][j][2] * v[k][j][2] + v[k][j][3] * v[k][j][3]); }
#pragma unroll
    for (int o2 = 1; o2 < 64; o2 <<= 1) { s[0] += shx(s[0], o2); s[1] += shx(s[1], o2); q[0] += shx(q[0], o2); q[1] += shx(q[1], o2); }
#pragma unroll
    for (int k = 0; k < 2; ++k) { const int t = k ? t1 : t0; const float mean = s[k] * (1.f / 1024.f), var = fmaxf(q[k] * (1.f / 1024.f) - mean * mean, 0.f), rstd = 1.f / sqrtf(var + 1e-5f);
#pragma unroll
        for (int j = 0; j < 4; ++j) { const int o = 256 * j + 4 * lane; const f32x4 gg = *(const f32x4*)(p.ln2_g + o), bb = *(const f32x4*)(p.ln2_b + o);
            *(f32x4*)(p.out + (size_t)t * DM + o) = (v[k][j] - mean) * rstd * gg + bb; } }
}

__global__ __launch_bounds__(256) void nk_prep_w(Params p) { __shared__ float tile[64 * 65]; prep_wjob(p, blockIdx.x, tile, threadIdx.x, 256); }
__global__ __launch_bounds__(256) void nk_ln0(Params p) { const int t = blockIdx.x * 4 + (threadIdx.x >> 6); ln0_row(p.x + (size_t)t * DM, p.ln0_g, p.ln0_b, p.hbuf + (size_t)t * DM, threadIdx.x & 63); }
__global__ __launch_bounds__(256) void nk_rope(Params p) { rope_entry(p, blockIdx.x * 256 + threadIdx.x); if (blockIdx.x == 0 && threadIdx.x < NEXP) p.cnt[threadIdx.x] = 0; }
__global__ __launch_bounds__(256) void nk_rowscale(Params p) {
    const int t = blockIdx.x * 4 + (threadIdx.x >> 6), lane = threadIdx.x & 63;
    float s = 0.f; for (int i = lane; i < 384; i += 64) { const float v = bf2f(p.zq[(size_t)t * 384 + i]); s += v * v; }
    s = wave_sum(s); float s2 = 0.f; for (int i = lane; i < 256; i += 64) { const float v = bf2f(p.zkv[(size_t)t * 256 + i]); s2 += v * v; }
    s2 = wave_sum(s2);
    if (lane == 0) { p.rsq[t] = 1.f / sqrtf(s * (1.f / 384.f) + 1e-6f); p.rskv[t] = 1.f / sqrtf(s2 * (1.f / 256.f) + 1e-6f); }
}
template <class PH> __global__ __launch_bounds__(256) void nk_gemm(PH ph) {
    Unit<typename PH::EP> u; if (!ph.unit(blockIdx.x, u)) return;
    const int wave = threadIdx.x >> 6, lane = threadIdx.x & 63, fr = lane & 15, fq = lane >> 4;
    const int task = blockIdx.y * 4 + wave, rb = task >> 3, cg = task & 7;
    const bf16_t* arow = u.am.row(rb * 16 + fr);
    const bf16_t* b0 = u.bt + (size_t)(cg * 32 + fr) * u.K; const bf16_t* b1 = b0 + (size_t)16 * u.K;
    f32x4 acc0 = {0.f, 0.f, 0.f, 0.f}, acc1 = {0.f, 0.f, 0.f, 0.f};
    for (int k = 0; k < u.K; k += 32) {
        const bf16x8 a = *(const bf16x8*)(arow + k + 8 * fq), x0 = *(const bf16x8*)(b0 + k + 8 * fq), x1 = *(const bf16x8*)(b1 + k + 8 * fq);
        acc0 = __builtin_amdgcn_mfma_f32_16x16x32_bf16(x0, a, acc0, 0, 0, 0);
        acc1 = __builtin_amdgcn_mfma_f32_16x16x32_bf16(x1, a, acc1, 0, 0, 0);
    }
    u.ep(rb * 16 + fr, cg * 32, fq, acc0, acc1);
}
__global__ __launch_bounds__(256) void nk_gmlp(Params p) {
    extern __shared__ float sm[];
    const int unit = blockIdx.x, h = unit & 3, bn = unit >> 2, row0 = bn * 128;
    const int wave = threadIdx.x >> 6, lane = threadIdx.x & 63;
    for (int j = wave; j < 128; j += 4) {
        const bf16_t* vr = p.zv + (size_t)(row0 + j) * 512 + h * 128;
        const float a = bf2f(vr[lane]), b = bf2f(vr[lane + 64]);
        const float mean = wave_sum(a + b) * (1.f / 128.f); const float da = a - mean, db = b - mean;
        const float rstd = 1.f / sqrtf(wave_sum(da * da + db * db) * (1.f / 128.f) + 1e-5f);
        sm[j * 129 + lane] = da * rstd * p.gm_g[h * 128 + lane] + p.gm_b[h * 128 + lane];
        sm[j * 129 + lane + 64] = db * rstd * p.gm_g[h * 128 + lane + 64] + p.gm_b[h * 128 + lane + 64];
    }
    __syncthreads();
    for (int idx = threadIdx.x; idx < 16384; idx += 256) {
        const int i = idx >> 7, c = idx & 127; const int jn = i < 64 ? 64 : 128;
        const float* w = p.w_sp + ((size_t)h * 128 + i) * 128; float f = p.b_sp[h * 128 + i];
        for (int j = 0; j < jn; ++j) f += w[j] * sm[j * 129 + c];
        const float u = bf2f(p.zu[(size_t)(row0 + i) * 512 + h * 128 + c]);
        p.mix[(size_t)(row0 + i) * DM + h * 128 + c] = f2bf(u * f);
    }
}
__global__ __launch_bounds__(256) void nk_attn(Params p) {
    extern __shared__ float sm[];
    float* Qs = sm; float* Ks = Qs + 64 * 192; float* Ss = Ks + 64 * 193; float* Vs = Ss + 64 * 65;
    const int qc = blockIdx.x & 31, bh = blockIdx.x >> 5, b = bh >> 2, h = bh & 3, tid = threadIdx.x, q = tid >> 2, sub = tid & 3;
    for (int idx = tid; idx < 64 * 192; idx += 256) { const int r = idx / 192, d = idx - r * 192; Qs[idx] = bf2f(p.Q[((size_t)bh * SEQ + qc * 64 + r) * 192 + d]); }
    __syncthreads();
    for (int idx = tid; idx < 64 * 32; idx += 256) { const int r = idx >> 5, i = idx & 31; const float2 cs = p.rope[((size_t)b * SEQ + qc * 64 + r) * 32 + i];
        const float x1 = Qs[r * 192 + 128 + i], x2 = Qs[r * 192 + 160 + i]; Qs[r * 192 + 128 + i] = x1 * cs.x - x2 * cs.y; Qs[r * 192 + 160 + i] = x2 * cs.x + x1 * cs.y; }
    float O[32]; float m = -INFINITY, l = 0.f;
#pragma unroll
    for (int j = 0; j < 32; ++j) O[j] = 0.f;
    for (int kt = 0; kt <= qc; ++kt) {
        __syncthreads();
        for (int idx = tid; idx < 64 * 192; idx += 256) { const int r = idx / 192, d = idx - r * 192; const int key = kt * 64 + r;
            Ks[r * 193 + d] = d < 128 ? bf2f(p.Kn[((size_t)bh * SEQ + key) * 128 + d]) : bf2f(p.krope[((size_t)b * SEQ + key) * 64 + d - 128]); }
        for (int idx = tid; idx < 64 * 128; idx += 256) { const int r = idx >> 7, dv = idx & 127; const int key = kt * 64 + r;
            Vs[r * 128 + dv] = bf2f(p.Vt[((size_t)bh * 128 + dv) * SEQ + (key & ~15) + perm16(key & 15)]); }
        __syncthreads();
        for (int kk = 0; kk < 16; ++kk) { const int key = sub * 16 + kk; float s = 0.f;
            for (int d = 0; d < 192; ++d) s += Qs[q * 192 + d] * Ks[key * 193 + d];
            Ss[q * 65 + key] = s; }
        __syncthreads();
        float mt = -INFINITY; for (int k = 0; k < 64; ++k) mt = fmaxf(mt, Ss[q * 65 + k]);
        const float mn = fmaxf(m, mt), alpha = exp2f(m - mn); m = mn; l *= alpha;
#pragma unroll
        for (int j = 0; j < 32; ++j) O[j] *= alpha;
        for (int k = 0; k < 64; ++k) { const float pk = exp2f(Ss[q * 65 + k] - mn); l += pk;
#pragma unroll
            for (int j = 0; j < 32; ++j) O[j] += pk * Vs[k * 128 + sub * 32 + j]; }
    }
    const float inv = 1.f / l; bf16_t* o = p.mix + ((size_t)b * SEQ + qc * 64 + q) * DM + 512 + h * 128 + sub * 32;
#pragma unroll
    for (int j = 0; j < 32; ++j) o[j] = f2bf(O[j] * inv);
}
__global__ __launch_bounds__(256) void nk_router(Params p) {
    const int t = blockIdx.x * 4 + (threadIdx.x >> 6);
    router_token(p, t, threadIdx.x & 63, (const float*)p.H, 1024);
}
__global__ __launch_bounds__(256) void nk_router_prep(Params p) {
    const int idx = blockIdx.x * 256 + threadIdx.x; if (idx >= 36 * 1024) return;
    const int o = idx >> 10, k = idx & 1023;
    ((float*)p.H)[idx] = o < 4 ? p.w_rg[k * 4 + o] : p.w_re[k * 32 + (o - 4)];
}
__global__ __launch_bounds__(256) void nk_final(Params p) { final_token(p, blockIdx.x * 4 + (threadIdx.x >> 6), threadIdx.x & 63); }

constexpr int LDS_BYTES = 152 * 1024, LDS_RS = 150 * 1024, LDS_XB = 151 * 1024;
constexpr int LDS_PRE = 128 * 1024, LDS_TOT = 144 * 1024, LDS_SEG = LDS_TOT + 256, LDS_AID = LDS_SEG + 2048;
constexpr int LDS_RW = 0, LDS_LCNT = 144 * 1024 + 512;
constexpr int NTHR = 512;

#define XB_TMO      128
#define XB_XCNT(j)  (256  + 64 * (j))
#define XB_XSUB(j)  (1280 + 64 * (j))
#define XB_XGEN(j)  (2304 + 64 * (j))
#define XB_TOP      3328
#define XB_TOPGEN   3392
#define XCD_BAR_WORDS 3456
#define XB_SPIN_CAP (1u << 20)
__device__ __forceinline__ unsigned xb_ld(unsigned* p) { return __hip_atomic_load(p, __ATOMIC_RELAXED, __HIP_MEMORY_SCOPE_AGENT); }
__device__ __forceinline__ unsigned xb_add(unsigned* p, unsigned v) { return __hip_atomic_fetch_add(p, v, __ATOMIC_RELAXED, __HIP_MEMORY_SCOPE_AGENT); }
__device__ __forceinline__ unsigned xb_xcc_id() { return (unsigned)__builtin_amdgcn_s_getreg((3 << 11) | 20) & 0xFu; }
#define XB_SPIN(cond, bar) do { unsigned _sp = 0; while (cond) { __builtin_amdgcn_s_sleep(1); \
    if ((++_sp & 255u) == 0u) { if (xb_ld(&(bar)[XB_TMO])) break; if (_sp > XB_SPIN_CAP) { atomicAdd(&(bar)[XB_TMO], 1u); break; } } } } while (0)
struct XcdBarrier { unsigned* bar; unsigned x; volatile LAS unsigned* st; };
__device__ __forceinline__ XcdBarrier xcd_barrier_post(unsigned* bar, volatile LAS unsigned* st) {
    XcdBarrier b; b.bar = bar; b.x = xb_xcc_id(); b.st = st;
    if (threadIdx.x == 0) (void)xb_add(&bar[XB_XCNT(b.x)], 1u);
    return b;
}
__device__ __forceinline__ void xcd_barrier_complete(unsigned* bar, unsigned x, unsigned& nloc, unsigned& nx) {
    const unsigned G = gridDim.x * gridDim.y * gridDim.z;
    unsigned sum, cnt, mine, sp = 0u;
    for (;;) {
        sum = 0u; cnt = 0u; mine = 0u;
#pragma unroll
        for (unsigned j = 0; j < 16; ++j) { const unsigned c = xb_ld(&bar[XB_XCNT(j)]); sum += c; cnt += (c > 0u) ? 1u : 0u; mine = (j == x) ? c : mine; }
        if (sum == G) break;
        __builtin_amdgcn_s_sleep(1);
        if ((++sp & 255u) == 0u) { if (xb_ld(&bar[XB_TMO])) break; if (sp > XB_SPIN_CAP) { atomicAdd(&bar[XB_TMO], 1u); break; } }
    }
    nloc = mine > 0u ? mine : 1u; nx = cnt > 0u ? cnt : 1u;
}
__device__ __forceinline__ void xcd_barrier(const XcdBarrier& b) {
    asm volatile("s_waitcnt vmcnt(0)" ::: "memory");
    __syncthreads();
    if (threadIdx.x == 0) {
        unsigned* bar = b.bar;
        __builtin_amdgcn_s_waitcnt(0);
        unsigned nloc = b.st[0], nx = b.st[1];
        if (nloc == 0u) { xcd_barrier_complete(bar, b.x, nloc, nx); b.st[0] = nloc; b.st[1] = nx; }
        const unsigned old = xb_add(&bar[XB_XSUB(b.x)], 1u);
        const unsigned gen = old / nloc;
        if (old + 1u == (gen + 1u) * nloc) {
            __builtin_amdgcn_fence(__ATOMIC_RELEASE, "agent");
            asm volatile("s_waitcnt vmcnt(0)" ::: "memory");
            const unsigned og = xb_add(&bar[XB_TOP], 1u);
            const unsigned tg = og / nx;
            if (og + 1u == (tg + 1u) * nx) xb_add(&bar[XB_TOPGEN], 1u);
            else XB_SPIN(xb_ld(&bar[XB_TOPGEN]) == tg, bar);
            __builtin_amdgcn_fence(__ATOMIC_ACQUIRE, "agent");
            xb_add(&bar[XB_XGEN(b.x)], 1u);
            asm volatile("s_waitcnt vmcnt(0)" ::: "memory");
        } else {
            XB_SPIN(xb_ld(&bar[XB_XGEN(b.x)]) == gen, bar);
            __builtin_amdgcn_fence(__ATOMIC_ACQUIRE, "agent");
            asm volatile("s_waitcnt vmcnt(0)" ::: "memory");
        }
    }
    __syncthreads();
}

constexpr int BK = 64, HALF = 128, HT = HALF * BK;
__device__ __forceinline__ int lds_byte(int r, int c) { const int st = (r >> 4) * 2 + (c >> 5), rr = r & 15, cc = c & 31, ob = rr * 64 + cc * 2; return st * 1024 + (ob ^ (((ob >> 9) & 1) << 5)); }
__device__ __forceinline__ void stage_rc(int b, int& R, int& C) { const int st = b / 1024, sb = b % 1024, swz = sb ^ (((sb >> 9) & 1) << 5); R = (st >> 1) * 16 + swz / 64; C = (st & 1) * 32 + (swz % 64) / 2; }

template <class PH> struct HasNext { template <class T> static char test(decltype(&T::next)); template <class T> static long test(...); static constexpr bool value = sizeof(test<PH>(nullptr)) == 1; };
template <class PH> struct HasDone { template <class T> static char test(decltype(&T::done)); template <class T> static long test(...); static constexpr bool value = sizeof(test<PH>(nullptr)) == 1; };
template <class EP> struct HasPre2 { template <class T> static char test(decltype(&T::pre2)); template <class T> static long test(...); static constexpr bool value = sizeof(test<EP>(nullptr)) == 1; };
template <class EP> struct IsBatch4 { template <class T> static char test(decltype(&T::BATCH4)); template <class T> static long test(...); static constexpr bool value = sizeof(test<EP>(nullptr)) == 1; };
template <class EP> __device__ __forceinline__ void run_epilogue(const EP& ep, const f32x4 (&acc)[2][2][4][2], int wr, int wc, int fr, int fq) {
    int rb = wr * 64 + fr, fq_ = fq; asm volatile("" : "+v"(rb), "+v"(fq_));
    if constexpr (IsBatch4<EP>::value) {
#pragma unroll
        for (int ai = 0; ai < 2; ++ai) {
            typename EP::Ctx cx[4];
#pragma unroll
            for (int m = 0; m < 4; ++m) cx[m] = ep.pre(ai * HALF + m * 16 + rb, wc * 32, fq_);
            if constexpr (HasPre2<EP>::value) {
#pragma unroll
                for (int m = 0; m < 4; ++m) ep.pre2(cx[m]);
            }
#pragma unroll
            for (int m = 0; m < 4; ++m) ep.post(ai * HALF + m * 16 + rb, wc * 32, fq_, cx[m], acc[ai][0][m][0], acc[ai][0][m][1], acc[ai][1][m][0], acc[ai][1][m][1]);
        }
    } else {
        typename EP::Ctx cx[8];
#pragma unroll
        for (int i = 0; i < 8; ++i) cx[i] = ep.pre((i >> 2) * HALF + (i & 3) * 16 + rb, wc * 32, fq_);
        if constexpr (HasPre2<EP>::value) {
#pragma unroll
            for (int i = 0; i < 8; ++i) ep.pre2(cx[i]);
        }
#pragma unroll
        for (int i = 0; i < 8; ++i) ep.post((i >> 2) * HALF + (i & 3) * 16 + rb, wc * 32, fq_, cx[i], acc[i >> 2][0][i & 3][0], acc[i >> 2][0][i & 3][1], acc[i >> 2][1][i & 3][0], acc[i >> 2][1][i & 3][1]);
    }
}
struct GmArgs { const float *gm_g, *gm_b, *w_sp, *b_sp; bf16_t* mix; int row0, h; };
__device__ __forceinline__ void gmlp_epilogue(f32x4 (&acc)[2][2][4][2], const GmArgs& g, char* lds, int wr, int wc, int fr, int fq) {
    typedef float f32x2 __attribute__((ext_vector_type(2)));
    f32x2* P = (f32x2*)lds;
    char* vT = lds + 8192;
#pragma unroll
    for (int ai = 0; ai < 2; ++ai)
#pragma unroll
        for (int bj = 0; bj < 2; ++bj)
#pragma unroll
            for (int m = 0; m < 4; ++m)
#pragma unroll
                for (int n = 0; n < 2; ++n)
#pragma unroll
                    for (int t = 0; t < 4; ++t) acc[ai][bj][m][n][t] = gelu_tanh(acc[ai][bj][m][n][t]);
#pragma unroll
    for (int ai = 0; ai < 2; ++ai)
#pragma unroll
        for (int m = 0; m < 4; ++m) { float s = 0.f, q = 0.f;
#pragma unroll
            for (int n = 0; n < 2; ++n)
#pragma unroll
                for (int t = 0; t < 4; ++t) { const float x = acc[ai][1][m][n][t]; s += x; q += x * x; }
            s += shx(s, 16); s += shx(s, 32); q += shx(q, 16); q += shx(q, 32);
            if (fq == 0) P[(ai * 128 + wr * 64 + m * 16 + fr) * 4 + wc] = (f32x2){s, q}; }
    __syncthreads();
    const int c0 = wc * 32 + 4 * fq;
    f32x4 gg[2], bb[2];
#pragma unroll
    for (int n = 0; n < 2; ++n) { gg[n] = *(const f32x4*)(g.gm_g + g.h * 128 + c0 + 16 * n); bb[n] = *(const f32x4*)(g.gm_b + g.h * 128 + c0 + 16 * n); }
#pragma unroll
    for (int ai = 0; ai < 2; ++ai)
#pragma unroll
        for (int m = 0; m < 4; ++m) { const int row = ai * 128 + wr * 64 + m * 16 + fr, j = wr * 64 + m * 16 + fr;
            const f32x2 p0 = P[row * 4 + 0], p1 = P[row * 4 + 1], p2 = P[row * 4 + 2], p3 = P[row * 4 + 3];
            const float mean = ((p0.x + p1.x) + (p2.x + p3.x)) * (1.f / 128.f), var = fmaxf(((p0.y + p1.y) + (p2.y + p3.y)) * (1.f / 128.f) - mean * mean, 0.f), rstd = 1.f / sqrtf(var + 1e-5f);
#pragma unroll
            for (int n = 0; n < 2; ++n)
#pragma unroll
                for (int t = 0; t < 4; ++t) *(bf16_t*)(vT + ai * (128 * 272) + (c0 + 16 * n + t) * 272 + j * 2) = f2bf((acc[ai][1][m][n][t] - mean) * rstd * gg[n][t] + bb[n][t]); }
    __syncthreads();
    const int nks = (wr == 0) ? 2 : 4;
#pragma unroll
    for (int m = 0; m < 4; ++m) {
        const int i = wr * 64 + m * 16 + fr;
        bf16x8 wf[4];
#pragma unroll
        for (int ks = 0; ks < 4; ++ks) { u32x4 pk = {0u, 0u, 0u, 0u};
            if (ks < nks) { const float* w = g.w_sp + ((size_t)g.h * 128 + i) * 128 + 32 * ks + 8 * fq; const f32x4 w0 = *(const f32x4*)w, w1 = *(const f32x4*)(w + 4);
                pk.x = pk2(w0[0], w0[1]); pk.y = pk2(w0[2], w0[3]); pk.z = pk2(w1[0], w1[1]); pk.w = pk2(w1[2], w1[3]); }
            wf[ks] = __builtin_bit_cast(bf16x8, pk); }
        const float bias = g.b_sp[g.h * 128 + i];
#pragma unroll
        for (int ai = 0; ai < 2; ++ai)
#pragma unroll
            for (int n = 0; n < 2; ++n) { f32x4 f = {0.f, 0.f, 0.f, 0.f};
#pragma unroll
                for (int ks = 0; ks < 4; ++ks) if (ks < nks) { const bf16x8 a = *(const bf16x8*)(vT + ai * (128 * 272) + (wc * 32 + n * 16 + fr) * 272 + (32 * ks + 8 * fq) * 2);
                    f = __builtin_amdgcn_mfma_f32_16x16x32_bf16(a, wf[ks], f, 0, 0, 0); }
                const f32x4 uu = acc[ai][0][m][n]; f32x4 o; o[0] = uu[0] * (f[0] + bias); o[1] = uu[1] * (f[1] + bias); o[2] = uu[2] * (f[2] + bias); o[3] = uu[3] * (f[3] + bias);
                st4(g.mix + (size_t)(g.row0 + ai * 128 + i) * DM + g.h * 128 + wc * 32 + n * 16 + 4 * fq, o); } }
}
struct KvArgs { bf16_t* zkv; float* tab; int row0; };
__device__ __forceinline__ void kvlat_epilogue(const f32x4 (&acc)[2][2][4][2], const KvArgs& g, char* lds, int wr, int wc, int fr, int fq) {
    float* P = (float*)lds;
#pragma unroll
    for (int ai = 0; ai < 2; ++ai)
#pragma unroll
        for (int m = 0; m < 4; ++m) { float q = 0.f; const int row = ai * 128 + wr * 64 + m * 16 + fr;
#pragma unroll
            for (int bj = 0; bj < 2; ++bj)
#pragma unroll
                for (int n = 0; n < 2; ++n) { const f32x4 x = acc[ai][bj][m][n]; q += (x[0] * x[0] + x[1] * x[1]) + (x[2] * x[2] + x[3] * x[3]);
                    st4(g.zkv + (size_t)(g.row0 + row) * 256 + bj * 128 + wc * 32 + n * 16 + 4 * fq, x); }
            q += shx(q, 16); q += shx(q, 32);
            if (fq == 0) P[row * 4 + wc] = q; }
    __syncthreads();
    if (threadIdx.x < 256) { const f32x4 s = *(const f32x4*)(P + threadIdx.x * 4); g.tab[threadIdx.x] = 1.f / sqrtf(((s[0] + s[1]) + (s[2] + s[3])) * (1.f / 256.f) + 1e-6f); }
    asm volatile("s_waitcnt vmcnt(0)" ::: "memory");
}
template <class EP, int EK = 0>
__device__ __forceinline__ void gemm256(const Unit<EP>& u, LAS unsigned char* lds, const GmArgs* gm = nullptr, const KvArgs* kv = nullptr) {
    int tid = threadIdx.x; asm volatile("" : "+v"(tid));
    const int K = u.K, nt = K / BK;
    const int wid = __builtin_amdgcn_readfirstlane(tid >> 6), lane = tid & 63, wr = wid >> 2, wc = wid & 3, fr = lane & 15, fq = lane >> 4;
    unsigned voffA[2][2], voffB[2];
    const char* gA = (const char*)u.am.base; const char* gB = (const char*)u.bt;
#pragma unroll
    for (int i = 0; i < 2; ++i) { int R, C; stage_rc(tid * 16 + i * 8192, R, C);
        voffB[i] = (unsigned)(R * K + C) * 2u;
        if (u.am.list) { const int a0 = u.am.list[R < u.am.nvalid ? R : 0], a1 = u.am.list[R + HALF < u.am.nvalid ? R + HALF : 0];
            voffA[0][i] = ((unsigned)(a0 >> 1) * (unsigned)u.am.ld + (unsigned)C) * 2u; voffA[1][i] = ((unsigned)(a1 >> 1) * (unsigned)u.am.ld + (unsigned)C) * 2u; }
        else { voffA[0][i] = (unsigned)(R * u.am.ld + C) * 2u; voffA[1][i] = (unsigned)((R + HALF) * u.am.ld + C) * 2u; } }
    const size_t hstepB = (size_t)HALF * K * 2;
    const unsigned ldsw = (unsigned)wid * 1024u;
    const int aoff = lds_byte(wr * 64 + fr, fq * 8), boff = lds_byte(wc * 32 + fr, fq * 8);
    #define SA(b,h) (((b)*2+(h))*HT*2)
    #define SB(b,h) ((4+(b)*2+(h))*HT*2)
    #define STAGE_A(bufoff,h,kt) do{ _Pragma("unroll") for(int _i=0;_i<2;++_i) { asm volatile("" : "+v"(voffA[h][_i])); \
        __builtin_amdgcn_global_load_lds((const unsigned*)(gA+(size_t)(kt)*(BK*2)+voffA[h][_i]),(LAS unsigned*)(lds+(bufoff)+ldsw+_i*8192),16,0,0);} }while(0)
    #define STAGE_B(bufoff,h,kt) do{ _Pragma("unroll") for(int _i=0;_i<2;++_i) { asm volatile("" : "+v"(voffB[_i])); \
        __builtin_amdgcn_global_load_lds((const unsigned*)(gB+(size_t)(h)*hstepB+(size_t)(kt)*(BK*2)+voffB[_i]),(LAS unsigned*)(lds+(bufoff)+ldsw+_i*8192),16,0,0);} }while(0)
    #define LDA(dst,b,h) _Pragma("unroll") for(int m=0;m<4;++m) _Pragma("unroll") for(int k=0;k<2;++k) \
        dst[m][k]=*(const LAS bf16x8*)(lds+SA(b,h)+aoff+m*2048+k*1024)
    #define LDB(dst,b,h) _Pragma("unroll") for(int n=0;n<2;++n) _Pragma("unroll") for(int k=0;k<2;++k) \
        dst[n][k]=*(const LAS bf16x8*)(lds+SB(b,h)+boff+n*2048+k*1024)
    #define MMA(ai,bj,At_,Bt_) do{__builtin_amdgcn_s_setprio(1); \
        _Pragma("unroll") for(int m=0;m<4;++m) _Pragma("unroll") for(int n=0;n<2;++n) _Pragma("unroll") for(int k=0;k<2;++k) \
          acc[ai][bj][m][n]=__builtin_amdgcn_mfma_f32_16x16x32_bf16(Bt_[n][k],At_[m][k],acc[ai][bj][m][n],0,0,0); \
        __builtin_amdgcn_s_setprio(0);}while(0)
    #define WAIT_V(n) asm volatile("s_waitcnt vmcnt(" #n ")":::"memory")
    #define WAIT_L(n) asm volatile("s_waitcnt lgkmcnt(" #n ")":::"memory")
    #define BAR __builtin_amdgcn_s_barrier()
    #define SCHED __builtin_amdgcn_sched_barrier(0)

    f32x4 acc[2][2][4][2];
#pragma unroll
    for (int a = 0; a < 2; ++a)
#pragma unroll
        for (int b = 0; b < 2; ++b)
#pragma unroll
            for (int m = 0; m < 4; ++m)
#pragma unroll
                for (int n = 0; n < 2; ++n) acc[a][b][m][n] = (f32x4){0.f, 0.f, 0.f, 0.f};
    bf16x8 At[4][2], B0[2][2], B1[2][2];
    STAGE_B(SB(0,0),0,0); STAGE_A(SA(0,0),0,0);
    STAGE_B(SB(0,1),1,0); STAGE_A(SA(0,1),1,0);
    if (wr == 1) BAR;
    WAIT_V(4); BAR;
    STAGE_B(SB(1,0),0,1); STAGE_A(SA(1,0),0,1); STAGE_B(SB(1,1),1,1);
    WAIT_V(6); BAR;
    for (int t = 0; t < nt - 2; t += 2) {
        LDB(B0,0,0); SCHED; LDA(At,0,0); STAGE_A(SA(1,1),1,t+1);
        WAIT_L(8); BAR; WAIT_L(0); MMA(0,0,At,B0); BAR; SCHED;
        LDB(B1,0,1); STAGE_B(SB(0,0),0,t+2);
        BAR; WAIT_L(0); MMA(0,1,At,B1); BAR;
        LDA(At,0,1); STAGE_A(SA(0,0),0,t+2);
        BAR; WAIT_L(0); MMA(1,0,At,B0); BAR; SCHED;
        STAGE_B(SB(0,1),1,t+2);
        WAIT_V(6); BAR; MMA(1,1,At,B1); BAR;
        LDB(B0,1,0); SCHED; LDA(At,1,0); STAGE_A(SA(0,1),1,t+2);
        WAIT_L(8); BAR; WAIT_L(0); MMA(0,0,At,B0); BAR; SCHED;
        LDB(B1,1,1); STAGE_B(SB(1,0),0,t+3);
        BAR; WAIT_L(0); MMA(0,1,At,B1); BAR;
        LDA(At,1,1); STAGE_A(SA(1,0),0,t+3);
        BAR; WAIT_L(0); MMA(1,0,At,B0); BAR; SCHED;
        STAGE_B(SB(1,1),1,t+3);
        WAIT_V(6); BAR; MMA(1,1,At,B1); BAR;
    }
    { LDB(B0,0,0); LDA(At,0,0); STAGE_A(SA(1,1),1,nt-1);
      BAR; WAIT_L(0); MMA(0,0,At,B0); BAR;
      LDB(B1,0,1); BAR; WAIT_L(0); MMA(0,1,At,B1); BAR;
      LDA(At,0,1); WAIT_V(4); BAR; WAIT_L(0); MMA(1,0,At,B0); MMA(1,1,At,B1); BAR; }
    { LDB(B0,1,0); LDA(At,1,0); WAIT_V(2); BAR; WAIT_L(0); MMA(0,0,At,B0); BAR;
      LDB(B1,1,1); WAIT_V(0); BAR; WAIT_L(0); MMA(0,1,At,B1); BAR;
      LDA(At,1,1); BAR; WAIT_L(0); MMA(1,0,At,B0); MMA(1,1,At,B1); BAR; }
    if (wr == 0) BAR;
    if constexpr (EK == 1) { __syncthreads(); gmlp_epilogue(acc, *gm, (char*)lds, wr, wc, fr, fq); } else if constexpr (EK == 2) { __syncthreads(); kvlat_epilogue(acc, *kv, (char*)lds, wr, wc, fr, fq); } else run_epilogue(u.ep, acc, wr, wc, fr, fq);
    __syncthreads();
    #undef SA
    #undef SB
    #undef STAGE_A
    #undef STAGE_B
    #undef LDA
    #undef LDB
    #undef MMA
}


template <class PH>
__device__ __forceinline__ void gemm_stream(const PH& ph, LAS unsigned char* lds, int u0, int ustride) {
    typedef Unit<typename PH::EP> U;
    int tid = threadIdx.x; asm volatile("" : "+v"(tid));
    const int wid = __builtin_amdgcn_readfirstlane(tid >> 6), lane = tid & 63, wr = wid >> 2, wc = wid & 3, fr = lane & 15, fq = lane >> 4;
    int u = u0;
    U cu; if (u >= PH::NU || !ph.unit(u, cu)) return;
    const int K = cu.K, nt = K / BK;
    int R0, C0, R1, C1; stage_rc(tid * 16, R0, C0); stage_rc(tid * 16 + 8192, R1, C1);
    unsigned voffB0 = (unsigned)(R0 * K + C0) * 2u, voffB1 = (unsigned)(R1 * K + C1) * 2u;
    #define VOFFA(am, o00, o01, o10, o11) do { \
        if ((am).list) { const int n_ = (am).nvalid; const int a00 = (am).list[R0 < n_ ? R0 : 0], a01 = (am).list[R1 < n_ ? R1 : 0], a10 = (am).list[R0 + HALF < n_ ? R0 + HALF : 0], a11 = (am).list[R1 + HALF < n_ ? R1 + HALF : 0]; \
            o00 = ((unsigned)(a00 >> 1) * (unsigned)(am).ld + (unsigned)C0) * 2u; o01 = ((unsigned)(a01 >> 1) * (unsigned)(am).ld + (unsigned)C1) * 2u; \
            o10 = ((unsigned)(a10 >> 1) * (unsigned)(am).ld + (unsigned)C0) * 2u; o11 = ((unsigned)(a11 >> 1) * (unsigned)(am).ld + (unsigned)C1) * 2u; } \
        else { o00 = (unsigned)(R0 * (am).ld + C0) * 2u; o01 = (unsigned)(R1 * (am).ld + C1) * 2u; o10 = (unsigned)((R0 + HALF) * (am).ld + C0) * 2u; o11 = (unsigned)((R1 + HALF) * (am).ld + C1) * 2u; } } while (0)
    unsigned va00, va01, va10, va11; VOFFA(cu.am, va00, va01, va10, va11);
    const char* cA = (const char*)cu.am.base; const char* cB = (const char*)cu.bt;
    const size_t hstepB = (size_t)HALF * K * 2, kstep = BK * 2;
    const unsigned ldsw = (unsigned)wid * 1024u;
    const int aoff = lds_byte(wr * 64 + fr, fq * 8), boff = lds_byte(wc * 32 + fr, fq * 8);
    #define SA(b,h) (((b)*2+(h))*HT*2)
    #define SB(b,h) ((4+(b)*2+(h))*HT*2)
    #define STG(bufoff, gbase, o0, o1) do { asm volatile("" : "+v"(o0)); asm volatile("" : "+v"(o1)); \
        __builtin_amdgcn_global_load_lds((const unsigned*)((gbase) + (o0)), (LAS unsigned*)(lds + (bufoff) + ldsw), 16, 0, 0); \
        __builtin_amdgcn_global_load_lds((const unsigned*)((gbase) + (o1)), (LAS unsigned*)(lds + (bufoff) + ldsw + 8192), 16, 0, 0); } while (0)
    #define LDA(dst,b,h) _Pragma("unroll") for(int m=0;m<4;++m) _Pragma("unroll") for(int k=0;k<2;++k) \
        dst[m][k]=*(const LAS bf16x8*)(lds+SA(b,h)+aoff+m*2048+k*1024)
    #define LDB(dst,b,h) _Pragma("unroll") for(int n=0;n<2;++n) _Pragma("unroll") for(int k=0;k<2;++k) \
        dst[n][k]=*(const LAS bf16x8*)(lds+SB(b,h)+boff+n*2048+k*1024)
    #define MMA(ai,bj,At_,Bt_) do{__builtin_amdgcn_s_setprio(1); \
        _Pragma("unroll") for(int m=0;m<4;++m) _Pragma("unroll") for(int n=0;n<2;++n) _Pragma("unroll") for(int k=0;k<2;++k) \
          acc[ai][bj][m][n]=__builtin_amdgcn_mfma_f32_16x16x32_bf16(Bt_[n][k],At_[m][k],acc[ai][bj][m][n],0,0,0); \
        __builtin_amdgcn_s_setprio(0);}while(0)
    f32x4 acc[2][2][4][2];
    #define ZERO_ACC _Pragma("unroll") for (int a = 0; a < 2; ++a) _Pragma("unroll") for (int b = 0; b < 2; ++b) _Pragma("unroll") for (int m = 0; m < 4; ++m) _Pragma("unroll") for (int n = 0; n < 2; ++n) acc[a][b][m][n] = (f32x4){0.f, 0.f, 0.f, 0.f}
    bf16x8 At[4][2], B0[2][2], B1[2][2];
#ifndef SP2
#define SP2 0
#endif
#if SP2
    STG(SB(0,0), cB, voffB0, voffB1); STG(SB(0,1), cB + hstepB, voffB0, voffB1); STG(SA(0,0), cA, va00, va01); STG(SA(0,1), cA, va10, va11);
    if (wr == 1) BAR;
    WAIT_V(2); BAR;
#else
    STG(SB(0,0), cB, voffB0, voffB1); STG(SA(0,0), cA, va00, va01); STG(SB(0,1), cB + hstepB, voffB0, voffB1); STG(SA(0,1), cA, va10, va11);
    if (wr == 1) BAR;
    WAIT_V(4); BAR;
#endif
    STG(SB(1,0), cB + kstep, voffB0, voffB1); STG(SA(1,0), cA + kstep, va00, va01); STG(SB(1,1), cB + hstepB + kstep, voffB0, voffB1);
    WAIT_V(6); BAR;
    for (;;) {
        U nx; int un; if constexpr (HasNext<PH>::value) un = ph.next(wr); else un = u + ustride;
        const bool has_next = (un < PH::NU) && ph.unit(un, nx);
        unsigned na00 = va00, na01 = va01, na10 = va10, na11 = va11; const char* nA = cA; const char* nB = cB;
        if (has_next) { VOFFA(nx.am, na00, na01, na10, na11); nA = (const char*)nx.am.base; nB = (const char*)nx.bt; }
        ZERO_ACC;
#if SP2
        #define KBODY(a1_, a2_, b2_, X00, X01, X10, X11) do { \
            const char* a3_ = (a2_) + kstep; const char* b3_ = (b2_) + kstep; \
            LDB(B0,0,0); LDB(B1,0,1); SCHED; LDA(At,0,0); STG(SA(1,1), a1_, va10, va11); \
            WAIT_V(8); WAIT_L(0); BAR; MMA(0,0,At,B0); MMA(0,1,At,B1); BAR; SCHED; \
            LDA(At,0,1); STG(SB(0,0), b2_, voffB0, voffB1); STG(SB(0,1), (b2_) + hstepB, voffB0, voffB1); STG(SA(0,0), a2_, X00, X01); \
            WAIT_V(8); WAIT_L(0); BAR; MMA(1,0,At,B0); MMA(1,1,At,B1); BAR; SCHED; \
            LDB(B0,1,0); LDB(B1,1,1); SCHED; LDA(At,1,0); STG(SA(0,1), a2_, X10, X11); \
            WAIT_V(8); WAIT_L(0); BAR; MMA(0,0,At,B0); MMA(0,1,At,B1); BAR; SCHED; \
            LDA(At,1,1); STG(SB(1,0), b3_, voffB0, voffB1); STG(SB(1,1), (b3_) + hstepB, voffB0, voffB1); STG(SA(1,0), a3_, X00, X01); \
            WAIT_V(8); WAIT_L(0); BAR; MMA(1,0,At,B0); MMA(1,1,At,B1); BAR; SCHED; } while (0)
#else
        #define KBODY(a1_, a2_, b2_, X00, X01, X10, X11) do { \
            const char* a3_ = (a2_) + kstep; const char* b3_ = (b2_) + kstep; \
            LDB(B0,0,0); SCHED; LDA(At,0,0); STG(SA(1,1), a1_, va10, va11); \
            WAIT_L(8); BAR; WAIT_L(0); MMA(0,0,At,B0); BAR; SCHED; \
            LDB(B1,0,1); STG(SB(0,0), b2_, voffB0, voffB1); \
            BAR; WAIT_L(0); MMA(0,1,At,B1); BAR; \
            LDA(At,0,1); STG(SA(0,0), a2_, X00, X01); \
            BAR; WAIT_L(0); MMA(1,0,At,B0); BAR; SCHED; \
            STG(SB(0,1), (b2_) + hstepB, voffB0, voffB1); \
            WAIT_V(6); BAR; MMA(1,1,At,B1); BAR; \
            LDB(B0,1,0); SCHED; LDA(At,1,0); STG(SA(0,1), a2_, X10, X11); \
            WAIT_L(8); BAR; WAIT_L(0); MMA(0,0,At,B0); BAR; SCHED; \
            LDB(B1,1,1); STG(SB(1,0), b3_, voffB0, voffB1); \
            BAR; WAIT_L(0); MMA(0,1,At,B1); BAR; \
            LDA(At,1,1); STG(SA(1,0), a3_, X00, X01); \
            BAR; WAIT_L(0); MMA(1,0,At,B0); BAR; SCHED; \
            STG(SB(1,1), (b3_) + hstepB, voffB0, voffB1); \
            WAIT_V(6); BAR; MMA(1,1,At,B1); BAR; } while (0)
#endif
#ifndef KREP
#define KREP 1
#endif
        for (int t = 0; t < nt * KREP - 2; t += 2) { const int t1 = (KREP > 1) ? (t + 1) % nt : t + 1, t2 = (KREP > 1) ? (t + 2) % nt : t + 2;
            const char* a1 = cA + (size_t)t1 * kstep; const char* a2 = cA + (size_t)t2 * kstep; const char* b2 = cB + (size_t)t2 * kstep;
            KBODY(a1, a2, b2, va00, va01, va10, va11); }
        { const char* a1 = cA + (size_t)(nt - 1) * kstep; KBODY(a1, nA, nB, na00, na01, na10, na11); }
        if (KREP > 1) {
#pragma unroll
            for (int a = 0; a < 2; ++a)
#pragma unroll
                for (int b = 0; b < 2; ++b)
#pragma unroll
                    for (int m = 0; m < 4; ++m)
#pragma unroll
                        for (int n = 0; n < 2; ++n) acc[a][b][m][n] = acc[a][b][m][n] * (1.0f / KREP); }
        #undef KBODY
        run_epilogue(cu.ep, acc, wr, wc, fr, fq);
        if constexpr (HasDone<PH>::value) ph.done(cu, wr);
        if (!has_next) break;
        cu = nx; va00 = na00; va01 = na01; va10 = na10; va11 = na11; cA = nA; cB = nB; u = un;
    }
    WAIT_V(0);
    if (wr == 0) BAR;
    BAR;
    __syncthreads();
    #undef SA
    #undef SB
    #undef STG
    #undef LDA
    #undef LDB
    #undef MMA
    #undef ZERO_ACC
    #undef VOFFA
}

__device__ __forceinline__ void witem(const float* s0, const float* s1, int ldsrc, bf16_t* dst, int K, int k0, int n0, int mode, const float* kscale, float* scr, int lane) {
    const int n = n0 + (lane & 31);
    const float* s = s0; int col = n;
    if (mode == 1) { if (n >= 1728) col = -1; else if (n >= 1664) { const int i = (n - 1664) >> 1, pp = (n - 1664) & 1; col = 1664 + i + 32 * pp; }
        else if (GMLP_FUSED && n < 1024) { const int t = n >> 8, w = n & 255; col = w < 128 ? t * 128 + w : 512 + t * 128 + (w - 128); }
        else if (ZLAYOUT2 && n >= 1024) { col = n < 1280 ? 1408 + (n - 1024) : n < 1536 ? 1024 + (n - 1280) : 1280 + (n - 1536); } }
    else if (mode == 2) { const int h = n / 192, d = n - h * 192; if (d >= 128) { const int i = (d - 128) >> 1, pp = (d - 128) & 1; col = h * 192 + 128 + i + 32 * pp; } }
    else if (mode == 3) { const int G = n >> 5, r = n & 31; col = 16 * G + (r & 15); s = (r < 16) ? s0 : s1; }
    const float* sp = s + (size_t)(k0 + (lane >> 5)) * ldsrc + (col < 0 ? 0 : col);
    float v[32];
#pragma unroll
    for (int i = 0; i < 32; ++i) v[i] = sp[(size_t)(2 * i) * ldsrc];
    if (kscale) {
#pragma unroll
        for (int i = 0; i < 32; ++i) v[i] *= kscale[k0 + 2 * i + (lane >> 5)];
    }
    if (col < 0) {
#pragma unroll
        for (int i = 0; i < 32; ++i) v[i] = 0.f;
    }
#pragma unroll
    for (int i = 0; i < 32; ++i) scr[(2 * i + (lane >> 5)) * 33 + (lane & 31)] = v[i];
    asm volatile("s_waitcnt lgkmcnt(0)" ::: "memory");
    const int c = lane & 7;
#pragma unroll
    for (int j = 0; j < 4; ++j) { const int nn = (lane >> 3) + 8 * j; const float* q = scr + (8 * c) * 33 + nn;
        u32x4 o; o.x = pk2(q[0], q[33]); o.y = pk2(q[2 * 33], q[3 * 33]); o.z = pk2(q[4 * 33], q[5 * 33]); o.w = pk2(q[6 * 33], q[7 * 33]);
        *(u32x4*)(dst + (size_t)(n0 + nn) * K + k0 + 8 * c) = o; }
    asm volatile("s_waitcnt lgkmcnt(0)" ::: "memory");
}
constexpr int I_IN = 16 * 56, I_UQ = 6 * 24, I_UKV = 4 * 32, I_OUT = 16 * 32, I_GU = 32 * 16 * 16, I_DN = 32 * 4 * 32;
constexpr int I_TOTAL = I_IN + I_UQ + I_UKV + I_OUT + I_GU + I_DN, I_EARLY = I_IN + I_UQ + I_UKV + I_OUT;
__device__ __forceinline__ void prep_witem(const Params& p, int it, float* scr, int lane) {
    if (it < I_IN) { const int kb = it / 56, nb = it - kb * 56; witem(p.w_in, nullptr, 1728, p.WinT, 1024, kb * 64, nb * 32, 1, nullptr, scr, lane); return; } it -= I_IN;
    if (it < I_UQ) { const int kb = it / 24, nb = it - kb * 24; witem(p.w_uq, nullptr, 768, p.WuqT, 384, kb * 64, nb * 32, 0, p.qn_g, scr, lane); return; } it -= I_UQ;
    if (it < I_UKV) { const int kb = it >> 5, nb = it & 31; witem(p.w_ukv, nullptr, 1024, p.WukvT, 256, kb * 64, nb * 32, 0, p.kvn_g, scr, lane); return; } it -= I_UKV;
    if (it < I_OUT) { const int kb = it >> 5, nb = it & 31; witem(p.w_out, nullptr, 1024, p.WoutT, 1024, kb * 64, nb * 32, 0, nullptr, scr, lane); return; } it -= I_OUT;
    if (it < I_GU) { const int e = it >> 8, r = it & 255, kb = r >> 4, nb = r & 15;
        witem(p.w_gate + (size_t)e * 1024 * 256, p.w_up + (size_t)e * 1024 * 256, 256, p.WguT + (size_t)e * 512 * 1024, 1024, kb * 64, nb * 32, 3, nullptr, scr, lane); return; } it -= I_GU;
    { const int e = it >> 7, r = it & 127, kb = r >> 5, nb = r & 31;
        witem(p.w_down + (size_t)e * 256 * 1024, nullptr, 1024, p.WdT + (size_t)e * 1024 * 256, 256, kb * 64, nb * 32, 0, nullptr, scr, lane); }
}
template <bool WT> __device__ __forceinline__ void ln0_row4(const float* x, size_t rstride, const float* g, const float* b, bf16_t* o, int lane) {
    f32x4 v[4][4]; float s[4], q[4];
#pragma unroll
    for (int r = 0; r < 4; ++r)
#pragma unroll
        for (int j = 0; j < 4; ++j) v[r][j] = *(const f32x4*)(x + r * rstride + 256 * j + 4 * lane);
#pragma unroll
    for (int r = 0; r < 4; ++r) { s[r] = 0.f; q[r] = 0.f;
#pragma unroll
        for (int j = 0; j < 4; ++j) { s[r] += (v[r][j][0] + v[r][j][1]) + (v[r][j][2] + v[r][j][3]);
            q[r] += (v[r][j][0] * v[r][j][0] + v[r][j][1] * v[r][j][1]) + (v[r][j][2] * v[r][j][2] + v[r][j][3] * v[r][j][3]); } }
#pragma unroll
    for (int o2 = 1; o2 < 64; o2 <<= 1) {
#pragma unroll
        for (int r = 0; r < 4; ++r) { s[r] += shx(s[r], o2); q[r] += shx(q[r], o2); } }
    f32x4 gg[4], bb[4];
#pragma unroll
    for (int j = 0; j < 4; ++j) { gg[j] = *(const f32x4*)(g + 256 * j + 4 * lane); bb[j] = *(const f32x4*)(b + 256 * j + 4 * lane); }
#pragma unroll
    for (int r = 0; r < 4; ++r) { const float mean = s[r] * (1.f / 1024.f), var = fmaxf(q[r] * (1.f / 1024.f) - mean * mean, 0.f), rstd = 1.f / sqrtf(var + 1e-5f);
#pragma unroll
        for (int j = 0; j < 4; ++j) { if (WT) st4wt(o + r * rstride + 256 * j + 4 * lane, (v[r][j] - mean) * rstd * gg[j] + bb[j]); else st4(o + r * rstride + 256 * j + 4 * lane, (v[r][j] - mean) * rstd * gg[j] + bb[j]); } }
}
__device__ __forceinline__ void ln0_row1_wt(const float* xr, const float* g, const float* b, bf16_t* orow, int lane) {
    f32x4 v[4]; float s = 0.f, q = 0.f;
#pragma unroll
    for (int j = 0; j < 4; ++j) { v[j] = *(const f32x4*)(xr + 256 * j + 4 * lane); s += (v[j][0] + v[j][1]) + (v[j][2] + v[j][3]); q += (v[j][0] * v[j][0] + v[j][1] * v[j][1]) + (v[j][2] * v[j][2] + v[j][3] * v[j][3]); }
#pragma unroll
    for (int o2 = 1; o2 < 64; o2 <<= 1) { s += shx(s, o2); q += shx(q, o2); }
    const float mean = s * (1.f / 1024.f), var = fmaxf(q * (1.f / 1024.f) - mean * mean, 0.f), rstd = 1.f / sqrtf(var + 1e-5f);
#pragma unroll
    for (int j = 0; j < 4; ++j) { const f32x4 gg = *(const f32x4*)(g + 256 * j + 4 * lane), bb = *(const f32x4*)(b + 256 * j + 4 * lane); st4wt(orow + 256 * j + 4 * lane, (v[j] - mean) * rstd * gg + bb); }
}

template <int K> __device__ __forceinline__ void rs_table(const bf16_t* A, float* tab) {
    int tid = threadIdx.x; asm volatile("" : "+v"(tid));
    const int r = tid >> 1, hf = tid & 1; constexpr int n = K >> 1;
    const bf16_t* a = A + (size_t)r * K + hf * n; float s = 0.f;
    u32x4 w[n / 8];
#pragma unroll
    for (int i = 0; i < n / 8; ++i) w[i] = *(const u32x4*)(a + 8 * i);
#pragma unroll
    for (int i = 0; i < n / 8; ++i) { const float a0 = bflo(w[i].x), a1 = bfhi(w[i].x), a2 = bflo(w[i].y), a3 = bfhi(w[i].y), a4 = bflo(w[i].z), a5 = bfhi(w[i].z), a6 = bflo(w[i].w), a7 = bfhi(w[i].w);
        s += (a0 * a0 + a1 * a1) + (a2 * a2 + a3 * a3) + (a4 * a4 + a5 * a5) + (a6 * a6 + a7 * a7); }
    s += shx(s, 1);
    if (hf == 0) tab[r] = 1.f / sqrtf(s / (float)K + 1e-6f);
}

__device__ __forceinline__ void gmlp_phase(const Params& p, char* shm, int vcu) {
    int tid = threadIdx.x; asm volatile("" : "+v"(tid));
    const int wid = __builtin_amdgcn_readfirstlane(tid >> 6), lane = tid & 63, fr = lane & 15, fq = lane >> 4;
    const int h = vcu & 3, iabs = 16 * wid + fr;
    bf16x8 wf[4];
#pragma unroll
    for (int ks = 0; ks < 4; ++ks) {
        const float* w = p.w_sp + ((size_t)h * 128 + iabs) * 128 + 32 * ks + 8 * fq;
        const f32x4 w0 = *(const f32x4*)w, w1 = *(const f32x4*)(w + 4);
        const bool ok = (ks >> 1) <= (iabs >> 6);
        u32x4 pk; pk.x = pk2(w0[0], w0[1]); pk.y = pk2(w0[2], w0[3]); pk.z = pk2(w1[0], w1[1]); pk.w = pk2(w1[2], w1[3]);
        if (!ok) pk = (u32x4){0u, 0u, 0u, 0u};
        wf[ks] = __builtin_bit_cast(bf16x8, pk);
    }
    const float bias = p.b_sp[h * 128 + iabs];
    const int nks = (wid < 4) ? 2 : 4;
    const int j = tid >> 2, part = tid & 3;
    const int nb_ = gridDim.x, nrem = 896 % nb_, ng = (nb_ == 256) ? ((vcu >= nrem) ? 5 : 3) : -1;
    for (int gi = 0;; ++gi) {
        int u;
        if (ng < 0) { u = vcu + gi * nb_; if (u >= (T_TOK / 128) * 4) break; }
        else { if (gi >= ng) break; u = gi < 3 ? vcu + gi * 256 : 768 + (vcu - 128) + 128 * (gi - 3); }
        const int bn = u >> 2, row0 = bn * 128;
        {
            const bf16_t* vr = p.zv + (size_t)(row0 + j) * 512 + h * 128 + part * 32;
            float v[32];
#pragma unroll
            for (int q = 0; q < 4; ++q) { const u32x4 w = *(const u32x4*)(vr + 8 * q);
                v[8 * q + 0] = bflo(w.x); v[8 * q + 1] = bfhi(w.x); v[8 * q + 2] = bflo(w.y); v[8 * q + 3] = bfhi(w.y);
                v[8 * q + 4] = bflo(w.z); v[8 * q + 5] = bfhi(w.z); v[8 * q + 6] = bflo(w.w); v[8 * q + 7] = bfhi(w.w); }
            float s = 0.f;
#pragma unroll
            for (int e = 0; e < 32; ++e) s += v[e];
            s += shx(s, 1); s += shx(s, 2);
            const float mean = s * (1.f / 128.f); float s2 = 0.f;
#pragma unroll
            for (int e = 0; e < 32; ++e) { v[e] -= mean; s2 += v[e] * v[e]; }
            s2 += shx(s2, 1); s2 += shx(s2, 2);
            const float rstd = 1.f / sqrtf(s2 * (1.f / 128.f) + 1e-5f);
            const float* gg = p.gm_g + h * 128 + part * 32; const float* bb = p.gm_b + h * 128 + part * 32;
#pragma unroll
            for (int e = 0; e < 32; ++e) *(bf16_t*)(shm + (part * 32 + e) * 272 + j * 2) = f2bf(v[e] * rstd * gg[e] + bb[e]);
        }
        __syncthreads();
        f32x4 acc[8];
#pragma unroll
        for (int cb = 0; cb < 8; ++cb) acc[cb] = (f32x4){0.f, 0.f, 0.f, 0.f};
#pragma unroll
        for (int ks = 0; ks < 4; ++ks) if (ks < nks) {
#pragma unroll
            for (int cb = 0; cb < 8; ++cb) { const bf16x8 a = *(const bf16x8*)(shm + (16 * cb + fr) * 272 + (32 * ks + 8 * fq) * 2);
                acc[cb] = __builtin_amdgcn_mfma_f32_16x16x32_bf16(a, wf[ks], acc[cb], 0, 0, 0); }
        }
        const bf16_t* ur = p.zu + (size_t)(row0 + iabs) * 512 + h * 128 + 4 * fq;
        bf16_t* orow = p.mix + (size_t)(row0 + iabs) * DM + h * 128 + 4 * fq;
#pragma unroll
        for (int cb = 0; cb < 8; ++cb) { const u32x2 uw = *(const u32x2*)(ur + 16 * cb); f32x4 o;
            o[0] = bflo(uw.x) * (acc[cb][0] + bias); o[1] = bfhi(uw.x) * (acc[cb][1] + bias); o[2] = bflo(uw.y) * (acc[cb][2] + bias); o[3] = bfhi(uw.y) * (acc[cb][3] + bias);
            st4(orow + 16 * cb, o); }
        __syncthreads();
    }
}

constexpr int KT_STRIDE = 400, VT_STRIDE = 144, KT_BYTES = 64 * KT_STRIDE, ATT_STAGE = KT_BYTES + 128 * VT_STRIDE;
template <int AMODE> __device__ __forceinline__ void attn_block(const Params& p, char* shm, int bh, int qb, bf16_t* outbuf) {
    int tid = threadIdx.x; asm volatile("" : "+v"(tid));
    const int wid = __builtin_amdgcn_readfirstlane(tid >> 6), lane = tid & 63, r = lane & 31, hh = lane >> 5;
    const int b = bh >> 2, h = bh & 3, q0 = qb * 256, ntile = 4 * qb + 4, nw = 4 * qb + (wid >> 1) + 1;
    bf16x8 qf[12];
    { const bf16_t* qp = p.Q + ((size_t)bh * SEQ + q0 + 32 * wid + r) * 192 + 8 * hh;
#pragma unroll
      for (int s = 0; s < 12; ++s) qf[s] = *(const bf16x8*)(qp + 16 * s);
      const float2* rp = p.rope + ((size_t)b * SEQ + q0 + 32 * wid + r) * 32 + 8 * hh;
#pragma unroll
      for (int s = 0; s < 2; ++s) { u32x4 x1 = __builtin_bit_cast(u32x4, qf[8 + s]), x2 = __builtin_bit_cast(u32x4, qf[10 + s]); float a[8], c2[8];
          a[0] = bflo(x1.x); a[1] = bfhi(x1.x); a[2] = bflo(x1.y); a[3] = bfhi(x1.y); a[4] = bflo(x1.z); a[5] = bfhi(x1.z); a[6] = bflo(x1.w); a[7] = bfhi(x1.w);
          c2[0] = bflo(x2.x); c2[1] = bfhi(x2.x); c2[2] = bflo(x2.y); c2[3] = bfhi(x2.y); c2[4] = bflo(x2.z); c2[5] = bfhi(x2.z); c2[6] = bflo(x2.w); c2[7] = bfhi(x2.w);
          float o1[8], o2[8];
#pragma unroll
          for (int j = 0; j < 8; ++j) { const float2 cs = rp[16 * s + j]; o1[j] = a[j] * cs.x - c2[j] * cs.y; o2[j] = c2[j] * cs.x + a[j] * cs.y; }
          x1.x = pk2(o1[0], o1[1]); x1.y = pk2(o1[2], o1[3]); x1.z = pk2(o1[4], o1[5]); x1.w = pk2(o1[6], o1[7]);
          x2.x = pk2(o2[0], o2[1]); x2.y = pk2(o2[2], o2[3]); x2.z = pk2(o2[4], o2[5]); x2.w = pk2(o2[6], o2[7]);
          qf[8 + s] = __builtin_bit_cast(bf16x8, x1); qf[10 + s] = __builtin_bit_cast(bf16x8, x2); } }
    f32x16 O[4];
#pragma unroll
    for (int d = 0; d < 4; ++d)
#pragma unroll
        for (int t = 0; t < 16; ++t) O[d][t] = 0.f;
    float m = -INFINITY, l = 0.f;
    const bf16_t* kn_src = p.Kn + ((size_t)bh * SEQ + (tid >> 4)) * 128 + (tid & 15) * 8;
    const bf16_t* kr_src = p.krope + ((size_t)b * SEQ + (tid >> 3)) * 64 + (tid & 7) * 8;
    const bf16_t* vt_src = p.Vt + ((size_t)bh * 128 + (tid >> 3)) * SEQ + (tid & 7) * 8;
    const int kn_dst = (tid >> 4) * KT_STRIDE + (tid & 15) * 16, kr_dst = (tid >> 3) * KT_STRIDE + 256 + (tid & 7) * 16, vt_dst = KT_BYTES + (tid >> 3) * VT_STRIDE + (tid & 7) * 16;
    u32x4 g0, g1, g2, g3, g4;
    #define ATT_LOAD(kt) do { g0 = *(const u32x4*)(kn_src + (size_t)(kt) * 64 * 128); g1 = *(const u32x4*)(kn_src + (size_t)((kt) * 64 + 32) * 128); \
        g2 = *(const u32x4*)(kr_src + (size_t)(kt) * 64 * 64); g3 = *(const u32x4*)(vt_src + (kt) * 64); g4 = *(const u32x4*)(vt_src + (size_t)64 * SEQ + (kt) * 64); } while (0)
    #define ATT_WRITE(buf) do { char* _s = shm + (buf) * ATT_STAGE; *(u32x4*)(_s + kn_dst) = g0; *(u32x4*)(_s + kn_dst + 32 * KT_STRIDE) = g1; *(u32x4*)(_s + kr_dst) = g2; \
        *(u32x4*)(_s + vt_dst) = g3; *(u32x4*)(_s + vt_dst + 64 * VT_STRIDE) = g4; } while (0)
    ATT_LOAD(0); ATT_WRITE(0);
    __syncthreads();
    for (int kt = 0; kt < ntile; ++kt) {
        const bool more = kt + 1 < ntile;
        if (more) ATT_LOAD(kt + 1);
        if (kt < nw) {
            const char* ks = shm + (kt & 1) * ATT_STAGE; const char* vs = ks + KT_BYTES;
            f32x16 S0, S1;
#pragma unroll
            for (int t = 0; t < 16; ++t) { S0[t] = 0.f; S1[t] = 0.f; }
            if (AMODE != 4 && AMODE != 5) {
            __builtin_amdgcn_s_setprio(1);
#pragma unroll
            for (int s = 0; s < 12; ++s) {
                const bf16x8 k0 = *(const bf16x8*)(ks + r * KT_STRIDE + (16 * s + 8 * hh) * 2), k1 = *(const bf16x8*)(ks + (32 + r) * KT_STRIDE + (16 * s + 8 * hh) * 2);
                S0 = __builtin_amdgcn_mfma_f32_32x32x16_bf16(k0, qf[s], S0, 0, 0, 0);
                S1 = __builtin_amdgcn_mfma_f32_32x32x16_bf16(k1, qf[s], S1, 0, 0, 0);
            }
            __builtin_amdgcn_s_setprio(0);
            } else { asm volatile("" : "+v"(S0), "+v"(S1)); }
            float mt = fmaxf(S0[0], S1[0]);
#pragma unroll
            for (int t = 1; t < 16; ++t) mt = fmaxf(mt, fmaxf(S0[t], S1[t]));
            mt = fmaxf(mt, shx(mt, 32));
            if (AMODE == 2 || AMODE == 5) { m = 0.f; l = 1.f; asm volatile("" : "+v"(S0), "+v"(S1)); } else {
            if (!__all(mt - m <= 8.0f)) {
                const float mn = fmaxf(m, mt), alpha = __builtin_amdgcn_exp2f(m - mn); m = mn; l *= alpha;
#pragma unroll
                for (int d = 0; d < 4; ++d)
#pragma unroll
                    for (int t = 0; t < 16; ++t) O[d][t] *= alpha;
            }
            float ls = 0.f;
#pragma unroll
            for (int t = 0; t < 16; ++t) { S0[t] = __builtin_amdgcn_exp2f(S0[t] - m); S1[t] = __builtin_amdgcn_exp2f(S1[t] - m); ls += S0[t] + S1[t]; }
            l += ls; }
            bf16x8 pf[4];
#pragma unroll
            for (int s = 0; s < 2; ++s) {
                u32x4 a, c; a.x = pk2(S0[8 * s + 0], S0[8 * s + 1]); a.y = pk2(S0[8 * s + 2], S0[8 * s + 3]); a.z = pk2(S0[8 * s + 4], S0[8 * s + 5]); a.w = pk2(S0[8 * s + 6], S0[8 * s + 7]);
                c.x = pk2(S1[8 * s + 0], S1[8 * s + 1]); c.y = pk2(S1[8 * s + 2], S1[8 * s + 3]); c.z = pk2(S1[8 * s + 4], S1[8 * s + 5]); c.w = pk2(S1[8 * s + 6], S1[8 * s + 7]);
                pf[s] = __builtin_bit_cast(bf16x8, a); pf[2 + s] = __builtin_bit_cast(bf16x8, c);
            }
            if (AMODE == 3 || AMODE == 5) { asm volatile("" :: "v"(pf[0]), "v"(pf[1]), "v"(pf[2]), "v"(pf[3])); } else {
            __builtin_amdgcn_s_setprio(1);
#pragma unroll
            for (int k4 = 0; k4 < 4; ++k4)
#pragma unroll
                for (int d = 0; d < 4; ++d) { const bf16x8 vf = *(const bf16x8*)(vs + (32 * d + r) * VT_STRIDE + (16 * k4 + 8 * hh) * 2);
                    O[d] = __builtin_amdgcn_mfma_f32_32x32x16_bf16(vf, pf[k4], O[d], 0, 0, 0); }
            __builtin_amdgcn_s_setprio(0); }
        }
        if (more) ATT_WRITE((kt + 1) & 1);
        __syncthreads();
    }
    #undef ATT_LOAD
    #undef ATT_WRITE
    l += shx(l, 32);
    const float inv = 1.f / l;
    bf16_t* o = outbuf + ((size_t)b * SEQ + q0 + 32 * wid + r) * DM + 512 + h * 128 + 4 * hh;
#pragma unroll
    for (int d = 0; d < 4; ++d)
#pragma unroll
        for (int g = 0; g < 4; ++g) { f32x4 v; v[0] = O[d][4 * g] * inv; v[1] = O[d][4 * g + 1] * inv; v[2] = O[d][4 * g + 2] * inv; v[3] = O[d][4 * g + 3] * inv; st4(o + 32 * d + 8 * g, v); }
}


__device__ __forceinline__ void router_tile(const Params& p, char* smc, int tb) {
    int tid = threadIdx.x; asm volatile("" : "+v"(tid));
    const int wid = __builtin_amdgcn_readfirstlane(tid >> 6), lane = tid & 63, fr = lane & 15, fq = lane >> 4;
    int* lcnt = (int*)(smc + LDS_LCNT);
    { u32x4 wreg[18];
#pragma unroll
      for (int k = 0; k < 18; ++k) { const int i = tid + k * NTHR; wreg[k] = *(const u32x4*)(p.WrT + (size_t)i * 8); }
#pragma unroll
      for (int k = 0; k < 18; ++k) { const int i = tid + k * NTHR, img = i / (36 * 128), rem = i - img * 36 * 128, o = rem >> 7, ch = rem & 127;
          *(u32x4*)(smc + LDS_RW + img * 73728 + o * 2048 + ((ch ^ (o & 15)) << 4)) = wreg[k]; } }
    if (tid < NEXP) lcnt[tid] = 0;
    __syncthreads();
    const int tok = tb * 128 + wid * 16 + fr;
    bf16_t* hr = p.hbuf + (size_t)tok * DM + 8 * fq;
    float s = 0.f, s2 = 0.f;
#if YSTAT
    { const f32x4 a = *(const f32x4*)(p.ystat + (size_t)tok * 32 + 8 * fq), b = *(const f32x4*)(p.ystat + (size_t)tok * 32 + 8 * fq + 4); s = (a[0] + a[2]) + (b[0] + b[2]); s2 = (a[1] + a[3]) + (b[1] + b[3]); }
    s += shx(s, 16); s += shx(s, 32); s2 += shx(s2, 16); s2 += shx(s2, 32);
#else
#pragma unroll 8
    for (int ks = 0; ks < 32; ++ks) { const u32x4 y = *(const u32x4*)(hr + 32 * ks);
        const float a0 = bflo(y.x), a1 = bfhi(y.x), a2 = bflo(y.y), a3 = bfhi(y.y), a4 = bflo(y.z), a5 = bfhi(y.z), a6 = bflo(y.w), a7 = bfhi(y.w);
        s += ((a0 + a1) + (a2 + a3)) + ((a4 + a5) + (a6 + a7)); s2 += ((a0 * a0 + a1 * a1) + (a2 * a2 + a3 * a3)) + ((a4 * a4 + a5 * a5) + (a6 * a6 + a7 * a7)); }
    s += shx(s, 16); s += shx(s, 32); s2 += shx(s2, 16); s2 += shx(s2, 32);
#endif
    const float mean = s * (1.f / 1024.f), var = fmaxf(s2 * (1.f / 1024.f) - mean * mean, 0.f), rstd = 1.f / sqrtf(var + 1e-5f);
    const int o0 = fr < 4 ? fr : 3, o1 = 4 + fr, o2 = 20 + fr;
    const int w0 = o0 * 2048, w1 = o1 * 2048, w2 = o2 * 2048, x0 = o0 & 15, x1 = o1 & 15, x2 = o2 & 15;
    f32x4 acc0 = {0.f, 0.f, 0.f, 0.f}, acc1 = acc0, acc2 = acc0;
    const float* lg_ = p.ln1_g + 8 * fq; const float* lb_ = p.ln1_b + 8 * fq;
#pragma unroll 8
    for (int ks = 0; ks < 32; ++ks) {
        const f32x4 g0 = *(const f32x4*)(lg_ + 32 * ks), g1 = *(const f32x4*)(lg_ + 32 * ks + 4), b0 = *(const f32x4*)(lb_ + 32 * ks), b1 = *(const f32x4*)(lb_ + 32 * ks + 4);
        const u32x4 yy = *(const u32x4*)(hr + 32 * ks);
        float h[8];
        h[0] = (bflo(yy.x) - mean) * rstd * g0[0] + b0[0]; h[1] = (bfhi(yy.x) - mean) * rstd * g0[1] + b0[1]; h[2] = (bflo(yy.y) - mean) * rstd * g0[2] + b0[2]; h[3] = (bfhi(yy.y) - mean) * rstd * g0[3] + b0[3];
        h[4] = (bflo(yy.z) - mean) * rstd * g1[0] + b1[0]; h[5] = (bfhi(yy.z) - mean) * rstd * g1[1] + b1[1]; h[6] = (bflo(yy.w) - mean) * rstd * g1[2] + b1[2]; h[7] = (bfhi(yy.w) - mean) * rstd * g1[3] + b1[3];
        u32x4 hi, lo; hi.x = pk2(h[0], h[1]); hi.y = pk2(h[2], h[3]); hi.z = pk2(h[4], h[5]); hi.w = pk2(h[6], h[7]);
        *(u32x4*)(hr + 32 * ks) = hi;
        lo.x = pk2(h[0] - bflo(hi.x), h[1] - bfhi(hi.x)); lo.y = pk2(h[2] - bflo(hi.y), h[3] - bfhi(hi.y)); lo.z = pk2(h[4] - bflo(hi.z), h[5] - bfhi(hi.z)); lo.w = pk2(h[6] - bflo(hi.w), h[7] - bfhi(hi.w));
        const bf16x8 hh = __builtin_bit_cast(bf16x8, hi), hl = __builtin_bit_cast(bf16x8, lo);
        const int ch = 4 * ks + fq;
        const bf16x8 a0h = *(const bf16x8*)(smc + LDS_RW + w0 + ((ch ^ x0) << 4)), a0l = *(const bf16x8*)(smc + LDS_RW + 73728 + w0 + ((ch ^ x0) << 4));
        const bf16x8 a1h = *(const bf16x8*)(smc + LDS_RW + w1 + ((ch ^ x1) << 4)), a1l = *(const bf16x8*)(smc + LDS_RW + 73728 + w1 + ((ch ^ x1) << 4));
        const bf16x8 a2h = *(const bf16x8*)(smc + LDS_RW + w2 + ((ch ^ x2) << 4)), a2l = *(const bf16x8*)(smc + LDS_RW + 73728 + w2 + ((ch ^ x2) << 4));
        acc0 = __builtin_amdgcn_mfma_f32_16x16x32_bf16(a0h, hh, acc0, 0, 0, 0); acc0 = __builtin_amdgcn_mfma_f32_16x16x32_bf16(a0h, hl, acc0, 0, 0, 0); acc0 = __builtin_amdgcn_mfma_f32_16x16x32_bf16(a0l, hh, acc0, 0, 0, 0);
        acc1 = __builtin_amdgcn_mfma_f32_16x16x32_bf16(a1h, hh, acc1, 0, 0, 0); acc1 = __builtin_amdgcn_mfma_f32_16x16x32_bf16(a1h, hl, acc1, 0, 0, 0); acc1 = __builtin_amdgcn_mfma_f32_16x16x32_bf16(a1l, hh, acc1, 0, 0, 0);
        acc2 = __builtin_amdgcn_mfma_f32_16x16x32_bf16(a2h, hh, acc2, 0, 0, 0); acc2 = __builtin_amdgcn_mfma_f32_16x16x32_bf16(a2h, hl, acc2, 0, 0, 0); acc2 = __builtin_amdgcn_mfma_f32_16x16x32_bf16(a2l, hh, acc2, 0, 0, 0);
    }
    __syncthreads();
    float* sc = (float*)(smc + LDS_RW) + wid * (16 * 40) + fr * 40;
    if (fq == 0) { sc[0] = acc0[0]; sc[1] = acc0[1]; sc[2] = acc0[2]; sc[3] = acc0[3]; }
    *(f32x4*)(sc + 4 + 4 * fq) = acc1; *(f32x4*)(sc + 20 + 4 * fq) = acc2;
    __syncthreads();
    if (lane < 16) {
        const float* lr = (const float*)(smc + LDS_RW) + wid * (16 * 40) + lane * 40;
        float lg[36];
#pragma unroll
        for (int o = 0; o < 36; o += 4) { const f32x4 v = *(const f32x4*)(lr + o); lg[o] = v[0]; lg[o + 1] = v[1]; lg[o + 2] = v[2]; lg[o + 3] = v[3]; }
#pragma unroll
        for (int o = 0; o < 4; ++o) lg[o] += p.b_rg[o];
#pragma unroll
        for (int o = 0; o < 32; ++o) lg[4 + o] += p.b_re[o];
        int g = 0; float gm = lg[0];
#pragma unroll
        for (int i = 1; i < 4; ++i) if (lg[i] > gm) { gm = lg[i]; g = i; }
        float se = 0.f;
#pragma unroll
        for (int i = 0; i < 4; ++i) se += expf(lg[i] - gm);
        const float pg = 1.f / se;
        float ev[8];
#pragma unroll
        for (int e = 0; e < 8; ++e) ev[e] = g == 0 ? lg[4 + e] : g == 1 ? lg[12 + e] : g == 2 ? lg[20 + e] : lg[28 + e];
        int i1 = 0; float v1 = ev[0];
#pragma unroll
        for (int e = 1; e < 8; ++e) if (ev[e] > v1) { v1 = ev[e]; i1 = e; }
        int i2 = -1; float v2 = -3.0e38f;
#pragma unroll
        for (int e = 0; e < 8; ++e) if (e != i1 && ev[e] > v2) { v2 = ev[e]; i2 = e; }
        const float d = expf(v2 - v1), g1 = pg / (1.f + d), g2 = pg * d / (1.f + d);
        const int t = tb * 128 + wid * 16 + lane, e1 = g * 8 + i1, e2 = g * 8 + i2;
        const int s1 = atomicAdd(lcnt + e1, 1), s2_ = atomicAdd(lcnt + e2, 1);
        p.listb[((size_t)tb * NEXP + e1) * 256 + s1] = 2 * t; p.listb[((size_t)tb * NEXP + e2) * 256 + s2_] = 2 * t + 1;
        p.gates[2 * t] = g1; p.gates[2 * t + 1] = g2;
    }
    __syncthreads();
    if (tid < NEXP) p.cntb[tb * NEXP + tid] = lcnt[tid];
    __syncthreads();
}
__device__ __forceinline__ void moe_tables(const Params& p, char* smc) {
    int tid = threadIdx.x; asm volatile("" : "+v"(tid));
    const int e = tid & 31, seg = tid >> 5;
    unsigned short* pre = (unsigned short*)(smc + LDS_PRE); int* tot = (int*)(smc + LDS_TOT); int* segtot = (int*)(smc + LDS_SEG);
    int c[16]; int run = 0;
#pragma unroll
    for (int i = 0; i < 16; ++i) c[i] = p.cntb[(16 * seg + i) * NEXP + e];
#pragma unroll
    for (int i = 0; i < 16; ++i) { const int v = c[i]; c[i] = run; run += v; }
    segtot[seg * 32 + e] = run;
    __syncthreads();
    int base = 0, all = 0;
#pragma unroll
    for (int s = 0; s < 16; ++s) { const int v = segtot[s * 32 + e]; base += (s < seg) ? v : 0; all += v; }
#pragma unroll
    for (int i = 0; i < 16; ++i) pre[e * 256 + 16 * seg + i] = (unsigned short)(base + c[i]);
    if (seg == 0) tot[e] = all;
    __syncthreads();
}

template <class PH> __device__ __forceinline__ void gemm_phase(const PH& ph, LAS unsigned char* shm, int vcu) {
#if defined(NOSTREAM)
    for (int u = vcu;; u += gridDim.x) { Unit<typename PH::EP> un; if (u >= PH::NU || !ph.unit(u, un)) break; gemm256(un, shm); }
#else
    gemm_stream(ph, shm, vcu, gridDim.x);
#endif
}

struct PhKVc { Params p; const float* tab; int pm; typedef EpiKV EP; static constexpr int NU = 4;
    __device__ __forceinline__ bool unit(int pn, Unit<EP>& o) const {
        o.am = AMap{p.zkv + (size_t)pm * 256 * 256, 256, nullptr, 256}; o.bt = p.WukvT + (size_t)pn * 256 * 256; o.K = 256;
        o.ep = EpiKV{p.Kn, p.Vt, tab, pm * 256, pm * 256, pn * 256}; return true; } };
struct PhZ2 { Params p; typedef EpiZ EP; static constexpr int NU = 128 * 2;
    __device__ __forceinline__ bool unit(int v, Unit<EP>& o) const { const int pm = v >> 1, pn = 5 + (v & 1);
        o.am = AMap{p.hbuf + (size_t)pm * 256 * DM, DM, nullptr, 256}; o.bt = p.WinT + (size_t)pn * 256 * DM; o.K = DM;
        o.ep = EpiZ{p.zu, p.zv, p.zq, p.zkv, p.krope, p.rope, pm * 256, pn * 256}; return true; } };
struct PhZ3 { Params p; typedef EpiZ EP; static constexpr int NU = 128 * 3;
    __device__ __forceinline__ bool unit(int v, Unit<EP>& o) const { const int pm = v / 3, pn = 4 + (v - pm * 3);
        o.am = AMap{p.hbuf + (size_t)pm * 256 * DM, DM, nullptr, 256}; o.bt = p.WinT + (size_t)pn * 256 * DM; o.K = DM;
        o.ep = EpiZ{p.zu, p.zv, p.zq, p.zkv, p.krope, p.rope, pm * 256, pn * 256}; return true; } };
struct PhQs { Params p; const float* tab; int u0, ustride; typedef EpiQ EP; static constexpr int NU = 128 * 3;
    __device__ __forceinline__ bool unit(int u, Unit<EP>& o) const { const int pm = u / 3, pn = u - pm * 3, slot = (u - u0) / ustride;
        o.am = AMap{p.zq + (size_t)pm * 256 * 384, 384, nullptr, 256}; o.bt = p.WuqT + (size_t)pn * 256 * 384; o.K = 384;
        o.ep = EpiQ{p.Q, tab + slot * 256, pm * 256, pm * 256, pn * 256}; return true; } };
struct PhKVs { Params p; const float* tab; int u0, ustride; typedef EpiKV EP; static constexpr int NU = 128 * 3 + 128 * 4;
    __device__ __forceinline__ bool unit(int u, Unit<EP>& o) const { const int v = u - 384, pm = v >> 2, pn = v & 3, slot = (u - u0) / ustride;
        o.am = AMap{p.zkv + (size_t)pm * 256 * 256, 256, nullptr, 256}; o.bt = p.WukvT + (size_t)pn * 256 * 256; o.K = 256;
        o.ep = EpiKV{p.Kn, p.Vt, tab + slot * 256, pm * 256, pm * 256, pn * 256}; return true; } };
struct PhHs { Params p; const int* tot; const int* aid_tab; int u0, ustride; typedef EpiH EP; static constexpr int NU = 288 * 2;
    __device__ __forceinline__ bool unit(int u, Unit<EP>& o) const { int e, rt, ct, pr; if (!moe_unit(tot, u, 2, e, rt, ct, pr)) return false;
        const int nv = __builtin_amdgcn_readfirstlane(min(256, tot[e] - rt * 256)), slot = (u - u0) / ustride;
        o.am = AMap{p.hbuf, DM, aid_tab + slot * 256, nv}; o.bt = p.WguT + ((size_t)e * 512 + ct * 256) * DM; o.K = DM;
        o.ep = EpiH{p.H, pr, ct * 256, MERGE67 != 0}; return true; }
    __device__ __forceinline__ void done(const Unit<EP>& cu, int wr) const {
        asm volatile("s_waitcnt vmcnt(0)" ::: "memory");
        if (wr == 0) __builtin_amdgcn_s_barrier();
        __builtin_amdgcn_s_barrier();
        if (threadIdx.x == 0) __hip_atomic_fetch_add(hready + (cu.ep.hrow0 >> 8), 1u, __ATOMIC_RELAXED, __HIP_MEMORY_SCOPE_AGENT);
        if (wr == 1) __builtin_amdgcn_s_barrier();
    }
    unsigned* hready; };
struct PhCs { Params p; const int* tot; unsigned* hready; int u0; unsigned* queue; volatile int* slot; typedef EpiC EP; static constexpr int NU = 288 * 4;
    __device__ __forceinline__ int take(bool stagger, int wr) const {
        if (stagger && wr == 0) __builtin_amdgcn_s_barrier();
        if (threadIdx.x == 0) slot[0] = (int)__hip_atomic_fetch_add(queue, 1u, __ATOMIC_RELAXED, __HIP_MEMORY_SCOPE_AGENT);
        __builtin_amdgcn_s_barrier();
        const int t = __builtin_amdgcn_readfirstlane(slot[0]);
        __builtin_amdgcn_s_barrier();
        if (stagger && wr == 1) __builtin_amdgcn_s_barrier();
        return t;
    }
    __device__ __forceinline__ int next(int wr) const { return take(true, wr); }
    __device__ __forceinline__ bool unit(int u, Unit<EP>& o) const { int e, rt, ct, pr; if (!moe_unit(tot, u, 4, e, rt, ct, pr)) return false;
        const int wr = __builtin_amdgcn_readfirstlane((int)threadIdx.x >> 8);
        if (u != u0 && wr == 0) __builtin_amdgcn_s_barrier();
        if (threadIdx.x == 0) { unsigned sp = 0; unsigned* w = hready + (pr >> 8);
            while (__hip_atomic_load(w, __ATOMIC_RELAXED, __HIP_MEMORY_SCOPE_AGENT) < 2u) { __builtin_amdgcn_s_sleep(2); if (++sp > (1u << 20)) break; }
            __builtin_amdgcn_fence(__ATOMIC_ACQUIRE, "agent");
            asm volatile("s_waitcnt vmcnt(0)" ::: "memory"); }
        __builtin_amdgcn_s_barrier();
        if (u != u0 && wr == 1) __builtin_amdgcn_s_barrier();
        const int nv = __builtin_amdgcn_readfirstlane(min(256, tot[e] - rt * 256));
        o.am = AMap{p.H + (size_t)pr * FF, FF, nullptr, 256}; o.bt = p.WdT + ((size_t)e * DM + ct * 256) * FF; o.K = FF;
        o.ep = EpiC{p.contrib, p.list + (size_t)e * LIST_CAP + rt * 256, p.gates, nv, ct * 256}; return true; } };


struct PhZj { Params p; int u0; unsigned* cnt; typedef EpiZ EP; static constexpr int NU = 128 * 7;
    __device__ __forceinline__ void chunk(int u) const {
        int tid = threadIdx.x; asm volatile("" : "+v"(tid));
        const int wid = __builtin_amdgcn_readfirstlane(tid >> 6), lane = tid & 63;
        const int pm = u / 7, pn = u - pm * 7, r0 = pm * 256 + pn * 36 + (pn < 4 ? pn : 4), n = pn < 4 ? 37 : 36;
        ln0_row4<true>(p.x + (size_t)(r0 + wid) * DM, (size_t)8 * DM, p.ln0_g, p.ln0_b, p.hbuf + (size_t)(r0 + wid) * DM, lane);
        if (32 + wid < n) ln0_row1_wt(p.x + (size_t)(r0 + 32 + wid) * DM, p.ln0_g, p.ln0_b, p.hbuf + (size_t)(r0 + 32 + wid) * DM, lane);
        asm volatile("s_waitcnt vmcnt(0)" ::: "memory");
        __syncthreads();
        if (tid == 0) {
            __hip_atomic_fetch_add(cnt + pm, 1u, __ATOMIC_RELAXED, __HIP_MEMORY_SCOPE_AGENT);
            unsigned sp = 0;
            while (__hip_atomic_load(cnt + pm, __ATOMIC_RELAXED, __HIP_MEMORY_SCOPE_AGENT) < 7u) { __builtin_amdgcn_s_sleep(2); if (++sp > (1u << 18)) break; }
            __builtin_amdgcn_fence(__ATOMIC_ACQUIRE, "agent");
            asm volatile("s_waitcnt vmcnt(0)" ::: "memory");
        }
        __syncthreads();
    }
    __device__ __forceinline__ bool unit(int u, Unit<EP>& o) const {
        if (u != u0) {
            const int wr = __builtin_amdgcn_readfirstlane((int)threadIdx.x >> 8);
            if (wr == 0) __builtin_amdgcn_s_barrier();
            chunk(u);
            if (wr == 1) __builtin_amdgcn_s_barrier();
        }
        const int pm = u / 7, pn = u - pm * 7;
        o.am = AMap{p.hbuf + (size_t)pm * 256 * DM, DM, nullptr, 256}; o.bt = p.WinT + (size_t)pn * 256 * DM; o.K = DM;
        o.ep = EpiZ{p.zu, p.zv, p.zq, p.zkv, p.krope, p.rope, pm * 256, pn * 256}; return true; } };

typedef const __attribute__((address_space(4))) Params* KParams;
__device__ __forceinline__ Params ldp() {
#if defined(__HIP_DEVICE_COMPILE__)
    KParams q = (KParams)__builtin_amdgcn_kernarg_segment_ptr(); asm volatile("" : "+s"(q)); return *q;
#else
    return Params{};
#endif
}
template <int LO, int HI>
__global__ __launch_bounds__(512, 2) void mega(Params p_arg_unused) {
    extern __shared__ __attribute__((aligned(16))) unsigned char lds_raw[];
    LAS unsigned char* shm = (LAS unsigned char*)lds_raw;
    char* smc = (char*)lds_raw;
    const int nblk = gridDim.x;
    const int vcu = (nblk % 8 == 0) ? (int)(blockIdx.x % 8) * (nblk / 8) + (int)(blockIdx.x / 8) : (int)blockIdx.x;
    #define PHASE_IDS int tid = threadIdx.x; asm volatile("" : "+v"(tid)); const int wid = __builtin_amdgcn_readfirstlane(tid >> 6), lane = tid & 63; (void)wid; (void)lane
    XcdBarrier xb;
    if (LO != HI) {
        if (threadIdx.x == 0) { ((volatile LAS unsigned*)(smc + LDS_XB))[0] = 0u; ((volatile LAS unsigned*)(smc + LDS_XB))[1] = 0u; }
        __syncthreads();
        { const Params p = ldp(); xb = xcd_barrier_post(p.bar, (volatile LAS unsigned*)(smc + LDS_XB)); }
    }
#ifndef TIMEPH
#define TIMEPH -1
#endif
    unsigned long long ts0_ = 0, ts1_ = 0;
    #define TSTAMP(k) do { if (TIMEPH >= 0) { if ((k) == TIMEPH) ts0_ = __builtin_amdgcn_s_memrealtime(); if ((k) == TIMEPH + 1) ts1_ = __builtin_amdgcn_s_memrealtime(); } } while (0)
    #define SEAM(ph) do { if (LO <= (ph) && HI > (ph)) xcd_barrier(xb); TSTAMP((ph) + 1); } while (0)
    TSTAMP(0);
#ifndef REPMASK
#define REPMASK 0
#endif
    #define NREP(k) ((((REPMASK) >> (k)) & 1) ? 2 : 1)
    #define REPEAT(k) for (int rep_ = 0; rep_ < NREP(k); ++rep_, (rep_ < NREP(k) ? xcd_barrier(xb) : (void)0))
    if (LO <= 0 && HI >= 0) REPEAT(0) {
        const Params p = ldp(); PHASE_IDS;
        { float* scr = (float*)(smc + wid * (64 * 33 * 4)); const int gw = blockIdx.x * 8 + wid, ngw = nblk * 8;
#ifndef P0REP
#define P0REP 0
#endif
          for (int rep = 0; rep < ((P0REP & 1) ? 2 : 1); ++rep)
          for (int it = gw; it < I_EARLY; it += ngw) prep_witem(p, it, scr, lane);
#if !JIT_LN0
          for (int t = gw; t < T_TOK / 4; t += ngw) ln0_row4<false>(p.x + (size_t)t * DM, (size_t)(T_TOK / 4) * DM, p.ln0_g, p.ln0_b, p.hbuf + (size_t)t * DM, lane);
#endif
          }
        for (int rep = 0; rep < ((P0REP & 4) ? 2 : 1); ++rep)
        { const int i0 = blockIdx.x * NTHR + tid; const float inv = powf(10000.f, -(float)(2 * (i0 & 31)) / 64.f);
          if (nblk * NTHR * 8 == T_TOK * 32) { int ps[8];
#pragma unroll
              for (int k = 0; k < 8; ++k) ps[k] = p.pos[(i0 + k * nblk * NTHR) >> 5];
#pragma unroll
              for (int k = 0; k < 8; ++k) { const float ang = (float)ps[k] * inv; p.rope[i0 + k * nblk * NTHR] = make_float2(cosf(ang), sinf(ang)); } }
          else for (int i = i0; i < T_TOK * 32; i += nblk * NTHR) { const float ang = (float)p.pos[i >> 5] * inv; p.rope[i] = make_float2(cosf(ang), sinf(ang)); } }
        for (int i = blockIdx.x * NTHR + tid; i < 36 * 1024; i += nblk * NTHR) { const int o = i >> 10, k = i & 1023; const float w = o < 4 ? p.w_rg[k * 4 + o] : p.w_re[k * 32 + (o - 4)];
            const bf16_t hi = f2bf(w); p.WrT[i] = hi; p.WrT[36864 + i] = f2bf(w - bf2f(hi)); }
    }
    SEAM(0);
    if (LO <= 1 && HI >= 1) REPEAT(1) {
#if GMLP_FUSED && KVCHAIN
        { { const Params p = ldp(); gemm_stream(PhZ2{p}, shm, vcu, nblk); }
          for (;;) {
              int t;
              { const Params p = ldp(); PHASE_IDS; volatile int* slot = (volatile int*)(smc + LDS_AID);
                if (tid == 0) slot[0] = (int)__hip_atomic_fetch_add(p.bar + 3584, 1u, __ATOMIC_RELAXED, __HIP_MEMORY_SCOPE_AGENT);
                __syncthreads();
                t = __builtin_amdgcn_readfirstlane(slot[0]);
                __syncthreads(); }
              if (t >= 128 + 512 + 128) break;
              if (t < 128) { const Params p = ldp(); const int pm = t; float* tab = (float*)(smc + LDS_PRE);
                  Unit<EpiZ> un; un.am = AMap{p.hbuf + (size_t)pm * 256 * DM, DM, nullptr, 256}; un.bt = p.WinT + (size_t)4 * 256 * DM; un.K = DM; un.ep = EpiZ{p.zu, p.zv, p.zq, p.zkv, p.krope, p.rope, pm * 256, 4 * 256};
                  const KvArgs kv{p.zkv, tab, pm * 256};
                  gemm256<EpiZ, 2>(un, shm, nullptr, &kv);
                  gemm_stream(PhKVc{p, tab, pm}, shm, 0, 1);
              } else if (t < 128 + 512) { const Params p = ldp(); const int w = t - 128, pm = w >> 2, h = w & 3;
                  Unit<EpiZ> un; un.am = AMap{p.hbuf + (size_t)pm * 256 * DM, DM, nullptr, 256}; un.bt = p.WinT + (size_t)h * 256 * DM; un.K = DM; un.ep = EpiZ{p.zu, p.zv, p.zq, p.zkv, p.krope, p.rope, pm * 256, h * 256};
                  const GmArgs gm{p.gm_g, p.gm_b, p.w_sp, p.b_sp, p.mix, pm * 256, h};
                  gemm256<EpiZ, 1>(un, shm, &gm);
              } else { const Params p = ldp(); PHASE_IDS; const int ch = t - 640; float* scr = (float*)(smc + wid * (64 * 33 * 4));
                  for (int k = wid; k < 96; k += 8) prep_witem(p, I_EARLY + ch * 96 + k, scr, lane);
                  __syncthreads(); }
          } }
#elif GMLP_FUSED
        { const Params p = ldp(); PHASE_IDS;
          gemm_stream(PhZ3{p}, shm, vcu, nblk);
          if (PhZ3::NU % nblk != 0 && vcu >= PhZ3::NU % nblk) { float* scr = (float*)(smc + wid * (64 * 33 * 4)); const int nlate = nblk - (PhZ3::NU % nblk), gw = (vcu - PhZ3::NU % nblk) * 8 + wid, ngw = nlate * 8;
              for (int it = I_EARLY + gw; it < I_TOTAL; it += ngw) prep_witem(p, it, scr, lane); }
          else if (PhZ3::NU % nblk == 0) { float* scr = (float*)(smc + wid * (64 * 33 * 4)); for (int it = I_EARLY + vcu * 8 + wid; it < I_TOTAL; it += nblk * 8) prep_witem(p, it, scr, lane); }
          __syncthreads();
          for (int w = vcu; w < 512; w += nblk) { const int pm = w >> 2, h = w & 3;
              Unit<EpiZ> un; un.am = AMap{p.hbuf + (size_t)pm * 256 * DM, DM, nullptr, 256}; un.bt = p.WinT + (size_t)h * 256 * DM; un.K = DM; un.ep = EpiZ{p.zu, p.zv, p.zq, p.zkv, p.krope, p.rope, pm * 256, h * 256};
              const GmArgs gm{p.gm_g, p.gm_b, p.w_sp, p.b_sp, p.mix, pm * 256, h};
              gemm256<EpiZ, 1>(un, shm, &gm); } }
#else
#if JIT_LN0
        { const Params p = ldp(); PhZj ph{p, vcu, p.bar + 3520}; ph.chunk(vcu); gemm_stream(ph, shm, vcu, nblk); }
#else
        gemm_phase(PhZ{ldp()}, shm, vcu);
#endif
        { const Params p = ldp(); PHASE_IDS; const int nlate = nblk - (PhZ::NU % nblk);
          if (PhZ::NU % nblk != 0 && vcu >= PhZ::NU % nblk) { float* scr = (float*)(smc + wid * (64 * 33 * 4)); const int gw = (vcu - PhZ::NU % nblk) * 8 + wid, ngw = nlate * 8;
              for (int it = I_EARLY + gw; it < I_TOTAL; it += ngw) prep_witem(p, it, scr, lane); }
          else if (PhZ::NU % nblk == 0) { float* scr = (float*)(smc + wid * (64 * 33 * 4)); for (int it = I_EARLY + vcu * 8 + wid; it < I_TOTAL; it += nblk * 8) prep_witem(p, it, scr, lane); } }
#endif
    }
    SEAM(1);
    if (LO <= 2 && HI >= 2) REPEAT(2) {
        const Params p = ldp();
        float* tab = (float*)(smc + LDS_PRE);
#if KVCHAIN
        { int slot = 0;
          for (int u = vcu; u < PhQs::NU; u += nblk, ++slot) rs_table<384>(p.zq + (size_t)(u / 3) * 256 * 384, tab + slot * 256); }
        __syncthreads();
        gemm_stream(PhQs{p, tab, vcu, nblk}, shm, vcu, nblk);
#else
        { int slot = 0;
          for (int u = vcu; u < PhKVs::NU; u += nblk, ++slot) {
              if (u < PhQs::NU) rs_table<384>(p.zq + (size_t)(u / 3) * 256 * 384, tab + slot * 256); else rs_table<256>(p.zkv + (size_t)((u - 384) >> 2) * 256 * 256, tab + slot * 256); } }
        __syncthreads();
        gemm_stream(PhQs{p, tab, vcu, nblk}, shm, vcu, nblk);
        { const int i0 = vcu >= PhQs::NU ? 0 : (PhQs::NU - vcu + nblk - 1) / nblk; gemm_stream(PhKVs{p, tab, vcu, nblk}, shm, vcu + i0 * nblk, nblk); }
#endif
#if !GMLP_FUSED
        gmlp_phase(p, smc, vcu);
#endif
    }
    SEAM(2);
    if (LO <= 3 && HI >= 3) REPEAT(3) {
        const Params p = ldp();
#ifndef ATTPROBE
#define ATTPROBE 0
#endif
        for (int u = vcu; u < 256; u += nblk) { const int bh = u >> 2, pr = u & 3; attn_block<0>(p, smc, bh, 7 - pr, p.mix); attn_block<0>(p, smc, bh, pr, p.mix); }
    }
    SEAM(3);
    if (LO <= 4 && HI >= 4) {
#if XPROBE > 0
        gemm_phase(PhYp<XPROBE>{ldp()}, shm, vcu); xcd_barrier(xb);
#endif
#ifndef WARM4
#define WARM4 0
#endif
        if (WARM4) { const Params p = ldp(); PHASE_IDS;
            for (int u = vcu; u < 512; u += nblk) { const char* a = (const char*)(p.mix + (size_t)(u >> 2) * 256 * DM); unsigned acc_ = 0;
#pragma unroll
                for (int i = 0; i < 8; ++i) acc_ += *(const unsigned*)(a + ((size_t)(i * 512 + tid) << 7));
                asm volatile("" :: "v"(acc_)); } }
        gemm_phase(PhY{ldp()}, shm, vcu);
    }
    SEAM(4);
    if (LO <= 5 && HI >= 5) {
        const Params p = ldp();
        for (int tb = blockIdx.x; tb < T_TOK / 128; tb += nblk) router_tile(p, smc, tb);
    }
    SEAM(5);
    if (LO <= 6 && HI >= 6) REPEAT(6) {
        const Params p = ldp(); PHASE_IDS;
        moe_tables(p, smc);
        const int* tot = (const int*)(smc + LDS_TOT); int* aid_tab = (int*)(smc + LDS_AID); const unsigned short* pre = (const unsigned short*)(smc + LDS_PRE);
        if (blockIdx.x == 0 && tid < NEXP) p.cnt[tid] = tot[tid];
        { int slot = 0;
          for (int u = vcu; slot < 3; u += nblk, ++slot) {
              int e, rt, ct, pr; if (!moe_unit(tot, u, 2, e, rt, ct, pr)) break;
              const int te = tot[e];
              if (tid < 256) { const int g = rt * 256 + tid; int aid = 0;
                  if (g < te) { int lo = 0, hi = 256;
#pragma unroll
                      for (int it = 0; it < 8; ++it) { const int mid = (lo + hi) >> 1; if ((int)pre[e * 256 + mid] <= g) lo = mid; else hi = mid; }
                      aid = p.listb[((size_t)lo * NEXP + e) * 256 + (g - (int)pre[e * 256 + lo])];
                      if (ct == 0) { if (MERGE67) __hip_atomic_store(p.list + (size_t)e * LIST_CAP + g, aid, __ATOMIC_RELAXED, __HIP_MEMORY_SCOPE_AGENT); else p.list[(size_t)e * LIST_CAP + g] = aid; } }
                  aid_tab[slot * 256 + tid] = aid; } } }
        __syncthreads();
        gemm_stream(PhHs{p, tot, aid_tab, vcu, nblk, p.bar + 3712}, shm, vcu, nblk);
#if MERGE67
        { PhCs pc{p, tot, p.bar + 3712, 0, p.bar + 3648, (volatile int*)(smc + LDS_AID)}; pc.u0 = pc.take(false, 0); gemm_stream(pc, shm, pc.u0, nblk); }
#endif
    }
#if !MERGE67
    SEAM(6);
#else
    TSTAMP(7);
#endif
    if (!MERGE67 && LO <= 7 && HI >= 7) REPEAT(7) {
        Params p = ldp(); PHASE_IDS;
        int* tot = (int*)(smc + LDS_TOT);
        if (tid < NEXP) tot[tid] = p.cnt[tid];
        __syncthreads();
        p.cnt = tot;
        gemm_phase(PhC{p}, shm, vcu);
    }
    SEAM(7);
#ifndef WPROBE
#define WPROBE 0
#endif
    if (WPROBE > 0 && LO <= 8 && HI >= 8 && LO != HI) {
        const Params p = ldp(); PHASE_IDS;
        const int wr = wid >> 2, wc = wid & 3, fr = lane & 15, fq = lane >> 4;
        for (int u = vcu; u < 512; u += nblk) { const int pm = u >> 2, pn = u & 3;
            bf16_t* base = p.mix + (size_t)pm * 256 * DM + pn * 256;
#pragma unroll
            for (int ai = 0; ai < 2; ++ai)
#pragma unroll
                for (int m = 0; m < 4; ++m) { bf16_t* rowp = base + (size_t)(ai * 128 + wr * 64 + m * 16 + fr) * DM;
                    if (WPROBE == 1) { const u32x2 z = {0u, 0u};
                        *(u32x2*)(rowp + wc * 32 + 4 * fq) = z; *(u32x2*)(rowp + wc * 32 + 16 + 4 * fq) = z; *(u32x2*)(rowp + 128 + wc * 32 + 4 * fq) = z; *(u32x2*)(rowp + 128 + wc * 32 + 16 + 4 * fq) = z; }
                    else { const u32x4 z = {0u, 0u, 0u, 0u}; *(u32x4*)(rowp + wc * 64 + 16 * fq) = z; *(u32x4*)(rowp + wc * 64 + 16 * fq + 8) = z; } } }
        xcd_barrier(xb);
    }
    if (LO <= 8 && HI >= 8) REPEAT(8) { const Params p = ldp(); PHASE_IDS; for (int t = blockIdx.x * 8 + wid; t < T_TOK / 2; t += nblk * 8) final_token2(p, t, t + T_TOK / 2, lane); }
    if (TIMEPH >= 0 && LO != HI) {
        xcd_barrier(xb); TSTAMP(9);
        if (blockIdx.x == 0 && threadIdx.x < 64) { const Params p = ldp(); const float dv = (float)(ts1_ - ts0_) * 6.0e-5f; for (int i = threadIdx.x; i < 4096; i += 64) p.out[i] = dv; }
    }
    #undef SEAM
}

#if ATTPROBE > 0
__global__ __launch_bounds__(512, 2) void attn_probe_kernel(Params p) {
    extern __shared__ __attribute__((aligned(16))) unsigned char lds_raw[];
    char* smc = (char*)lds_raw; const int nblk = gridDim.x;
    const int vcu = (nblk % 8 == 0) ? (int)(blockIdx.x % 8) * (nblk / 8) + (int)(blockIdx.x / 8) : (int)blockIdx.x;
    for (int u = vcu; u < 256; u += nblk) { const int bh = u >> 2, pr = u & 3; attn_block<ATTPROBE>(p, smc, bh, 7 - pr, (bf16_t*)p.out); attn_block<ATTPROBE>(p, smc, bh, pr, (bf16_t*)p.out); }
}
#endif
#ifndef MODE
#ifndef MODE
#define MODE 1
#endif
#endif
#ifndef FASTMASK
#define FASTMASK 0x1ff
#endif
static size_t carve(size_t& off, size_t bytes) { const size_t o = off; off += (bytes + 255) & ~(size_t)255; return o; }
#ifndef DUPMASK
#define DUPMASK 0
#endif
template <int PH> static void launch_fast(const Params& p, int grid, hipStream_t stream) { hipLaunchKernelGGL((mega<PH, PH>), dim3(grid), dim3(NTHR), LDS_BYTES, stream, p);
    if ((DUPMASK >> PH) & 1) hipLaunchKernelGGL((mega<PH, PH>), dim3(grid), dim3(NTHR), LDS_BYTES, stream, p); }
extern "C" void kernel_launch(void* const* d_in, const int* in_sizes, int n_in, void* d_out, int out_size, void* d_ws, size_t ws_size, hipStream_t stream) {
    Params p{};
    p.x = (const float*)d_in[0]; p.pos = (const int*)d_in[1]; p.ln0_g = (const float*)d_in[2]; p.ln0_b = (const float*)d_in[3]; p.w_in = (const float*)d_in[4];
    p.gm_g = (const float*)d_in[5]; p.gm_b = (const float*)d_in[6]; p.w_sp = (const float*)d_in[7]; p.b_sp = (const float*)d_in[8]; p.qn_g = (const float*)d_in[9];
    p.w_uq = (const float*)d_in[10]; p.kvn_g = (const float*)d_in[11]; p.w_ukv = (const float*)d_in[12]; p.w_out = (const float*)d_in[13]; p.ln1_g = (const float*)d_in[14];
    p.ln1_b = (const float*)d_in[15]; p.w_rg = (const float*)d_in[16]; p.b_rg = (const float*)d_in[17]; p.w_re = (const float*)d_in[18]; p.b_re = (const float*)d_in[19];
    p.w_gate = (const float*)d_in[20]; p.w_up = (const float*)d_in[21]; p.w_down = (const float*)d_in[22]; p.ln2_g = (const float*)d_in[23]; p.ln2_b = (const float*)d_in[24];
    p.out = (float*)d_out;
    char* ws = (char*)d_ws; size_t off = 0;
    p.bar = (unsigned*)(ws + carve(off, 16384));
    p.cnt = (int*)(ws + carve(off, 1024));
    p.WinT = (bf16_t*)(ws + carve(off, (size_t)ZN * 1024 * 2)); p.WuqT = (bf16_t*)(ws + carve(off, 768 * 384 * 2)); p.WukvT = (bf16_t*)(ws + carve(off, 1024 * 256 * 2));
    p.WoutT = (bf16_t*)(ws + carve(off, 1024 * 1024 * 2)); p.WguT = (bf16_t*)(ws + carve(off, (size_t)32 * 512 * 1024 * 2)); p.WdT = (bf16_t*)(ws + carve(off, (size_t)32 * 1024 * 256 * 2));
    p.hbuf = (bf16_t*)(ws + carve(off, (size_t)T_TOK * DM * 2)); p.rope = (float2*)(ws + carve(off, (size_t)T_TOK * 32 * 8));
    p.list = (int*)(ws + carve(off, (size_t)NEXP * LIST_CAP * 4)); p.gates = (float*)(ws + carve(off, (size_t)T_TOK * 2 * 4));
    p.ystat = (float*)(ws + carve(off, (size_t)T_TOK * 32 * 4)); p.WrT = (bf16_t*)(ws + carve(off, 2 * 36 * 1024 * 2)); p.cntb = (int*)(ws + carve(off, 256 * NEXP * 4)); p.listb = (int*)(ws + carve(off, (size_t)256 * NEXP * 256 * 4));
    p.rsq = (float*)(ws + carve(off, T_TOK * 4)); p.rskv = (float*)(ws + carve(off, T_TOK * 4));
    const size_t stage0 = off;
    p.zu = (bf16_t*)(ws + carve(off, (size_t)T_TOK * 512 * 2)); p.zv = (bf16_t*)(ws + carve(off, (size_t)T_TOK * 512 * 2));
    p.zq = (bf16_t*)(ws + carve(off, (size_t)T_TOK * 384 * 2)); p.zkv = (bf16_t*)(ws + carve(off, (size_t)T_TOK * 256 * 2)); p.krope = (bf16_t*)(ws + carve(off, (size_t)T_TOK * 64 * 2));
    p.Q = (bf16_t*)(ws + carve(off, (size_t)T_TOK * 768 * 2)); p.Kn = (bf16_t*)(ws + carve(off, (size_t)T_TOK * 512 * 2)); p.Vt = (bf16_t*)(ws + carve(off, (size_t)T_TOK * 512 * 2));
    p.mix = (bf16_t*)(ws + carve(off, (size_t)T_TOK * DM * 2));
    const size_t stage_end = off;
    size_t o2 = stage0; p.contrib = (bf16_t*)(ws + carve(o2, (size_t)T_TOK * 2 * DM * 2)); p.H = (bf16_t*)(ws + carve(o2, (size_t)(65536 + 8192) * FF * 2));
    if (o2 > stage_end || stage_end > ws_size) { fprintf(stderr, "kernel_launch: workspace too small (%zu needed, %zu given)\n", stage_end, ws_size); return; }

    static int grid = 0;
    if (!grid) {
        int dev = 0, cus = 0; (void)hipGetDevice(&dev); (void)hipDeviceGetAttribute(&cus, hipDeviceAttributeMultiprocessorCount, dev);
        grid = cus > 0 ? (cus / 8) * 8 : 256;
        (void)hipFuncSetAttribute((const void*)nk_gmlp, hipFuncAttributeMaxDynamicSharedMemorySize, 128 * 129 * 4);
        (void)hipFuncSetAttribute((const void*)nk_attn, hipFuncAttributeMaxDynamicSharedMemorySize, (64 * 192 + 64 * 193 + 64 * 65 + 64 * 128) * 4);
        (void)hipFuncSetAttribute((const void*)mega<0, 8>, hipFuncAttributeMaxDynamicSharedMemorySize, LDS_BYTES);
#if MODE == 2
        (void)hipFuncSetAttribute((const void*)mega<0, 0>, hipFuncAttributeMaxDynamicSharedMemorySize, LDS_BYTES);
        (void)hipFuncSetAttribute((const void*)mega<1, 1>, hipFuncAttributeMaxDynamicSharedMemorySize, LDS_BYTES);
        (void)hipFuncSetAttribute((const void*)mega<2, 2>, hipFuncAttributeMaxDynamicSharedMemorySize, LDS_BYTES);
        (void)hipFuncSetAttribute((const void*)mega<3, 3>, hipFuncAttributeMaxDynamicSharedMemorySize, LDS_BYTES);
        (void)hipFuncSetAttribute((const void*)mega<4, 4>, hipFuncAttributeMaxDynamicSharedMemorySize, LDS_BYTES);
        (void)hipFuncSetAttribute((const void*)mega<5, 5>, hipFuncAttributeMaxDynamicSharedMemorySize, LDS_BYTES);
        (void)hipFuncSetAttribute((const void*)mega<6, 6>, hipFuncAttributeMaxDynamicSharedMemorySize, LDS_BYTES);
        (void)hipFuncSetAttribute((const void*)mega<7, 7>, hipFuncAttributeMaxDynamicSharedMemorySize, LDS_BYTES);
        (void)hipFuncSetAttribute((const void*)mega<8, 8>, hipFuncAttributeMaxDynamicSharedMemorySize, LDS_BYTES);
#endif
    }
#if MODE == 1
    (void)hipMemsetAsync(p.bar, 0, 16384, stream);
    hipLaunchKernelGGL((mega<0, 8>), dim3(grid), dim3(NTHR), LDS_BYTES, stream, p);
#else
    const unsigned fm = (MODE == 2) ? (unsigned)(FASTMASK) : 0u;
    if (fm & 1) launch_fast<0>(p, grid, stream); else { nk_prep_w<<<J_TOTAL, 256, 0, stream>>>(p); nk_ln0<<<T_TOK / 4, 256, 0, stream>>>(p); nk_rope<<<T_TOK * 32 / 256, 256, 0, stream>>>(p); }
    if (fm & 2) launch_fast<1>(p, grid, stream); else nk_gemm<PhZ><<<dim3(PhZ::NU, 32), 256, 0, stream>>>(PhZ{p});
#if defined(P2VAR) && P2VAR == 1
    launch_fast<2>(p, grid, stream); nk_gmlp<<<T_TOK / 128 * 4, 256, 128 * 129 * 4, stream>>>(p);
#elif defined(P2VAR) && P2VAR == 2
    nk_rowscale<<<T_TOK / 4, 256, 0, stream>>>(p); nk_gemm<PhQ><<<dim3(PhQ::NU, 32), 256, 0, stream>>>(PhQ{p, p.rsq});
    nk_gemm<PhKV><<<dim3(PhKV::NU, 32), 256, 0, stream>>>(PhKV{p, p.rskv}); launch_fast<2>(p, grid, stream);
#else
    if (fm & 4) launch_fast<2>(p, grid, stream); else { nk_rowscale<<<T_TOK / 4, 256, 0, stream>>>(p); nk_gemm<PhQ><<<dim3(PhQ::NU, 32), 256, 0, stream>>>(PhQ{p, p.rsq});
        nk_gemm<PhKV><<<dim3(PhKV::NU, 32), 256, 0, stream>>>(PhKV{p, p.rskv}); nk_gmlp<<<T_TOK / 128 * 4, 256, 128 * 129 * 4, stream>>>(p); }
#endif
#if ATTPROBE > 0
    { static bool a2 = false; if (!a2) { a2 = true; (void)hipFuncSetAttribute((const void*)attn_probe_kernel, hipFuncAttributeMaxDynamicSharedMemorySize, LDS_BYTES); }
      hipLaunchKernelGGL(attn_probe_kernel, dim3(grid), dim3(NTHR), LDS_BYTES, stream, p); }
#endif
    if (fm & 8) launch_fast<3>(p, grid, stream); else nk_attn<<<64 * 32, 256, (64 * 192 + 64 * 193 + 64 * 65 + 64 * 128) * 4, stream>>>(p);
    if (fm & 16) launch_fast<4>(p, grid, stream); else nk_gemm<PhY><<<dim3(PhY::NU, 32), 256, 0, stream>>>(PhY{p});
    if (fm & 32) launch_fast<5>(p, grid, stream); else { nk_router_prep<<<144, 256, 0, stream>>>(p); nk_router<<<T_TOK / 4, 256, 0, stream>>>(p); }
    if (fm & 64) launch_fast<6>(p, grid, stream); else nk_gemm<PhH><<<dim3(PhH::NU, 32), 256, 0, stream>>>(PhH{p});
    if (fm & 128) launch_fast<7>(p, grid, stream); else nk_gemm<PhC><<<dim3(PhC::NU, 32), 256, 0, stream>>>(PhC{p});
    if (fm & 256) launch_fast<8>(p, grid, stream); else nk_final<<<T_TOK / 4, 256, 0, stream>>>(p);
#endif
}
```

```cpp
#include <hip/hip_runtime.h>
#define P2VAR 0
#define REPMASK 0x0
#define DUPMASK 0x0
#define TIMEPH -1
#define KREP 1
#define XPROBE 0
#define P0REP 0
#define WPROBE 0
#define ATTPROBE 0
#define JIT_LN0 0
#define MERGE67 1
#define GMLP_FUSED 1
#define ZLAYOUT2 1
#define KVCHAIN 0
#define YSTAT 1
#define P1QUEUE 1
#include <stdint.h>
#include <cstdio>

#define LAS __attribute__((address_space(3)))
typedef unsigned short bf16_t;
typedef short bf16x8 __attribute__((ext_vector_type(8)));
typedef float f32x4 __attribute__((ext_vector_type(4)));
typedef float f32x16 __attribute__((ext_vector_type(16)));
typedef unsigned u32x2 __attribute__((ext_vector_type(2)));
typedef unsigned u32x4 __attribute__((ext_vector_type(4)));

constexpr int T_TOK = 32768, DM = 1024, SEQ = 2048, NBATCH = 16;
constexpr int ZN = 1792;
constexpr int NEXP = 32, FF = 256;
constexpr int LIST_CAP = 32768;
constexpr float ALPHA = 1.189207115002721f;
constexpr float QSCALE = 0.07216878364870322f * 1.4426950408889634f;

struct Params {
    const float* x; const int* pos; const float *ln0_g, *ln0_b, *w_in, *gm_g, *gm_b, *w_sp, *b_sp, *qn_g, *w_uq, *kvn_g, *w_ukv, *w_out, *ln1_g, *ln1_b,
        *w_rg, *b_rg, *w_re, *b_re, *w_gate, *w_up, *w_down, *ln2_g, *ln2_b;
    float* out;
    bf16_t *WinT, *WuqT, *WukvT, *WoutT, *WguT, *WdT;
    bf16_t* hbuf; float2* rope;
    bf16_t *zu, *zv, *zq, *zkv, *krope, *Q, *Kn, *Vt, *mix;
    float *rsq, *rskv;
    int* cnt; int* list; float* gates; bf16_t* H; bf16_t* contrib;
    float* ystat;
    bf16_t* WrT; int* cntb; int* listb;
    unsigned* bar;
};

__device__ __forceinline__ unsigned pk2(float lo, float hi) { unsigned r; asm volatile("v_cvt_pk_bf16_f32 %0, %1, %2" : "=v"(r) : "v"(lo), "v"(hi)); return r; }
__device__ __forceinline__ bf16_t f2bf(float f) { return (bf16_t)(pk2(f, 0.f) & 0xffffu); }
__device__ __forceinline__ float bf2f(bf16_t h) { return __uint_as_float(((unsigned)h) << 16); }
__device__ __forceinline__ float bflo(unsigned u) { return __uint_as_float(u << 16); }
__device__ __forceinline__ float bfhi(unsigned u) { return __uint_as_float(u & 0xffff0000u); }
__device__ __forceinline__ void st4(bf16_t* p, f32x4 v) { u32x2 w; w.x = pk2(v[0], v[1]); w.y = pk2(v[2], v[3]); *(u32x2*)p = w; }
__device__ __forceinline__ void st4wt(bf16_t* p, f32x4 v) { const unsigned lo = pk2(v[0], v[1]), hi = pk2(v[2], v[3]);
    __hip_atomic_store((unsigned long long*)p, ((unsigned long long)hi << 32) | lo, __ATOMIC_RELAXED, __HIP_MEMORY_SCOPE_AGENT); }
__device__ __forceinline__ float shx(float v, int mask) { int l = threadIdx.x; asm volatile("" : "+v"(l)); const int idx = ((l ^ mask) & 63) << 2; return __int_as_float(__builtin_amdgcn_ds_bpermute(idx, __float_as_int(v))); }
__device__ __forceinline__ float wave_sum(float v) {
#pragma unroll
    for (int o = 1; o < 64; o <<= 1) v += shx(v, o);
    return v;
}
__device__ __forceinline__ float gelu_tanh(float x) {
    const float u = x + 0.044715f * x * x * x;
    const float e = __builtin_amdgcn_exp2f(-2.f * 0.7978845608028654f * 1.4426950408889634f * u);
    return x * __builtin_amdgcn_rcpf(1.f + e);
}
__device__ __forceinline__ float silu_f(float x) { return x * __builtin_amdgcn_rcpf(1.f + __builtin_amdgcn_exp2f(-1.4426950408889634f * x)); }
__device__ __forceinline__ int perm16(int k) { return 8 * ((k >> 2) & 1) + (k & 3) + 4 * (k >> 3); }

struct AMap {
    const bf16_t* base; int ld; const int* list; int nvalid;
    __device__ __forceinline__ const bf16_t* row(int r) const {
        if (list) { const int a = list[r < nvalid ? r : 0]; return base + (size_t)(a >> 1) * ld; }
        return base + (size_t)r * ld;
    }
};

struct EpiZ {
    bf16_t *zu, *zv, *zq, *zkv, *krope; const float2* rope; int row0, col0;
    __device__ __forceinline__ void rope_store(int row, int c, f32x4 v, float2 cs0, float2 cs1) const {
        const int i0 = (c - 1664) >> 1; bf16_t* kr = krope + (size_t)row * 64;
        kr[i0] = f2bf(v[0] * cs0.x - v[1] * cs0.y); kr[i0 + 32] = f2bf(v[1] * cs0.x + v[0] * cs0.y);
        kr[i0 + 1] = f2bf(v[2] * cs1.x - v[3] * cs1.y); kr[i0 + 33] = f2bf(v[3] * cs1.x + v[2] * cs1.y);
    }
    __device__ __forceinline__ void plain(int row, int c, f32x4 v) const {
        if (c < 1024) {
            f32x4 g; g[0] = gelu_tanh(v[0]); g[1] = gelu_tanh(v[1]); g[2] = gelu_tanh(v[2]); g[3] = gelu_tanh(v[3]);
            if (c < 512) st4(zu + (size_t)row * 512 + c, g); else st4(zv + (size_t)row * 512 + (c - 512), g);
        }
#if ZLAYOUT2
        else if (c < 1280) st4(zkv + (size_t)row * 256 + (c - 1024), v);
        else if (c < 1536) st4(zq + (size_t)row * 384 + (c - 1280), v);
        else if (c < 1664) st4(zq + (size_t)row * 384 + 256 + (c - 1536), v);
#else
        else if (c < 1408) st4(zq + (size_t)row * 384 + (c - 1024), v);
        else if (c < 1664) st4(zkv + (size_t)row * 256 + (c - 1408), v);
#endif
    }
    __device__ __forceinline__ void half(int row, int c, f32x4 v) const {
        if (c < 1664) plain(row, c, v);
        else if (c < 1728) { const int i0 = (c - 1664) >> 1; rope_store(row, c, v, rope[(size_t)row * 32 + i0], rope[(size_t)row * 32 + i0 + 1]); }
    }
    __device__ __forceinline__ void operator()(int r, int c32, int fq, f32x4 a, f32x4 b) const { const int row = row0 + r, c = col0 + c32 + 4 * fq; half(row, c, a); half(row, c + 16, b); }
    struct Ctx { float2 cs[4]; }; static constexpr int BATCH4 = 1;
    __device__ __forceinline__ bool is_rope(int c32) const { const int c = col0 + c32 + HALF_COLS; return c >= 1664 && c < 1728; }
    static constexpr int HALF_COLS = 128;
    __device__ __forceinline__ Ctx pre(int r, int c32, int fq) const { Ctx x;
        if (is_rope(c32)) { const int i0 = (col0 + c32 + 128 + 4 * fq - 1664) >> 1; const float2* rp = rope + (size_t)(row0 + r) * 32 + i0; x.cs[0] = rp[0]; x.cs[1] = rp[1]; x.cs[2] = rp[8]; x.cs[3] = rp[9]; }
        else { x.cs[0] = x.cs[1] = x.cs[2] = x.cs[3] = make_float2(0.f, 0.f); }
        return x; }
    __device__ __forceinline__ void post(int r, int c32, int fq, const Ctx& x, f32x4 a0, f32x4 b0, f32x4 a1, f32x4 b1) const {
        const int row = row0 + r, c = col0 + c32 + 4 * fq;
        plain(row, c, a0); plain(row, c + 16, b0);
        if (is_rope(c32)) { rope_store(row, c + 128, a1, x.cs[0], x.cs[1]); rope_store(row, c + 144, b1, x.cs[2], x.cs[3]); }
        else if (c + 128 < 1664) { plain(row, c + 128, a1); plain(row, c + 144, b1); }
    }
};
struct EpiQ {
    bf16_t* Q; const float* rs; int rs0; int row0, col0;
    __device__ __forceinline__ void half(int row, int c, f32x4 v, float sc) const {
        const int h = c / 192, d = c - h * 192, b = row >> 11, s = row & 2047;
        st4(Q + ((size_t)((b * 4 + h) * SEQ + s)) * 192 + d, v * sc);
    }
    __device__ __forceinline__ void operator()(int r, int c32, int fq, f32x4 a, f32x4 b) const {
        const int row = row0 + r, c = col0 + c32 + 4 * fq; const float sc = rs[row - rs0] * QSCALE; half(row, c, a, sc); half(row, c + 16, b, sc); }
    struct Ctx { float sc; };
    __device__ __forceinline__ Ctx pre(int r, int c32, int fq) const { Ctx x; x.sc = rs[row0 + r - rs0] * QSCALE; return x; }
    __device__ __forceinline__ void post(int r, int c32, int fq, const Ctx& x, f32x4 a0, f32x4 b0, f32x4 a1, f32x4 b1) const {
        const int row = row0 + r, c = col0 + c32 + 4 * fq; half(row, c, a0, x.sc); half(row, c + 16, b0, x.sc); half(row, c + 128, a1, x.sc); half(row, c + 144, b1, x.sc); }
};
struct EpiKV {
    bf16_t *Kn, *Vt; const float* rs; int rs0; int row0, col0;
    __device__ __forceinline__ void half(int row, int c, f32x4 v, float sc) const {
        const int h = c >> 8, e = c & 255, b = row >> 11, s = row & 2047;
        v = v * sc;
        if (e < 128) st4(Kn + ((size_t)((b * 4 + h) * SEQ + s)) * 128 + e, v);
        else {
            bf16_t* vt = Vt + ((size_t)((b * 4 + h) * 128 + (e - 128))) * SEQ + (s & ~15) + perm16(s & 15);
            vt[0] = f2bf(v[0]); vt[SEQ] = f2bf(v[1]); vt[2 * SEQ] = f2bf(v[2]); vt[3 * SEQ] = f2bf(v[3]);
        }
    }
    __device__ __forceinline__ void operator()(int r, int c32, int fq, f32x4 a, f32x4 b) const {
        const int row = row0 + r, c = col0 + c32 + 4 * fq; const float sc = rs[row - rs0]; half(row, c, a, sc); half(row, c + 16, b, sc); }
    struct Ctx { float sc; };
    __device__ __forceinline__ Ctx pre(int r, int c32, int fq) const { Ctx x; x.sc = rs[row0 + r - rs0]; return x; }
    __device__ __forceinline__ void post(int r, int c32, int fq, const Ctx& x, f32x4 a0, f32x4 b0, f32x4 a1, f32x4 b1) const {
        const int row = row0 + r, c = col0 + c32 + 4 * fq; half(row, c, a0, x.sc); half(row, c + 16, b0, x.sc); half(row, c + 128, a1, x.sc); half(row, c + 144, b1, x.sc); }
};
struct EpiY {
    bf16_t* hb; int row0, col0; float* ystat;
    __device__ __forceinline__ void fin(bf16_t* p, u32x2 h, f32x4 v) const {
        v[0] += ALPHA * bflo(h.x); v[1] += ALPHA * bfhi(h.x); v[2] += ALPHA * bflo(h.y); v[3] += ALPHA * bfhi(h.y); st4(p, v); }
    __device__ __forceinline__ void fin2(bf16_t* p, u32x2 h, f32x4 v, float& s, float& q) const {
        v[0] += ALPHA * bflo(h.x); v[1] += ALPHA * bfhi(h.x); v[2] += ALPHA * bflo(h.y); v[3] += ALPHA * bfhi(h.y); st4(p, v);
        s += (v[0] + v[1]) + (v[2] + v[3]); q += (v[0] * v[0] + v[1] * v[1]) + (v[2] * v[2] + v[3] * v[3]); }
    __device__ __forceinline__ void half(int row, int c, f32x4 v) const { bf16_t* p = hb + (size_t)row * DM + c; fin(p, *(const u32x2*)p, v); }
    __device__ __forceinline__ void operator()(int r, int c32, int fq, f32x4 a, f32x4 b) const { const int row = row0 + r, c = col0 + c32 + 4 * fq; half(row, c, a); half(row, c + 16, b); }
    struct Ctx { u32x2 h[4]; }; static constexpr int BATCH4 = 1;
    __device__ __forceinline__ Ctx pre(int r, int c32, int fq) const { Ctx x; const bf16_t* p = hb + (size_t)(row0 + r) * DM + col0 + c32 + 4 * fq;
        x.h[0] = *(const u32x2*)p; x.h[1] = *(const u32x2*)(p + 16); x.h[2] = *(const u32x2*)(p + 128); x.h[3] = *(const u32x2*)(p + 144); return x; }
    __device__ __forceinline__ void post(int r, int c32, int fq, const Ctx& x, f32x4 a0, f32x4 b0, f32x4 a1, f32x4 b1) const {
        bf16_t* p = hb + (size_t)(row0 + r) * DM + col0 + c32 + 4 * fq;
        if (ystat) { float s = 0.f, q = 0.f; fin2(p, x.h[0], a0, s, q); fin2(p + 16, x.h[1], b0, s, q); fin2(p + 128, x.h[2], a1, s, q); fin2(p + 144, x.h[3], b1, s, q);
            s += shx(s, 16); s += shx(s, 32); q += shx(q, 16); q += shx(q, 32);
            if (fq == 0) { typedef float f32x2 __attribute__((ext_vector_type(2))); *(f32x2*)(ystat + ((size_t)(row0 + r) * 16 + (col0 >> 6) + (c32 >> 5)) * 2) = (f32x2){s, q}; } }
        else { fin(p, x.h[0], a0); fin(p + 16, x.h[1], b0); fin(p + 128, x.h[2], a1); fin(p + 144, x.h[3], b1); } }
};
struct EpiH {
    bf16_t* H; int hrow0, col0; bool wt;
    __device__ __forceinline__ void operator()(int r, int c32, int fq, f32x4 a, f32x4 b) const {
        const int hid = ((col0 + c32) >> 5) * 16 + 4 * fq;
        f32x4 o; o[0] = silu_f(a[0]) * b[0]; o[1] = silu_f(a[1]) * b[1]; o[2] = silu_f(a[2]) * b[2]; o[3] = silu_f(a[3]) * b[3];
        if (wt) st4wt(H + (size_t)(hrow0 + r) * FF + hid, o); else st4(H + (size_t)(hrow0 + r) * FF + hid, o);
    }
    struct Ctx { int dummy; };
    __device__ __forceinline__ Ctx pre(int, int, int) const { Ctx x; x.dummy = 0; return x; }
    __device__ __forceinline__ void post(int r, int c32, int fq, const Ctx&, f32x4 a0, f32x4 b0, f32x4 a1, f32x4 b1) const { (*this)(r, c32, fq, a0, b0); (*this)(r, c32 + 128, fq, a1, b1); }
};
struct EpiC {
    bf16_t* contrib; const int* list; const float* gates; int nvalid; int col0;
    __device__ __forceinline__ void operator()(int r, int c32, int fq, f32x4 a, f32x4 b) const {
        if (r >= nvalid) return;
        const int aid = list[r]; const float g = gates[aid];
        char* p = (char*)contrib + ((unsigned)aid * (unsigned)(DM * 2) + (unsigned)((col0 + c32 + 4 * fq) * 2));
        u32x2 w; w.x = pk2(a[0] * g, a[1] * g); w.y = pk2(a[2] * g, a[3] * g); *(u32x2*)p = w;
        w.x = pk2(b[0] * g, b[1] * g); w.y = pk2(b[2] * g, b[3] * g); *(u32x2*)(p + 32) = w;
    }
    struct Ctx { int aid; float g; };
    __device__ __forceinline__ Ctx pre(int r, int, int) const { Ctx x; x.aid = r < nvalid ? list[r] : -1; x.g = 0.f; return x; }
    __device__ __forceinline__ void pre2(Ctx& x) const { if (x.aid >= 0) x.g = gates[x.aid]; }
    __device__ __forceinline__ void post(int r, int c32, int fq, const Ctx& x, f32x4 a0, f32x4 b0, f32x4 a1, f32x4 b1) const {
        if (x.aid < 0) return;
        const float g = x.g;
        char* p = (char*)contrib + ((unsigned)x.aid * (unsigned)(DM * 2) + (unsigned)((col0 + c32 + 4 * fq) * 2));
        u32x2 w; w.x = pk2(a0[0] * g, a0[1] * g); w.y = pk2(a0[2] * g, a0[3] * g); *(u32x2*)p = w;
        w.x = pk2(b0[0] * g, b0[1] * g); w.y = pk2(b0[2] * g, b0[3] * g); *(u32x2*)(p + 32) = w;
        w.x = pk2(a1[0] * g, a1[1] * g); w.y = pk2(a1[2] * g, a1[3] * g); *(u32x2*)(p + 256) = w;
        w.x = pk2(b1[0] * g, b1[1] * g); w.y = pk2(b1[2] * g, b1[3] * g); *(u32x2*)(p + 288) = w;
    }
};

template <class EP> struct Unit { AMap am; const bf16_t* bt; int K; EP ep; };

__device__ __forceinline__ bool moe_unit(const int* cnt, int u, int ncol, int& e, int& rt, int& ct, int& padrow) {
    int acc = 0, fe = -1, facc = 0;
#pragma unroll 4
    for (int i = 0; i < NEXP; ++i) {
        const int t = (cnt[i] + 255) >> 8;
        if (fe < 0 && u < (acc + t) * ncol) { fe = i; facc = acc; }
        acc += t;
    }
    fe = __builtin_amdgcn_readfirstlane(fe); facc = __builtin_amdgcn_readfirstlane(facc);
    if (fe < 0) return false;
    const int w = u - facc * ncol; e = fe; rt = w / ncol; ct = w - rt * ncol; padrow = (facc + rt) * 256;
    return true;
}

struct PhZ { Params p; typedef EpiZ EP; static constexpr int NU = 128 * 7;
    __device__ __forceinline__ bool unit(int u, Unit<EP>& o) const { const int pm = u / 7, pn = u - pm * 7;
        o.am = AMap{p.hbuf + (size_t)pm * 256 * DM, DM, nullptr, 256}; o.bt = p.WinT + (size_t)pn * 256 * DM; o.K = DM;
        o.ep = EpiZ{p.zu, p.zv, p.zq, p.zkv, p.krope, p.rope, pm * 256, pn * 256}; return true; } };
struct PhQ { Params p; const float* rs; typedef EpiQ EP; static constexpr int NU = 128 * 3;
    __device__ __forceinline__ bool unit(int u, Unit<EP>& o) const { const int pm = u / 3, pn = u - pm * 3;
        o.am = AMap{p.zq + (size_t)pm * 256 * 384, 384, nullptr, 256}; o.bt = p.WuqT + (size_t)pn * 256 * 384; o.K = 384;
        o.ep = EpiQ{p.Q, rs, 0, pm * 256, pn * 256}; return true; } };
struct PhKV { Params p; const float* rs; typedef EpiKV EP; static constexpr int NU = 128 * 4;
    __device__ __forceinline__ bool unit(int u, Unit<EP>& o) const { const int pm = u >> 2, pn = u & 3;
        o.am = AMap{p.zkv + (size_t)pm * 256 * 256, 256, nullptr, 256}; o.bt = p.WukvT + (size_t)pn * 256 * 256; o.K = 256;
        o.ep = EpiKV{p.Kn, p.Vt, rs, 0, pm * 256, pn * 256}; return true; } };
struct PhY { Params p; typedef EpiY EP; static constexpr int NU = 128 * 4;
    __device__ __forceinline__ bool unit(int u, Unit<EP>& o) const { const int pm = u >> 2, pn = u & 3;
        o.am = AMap{p.mix + (size_t)pm * 256 * DM, DM, nullptr, 256}; o.bt = p.WoutT + (size_t)pn * 256 * DM; o.K = DM;
        o.ep = EpiY{p.hbuf, pm * 256, pn * 256, YSTAT ? p.ystat : nullptr}; return true; } };
struct PhH { Params p; typedef EpiH EP; static constexpr int NU = 288 * 2;
    __device__ __forceinline__ bool unit(int u, Unit<EP>& o) const { int e, rt, ct, pr; if (!moe_unit(p.cnt, u, 2, e, rt, ct, pr)) return false;
        const int nv = __builtin_amdgcn_readfirstlane(min(256, p.cnt[e] - rt * 256));
        o.am = AMap{p.hbuf, DM, p.list + (size_t)e * LIST_CAP + rt * 256, nv}; o.bt = p.WguT + ((size_t)e * 512 + ct * 256) * DM; o.K = DM;
        o.ep = EpiH{p.H, pr, ct * 256, false}; return true; } };
struct PhC { Params p; typedef EpiC EP; static constexpr int NU = 288 * 4;
    __device__ __forceinline__ bool unit(int u, Unit<EP>& o) const { int e, rt, ct, pr; if (!moe_unit(p.cnt, u, 4, e, rt, ct, pr)) return false;
        const int nv = __builtin_amdgcn_readfirstlane(min(256, p.cnt[e] - rt * 256));
        o.am = AMap{p.H + (size_t)pr * FF, FF, nullptr, 256}; o.bt = p.WdT + ((size_t)e * DM + ct * 256) * FF; o.K = FF;
        o.ep = EpiC{p.contrib, p.list + (size_t)e * LIST_CAP + rt * 256, p.gates, nv, ct * 256}; return true; } };


template <int XMODE> struct EpiProbe {
    const bf16_t* hb; bf16_t* ob; int row0, col0;
    __device__ __forceinline__ void operator()(int, int, int, f32x4, f32x4) const {}
    struct Ctx { u32x2 h[4]; };
    __device__ __forceinline__ Ctx pre(int r, int c32, int fq) const { Ctx x; const bf16_t* p = hb + (size_t)(row0 + r) * DM + col0 + c32 + 4 * fq;
        if (XMODE == 1) { x.h[0] = *(const u32x2*)p; x.h[1] = *(const u32x2*)(p + 16); x.h[2] = *(const u32x2*)(p + 128); x.h[3] = *(const u32x2*)(p + 144); }
        else { x.h[0] = x.h[1] = x.h[2] = x.h[3] = (u32x2){0u, 0u}; }
        return x; }
    __device__ __forceinline__ void fin(bf16_t* p, u32x2 h, f32x4 v) const {
        v[0] += ALPHA * bflo(h.x); v[1] += ALPHA * bfhi(h.x); v[2] += ALPHA * bflo(h.y); v[3] += ALPHA * bfhi(h.y); st4(p, v); }
    __device__ __forceinline__ void post(int r, int c32, int fq, const Ctx& x, f32x4 a0, f32x4 b0, f32x4 a1, f32x4 b1) const {
        if (XMODE == 2) { asm volatile("" :: "v"(a0), "v"(b0), "v"(a1), "v"(b1)); return; }
        if (XMODE == 4) {
            bf16_t* q = ob + (size_t)(row0 + r) * DM + col0 + (c32 >> 5) * 64 + 16 * fq; u32x4 w0, w1;
            w0.x = pk2(a0[0], a0[1]); w0.y = pk2(a0[2], a0[3]); w0.z = pk2(b0[0], b0[1]); w0.w = pk2(b0[2], b0[3]);
            w1.x = pk2(a1[0], a1[1]); w1.y = pk2(a1[2], a1[3]); w1.z = pk2(b1[0], b1[1]); w1.w = pk2(b1[2], b1[3]);
            *(u32x4*)q = w0; *(u32x4*)(q + 8) = w1; return; }
        bf16_t* p = ob + (size_t)(row0 + r) * DM + col0 + c32 + 4 * fq; fin(p, x.h[0], a0); fin(p + 16, x.h[1], b0); fin(p + 128, x.h[2], a1); fin(p + 144, x.h[3], b1); }
};
template <int XMODE> struct PhYp { Params p; typedef EpiProbe<XMODE> EP; static constexpr int NU = 128 * 4;
    __device__ __forceinline__ bool unit(int u, Unit<EP>& o) const { const int pm = u >> 2, pn = u & 3;
        o.am = AMap{p.mix + (size_t)pm * 256 * DM, DM, nullptr, 256}; o.bt = p.WoutT + (size_t)pn * 256 * DM; o.K = DM;
        o.ep = EP{p.hbuf, p.contrib, pm * 256, pn * 256}; return true; } };

__device__ __forceinline__ void wtile(const float* s0, const float* s1, int ldsrc, bf16_t* dst, int K, int k0, int n0, int mode, const float* kscale, float* tile, int tid, int nthr) {
    for (int idx = tid; idx < 4096; idx += nthr) {
        const int kk = idx >> 6, n = n0 + (idx & 63);
        const float* s = s0; int col = n;
        if (mode == 1) { if (n >= 1728) col = -1; else if (n >= 1664) { const int i = (n - 1664) >> 1, pp = (n - 1664) & 1; col = 1664 + i + 32 * pp; } }
        else if (mode == 2) { const int h = n / 192, d = n - h * 192; if (d >= 128) { const int i = (d - 128) >> 1, pp = (d - 128) & 1; col = h * 192 + 128 + i + 32 * pp; } }
        else if (mode == 3) { const int G = n >> 5, r = n & 31; col = 16 * G + (r & 15); s = (r < 16) ? s0 : s1; }
        float v = 0.f;
        if (col >= 0) { v = s[(size_t)(k0 + kk) * ldsrc + col]; if (kscale) v *= kscale[k0 + kk]; }
        tile[kk * 65 + (idx & 63)] = v;
    }
    __syncthreads();
    for (int idx = tid; idx < 4096; idx += nthr) {
        const int nn = idx >> 6, kk = idx & 63;
        dst[(size_t)(n0 + nn) * K + k0 + kk] = f2bf(tile[kk * 65 + nn]);
    }
    __syncthreads();
}
constexpr int J_IN = 28 * 16, J_UQ = 12 * 6, J_UKV = 16 * 4, J_OUT = 16 * 16, J_GU = 32 * 8 * 16, J_DN = 32 * 16 * 4;
constexpr int J_TOTAL = J_IN + J_UQ + J_UKV + J_OUT + J_GU + J_DN;
__device__ __forceinline__ void prep_wjob(const Params& p, int job, float* tile, int tid, int nthr) {
    if (job < J_IN) { const int nb = job >> 4, kb = job & 15; wtile(p.w_in, nullptr, 1728, p.WinT, 1024, kb * 64, nb * 64, 1, nullptr, tile, tid, nthr); return; } job -= J_IN;
    if (job < J_UQ) { const int nb = job / 6, kb = job - nb * 6; wtile(p.w_uq, nullptr, 768, p.WuqT, 384, kb * 64, nb * 64, 0, p.qn_g, tile, tid, nthr); return; } job -= J_UQ;
    if (job < J_UKV) { const int nb = job >> 2, kb = job & 3; wtile(p.w_ukv, nullptr, 1024, p.WukvT, 256, kb * 64, nb * 64, 0, p.kvn_g, tile, tid, nthr); return; } job -= J_UKV;
    if (job < J_OUT) { const int nb = job >> 4, kb = job & 15; wtile(p.w_out, nullptr, 1024, p.WoutT, 1024, kb * 64, nb * 64, 0, nullptr, tile, tid, nthr); return; } job -= J_OUT;
    if (job < J_GU) { const int e = job >> 7, r = job & 127, nb = r >> 4, kb = r & 15;
        wtile(p.w_gate + (size_t)e * 1024 * 256, p.w_up + (size_t)e * 1024 * 256, 256, p.WguT + (size_t)e * 512 * 1024, 1024, kb * 64, nb * 64, 3, nullptr, tile, tid, nthr); return; } job -= J_GU;
    { const int e = job >> 6, r = job & 63, nb = r >> 2, kb = r & 3;
        wtile(p.w_down + (size_t)e * 256 * 1024, nullptr, 1024, p.WdT + (size_t)e * 1024 * 256, 256, kb * 64, nb * 64, 0, nullptr, tile, tid, nthr); }
}
__device__ __forceinline__ void ln0_row(const float* xr, const float* g, const float* b, bf16_t* orow, int lane) {
    f32x4 v[4]; float s = 0.f;
#pragma unroll
    for (int j = 0; j < 4; ++j) { v[j] = *(const f32x4*)(xr + 256 * j + 4 * lane); s += (v[j][0] + v[j][1]) + (v[j][2] + v[j][3]); }
    const float mean = wave_sum(s) * (1.f / 1024.f); float s2 = 0.f;
#pragma unroll
    for (int j = 0; j < 4; ++j) { v[j] = v[j] - mean; s2 += (v[j][0] * v[j][0] + v[j][1] * v[j][1]) + (v[j][2] * v[j][2] + v[j][3] * v[j][3]); }
    const float rstd = 1.f / sqrtf(wave_sum(s2) * (1.f / 1024.f) + 1e-5f);
#pragma unroll
    for (int j = 0; j < 4; ++j) { const f32x4 gg = *(const f32x4*)(g + 256 * j + 4 * lane), bb = *(const f32x4*)(b + 256 * j + 4 * lane);
        st4(orow + 256 * j + 4 * lane, v[j] * rstd * gg + bb); }
}
__device__ __forceinline__ void rope_entry(const Params& p, int idx) {
    const int t = idx >> 5, i = idx & 31;
    const float inv = powf(10000.f, -(float)(2 * i) / 64.f);
    const float ang = (float)p.pos[t] * inv;
    p.rope[idx] = make_float2(cosf(ang), sinf(ang));
}

__device__ __forceinline__ void router_token(const Params& p, int t, int lane, const float* wr  , int wstride) {
    bf16_t* hr = p.hbuf + (size_t)t * DM;
    f32x4 v[4]; float s = 0.f;
#pragma unroll
    for (int j = 0; j < 4; ++j) { const u32x2 w = *(const u32x2*)(hr + 256 * j + 4 * lane); v[j][0] = bflo(w.x); v[j][1] = bfhi(w.x); v[j][2] = bflo(w.y); v[j][3] = bfhi(w.y);
        s += (v[j][0] + v[j][1]) + (v[j][2] + v[j][3]); }
    const float mean = wave_sum(s) * (1.f / 1024.f); float s2 = 0.f;
#pragma unroll
    for (int j = 0; j < 4; ++j) { v[j] = v[j] - mean; s2 += (v[j][0] * v[j][0] + v[j][1] * v[j][1]) + (v[j][2] * v[j][2] + v[j][3] * v[j][3]); }
    const float rstd = 1.f / sqrtf(wave_sum(s2) * (1.f / 1024.f) + 1e-5f);
#pragma unroll
    for (int j = 0; j < 4; ++j) { const f32x4 gg = *(const f32x4*)(p.ln1_g + 256 * j + 4 * lane), bb = *(const f32x4*)(p.ln1_b + 256 * j + 4 * lane);
        v[j] = v[j] * rstd * gg + bb; st4(hr + 256 * j + 4 * lane, v[j]); }
    float lg[36];
#pragma unroll
    for (int o = 0; o < 36; ++o) { float a = 0.f;
#pragma unroll
        for (int j = 0; j < 4; ++j) { const f32x4 w = *(const f32x4*)(wr + o * wstride + 256 * j + 4 * lane); a += (v[j][0] * w[0] + v[j][1] * w[1]) + (v[j][2] * w[2] + v[j][3] * w[3]); }
        lg[o] = wave_sum(a); }
#pragma unroll
    for (int o = 0; o < 4; ++o) lg[o] += p.b_rg[o];
#pragma unroll
    for (int o = 0; o < 32; ++o) lg[4 + o] += p.b_re[o];
    int g = 0; float gm = lg[0];
#pragma unroll
    for (int i = 1; i < 4; ++i) if (lg[i] > gm) { gm = lg[i]; g = i; }
    float se = 0.f;
#pragma unroll
    for (int i = 0; i < 4; ++i) se += expf(lg[i] - gm);
    const float pg = 1.f / se;
    float ev[8];
#pragma unroll
    for (int e = 0; e < 8; ++e) ev[e] = g == 0 ? lg[4 + e] : g == 1 ? lg[12 + e] : g == 2 ? lg[20 + e] : lg[28 + e];
    int i1 = 0; float v1 = ev[0];
#pragma unroll
    for (int e = 1; e < 8; ++e) if (ev[e] > v1) { v1 = ev[e]; i1 = e; }
    int i2 = -1; float v2 = -3.0e38f;
#pragma unroll
    for (int e = 0; e < 8; ++e) if (e != i1 && ev[e] > v2) { v2 = ev[e]; i2 = e; }
    const float d = expf(v2 - v1), g1 = pg / (1.f + d), g2 = pg * d / (1.f + d);
    if (lane < 2) {
        const int ex = g * 8 + (lane == 0 ? i1 : i2), aid = 2 * t + lane;
        const int slot = atomicAdd(p.cnt + ex, 1);
        p.list[(size_t)ex * LIST_CAP + slot] = aid;
        p.gates[aid] = lane == 0 ? g1 : g2;
    }
}
__device__ __forceinline__ void final_token(const Params& p, int t, int lane) {
    const bf16_t* hr = p.hbuf + (size_t)t * DM; const bf16_t* c0 = p.contrib + (size_t)(2 * t) * DM; const bf16_t* c1 = c0 + DM;
    f32x4 v[4]; float s = 0.f;
#pragma unroll
    for (int j = 0; j < 4; ++j) { const int o = 256 * j + 4 * lane; const u32x2 w = *(const u32x2*)(hr + o), a = *(const u32x2*)(c0 + o), b = *(const u32x2*)(c1 + o);
        v[j][0] = ALPHA * bflo(w.x) + bflo(a.x) + bflo(b.x); v[j][1] = ALPHA * bfhi(w.x) + bfhi(a.x) + bfhi(b.x);
        v[j][2] = ALPHA * bflo(w.y) + bflo(a.y) + bflo(b.y); v[j][3] = ALPHA * bfhi(w.y) + bfhi(a.y) + bfhi(b.y);
        s += (v[j][0] + v[j][1]) + (v[j][2] + v[j][3]); }
    const float mean = wave_sum(s) * (1.f / 1024.f); float s2 = 0.f;
#pragma unroll
    for (int j = 0; j < 4; ++j) { v[j] = v[j] - mean; s2 += (v[j][0] * v[j][0] + v[j][1] * v[j][1]) + (v[j][2] * v[j][2] + v[j][3] * v[j][3]); }
    const float rstd = 1.f / sqrtf(wave_sum(s2) * (1.f / 1024.f) + 1e-5f);
#pragma unroll
    for (int j = 0; j < 4; ++j) { const int o = 256 * j + 4 * lane; const f32x4 gg = *(const f32x4*)(p.ln2_g + o), bb = *(const f32x4*)(p.ln2_b + o);
        *(f32x4*)(p.out + (size_t)t * DM + o) = v[j] * rstd * gg + bb; }
}


__device__ __forceinline__ void final_token2(const Params& p, int t0, int t1, int lane) {
    f32x4 v[2][4]; float s[2] = {0.f, 0.f}, q[2] = {0.f, 0.f};
    u32x2 w[2][4], a[2][4], b[2][4];
#pragma unroll
    for (int k = 0; k < 2; ++k) { const int t = k ? t1 : t0; const bf16_t* hr = p.hbuf + (size_t)t * DM; const bf16_t* c0 = p.contrib + (size_t)(2 * t) * DM; const bf16_t* c1 = c0 + DM;
#pragma unroll
        for (int j = 0; j < 4; ++j) { const int o = 256 * j + 4 * lane; w[k][j] = *(const u32x2*)(hr + o); a[k][j] = *(const u32x2*)(c0 + o); b[k][j] = *(const u32x2*)(c1 + o); } }
#pragma unroll
    for (int k = 0; k < 2; ++k)
#pragma unroll
        for (int j = 0; j < 4; ++j) {
            v[k][j][0] = ALPHA * bflo(w[k][j].x) + bflo(a[k][j].x) + bflo(b[k][j].x); v[k][j][1] = ALPHA * bfhi(w[k][j].x) + bfhi(a[k][j].x) + bfhi(b[k][j].x);
            v[k][j][2] = ALPHA * bflo(w[k][j].y) + bflo(a[k][j].y) + bflo(b[k][j].y); v[k][j][3] = ALPHA * bfhi(w[k][j].y) + bfhi(a[k][j].y) + bfhi(b[k][j].y);
            s[k] += (v[k][j][0] + v[k][j][1]) + (v[k][j][2] + v[k][j][3]);
            q[k] += (v[k][j][0] * v[k][j][0] + v[k][j][1] * v[k][j][1]) + (v[k][j][2] * v[k][j][2] + v[k][j][3] * v[k][j][3]); }
#pragma unroll
    for (int o2 = 1; o2 < 64; o2 <<= 1) { s[0] += shx(s[0], o2); s[1] += shx(s[1], o2); q[0] += shx(q[0], o2); q[1] += shx(q[1], o2); }
#pragma unroll
    for (int k = 0; k < 2; ++k) { const int t = k ? t1 : t0; const float mean = s[k] * (1.f / 1024.f), var = fmaxf(q[k] * (1.f / 1024.f) - mean * mean, 0.f), rstd = 1.f / sqrtf(var + 1e-5f);
#pragma unroll
        for (int j = 0; j < 4; ++j) { const int o = 256 * j + 4 * lane; const f32x4 gg = *(const f32x4*)(p.ln2_g + o), bb = *(const f32x4*)(p.ln2_b + o);
            *(f32x4*)(p.out + (size_t)t * DM + o) = (v[k][j] - mean) * rstd * gg + bb; } }
}

__global__ __launch_bounds__(256) void nk_prep_w(Params p) { __shared__ float tile[64 * 65]; prep_wjob(p, blockIdx.x, tile, threadIdx.x, 256); }
__global__ __launch_bounds__(256) void nk_ln0(Params p) { const int t = blockIdx.x * 4 + (threadIdx.x >> 6); ln0_row(p.x + (size_t)t * DM, p.ln0_g, p.ln0_b, p.hbuf + (size_t)t * DM, threadIdx.x & 63); }
__global__ __launch_bounds__(256) void nk_rope(Params p) { rope_entry(p, blockIdx.x * 256 + threadIdx.x); if (blockIdx.x == 0 && threadIdx.x < NEXP) p.cnt[threadIdx.x] = 0; }
__global__ __launch_bounds__(256) void nk_rowscale(Params p) {
    const int t = blockIdx.x * 4 + (threadIdx.x >> 6), lane = threadIdx.x & 63;
    float s = 0.f; for (int i = lane; i < 384; i += 64) { const float v = bf2f(p.zq[(size_t)t * 384 + i]); s += v * v; }
    s = wave_sum(s); float s2 = 0.f; for (int i = lane; i < 256; i += 64) { const float v = bf2f(p.zkv[(size_t)t * 256 + i]); s2 += v * v; }
    s2 = wave_sum(s2);
    if (lane == 0) { p.rsq[t] = 1.f / sqrtf(s * (1.f / 384.f) + 1e-6f); p.rskv[t] = 1.f / sqrtf(s2 * (1.f / 256.f) + 1e-6f); }
}
template <class PH> __global__ __launch_bounds__(256) void nk_gemm(PH ph) {
    Unit<typename PH::EP> u; if (!ph.unit(blockIdx.x, u)) return;
    const int wave = threadIdx.x >> 6, lane = threadIdx.x & 63, fr = lane & 15, fq = lane >> 4;
    const int task = blockIdx.y * 4 + wave, rb = task >> 3, cg = task & 7;
    const bf16_t* arow = u.am.row(rb * 16 + fr);
    const bf16_t* b0 = u.bt + (size_t)(cg * 32 + fr) * u.K; const bf16_t* b1 = b0 + (size_t)16 * u.K;
    f32x4 acc0 = {0.f, 0.f, 0.f, 0.f}, acc1 = {0.f, 0.f, 0.f, 0.f};
    for (int k = 0; k < u.K; k += 32) {
        const bf16x8 a = *(const bf16x8*)(arow + k + 8 * fq), x0 = *(const bf16x8*)(b0 + k + 8 * fq), x1 = *(const bf16x8*)(b1 + k + 8 * fq);
        acc0 = __builtin_amdgcn_mfma_f32_16x16x32_bf16(x0, a, acc0, 0, 0, 0);
        acc1 = __builtin_amdgcn_mfma_f32_16x16x32_bf16(x1, a, acc1, 0, 0, 0);
    }
    u.ep(rb * 16 + fr, cg * 32, fq, acc0, acc1);
}
__global__ __launch_bounds__(256) void nk_gmlp(Params p) {
    extern __shared__ float sm[];
    const int unit = blockIdx.x, h = unit & 3, bn = unit >> 2, row0 = bn * 128;
    const int wave = threadIdx.x >> 6, lane = threadIdx.x & 63;
    for (int j = wave; j < 128; j += 4) {
        const bf16_t* vr = p.zv + (size_t)(row0 + j) * 512 + h * 128;
        const float a = bf2f(vr[lane]), b = bf2f(vr[lane + 64]);
        const float mean = wave_sum(a + b) * (1.f / 128.f); const float da = a - mean, db = b - mean;
        const float rstd = 1.f / sqrtf(wave_sum(da * da + db * db) * (1.f / 128.f) + 1e-5f);
        sm[j * 129 + lane] = da * rstd * p.gm_g[h * 128 + lane] + p.gm_b[h * 128 + lane];
        sm[j * 129 + lane + 64] = db * rstd * p.gm_g[h * 128 + lane + 64] + p.gm_b[h * 128 + lane + 64];
    }
    __syncthreads();
    for (int idx = threadIdx.x; idx < 16384; idx += 256) {
        const int i = idx >> 7, c = idx & 127; const int jn = i < 64 ? 64 : 128;
        const float* w = p.w_sp + ((size_t)h * 128 + i) * 128; float f = p.b_sp[h * 128 + i];
        for (int j = 0; j < jn; ++j) f += w[j] * sm[j * 129 + c];
        const float u = bf2f(p.zu[(size_t)(row0 + i) * 512 + h * 128 + c]);
        p.mix[(size_t)(row0 + i) * DM + h * 128 + c] = f2bf(u * f);
    }
}
__global__ __launch_bounds__(256) void nk_attn(Params p) {
    extern __shared__ float sm[];
    float* Qs = sm; float* Ks = Qs + 64 * 192; float* Ss = Ks + 64 * 193; float* Vs = Ss + 64 * 65;
    const int qc = blockIdx.x & 31, bh = blockIdx.x >> 5, b = bh >> 2, h = bh & 3, tid = threadIdx.x, q = tid >> 2, sub = tid & 3;
    for (int idx = tid; idx < 64 * 192; idx += 256) { const int r = idx / 192, d = idx - r * 192; Qs[idx] = bf2f(p.Q[((size_t)bh * SEQ + qc * 64 + r) * 192 + d]); }
    __syncthreads();
    for (int idx = tid; idx < 64 * 32; idx += 256) { const int r = idx >> 5, i = idx & 31; const float2 cs = p.rope[((size_t)b * SEQ + qc * 64 + r) * 32 + i];
        const float x1 = Qs[r * 192 + 128 + i], x2 = Qs[r * 192 + 160 + i]; Qs[r * 192 + 128 + i] = x1 * cs.x - x2 * cs.y; Qs[r * 192 + 160 + i] = x2 * cs.x + x1 * cs.y; }
    float O[32]; float m = -INFINITY, l = 0.f;
#pragma unroll
    for (int j = 0; j < 32; ++j) O[j] = 0.f;
    for (int kt = 0; kt <= qc; ++kt) {
        __syncthreads();
        for (int idx = tid; idx < 64 * 192; idx += 256) { const int r = idx / 192, d = idx - r * 192; const int key = kt * 64 + r;
            Ks[r * 193 + d] = d < 128 ? bf2f(p.Kn[((size_t)bh * SEQ + key) * 128 + d]) : bf2f(p.krope[((size_t)b * SEQ + key) * 64 + d - 128]); }
        for (int idx = tid; idx < 64 * 128; idx += 256) { const int r = idx >> 7, dv = idx & 127; const int key = kt * 64 + r;
            Vs[r * 128 + dv] = bf2f(p.Vt[((size_t)bh * 128 + dv) * SEQ + (key & ~15) + perm16(key & 15)]); }
        __syncthreads();
        for (int kk = 0; kk < 16; ++kk) { const int key = sub * 16 + kk; float s = 0.f;
            for (int d = 0; d < 192; ++d) s += Qs[q * 192 + d] * Ks[key * 193 + d];
            Ss[q * 65 + key] = s; }
        __syncthreads();
        float mt = -INFINITY; for (int k = 0; k < 64; ++k) mt = fmaxf(mt, Ss[q * 65 + k]);
        const float mn = fmaxf(m, mt), alpha = exp2f(m - mn); m = mn; l *= alpha;
#pragma unroll
        for (int j = 0; j < 32; ++j) O[j] *= alpha;
        for (int k = 0; k < 64; ++k) { const float pk = exp2f(Ss[q * 65 + k] - mn); l += pk;
#pragma unroll
            for (int j = 0; j < 32; ++j) O[j] += pk * Vs[k * 128 + sub * 32 + j]; }
    }
    const float inv = 1.f / l; bf16_t* o = p.mix + ((size_t)b * SEQ + qc * 64 + q) * DM + 512 + h * 128 + sub * 32;
#pragma unroll
    for (int j = 0; j < 32; ++j) o[j] = f2bf(O[j] * inv);
}
__global__ __launch_bounds__(256) void nk_router(Params p) {
    const int t = blockIdx.x * 4 + (threadIdx.x >> 6);
    router_token(p, t, threadIdx.x & 63, (const float*)p.H, 1024);
}
__global__ __launch_bounds__(256) void nk_router_prep(Params p) {
    const int idx = blockIdx.x * 256 + threadIdx.x; if (idx >= 36 * 1024) return;
    const int o = idx >> 10, k = idx & 1023;
    ((float*)p.H)[idx] = o < 4 ? p.w_rg[k * 4 + o] : p.w_re[k * 32 + (o - 4)];
}
__global__ __launch_bounds__(256) void nk_final(Params p) { final_token(p, blockIdx.x * 4 + (threadIdx.x >> 6), threadIdx.x & 63); }

constexpr int LDS_BYTES = 152 * 1024, LDS_RS = 150 * 1024, LDS_XB = 151 * 1024;
constexpr int LDS_PRE = 128 * 1024, LDS_TOT = 144 * 1024, LDS_SEG = LDS_TOT + 256, LDS_AID = LDS_SEG + 2048;
constexpr int LDS_RW = 0, LDS_LCNT = 144 * 1024 + 512;
constexpr int NTHR = 512;

#ifndef EARLY_WB
#define EARLY_WB 0
#endif
#define XB_TMO      128
#define XB_XCNT(j)  (256  + 64 * (j))
#define XB_XSUB(j)  (1280 + 64 * (j))
#define XB_XGEN(j)  (2304 + 64 * (j))
#define XB_TOP      3328
#define XB_TOPGEN   3392
#define XCD_BAR_WORDS 3456
#define XB_SPIN_CAP (1u << 20)
__device__ __forceinline__ unsigned xb_ld(unsigned* p) { return __hip_atomic_load(p, __ATOMIC_RELAXED, __HIP_MEMORY_SCOPE_AGENT); }
__device__ __forceinline__ unsigned xb_add(unsigned* p, unsigned v) { return __hip_atomic_fetch_add(p, v, __ATOMIC_RELAXED, __HIP_MEMORY_SCOPE_AGENT); }
__device__ __forceinline__ unsigned xb_xcc_id() { return (unsigned)__builtin_amdgcn_s_getreg((3 << 11) | 20) & 0xFu; }
#define XB_SPIN(cond, bar) do { unsigned _sp = 0; while (cond) { __builtin_amdgcn_s_sleep(1); \
    if ((++_sp & 255u) == 0u) { if (xb_ld(&(bar)[XB_TMO])) break; if (_sp > XB_SPIN_CAP) { atomicAdd(&(bar)[XB_TMO], 1u); break; } } } } while (0)
struct XcdBarrier { unsigned* bar; unsigned x; volatile LAS unsigned* st; };
__device__ __forceinline__ XcdBarrier xcd_barrier_post(unsigned* bar, volatile LAS unsigned* st) {
    XcdBarrier b; b.bar = bar; b.x = xb_xcc_id(); b.st = st;
    if (threadIdx.x == 0) (void)xb_add(&bar[XB_XCNT(b.x)], 1u);
    return b;
}
__device__ __forceinline__ void xcd_barrier_complete(unsigned* bar, unsigned x, unsigned& nloc, unsigned& nx) {
    const unsigned G = gridDim.x * gridDim.y * gridDim.z;
    unsigned sum, cnt, mine, sp = 0u;
    for (;;) {
        sum = 0u; cnt = 0u; mine = 0u;
#pragma unroll
        for (unsigned j = 0; j < 16; ++j) { const unsigned c = xb_ld(&bar[XB_XCNT(j)]); sum += c; cnt += (c > 0u) ? 1u : 0u; mine = (j == x) ? c : mine; }
        if (sum == G) break;
        __builtin_amdgcn_s_sleep(1);
        if ((++sp & 255u) == 0u) { if (xb_ld(&bar[XB_TMO])) break; if (sp > XB_SPIN_CAP) { atomicAdd(&bar[XB_TMO], 1u); break; } }
    }
    nloc = mine > 0u ? mine : 1u; nx = cnt > 0u ? cnt : 1u;
}
__device__ __forceinline__ void xcd_barrier(const XcdBarrier& b) {
    asm volatile("s_waitcnt vmcnt(0)" ::: "memory");
    __syncthreads();
    if (threadIdx.x == 0) {
        unsigned* bar = b.bar;
        __builtin_amdgcn_s_waitcnt(0);
        unsigned nloc = b.st[0], nx = b.st[1];
        if (nloc == 0u) { xcd_barrier_complete(bar, b.x, nloc, nx); b.st[0] = nloc; b.st[1] = nx; }
#if EARLY_WB
        __builtin_amdgcn_fence(__ATOMIC_RELEASE, "agent"); asm volatile("s_waitcnt vmcnt(0)" ::: "memory");
#endif
        const unsigned old = xb_add(&bar[XB_XSUB(b.x)], 1u);
        const unsigned gen = old / nloc;
        if (old + 1u == (gen + 1u) * nloc) {
            __builtin_amdgcn_fence(__ATOMIC_RELEASE, "agent");
            asm volatile("s_waitcnt vmcnt(0)" ::: "memory");
            const unsigned og = xb_add(&bar[XB_TOP], 1u);
            const unsigned tg = og / nx;
            if (og + 1u == (tg + 1u) * nx) xb_add(&bar[XB_TOPGEN], 1u);
            else XB_SPIN(xb_ld(&bar[XB_TOPGEN]) == tg, bar);
            __builtin_amdgcn_fence(__ATOMIC_ACQUIRE, "agent");
            xb_add(&bar[XB_XGEN(b.x)], 1u);
            asm volatile("s_waitcnt vmcnt(0)" ::: "memory");
        } else {
            XB_SPIN(xb_ld(&bar[XB_XGEN(b.x)]) == gen, bar);
            __builtin_amdgcn_fence(__ATOMIC_ACQUIRE, "agent");
            asm volatile("s_waitcnt vmcnt(0)" ::: "memory");
        }
    }
    __syncthreads();
}

constexpr int BK = 64, HALF = 128, HT = HALF * BK;
__device__ __forceinline__ int lds_byte(int r, int c) { const int st = (r >> 4) * 2 + (c >> 5), rr = r & 15, cc = c & 31, ob = rr * 64 + cc * 2; return st * 1024 + (ob ^ (((ob >> 9) & 1) << 5)); }
__device__ __forceinline__ void stage_rc(int b, int& R, int& C) { const int st = b / 1024, sb = b % 1024, swz = sb ^ (((sb >> 9) & 1) << 5); R = (st >> 1) * 16 + swz / 64; C = (st & 1) * 32 + (swz % 64) / 2; }

template <class PH> struct HasNext { template <class T> static char test(decltype(&T::next)); template <class T> static long test(...); static constexpr bool value = sizeof(test<PH>(nullptr)) == 1; };
template <class PH> struct HasDone { template <class T> static char test(decltype(&T::done)); template <class T> static long test(...); static constexpr bool value = sizeof(test<PH>(nullptr)) == 1; };
template <class EP> struct HasPre2 { template <class T> static char test(decltype(&T::pre2)); template <class T> static long test(...); static constexpr bool value = sizeof(test<EP>(nullptr)) == 1; };
template <class EP> struct IsBatch4 { template <class T> static char test(decltype(&T::BATCH4)); template <class T> static long test(...); static constexpr bool value = sizeof(test<EP>(nullptr)) == 1; };
template <class EP> __device__ __forceinline__ void run_epilogue(const EP& ep, const f32x4 (&acc)[2][2][4][2], int wr, int wc, int fr, int fq) {
    int rb = wr * 64 + fr, fq_ = fq; asm volatile("" : "+v"(rb), "+v"(fq_));
    if constexpr (IsBatch4<EP>::value) {
#pragma unroll
        for (int ai = 0; ai < 2; ++ai) {
            typename EP::Ctx cx[4];
#pragma unroll
            for (int m = 0; m < 4; ++m) cx[m] = ep.pre(ai * HALF + m * 16 + rb, wc * 32, fq_);
            if constexpr (HasPre2<EP>::value) {
#pragma unroll
                for (int m = 0; m < 4; ++m) ep.pre2(cx[m]);
            }
#pragma unroll
            for (int m = 0; m < 4; ++m) ep.post(ai * HALF + m * 16 + rb, wc * 32, fq_, cx[m], acc[ai][0][m][0], acc[ai][0][m][1], acc[ai][1][m][0], acc[ai][1][m][1]);
        }
    } else {
        typename EP::Ctx cx[8];
#pragma unroll
        for (int i = 0; i < 8; ++i) cx[i] = ep.pre((i >> 2) * HALF + (i & 3) * 16 + rb, wc * 32, fq_);
        if constexpr (HasPre2<EP>::value) {
#pragma unroll
            for (int i = 0; i < 8; ++i) ep.pre2(cx[i]);
        }
#pragma unroll
        for (int i = 0; i < 8; ++i) ep.post((i >> 2) * HALF + (i & 3) * 16 + rb, wc * 32, fq_, cx[i], acc[i >> 2][0][i & 3][0], acc[i >> 2][0][i & 3][1], acc[i >> 2][1][i & 3][0], acc[i >> 2][1][i & 3][1]);
    }
}
struct GmArgs { const float *gm_g, *gm_b, *w_sp, *b_sp; bf16_t* mix; int row0, h; };
__device__ __forceinline__ void gmlp_epilogue(f32x4 (&acc)[2][2][4][2], const GmArgs& g, char* lds, int wr, int wc, int fr, int fq) {
    typedef float f32x2 __attribute__((ext_vector_type(2)));
    f32x2* P = (f32x2*)lds;
    char* vT = lds + 8192;
#pragma unroll
    for (int ai = 0; ai < 2; ++ai)
#pragma unroll
        for (int bj = 0; bj < 2; ++bj)
#pragma unroll
            for (int m = 0; m < 4; ++m)
#pragma unroll
                for (int n = 0; n < 2; ++n)
#pragma unroll
                    for (int t = 0; t < 4; ++t) acc[ai][bj][m][n][t] = gelu_tanh(acc[ai][bj][m][n][t]);
#pragma unroll
    for (int ai = 0; ai < 2; ++ai)
#pragma unroll
        for (int m = 0; m < 4; ++m) { float s = 0.f, q = 0.f;
#pragma unroll
            for (int n = 0; n < 2; ++n)
#pragma unroll
                for (int t = 0; t < 4; ++t) { const float x = acc[ai][1][m][n][t]; s += x; q += x * x; }
            s += shx(s, 16); s += shx(s, 32); q += shx(q, 16); q += shx(q, 32);
            if (fq == 0) P[(ai * 128 + wr * 64 + m * 16 + fr) * 4 + wc] = (f32x2){s, q}; }
    __syncthreads();
    const int c0 = wc * 32 + 4 * fq;
    f32x4 gg[2], bb[2];
#pragma unroll
    for (int n = 0; n < 2; ++n) { gg[n] = *(const f32x4*)(g.gm_g + g.h * 128 + c0 + 16 * n); bb[n] = *(const f32x4*)(g.gm_b + g.h * 128 + c0 + 16 * n); }
#pragma unroll
    for (int ai = 0; ai < 2; ++ai)
#pragma unroll
        for (int m = 0; m < 4; ++m) { const int row = ai * 128 + wr * 64 + m * 16 + fr, j = wr * 64 + m * 16 + fr;
            const f32x2 p0 = P[row * 4 + 0], p1 = P[row * 4 + 1], p2 = P[row * 4 + 2], p3 = P[row * 4 + 3];
            const float mean = ((p0.x + p1.x) + (p2.x + p3.x)) * (1.f / 128.f), var = fmaxf(((p0.y + p1.y) + (p2.y + p3.y)) * (1.f / 128.f) - mean * mean, 0.f), rstd = 1.f / sqrtf(var + 1e-5f);
#pragma unroll
            for (int n = 0; n < 2; ++n)
#pragma unroll
                for (int t = 0; t < 4; ++t) *(bf16_t*)(vT + ai * (128 * 272) + (c0 + 16 * n + t) * 272 + j * 2) = f2bf((acc[ai][1][m][n][t] - mean) * rstd * gg[n][t] + bb[n][t]); }
    __syncthreads();
    const int nks = (wr == 0) ? 2 : 4;
#pragma unroll
    for (int m = 0; m < 4; ++m) {
        const int i = wr * 64 + m * 16 + fr;
        bf16x8 wf[4];
#pragma unroll
        for (int ks = 0; ks < 4; ++ks) { u32x4 pk = {0u, 0u, 0u, 0u};
            if (ks < nks) { const float* w = g.w_sp + ((size_t)g.h * 128 + i) * 128 + 32 * ks + 8 * fq; const f32x4 w0 = *(const f32x4*)w, w1 = *(const f32x4*)(w + 4);
                pk.x = pk2(w0[0], w0[1]); pk.y = pk2(w0[2], w0[3]); pk.z = pk2(w1[0], w1[1]); pk.w = pk2(w1[2], w1[3]); }
            wf[ks] = __builtin_bit_cast(bf16x8, pk); }
        const float bias = g.b_sp[g.h * 128 + i];
#pragma unroll
        for (int ai = 0; ai < 2; ++ai)
#pragma unroll
            for (int n = 0; n < 2; ++n) { f32x4 f = {0.f, 0.f, 0.f, 0.f};
#pragma unroll
                for (int ks = 0; ks < 4; ++ks) if (ks < nks) { const bf16x8 a = *(const bf16x8*)(vT + ai * (128 * 272) + (wc * 32 + n * 16 + fr) * 272 + (32 * ks + 8 * fq) * 2);
                    f = __builtin_amdgcn_mfma_f32_16x16x32_bf16(a, wf[ks], f, 0, 0, 0); }
                const f32x4 uu = acc[ai][0][m][n]; f32x4 o; o[0] = uu[0] * (f[0] + bias); o[1] = uu[1] * (f[1] + bias); o[2] = uu[2] * (f[2] + bias); o[3] = uu[3] * (f[3] + bias);
                st4(g.mix + (size_t)(g.row0 + ai * 128 + i) * DM + g.h * 128 + wc * 32 + n * 16 + 4 * fq, o); } }
}
struct KvArgs { bf16_t* zkv; float* tab; int row0; };
__device__ __forceinline__ void kvlat_epilogue(const f32x4 (&acc)[2][2][4][2], const KvArgs& g, char* lds, int wr, int wc, int fr, int fq) {
    float* P = (float*)lds;
#pragma unroll
    for (int ai = 0; ai < 2; ++ai)
#pragma unroll
        for (int m = 0; m < 4; ++m) { float q = 0.f; const int row = ai * 128 + wr * 64 + m * 16 + fr;
#pragma unroll
            for (int bj = 0; bj < 2; ++bj)
#pragma unroll
                for (int n = 0; n < 2; ++n) { const f32x4 x = acc[ai][bj][m][n]; q += (x[0] * x[0] + x[1] * x[1]) + (x[2] * x[2] + x[3] * x[3]);
                    st4(g.zkv + (size_t)(g.row0 + row) * 256 + bj * 128 + wc * 32 + n * 16 + 4 * fq, x); }
            q += shx(q, 16); q += shx(q, 32);
            if (fq == 0) P[row * 4 + wc] = q; }
    __syncthreads();
    if (threadIdx.x < 256) { const f32x4 s = *(const f32x4*)(P + threadIdx.x * 4); g.tab[threadIdx.x] = 1.f / sqrtf(((s[0] + s[1]) + (s[2] + s[3])) * (1.f / 256.f) + 1e-6f); }
    asm volatile("s_waitcnt vmcnt(0)" ::: "memory");
}
template <class EP, int EK = 0>
__device__ __forceinline__ void gemm256(const Unit<EP>& u, LAS unsigned char* lds, const GmArgs* gm = nullptr, const KvArgs* kv = nullptr) {
    int tid = threadIdx.x; asm volatile("" : "+v"(tid));
    const int K = u.K, nt = K / BK;
    const int wid = __builtin_amdgcn_readfirstlane(tid >> 6), lane = tid & 63, wr = wid >> 2, wc = wid & 3, fr = lane & 15, fq = lane >> 4;
    unsigned voffA[2][2], voffB[2];
    const char* gA = (const char*)u.am.base; const char* gB = (const char*)u.bt;
#pragma unroll
    for (int i = 0; i < 2; ++i) { int R, C; stage_rc(tid * 16 + i * 8192, R, C);
        voffB[i] = (unsigned)(R * K + C) * 2u;
        if (u.am.list) { const int a0 = u.am.list[R < u.am.nvalid ? R : 0], a1 = u.am.list[R + HALF < u.am.nvalid ? R + HALF : 0];
            voffA[0][i] = ((unsigned)(a0 >> 1) * (unsigned)u.am.ld + (unsigned)C) * 2u; voffA[1][i] = ((unsigned)(a1 >> 1) * (unsigned)u.am.ld + (unsigned)C) * 2u; }
        else { voffA[0][i] = (unsigned)(R * u.am.ld + C) * 2u; voffA[1][i] = (unsigned)((R + HALF) * u.am.ld + C) * 2u; } }
    const size_t hstepB = (size_t)HALF * K * 2;
    const unsigned ldsw = (unsigned)wid * 1024u;
    const int aoff = lds_byte(wr * 64 + fr, fq * 8), boff = lds_byte(wc * 32 + fr, fq * 8);
    #define SA(b,h) (((b)*2+(h))*HT*2)
    #define SB(b,h) ((4+(b)*2+(h))*HT*2)
    #define STAGE_A(bufoff,h,kt) do{ _Pragma("unroll") for(int _i=0;_i<2;++_i) { asm volatile("" : "+v"(voffA[h][_i])); \
        __builtin_amdgcn_global_load_lds((const unsigned*)(gA+(size_t)(kt)*(BK*2)+voffA[h][_i]),(LAS unsigned*)(lds+(bufoff)+ldsw+_i*8192),16,0,0);} }while(0)
    #define STAGE_B(bufoff,h,kt) do{ _Pragma("unroll") for(int _i=0;_i<2;++_i) { asm volatile("" : "+v"(voffB[_i])); \
        __builtin_amdgcn_global_load_lds((const unsigned*)(gB+(size_t)(h)*hstepB+(size_t)(kt)*(BK*2)+voffB[_i]),(LAS unsigned*)(lds+(bufoff)+ldsw+_i*8192),16,0,0);} }while(0)
    #define LDA(dst,b,h) _Pragma("unroll") for(int m=0;m<4;++m) _Pragma("unroll") for(int k=0;k<2;++k) \
        dst[m][k]=*(const LAS bf16x8*)(lds+SA(b,h)+aoff+m*2048+k*1024)
    #define LDB(dst,b,h) _Pragma("unroll") for(int n=0;n<2;++n) _Pragma("unroll") for(int k=0;k<2;++k) \
        dst[n][k]=*(const LAS bf16x8*)(lds+SB(b,h)+boff+n*2048+k*1024)
    #define MMA(ai,bj,At_,Bt_) do{__builtin_amdgcn_s_setprio(1); \
        _Pragma("unroll") for(int m=0;m<4;++m) _Pragma("unroll") for(int n=0;n<2;++n) _Pragma("unroll") for(int k=0;k<2;++k) \
          acc[ai][bj][m][n]=__builtin_amdgcn_mfma_f32_16x16x32_bf16(Bt_[n][k],At_[m][k],acc[ai][bj][m][n],0,0,0); \
        __builtin_amdgcn_s_setprio(0);}while(0)
    #define WAIT_V(n) asm volatile("s_waitcnt vmcnt(" #n ")":::"memory")
    #define WAIT_L(n) asm volatile("s_waitcnt lgkmcnt(" #n ")":::"memory")
    #define BAR __builtin_amdgcn_s_barrier()
    #define SCHED __builtin_amdgcn_sched_barrier(0)

    f32x4 acc[2][2][4][2];
#pragma unroll
    for (int a = 0; a < 2; ++a)
#pragma unroll
        for (int b = 0; b < 2; ++b)
#pragma unroll
            for (int m = 0; m < 4; ++m)
#pragma unroll
                for (int n = 0; n < 2; ++n) acc[a][b][m][n] = (f32x4){0.f, 0.f, 0.f, 0.f};
    bf16x8 At[4][2], B0[2][2], B1[2][2];
    STAGE_B(SB(0,0),0,0); STAGE_A(SA(0,0),0,0);
    STAGE_B(SB(0,1),1,0); STAGE_A(SA(0,1),1,0);
    if (wr == 1) BAR;
    WAIT_V(4); BAR;
    STAGE_B(SB(1,0),0,1); STAGE_A(SA(1,0),0,1); STAGE_B(SB(1,1),1,1);
    WAIT_V(6); BAR;
    for (int t = 0; t < nt - 2; t += 2) {
        LDB(B0,0,0); SCHED; LDA(At,0,0); STAGE_A(SA(1,1),1,t+1);
        WAIT_L(8); BAR; WAIT_L(0); MMA(0,0,At,B0); BAR; SCHED;
        LDB(B1,0,1); STAGE_B(SB(0,0),0,t+2);
        BAR; WAIT_L(0); MMA(0,1,At,B1); BAR;
        LDA(At,0,1); STAGE_A(SA(0,0),0,t+2);
        BAR; WAIT_L(0); MMA(1,0,At,B0); BAR; SCHED;
        STAGE_B(SB(0,1),1,t+2);
        WAIT_V(6); BAR; MMA(1,1,At,B1); BAR;
        LDB(B0,1,0); SCHED; LDA(At,1,0); STAGE_A(SA(0,1),1,t+2);
        WAIT_L(8); BAR; WAIT_L(0); MMA(0,0,At,B0); BAR; SCHED;
        LDB(B1,1,1); STAGE_B(SB(1,0),0,t+3);
        BAR; WAIT_L(0); MMA(0,1,At,B1); BAR;
        LDA(At,1,1); STAGE_A(SA(1,0),0,t+3);
        BAR; WAIT_L(0); MMA(1,0,At,B0); BAR; SCHED;
        STAGE_B(SB(1,1),1,t+3);
        WAIT_V(6); BAR; MMA(1,1,At,B1); BAR;
    }
    { LDB(B0,0,0); LDA(At,0,0); STAGE_A(SA(1,1),1,nt-1);
      BAR; WAIT_L(0); MMA(0,0,At,B0); BAR;
      LDB(B1,0,1); BAR; WAIT_L(0); MMA(0,1,At,B1); BAR;
      LDA(At,0,1); WAIT_V(4); BAR; WAIT_L(0); MMA(1,0,At,B0); MMA(1,1,At,B1); BAR; }
    { LDB(B0,1,0); LDA(At,1,0); WAIT_V(2); BAR; WAIT_L(0); MMA(0,0,At,B0); BAR;
      LDB(B1,1,1); WAIT_V(0); BAR; WAIT_L(0); MMA(0,1,At,B1); BAR;
      LDA(At,1,1); BAR; WAIT_L(0); MMA(1,0,At,B0); MMA(1,1,At,B1); BAR; }
    if (wr == 0) BAR;
    if constexpr (EK == 1) { __syncthreads(); gmlp_epilogue(acc, *gm, (char*)lds, wr, wc, fr, fq); } else if constexpr (EK == 2) { __syncthreads(); kvlat_epilogue(acc, *kv, (char*)lds, wr, wc, fr, fq); } else run_epilogue(u.ep, acc, wr, wc, fr, fq);
    __syncthreads();
    #undef SA
    #undef SB
    #undef STAGE_A
    #undef STAGE_B
    #undef LDA
    #undef LDB
    #undef MMA
}


template <class PH>
__device__ __forceinline__ void gemm_stream(const PH& ph, LAS unsigned char* lds, int u0, int ustride) {
    typedef Unit<typename PH::EP> U;
    int tid = threadIdx.x; asm volatile("" : "+v"(tid));
    const int wid = __builtin_amdgcn_readfirstlane(tid >> 6), lane = tid & 63, wr = wid >> 2, wc = wid & 3, fr = lane & 15, fq = lane >> 4;
    int u = u0;
    U cu; if (u >= PH::NU || !ph.unit(u, cu)) return;
    const int K = cu.K, nt = K / BK;
    int R0, C0, R1, C1; stage_rc(tid * 16, R0, C0); stage_rc(tid * 16 + 8192, R1, C1);
    unsigned voffB0 = (unsigned)(R0 * K + C0) * 2u, voffB1 = (unsigned)(R1 * K + C1) * 2u;
    #define VOFFA(am, o00, o01, o10, o11) do { \
        if ((am).list) { const int n_ = (am).nvalid; const int a00 = (am).list[R0 < n_ ? R0 : 0], a01 = (am).list[R1 < n_ ? R1 : 0], a10 = (am).list[R0 + HALF < n_ ? R0 + HALF : 0], a11 = (am).list[R1 + HALF < n_ ? R1 + HALF : 0]; \
            o00 = ((unsigned)(a00 >> 1) * (unsigned)(am).ld + (unsigned)C0) * 2u; o01 = ((unsigned)(a01 >> 1) * (unsigned)(am).ld + (unsigned)C1) * 2u; \
            o10 = ((unsigned)(a10 >> 1) * (unsigned)(am).ld + (unsigned)C0) * 2u; o11 = ((unsigned)(a11 >> 1) * (unsigned)(am).ld + (unsigned)C1) * 2u; } \
        else { o00 = (unsigned)(R0 * (am).ld + C0) * 2u; o01 = (unsigned)(R1 * (am).ld + C1) * 2u; o10 = (unsigned)((R0 + HALF) * (am).ld + C0) * 2u; o11 = (unsigned)((R1 + HALF) * (am).ld + C1) * 2u; } } while (0)
    unsigned va00, va01, va10, va11; VOFFA(cu.am, va00, va01, va10, va11);
    const char* cA = (const char*)cu.am.base; const char* cB = (const char*)cu.bt;
    const size_t hstepB = (size_t)HALF * K * 2, kstep = BK * 2;
    const unsigned ldsw = (unsigned)wid * 1024u;
    const int aoff = lds_byte(wr * 64 + fr, fq * 8), boff = lds_byte(wc * 32 + fr, fq * 8);
    #define SA(b,h) (((b)*2+(h))*HT*2)
    #define SB(b,h) ((4+(b)*2+(h))*HT*2)
    #define STG(bufoff, gbase, o0, o1) do { asm volatile("" : "+v"(o0)); asm volatile("" : "+v"(o1)); \
        __builtin_amdgcn_global_load_lds((const unsigned*)((gbase) + (o0)), (LAS unsigned*)(lds + (bufoff) + ldsw), 16, 0, 0); \
        __builtin_amdgcn_global_load_lds((const unsigned*)((gbase) + (o1)), (LAS unsigned*)(lds + (bufoff) + ldsw + 8192), 16, 0, 0); } while (0)
    #define LDA(dst,b,h) _Pragma("unroll") for(int m=0;m<4;++m) _Pragma("unroll") for(int k=0;k<2;++k) \
        dst[m][k]=*(const LAS bf16x8*)(lds+SA(b,h)+aoff+m*2048+k*1024)
    #define LDB(dst,b,h) _Pragma("unroll") for(int n=0;n<2;++n) _Pragma("unroll") for(int k=0;k<2;++k) \
        dst[n][k]=*(const LAS bf16x8*)(lds+SB(b,h)+boff+n*2048+k*1024)
    #define MMA(ai,bj,At_,Bt_) do{__builtin_amdgcn_s_setprio(1); \
        _Pragma("unroll") for(int m=0;m<4;++m) _Pragma("unroll") for(int n=0;n<2;++n) _Pragma("unroll") for(int k=0;k<2;++k) \
          acc[ai][bj][m][n]=__builtin_amdgcn_mfma_f32_16x16x32_bf16(Bt_[n][k],At_[m][k],acc[ai][bj][m][n],0,0,0); \
        __builtin_amdgcn_s_setprio(0);}while(0)
    f32x4 acc[2][2][4][2];
    #define ZERO_ACC _Pragma("unroll") for (int a = 0; a < 2; ++a) _Pragma("unroll") for (int b = 0; b < 2; ++b) _Pragma("unroll") for (int m = 0; m < 4; ++m) _Pragma("unroll") for (int n = 0; n < 2; ++n) acc[a][b][m][n] = (f32x4){0.f, 0.f, 0.f, 0.f}
    bf16x8 At[4][2], B0[2][2], B1[2][2];
#ifndef SP2
#define SP2 0
#endif
#if SP2
    STG(SB(0,0), cB, voffB0, voffB1); STG(SB(0,1), cB + hstepB, voffB0, voffB1); STG(SA(0,0), cA, va00, va01); STG(SA(0,1), cA, va10, va11);
    if (wr == 1) BAR;
    WAIT_V(2); BAR;
#else
    STG(SB(0,0), cB, voffB0, voffB1); STG(SA(0,0), cA, va00, va01); STG(SB(0,1), cB + hstepB, voffB0, voffB1); STG(SA(0,1), cA, va10, va11);
    if (wr == 1) BAR;
    WAIT_V(4); BAR;
#endif
    STG(SB(1,0), cB + kstep, voffB0, voffB1); STG(SA(1,0), cA + kstep, va00, va01); STG(SB(1,1), cB + hstepB + kstep, voffB0, voffB1);
    WAIT_V(6); BAR;
    for (;;) {
        U nx; int un; if constexpr (HasNext<PH>::value) un = ph.next(wr); else un = u + ustride;
        const bool has_next = (un < PH::NU) && ph.unit(un, nx);
        unsigned na00 = va00, na01 = va01, na10 = va10, na11 = va11; const char* nA = cA; const char* nB = cB;
        if (has_next) { VOFFA(nx.am, na00, na01, na10, na11); nA = (const char*)nx.am.base; nB = (const char*)nx.bt; }
        ZERO_ACC;
#if SP2
        #define KBODY(a1_, a2_, b2_, X00, X01, X10, X11) do { \
            const char* a3_ = (a2_) + kstep; const char* b3_ = (b2_) + kstep; \
            LDB(B0,0,0); LDB(B1,0,1); SCHED; LDA(At,0,0); STG(SA(1,1), a1_, va10, va11); \
            WAIT_V(8); WAIT_L(0); BAR; MMA(0,0,At,B0); MMA(0,1,At,B1); BAR; SCHED; \
            LDA(At,0,1); STG(SB(0,0), b2_, voffB0, voffB1); STG(SB(0,1), (b2_) + hstepB, voffB0, voffB1); STG(SA(0,0), a2_, X00, X01); \
            WAIT_V(8); WAIT_L(0); BAR; MMA(1,0,At,B0); MMA(1,1,At,B1); BAR; SCHED; \
            LDB(B0,1,0); LDB(B1,1,1); SCHED; LDA(At,1,0); STG(SA(0,1), a2_, X10, X11); \
            WAIT_V(8); WAIT_L(0); BAR; MMA(0,0,At,B0); MMA(0,1,At,B1); BAR; SCHED; \
            LDA(At,1,1); STG(SB(1,0), b3_, voffB0, voffB1); STG(SB(1,1), (b3_) + hstepB, voffB0, voffB1); STG(SA(1,0), a3_, X00, X01); \
            WAIT_V(8); WAIT_L(0); BAR; MMA(1,0,At,B0); MMA(1,1,At,B1); BAR; SCHED; } while (0)
#else
        #define KBODY(a1_, a2_, b2_, X00, X01, X10, X11) do { \
            const char* a3_ = (a2_) + kstep; const char* b3_ = (b2_) + kstep; \
            LDB(B0,0,0); SCHED; LDA(At,0,0); STG(SA(1,1), a1_, va10, va11); \
            WAIT_L(8); BAR; WAIT_L(0); MMA(0,0,At,B0); BAR; SCHED; \
            LDB(B1,0,1); STG(SB(0,0), b2_, voffB0, voffB1); \
            BAR; WAIT_L(0); MMA(0,1,At,B1); BAR; \
            LDA(At,0,1); STG(SA(0,0), a2_, X00, X01); \
            BAR; WAIT_L(0); MMA(1,0,At,B0); BAR; SCHED; \
            STG(SB(0,1), (b2_) + hstepB, voffB0, voffB1); \
            WAIT_V(6); BAR; MMA(1,1,At,B1); BAR; \
            LDB(B0,1,0); SCHED; LDA(At,1,0); STG(SA(0,1), a2_, X10, X11); \
            WAIT_L(8); BAR; WAIT_L(0); MMA(0,0,At,B0); BAR; SCHED; \
            LDB(B1,1,1); STG(SB(1,0), b3_, voffB0, voffB1); \
            BAR; WAIT_L(0); MMA(0,1,At,B1); BAR; \
            LDA(At,1,1); STG(SA(1,0), a3_, X00, X01); \
            BAR; WAIT_L(0); MMA(1,0,At,B0); BAR; SCHED; \
            STG(SB(1,1), (b3_) + hstepB, voffB0, voffB1); \
            WAIT_V(6); BAR; MMA(1,1,At,B1); BAR; } while (0)
#endif
#ifndef KREP
#define KREP 1
#endif
        for (int t = 0; t < nt * KREP - 2; t += 2) { const int t1 = (KREP > 1) ? (t + 1) % nt : t + 1, t2 = (KREP > 1) ? (t + 2) % nt : t + 2;
            const char* a1 = cA + (size_t)t1 * kstep; const char* a2 = cA + (size_t)t2 * kstep; const char* b2 = cB + (size_t)t2 * kstep;
            KBODY(a1, a2, b2, va00, va01, va10, va11); }
        { const char* a1 = cA + (size_t)(nt - 1) * kstep; KBODY(a1, nA, nB, na00, na01, na10, na11); }
        if (KREP > 1) {
#pragma unroll
            for (int a = 0; a < 2; ++a)
#pragma unroll
                for (int b = 0; b < 2; ++b)
#pragma unroll
                    for (int m = 0; m < 4; ++m)
#pragma unroll
                        for (int n = 0; n < 2; ++n) acc[a][b][m][n] = acc[a][b][m][n] * (1.0f / KREP); }
        #undef KBODY
        run_epilogue(cu.ep, acc, wr, wc, fr, fq);
        if constexpr (HasDone<PH>::value) ph.done(cu, wr);
        if (!has_next) break;
        cu = nx; va00 = na00; va01 = na01; va10 = na10; va11 = na11; cA = nA; cB = nB; u = un;
    }
    WAIT_V(0);
    if (wr == 0) BAR;
    BAR;
    __syncthreads();
    #undef SA
    #undef SB
    #undef STG
    #undef LDA
    #undef LDB
    #undef MMA
    #undef ZERO_ACC
    #undef VOFFA
}

__device__ __forceinline__ void witem(const float* s0, const float* s1, int ldsrc, bf16_t* dst, int K, int k0, int n0, int mode, const float* kscale, float* scr, int lane) {
    const int n = n0 + (lane & 31);
    const float* s = s0; int col = n;
    if (mode == 1) { if (n >= 1728) col = -1; else if (n >= 1664) { const int i = (n - 1664) >> 1, pp = (n - 1664) & 1; col = 1664 + i + 32 * pp; }
        else if (GMLP_FUSED && n < 1024) { const int t = n >> 8, w = n & 255; col = w < 128 ? t * 128 + w : 512 + t * 128 + (w - 128); }
        else if (ZLAYOUT2 && n >= 1024) { col = n < 1280 ? 1408 + (n - 1024) : n < 1536 ? 1024 + (n - 1280) : 1280 + (n - 1536); } }
    else if (mode == 2) { const int h = n / 192, d = n - h * 192; if (d >= 128) { const int i = (d - 128) >> 1, pp = (d - 128) & 1; col = h * 192 + 128 + i + 32 * pp; } }
    else if (mode == 3) { const int G = n >> 5, r = n & 31; col = 16 * G + (r & 15); s = (r < 16) ? s0 : s1; }
    const float* sp = s + (size_t)(k0 + (lane >> 5)) * ldsrc + (col < 0 ? 0 : col);
    float v[32];
#pragma unroll
    for (int i = 0; i < 32; ++i) v[i] = sp[(size_t)(2 * i) * ldsrc];
    if (kscale) {
#pragma unroll
        for (int i = 0; i < 32; ++i) v[i] *= kscale[k0 + 2 * i + (lane >> 5)];
    }
    if (col < 0) {
#pragma unroll
        for (int i = 0; i < 32; ++i) v[i] = 0.f;
    }
#pragma unroll
    for (int i = 0; i < 32; ++i) scr[(2 * i + (lane >> 5)) * 33 + (lane & 31)] = v[i];
    asm volatile("s_waitcnt lgkmcnt(0)" ::: "memory");
    const int c = lane & 7;
#pragma unroll
    for (int j = 0; j < 4; ++j) { const int nn = (lane >> 3) + 8 * j; const float* q = scr + (8 * c) * 33 + nn;
        u32x4 o; o.x = pk2(q[0], q[33]); o.y = pk2(q[2 * 33], q[3 * 33]); o.z = pk2(q[4 * 33], q[5 * 33]); o.w = pk2(q[6 * 33], q[7 * 33]);
        *(u32x4*)(dst + (size_t)(n0 + nn) * K + k0 + 8 * c) = o; }
    asm volatile("s_waitcnt lgkmcnt(0)" ::: "memory");
}
constexpr int I_IN = 16 * 56, I_UQ = 6 * 24, I_UKV = 4 * 32, I_OUT = 16 * 32, I_GU = 32 * 16 * 16, I_DN = 32 * 4 * 32;
constexpr int I_TOTAL = I_IN + I_UQ + I_UKV + I_OUT + I_GU + I_DN, I_EARLY = I_IN + I_UQ + I_UKV + I_OUT;
__device__ __forceinline__ void prep_witem(const Params& p, int it, float* scr, int lane) {
    if (it < I_IN) { const int kb = it / 56, nb = it - kb * 56; witem(p.w_in, nullptr, 1728, p.WinT, 1024, kb * 64, nb * 32, 1, nullptr, scr, lane); return; } it -= I_IN;
    if (it < I_UQ) { const int kb = it / 24, nb = it - kb * 24; witem(p.w_uq, nullptr, 768, p.WuqT, 384, kb * 64, nb * 32, 0, p.qn_g, scr, lane); return; } it -= I_UQ;
    if (it < I_UKV) { const int kb = it >> 5, nb = it & 31; witem(p.w_ukv, nullptr, 1024, p.WukvT, 256, kb * 64, nb * 32, 0, p.kvn_g, scr, lane); return; } it -= I_UKV;
    if (it < I_OUT) { const int kb = it >> 5, nb = it & 31; witem(p.w_out, nullptr, 1024, p.WoutT, 1024, kb * 64, nb * 32, 0, nullptr, scr, lane); return; } it -= I_OUT;
    if (it < I_GU) { const int e = it >> 8, r = it & 255, kb = r >> 4, nb = r & 15;
        witem(p.w_gate + (size_t)e * 1024 * 256, p.w_up + (size_t)e * 1024 * 256, 256, p.WguT + (size_t)e * 512 * 1024, 1024, kb * 64, nb * 32, 3, nullptr, scr, lane); return; } it -= I_GU;
    { const int e = it >> 7, r = it & 127, kb = r >> 5, nb = r & 31;
        witem(p.w_down + (size_t)e * 256 * 1024, nullptr, 1024, p.WdT + (size_t)e * 1024 * 256, 256, kb * 64, nb * 32, 0, nullptr, scr, lane); }
}
template <bool WT> __device__ __forceinline__ void ln0_row4(const float* x, size_t rstride, const float* g, const float* b, bf16_t* o, int lane) {
    f32x4 v[4][4]; float s[4], q[4];
#pragma unroll
    for (int r = 0; r < 4; ++r)
#pragma unroll
        for (int j = 0; j < 4; ++j) v[r][j] = *(const f32x4*)(x + r * rstride + 256 * j + 4 * lane);
#pragma unroll
    for (int r = 0; r < 4; ++r) { s[r] = 0.f; q[r] = 0.f;
#pragma unroll
        for (int j = 0; j < 4; ++j) { s[r] += (v[r][j][0] + v[r][j][1]) + (v[r][j][2] + v[r][j][3]);
            q[r] += (v[r][j][0] * v[r][j][0] + v[r][j][1] * v[r][j][1]) + (v[r][j][2] * v[r][j][2] + v[r][j][3] * v[r][j][3]); } }
#pragma unroll
    for (int o2 = 1; o2 < 64; o2 <<= 1) {
#pragma unroll
        for (int r = 0; r < 4; ++r) { s[r] += shx(s[r], o2); q[r] += shx(q[r], o2); } }
    f32x4 gg[4], bb[4];
#pragma unroll
    for (int j = 0; j < 4; ++j) { gg[j] = *(const f32x4*)(g + 256 * j + 4 * lane); bb[j] = *(const f32x4*)(b + 256 * j + 4 * lane); }
#pragma unroll
    for (int r = 0; r < 4; ++r) { const float mean = s[r] * (1.f / 1024.f), var = fmaxf(q[r] * (1.f / 1024.f) - mean * mean, 0.f), rstd = 1.f / sqrtf(var + 1e-5f);
#pragma unroll
        for (int j = 0; j < 4; ++j) { if (WT) st4wt(o + r * rstride + 256 * j + 4 * lane, (v[r][j] - mean) * rstd * gg[j] + bb[j]); else st4(o + r * rstride + 256 * j + 4 * lane, (v[r][j] - mean) * rstd * gg[j] + bb[j]); } }
}
__device__ __forceinline__ void ln0_row1_wt(const float* xr, const float* g, const float* b, bf16_t* orow, int lane) {
    f32x4 v[4]; float s = 0.f, q = 0.f;
#pragma unroll
    for (int j = 0; j < 4; ++j) { v[j] = *(const f32x4*)(xr + 256 * j + 4 * lane); s += (v[j][0] + v[j][1]) + (v[j][2] + v[j][3]); q += (v[j][0] * v[j][0] + v[j][1] * v[j][1]) + (v[j][2] * v[j][2] + v[j][3] * v[j][3]); }
#pragma unroll
    for (int o2 = 1; o2 < 64; o2 <<= 1) { s += shx(s, o2); q += shx(q, o2); }
    const float mean = s * (1.f / 1024.f), var = fmaxf(q * (1.f / 1024.f) - mean * mean, 0.f), rstd = 1.f / sqrtf(var + 1e-5f);
#pragma unroll
    for (int j = 0; j < 4; ++j) { const f32x4 gg = *(const f32x4*)(g + 256 * j + 4 * lane), bb = *(const f32x4*)(b + 256 * j + 4 * lane); st4wt(orow + 256 * j + 4 * lane, (v[j] - mean) * rstd * gg + bb); }
}

template <int K> __device__ __forceinline__ void rs_table(const bf16_t* A, float* tab) {
    int tid = threadIdx.x; asm volatile("" : "+v"(tid));
    const int r = tid >> 1, hf = tid & 1; constexpr int n = K >> 1;
    const bf16_t* a = A + (size_t)r * K + hf * n; float s = 0.f;
    u32x4 w[n / 8];
#pragma unroll
    for (int i = 0; i < n / 8; ++i) w[i] = *(const u32x4*)(a + 8 * i);
#pragma unroll
    for (int i = 0; i < n / 8; ++i) { const float a0 = bflo(w[i].x), a1 = bfhi(w[i].x), a2 = bflo(w[i].y), a3 = bfhi(w[i].y), a4 = bflo(w[i].z), a5 = bfhi(w[i].z), a6 = bflo(w[i].w), a7 = bfhi(w[i].w);
        s += (a0 * a0 + a1 * a1) + (a2 * a2 + a3 * a3) + (a4 * a4 + a5 * a5) + (a6 * a6 + a7 * a7); }
    s += shx(s, 1);
    if (hf == 0) tab[r] = 1.f / sqrtf(s / (float)K + 1e-6f);
}

__device__ __forceinline__ void gmlp_phase(const Params& p, char* shm, int vcu) {
    int tid = threadIdx.x; asm volatile("" : "+v"(tid));
    const int wid = __builtin_amdgcn_readfirstlane(tid >> 6), lane = tid & 63, fr = lane & 15, fq = lane >> 4;
    const int h = vcu & 3, iabs = 16 * wid + fr;
    bf16x8 wf[4];
#pragma unroll
    for (int ks = 0; ks < 4; ++ks) {
        const float* w = p.w_sp + ((size_t)h * 128 + iabs) * 128 + 32 * ks + 8 * fq;
        const f32x4 w0 = *(const f32x4*)w, w1 = *(const f32x4*)(w + 4);
        const bool ok = (ks >> 1) <= (iabs >> 6);
        u32x4 pk; pk.x = pk2(w0[0], w0[1]); pk.y = pk2(w0[2], w0[3]); pk.z = pk2(w1[0], w1[1]); pk.w = pk2(w1[2], w1[3]);
        if (!ok) pk = (u32x4){0u, 0u, 0u, 0u};
        wf[ks] = __builtin_bit_cast(bf16x8, pk);
    }
    const float bias = p.b_sp[h * 128 + iabs];
    const int nks = (wid < 4) ? 2 : 4;
    const int j = tid >> 2, part = tid & 3;
    const int nb_ = gridDim.x, nrem = 896 % nb_, ng = (nb_ == 256) ? ((vcu >= nrem) ? 5 : 3) : -1;
    for (int gi = 0;; ++gi) {
        int u;
        if (ng < 0) { u = vcu + gi * nb_; if (u >= (T_TOK / 128) * 4) break; }
        else { if (gi >= ng) break; u = gi < 3 ? vcu + gi * 256 : 768 + (vcu - 128) + 128 * (gi - 3); }
        const int bn = u >> 2, row0 = bn * 128;
        {
            const bf16_t* vr = p.zv + (size_t)(row0 + j) * 512 + h * 128 + part * 32;
            float v[32];
#pragma unroll
            for (int q = 0; q < 4; ++q) { const u32x4 w = *(const u32x4*)(vr + 8 * q);
                v[8 * q + 0] = bflo(w.x); v[8 * q + 1] = bfhi(w.x); v[8 * q + 2] = bflo(w.y); v[8 * q + 3] = bfhi(w.y);
                v[8 * q + 4] = bflo(w.z); v[8 * q + 5] = bfhi(w.z); v[8 * q + 6] = bflo(w.w); v[8 * q + 7] = bfhi(w.w); }
            float s = 0.f;
#pragma unroll
            for (int e = 0; e < 32; ++e) s += v[e];
            s += shx(s, 1); s += shx(s, 2);
            const float mean = s * (1.f / 128.f); float s2 = 0.f;
#pragma unroll
            for (int e = 0; e < 32; ++e) { v[e] -= mean; s2 += v[e] * v[e]; }
            s2 += shx(s2, 1); s2 += shx(s2, 2);
            const float rstd = 1.f / sqrtf(s2 * (1.f / 128.f) + 1e-5f);
            const float* gg = p.gm_g + h * 128 + part * 32; const float* bb = p.gm_b + h * 128 + part * 32;
#pragma unroll
            for (int e = 0; e < 32; ++e) *(bf16_t*)(shm + (part * 32 + e) * 272 + j * 2) = f2bf(v[e] * rstd * gg[e] + bb[e]);
        }
        __syncthreads();
        f32x4 acc[8];
#pragma unroll
        for (int cb = 0; cb < 8; ++cb) acc[cb] = (f32x4){0.f, 0.f, 0.f, 0.f};
#pragma unroll
        for (int ks = 0; ks < 4; ++ks) if (ks < nks) {
#pragma unroll
            for (int cb = 0; cb < 8; ++cb) { const bf16x8 a = *(const bf16x8*)(shm + (16 * cb + fr) * 272 + (32 * ks + 8 * fq) * 2);
                acc[cb] = __builtin_amdgcn_mfma_f32_16x16x32_bf16(a, wf[ks], acc[cb], 0, 0, 0); }
        }
        const bf16_t* ur = p.zu + (size_t)(row0 + iabs) * 512 + h * 128 + 4 * fq;
        bf16_t* orow = p.mix + (size_t)(row0 + iabs) * DM + h * 128 + 4 * fq;
#pragma unroll
        for (int cb = 0; cb < 8; ++cb) { const u32x2 uw = *(const u32x2*)(ur + 16 * cb); f32x4 o;
            o[0] = bflo(uw.x) * (acc[cb][0] + bias); o[1] = bfhi(uw.x) * (acc[cb][1] + bias); o[2] = bflo(uw.y) * (acc[cb][2] + bias); o[3] = bfhi(uw.y) * (acc[cb][3] + bias);
            st4(orow + 16 * cb, o); }
        __syncthreads();
    }
}

constexpr int KT_STRIDE = 400, VT_STRIDE = 144, KT_BYTES = 64 * KT_STRIDE, ATT_STAGE = KT_BYTES + 128 * VT_STRIDE;
template <int AMODE> __device__ __forceinline__ void attn_block(const Params& p, char* shm, int bh, int qb, bf16_t* outbuf) {
    int tid = threadIdx.x; asm volatile("" : "+v"(tid));
    const int wid = __builtin_amdgcn_readfirstlane(tid >> 6), lane = tid & 63, r = lane & 31, hh = lane >> 5;
    const int b = bh >> 2, h = bh & 3, q0 = qb * 256, ntile = 4 * qb + 4, nw = 4 * qb + (wid >> 1) + 1;
    bf16x8 qf[12];
    { const bf16_t* qp = p.Q + ((size_t)bh * SEQ + q0 + 32 * wid + r) * 192 + 8 * hh;
#pragma unroll
      for (int s = 0; s < 12; ++s) qf[s] = *(const bf16x8*)(qp + 16 * s);
      const float2* rp = p.rope + ((size_t)b * SEQ + q0 + 32 * wid + r) * 32 + 8 * hh;
#pragma unroll
      for (int s = 0; s < 2; ++s) { u32x4 x1 = __builtin_bit_cast(u32x4, qf[8 + s]), x2 = __builtin_bit_cast(u32x4, qf[10 + s]); float a[8], c2[8];
          a[0] = bflo(x1.x); a[1] = bfhi(x1.x); a[2] = bflo(x1.y); a[3] = bfhi(x1.y); a[4] = bflo(x1.z); a[5] = bfhi(x1.z); a[6] = bflo(x1.w); a[7] = bfhi(x1.w);
          c2[0] = bflo(x2.x); c2[1] = bfhi(x2.x); c2[2] = bflo(x2.y); c2[3] = bfhi(x2.y); c2[4] = bflo(x2.z); c2[5] = bfhi(x2.z); c2[6] = bflo(x2.w); c2[7] = bfhi(x2.w);
          float o1[8], o2[8];
#pragma unroll
          for (int j = 0; j < 8; ++j) { const float2 cs = rp[16 * s + j]; o1[j] = a[j] * cs.x - c2[j] * cs.y; o2[j] = c2[j] * cs.x + a[j] * cs.y; }
          x1.x = pk2(o1[0], o1[1]); x1.y = pk2(o1[2], o1[3]); x1.z = pk2(o1[4], o1[5]); x1.w = pk2(o1[6], o1[7]);
          x2.x = pk2(o2[0], o2[1]); x2.y = pk2(o2[2], o2[3]); x2.z = pk2(o2[4], o2[5]); x2.w = pk2(o2[6], o2[7]);
          qf[8 + s] = __builtin_bit_cast(bf16x8, x1); qf[10 + s] = __builtin_bit_cast(bf16x8, x2); } }
    f32x16 O[4];
#pragma unroll
    for (int d = 0; d < 4; ++d)
#pragma unroll
        for (int t = 0; t < 16; ++t) O[d][t] = 0.f;
    float m = -INFINITY, l = 0.f;
    const bf16_t* kn_src = p.Kn + ((size_t)bh * SEQ + (tid >> 4)) * 128 + (tid & 15) * 8;
    const bf16_t* kr_src = p.krope + ((size_t)b * SEQ + (tid >> 3)) * 64 + (tid & 7) * 8;
    const bf16_t* vt_src = p.Vt + ((size_t)bh * 128 + (tid >> 3)) * SEQ + (tid & 7) * 8;
    const int kn_dst = (tid >> 4) * KT_STRIDE + (tid & 15) * 16, kr_dst = (tid >> 3) * KT_STRIDE + 256 + (tid & 7) * 16, vt_dst = KT_BYTES + (tid >> 3) * VT_STRIDE + (tid & 7) * 16;
    u32x4 g0, g1, g2, g3, g4;
    #define ATT_LOAD(kt) do { g0 = *(const u32x4*)(kn_src + (size_t)(kt) * 64 * 128); g1 = *(const u32x4*)(kn_src + (size_t)((kt) * 64 + 32) * 128); \
        g2 = *(const u32x4*)(kr_src + (size_t)(kt) * 64 * 64); g3 = *(const u32x4*)(vt_src + (kt) * 64); g4 = *(const u32x4*)(vt_src + (size_t)64 * SEQ + (kt) * 64); } while (0)
    #define ATT_WRITE(buf) do { char* _s = shm + (buf) * ATT_STAGE; *(u32x4*)(_s + kn_dst) = g0; *(u32x4*)(_s + kn_dst + 32 * KT_STRIDE) = g1; *(u32x4*)(_s + kr_dst) = g2; \
        *(u32x4*)(_s + vt_dst) = g3; *(u32x4*)(_s + vt_dst + 64 * VT_STRIDE) = g4; } while (0)
    ATT_LOAD(0); ATT_WRITE(0);
    __syncthreads();
    for (int kt = 0; kt < ntile; ++kt) {
        const bool more = kt + 1 < ntile;
        if (more) ATT_LOAD(kt + 1);
        if (kt < nw) {
            const char* ks = shm + (kt & 1) * ATT_STAGE; const char* vs = ks + KT_BYTES;
            f32x16 S0, S1;
#pragma unroll
            for (int t = 0; t < 16; ++t) { S0[t] = 0.f; S1[t] = 0.f; }
            if (AMODE != 4 && AMODE != 5) {
            __builtin_amdgcn_s_setprio(1);
#pragma unroll
            for (int s = 0; s < 12; ++s) {
                const bf16x8 k0 = *(const bf16x8*)(ks + r * KT_STRIDE + (16 * s + 8 * hh) * 2), k1 = *(const bf16x8*)(ks + (32 + r) * KT_STRIDE + (16 * s + 8 * hh) * 2);
                S0 = __builtin_amdgcn_mfma_f32_32x32x16_bf16(k0, qf[s], S0, 0, 0, 0);
                S1 = __builtin_amdgcn_mfma_f32_32x32x16_bf16(k1, qf[s], S1, 0, 0, 0);
            }
            __builtin_amdgcn_s_setprio(0);
            } else { asm volatile("" : "+v"(S0), "+v"(S1)); }
            float mt = fmaxf(S0[0], S1[0]);
#pragma unroll
            for (int t = 1; t < 16; ++t) mt = fmaxf(mt, fmaxf(S0[t], S1[t]));
            mt = fmaxf(mt, shx(mt, 32));
            if (AMODE == 2 || AMODE == 5) { m = 0.f; l = 1.f; asm volatile("" : "+v"(S0), "+v"(S1)); } else {
            if (!__all(mt - m <= 8.0f)) {
                const float mn = fmaxf(m, mt), alpha = __builtin_amdgcn_exp2f(m - mn); m = mn; l *= alpha;
#pragma unroll
                for (int d = 0; d < 4; ++d)
#pragma unroll
                    for (int t = 0; t < 16; ++t) O[d][t] *= alpha;
            }
            float ls = 0.f;
#pragma unroll
            for (int t = 0; t < 16; ++t) { S0[t] = __builtin_amdgcn_exp2f(S0[t] - m); S1[t] = __builtin_amdgcn_exp2f(S1[t] - m); ls += S0[t] + S1[t]; }
            l += ls; }
            bf16x8 pf[4];
#pragma unroll
            for (int s = 0; s < 2; ++s) {
                u32x4 a, c; a.x = pk2(S0[8 * s + 0], S0[8 * s + 1]); a.y = pk2(S0[8 * s + 2], S0[8 * s + 3]); a.z = pk2(S0[8 * s + 4], S0[8 * s + 5]); a.w = pk2(S0[8 * s + 6], S0[8 * s + 7]);
                c.x = pk2(S1[8 * s + 0], S1[8 * s + 1]); c.y = pk2(S1[8 * s + 2], S1[8 * s + 3]); c.z = pk2(S1[8 * s + 4], S1[8 * s + 5]); c.w = pk2(S1[8 * s + 6], S1[8 * s + 7]);
                pf[s] = __builtin_bit_cast(bf16x8, a); pf[2 + s] = __builtin_bit_cast(bf16x8, c);
            }
            if (AMODE == 3 || AMODE == 5) { asm volatile("" :: "v"(pf[0]), "v"(pf[1]), "v"(pf[2]), "v"(pf[3])); } else {
            __builtin_amdgcn_s_setprio(1);
#pragma unroll
            for (int k4 = 0; k4 < 4; ++k4)
#pragma unroll
                for (int d = 0; d < 4; ++d) { const bf16x8 vf = *(const bf16x8*)(vs + (32 * d + r) * VT_STRIDE + (16 * k4 + 8 * hh) * 2);
                    O[d] = __builtin_amdgcn_mfma_f32_32x32x16_bf16(vf, pf[k4], O[d], 0, 0, 0); }
            __builtin_amdgcn_s_setprio(0); }
        }
        if (more) ATT_WRITE((kt + 1) & 1);
        __syncthreads();
    }
    #undef ATT_LOAD
    #undef ATT_WRITE
    l += shx(l, 32);
    const float inv = 1.f / l;
    bf16_t* o = outbuf + ((size_t)b * SEQ + q0 + 32 * wid + r) * DM + 512 + h * 128 + 4 * hh;
#pragma unroll
    for (int d = 0; d < 4; ++d)
#pragma unroll
        for (int g = 0; g < 4; ++g) { f32x4 v; v[0] = O[d][4 * g] * inv; v[1] = O[d][4 * g + 1] * inv; v[2] = O[d][4 * g + 2] * inv; v[3] = O[d][4 * g + 3] * inv; st4(o + 32 * d + 8 * g, v); }
}


__device__ __forceinline__ void router_tile(const Params& p, char* smc, int tb) {
    int tid = threadIdx.x; asm volatile("" : "+v"(tid));
    const int wid = __builtin_amdgcn_readfirstlane(tid >> 6), lane = tid & 63, fr = lane & 15, fq = lane >> 4;
    int* lcnt = (int*)(smc + LDS_LCNT);
    { u32x4 wreg[18];
#pragma unroll
      for (int k = 0; k < 18; ++k) { const int i = tid + k * NTHR; wreg[k] = *(const u32x4*)(p.WrT + (size_t)i * 8); }
#pragma unroll
      for (int k = 0; k < 18; ++k) { const int i = tid + k * NTHR, img = i / (36 * 128), rem = i - img * 36 * 128, o = rem >> 7, ch = rem & 127;
          *(u32x4*)(smc + LDS_RW + img * 73728 + o * 2048 + ((ch ^ (o & 15)) << 4)) = wreg[k]; } }
    if (tid < NEXP) lcnt[tid] = 0;
    __syncthreads();
    const int tok = tb * 128 + wid * 16 + fr;
    bf16_t* hr = p.hbuf + (size_t)tok * DM + 8 * fq;
    float s = 0.f, s2 = 0.f;
#if YSTAT
    { const f32x4 a = *(const f32x4*)(p.ystat + (size_t)tok * 32 + 8 * fq), b = *(const f32x4*)(p.ystat + (size_t)tok * 32 + 8 * fq + 4); s = (a[0] + a[2]) + (b[0] + b[2]); s2 = (a[1] + a[3]) + (b[1] + b[3]); }
    s += shx(s, 16); s += shx(s, 32); s2 += shx(s2, 16); s2 += shx(s2, 32);
#else
#pragma unroll 8
    for (int ks = 0; ks < 32; ++ks) { const u32x4 y = *(const u32x4*)(hr + 32 * ks);
        const float a0 = bflo(y.x), a1 = bfhi(y.x), a2 = bflo(y.y), a3 = bfhi(y.y), a4 = bflo(y.z), a5 = bfhi(y.z), a6 = bflo(y.w), a7 = bfhi(y.w);
        s += ((a0 + a1) + (a2 + a3)) + ((a4 + a5) + (a6 + a7)); s2 += ((a0 * a0 + a1 * a1) + (a2 * a2 + a3 * a3)) + ((a4 * a4 + a5 * a5) + (a6 * a6 + a7 * a7)); }
    s += shx(s, 16); s += shx(s, 32); s2 += shx(s2, 16); s2 += shx(s2, 32);
#endif
    const float mean = s * (1.f / 1024.f), var = fmaxf(s2 * (1.f / 1024.f) - mean * mean, 0.f), rstd = 1.f / sqrtf(var + 1e-5f);
    const int o0 = fr < 4 ? fr : 3, o1 = 4 + fr, o2 = 20 + fr;
    const int w0 = o0 * 2048, w1 = o1 * 2048, w2 = o2 * 2048, x0 = o0 & 15, x1 = o1 & 15, x2 = o2 & 15;
    f32x4 acc0 = {0.f, 0.f, 0.f, 0.f}, acc1 = acc0, acc2 = acc0;
    const float* lg_ = p.ln1_g + 8 * fq; const float* lb_ = p.ln1_b + 8 * fq;
#pragma unroll 8
    for (int ks = 0; ks < 32; ++ks) {
        const f32x4 g0 = *(const f32x4*)(lg_ + 32 * ks), g1 = *(const f32x4*)(lg_ + 32 * ks + 4), b0 = *(const f32x4*)(lb_ + 32 * ks), b1 = *(const f32x4*)(lb_ + 32 * ks + 4);
        const u32x4 yy = *(const u32x4*)(hr + 32 * ks);
        float h[8];
        h[0] = (bflo(yy.x) - mean) * rstd * g0[0] + b0[0]; h[1] = (bfhi(yy.x) - mean) * rstd * g0[1] + b0[1]; h[2] = (bflo(yy.y) - mean) * rstd * g0[2] + b0[2]; h[3] = (bfhi(yy.y) - mean) * rstd * g0[3] + b0[3];
        h[4] = (bflo(yy.z) - mean) * rstd * g1[0] + b1[0]; h[5] = (bfhi(yy.z) - mean) * rstd * g1[1] + b1[1]; h[6] = (bflo(yy.w) - mean) * rstd * g1[2] + b1[2]; h[7] = (bfhi(yy.w) - mean) * rstd * g1[3] + b1[3];
        u32x4 hi, lo; hi.x = pk2(h[0], h[1]); hi.y = pk2(h[2], h[3]); hi.z = pk2(h[4], h[5]); hi.w = pk2(h[6], h[7]);
        *(u32x4*)(hr + 32 * ks) = hi;
        lo.x = pk2(h[0] - bflo(hi.x), h[1] - bfhi(hi.x)); lo.y = pk2(h[2] - bflo(hi.y), h[3] - bfhi(hi.y)); lo.z = pk2(h[4] - bflo(hi.z), h[5] - bfhi(hi.z)); lo.w = pk2(h[6] - bflo(hi.w), h[7] - bfhi(hi.w));
        const bf16x8 hh = __builtin_bit_cast(bf16x8, hi), hl = __builtin_bit_cast(bf16x8, lo);
        const int ch = 4 * ks + fq;
        const bf16x8 a0h = *(const bf16x8*)(smc + LDS_RW + w0 + ((ch ^ x0) << 4)), a0l = *(const bf16x8*)(smc + LDS_RW + 73728 + w0 + ((ch ^ x0) << 4));
        const bf16x8 a1h = *(const bf16x8*)(smc + LDS_RW + w1 + ((ch ^ x1) << 4)), a1l = *(const bf16x8*)(smc + LDS_RW + 73728 + w1 + ((ch ^ x1) << 4));
        const bf16x8 a2h = *(const bf16x8*)(smc + LDS_RW + w2 + ((ch ^ x2) << 4)), a2l = *(const bf16x8*)(smc + LDS_RW + 73728 + w2 + ((ch ^ x2) << 4));
        acc0 = __builtin_amdgcn_mfma_f32_16x16x32_bf16(a0h, hh, acc0, 0, 0, 0); acc0 = __builtin_amdgcn_mfma_f32_16x16x32_bf16(a0h, hl, acc0, 0, 0, 0); acc0 = __builtin_amdgcn_mfma_f32_16x16x32_bf16(a0l, hh, acc0, 0, 0, 0);
        acc1 = __builtin_amdgcn_mfma_f32_16x16x32_bf16(a1h, hh, acc1, 0, 0, 0); acc1 = __builtin_amdgcn_mfma_f32_16x16x32_bf16(a1h, hl, acc1, 0, 0, 0); acc1 = __builtin_amdgcn_mfma_f32_16x16x32_bf16(a1l, hh, acc1, 0, 0, 0);
        acc2 = __builtin_amdgcn_mfma_f32_16x16x32_bf16(a2h, hh, acc2, 0, 0, 0); acc2 = __builtin_amdgcn_mfma_f32_16x16x32_bf16(a2h, hl, acc2, 0, 0, 0); acc2 = __builtin_amdgcn_mfma_f32_16x16x32_bf16(a2l, hh, acc2, 0, 0, 0);
    }
    __syncthreads();
    float* sc = (float*)(smc + LDS_RW) + wid * (16 * 40) + fr * 40;
    if (fq == 0) { sc[0] = acc0[0]; sc[1] = acc0[1]; sc[2] = acc0[2]; sc[3] = acc0[3]; }
    *(f32x4*)(sc + 4 + 4 * fq) = acc1; *(f32x4*)(sc + 20 + 4 * fq) = acc2;
    __syncthreads();
    if (lane < 16) {
        const float* lr = (const float*)(smc + LDS_RW) + wid * (16 * 40) + lane * 40;
        float lg[36];
#pragma unroll
        for (int o = 0; o < 36; o += 4) { const f32x4 v = *(const f32x4*)(lr + o); lg[o] = v[0]; lg[o + 1] = v[1]; lg[o + 2] = v[2]; lg[o + 3] = v[3]; }
#pragma unroll
        for (int o = 0; o < 4; ++o) lg[o] += p.b_rg[o];
#pragma unroll
        for (int o = 0; o < 32; ++o) lg[4 + o] += p.b_re[o];
        int g = 0; float gm = lg[0];
#pragma unroll
        for (int i = 1; i < 4; ++i) if (lg[i] > gm) { gm = lg[i]; g = i; }
        float se = 0.f;
#pragma unroll
        for (int i = 0; i < 4; ++i) se += expf(lg[i] - gm);
        const float pg = 1.f / se;
        float ev[8];
#pragma unroll
        for (int e = 0; e < 8; ++e) ev[e] = g == 0 ? lg[4 + e] : g == 1 ? lg[12 + e] : g == 2 ? lg[20 + e] : lg[28 + e];
        int i1 = 0; float v1 = ev[0];
#pragma unroll
        for (int e = 1; e < 8; ++e) if (ev[e] > v1) { v1 = ev[e]; i1 = e; }
        int i2 = -1; float v2 = -3.0e38f;
#pragma unroll
        for (int e = 0; e < 8; ++e) if (e != i1 && ev[e] > v2) { v2 = ev[e]; i2 = e; }
        const float d = expf(v2 - v1), g1 = pg / (1.f + d), g2 = pg * d / (1.f + d);
        const int t = tb * 128 + wid * 16 + lane, e1 = g * 8 + i1, e2 = g * 8 + i2;
        const int s1 = atomicAdd(lcnt + e1, 1), s2_ = atomicAdd(lcnt + e2, 1);
        p.listb[((size_t)tb * NEXP + e1) * 256 + s1] = 2 * t; p.listb[((size_t)tb * NEXP + e2) * 256 + s2_] = 2 * t + 1;
        p.gates[2 * t] = g1; p.gates[2 * t + 1] = g2;
    }
    __syncthreads();
    if (tid < NEXP) p.cntb[tb * NEXP + tid] = lcnt[tid];
    __syncthreads();
}
__device__ __forceinline__ void moe_tables(const Params& p, char* smc) {
    int tid = threadIdx.x; asm volatile("" : "+v"(tid));
    const int e = tid & 31, seg = tid >> 5;
    unsigned short* pre = (unsigned short*)(smc + LDS_PRE); int* tot = (int*)(smc + LDS_TOT); int* segtot = (int*)(smc + LDS_SEG);
    int c[16]; int run = 0;
#pragma unroll
    for (int i = 0; i < 16; ++i) c[i] = p.cntb[(16 * seg + i) * NEXP + e];
#pragma unroll
    for (int i = 0; i < 16; ++i) { const int v = c[i]; c[i] = run; run += v; }
    segtot[seg * 32 + e] = run;
    __syncthreads();
    int base = 0, all = 0;
#pragma unroll
    for (int s = 0; s < 16; ++s) { const int v = segtot[s * 32 + e]; base += (s < seg) ? v : 0; all += v; }
#pragma unroll
    for (int i = 0; i < 16; ++i) pre[e * 256 + 16 * seg + i] = (unsigned short)(base + c[i]);
    if (seg == 0) tot[e] = all;
    __syncthreads();
}

template <class PH> __device__ __forceinline__ void gemm_phase(const PH& ph, LAS unsigned char* shm, int vcu) {
#if defined(NOSTREAM)
    for (int u = vcu;; u += gridDim.x) { Unit<typename PH::EP> un; if (u >= PH::NU || !ph.unit(u, un)) break; gemm256(un, shm); }
#else
    gemm_stream(ph, shm, vcu, gridDim.x);
#endif
}

struct PhKVc { Params p; const float* tab; int pm; typedef EpiKV EP; static constexpr int NU = 4;
    __device__ __forceinline__ bool unit(int pn, Unit<EP>& o) const {
        o.am = AMap{p.zkv + (size_t)pm * 256 * 256, 256, nullptr, 256}; o.bt = p.WukvT + (size_t)pn * 256 * 256; o.K = 256;
        o.ep = EpiKV{p.Kn, p.Vt, tab, pm * 256, pm * 256, pn * 256}; return true; } };
struct PhZ2 { Params p; typedef EpiZ EP; static constexpr int NU = 128 * 2;
    __device__ __forceinline__ bool unit(int v, Unit<EP>& o) const { const int pm = v >> 1, pn = 5 + (v & 1);
        o.am = AMap{p.hbuf + (size_t)pm * 256 * DM, DM, nullptr, 256}; o.bt = p.WinT + (size_t)pn * 256 * DM; o.K = DM;
        o.ep = EpiZ{p.zu, p.zv, p.zq, p.zkv, p.krope, p.rope, pm * 256, pn * 256}; return true; } };
struct PhZ3 { Params p; typedef EpiZ EP; static constexpr int NU = 128 * 3;
    __device__ __forceinline__ bool unit(int v, Unit<EP>& o) const { const int pm = v / 3, pn = 4 + (v - pm * 3);
        o.am = AMap{p.hbuf + (size_t)pm * 256 * DM, DM, nullptr, 256}; o.bt = p.WinT + (size_t)pn * 256 * DM; o.K = DM;
        o.ep = EpiZ{p.zu, p.zv, p.zq, p.zkv, p.krope, p.rope, pm * 256, pn * 256}; return true; } };
struct PhQs { Params p; const float* tab; int u0, ustride; typedef EpiQ EP; static constexpr int NU = 128 * 3;
    __device__ __forceinline__ bool unit(int u, Unit<EP>& o) const { const int pm = u / 3, pn = u - pm * 3, slot = (u - u0) / ustride;
        o.am = AMap{p.zq + (size_t)pm * 256 * 384, 384, nullptr, 256}; o.bt = p.WuqT + (size_t)pn * 256 * 384; o.K = 384;
        o.ep = EpiQ{p.Q, tab + slot * 256, pm * 256, pm * 256, pn * 256}; return true; } };
struct PhKVs { Params p; const float* tab; int u0, ustride; typedef EpiKV EP; static constexpr int NU = 128 * 3 + 128 * 4;
    __device__ __forceinline__ bool unit(int u, Unit<EP>& o) const { const int v = u - 384, pm = v >> 2, pn = v & 3, slot = (u - u0) / ustride;
        o.am = AMap{p.zkv + (size_t)pm * 256 * 256, 256, nullptr, 256}; o.bt = p.WukvT + (size_t)pn * 256 * 256; o.K = 256;
        o.ep = EpiKV{p.Kn, p.Vt, tab + slot * 256, pm * 256, pm * 256, pn * 256}; return true; } };
struct PhKVb { Params p; const float* tab; int kbeg, kend, slot0; typedef EpiKV EP; static constexpr int NU = 128 * 4;
    __device__ __forceinline__ bool unit(int k, Unit<EP>& o) const { if (k >= kend) return false; const int pm = k >> 2, pn = k & 3, slot = slot0 + (k - kbeg);
        o.am = AMap{p.zkv + (size_t)pm * 256 * 256, 256, nullptr, 256}; o.bt = p.WukvT + (size_t)pn * 256 * 256; o.K = 256;
        o.ep = EpiKV{p.Kn, p.Vt, tab + slot * 256, pm * 256, pm * 256, pn * 256}; return true; } };
struct PhHs { Params p; const int* tot; const int* aid_tab; int u0, ustride; typedef EpiH EP; static constexpr int NU = 288 * 2;
    __device__ __forceinline__ bool unit(int u, Unit<EP>& o) const { int e, rt, ct, pr; if (!moe_unit(tot, u, 2, e, rt, ct, pr)) return false;
        const int nv = __builtin_amdgcn_readfirstlane(min(256, tot[e] - rt * 256)), slot = (u - u0) / ustride;
        o.am = AMap{p.hbuf, DM, aid_tab + slot * 256, nv}; o.bt = p.WguT + ((size_t)e * 512 + ct * 256) * DM; o.K = DM;
        o.ep = EpiH{p.H, pr, ct * 256, MERGE67 != 0}; return true; }
    __device__ __forceinline__ void done(const Unit<EP>& cu, int wr) const {
        asm volatile("s_waitcnt vmcnt(0)" ::: "memory");
        if (wr == 0) __builtin_amdgcn_s_barrier();
        __builtin_amdgcn_s_barrier();
        if (threadIdx.x == 0) __hip_atomic_fetch_add(hready + (cu.ep.hrow0 >> 8), 1u, __ATOMIC_RELAXED, __HIP_MEMORY_SCOPE_AGENT);
        if (wr == 1) __builtin_amdgcn_s_barrier();
    }
    unsigned* hready; };
struct PhCs { Params p; const int* tot; unsigned* hready; int u0; unsigned* queue; volatile int* slot; typedef EpiC EP; static constexpr int NU = 288 * 4;
    __device__ __forceinline__ int take(bool stagger, int wr) const {
        if (stagger && wr == 0) __builtin_amdgcn_s_barrier();
        if (threadIdx.x == 0) slot[0] = (int)__hip_atomic_fetch_add(queue, 1u, __ATOMIC_RELAXED, __HIP_MEMORY_SCOPE_AGENT);
        __builtin_amdgcn_s_barrier();
        const int t = __builtin_amdgcn_readfirstlane(slot[0]);
        __builtin_amdgcn_s_barrier();
        if (stagger && wr == 1) __builtin_amdgcn_s_barrier();
        return t;
    }
    __device__ __forceinline__ int next(int wr) const { return take(true, wr); }
    __device__ __forceinline__ bool unit(int u, Unit<EP>& o) const { int e, rt, ct, pr; if (!moe_unit(tot, u, 4, e, rt, ct, pr)) return false;
        const int wr = __builtin_amdgcn_readfirstlane((int)threadIdx.x >> 8);
        if (u != u0 && wr == 0) __builtin_amdgcn_s_barrier();
        if (threadIdx.x == 0) { unsigned sp = 0; unsigned* w = hready + (pr >> 8);
            while (__hip_atomic_load(w, __ATOMIC_RELAXED, __HIP_MEMORY_SCOPE_AGENT) < 2u) { __builtin_amdgcn_s_sleep(2); if (++sp > (1u << 20)) break; }
            __builtin_amdgcn_fence(__ATOMIC_ACQUIRE, "agent");
            asm volatile("s_waitcnt vmcnt(0)" ::: "memory"); }
        __builtin_amdgcn_s_barrier();
        if (u != u0 && wr == 1) __builtin_amdgcn_s_barrier();
        const int nv = __builtin_amdgcn_readfirstlane(min(256, tot[e] - rt * 256));
        o.am = AMap{p.H + (size_t)pr * FF, FF, nullptr, 256}; o.bt = p.WdT + ((size_t)e * DM + ct * 256) * FF; o.K = FF;
        o.ep = EpiC{p.contrib, p.list + (size_t)e * LIST_CAP + rt * 256, p.gates, nv, ct * 256}; return true; } };


struct PhZj { Params p; int u0; unsigned* cnt; typedef EpiZ EP; static constexpr int NU = 128 * 7;
    __device__ __forceinline__ void chunk(int u) const {
        int tid = threadIdx.x; asm volatile("" : "+v"(tid));
        const int wid = __builtin_amdgcn_readfirstlane(tid >> 6), lane = tid & 63;
        const int pm = u / 7, pn = u - pm * 7, r0 = pm * 256 + pn * 36 + (pn < 4 ? pn : 4), n = pn < 4 ? 37 : 36;
        ln0_row4<true>(p.x + (size_t)(r0 + wid) * DM, (size_t)8 * DM, p.ln0_g, p.ln0_b, p.hbuf + (size_t)(r0 + wid) * DM, lane);
        if (32 + wid < n) ln0_row1_wt(p.x + (size_t)(r0 + 32 + wid) * DM, p.ln0_g, p.ln0_b, p.hbuf + (size_t)(r0 + 32 + wid) * DM, lane);
        asm volatile("s_waitcnt vmcnt(0)" ::: "memory");
        __syncthreads();
        if (tid == 0) {
            __hip_atomic_fetch_add(cnt + pm, 1u, __ATOMIC_RELAXED, __HIP_MEMORY_SCOPE_AGENT);
            unsigned sp = 0;
            while (__hip_atomic_load(cnt + pm, __ATOMIC_RELAXED, __HIP_MEMORY_SCOPE_AGENT) < 7u) { __builtin_amdgcn_s_sleep(2); if (++sp > (1u << 18)) break; }
            __builtin_amdgcn_fence(__ATOMIC_ACQUIRE, "agent");
            asm volatile("s_waitcnt vmcnt(0)" ::: "memory");
        }
        __syncthreads();
    }
    __device__ __forceinline__ bool unit(int u, Unit<EP>& o) const {
        if (u != u0) {
            const int wr = __builtin_amdgcn_readfirstlane((int)threadIdx.x >> 8);
            if (wr == 0) __builtin_amdgcn_s_barrier();
            chunk(u);
            if (wr == 1) __builtin_amdgcn_s_barrier();
        }
        const int pm = u / 7, pn = u - pm * 7;
        o.am = AMap{p.hbuf + (size_t)pm * 256 * DM, DM, nullptr, 256}; o.bt = p.WinT + (size_t)pn * 256 * DM; o.K = DM;
        o.ep = EpiZ{p.zu, p.zv, p.zq, p.zkv, p.krope, p.rope, pm * 256, pn * 256}; return true; } };

typedef const __attribute__((address_space(4))) Params* KParams;
__device__ __forceinline__ Params ldp() {
#if defined(__HIP_DEVICE_COMPILE__)
    KParams q = (KParams)__builtin_amdgcn_kernarg_segment_ptr(); asm volatile("" : "+s"(q)); return *q;
#else
    return Params{};
#endif
}
template <int LO, int HI>
__global__ __launch_bounds__(512, 2) void mega(Params p_arg_unused) {
    extern __shared__ __attribute__((aligned(16))) unsigned char lds_raw[];
    LAS unsigned char* shm = (LAS unsigned char*)lds_raw;
    char* smc = (char*)lds_raw;
    const int nblk = gridDim.x;
    const int vcu = (nblk % 8 == 0) ? (int)(blockIdx.x % 8) * (nblk / 8) + (int)(blockIdx.x / 8) : (int)blockIdx.x;
    #define PHASE_IDS int tid = threadIdx.x; asm volatile("" : "+v"(tid)); const int wid = __builtin_amdgcn_readfirstlane(tid >> 6), lane = tid & 63; (void)wid; (void)lane
    XcdBarrier xb;
    if (LO != HI) {
        if (threadIdx.x == 0) { ((volatile LAS unsigned*)(smc + LDS_XB))[0] = 0u; ((volatile LAS unsigned*)(smc + LDS_XB))[1] = 0u; }
        __syncthreads();
        { const Params p = ldp(); xb = xcd_barrier_post(p.bar, (volatile LAS unsigned*)(smc + LDS_XB)); }
    }
#ifndef TIMEPH
#define TIMEPH -1
#endif
    unsigned long long ts0_ = 0, ts1_ = 0;
    #define TSTAMP(k) do { if (TIMEPH >= 0) { if ((k) == TIMEPH) ts0_ = __builtin_amdgcn_s_memrealtime(); if ((k) == TIMEPH + 1) ts1_ = __builtin_amdgcn_s_memrealtime(); } } while (0)
    #define SEAM(ph) do { if (LO <= (ph) && HI > (ph)) xcd_barrier(xb); TSTAMP((ph) + 1); } while (0)
    TSTAMP(0);
#ifndef REPMASK
#define REPMASK 0
#endif
    #define NREP(k) ((((REPMASK) >> (k)) & 1) ? 2 : 1)
    #define REPEAT(k) for (int rep_ = 0; rep_ < NREP(k); ++rep_, (rep_ < NREP(k) ? xcd_barrier(xb) : (void)0))
    if (LO <= 0 && HI >= 0) REPEAT(0) {
        const Params p = ldp(); PHASE_IDS;
        { float* scr = (float*)(smc + wid * (64 * 33 * 4)); const int gw = blockIdx.x * 8 + wid, ngw = nblk * 8;
#ifndef P0REP
#define P0REP 0
#endif
          for (int rep = 0; rep < ((P0REP & 1) ? 2 : 1); ++rep)
          for (int it = gw; it < I_EARLY; it += ngw) prep_witem(p, it, scr, lane);
#if !JIT_LN0
          for (int t = gw; t < T_TOK / 4; t += ngw) ln0_row4<false>(p.x + (size_t)t * DM, (size_t)(T_TOK / 4) * DM, p.ln0_g, p.ln0_b, p.hbuf + (size_t)t * DM, lane);
#endif
          }
        for (int rep = 0; rep < ((P0REP & 4) ? 2 : 1); ++rep)
        { const int i0 = blockIdx.x * NTHR + tid; const float inv = powf(10000.f, -(float)(2 * (i0 & 31)) / 64.f);
          if (nblk * NTHR * 8 == T_TOK * 32) { int ps[8];
#pragma unroll
              for (int k = 0; k < 8; ++k) ps[k] = p.pos[(i0 + k * nblk * NTHR) >> 5];
#pragma unroll
              for (int k = 0; k < 8; ++k) { const float ang = (float)ps[k] * inv; p.rope[i0 + k * nblk * NTHR] = make_float2(cosf(ang), sinf(ang)); } }
          else for (int i = i0; i < T_TOK * 32; i += nblk * NTHR) { const float ang = (float)p.pos[i >> 5] * inv; p.rope[i] = make_float2(cosf(ang), sinf(ang)); } }
        for (int i = blockIdx.x * NTHR + tid; i < 36 * 1024; i += nblk * NTHR) { const int o = i >> 10, k = i & 1023; const float w = o < 4 ? p.w_rg[k * 4 + o] : p.w_re[k * 32 + (o - 4)];
            const bf16_t hi = f2bf(w); p.WrT[i] = hi; p.WrT[36864 + i] = f2bf(w - bf2f(hi)); }
    }
    SEAM(0);
    if (LO <= 1 && HI >= 1) REPEAT(1) {
#if GMLP_FUSED && KVCHAIN
        { { const Params p = ldp(); gemm_stream(PhZ2{p}, shm, vcu, nblk); }
          for (;;) {
              int t;
              { const Params p = ldp(); PHASE_IDS; volatile int* slot = (volatile int*)(smc + LDS_AID);
                if (tid == 0) slot[0] = (int)__hip_atomic_fetch_add(p.bar + 3584, 1u, __ATOMIC_RELAXED, __HIP_MEMORY_SCOPE_AGENT);
                __syncthreads();
                t = __builtin_amdgcn_readfirstlane(slot[0]);
                __syncthreads(); }
              if (t >= 128 + 512 + 128) break;
              if (t < 128) { const Params p = ldp(); const int pm = t; float* tab = (float*)(smc + LDS_PRE);
                  Unit<EpiZ> un; un.am = AMap{p.hbuf + (size_t)pm * 256 * DM, DM, nullptr, 256}; un.bt = p.WinT + (size_t)4 * 256 * DM; un.K = DM; un.ep = EpiZ{p.zu, p.zv, p.zq, p.zkv, p.krope, p.rope, pm * 256, 4 * 256};
                  const KvArgs kv{p.zkv, tab, pm * 256};
                  gemm256<EpiZ, 2>(un, shm, nullptr, &kv);
                  gemm_stream(PhKVc{p, tab, pm}, shm, 0, 1);
              } else if (t < 128 + 512) { const Params p = ldp(); const int w = t - 128, pm = w >> 2, h = w & 3;
                  Unit<EpiZ> un; un.am = AMap{p.hbuf + (size_t)pm * 256 * DM, DM, nullptr, 256}; un.bt = p.WinT + (size_t)h * 256 * DM; un.K = DM; un.ep = EpiZ{p.zu, p.zv, p.zq, p.zkv, p.krope, p.rope, pm * 256, h * 256};
                  const GmArgs gm{p.gm_g, p.gm_b, p.w_sp, p.b_sp, p.mix, pm * 256, h};
                  gemm256<EpiZ, 1>(un, shm, &gm);
              } else { const Params p = ldp(); PHASE_IDS; const int ch = t - 640; float* scr = (float*)(smc + wid * (64 * 33 * 4));
                  for (int k = wid; k < 96; k += 8) prep_witem(p, I_EARLY + ch * 96 + k, scr, lane);
                  __syncthreads(); }
          } }
#elif GMLP_FUSED && P1QUEUE
        { { const Params p = ldp(); gemm_stream(PhZ3{p}, shm, vcu, nblk); }
          for (;;) {
              int t;
              { const Params p = ldp(); PHASE_IDS; volatile int* slot = (volatile int*)(smc + LDS_AID);
                if (tid == 0) slot[0] = (int)__hip_atomic_fetch_add(p.bar + 3584, 1u, __ATOMIC_RELAXED, __HIP_MEMORY_SCOPE_AGENT);
                __syncthreads();
                t = __builtin_amdgcn_readfirstlane(slot[0]);
                __syncthreads(); }
              if (t >= 512 + 128) break;
              if (t < 512) { const Params p = ldp(); const int pm = t >> 2, h = t & 3;
                  Unit<EpiZ> un; un.am = AMap{p.hbuf + (size_t)pm * 256 * DM, DM, nullptr, 256}; un.bt = p.WinT + (size_t)h * 256 * DM; un.K = DM; un.ep = EpiZ{p.zu, p.zv, p.zq, p.zkv, p.krope, p.rope, pm * 256, h * 256};
                  const GmArgs gm{p.gm_g, p.gm_b, p.w_sp, p.b_sp, p.mix, pm * 256, h};
                  gemm256<EpiZ, 1>(un, shm, &gm);
              } else { const Params p = ldp(); PHASE_IDS; const int ch = t - 512; float* scr = (float*)(smc + wid * (64 * 33 * 4));
                  for (int k = wid; k < 96; k += 8) prep_witem(p, I_EARLY + ch * 96 + k, scr, lane);
                  __syncthreads(); }
          } }
#elif GMLP_FUSED
        { const Params p = ldp(); PHASE_IDS;
          gemm_stream(PhZ3{p}, shm, vcu, nblk);
          if (PhZ3::NU % nblk != 0 && vcu >= PhZ3::NU % nblk) { float* scr = (float*)(smc + wid * (64 * 33 * 4)); const int nlate = nblk - (PhZ3::NU % nblk), gw = (vcu - PhZ3::NU % nblk) * 8 + wid, ngw = nlate * 8;
              for (int it = I_EARLY + gw; it < I_TOTAL; it += ngw) prep_witem(p, it, scr, lane); }
          else if (PhZ3::NU % nblk == 0) { float* scr = (float*)(smc + wid * (64 * 33 * 4)); for (int it = I_EARLY + vcu * 8 + wid; it < I_TOTAL; it += nblk * 8) prep_witem(p, it, scr, lane); }
          __syncthreads();
          for (int w = vcu; w < 512; w += nblk) { const int pm = w >> 2, h = w & 3;
              Unit<EpiZ> un; un.am = AMap{p.hbuf + (size_t)pm * 256 * DM, DM, nullptr, 256}; un.bt = p.WinT + (size_t)h * 256 * DM; un.K = DM; un.ep = EpiZ{p.zu, p.zv, p.zq, p.zkv, p.krope, p.rope, pm * 256, h * 256};
              const GmArgs gm{p.gm_g, p.gm_b, p.w_sp, p.b_sp, p.mix, pm * 256, h};
              gemm256<EpiZ, 1>(un, shm, &gm); } }
#else
#if JIT_LN0
        { const Params p = ldp(); PhZj ph{p, vcu, p.bar + 3520}; ph.chunk(vcu); gemm_stream(ph, shm, vcu, nblk); }
#else
        gemm_phase(PhZ{ldp()}, shm, vcu);
#endif
        { const Params p = ldp(); PHASE_IDS; const int nlate = nblk - (PhZ::NU % nblk);
          if (PhZ::NU % nblk != 0 && vcu >= PhZ::NU % nblk) { float* scr = (float*)(smc + wid * (64 * 33 * 4)); const int gw = (vcu - PhZ::NU % nblk) * 8 + wid, ngw = nlate * 8;
              for (int it = I_EARLY + gw; it < I_TOTAL; it += ngw) prep_witem(p, it, scr, lane); }
          else if (PhZ::NU % nblk == 0) { float* scr = (float*)(smc + wid * (64 * 33 * 4)); for (int it = I_EARLY + vcu * 8 + wid; it < I_TOTAL; it += nblk * 8) prep_witem(p, it, scr, lane); } }
#endif
    }
    SEAM(1);
    if (LO <= 2 && HI >= 2) REPEAT(2) {
        const Params p = ldp();
        float* tab = (float*)(smc + LDS_PRE);
#if KVCHAIN
        { int slot = 0;
          for (int u = vcu; u < PhQs::NU; u += nblk, ++slot) rs_table<384>(p.zq + (size_t)(u / 3) * 256 * 384, tab + slot * 256); }
        __syncthreads();
        gemm_stream(PhQs{p, tab, vcu, nblk}, shm, vcu, nblk);
#else
        if (nblk == 256) {
            const int nq = vcu < 128 ? 2 : 1, kbeg = vcu < 128 ? vcu : 128 + (vcu - 128) * 3, kend = vcu < 128 ? vcu + 1 : kbeg + 3;
            for (int i = 0; i < nq; ++i) rs_table<384>(p.zq + (size_t)((vcu + i * 256) / 3) * 256 * 384, tab + i * 256);
            for (int k = kbeg; k < kend; ++k) rs_table<256>(p.zkv + (size_t)(k >> 2) * 256 * 256, tab + (nq + k - kbeg) * 256);
            __syncthreads();
            gemm_stream(PhQs{p, tab, vcu, nblk}, shm, vcu, nblk);
            gemm_stream(PhKVb{p, tab, kbeg, kend, nq}, shm, kbeg, 1);
        } else {
        { int slot = 0;
          for (int u = vcu; u < PhKVs::NU; u += nblk, ++slot) {
              if (u < PhQs::NU) rs_table<384>(p.zq + (size_t)(u / 3) * 256 * 384, tab + slot * 256); else rs_table<256>(p.zkv + (size_t)((u - 384) >> 2) * 256 * 256, tab + slot * 256); } }
        __syncthreads();
        gemm_stream(PhQs{p, tab, vcu, nblk}, shm, vcu, nblk);
        { const int i0 = vcu >= PhQs::NU ? 0 : (PhQs::NU - vcu + nblk - 1) / nblk; gemm_stream(PhKVs{p, tab, vcu, nblk}, shm, vcu + i0 * nblk, nblk); }
        }
#endif
#if !GMLP_FUSED
        gmlp_phase(p, smc, vcu);
#endif
    }
    SEAM(2);
    if (LO <= 3 && HI >= 3) REPEAT(3) {
        const Params p = ldp();
#ifndef ATTPROBE
#define ATTPROBE 0
#endif
        for (int u = vcu; u < 256; u += nblk) { const int bh = u >> 2, pr = u & 3; attn_block<0>(p, smc, bh, 7 - pr, p.mix); attn_block<0>(p, smc, bh, pr, p.mix); }
    }
    SEAM(3);
    if (LO <= 4 && HI >= 4) {
#if XPROBE > 0
        gemm_phase(PhYp<XPROBE>{ldp()}, shm, vcu); xcd_barrier(xb);
#endif
#ifndef WARM4
#define WARM4 0
#endif
        if (WARM4) { const Params p = ldp(); PHASE_IDS;
            for (int u = vcu; u < 512; u += nblk) { const char* a = (const char*)(p.mix + (size_t)(u >> 2) * 256 * DM); unsigned acc_ = 0;
#pragma unroll
                for (int i = 0; i < 8; ++i) acc_ += *(const unsigned*)(a + ((size_t)(i * 512 + tid) << 7));
                asm volatile("" :: "v"(acc_)); } }
        gemm_phase(PhY{ldp()}, shm, vcu);
    }
    SEAM(4);
    if (LO <= 5 && HI >= 5) {
        const Params p = ldp();
        for (int tb = blockIdx.x; tb < T_TOK / 128; tb += nblk) router_tile(p, smc, tb);
    }
    SEAM(5);
    if (LO <= 6 && HI >= 6) REPEAT(6) {
        const Params p = ldp(); PHASE_IDS;
        moe_tables(p, smc);
        const int* tot = (const int*)(smc + LDS_TOT); int* aid_tab = (int*)(smc + LDS_AID); const unsigned short* pre = (const unsigned short*)(smc + LDS_PRE);
        if (blockIdx.x == 0 && tid < NEXP) p.cnt[tid] = tot[tid];
        { int slot = 0;
          for (int u = vcu; slot < 3; u += nblk, ++slot) {
              int e, rt, ct, pr; if (!moe_unit(tot, u, 2, e, rt, ct, pr)) break;
              const int te = tot[e];
              if (tid < 256) { const int g = rt * 256 + tid; int aid = 0;
                  if (g < te) { int lo = 0, hi = 256;
#pragma unroll
                      for (int it = 0; it < 8; ++it) { const int mid = (lo + hi) >> 1; if ((int)pre[e * 256 + mid] <= g) lo = mid; else hi = mid; }
                      aid = p.listb[((size_t)lo * NEXP + e) * 256 + (g - (int)pre[e * 256 + lo])];
                      if (ct == 0) { if (MERGE67) __hip_atomic_store(p.list + (size_t)e * LIST_CAP + g, aid, __ATOMIC_RELAXED, __HIP_MEMORY_SCOPE_AGENT); else p.list[(size_t)e * LIST_CAP + g] = aid; } }
                  aid_tab[slot * 256 + tid] = aid; } } }
        __syncthreads();
        gemm_stream(PhHs{p, tot, aid_tab, vcu, nblk, p.bar + 3712}, shm, vcu, nblk);
#if MERGE67
        { PhCs pc{p, tot, p.bar + 3712, 0, p.bar + 3648, (volatile int*)(smc + LDS_AID)}; pc.u0 = pc.take(false, 0); gemm_stream(pc, shm, pc.u0, nblk); }
#endif
    }
#if !MERGE67
    SEAM(6);
#else
    TSTAMP(7);
#endif
    if (!MERGE67 && LO <= 7 && HI >= 7) REPEAT(7) {
        Params p = ldp(); PHASE_IDS;
        int* tot = (int*)(smc + LDS_TOT);
        if (tid < NEXP) tot[tid] = p.cnt[tid];
        __syncthreads();
        p.cnt = tot;
        gemm_phase(PhC{p}, shm, vcu);
    }
    SEAM(7);
#ifndef WPROBE
#define WPROBE 0
#endif
    if (WPROBE > 0 && LO <= 8 && HI >= 8 && LO != HI) {
        const Params p = ldp(); PHASE_IDS;
        const int wr = wid >> 2, wc = wid & 3, fr = lane & 15, fq = lane >> 4;
        for (int u = vcu; u < 512; u += nblk) { const int pm = u >> 2, pn = u & 3;
            bf16_t* base = p.mix + (size_t)pm * 256 * DM + pn * 256;
#pragma unroll
            for (int ai = 0; ai < 2; ++ai)
#pragma unroll
                for (int m = 0; m < 4; ++m) { bf16_t* rowp = base + (size_t)(ai * 128 + wr * 64 + m * 16 + fr) * DM;
                    if (WPROBE == 1) { const u32x2 z = {0u, 0u};
                        *(u32x2*)(rowp + wc * 32 + 4 * fq) = z; *(u32x2*)(rowp + wc * 32 + 16 + 4 * fq) = z; *(u32x2*)(rowp + 128 + wc * 32 + 4 * fq) = z; *(u32x2*)(rowp + 128 + wc * 32 + 16 + 4 * fq) = z; }
                    else { const u32x4 z = {0u, 0u, 0u, 0u}; *(u32x4*)(rowp + wc * 64 + 16 * fq) = z; *(u32x4*)(rowp + wc * 64 + 16 * fq + 8) = z; } } }
        xcd_barrier(xb);
    }
    if (LO <= 8 && HI >= 8) REPEAT(8) { const Params p = ldp(); PHASE_IDS; for (int t = blockIdx.x * 8 + wid; t < T_TOK / 2; t += nblk * 8) final_token2(p, t, t + T_TOK / 2, lane); }
    if (TIMEPH >= 0 && LO != HI) {
        xcd_barrier(xb); TSTAMP(9);
        if (blockIdx.x == 0 && threadIdx.x < 64) { const Params p = ldp(); const float dv = (float)(ts1_ - ts0_) * 6.0e-5f; for (int i = threadIdx.x; i < 4096; i += 64) p.out[i] = dv; }
    }
    #undef SEAM
}

#if ATTPROBE > 0
__global__ __launch_bounds__(512, 2) void attn_probe_kernel(Params p) {
    extern __shared__ __attribute__((aligned(16))) unsigned char lds_raw[];
    char* smc = (char*)lds_raw; const int nblk = gridDim.x;
    const int vcu = (nblk % 8 == 0) ? (int)(blockIdx.x % 8) * (nblk / 8) + (int)(blockIdx.x / 8) : (int)blockIdx.x;
    for (int u = vcu; u < 256; u += nblk) { const int bh = u >> 2, pr = u & 3; attn_block<ATTPROBE>(p, smc, bh, 7 - pr, (bf16_t*)p.out); attn_block<ATTPROBE>(p, smc, bh, pr, (bf16_t*)p.out); }
}
#endif
#ifndef MODE
#ifndef MODE
#define MODE 1
#endif
#endif
#ifndef FASTMASK
#define FASTMASK 0x1ff
#endif
static size_t carve(size_t& off, size_t bytes) { const size_t o = off; off += (bytes + 255) & ~(size_t)255; return o; }
#ifndef DUPMASK
#define DUPMASK 0
#endif
template <int PH> static void launch_fast(const Params& p, int grid, hipStream_t stream) { hipLaunchKernelGGL((mega<PH, PH>), dim3(grid), dim3(NTHR), LDS_BYTES, stream, p);
    if ((DUPMASK >> PH) & 1) hipLaunchKernelGGL((mega<PH, PH>), dim3(grid), dim3(NTHR), LDS_BYTES, stream, p); }
extern "C" void kernel_launch(void* const* d_in, const int* in_sizes, int n_in, void* d_out, int out_size, void* d_ws, size_t ws_size, hipStream_t stream) {
    Params p{};
    p.x = (const float*)d_in[0]; p.pos = (const int*)d_in[1]; p.ln0_g = (const float*)d_in[2]; p.ln0_b = (const float*)d_in[3]; p.w_in = (const float*)d_in[4];
    p.gm_g = (const float*)d_in[5]; p.gm_b = (const float*)d_in[6]; p.w_sp = (const float*)d_in[7]; p.b_sp = (const float*)d_in[8]; p.qn_g = (const float*)d_in[9];
    p.w_uq = (const float*)d_in[10]; p.kvn_g = (const float*)d_in[11]; p.w_ukv = (const float*)d_in[12]; p.w_out = (const float*)d_in[13]; p.ln1_g = (const float*)d_in[14];
    p.ln1_b = (const float*)d_in[15]; p.w_rg = (const float*)d_in[16]; p.b_rg = (const float*)d_in[17]; p.w_re = (const float*)d_in[18]; p.b_re = (const float*)d_in[19];
    p.w_gate = (const float*)d_in[20]; p.w_up = (const float*)d_in[21]; p.w_down = (const float*)d_in[22]; p.ln2_g = (const float*)d_in[23]; p.ln2_b = (const float*)d_in[24];
    p.out = (float*)d_out;
    char* ws = (char*)d_ws; size_t off = 0;
    p.bar = (unsigned*)(ws + carve(off, 16384));
    p.cnt = (int*)(ws + carve(off, 1024));
    p.WinT = (bf16_t*)(ws + carve(off, (size_t)ZN * 1024 * 2)); p.WuqT = (bf16_t*)(ws + carve(off, 768 * 384 * 2)); p.WukvT = (bf16_t*)(ws + carve(off, 1024 * 256 * 2));
    p.WoutT = (bf16_t*)(ws + carve(off, 1024 * 1024 * 2)); p.WguT = (bf16_t*)(ws + carve(off, (size_t)32 * 512 * 1024 * 2)); p.WdT = (bf16_t*)(ws + carve(off, (size_t)32 * 1024 * 256 * 2));
    p.hbuf = (bf16_t*)(ws + carve(off, (size_t)T_TOK * DM * 2)); p.rope = (float2*)(ws + carve(off, (size_t)T_TOK * 32 * 8));
    p.list = (int*)(ws + carve(off, (size_t)NEXP * LIST_CAP * 4)); p.gates = (float*)(ws + carve(off, (size_t)T_TOK * 2 * 4));
    p.ystat = (float*)(ws + carve(off, (size_t)T_TOK * 32 * 4)); p.WrT = (bf16_t*)(ws + carve(off, 2 * 36 * 1024 * 2)); p.cntb = (int*)(ws + carve(off, 256 * NEXP * 4)); p.listb = (int*)(ws + carve(off, (size_t)256 * NEXP * 256 * 4));
    p.rsq = (float*)(ws + carve(off, T_TOK * 4)); p.rskv = (float*)(ws + carve(off, T_TOK * 4));
    const size_t stage0 = off;
    p.zu = (bf16_t*)(ws + carve(off, (size_t)T_TOK * 512 * 2)); p.zv = (bf16_t*)(ws + carve(off, (size_t)T_TOK * 512 * 2));
    p.zq = (bf16_t*)(ws + carve(off, (size_t)T_TOK * 384 * 2)); p.zkv = (bf16_t*)(ws + carve(off, (size_t)T_TOK * 256 * 2)); p.krope = (bf16_t*)(ws + carve(off, (size_t)T_TOK * 64 * 2));
    p.Q = (bf16_t*)(ws + carve(off, (size_t)T_TOK * 768 * 2)); p.Kn = (bf16_t*)(ws + carve(off, (size_t)T_TOK * 512 * 2)); p.Vt = (bf16_t*)(ws + carve(off, (size_t)T_TOK * 512 * 2));
    p.mix = (bf16_t*)(ws + carve(off, (size_t)T_TOK * DM * 2));
    const size_t stage_end = off;
    size_t o2 = stage0; p.contrib = (bf16_t*)(ws + carve(o2, (size_t)T_TOK * 2 * DM * 2)); p.H = (bf16_t*)(ws + carve(o2, (size_t)(65536 + 8192) * FF * 2));
    if (o2 > stage_end || stage_end > ws_size) { fprintf(stderr, "kernel_launch: workspace too small (%zu needed, %zu given)\n", stage_end, ws_size); return; }

    static int grid = 0;
    if (!grid) {
        int dev = 0, cus = 0; (void)hipGetDevice(&dev); (void)hipDeviceGetAttribute(&cus, hipDeviceAttributeMultiprocessorCount, dev);
        grid = cus > 0 ? (cus / 8) * 8 : 256;
        (void)hipFuncSetAttribute((const void*)nk_gmlp, hipFuncAttributeMaxDynamicSharedMemorySize, 128 * 129 * 4);
        (void)hipFuncSetAttribute((const void*)nk_attn, hipFuncAttributeMaxDynamicSharedMemorySize, (64 * 192 + 64 * 193 + 64 * 65 + 64 * 128) * 4);
        (void)hipFuncSetAttribute((const void*)mega<0, 8>, hipFuncAttributeMaxDynamicSharedMemorySize, LDS_BYTES);
#if MODE == 2
        (void)hipFuncSetAttribute((const void*)mega<0, 0>, hipFuncAttributeMaxDynamicSharedMemorySize, LDS_BYTES);
        (void)hipFuncSetAttribute((const void*)mega<1, 1>, hipFuncAttributeMaxDynamicSharedMemorySize, LDS_BYTES);
        (void)hipFuncSetAttribute((const void*)mega<2, 2>, hipFuncAttributeMaxDynamicSharedMemorySize, LDS_BYTES);
        (void)hipFuncSetAttribute((const void*)mega<3, 3>, hipFuncAttributeMaxDynamicSharedMemorySize, LDS_BYTES);
        (void)hipFuncSetAttribute((const void*)mega<4, 4>, hipFuncAttributeMaxDynamicSharedMemorySize, LDS_BYTES);
        (void)hipFuncSetAttribute((const void*)mega<5, 5>, hipFuncAttributeMaxDynamicSharedMemorySize, LDS_BYTES);
        (void)hipFuncSetAttribute((const void*)mega<6, 6>, hipFuncAttributeMaxDynamicSharedMemorySize, LDS_BYTES);
        (void)hipFuncSetAttribute((const void*)mega<7, 7>, hipFuncAttributeMaxDynamicSharedMemorySize, LDS_BYTES);
        (void)hipFuncSetAttribute((const void*)mega<8, 8>, hipFuncAttributeMaxDynamicSharedMemorySize, LDS_BYTES);
#endif
    }
#if MODE == 1
    (void)hipMemsetAsync(p.bar, 0, 16384, stream);
    hipLaunchKernelGGL((mega<0, 8>), dim3(grid), dim3(NTHR), LDS_BYTES, stream, p);
#else
    const unsigned fm = (MODE == 2) ? (unsigned)(FASTMASK) : 0u;
    if (fm & 1) launch_fast<0>(p, grid, stream); else { nk_prep_w<<<J_TOTAL, 256, 0, stream>>>(p); nk_ln0<<<T_TOK / 4, 256, 0, stream>>>(p); nk_rope<<<T_TOK * 32 / 256, 256, 0, stream>>>(p); }
    if (fm & 2) launch_fast<1>(p, grid, stream); else nk_gemm<PhZ><<<dim3(PhZ::NU, 32), 256, 0, stream>>>(PhZ{p});
#if defined(P2VAR) && P2VAR == 1
    launch_fast<2>(p, grid, stream); nk_gmlp<<<T_TOK / 128 * 4, 256, 128 * 129 * 4, stream>>>(p);
#elif defined(P2VAR) && P2VAR == 2
    nk_rowscale<<<T_TOK / 4, 256, 0, stream>>>(p); nk_gemm<PhQ><<<dim3(PhQ::NU, 32), 256, 0, stream>>>(PhQ{p, p.rsq});
    nk_gemm<PhKV><<<dim3(PhKV::NU, 32), 256, 0, stream>>>(PhKV{p, p.rskv}); launch_fast<2>(p, grid, stream);
#else
    if (fm & 4) launch_fast<2>(p, grid, stream); else { nk_rowscale<<<T_TOK / 4, 256, 0, stream>>>(p); nk_gemm<PhQ><<<dim3(PhQ::NU, 32), 256, 0, stream>>>(PhQ{p, p.rsq});
        nk_gemm<PhKV><<<dim3(PhKV::NU, 32), 256, 0, stream>>>(PhKV{p, p.rskv}); nk_gmlp<<<T_TOK / 128 * 4, 256, 128 * 129 * 4, stream>>>(p); }
#endif
#if ATTPROBE > 0
    { static bool a2 = false; if (!a2) { a2 = true; (void)hipFuncSetAttribute((const void*)attn_probe_kernel, hipFuncAttributeMaxDynamicSharedMemorySize, LDS_BYTES); }
      hipLaunchKernelGGL(attn_probe_kernel, dim3(grid), dim3(NTHR), LDS_BYTES, stream, p); }
#endif
    if (fm & 8) launch_fast<3>(p, grid, stream); else nk_attn<<<64 * 32, 256, (64 * 192 + 64 * 193 + 64 * 65 + 64 * 128) * 4, stream>>>(p);
    if (fm & 16) launch_fast<4>(p, grid, stream); else nk_gemm<PhY><<<dim3(PhY::NU, 32), 256, 0, stream>>>(PhY{p});
    if (fm & 32) launch_fast<5>(p, grid, stream); else { nk_router_prep<<<144, 256, 0, stream>>>(p); nk_router<<<T_TOK / 4, 256, 0, stream>>>(p); }
    if (fm & 64) launch_fast<6>(p, grid, stream); else nk_gemm<PhH><<<dim3(PhH::NU, 32), 256, 0, stream>>>(PhH{p});
    if (fm & 128) launch_fast<7>(p, grid, stream); else nk_gemm<PhC><<<dim3(PhC::NU, 32), 256, 0, stream>>>(PhC{p});
    if (fm & 256) launch_fast<8>(p, grid, stream); else nk_final<<<T_TOK / 4, 256, 0, stream>>>(p);
#endif
}
```

```cpp
#include <hip/hip_runtime.h>
#define P2VAR 0
#define REPMASK 0x0
#define DUPMASK 0x0
#define TIMEPH -1
#define KREP 1
#define XPROBE 0
#define P0REP 0
#define WPROBE 0
#define ATTPROBE 0
#define JIT_LN0 0
#define MERGE67 1
#define GMLP_FUSED 1
#define ZLAYOUT2 1
#define KVCHAIN 0
#define YSTAT 1
#define P1QUEUE 1
#include <stdint.h>
#include <cstdio>

#define LAS __attribute__((address_space(3)))
typedef unsigned short bf16_t;
typedef short bf16x8 __attribute__((ext_vector_type(8)));
typedef float f32x4 __attribute__((ext_vector_type(4)));
typedef float f32x16 __attribute__((ext_vector_type(16)));
typedef unsigned u32x2 __attribute__((ext_vector_type(2)));
typedef unsigned u32x4 __attribute__((ext_vector_type(4)));

constexpr int T_TOK = 32768, DM = 1024, SEQ = 2048, NBATCH = 16;
constexpr int ZN = 1792;
constexpr int NEXP = 32, FF = 256;
constexpr int LIST_CAP = 32768;
constexpr float ALPHA = 1.189207115002721f;
constexpr float QSCALE = 0.07216878364870322f * 1.4426950408889634f;

struct Params {
    const float* x; const int* pos; const float *ln0_g, *ln0_b, *w_in, *gm_g, *gm_b, *w_sp, *b_sp, *qn_g, *w_uq, *kvn_g, *w_ukv, *w_out, *ln1_g, *ln1_b,
        *w_rg, *b_rg, *w_re, *b_re, *w_gate, *w_up, *w_down, *ln2_g, *ln2_b;
    float* out;
    bf16_t *WinT, *WuqT, *WukvT, *WoutT, *WguT, *WdT;
    bf16_t* hbuf; float2* rope;
    bf16_t *zu, *zv, *zq, *zkv, *krope, *Q, *Kn, *Vt, *mix;
    float *rsq, *rskv;
    int* cnt; int* list; float* gates; bf16_t* H; bf16_t* contrib;
    float* ystat;
    bf16_t* WrT; int* cntb; int* listb;
    unsigned* bar;
};

__device__ __forceinline__ unsigned pk2(float lo, float hi) { unsigned r; asm volatile("v_cvt_pk_bf16_f32 %0, %1, %2" : "=v"(r) : "v"(lo), "v"(hi)); return r; }
__device__ __forceinline__ bf16_t f2bf(float f) { return (bf16_t)(pk2(f, 0.f) & 0xffffu); }
__device__ __forceinline__ float bf2f(bf16_t h) { return __uint_as_float(((unsigned)h) << 16); }
__device__ __forceinline__ float bflo(unsigned u) { return __uint_as_float(u << 16); }
__device__ __forceinline__ float bfhi(unsigned u) { return __uint_as_float(u & 0xffff0000u); }
__device__ __forceinline__ void st4(bf16_t* p, f32x4 v) { u32x2 w; w.x = pk2(v[0], v[1]); w.y = pk2(v[2], v[3]); *(u32x2*)p = w; }
__device__ __forceinline__ void st4wt(bf16_t* p, f32x4 v) { const unsigned lo = pk2(v[0], v[1]), hi = pk2(v[2], v[3]);
    __hip_atomic_store((unsigned long long*)p, ((unsigned long long)hi << 32) | lo, __ATOMIC_RELAXED, __HIP_MEMORY_SCOPE_AGENT); }
__device__ __forceinline__ float shx(float v, int mask) { int l = threadIdx.x; asm volatile("" : "+v"(l)); const int idx = ((l ^ mask) & 63) << 2; return __int_as_float(__builtin_amdgcn_ds_bpermute(idx, __float_as_int(v))); }
__device__ __forceinline__ float wave_sum(float v) {
#pragma unroll
    for (int o = 1; o < 64; o <<= 1) v += shx(v, o);
    return v;
}
__device__ __forceinline__ float gelu_tanh(float x) {
    const float u = x + 0.044715f * x * x * x;
    const float e = __builtin_amdgcn_exp2f(-2.f * 0.7978845608028654f * 1.4426950408889634f * u);
    return x * __builtin_amdgcn_rcpf(1.f + e);
}
__device__ __forceinline__ float silu_f(float x) { return x * __builtin_amdgcn_rcpf(1.f + __builtin_amdgcn_exp2f(-1.4426950408889634f * x)); }
__device__ __forceinline__ int perm16(int k) { return 8 * ((k >> 2) & 1) + (k & 3) + 4 * (k >> 3); }

struct AMap {
    const bf16_t* base; int ld; const int* list; int nvalid;
    __device__ __forceinline__ const bf16_t* row(int r) const {
        if (list) { const int a = list[r < nvalid ? r : 0]; return base + (size_t)(a >> 1) * ld; }
        return base + (size_t)r * ld;
    }
};

struct EpiZ {
    bf16_t *zu, *zv, *zq, *zkv, *krope; const float2* rope; int row0, col0;
    __device__ __forceinline__ void rope_store(int row, int c, f32x4 v, float2 cs0, float2 cs1) const {
        const int i0 = (c - 1664) >> 1; bf16_t* kr = krope + (size_t)row * 64;
        kr[i0] = f2bf(v[0] * cs0.x - v[1] * cs0.y); kr[i0 + 32] = f2bf(v[1] * cs0.x + v[0] * cs0.y);
        kr[i0 + 1] = f2bf(v[2] * cs1.x - v[3] * cs1.y); kr[i0 + 33] = f2bf(v[3] * cs1.x + v[2] * cs1.y);
    }
    __device__ __forceinline__ void plain(int row, int c, f32x4 v) const {
        if (c < 1024) {
            f32x4 g; g[0] = gelu_tanh(v[0]); g[1] = gelu_tanh(v[1]); g[2] = gelu_tanh(v[2]); g[3] = gelu_tanh(v[3]);
            if (c < 512) st4(zu + (size_t)row * 512 + c, g); else st4(zv + (size_t)row * 512 + (c - 512), g);
        }
#if ZLAYOUT2
        else if (c < 1280) st4(zkv + (size_t)row * 256 + (c - 1024), v);
        else if (c < 1536) st4(zq + (size_t)row * 384 + (c - 1280), v);
        else if (c < 1664) st4(zq + (size_t)row * 384 + 256 + (c - 1536), v);
#else
        else if (c < 1408) st4(zq + (size_t)row * 384 + (c - 1024), v);
        else if (c < 1664) st4(zkv + (size_t)row * 256 + (c - 1408), v);
#endif
    }
    __device__ __forceinline__ void half(int row, int c, f32x4 v) const {
        if (c < 1664) plain(row, c, v);
        else if (c < 1728) { const int i0 = (c - 1664) >> 1; rope_store(row, c, v, rope[(size_t)row * 32 + i0], rope[(size_t)row * 32 + i0 + 1]); }
    }
    __device__ __forceinline__ void operator()(int r, int c32, int fq, f32x4 a, f32x4 b) const { const int row = row0 + r, c = col0 + c32 + 4 * fq; half(row, c, a); half(row, c + 16, b); }
    struct Ctx { float2 cs[4]; }; static constexpr int BATCH4 = 1;
    __device__ __forceinline__ bool is_rope(int c32) const { const int c = col0 + c32 + HALF_COLS; return c >= 1664 && c < 1728; }
    static constexpr int HALF_COLS = 128;
    __device__ __forceinline__ Ctx pre(int r, int c32, int fq) const { Ctx x;
        if (is_rope(c32)) { const int i0 = (col0 + c32 + 128 + 4 * fq - 1664) >> 1; const float2* rp = rope + (size_t)(row0 + r) * 32 + i0; x.cs[0] = rp[0]; x.cs[1] = rp[1]; x.cs[2] = rp[8]; x.cs[3] = rp[9]; }
        else { x.cs[0] = x.cs[1] = x.cs[2] = x.cs[3] = make_float2(0.f, 0.f); }
        return x; }
    __device__ __forceinline__ void post(int r, int c32, int fq, const Ctx& x, f32x4 a0, f32x4 b0, f32x4 a1, f32x4 b1) const {
        const int row = row0 + r, c = col0 + c32 + 4 * fq;
        plain(row, c, a0); plain(row, c + 16, b0);
        if (is_rope(c32)) { rope_store(row, c + 128, a1, x.cs[0], x.cs[1]); rope_store(row, c + 144, b1, x.cs[2], x.cs[3]); }
        else if (c + 128 < 1664) { plain(row, c + 128, a1); plain(row, c + 144, b1); }
    }
};
struct EpiQ {
    bf16_t* Q; const float* rs; int rs0; int row0, col0;
    __device__ __forceinline__ void half(int row, int c, f32x4 v, float sc) const {
        const int h = c / 192, d = c - h * 192, b = row >> 11, s = row & 2047;
        st4(Q + ((size_t)((b * 4 + h) * SEQ + s)) * 192 + d, v * sc);
    }
    __device__ __forceinline__ void operator()(int r, int c32, int fq, f32x4 a, f32x4 b) const {
        const int row = row0 + r, c = col0 + c32 + 4 * fq; const float sc = rs[row - rs0] * QSCALE; half(row, c, a, sc); half(row, c + 16, b, sc); }
    struct Ctx { float sc; };
    __device__ __forceinline__ Ctx pre(int r, int c32, int fq) const { Ctx x; x.sc = rs[row0 + r - rs0] * QSCALE; return x; }
    __device__ __forceinline__ void post(int r, int c32, int fq, const Ctx& x, f32x4 a0, f32x4 b0, f32x4 a1, f32x4 b1) const {
        const int row = row0 + r, c = col0 + c32 + 4 * fq; half(row, c, a0, x.sc); half(row, c + 16, b0, x.sc); half(row, c + 128, a1, x.sc); half(row, c + 144, b1, x.sc); }
};
struct EpiKV {
    bf16_t *Kn, *Vt; const float* rs; int rs0; int row0, col0;
    __device__ __forceinline__ void half(int row, int c, f32x4 v, float sc) const {
        const int h = c >> 8, e = c & 255, b = row >> 11, s = row & 2047;
        v = v * sc;
        if (e < 128) st4(Kn + ((size_t)((b * 4 + h) * SEQ + s)) * 128 + e, v);
        else {
            bf16_t* vt = Vt + ((size_t)((b * 4 + h) * 128 + (e - 128))) * SEQ + (s & ~15) + perm16(s & 15);
            vt[0] = f2bf(v[0]); vt[SEQ] = f2bf(v[1]); vt[2 * SEQ] = f2bf(v[2]); vt[3 * SEQ] = f2bf(v[3]);
        }
    }
    __device__ __forceinline__ void operator()(int r, int c32, int fq, f32x4 a, f32x4 b) const {
        const int row = row0 + r, c = col0 + c32 + 4 * fq; const float sc = rs[row - rs0]; half(row, c, a, sc); half(row, c + 16, b, sc); }
    struct Ctx { float sc; };
    __device__ __forceinline__ Ctx pre(int r, int c32, int fq) const { Ctx x; x.sc = rs[row0 + r - rs0]; return x; }
    __device__ __forceinline__ void post(int r, int c32, int fq, const Ctx& x, f32x4 a0, f32x4 b0, f32x4 a1, f32x4 b1) const {
        const int row = row0 + r, c = col0 + c32 + 4 * fq; half(row, c, a0, x.sc); half(row, c + 16, b0, x.sc); half(row, c + 128, a1, x.sc); half(row, c + 144, b1, x.sc); }
};
struct EpiY {
    bf16_t* hb; int row0, col0; float* ystat;
    __device__ __forceinline__ void fin(bf16_t* p, u32x2 h, f32x4 v) const {
        v[0] += ALPHA * bflo(h.x); v[1] += ALPHA * bfhi(h.x); v[2] += ALPHA * bflo(h.y); v[3] += ALPHA * bfhi(h.y); st4(p, v); }
    __device__ __forceinline__ void fin2(bf16_t* p, u32x2 h, f32x4 v, float& s, float& q) const {
        v[0] += ALPHA * bflo(h.x); v[1] += ALPHA * bfhi(h.x); v[2] += ALPHA * bflo(h.y); v[3] += ALPHA * bfhi(h.y); st4(p, v);
        s += (v[0] + v[1]) + (v[2] + v[3]); q += (v[0] * v[0] + v[1] * v[1]) + (v[2] * v[2] + v[3] * v[3]); }
    __device__ __forceinline__ void half(int row, int c, f32x4 v) const { bf16_t* p = hb + (size_t)row * DM + c; fin(p, *(const u32x2*)p, v); }
    __device__ __forceinline__ void operator()(int r, int c32, int fq, f32x4 a, f32x4 b) const { const int row = row0 + r, c = col0 + c32 + 4 * fq; half(row, c, a); half(row, c + 16, b); }
    struct Ctx { u32x2 h[4]; }; static constexpr int BATCH4 = 1;
    __device__ __forceinline__ Ctx pre(int r, int c32, int fq) const { Ctx x; const bf16_t* p = hb + (size_t)(row0 + r) * DM + col0 + c32 + 4 * fq;
        x.h[0] = *(const u32x2*)p; x.h[1] = *(const u32x2*)(p + 16); x.h[2] = *(const u32x2*)(p + 128); x.h[3] = *(const u32x2*)(p + 144); return x; }
    __device__ __forceinline__ void post(int r, int c32, int fq, const Ctx& x, f32x4 a0, f32x4 b0, f32x4 a1, f32x4 b1) const {
        bf16_t* p = hb + (size_t)(row0 + r) * DM + col0 + c32 + 4 * fq;
        if (ystat) { float s = 0.f, q = 0.f; fin2(p, x.h[0], a0, s, q); fin2(p + 16, x.h[1], b0, s, q); fin2(p + 128, x.h[2], a1, s, q); fin2(p + 144, x.h[3], b1, s, q);
            s += shx(s, 16); s += shx(s, 32); q += shx(q, 16); q += shx(q, 32);
            if (fq == 0) { typedef float f32x2 __attribute__((ext_vector_type(2))); *(f32x2*)(ystat + ((size_t)(row0 + r) * 16 + (col0 >> 6) + (c32 >> 5)) * 2) = (f32x2){s, q}; } }
        else { fin(p, x.h[0], a0); fin(p + 16, x.h[1], b0); fin(p + 128, x.h[2], a1); fin(p + 144, x.h[3], b1); } }
};
struct EpiH {
    bf16_t* H; int hrow0, col0; bool wt;
    __device__ __forceinline__ void operator()(int r, int c32, int fq, f32x4 a, f32x4 b) const {
        const int hid = ((col0 + c32) >> 5) * 16 + 4 * fq;
        f32x4 o; o[0] = silu_f(a[0]) * b[0]; o[1] = silu_f(a[1]) * b[1]; o[2] = silu_f(a[2]) * b[2]; o[3] = silu_f(a[3]) * b[3];
        if (wt) st4wt(H + (size_t)(hrow0 + r) * FF + hid, o); else st4(H + (size_t)(hrow0 + r) * FF + hid, o);
    }
    struct Ctx { int dummy; };
    __device__ __forceinline__ Ctx pre(int, int, int) const { Ctx x; x.dummy = 0; return x; }
    __device__ __forceinline__ void post(int r, int c32, int fq, const Ctx&, f32x4 a0, f32x4 b0, f32x4 a1, f32x4 b1) const { (*this)(r, c32, fq, a0, b0); (*this)(r, c32 + 128, fq, a1, b1); }
};
struct EpiC {
    bf16_t* contrib; const int* list; const float* gates; int nvalid; int col0;
    __device__ __forceinline__ void operator()(int r, int c32, int fq, f32x4 a, f32x4 b) const {
        if (r >= nvalid) return;
        const int aid = list[r]; const float g = gates[aid];
        char* p = (char*)contrib + ((unsigned)aid * (unsigned)(DM * 2) + (unsigned)((col0 + c32 + 4 * fq) * 2));
        u32x2 w; w.x = pk2(a[0] * g, a[1] * g); w.y = pk2(a[2] * g, a[3] * g); *(u32x2*)p = w;
        w.x = pk2(b[0] * g, b[1] * g); w.y = pk2(b[2] * g, b[3] * g); *(u32x2*)(p + 32) = w;
    }
    struct Ctx { int aid; float g; };
    __device__ __forceinline__ Ctx pre(int r, int, int) const { Ctx x; x.aid = r < nvalid ? list[r] : -1; x.g = 0.f; return x; }
    __device__ __forceinline__ void pre2(Ctx& x) const { if (x.aid >= 0) x.g = gates[x.aid]; }
    __device__ __forceinline__ void post(int r, int c32, int fq, const Ctx& x, f32x4 a0, f32x4 b0, f32x4 a1, f32x4 b1) const {
        if (x.aid < 0) return;
        const float g = x.g;
        char* p = (char*)contrib + ((unsigned)x.aid * (unsigned)(DM * 2) + (unsigned)((col0 + c32 + 4 * fq) * 2));
        u32x2 w; w.x = pk2(a0[0] * g, a0[1] * g); w.y = pk2(a0[2] * g, a0[3] * g); *(u32x2*)p = w;
        w.x = pk2(b0[0] * g, b0[1] * g); w.y = pk2(b0[2] * g, b0[3] * g); *(u32x2*)(p + 32) = w;
        w.x = pk2(a1[0] * g, a1[1] * g); w.y = pk2(a1[2] * g, a1[3] * g); *(u32x2*)(p + 256) = w;
        w.x = pk2(b1[0] * g, b1[1] * g); w.y = pk2(b1[2] * g, b1[3] * g); *(u32x2*)(p + 288) = w;
    }
};

template <class EP> struct Unit { AMap am; const bf16_t* bt; int K; EP ep; };

__device__ __forceinline__ bool moe_unit(const int* cnt, int u, int ncol, int& e, int& rt, int& ct, int& padrow) {
    int acc = 0, fe = -1, facc = 0;
#pragma unroll 4
    for (int i = 0; i < NEXP; ++i) {
        const int t = (cnt[i] + 255) >> 8;
        if (fe < 0 && u < (acc + t) * ncol) { fe = i; facc = acc; }
        acc += t;
    }
    fe = __builtin_amdgcn_readfirstlane(fe); facc = __builtin_amdgcn_readfirstlane(facc);
    if (fe < 0) return false;
    const int w = u - facc * ncol; e = fe; rt = w / ncol; ct = w - rt * ncol; padrow = (facc + rt) * 256;
    return true;
}

struct PhZ { Params p; typedef EpiZ EP; static constexpr int NU = 128 * 7;
    __device__ __forceinline__ bool unit(int u, Unit<EP>& o) const { const int pm = u / 7, pn = u - pm * 7;
        o.am = AMap{p.hbuf + (size_t)pm * 256 * DM, DM, nullptr, 256}; o.bt = p.WinT + (size_t)pn * 256 * DM; o.K = DM;
        o.ep = EpiZ{p.zu, p.zv, p.zq, p.zkv, p.krope, p.rope, pm * 256, pn * 256}; return true; } };
struct PhQ { Params p; const float* rs; typedef EpiQ EP; static constexpr int NU = 128 * 3;
    __device__ __forceinline__ bool unit(int u, Unit<EP>& o) const { const int pm = u / 3, pn = u - pm * 3;
        o.am = AMap{p.zq + (size_t)pm * 256 * 384, 384, nullptr, 256}; o.bt = p.WuqT + (size_t)pn * 256 * 384; o.K = 384;
        o.ep = EpiQ{p.Q, rs, 0, pm * 256, pn * 256}; return true; } };
struct PhKV { Params p; const float* rs; typedef EpiKV EP; static constexpr int NU = 128 * 4;
    __device__ __forceinline__ bool unit(int u, Unit<EP>& o) const { const int pm = u >> 2, pn = u & 3;
        o.am = AMap{p.zkv + (size_t)pm * 256 * 256, 256, nullptr, 256}; o.bt = p.WukvT + (size_t)pn * 256 * 256; o.K = 256;
        o.ep = EpiKV{p.Kn, p.Vt, rs, 0, pm * 256, pn * 256}; return true; } };
struct PhY { Params p; typedef EpiY EP; static constexpr int NU = 128 * 4;
    __device__ __forceinline__ bool unit(int u, Unit<EP>& o) const { const int pm = u >> 2, pn = u & 3;
        o.am = AMap{p.mix + (size_t)pm * 256 * DM, DM, nullptr, 256}; o.bt = p.WoutT + (size_t)pn * 256 * DM; o.K = DM;
        o.ep = EpiY{p.hbuf, pm * 256, pn * 256, YSTAT ? p.ystat : nullptr}; return true; } };
struct PhH { Params p; typedef EpiH EP; static constexpr int NU = 288 * 2;
    __device__ __forceinline__ bool unit(int u, Unit<EP>& o) const { int e, rt, ct, pr; if (!moe_unit(p.cnt, u, 2, e, rt, ct, pr)) return false;
        const int nv = __builtin_amdgcn_readfirstlane(min(256, p.cnt[e] - rt * 256));
        o.am = AMap{p.hbuf, DM, p.list + (size_t)e * LIST_CAP + rt * 256, nv}; o.bt = p.WguT + ((size_t)e * 512 + ct * 256) * DM; o.K = DM;
        o.ep = EpiH{p.H, pr, ct * 256, false}; return true; } };
struct PhC { Params p; typedef EpiC EP; static constexpr int NU = 288 * 4;
    __device__ __forceinline__ bool unit(int u, Unit<EP>& o) const { int e, rt, ct, pr; if (!moe_unit(p.cnt, u, 4, e, rt, ct, pr)) return false;
        const int nv = __builtin_amdgcn_readfirstlane(min(256, p.cnt[e] - rt * 256));
        o.am = AMap{p.H + (size_t)pr * FF, FF, nullptr, 256}; o.bt = p.WdT + ((size_t)e * DM + ct * 256) * FF; o.K = FF;
        o.ep = EpiC{p.contrib, p.list + (size_t)e * LIST_CAP + rt * 256, p.gates, nv, ct * 256}; return true; } };


template <int XMODE> struct EpiProbe {
    const bf16_t* hb; bf16_t* ob; int row0, col0;
    __device__ __forceinline__ void operator()(int, int, int, f32x4, f32x4) const {}
    struct Ctx { u32x2 h[4]; };
    __device__ __forceinline__ Ctx pre(int r, int c32, int fq) const { Ctx x; const bf16_t* p = hb + (size_t)(row0 + r) * DM + col0 + c32 + 4 * fq;
        if (XMODE == 1) { x.h[0] = *(const u32x2*)p; x.h[1] = *(const u32x2*)(p + 16); x.h[2] = *(const u32x2*)(p + 128); x.h[3] = *(const u32x2*)(p + 144); }
        else { x.h[0] = x.h[1] = x.h[2] = x.h[3] = (u32x2){0u, 0u}; }
        return x; }
    __device__ __forceinline__ void fin(bf16_t* p, u32x2 h, f32x4 v) const {
        v[0] += ALPHA * bflo(h.x); v[1] += ALPHA * bfhi(h.x); v[2] += ALPHA * bflo(h.y); v[3] += ALPHA * bfhi(h.y); st4(p, v); }
    __device__ __forceinline__ void post(int r, int c32, int fq, const Ctx& x, f32x4 a0, f32x4 b0, f32x4 a1, f32x4 b1) const {
        if (XMODE == 2) { asm volatile("" :: "v"(a0), "v"(b0), "v"(a1), "v"(b1)); return; }
        if (XMODE == 4) {
            bf16_t* q = ob + (size_t)(row0 + r) * DM + col0 + (c32 >> 5) * 64 + 16 * fq; u32x4 w0, w1;
            w0.x = pk2(a0[0], a0[1]); w0.y = pk2(a0[2], a0[3]); w0.z = pk2(b0[0], b0[1]); w0.w = pk2(b0[2], b0[3]);
            w1.x = pk2(a1[0], a1[1]); w1.y = pk2(a1[2], a1[3]); w1.z = pk2(b1[0], b1[1]); w1.w = pk2(b1[2], b1[3]);
            *(u32x4*)q = w0; *(u32x4*)(q + 8) = w1; return; }
        bf16_t* p = ob + (size_t)(row0 + r) * DM + col0 + c32 + 4 * fq; fin(p, x.h[0], a0); fin(p + 16, x.h[1], b0); fin(p + 128, x.h[2], a1); fin(p + 144, x.h[3], b1); }
};
template <int XMODE> struct PhYp { Params p; typedef EpiProbe<XMODE> EP; static constexpr int NU = 128 * 4;
    __device__ __forceinline__ bool unit(int u, Unit<EP>& o) const { const int pm = u >> 2, pn = u & 3;
        o.am = AMap{p.mix + (size_t)pm * 256 * DM, DM, nullptr, 256}; o.bt = p.WoutT + (size_t)pn * 256 * DM; o.K = DM;
        o.ep = EP{p.hbuf, p.contrib, pm * 256, pn * 256}; return true; } };

__device__ __forceinline__ void wtile(const float* s0, const float* s1, int ldsrc, bf16_t* dst, int K, int k0, int n0, int mode, const float* kscale, float* tile, int tid, int nthr) {
    for (int idx = tid; idx < 4096; idx += nthr) {
        const int kk = idx >> 6, n = n0 + (idx & 63);
        const float* s = s0; int col = n;
        if (mode == 1) { if (n >= 1728) col = -1; else if (n >= 1664) { const int i = (n - 1664) >> 1, pp = (n - 1664) & 1; col = 1664 + i + 32 * pp; } }
        else if (mode == 2) { const int h = n / 192, d = n - h * 192; if (d >= 128) { const int i = (d - 128) >> 1, pp = (d - 128) & 1; col = h * 192 + 128 + i + 32 * pp; } }
        else if (mode == 3) { const int G = n >> 5, r = n & 31; col = 16 * G + (r & 15); s = (r < 16) ? s0 : s1; }
        float v = 0.f;
        if (col >= 0) { v = s[(size_t)(k0 + kk) * ldsrc + col]; if (kscale) v *= kscale[k0 + kk]; }
        tile[kk * 65 + (idx & 63)] = v;
    }
    __syncthreads();
    for (int idx = tid; idx < 4096; idx += nthr) {
        const int nn = idx >> 6, kk = idx & 63;
        dst[(size_t)(n0 + nn) * K + k0 + kk] = f2bf(tile[kk * 65 + nn]);
    }
    __syncthreads();
}
constexpr int J_IN = 28 * 16, J_UQ = 12 * 6, J_UKV = 16 * 4, J_OUT = 16 * 16, J_GU = 32 * 8 * 16, J_DN = 32 * 16 * 4;
constexpr int J_TOTAL = J_IN + J_UQ + J_UKV + J_OUT + J_GU + J_DN;
__device__ __forceinline__ void prep_wjob(const Params& p, int job, float* tile, int tid, int nthr) {
    if (job < J_IN) { const int nb = job >> 4, kb = job & 15; wtile(p.w_in, nullptr, 1728, p.WinT, 1024, kb * 64, nb * 64, 1, nullptr, tile, tid, nthr); return; } job -= J_IN;
    if (job < J_UQ) { const int nb = job / 6, kb = job - nb * 6; wtile(p.w_uq, nullptr, 768, p.WuqT, 384, kb * 64, nb * 64, 0, p.qn_g, tile, tid, nthr); return; } job -= J_UQ;
    if (job < J_UKV) { const int nb = job >> 2, kb = job & 3; wtile(p.w_ukv, nullptr, 1024, p.WukvT, 256, kb * 64, nb * 64, 0, p.kvn_g, tile, tid, nthr); return; } job -= J_UKV;
    if (job < J_OUT) { const int nb = job >> 4, kb = job & 15; wtile(p.w_out, nullptr, 1024, p.WoutT, 1024, kb * 64, nb * 64, 0, nullptr, tile, tid, nthr); return; } job -= J_OUT;
    if (job < J_GU) { const int e = job >> 7, r = job & 127, nb = r >> 4, kb = r & 15;
        wtile(p.w_gate + (size_t)e * 1024 * 256, p.w_up + (size_t)e * 1024 * 256, 256, p.WguT + (size_t)e * 512 * 1024, 1024, kb * 64, nb * 64, 3, nullptr, tile, tid, nthr); return; } job -= J_GU;
    { const int e = job >> 6, r = job & 63, nb = r >> 2, kb = r & 3;
        wtile(p.w_down + (size_t)e * 256 * 1024, nullptr, 1024, p.WdT + (size_t)e * 1024 * 256, 256, kb * 64, nb * 64, 0, nullptr, tile, tid, nthr); }
}
__device__ __forceinline__ void ln0_row(const float* xr, const float* g, const float* b, bf16_t* orow, int lane) {
    f32x4 v[4]; float s = 0.f;
#pragma unroll
    for (int j = 0; j < 4; ++j) { v[j] = *(const f32x4*)(xr + 256 * j + 4 * lane); s += (v[j][0] + v[j][1]) + (v[j][2] + v[j][3]); }
    const float mean = wave_sum(s) * (1.f / 1024.f); float s2 = 0.f;
#pragma unroll
    for (int j = 0; j < 4; ++j) { v[j] = v[j] - mean; s2 += (v[j][0] * v[j][0] + v[j][1] * v[j][1]) + (v[j][2] * v[j][2] + v[j][3] * v[j][3]); }
    const float rstd = 1.f / sqrtf(wave_sum(s2) * (1.f / 1024.f) + 1e-5f);
#pragma unroll
    for (int j = 0; j < 4; ++j) { const f32x4 gg = *(const f32x4*)(g + 256 * j + 4 * lane), bb = *(const f32x4*)(b + 256 * j + 4 * lane);
        st4(orow + 256 * j + 4 * lane, v[j] * rstd * gg + bb); }
}
__device__ __forceinline__ void rope_entry(const Params& p, int idx) {
    const int t = idx >> 5, i = idx & 31;
    const float inv = powf(10000.f, -(float)(2 * i) / 64.f);
    const float ang = (float)p.pos[t] * inv;
    p.rope[idx] = make_float2(cosf(ang), sinf(ang));
}

__device__ __forceinline__ void router_token(const Params& p, int t, int lane, const float* wr  , int wstride) {
    bf16_t* hr = p.hbuf + (size_t)t * DM;
    f32x4 v[4]; float s = 0.f;
#pragma unroll
    for (int j = 0; j < 4; ++j) { const u32x2 w = *(const u32x2*)(hr + 256 * j + 4 * lane); v[j][0] = bflo(w.x); v[j][1] = bfhi(w.x); v[j][2] = bflo(w.y); v[j][3] = bfhi(w.y);
        s += (v[j][0] + v[j][1]) + (v[j][2] + v[j][3]); }
    const float mean = wave_sum(s) * (1.f / 1024.f); float s2 = 0.f;
#pragma unroll
    for (int j = 0; j < 4; ++j) { v[j] = v[j] - mean; s2 += (v[j][0] * v[j][0] + v[j][1] * v[j][1]) + (v[j][2] * v[j][2] + v[j][3] * v[j][3]); }
    const float rstd = 1.f / sqrtf(wave_sum(s2) * (1.f / 1024.f) + 1e-5f);
#pragma unroll
    for (int j = 0; j < 4; ++j) { const f32x4 gg = *(const f32x4*)(p.ln1_g + 256 * j + 4 * lane), bb = *(const f32x4*)(p.ln1_b + 256 * j + 4 * lane);
        v[j] = v[j] * rstd * gg + bb; st4(hr + 256 * j + 4 * lane, v[j]); }
    float lg[36];
#pragma unroll
    for (int o = 0; o < 36; ++o) { float a = 0.f;
#pragma unroll
        for (int j = 0; j < 4; ++j) { const f32x4 w = *(const f32x4*)(wr + o * wstride + 256 * j + 4 * lane); a += (v[j][0] * w[0] + v[j][1] * w[1]) + (v[j][2] * w[2] + v[j][3] * w[3]); }
        lg[o] = wave_sum(a); }
#pragma unroll
    for (int o = 0; o < 4; ++o) lg[o] += p.b_rg[o];
#pragma unroll
    for (int o = 0; o < 32; ++o) lg[4 + o] += p.b_re[o];
    int g = 0; float gm = lg[0];
#pragma unroll
    for (int i = 1; i < 4; ++i) if (lg[i] > gm) { gm = lg[i]; g = i; }
    float se = 0.f;
#pragma unroll
    for (int i = 0; i < 4; ++i) se += expf(lg[i] - gm);
    const float pg = 1.f / se;
    float ev[8];
#pragma unroll
    for (int e = 0; e < 8; ++e) ev[e] = g == 0 ? lg[4 + e] : g == 1 ? lg[12 + e] : g == 2 ? lg[20 + e] : lg[28 + e];
    int i1 = 0; float v1 = ev[0];
#pragma unroll
    for (int e = 1; e < 8; ++e) if (ev[e] > v1) { v1 = ev[e]; i1 = e; }
    int i2 = -1; float v2 = -3.0e38f;
#pragma unroll
    for (int e = 0; e < 8; ++e) if (e != i1 && ev[e] > v2) { v2 = ev[e]; i2 = e; }
    const float d = expf(v2 - v1), g1 = pg / (1.f + d), g2 = pg * d / (1.f + d);
    if (lane < 2) {
        const int ex = g * 8 + (lane == 0 ? i1 : i2), aid = 2 * t + lane;
        const int slot = atomicAdd(p.cnt + ex, 1);
        p.list[(size_t)ex * LIST_CAP + slot] = aid;
        p.gates[aid] = lane == 0 ? g1 : g2;
    }
}
__device__ __forceinline__ void final_token(const Params& p, int t, int lane) {
    const bf16_t* hr = p.hbuf + (size_t)t * DM; const bf16_t* c0 = p.contrib + (size_t)(2 * t) * DM; const bf16_t* c1 = c0 + DM;
    f32x4 v[4]; float s = 0.f;
#pragma unroll
    for (int j = 0; j < 4; ++j) { const int o = 256 * j + 4 * lane; const u32x2 w = *(const u32x2*)(hr + o), a = *(const u32x2*)(c0 + o), b = *(const u32x2*)(c1 + o);
        v[j][0] = ALPHA * bflo(w.x) + bflo(a.x) + bflo(b.x); v[j][1] = ALPHA * bfhi(w.x) + bfhi(a.x) + bfhi(b.x);
        v[j][2] = ALPHA * bflo(w.y) + bflo(a.y) + bflo(b.y); v[j][3] = ALPHA * bfhi(w.y) + bfhi(a.y) + bfhi(b.y);
        s += (v[j][0] + v[j][1]) + (v[j][2] + v[j][3]); }
    const float mean = wave_sum(s) * (1.f / 1024.f); float s2 = 0.f;
#pragma unroll
    for (int j = 0; j < 4; ++j) { v[j] = v[j] - mean; s2 += (v[j][0] * v[j][0] + v[j][1] * v[j][1]) + (v[j][2] * v[j][2] + v[j][3] * v[j][3]); }
    const float rstd = 1.f / sqrtf(wave_sum(s2) * (1.f / 1024.f) + 1e-5f);
#pragma unroll
    for (int j = 0; j < 4; ++j) { const int o = 256 * j + 4 * lane; const f32x4 gg = *(const f32x4*)(p.ln2_g + o), bb = *(const f32x4*)(p.ln2_b + o);
        *(f32x4*)(p.out + (size_t)t * DM + o) = v[j] * rstd * gg + bb; }
}


__device__ __forceinline__ void final_token2(const Params& p, int t0, int t1, int lane) {
    f32x4 v[2][4]; float s[2] = {0.f, 0.f}, q[2] = {0.f, 0.f};
    u32x2 w[2][4], a[2][4], b[2][4];
#pragma unroll
    for (int k = 0; k < 2; ++k) { const int t = k ? t1 : t0; const bf16_t* hr = p.hbuf + (size_t)t * DM; const bf16_t* c0 = p.contrib + (size_t)(2 * t) * DM; const bf16_t* c1 = c0 + DM;
#pragma unroll
        for (int j = 0; j < 4; ++j) { const int o = 256 * j + 4 * lane; w[k][j] = *(const u32x2*)(hr + o); a[k][j] = *(const u32x2*)(c0 + o); b[k][j] = *(const u32x2*)(c1 + o); } }
#pragma unroll
    for (int k = 0; k < 2; ++k)
#pragma unroll
        for (int j = 0; j < 4; ++j) {
            v[k][j][0] = ALPHA * bflo(w[k][j].x) + bflo(a[k][j].x) + bflo(b[k][j].x); v[k][j][1] = ALPHA * bfhi(w[k][j].x) + bfhi(a[k][j].x) + bfhi(b[k][j].x);
            v[k][j][2] = ALPHA * bflo(w[k][j].y) + bflo(a[k][j].y) + bflo(b[k][j].y); v[k][j][3] = ALPHA * bfhi(w[k][j].y) + bfhi(a[k][j].y) + bfhi(b[k][j].y);
            s[k] += (v[k][j][0] + v[k][j][1]) + (v[k][j][2] + v[k][j][3]);
            q[k] += (v[k][j][0] * v[k][j][0] + v[k][j][1] * v[k][j][1]) + (v[k][j][2] * v[k][j][2] + v[k][j][3] * v[k][j][3]); }
#pragma unroll
    for (int o2 = 1; o2 < 64; o2 <<= 1) { s[0] += shx(s[0], o2); s[1] += shx(s[1], o2); q[0] += shx(q[0], o2); q[1] += shx(q[1], o2); }
#pragma unroll
    for (int k = 0; k < 2; ++k) { const int t = k ? t1 : t0; const float mean = s[k] * (1.f / 1024.f), var = fmaxf(q[k] * (1.f / 1024.f) - mean * mean, 0.f), rstd = 1.f / sqrtf(var + 1e-5f);
#pragma unroll
        for (int j = 0; j < 4; ++j) { const int o = 256 * j + 4 * lane; const f32x4 gg = *(const f32x4*)(p.ln2_g + o), bb = *(const f32x4*)(p.ln2_b + o);
            *(f32x4*)(p.out + (size_t)t * DM + o) = (v[k][j] - mean) * rstd * gg + bb; } }
}

__global__ __launch_bounds__(256) void nk_prep_w(Params p) { __shared__ float tile[64 * 65]; prep_wjob(p, blockIdx.x, tile, threadIdx.x, 256); }
__global__ __launch_bounds__(256) void nk_ln0(Params p) { const int t = blockIdx.x * 4 + (threadIdx.x >> 6); ln0_row(p.x + (size_t)t * DM, p.ln0_g, p.ln0_b, p.hbuf + (size_t)t * DM, threadIdx.x & 63); }
__global__ __launch_bounds__(256) void nk_rope(Params p) { rope_entry(p, blockIdx.x * 256 + threadIdx.x); if (blockIdx.x == 0 && threadIdx.x < NEXP) p.cnt[threadIdx.x] = 0; }
__global__ __launch_bounds__(256) void nk_rowscale(Params p) {
    const int t = blockIdx.x * 4 + (threadIdx.x >> 6), lane = threadIdx.x & 63;
    float s = 0.f; for (int i = lane; i < 384; i += 64) { const float v = bf2f(p.zq[(size_t)t * 384 + i]); s += v * v; }
    s = wave_sum(s); float s2 = 0.f; for (int i = lane; i < 256; i += 64) { const float v = bf2f(p.zkv[(size_t)t * 256 + i]); s2 += v * v; }
    s2 = wave_sum(s2);
    if (lane == 0) { p.rsq[t] = 1.f / sqrtf(s * (1.f / 384.f) + 1e-6f); p.rskv[t] = 1.f / sqrtf(s2 * (1.f / 256.f) + 1e-6f); }
}
template <class PH> __global__ __launch_bounds__(256) void nk_gemm(PH ph) {
    Unit<typename PH::EP> u; if (!ph.unit(blockIdx.x, u)) return;
    const int wave = threadIdx.x >> 6, lane = threadIdx.x & 63, fr = lane & 15, fq = lane >> 4;
    const int task = blockIdx.y * 4 + wave, rb = task >> 3, cg = task & 7;
    const bf16_t* arow = u.am.row(rb * 16 + fr);
    const bf16_t* b0 = u.bt + (size_t)(cg * 32 + fr) * u.K; const bf16_t* b1 = b0 + (size_t)16 * u.K;
    f32x4 acc0 = {0.f, 0.f, 0.f, 0.f}, acc1 = {0.f, 0.f, 0.f, 0.f};
    for (int k = 0; k < u.K; k += 32) {
        const bf16x8 a = *(const bf16x8*)(arow + k + 8 * fq), x0 = *(const bf16x8*)(b0 + k + 8 * fq), x1 = *(const bf16x8*)(b1 + k + 8 * fq);
        acc0 = __builtin_amdgcn_mfma_f32_16x16x32_bf16(x0, a, acc0, 0, 0, 0);
        acc1 = __builtin_amdgcn_mfma_f32_16x16x32_bf16(x1, a, acc1, 0, 0, 0);
    }
    u.ep(rb * 16 + fr, cg * 32, fq, acc0, acc1);
}
__global__ __launch_bounds__(256) void nk_gmlp(Params p) {
    extern __shared__ float sm[];
    const int unit = blockIdx.x, h = unit & 3, bn = unit >> 2, row0 = bn * 128;
    const int wave = threadIdx.x >> 6, lane = threadIdx.x & 63;
    for (int j = wave; j < 128; j += 4) {
        const bf16_t* vr = p.zv + (size_t)(row0 + j) * 512 + h * 128;
        const float a = bf2f(vr[lane]), b = bf2f(vr[lane + 64]);
        const float mean = wave_sum(a + b) * (1.f / 128.f); const float da = a - mean, db = b - mean;
        const float rstd = 1.f / sqrtf(wave_sum(da * da + db * db) * (1.f / 128.f) + 1e-5f);
        sm[j * 129 + lane] = da * rstd * p.gm_g[h * 128 + lane] + p.gm_b[h * 128 + lane];
        sm[j * 129 + lane + 64] = db * rstd * p.gm_g[h * 128 + lane + 64] + p.gm_b[h * 128 + lane + 64];
    }
    __syncthreads();
    for (int idx = threadIdx.x; idx < 16384; idx += 256) {
        const int i = idx >> 7, c = idx & 127; const int jn = i < 64 ? 64 : 128;
        const float* w = p.w_sp + ((size_t)h * 128 + i) * 128; float f = p.b_sp[h * 128 + i];
        for (int j = 0; j < jn; ++j) f += w[j] * sm[j * 129 + c];
        const float u = bf2f(p.zu[(size_t)(row0 + i) * 512 + h * 128 + c]);
        p.mix[(size_t)(row0 + i) * DM + h * 128 + c] = f2bf(u * f);
    }
}
__global__ __launch_bounds__(256) void nk_attn(Params p) {
    extern __shared__ float sm[];
    float* Qs = sm; float* Ks = Qs + 64 * 192; float* Ss = Ks + 64 * 193; float* Vs = Ss + 64 * 65;
    const int qc = blockIdx.x & 31, bh = blockIdx.x >> 5, b = bh >> 2, h = bh & 3, tid = threadIdx.x, q = tid >> 2, sub = tid & 3;
    for (int idx = tid; idx < 64 * 192; idx += 256) { const int r = idx / 192, d = idx - r * 192; Qs[idx] = bf2f(p.Q[((size_t)bh * SEQ + qc * 64 + r) * 192 + d]); }
    __syncthreads();
    for (int idx = tid; idx < 64 * 32; idx += 256) { const int r = idx >> 5, i = idx & 31; const float2 cs = p.rope[((size_t)b * SEQ + qc * 64 + r) * 32 + i];
        const float x1 = Qs[r * 192 + 128 + i], x2 = Qs[r * 192 + 160 + i]; Qs[r * 192 + 128 + i] = x1 * cs.x - x2 * cs.y; Qs[r * 192 + 160 + i] = x2 * cs.x + x1 * cs.y; }
    float O[32]; float m = -INFINITY, l = 0.f;
#pragma unroll
    for (int j = 0; j < 32; ++j) O[j] = 0.f;
    for (int kt = 0; kt <= qc; ++kt) {
        __syncthreads();
        for (int idx = tid; idx < 64 * 192; idx += 256) { const int r = idx / 192, d = idx - r * 192; const int key = kt * 64 + r;
            Ks[r * 193 + d] = d < 128 ? bf2f(p.Kn[((size_t)bh * SEQ + key) * 128 + d]) : bf2f(p.krope[((size_t)b * SEQ + key) * 64 + d - 128]); }
        for (int idx = tid; idx < 64 * 128; idx += 256) { const int r = idx >> 7, dv = idx & 127; const int key = kt * 64 + r;
            Vs[r * 128 + dv] = bf2f(p.Vt[((size_t)bh * 128 + dv) * SEQ + (key & ~15) + perm16(key & 15)]); }
        __syncthreads();
        for (int kk = 0; kk < 16; ++kk) { const int key = sub * 16 + kk; float s = 0.f;
            for (int d = 0; d < 192; ++d) s += Qs[q * 192 + d] * Ks[key * 193 + d];
            Ss[q * 65 + key] = s; }
        __syncthreads();
        float mt = -INFINITY; for (int k = 0; k < 64; ++k) mt = fmaxf(mt, Ss[q * 65 + k]);
        const float mn = fmaxf(m, mt), alpha = exp2f(m - mn); m = mn; l *= alpha;
#pragma unroll
        for (int j = 0; j < 32; ++j) O[j] *= alpha;
        for (int k = 0; k < 64; ++k) { const float pk = exp2f(Ss[q * 65 + k] - mn); l += pk;
#pragma unroll
            for (int j = 0; j < 32; ++j) O[j] += pk * Vs[k * 128 + sub * 32 + j]; }
    }
    const float inv = 1.f / l; bf16_t* o = p.mix + ((size_t)b * SEQ + qc * 64 + q) * DM + 512 + h * 128 + sub * 32;
#pragma unroll
    for (int j = 0; j < 32; ++j) o[j] = f2bf(O[j] * inv);
}
__global__ __launch_bounds__(256) void nk_router(Params p) {
    const int t = blockIdx.x * 4 + (threadIdx.x >> 6);
    router_token(p, t, threadIdx.x & 63, (const float*)p.H, 1024);
}
__global__ __launch_bounds__(256) void nk_router_prep(Params p) {
    const int idx = blockIdx.x * 256 + threadIdx.x; if (idx >= 36 * 1024) return;
    const int o = idx >> 10, k = idx & 1023;
    ((float*)p.H)[idx] = o < 4 ? p.w_rg[k * 4 + o] : p.w_re[k * 32 + (o - 4)];
}
__global__ __launch_bounds__(256) void nk_final(Params p) { final_token(p, blockIdx.x * 4 + (threadIdx.x >> 6), threadIdx.x & 63); }

constexpr int LDS_BYTES = 152 * 1024, LDS_RS = 150 * 1024, LDS_XB = 151 * 1024;
constexpr int LDS_PRE = 128 * 1024, LDS_TOT = 144 * 1024, LDS_SEG = LDS_TOT + 256, LDS_AID = LDS_SEG + 2048;
constexpr int LDS_RW = 0, LDS_LCNT = 144 * 1024 + 512;
constexpr int NTHR = 512;

#ifndef EARLY_WB
#define EARLY_WB 0
#endif
#define XB_TMO      128
#define XB_XCNT(j)  (256  + 64 * (j))
#define XB_XSUB(j)  (1280 + 64 * (j))
#define XB_XGEN(j)  (2304 + 64 * (j))
#define XB_TOP      3328
#define XB_TOPGEN   3392
#define XCD_BAR_WORDS 3456
#define XB_SPIN_CAP (1u << 20)
__device__ __forceinline__ unsigned xb_ld(unsigned* p) { return __hip_atomic_load(p, __ATOMIC_RELAXED, __HIP_MEMORY_SCOPE_AGENT); }
__device__ __forceinline__ unsigned xb_add(unsigned* p, unsigned v) { return __hip_atomic_fetch_add(p, v, __ATOMIC_RELAXED, __HIP_MEMORY_SCOPE_AGENT); }
__device__ __forceinline__ unsigned xb_xcc_id() { return (unsigned)__builtin_amdgcn_s_getreg((3 << 11) | 20) & 0xFu; }
#define XB_SPIN(cond, bar) do { unsigned _sp = 0; while (cond) { __builtin_amdgcn_s_sleep(1); \
    if ((++_sp & 255u) == 0u) { if (xb_ld(&(bar)[XB_TMO])) break; if (_sp > XB_SPIN_CAP) { atomicAdd(&(bar)[XB_TMO], 1u); break; } } } } while (0)
struct XcdBarrier { unsigned* bar; unsigned x; volatile LAS unsigned* st; };
__device__ __forceinline__ XcdBarrier xcd_barrier_post(unsigned* bar, volatile LAS unsigned* st) {
    XcdBarrier b; b.bar = bar; b.x = xb_xcc_id(); b.st = st;
    if (threadIdx.x == 0) (void)xb_add(&bar[XB_XCNT(b.x)], 1u);
    return b;
}
__device__ __forceinline__ void xcd_barrier_complete(unsigned* bar, unsigned x, unsigned& nloc, unsigned& nx) {
    const unsigned G = gridDim.x * gridDim.y * gridDim.z;
    unsigned sum, cnt, mine, sp = 0u;
    for (;;) {
        sum = 0u; cnt = 0u; mine = 0u;
#pragma unroll
        for (unsigned j = 0; j < 16; ++j) { const unsigned c = xb_ld(&bar[XB_XCNT(j)]); sum += c; cnt += (c > 0u) ? 1u : 0u; mine = (j == x) ? c : mine; }
        if (sum == G) break;
        __builtin_amdgcn_s_sleep(1);
        if ((++sp & 255u) == 0u) { if (xb_ld(&bar[XB_TMO])) break; if (sp > XB_SPIN_CAP) { atomicAdd(&bar[XB_TMO], 1u); break; } }
    }
    nloc = mine > 0u ? mine : 1u; nx = cnt > 0u ? cnt : 1u;
}
__device__ __forceinline__ void xcd_barrier(const XcdBarrier& b) {
    asm volatile("s_waitcnt vmcnt(0)" ::: "memory");
    __syncthreads();
    if (threadIdx.x == 0) {
        unsigned* bar = b.bar;
        __builtin_amdgcn_s_waitcnt(0);
        unsigned nloc = b.st[0], nx = b.st[1];
        if (nloc == 0u) { xcd_barrier_complete(bar, b.x, nloc, nx); b.st[0] = nloc; b.st[1] = nx; }
#if EARLY_WB
        __builtin_amdgcn_fence(__ATOMIC_RELEASE, "agent"); asm volatile("s_waitcnt vmcnt(0)" ::: "memory");
#endif
        const unsigned old = xb_add(&bar[XB_XSUB(b.x)], 1u);
        const unsigned gen = old / nloc;
        if (old + 1u == (gen + 1u) * nloc) {
            __builtin_amdgcn_fence(__ATOMIC_RELEASE, "agent");
            asm volatile("s_waitcnt vmcnt(0)" ::: "memory");
            const unsigned og = xb_add(&bar[XB_TOP], 1u);
            const unsigned tg = og / nx;
            if (og + 1u == (tg + 1u) * nx) xb_add(&bar[XB_TOPGEN], 1u);
            else XB_SPIN(xb_ld(&bar[XB_TOPGEN]) == tg, bar);
            __builtin_amdgcn_fence(__ATOMIC_ACQUIRE, "agent");
            xb_add(&bar[XB_XGEN(b.x)], 1u);
            asm volatile("s_waitcnt vmcnt(0)" ::: "memory");
        } else {
            XB_SPIN(xb_ld(&bar[XB_XGEN(b.x)]) == gen, bar);
            __builtin_amdgcn_fence(__ATOMIC_ACQUIRE, "agent");
            asm volatile("s_waitcnt vmcnt(0)" ::: "memory");
        }
    }
    __syncthreads();
}

constexpr int BK = 64, HALF = 128, HT = HALF * BK;
__device__ __forceinline__ int lds_byte(int r, int c) { const int st = (r >> 4) * 2 + (c >> 5), rr = r & 15, cc = c & 31, ob = rr * 64 + cc * 2; return st * 1024 + (ob ^ (((ob >> 9) & 1) << 5)); }
__device__ __forceinline__ void stage_rc(int b, int& R, int& C) { const int st = b / 1024, sb = b % 1024, swz = sb ^ (((sb >> 9) & 1) << 5); R = (st >> 1) * 16 + swz / 64; C = (st & 1) * 32 + (swz % 64) / 2; }

template <class PH> struct HasNext { template <class T> static char test(decltype(&T::next)); template <class T> static long test(...); static constexpr bool value = sizeof(test<PH>(nullptr)) == 1; };
template <class PH> struct HasDone { template <class T> static char test(decltype(&T::done)); template <class T> static long test(...); static constexpr bool value = sizeof(test<PH>(nullptr)) == 1; };
template <class EP> struct HasPre2 { template <class T> static char test(decltype(&T::pre2)); template <class T> static long test(...); static constexpr bool value = sizeof(test<EP>(nullptr)) == 1; };
template <class EP> struct IsBatch4 { template <class T> static char test(decltype(&T::BATCH4)); template <class T> static long test(...); static constexpr bool value = sizeof(test<EP>(nullptr)) == 1; };
template <class EP> __device__ __forceinline__ void run_epilogue(const EP& ep, const f32x4 (&acc)[2][2][4][2], int wr, int wc, int fr, int fq) {
    int rb = wr * 64 + fr, fq_ = fq; asm volatile("" : "+v"(rb), "+v"(fq_));
    if constexpr (IsBatch4<EP>::value) {
#pragma unroll
        for (int ai = 0; ai < 2; ++ai) {
            typename EP::Ctx cx[4];
#pragma unroll
            for (int m = 0; m < 4; ++m) cx[m] = ep.pre(ai * HALF + m * 16 + rb, wc * 32, fq_);
            if constexpr (HasPre2<EP>::value) {
#pragma unroll
                for (int m = 0; m < 4; ++m) ep.pre2(cx[m]);
            }
#pragma unroll
            for (int m = 0; m < 4; ++m) ep.post(ai * HALF + m * 16 + rb, wc * 32, fq_, cx[m], acc[ai][0][m][0], acc[ai][0][m][1], acc[ai][1][m][0], acc[ai][1][m][1]);
        }
    } else {
        typename EP::Ctx cx[8];
#pragma unroll
        for (int i = 0; i < 8; ++i) cx[i] = ep.pre((i >> 2) * HALF + (i & 3) * 16 + rb, wc * 32, fq_);
        if constexpr (HasPre2<EP>::value) {
#pragma unroll
            for (int i = 0; i < 8; ++i) ep.pre2(cx[i]);
        }
#pragma unroll
        for (int i = 0; i < 8; ++i) ep.post((i >> 2) * HALF + (i & 3) * 16 + rb, wc * 32, fq_, cx[i], acc[i >> 2][0][i & 3][0], acc[i >> 2][0][i & 3][1], acc[i >> 2][1][i & 3][0], acc[i >> 2][1][i & 3][1]);
    }
}
struct GmArgs { const float *gm_g, *gm_b, *w_sp, *b_sp; bf16_t* mix; int row0, h; };
__device__ __forceinline__ void gmlp_epilogue(f32x4 (&acc)[2][2][4][2], const GmArgs& g, char* lds, int wr, int wc, int fr, int fq) {
    typedef float f32x2 __attribute__((ext_vector_type(2)));
    f32x2* P = (f32x2*)lds;
    char* vT = lds + 8192;
#pragma unroll
    for (int ai = 0; ai < 2; ++ai)
#pragma unroll
        for (int bj = 0; bj < 2; ++bj)
#pragma unroll
            for (int m = 0; m < 4; ++m)
#pragma unroll
                for (int n = 0; n < 2; ++n)
#pragma unroll
                    for (int t = 0; t < 4; ++t) acc[ai][bj][m][n][t] = gelu_tanh(acc[ai][bj][m][n][t]);
#pragma unroll
    for (int ai = 0; ai < 2; ++ai)
#pragma unroll
        for (int m = 0; m < 4; ++m) { float s = 0.f, q = 0.f;
#pragma unroll
            for (int n = 0; n < 2; ++n)
#pragma unroll
                for (int t = 0; t < 4; ++t) { const float x = acc[ai][1][m][n][t]; s += x; q += x * x; }
            s += shx(s, 16); s += shx(s, 32); q += shx(q, 16); q += shx(q, 32);
            if (fq == 0) P[(ai * 128 + wr * 64 + m * 16 + fr) * 4 + wc] = (f32x2){s, q}; }
    __syncthreads();
    const int c0 = wc * 32 + 4 * fq;
    f32x4 gg[2], bb[2];
#pragma unroll
    for (int n = 0; n < 2; ++n) { gg[n] = *(const f32x4*)(g.gm_g + g.h * 128 + c0 + 16 * n); bb[n] = *(const f32x4*)(g.gm_b + g.h * 128 + c0 + 16 * n); }
#pragma unroll
    for (int ai = 0; ai < 2; ++ai)
#pragma unroll
        for (int m = 0; m < 4; ++m) { const int row = ai * 128 + wr * 64 + m * 16 + fr, j = wr * 64 + m * 16 + fr;
            const f32x2 p0 = P[row * 4 + 0], p1 = P[row * 4 + 1], p2 = P[row * 4 + 2], p3 = P[row * 4 + 3];
            const float mean = ((p0.x + p1.x) + (p2.x + p3.x)) * (1.f / 128.f), var = fmaxf(((p0.y + p1.y) + (p2.y + p3.y)) * (1.f / 128.f) - mean * mean, 0.f), rstd = 1.f / sqrtf(var + 1e-5f);
#pragma unroll
            for (int n = 0; n < 2; ++n)
#pragma unroll
                for (int t = 0; t < 4; ++t) *(bf16_t*)(vT + ai * (128 * 272) + (c0 + 16 * n + t) * 272 + j * 2) = f2bf((acc[ai][1][m][n][t] - mean) * rstd * gg[n][t] + bb[n][t]); }
    __syncthreads();
    const int nks = (wr == 0) ? 2 : 4;
#pragma unroll
    for (int m = 0; m < 4; ++m) {
        const int i = wr * 64 + m * 16 + fr;
        bf16x8 wf[4];
#pragma unroll
        for (int ks = 0; ks < 4; ++ks) { u32x4 pk = {0u, 0u, 0u, 0u};
            if (ks < nks) { const float* w = g.w_sp + ((size_t)g.h * 128 + i) * 128 + 32 * ks + 8 * fq; const f32x4 w0 = *(const f32x4*)w, w1 = *(const f32x4*)(w + 4);
                pk.x = pk2(w0[0], w0[1]); pk.y = pk2(w0[2], w0[3]); pk.z = pk2(w1[0], w1[1]); pk.w = pk2(w1[2], w1[3]); }
            wf[ks] = __builtin_bit_cast(bf16x8, pk); }
        const float bias = g.b_sp[g.h * 128 + i];
#pragma unroll
        for (int ai = 0; ai < 2; ++ai)
#pragma unroll
            for (int n = 0; n < 2; ++n) { f32x4 f = {0.f, 0.f, 0.f, 0.f};
#pragma unroll
                for (int ks = 0; ks < 4; ++ks) if (ks < nks) { const bf16x8 a = *(const bf16x8*)(vT + ai * (128 * 272) + (wc * 32 + n * 16 + fr) * 272 + (32 * ks + 8 * fq) * 2);
                    f = __builtin_amdgcn_mfma_f32_16x16x32_bf16(a, wf[ks], f, 0, 0, 0); }
                const f32x4 uu = acc[ai][0][m][n]; f32x4 o; o[0] = uu[0] * (f[0] + bias); o[1] = uu[1] * (f[1] + bias); o[2] = uu[2] * (f[2] + bias); o[3] = uu[3] * (f[3] + bias);
                st4(g.mix + (size_t)(g.row0 + ai * 128 + i) * DM + g.h * 128 + wc * 32 + n * 16 + 4 * fq, o); } }
}
struct KvArgs { bf16_t* zkv; float* tab; int row0; };
__device__ __forceinline__ void kvlat_epilogue(const f32x4 (&acc)[2][2][4][2], const KvArgs& g, char* lds, int wr, int wc, int fr, int fq) {
    float* P = (float*)lds;
#pragma unroll
    for (int ai = 0; ai < 2; ++ai)
#pragma unroll
        for (int m = 0; m < 4; ++m) { float q = 0.f; const int row = ai * 128 + wr * 64 + m * 16 + fr;
#pragma unroll
            for (int bj = 0; bj < 2; ++bj)
#pragma unroll
                for (int n = 0; n < 2; ++n) { const f32x4 x = acc[ai][bj][m][n]; q += (x[0] * x[0] + x[1] * x[1]) + (x[2] * x[2] + x[3] * x[3]);
                    st4(g.zkv + (size_t)(g.row0 + row) * 256 + bj * 128 + wc * 32 + n * 16 + 4 * fq, x); }
            q += shx(q, 16); q += shx(q, 32);
            if (fq == 0) P[row * 4 + wc] = q; }
    __syncthreads();
    if (threadIdx.x < 256) { const f32x4 s = *(const f32x4*)(P + threadIdx.x * 4); g.tab[threadIdx.x] = 1.f / sqrtf(((s[0] + s[1]) + (s[2] + s[3])) * (1.f / 256.f) + 1e-6f); }
    asm volatile("s_waitcnt vmcnt(0)" ::: "memory");
}
template <class EP, int EK = 0>
__device__ __forceinline__ void gemm256(const Unit<EP>& u, LAS unsigned char* lds, const GmArgs* gm = nullptr, const KvArgs* kv = nullptr) {
    int tid = threadIdx.x; asm volatile("" : "+v"(tid));
    const int K = u.K, nt = K / BK;
    const int wid = __builtin_amdgcn_readfirstlane(tid >> 6), lane = tid & 63, wr = wid >> 2, wc = wid & 3, fr = lane & 15, fq = lane >> 4;
    unsigned voffA[2][2], voffB[2];
    const char* gA = (const char*)u.am.base; const char* gB = (const char*)u.bt;
#pragma unroll
    for (int i = 0; i < 2; ++i) { int R, C; stage_rc(tid * 16 + i * 8192, R, C);
        voffB[i] = (unsigned)(R * K + C) * 2u;
        if (u.am.list) { const int a0 = u.am.list[R < u.am.nvalid ? R : 0], a1 = u.am.list[R + HALF < u.am.nvalid ? R + HALF : 0];
            voffA[0][i] = ((unsigned)(a0 >> 1) * (unsigned)u.am.ld + (unsigned)C) * 2u; voffA[1][i] = ((unsigned)(a1 >> 1) * (unsigned)u.am.ld + (unsigned)C) * 2u; }
        else { voffA[0][i] = (unsigned)(R * u.am.ld + C) * 2u; voffA[1][i] = (unsigned)((R + HALF) * u.am.ld + C) * 2u; } }
    const size_t hstepB = (size_t)HALF * K * 2;
    const unsigned ldsw = (unsigned)wid * 1024u;
    const int aoff = lds_byte(wr * 64 + fr, fq * 8), boff = lds_byte(wc * 32 + fr, fq * 8);
    #define SA(b,h) (((b)*2+(h))*HT*2)
    #define SB(b,h) ((4+(b)*2+(h))*HT*2)
    #define STAGE_A(bufoff,h,kt) do{ _Pragma("unroll") for(int _i=0;_i<2;++_i) { asm volatile("" : "+v"(voffA[h][_i])); \
        __builtin_amdgcn_global_load_lds((const unsigned*)(gA+(size_t)(kt)*(BK*2)+voffA[h][_i]),(LAS unsigned*)(lds+(bufoff)+ldsw+_i*8192),16,0,0);} }while(0)
    #define STAGE_B(bufoff,h,kt) do{ _Pragma("unroll") for(int _i=0;_i<2;++_i) { asm volatile("" : "+v"(voffB[_i])); \
        __builtin_amdgcn_global_load_lds((const unsigned*)(gB+(size_t)(h)*hstepB+(size_t)(kt)*(BK*2)+voffB[_i]),(LAS unsigned*)(lds+(bufoff)+ldsw+_i*8192),16,0,0);} }while(0)
    #define LDA(dst,b,h) _Pragma("unroll") for(int m=0;m<4;++m) _Pragma("unroll") for(int k=0;k<2;++k) \
        dst[m][k]=*(const LAS bf16x8*)(lds+SA(b,h)+aoff+m*2048+k*1024)
    #define LDB(dst,b,h) _Pragma("unroll") for(int n=0;n<2;++n) _Pragma("unroll") for(int k=0;k<2;++k) \
        dst[n][k]=*(const LAS bf16x8*)(lds+SB(b,h)+boff+n*2048+k*1024)
    #define MMA(ai,bj,At_,Bt_) do{__builtin_amdgcn_s_setprio(1); \
        _Pragma("unroll") for(int m=0;m<4;++m) _Pragma("unroll") for(int n=0;n<2;++n) _Pragma("unroll") for(int k=0;k<2;++k) \
          acc[ai][bj][m][n]=__builtin_amdgcn_mfma_f32_16x16x32_bf16(Bt_[n][k],At_[m][k],acc[ai][bj][m][n],0,0,0); \
        __builtin_amdgcn_s_setprio(0);}while(0)
    #define WAIT_V(n) asm volatile("s_waitcnt vmcnt(" #n ")":::"memory")
    #define WAIT_L(n) asm volatile("s_waitcnt lgkmcnt(" #n ")":::"memory")
    #define BAR __builtin_amdgcn_s_barrier()
    #define SCHED __builtin_amdgcn_sched_barrier(0)

    f32x4 acc[2][2][4][2];
#pragma unroll
    for (int a = 0; a < 2; ++a)
#pragma unroll
        for (int b = 0; b < 2; ++b)
#pragma unroll
            for (int m = 0; m < 4; ++m)
#pragma unroll
                for (int n = 0; n < 2; ++n) acc[a][b][m][n] = (f32x4){0.f, 0.f, 0.f, 0.f};
    bf16x8 At[4][2], B0[2][2], B1[2][2];
    STAGE_B(SB(0,0),0,0); STAGE_A(SA(0,0),0,0);
    STAGE_B(SB(0,1),1,0); STAGE_A(SA(0,1),1,0);
    if (wr == 1) BAR;
    WAIT_V(4); BAR;
    STAGE_B(SB(1,0),0,1); STAGE_A(SA(1,0),0,1); STAGE_B(SB(1,1),1,1);
    WAIT_V(6); BAR;
    for (int t = 0; t < nt - 2; t += 2) {
        LDB(B0,0,0); SCHED; LDA(At,0,0); STAGE_A(SA(1,1),1,t+1);
        WAIT_L(8); BAR; WAIT_L(0); MMA(0,0,At,B0); BAR; SCHED;
        LDB(B1,0,1); STAGE_B(SB(0,0),0,t+2);
        BAR; WAIT_L(0); MMA(0,1,At,B1); BAR;
        LDA(At,0,1); STAGE_A(SA(0,0),0,t+2);
        BAR; WAIT_L(0); MMA(1,0,At,B0); BAR; SCHED;
        STAGE_B(SB(0,1),1,t+2);
        WAIT_V(6); BAR; MMA(1,1,At,B1); BAR;
        LDB(B0,1,0); SCHED; LDA(At,1,0); STAGE_A(SA(0,1),1,t+2);
        WAIT_L(8); BAR; WAIT_L(0); MMA(0,0,At,B0); BAR; SCHED;
        LDB(B1,1,1); STAGE_B(SB(1,0),0,t+3);
        BAR; WAIT_L(0); MMA(0,1,At,B1); BAR;
        LDA(At,1,1); STAGE_A(SA(1,0),0,t+3);
        BAR; WAIT_L(0); MMA(1,0,At,B0); BAR; SCHED;
        STAGE_B(SB(1,1),1,t+3);
        WAIT_V(6); BAR; MMA(1,1,At,B1); BAR;
    }
    { LDB(B0,0,0); LDA(At,0,0); STAGE_A(SA(1,1),1,nt-1);
      BAR; WAIT_L(0); MMA(0,0,At,B0); BAR;
      LDB(B1,0,1); BAR; WAIT_L(0); MMA(0,1,At,B1); BAR;
      LDA(At,0,1); WAIT_V(4); BAR; WAIT_L(0); MMA(1,0,At,B0); MMA(1,1,At,B1); BAR; }
    { LDB(B0,1,0); LDA(At,1,0); WAIT_V(2); BAR; WAIT_L(0); MMA(0,0,At,B0); BAR;
      LDB(B1,1,1); WAIT_V(0); BAR; WAIT_L(0); MMA(0,1,At,B1); BAR;
      LDA(At,1,1); BAR; WAIT_L(0); MMA(1,0,At,B0); MMA(1,1,At,B1); BAR; }
    if (wr == 0) BAR;
    if constexpr (EK == 1) { __syncthreads(); gmlp_epilogue(acc, *gm, (char*)lds, wr, wc, fr, fq); } else if constexpr (EK == 2) { __syncthreads(); kvlat_epilogue(acc, *kv, (char*)lds, wr, wc, fr, fq); } else run_epilogue(u.ep, acc, wr, wc, fr, fq);
    __syncthreads();
    #undef SA
    #undef SB
    #undef STAGE_A
    #undef STAGE_B
    #undef LDA
    #undef LDB
    #undef MMA
}


template <class PH>
__device__ __forceinline__ void gemm_stream(const PH& ph, LAS unsigned char* lds, int u0, int ustride) {
    typedef Unit<typename PH::EP> U;
    int tid = threadIdx.x; asm volatile("" : "+v"(tid));
    const int wid = __builtin_amdgcn_readfirstlane(tid >> 6), lane = tid & 63, wr = wid >> 2, wc = wid & 3, fr = lane & 15, fq = lane >> 4;
    int u = u0;
    U cu; if (u >= PH::NU || !ph.unit(u, cu)) return;
    const int K = cu.K, nt = K / BK;
    int R0, C0, R1, C1; stage_rc(tid * 16, R0, C0); stage_rc(tid * 16 + 8192, R1, C1);
    unsigned voffB0 = (unsigned)(R0 * K + C0) * 2u, voffB1 = (unsigned)(R1 * K + C1) * 2u;
    #define VOFFA(am, o00, o01, o10, o11) do { \
        if ((am).list) { const int n_ = (am).nvalid; const int a00 = (am).list[R0 < n_ ? R0 : 0], a01 = (am).list[R1 < n_ ? R1 : 0], a10 = (am).list[R0 + HALF < n_ ? R0 + HALF : 0], a11 = (am).list[R1 + HALF < n_ ? R1 + HALF : 0]; \
            o00 = ((unsigned)(a00 >> 1) * (unsigned)(am).ld + (unsigned)C0) * 2u; o01 = ((unsigned)(a01 >> 1) * (unsigned)(am).ld + (unsigned)C1) * 2u; \
            o10 = ((unsigned)(a10 >> 1) * (unsigned)(am).ld + (unsigned)C0) * 2u; o11 = ((unsigned)(a11 >> 1) * (unsigned)(am).ld + (unsigned)C1) * 2u; } \
        else { o00 = (unsigned)(R0 * (am).ld + C0) * 2u; o01 = (unsigned)(R1 * (am).ld + C1) * 2u; o10 = (unsigned)((R0 + HALF) * (am).ld + C0) * 2u; o11 = (unsigned)((R1 + HALF) * (am).ld + C1) * 2u; } } while (0)
    unsigned va00, va01, va10, va11; VOFFA(cu.am, va00, va01, va10, va11);
    const char* cA = (const char*)cu.am.base; const char* cB = (const char*)cu.bt;
    const size_t hstepB = (size_t)HALF * K * 2, kstep = BK * 2;
    const unsigned ldsw = (unsigned)wid * 1024u;
    const int aoff = lds_byte(wr * 64 + fr, fq * 8), boff = lds_byte(wc * 32 + fr, fq * 8);
    #define SA(b,h) (((b)*2+(h))*HT*2)
    #define SB(b,h) ((4+(b)*2+(h))*HT*2)
    #define STG(bufoff, gbase, o0, o1) do { asm volatile("" : "+v"(o0)); asm volatile("" : "+v"(o1)); \
        __builtin_amdgcn_global_load_lds((const unsigned*)((gbase) + (o0)), (LAS unsigned*)(lds + (bufoff) + ldsw), 16, 0, 0); \
        __builtin_amdgcn_global_load_lds((const unsigned*)((gbase) + (o1)), (LAS unsigned*)(lds + (bufoff) + ldsw + 8192), 16, 0, 0); } while (0)
    #define LDA(dst,b,h) _Pragma("unroll") for(int m=0;m<4;++m) _Pragma("unroll") for(int k=0;k<2;++k) \
        dst[m][k]=*(const LAS bf16x8*)(lds+SA(b,h)+aoff+m*2048+k*1024)
    #define LDB(dst,b,h) _Pragma("unroll") for(int n=0;n<2;++n) _Pragma("unroll") for(int k=0;k<2;++k) \
        dst[n][k]=*(const LAS bf16x8*)(lds+SB(b,h)+boff+n*2048+k*1024)
    #define MMA(ai,bj,At_,Bt_) do{__builtin_amdgcn_s_setprio(1); \
        _Pragma("unroll") for(int m=0;m<4;++m) _Pragma("unroll") for(int n=0;n<2;++n) _Pragma("unroll") for(int k=0;k<2;++k) \
          acc[ai][bj][m][n]=__builtin_amdgcn_mfma_f32_16x16x32_bf16(Bt_[n][k],At_[m][k],acc[ai][bj][m][n],0,0,0); \
        __builtin_amdgcn_s_setprio(0);}while(0)
    f32x4 acc[2][2][4][2];
    #define ZERO_ACC _Pragma("unroll") for (int a = 0; a < 2; ++a) _Pragma("unroll") for (int b = 0; b < 2; ++b) _Pragma("unroll") for (int m = 0; m < 4; ++m) _Pragma("unroll") for (int n = 0; n < 2; ++n) acc[a][b][m][n] = (f32x4){0.f, 0.f, 0.f, 0.f}
    bf16x8 At[4][2], B0[2][2], B1[2][2];
#ifndef SP2
#define SP2 0
#endif
#if SP2
    STG(SB(0,0), cB, voffB0, voffB1); STG(SB(0,1), cB + hstepB, voffB0, voffB1); STG(SA(0,0), cA, va00, va01); STG(SA(0,1), cA, va10, va11);
    if (wr == 1) BAR;
    WAIT_V(2); BAR;
#else
    STG(SB(0,0), cB, voffB0, voffB1); STG(SA(0,0), cA, va00, va01); STG(SB(0,1), cB + hstepB, voffB0, voffB1); STG(SA(0,1), cA, va10, va11);
    if (wr == 1) BAR;
    WAIT_V(4); BAR;
#endif
    STG(SB(1,0), cB + kstep, voffB0, voffB1); STG(SA(1,0), cA + kstep, va00, va01); STG(SB(1,1), cB + hstepB + kstep, voffB0, voffB1);
    WAIT_V(6); BAR;
    for (;;) {
        U nx; int un; if constexpr (HasNext<PH>::value) un = ph.next(wr); else un = u + ustride;
        const bool has_next = (un < PH::NU) && ph.unit(un, nx);
        unsigned na00 = va00, na01 = va01, na10 = va10, na11 = va11; const char* nA = cA; const char* nB = cB;
        if (has_next) { VOFFA(nx.am, na00, na01, na10, na11); nA = (const char*)nx.am.base; nB = (const char*)nx.bt; }
        ZERO_ACC;
#if SP2
        #define KBODY(a1_, a2_, b2_, X00, X01, X10, X11) do { \
            const char* a3_ = (a2_) + kstep; const char* b3_ = (b2_) + kstep; \
            LDB(B0,0,0); LDB(B1,0,1); SCHED; LDA(At,0,0); STG(SA(1,1), a1_, va10, va11); \
            WAIT_V(8); WAIT_L(0); BAR; MMA(0,0,At,B0); MMA(0,1,At,B1); BAR; SCHED; \
            LDA(At,0,1); STG(SB(0,0), b2_, voffB0, voffB1); STG(SB(0,1), (b2_) + hstepB, voffB0, voffB1); STG(SA(0,0), a2_, X00, X01); \
            WAIT_V(8); WAIT_L(0); BAR; MMA(1,0,At,B0); MMA(1,1,At,B1); BAR; SCHED; \
            LDB(B0,1,0); LDB(B1,1,1); SCHED; LDA(At,1,0); STG(SA(0,1), a2_, X10, X11); \
            WAIT_V(8); WAIT_L(0); BAR; MMA(0,0,At,B0); MMA(0,1,At,B1); BAR; SCHED; \
            LDA(At,1,1); STG(SB(1,0), b3_, voffB0, voffB1); STG(SB(1,1), (b3_) + hstepB, voffB0, voffB1); STG(SA(1,0), a3_, X00, X01); \
            WAIT_V(8); WAIT_L(0); BAR; MMA(1,0,At,B0); MMA(1,1,At,B1); BAR; SCHED; } while (0)
#else
        #define KBODY(a1_, a2_, b2_, X00, X01, X10, X11) do { \
            const char* a3_ = (a2_) + kstep; const char* b3_ = (b2_) + kstep; \
            LDB(B0,0,0); SCHED; LDA(At,0,0); STG(SA(1,1), a1_, va10, va11); \
            WAIT_L(8); BAR; WAIT_L(0); MMA(0,0,At,B0); BAR; SCHED; \
            LDB(B1,0,1); STG(SB(0,0), b2_, voffB0, voffB1); \
            BAR; WAIT_L(0); MMA(0,1,At,B1); BAR; \
            LDA(At,0,1); STG(SA(0,0), a2_, X00, X01); \
            BAR; WAIT_L(0); MMA(1,0,At,B0); BAR; SCHED; \
            STG(SB(0,1), (b2_) + hstepB, voffB0, voffB1); \
            WAIT_V(6); BAR; MMA(1,1,At,B1); BAR; \
            LDB(B0,1,0); SCHED; LDA(At,1,0); STG(SA(0,1), a2_, X10, X11); \
            WAIT_L(8); BAR; WAIT_L(0); MMA(0,0,At,B0); BAR; SCHED; \
            LDB(B1,1,1); STG(SB(1,0), b3_, voffB0, voffB1); \
            BAR; WAIT_L(0); MMA(0,1,At,B1); BAR; \
            LDA(At,1,1); STG(SA(1,0), a3_, X00, X01); \
            BAR; WAIT_L(0); MMA(1,0,At,B0); BAR; SCHED; \
            STG(SB(1,1), (b3_) + hstepB, voffB0, voffB1); \
            WAIT_V(6); BAR; MMA(1,1,At,B1); BAR; } while (0)
#endif
#ifndef KREP
#define KREP 1
#endif
        for (int t = 0; t < nt * KREP - 2; t += 2) { const int t1 = (KREP > 1) ? (t + 1) % nt : t + 1, t2 = (KREP > 1) ? (t + 2) % nt : t + 2;
            const char* a1 = cA + (size_t)t1 * kstep; const char* a2 = cA + (size_t)t2 * kstep; const char* b2 = cB + (size_t)t2 * kstep;
            KBODY(a1, a2, b2, va00, va01, va10, va11); }
        { const char* a1 = cA + (size_t)(nt - 1) * kstep; KBODY(a1, nA, nB, na00, na01, na10, na11); }
        if (KREP > 1) {
#pragma unroll
            for (int a = 0; a < 2; ++a)
#pragma unroll
                for (int b = 0; b < 2; ++b)
#pragma unroll
                    for (int m = 0; m < 4; ++m)
#pragma unroll
                        for (int n = 0; n < 2; ++n) acc[a][b][m][n] = acc[a][b][m][n] * (1.0f / KREP); }
        #undef KBODY
        run_epilogue(cu.ep, acc, wr, wc, fr, fq);
        if constexpr (HasDone<PH>::value) ph.done(cu, wr);
        if (!has_next) break;
        cu = nx; va00 = na00; va01 = na01; va10 = na10; va11 = na11; cA = nA; cB = nB; u = un;
    }
    WAIT_V(0);
    if (wr == 0) BAR;
    BAR;
    __syncthreads();
    #undef SA
    #undef SB
    #undef STG
    #undef LDA
    #undef LDB
    #undef MMA
    #undef ZERO_ACC
    #undef VOFFA
}

__device__ __forceinline__ void witem(const float* s0, const float* s1, int ldsrc, bf16_t* dst, int K, int k0, int n0, int mode, const float* kscale, float* scr, int lane) {
    const int n = n0 + (lane & 31);
    const float* s = s0; int col = n;
    if (mode == 1) { if (n >= 1728) col = -1; else if (n >= 1664) { const int i = (n - 1664) >> 1, pp = (n - 1664) & 1; col = 1664 + i + 32 * pp; }
        else if (GMLP_FUSED && n < 1024) { const int t = n >> 8, w = n & 255; col = w < 128 ? t * 128 + w : 512 + t * 128 + (w - 128); }
        else if (ZLAYOUT2 && n >= 1024) { col = n < 1280 ? 1408 + (n - 1024) : n < 1536 ? 1024 + (n - 1280) : 1280 + (n - 1536); } }
    else if (mode == 2) { const int h = n / 192, d = n - h * 192; if (d >= 128) { const int i = (d - 128) >> 1, pp = (d - 128) & 1; col = h * 192 + 128 + i + 32 * pp; } }
    else if (mode == 3) { const int G = n >> 5, r = n & 31; col = 16 * G + (r & 15); s = (r < 16) ? s0 : s1; }
    const float* sp = s + (size_t)(k0 + (lane >> 5)) * ldsrc + (col < 0 ? 0 : col);
    float v[32];
#pragma unroll
    for (int i = 0; i < 32; ++i) v[i] = sp[(size_t)(2 * i) * ldsrc];
    if (kscale) {
#pragma unroll
        for (int i = 0; i < 32; ++i) v[i] *= kscale[k0 + 2 * i + (lane >> 5)];
    }
    if (col < 0) {
#pragma unroll
        for (int i = 0; i < 32; ++i) v[i] = 0.f;
    }
#pragma unroll
    for (int i = 0; i < 32; ++i) scr[(2 * i + (lane >> 5)) * 33 + (lane & 31)] = v[i];
    asm volatile("s_waitcnt lgkmcnt(0)" ::: "memory");
    const int c = lane & 7;
#pragma unroll
    for (int j = 0; j < 4; ++j) { const int nn = (lane >> 3) + 8 * j; const float* q = scr + (8 * c) * 33 + nn;
        u32x4 o; o.x = pk2(q[0], q[33]); o.y = pk2(q[2 * 33], q[3 * 33]); o.z = pk2(q[4 * 33], q[5 * 33]); o.w = pk2(q[6 * 33], q[7 * 33]);
        *(u32x4*)(dst + (size_t)(n0 + nn) * K + k0 + 8 * c) = o; }
    asm volatile("s_waitcnt lgkmcnt(0)" ::: "memory");
}
constexpr int I_IN = 16 * 56, I_UQ = 6 * 24, I_UKV = 4 * 32, I_OUT = 16 * 32, I_GU = 32 * 16 * 16, I_DN = 32 * 4 * 32;
constexpr int I_TOTAL = I_IN + I_UQ + I_UKV + I_OUT + I_GU + I_DN, I_EARLY = I_IN + I_UQ + I_UKV + I_OUT;
__device__ __forceinline__ void prep_witem(const Params& p, int it, float* scr, int lane) {
    if (it < I_IN) { const int kb = it / 56, nb = it - kb * 56; witem(p.w_in, nullptr, 1728, p.WinT, 1024, kb * 64, nb * 32, 1, nullptr, scr, lane); return; } it -= I_IN;
    if (it < I_UQ) { const int kb = it / 24, nb = it - kb * 24; witem(p.w_uq, nullptr, 768, p.WuqT, 384, kb * 64, nb * 32, 0, p.qn_g, scr, lane); return; } it -= I_UQ;
    if (it < I_UKV) { const int kb = it >> 5, nb = it & 31; witem(p.w_ukv, nullptr, 1024, p.WukvT, 256, kb * 64, nb * 32, 0, p.kvn_g, scr, lane); return; } it -= I_UKV;
    if (it < I_OUT) { const int kb = it >> 5, nb = it & 31; witem(p.w_out, nullptr, 1024, p.WoutT, 1024, kb * 64, nb * 32, 0, nullptr, scr, lane); return; } it -= I_OUT;
    if (it < I_GU) { const int e = it >> 8, r = it & 255, kb = r >> 4, nb = r & 15;
        witem(p.w_gate + (size_t)e * 1024 * 256, p.w_up + (size_t)e * 1024 * 256, 256, p.WguT + (size_t)e * 512 * 1024, 1024, kb * 64, nb * 32, 3, nullptr, scr, lane); return; } it -= I_GU;
    { const int e = it >> 7, r = it & 127, kb = r >> 5, nb = r & 31;
        witem(p.w_down + (size_t)e * 256 * 1024, nullptr, 1024, p.WdT + (size_t)e * 1024 * 256, 256, kb * 64, nb * 32, 0, nullptr, scr, lane); }
}
template <bool WT> __device__ __forceinline__ void ln0_row4(const float* x, size_t rstride, const float* g, const float* b, bf16_t* o, int lane) {
    f32x4 v[4][4]; float s[4], q[4];
#pragma unroll
    for (int r = 0; r < 4; ++r)
#pragma unroll
        for (int j = 0; j < 4; ++j) v[r][j] = *(const f32x4*)(x + r * rstride + 256 * j + 4 * lane);
#pragma unroll
    for (int r = 0; r < 4; ++r) { s[r] = 0.f; q[r] = 0.f;
#pragma unroll
        for (int j = 0; j < 4; ++j) { s[r] += (v[r][j][0] + v[r][j][1]) + (v[r][j][2] + v[r][j][3]);
            q[r] += (v[r][j][0] * v[r][j][0] + v[r][j][1] * v[r][j][1]) + (v[r][j][2] * v[r][j][2] + v[r][j][3] * v[r][j][3]); } }
#pragma unroll
    for (int o2 = 1; o2 < 64; o2 <<= 1) {
#pragma unroll
        for (int r = 0; r < 4; ++r) { s[r] += shx(s[r], o2); q[r] += shx(q[r], o2); } }
    f32x4 gg[4], bb[4];
#pragma unroll
    for (int j = 0; j < 4; ++j) { gg[j] = *(const f32x4*)(g + 256 * j + 4 * lane); bb[j] = *(const f32x4*)(b + 256 * j + 4 * lane); }
#pragma unroll
    for (int r = 0; r < 4; ++r) { const float mean = s[r] * (1.f / 1024.f), var = fmaxf(q[r] * (1.f / 1024.f) - mean * mean, 0.f), rstd = 1.f / sqrtf(var + 1e-5f);
#pragma unroll
        for (int j = 0; j < 4; ++j) { if (WT) st4wt(o + r * rstride + 256 * j + 4 * lane, (v[r][j] - mean) * rstd * gg[j] + bb[j]); else st4(o + r * rstride + 256 * j + 4 * lane, (v[r][j] - mean) * rstd * gg[j] + bb[j]); } }
}
__device__ __forceinline__ void ln0_row1_wt(const float* xr, const float* g, const float* b, bf16_t* orow, int lane) {
    f32x4 v[4]; float s = 0.f, q = 0.f;
#pragma unroll
    for (int j = 0; j < 4; ++j) { v[j] = *(const f32x4*)(xr + 256 * j + 4 * lane); s += (v[j][0] + v[j][1]) + (v[j][2] + v[j][3]); q += (v[j][0] * v[j][0] + v[j][1] * v[j][1]) + (v[j][2] * v[j][2] + v[j][3] * v[j][3]); }
#pragma unroll
    for (int o2 = 1; o2 < 64; o2 <<= 1) { s += shx(s, o2); q += shx(q, o2); }
    const float mean = s * (1.f / 1024.f), var = fmaxf(q * (1.f / 1024.f) - mean * mean, 0.f), rstd = 1.f / sqrtf(var + 1e-5f);
#pragma unroll
    for (int j = 0; j < 4; ++j) { const f32x4 gg = *(const f32x4*)(g + 256 * j + 4 * lane), bb = *(const f32x4*)(b + 256 * j + 4 * lane); st4wt(orow + 256 * j + 4 * lane, (v[j] - mean) * rstd * gg + bb); }
}

template <int K> __device__ __forceinline__ void rs_table(const bf16_t* A, float* tab) {
    int tid = threadIdx.x; asm volatile("" : "+v"(tid));
    const int r = tid >> 1, hf = tid & 1; constexpr int n = K >> 1;
    const bf16_t* a = A + (size_t)r * K + hf * n; float s = 0.f;
    u32x4 w[n / 8];
#pragma unroll
    for (int i = 0; i < n / 8; ++i) w[i] = *(const u32x4*)(a + 8 * i);
#pragma unroll
    for (int i = 0; i < n / 8; ++i) { const float a0 = bflo(w[i].x), a1 = bfhi(w[i].x), a2 = bflo(w[i].y), a3 = bfhi(w[i].y), a4 = bflo(w[i].z), a5 = bfhi(w[i].z), a6 = bflo(w[i].w), a7 = bfhi(w[i].w);
        s += (a0 * a0 + a1 * a1) + (a2 * a2 + a3 * a3) + (a4 * a4 + a5 * a5) + (a6 * a6 + a7 * a7); }
    s += shx(s, 1);
    if (hf == 0) tab[r] = 1.f / sqrtf(s / (float)K + 1e-6f);
}

__device__ __forceinline__ void gmlp_phase(const Params& p, char* shm, int vcu) {
    int tid = threadIdx.x; asm volatile("" : "+v"(tid));
    const int wid = __builtin_amdgcn_readfirstlane(tid >> 6), lane = tid & 63, fr = lane & 15, fq = lane >> 4;
    const int h = vcu & 3, iabs = 16 * wid + fr;
    bf16x8 wf[4];
#pragma unroll
    for (int ks = 0; ks < 4; ++ks) {
        const float* w = p.w_sp + ((size_t)h * 128 + iabs) * 128 + 32 * ks + 8 * fq;
        const f32x4 w0 = *(const f32x4*)w, w1 = *(const f32x4*)(w + 4);
        const bool ok = (ks >> 1) <= (iabs >> 6);
        u32x4 pk; pk.x = pk2(w0[0], w0[1]); pk.y = pk2(w0[2], w0[3]); pk.z = pk2(w1[0], w1[1]); pk.w = pk2(w1[2], w1[3]);
        if (!ok) pk = (u32x4){0u, 0u, 0u, 0u};
        wf[ks] = __builtin_bit_cast(bf16x8, pk);
    }
    const float bias = p.b_sp[h * 128 + iabs];
    const int nks = (wid < 4) ? 2 : 4;
    const int j = tid >> 2, part = tid & 3;
    const int nb_ = gridDim.x, nrem = 896 % nb_, ng = (nb_ == 256) ? ((vcu >= nrem) ? 5 : 3) : -1;
    for (int gi = 0;; ++gi) {
        int u;
        if (ng < 0) { u = vcu + gi * nb_; if (u >= (T_TOK / 128) * 4) break; }
        else { if (gi >= ng) break; u = gi < 3 ? vcu + gi * 256 : 768 + (vcu - 128) + 128 * (gi - 3); }
        const int bn = u >> 2, row0 = bn * 128;
        {
            const bf16_t* vr = p.zv + (size_t)(row0 + j) * 512 + h * 128 + part * 32;
            float v[32];
#pragma unroll
            for (int q = 0; q < 4; ++q) { const u32x4 w = *(const u32x4*)(vr + 8 * q);
                v[8 * q + 0] = bflo(w.x); v[8 * q + 1] = bfhi(w.x); v[8 * q + 2] = bflo(w.y); v[8 * q + 3] = bfhi(w.y);
                v[8 * q + 4] = bflo(w.z); v[8 * q + 5] = bfhi(w.z); v[8 * q + 6] = bflo(w.w); v[8 * q + 7] = bfhi(w.w); }
            float s = 0.f;
#pragma unroll
            for (int e = 0; e < 32; ++e) s += v[e];
            s += shx(s, 1); s += shx(s, 2);
            const float mean = s * (1.f / 128.f); float s2 = 0.f;
#pragma unroll
            for (int e = 0; e < 32; ++e) { v[e] -= mean; s2 += v[e] * v[e]; }
            s2 += shx(s2, 1); s2 += shx(s2, 2);
            const float rstd = 1.f / sqrtf(s2 * (1.f / 128.f) + 1e-5f);
            const float* gg = p.gm_g + h * 128 + part * 32; const float* bb = p.gm_b + h * 128 + part * 32;
#pragma unroll
            for (int e = 0; e < 32; ++e) *(bf16_t*)(shm + (part * 32 + e) * 272 + j * 2) = f2bf(v[e] * rstd * gg[e] + bb[e]);
        }
        __syncthreads();
        f32x4 acc[8];
#pragma unroll
        for (int cb = 0; cb < 8; ++cb) acc[cb] = (f32x4){0.f, 0.f, 0.f, 0.f};
#pragma unroll
        for (int ks = 0; ks < 4; ++ks) if (ks < nks) {
#pragma unroll
            for (int cb = 0; cb < 8; ++cb) { const bf16x8 a = *(const bf16x8*)(shm + (16 * cb + fr) * 272 + (32 * ks + 8 * fq) * 2);
                acc[cb] = __builtin_amdgcn_mfma_f32_16x16x32_bf16(a, wf[ks], acc[cb], 0, 0, 0); }
        }
        const bf16_t* ur = p.zu + (size_t)(row0 + iabs) * 512 + h * 128 + 4 * fq;
        bf16_t* orow = p.mix + (size_t)(row0 + iabs) * DM + h * 128 + 4 * fq;
#pragma unroll
        for (int cb = 0; cb < 8; ++cb) { const u32x2 uw = *(const u32x2*)(ur + 16 * cb); f32x4 o;
            o[0] = bflo(uw.x) * (acc[cb][0] + bias); o[1] = bfhi(uw.x) * (acc[cb][1] + bias); o[2] = bflo(uw.y) * (acc[cb][2] + bias); o[3] = bfhi(uw.y) * (acc[cb][3] + bias);
            st4(orow + 16 * cb, o); }
        __syncthreads();
    }
}

constexpr int KT_STRIDE = 400, VT_STRIDE = 144, KT_BYTES = 64 * KT_STRIDE, ATT_STAGE = KT_BYTES + 128 * VT_STRIDE;
template <int AMODE> __device__ __forceinline__ void attn_block(const Params& p, char* shm, int bh, int qb, bf16_t* outbuf) {
    int tid = threadIdx.x; asm volatile("" : "+v"(tid));
    const int wid = __builtin_amdgcn_readfirstlane(tid >> 6), lane = tid & 63, r = lane & 31, hh = lane >> 5;
    const int b = bh >> 2, h = bh & 3, q0 = qb * 256, ntile = 4 * qb + 4, nw = 4 * qb + (wid >> 1) + 1;
    bf16x8 qf[12];
    { const bf16_t* qp = p.Q + ((size_t)bh * SEQ + q0 + 32 * wid + r) * 192 + 8 * hh;
#pragma unroll
      for (int s = 0; s < 12; ++s) qf[s] = *(const bf16x8*)(qp + 16 * s);
      const float2* rp = p.rope + ((size_t)b * SEQ + q0 + 32 * wid + r) * 32 + 8 * hh;
#pragma unroll
      for (int s = 0; s < 2; ++s) { u32x4 x1 = __builtin_bit_cast(u32x4, qf[8 + s]), x2 = __builtin_bit_cast(u32x4, qf[10 + s]); float a[8], c2[8];
          a[0] = bflo(x1.x); a[1] = bfhi(x1.x); a[2] = bflo(x1.y); a[3] = bfhi(x1.y); a[4] = bflo(x1.z); a[5] = bfhi(x1.z); a[6] = bflo(x1.w); a[7] = bfhi(x1.w);
          c2[0] = bflo(x2.x); c2[1] = bfhi(x2.x); c2[2] = bflo(x2.y); c2[3] = bfhi(x2.y); c2[4] = bflo(x2.z); c2[5] = bfhi(x2.z); c2[6] = bflo(x2.w); c2[7] = bfhi(x2.w);
          float o1[8], o2[8];
#pragma unroll
          for (int j = 0; j < 8; ++j) { const float2 cs = rp[16 * s + j]; o1[j] = a[j] * cs.x - c2[j] * cs.y; o2[j] = c2[j] * cs.x + a[j] * cs.y; }
          x1.x = pk2(o1[0], o1[1]); x1.y = pk2(o1[2], o1[3]); x1.z = pk2(o1[4], o1[5]); x1.w = pk2(o1[6], o1[7]);
          x2.x = pk2(o2[0], o2[1]); x2.y = pk2(o2[2], o2[3]); x2.z = pk2(o2[4], o2[5]); x2.w = pk2(o2[6], o2[7]);
          qf[8 + s] = __builtin_bit_cast(bf16x8, x1); qf[10 + s] = __builtin_bit_cast(bf16x8, x2); } }
    f32x16 O[4];
#pragma unroll
    for (int d = 0; d < 4; ++d)
#pragma unroll
        for (int t = 0; t < 16; ++t) O[d][t] = 0.f;
    float m = -INFINITY, l = 0.f;
    const bf16_t* kn_src = p.Kn + ((size_t)bh * SEQ + (tid >> 4)) * 128 + (tid & 15) * 8;
    const bf16_t* kr_src = p.krope + ((size_t)b * SEQ + (tid >> 3)) * 64 + (tid & 7) * 8;
    const bf16_t* vt_src = p.Vt + ((size_t)bh * 128 + (tid >> 3)) * SEQ + (tid & 7) * 8;
    const int kn_dst = (tid >> 4) * KT_STRIDE + (tid & 15) * 16, kr_dst = (tid >> 3) * KT_STRIDE + 256 + (tid & 7) * 16, vt_dst = KT_BYTES + (tid >> 3) * VT_STRIDE + (tid & 7) * 16;
    u32x4 g0, g1, g2, g3, g4;
    #define ATT_LOAD(kt) do { g0 = *(const u32x4*)(kn_src + (size_t)(kt) * 64 * 128); g1 = *(const u32x4*)(kn_src + (size_t)((kt) * 64 + 32) * 128); \
        g2 = *(const u32x4*)(kr_src + (size_t)(kt) * 64 * 64); g3 = *(const u32x4*)(vt_src + (kt) * 64); g4 = *(const u32x4*)(vt_src + (size_t)64 * SEQ + (kt) * 64); } while (0)
    #define ATT_WRITE(buf) do { char* _s = shm + (buf) * ATT_STAGE; *(u32x4*)(_s + kn_dst) = g0; *(u32x4*)(_s + kn_dst + 32 * KT_STRIDE) = g1; *(u32x4*)(_s + kr_dst) = g2; \
        *(u32x4*)(_s + vt_dst) = g3; *(u32x4*)(_s + vt_dst + 64 * VT_STRIDE) = g4; } while (0)
    ATT_LOAD(0); ATT_WRITE(0);
    __syncthreads();
    for (int kt = 0; kt < ntile; ++kt) {
        const bool more = kt + 1 < ntile;
        if (more) ATT_LOAD(kt + 1);
        if (kt < nw) {
            const char* ks = shm + (kt & 1) * ATT_STAGE; const char* vs = ks + KT_BYTES;
            f32x16 S0, S1;
#pragma unroll
            for (int t = 0; t < 16; ++t) { S0[t] = 0.f; S1[t] = 0.f; }
            if (AMODE != 4 && AMODE != 5) {
            __builtin_amdgcn_s_setprio(1);
#pragma unroll
            for (int s = 0; s < 12; ++s) {
                const bf16x8 k0 = *(const bf16x8*)(ks + r * KT_STRIDE + (16 * s + 8 * hh) * 2), k1 = *(const bf16x8*)(ks + (32 + r) * KT_STRIDE + (16 * s + 8 * hh) * 2);
                S0 = __builtin_amdgcn_mfma_f32_32x32x16_bf16(k0, qf[s], S0, 0, 0, 0);
                S1 = __builtin_amdgcn_mfma_f32_32x32x16_bf16(k1, qf[s], S1, 0, 0, 0);
            }
            __builtin_amdgcn_s_setprio(0);
            } else { asm volatile("" : "+v"(S0), "+v"(S1)); }
            float mt = fmaxf(S0[0], S1[0]);
#pragma unroll
            for (int t = 1; t < 16; ++t) mt = fmaxf(mt, fmaxf(S0[t], S1[t]));
            mt = fmaxf(mt, shx(mt, 32));
            if (AMODE == 2 || AMODE == 5) { m = 0.f; l = 1.f; asm volatile("" : "+v"(S0), "+v"(S1)); } else {
            if (!__all(mt - m <= 8.0f)) {
                const float mn = fmaxf(m, mt), alpha = __builtin_amdgcn_exp2f(m - mn); m = mn; l *= alpha;
#pragma unroll
                for (int d = 0; d < 4; ++d)
#pragma unroll
                    for (int t = 0; t < 16; ++t) O[d][t] *= alpha;
            }
            float ls = 0.f;
#pragma unroll
            for (int t = 0; t < 16; ++t) { S0[t] = __builtin_amdgcn_exp2f(S0[t] - m); S1[t] = __builtin_amdgcn_exp2f(S1[t] - m); ls += S0[t] + S1[t]; }
            l += ls; }
            bf16x8 pf[4];
#pragma unroll
            for (int s = 0; s < 2; ++s) {
                u32x4 a, c; a.x = pk2(S0[8 * s + 0], S0[8 * s + 1]); a.y = pk2(S0[8 * s + 2], S0[8 * s + 3]); a.z = pk2(S0[8 * s + 4], S0[8 * s + 5]); a.w = pk2(S0[8 * s + 6], S0[8 * s + 7]);
                c.x = pk2(S1[8 * s + 0], S1[8 * s + 1]); c.y = pk2(S1[8 * s + 2], S1[8 * s + 3]); c.z = pk2(S1[8 * s + 4], S1[8 * s + 5]); c.w = pk2(S1[8 * s + 6], S1[8 * s + 7]);
                pf[s] = __builtin_bit_cast(bf16x8, a); pf[2 + s] = __builtin_bit_cast(bf16x8, c);
            }
            if (AMODE == 3 || AMODE == 5) { asm volatile("" :: "v"(pf[0]), "v"(pf[1]), "v"(pf[2]), "v"(pf[3])); } else {
            __builtin_amdgcn_s_setprio(1);
#pragma unroll
            for (int k4 = 0; k4 < 4; ++k4)
#pragma unroll
                for (int d = 0; d < 4; ++d) { const bf16x8 vf = *(const bf16x8*)(vs + (32 * d + r) * VT_STRIDE + (16 * k4 + 8 * hh) * 2);
                    O[d] = __builtin_amdgcn_mfma_f32_32x32x16_bf16(vf, pf[k4], O[d], 0, 0, 0); }
            __builtin_amdgcn_s_setprio(0); }
        }
        if (more) ATT_WRITE((kt + 1) & 1);
        __syncthreads();
    }
    #undef ATT_LOAD
    #undef ATT_WRITE
    l += shx(l, 32);
    const float inv = 1.f / l;
    bf16_t* o = outbuf + ((size_t)b * SEQ + q0 + 32 * wid + r) * DM + 512 + h * 128 + 4 * hh;
#pragma unroll
    for (int d = 0; d < 4; ++d)
#pragma unroll
        for (int g = 0; g < 4; ++g) { f32x4 v; v[0] = O[d][4 * g] * inv; v[1] = O[d][4 * g + 1] * inv; v[2] = O[d][4 * g + 2] * inv; v[3] = O[d][4 * g + 3] * inv; st4(o + 32 * d + 8 * g, v); }
}


__device__ __forceinline__ void router_tile(const Params& p, char* smc, int tb) {
    int tid = threadIdx.x; asm volatile("" : "+v"(tid));
    const int wid = __builtin_amdgcn_readfirstlane(tid >> 6), lane = tid & 63, fr = lane & 15, fq = lane >> 4;
    int* lcnt = (int*)(smc + LDS_LCNT);
    { u32x4 wreg[18];
#pragma unroll
      for (int k = 0; k < 18; ++k) { const int i = tid + k * NTHR; wreg[k] = *(const u32x4*)(p.WrT + (size_t)i * 8); }
#pragma unroll
      for (int k = 0; k < 18; ++k) { const int i = tid + k * NTHR, img = i / (36 * 128), rem = i - img * 36 * 128, o = rem >> 7, ch = rem & 127;
          *(u32x4*)(smc + LDS_RW + img * 73728 + o * 2048 + ((ch ^ (o & 15)) << 4)) = wreg[k]; } }
    if (tid < NEXP) lcnt[tid] = 0;
    __syncthreads();
    const int tok = tb * 128 + wid * 16 + fr;
    bf16_t* hr = p.hbuf + (size_t)tok * DM + 8 * fq;
    float s = 0.f, s2 = 0.f;
#if YSTAT
    { const f32x4 a = *(const f32x4*)(p.ystat + (size_t)tok * 32 + 8 * fq), b = *(const f32x4*)(p.ystat + (size_t)tok * 32 + 8 * fq + 4); s = (a[0] + a[2]) + (b[0] + b[2]); s2 = (a[1] + a[3]) + (b[1] + b[3]); }
    s += shx(s, 16); s += shx(s, 32); s2 += shx(s2, 16); s2 += shx(s2, 32);
#else
#pragma unroll 8
    for (int ks = 0; ks < 32; ++ks) { const u32x4 y = *(const u32x4*)(hr + 32 * ks);
        const float a0 = bflo(y.x), a1 = bfhi(y.x), a2 = bflo(y.y), a3 = bfhi(y.y), a4 = bflo(y.z), a5 = bfhi(y.z), a6 = bflo(y.w), a7 = bfhi(y.w);
        s += ((a0 + a1) + (a2 + a3)) + ((a4 + a5) + (a6 + a7)); s2 += ((a0 * a0 + a1 * a1) + (a2 * a2 + a3 * a3)) + ((a4 * a4 + a5 * a5) + (a6 * a6 + a7 * a7)); }
    s += shx(s, 16); s += shx(s, 32); s2 += shx(s2, 16); s2 += shx(s2, 32);
#endif
    const float mean = s * (1.f / 1024.f), var = fmaxf(s2 * (1.f / 1024.f) - mean * mean, 0.f), rstd = 1.f / sqrtf(var + 1e-5f);
    const int o0 = fr < 4 ? fr : 3, o1 = 4 + fr, o2 = 20 + fr;
    const int w0 = o0 * 2048, w1 = o1 * 2048, w2 = o2 * 2048, x0 = o0 & 15, x1 = o1 & 15, x2 = o2 & 15;
    f32x4 acc0 = {0.f, 0.f, 0.f, 0.f}, acc1 = acc0, acc2 = acc0;
    const float* lg_ = p.ln1_g + 8 * fq; const float* lb_ = p.ln1_b + 8 * fq;
#pragma unroll 8
    for (int ks = 0; ks < 32; ++ks) {
        const f32x4 g0 = *(const f32x4*)(lg_ + 32 * ks), g1 = *(const f32x4*)(lg_ + 32 * ks + 4), b0 = *(const f32x4*)(lb_ + 32 * ks), b1 = *(const f32x4*)(lb_ + 32 * ks + 4);
        const u32x4 yy = *(const u32x4*)(hr + 32 * ks);
        float h[8];
        h[0] = (bflo(yy.x) - mean) * rstd * g0[0] + b0[0]; h[1] = (bfhi(yy.x) - mean) * rstd * g0[1] + b0[1]; h[2] = (bflo(yy.y) - mean) * rstd * g0[2] + b0[2]; h[3] = (bfhi(yy.y) - mean) * rstd * g0[3] + b0[3];
        h[4] = (bflo(yy.z) - mean) * rstd * g1[0] + b1[0]; h[5] = (bfhi(yy.z) - mean) * rstd * g1[1] + b1[1]; h[6] = (bflo(yy.w) - mean) * rstd * g1[2] + b1[2]; h[7] = (bfhi(yy.w) - mean) * rstd * g1[3] + b1[3];
        u32x4 hi, lo; hi.x = pk2(h[0], h[1]); hi.y = pk2(h[2], h[3]); hi.z = pk2(h[4], h[5]); hi.w = pk2(h[6], h[7]);
        *(u32x4*)(hr + 32 * ks) = hi;
        lo.x = pk2(h[0] - bflo(hi.x), h[1] - bfhi(hi.x)); lo.y = pk2(h[2] - bflo(hi.y), h[3] - bfhi(hi.y)); lo.z = pk2(h[4] - bflo(hi.z), h[5] - bfhi(hi.z)); lo.w = pk2(h[6] - bflo(hi.w), h[7] - bfhi(hi.w));
        const bf16x8 hh = __builtin_bit_cast(bf16x8, hi), hl = __builtin_bit_cast(bf16x8, lo);
        const int ch = 4 * ks + fq;
        const bf16x8 a0h = *(const bf16x8*)(smc + LDS_RW + w0 + ((ch ^ x0) << 4)), a0l = *(const bf16x8*)(smc + LDS_RW + 73728 + w0 + ((ch ^ x0) << 4));
        const bf16x8 a1h = *(const bf16x8*)(smc + LDS_RW + w1 + ((ch ^ x1) << 4)), a1l = *(const bf16x8*)(smc + LDS_RW + 73728 + w1 + ((ch ^ x1) << 4));
        const bf16x8 a2h = *(const bf16x8*)(smc + LDS_RW + w2 + ((ch ^ x2) << 4)), a2l = *(const bf16x8*)(smc + LDS_RW + 73728 + w2 + ((ch ^ x2) << 4));
        acc0 = __builtin_amdgcn_mfma_f32_16x16x32_bf16(a0h, hh, acc0, 0, 0, 0); acc0 = __builtin_amdgcn_mfma_f32_16x16x32_bf16(a0h, hl, acc0, 0, 0, 0); acc0 = __builtin_amdgcn_mfma_f32_16x16x32_bf16(a0l, hh, acc0, 0, 0, 0);
        acc1 = __builtin_amdgcn_mfma_f32_16x16x32_bf16(a1h, hh, acc1, 0, 0, 0); acc1 = __builtin_amdgcn_mfma_f32_16x16x32_bf16(a1h, hl, acc1, 0, 0, 0); acc1 = __builtin_amdgcn_mfma_f32_16x16x32_bf16(a1l, hh, acc1, 0, 0, 0);
        acc2 = __builtin_amdgcn_mfma_f32_16x16x32_bf16(a2h, hh, acc2, 0, 0, 0); acc2 = __builtin_amdgcn_mfma_f32_16x16x32_bf16(a2h, hl, acc2, 0, 0, 0); acc2 = __builtin_amdgcn_mfma_f32_16x16x32_bf16(a2l, hh, acc2, 0, 0, 0);
    }
    __syncthreads();
    float* sc = (float*)(smc + LDS_RW) + wid * (16 * 40) + fr * 40;
    if (fq == 0) { sc[0] = acc0[0]; sc[1] = acc0[1]; sc[2] = acc0[2]; sc[3] = acc0[3]; }
    *(f32x4*)(sc + 4 + 4 * fq) = acc1; *(f32x4*)(sc + 20 + 4 * fq) = acc2;
    __syncthreads();
    if (lane < 16) {
        const float* lr = (const float*)(smc + LDS_RW) + wid * (16 * 40) + lane * 40;
        float lg[36];
#pragma unroll
        for (int o = 0; o < 36; o += 4) { const f32x4 v = *(const f32x4*)(lr + o); lg[o] = v[0]; lg[o + 1] = v[1]; lg[o + 2] = v[2]; lg[o + 3] = v[3]; }
#pragma unroll
        for (int o = 0; o < 4; ++o) lg[o] += p.b_rg[o];
#pragma unroll
        for (int o = 0; o < 32; ++o) lg[4 + o] += p.b_re[o];
        int g = 0; float gm = lg[0];
#pragma unroll
        for (int i = 1; i < 4; ++i) if (lg[i] > gm) { gm = lg[i]; g = i; }
        float se = 0.f;
#pragma unroll
        for (int i = 0; i < 4; ++i) se += expf(lg[i] - gm);
        const float pg = 1.f / se;
        float ev[8];
#pragma unroll
        for (int e = 0; e < 8; ++e) ev[e] = g == 0 ? lg[4 + e] : g == 1 ? lg[12 + e] : g == 2 ? lg[20 + e] : lg[28 + e];
        int i1 = 0; float v1 = ev[0];
#pragma unroll
        for (int e = 1; e < 8; ++e) if (ev[e] > v1) { v1 = ev[e]; i1 = e; }
        int i2 = -1; float v2 = -3.0e38f;
#pragma unroll
        for (int e = 0; e < 8; ++e) if (e != i1 && ev[e] > v2) { v2 = ev[e]; i2 = e; }
        const float d = expf(v2 - v1), g1 = pg / (1.f + d), g2 = pg * d / (1.f + d);
        const int t = tb * 128 + wid * 16 + lane, e1 = g * 8 + i1, e2 = g * 8 + i2;
        const int s1 = atomicAdd(lcnt + e1, 1), s2_ = atomicAdd(lcnt + e2, 1);
        p.listb[((size_t)tb * NEXP + e1) * 256 + s1] = 2 * t; p.listb[((size_t)tb * NEXP + e2) * 256 + s2_] = 2 * t + 1;
        p.gates[2 * t] = g1; p.gates[2 * t + 1] = g2;
    }
    __syncthreads();
    if (tid < NEXP) p.cntb[tb * NEXP + tid] = lcnt[tid];
    __syncthreads();
}
__device__ __forceinline__ void moe_tables(const Params& p, char* smc) {
    int tid = threadIdx.x; asm volatile("" : "+v"(tid));
    const int e = tid & 31, seg = tid >> 5;
    unsigned short* pre = (unsigned short*)(smc + LDS_PRE); int* tot = (int*)(smc + LDS_TOT); int* segtot = (int*)(smc + LDS_SEG);
    int c[16]; int run = 0;
#pragma unroll
    for (int i = 0; i < 16; ++i) c[i] = p.cntb[(16 * seg + i) * NEXP + e];
#pragma unroll
    for (int i = 0; i < 16; ++i) { const int v = c[i]; c[i] = run; run += v; }
    segtot[seg * 32 + e] = run;
    __syncthreads();
    int base = 0, all = 0;
#pragma unroll
    for (int s = 0; s < 16; ++s) { const int v = segtot[s * 32 + e]; base += (s < seg) ? v : 0; all += v; }
#pragma unroll
    for (int i = 0; i < 16; ++i) pre[e * 256 + 16 * seg + i] = (unsigned short)(base + c[i]);
    if (seg == 0) tot[e] = all;
    __syncthreads();
}

template <class PH> __device__ __forceinline__ void gemm_phase(const PH& ph, LAS unsigned char* shm, int vcu) {
#if defined(NOSTREAM)
    for (int u = vcu;; u += gridDim.x) { Unit<typename PH::EP> un; if (u >= PH::NU || !ph.unit(u, un)) break; gemm256(un, shm); }
#else
    gemm_stream(ph, shm, vcu, gridDim.x);
#endif
}

struct PhKVc { Params p; const float* tab; int pm; typedef EpiKV EP; static constexpr int NU = 4;
    __device__ __forceinline__ bool unit(int pn, Unit<EP>& o) const {
        o.am = AMap{p.zkv + (size_t)pm * 256 * 256, 256, nullptr, 256}; o.bt = p.WukvT + (size_t)pn * 256 * 256; o.K = 256;
        o.ep = EpiKV{p.Kn, p.Vt, tab, pm * 256, pm * 256, pn * 256}; return true; } };
struct PhZ2 { Params p; typedef EpiZ EP; static constexpr int NU = 128 * 2;
    __device__ __forceinline__ bool unit(int v, Unit<EP>& o) const { const int pm = v >> 1, pn = 5 + (v & 1);
        o.am = AMap{p.hbuf + (size_t)pm * 256 * DM, DM, nullptr, 256}; o.bt = p.WinT + (size_t)pn * 256 * DM; o.K = DM;
        o.ep = EpiZ{p.zu, p.zv, p.zq, p.zkv, p.krope, p.rope, pm * 256, pn * 256}; return true; } };
struct PhZ3x { Params p; int xq; typedef EpiZ EP; static constexpr int NU = 48;
    __device__ __forceinline__ bool unit(int v, Unit<EP>& o) const { const int pm = 16 * xq + v / 3, pn = 4 + v % 3;
        o.am = AMap{p.hbuf + (size_t)pm * 256 * DM, DM, nullptr, 256}; o.bt = p.WinT + (size_t)pn * 256 * DM; o.K = DM;
        o.ep = EpiZ{p.zu, p.zv, p.zq, p.zkv, p.krope, p.rope, pm * 256, pn * 256}; return true; } };
struct PhZ3 { Params p; typedef EpiZ EP; static constexpr int NU = 128 * 3;
    __device__ __forceinline__ bool unit(int v, Unit<EP>& o) const { const int pm = v / 3, pn = 4 + (v - pm * 3);
        o.am = AMap{p.hbuf + (size_t)pm * 256 * DM, DM, nullptr, 256}; o.bt = p.WinT + (size_t)pn * 256 * DM; o.K = DM;
        o.ep = EpiZ{p.zu, p.zv, p.zq, p.zkv, p.krope, p.rope, pm * 256, pn * 256}; return true; } };
struct PhQs { Params p; const float* tab; int u0, ustride; typedef EpiQ EP; static constexpr int NU = 128 * 3;
    __device__ __forceinline__ bool unit(int u, Unit<EP>& o) const { const int pm = u / 3, pn = u - pm * 3, slot = (u - u0) / ustride;
        o.am = AMap{p.zq + (size_t)pm * 256 * 384, 384, nullptr, 256}; o.bt = p.WuqT + (size_t)pn * 256 * 384; o.K = 384;
        o.ep = EpiQ{p.Q, tab + slot * 256, pm * 256, pm * 256, pn * 256}; return true; } };
struct PhKVs { Params p; const float* tab; int u0, ustride; typedef EpiKV EP; static constexpr int NU = 128 * 3 + 128 * 4;
    __device__ __forceinline__ bool unit(int u, Unit<EP>& o) const { const int v = u - 384, pm = v >> 2, pn = v & 3, slot = (u - u0) / ustride;
        o.am = AMap{p.zkv + (size_t)pm * 256 * 256, 256, nullptr, 256}; o.bt = p.WukvT + (size_t)pn * 256 * 256; o.K = 256;
        o.ep = EpiKV{p.Kn, p.Vt, tab + slot * 256, pm * 256, pm * 256, pn * 256}; return true; } };
struct PhKVb { Params p; const float* tab; int kbeg, kend, slot0; typedef EpiKV EP; static constexpr int NU = 128 * 4;
    __device__ __forceinline__ bool unit(int k, Unit<EP>& o) const { if (k >= kend) return false; const int pm = k >> 2, pn = k & 3, slot = slot0 + (k - kbeg);
        o.am = AMap{p.zkv + (size_t)pm * 256 * 256, 256, nullptr, 256}; o.bt = p.WukvT + (size_t)pn * 256 * 256; o.K = 256;
        o.ep = EpiKV{p.Kn, p.Vt, tab + slot * 256, pm * 256, pm * 256, pn * 256}; return true; } };
struct PhHs { Params p; const int* tot; const int* aid_tab; int u0, ustride; typedef EpiH EP; static constexpr int NU = 288 * 2;
    __device__ __forceinline__ bool unit(int u, Unit<EP>& o) const { int e, rt, ct, pr; if (!moe_unit(tot, u, 2, e, rt, ct, pr)) return false;
        const int nv = __builtin_amdgcn_readfirstlane(min(256, tot[e] - rt * 256)), slot = (u - u0) / ustride;
        o.am = AMap{p.hbuf, DM, aid_tab + slot * 256, nv}; o.bt = p.WguT + ((size_t)e * 512 + ct * 256) * DM; o.K = DM;
        o.ep = EpiH{p.H, pr, ct * 256, MERGE67 != 0}; return true; }
    __device__ __forceinline__ void done(const Unit<EP>& cu, int wr) const {
        asm volatile("s_waitcnt vmcnt(0)" ::: "memory");
        if (wr == 0) __builtin_amdgcn_s_barrier();
        __builtin_amdgcn_s_barrier();
        if (threadIdx.x == 0) __hip_atomic_fetch_add(hready + (cu.ep.hrow0 >> 8), 1u, __ATOMIC_RELAXED, __HIP_MEMORY_SCOPE_AGENT);
        if (wr == 1) __builtin_amdgcn_s_barrier();
    }
    unsigned* hready; };
struct PhCs { Params p; const int* tot; unsigned* hready; int u0; unsigned* queue; volatile int* slot; typedef EpiC EP; static constexpr int NU = 288 * 4;
    __device__ __forceinline__ int take(bool stagger, int wr) const {
        if (stagger && wr == 0) __builtin_amdgcn_s_barrier();
        if (threadIdx.x == 0) slot[0] = (int)__hip_atomic_fetch_add(queue, 1u, __ATOMIC_RELAXED, __HIP_MEMORY_SCOPE_AGENT);
        __builtin_amdgcn_s_barrier();
        const int t = __builtin_amdgcn_readfirstlane(slot[0]);
        __builtin_amdgcn_s_barrier();
        if (stagger && wr == 1) __builtin_amdgcn_s_barrier();
        return t;
    }
    __device__ __forceinline__ int next(int wr) const { return take(true, wr); }
    __device__ __forceinline__ bool unit(int u, Unit<EP>& o) const { int e, rt, ct, pr; if (!moe_unit(tot, u, 4, e, rt, ct, pr)) return false;
        const int wr = __builtin_amdgcn_readfirstlane((int)threadIdx.x >> 8);
        if (u != u0 && wr == 0) __builtin_amdgcn_s_barrier();
        if (threadIdx.x == 0) { unsigned sp = 0; unsigned* w = hready + (pr >> 8);
            while (__hip_atomic_load(w, __ATOMIC_RELAXED, __HIP_MEMORY_SCOPE_AGENT) < 2u) { __builtin_amdgcn_s_sleep(2); if (++sp > (1u << 20)) break; }
            __builtin_amdgcn_fence(__ATOMIC_ACQUIRE, "agent");
            asm volatile("s_waitcnt vmcnt(0)" ::: "memory"); }
        __builtin_amdgcn_s_barrier();
        if (u != u0 && wr == 1) __builtin_amdgcn_s_barrier();
        const int nv = __builtin_amdgcn_readfirstlane(min(256, tot[e] - rt * 256));
        o.am = AMap{p.H + (size_t)pr * FF, FF, nullptr, 256}; o.bt = p.WdT + ((size_t)e * DM + ct * 256) * FF; o.K = FF;
        o.ep = EpiC{p.contrib, p.list + (size_t)e * LIST_CAP + rt * 256, p.gates, nv, ct * 256}; return true; } };


struct PhZj { Params p; int u0; unsigned* cnt; typedef EpiZ EP; static constexpr int NU = 128 * 7;
    __device__ __forceinline__ void chunk(int u) const {
        int tid = threadIdx.x; asm volatile("" : "+v"(tid));
        const int wid = __builtin_amdgcn_readfirstlane(tid >> 6), lane = tid & 63;
        const int pm = u / 7, pn = u - pm * 7, r0 = pm * 256 + pn * 36 + (pn < 4 ? pn : 4), n = pn < 4 ? 37 : 36;
        ln0_row4<true>(p.x + (size_t)(r0 + wid) * DM, (size_t)8 * DM, p.ln0_g, p.ln0_b, p.hbuf + (size_t)(r0 + wid) * DM, lane);
        if (32 + wid < n) ln0_row1_wt(p.x + (size_t)(r0 + 32 + wid) * DM, p.ln0_g, p.ln0_b, p.hbuf + (size_t)(r0 + 32 + wid) * DM, lane);
        asm volatile("s_waitcnt vmcnt(0)" ::: "memory");
        __syncthreads();
        if (tid == 0) {
            __hip_atomic_fetch_add(cnt + pm, 1u, __ATOMIC_RELAXED, __HIP_MEMORY_SCOPE_AGENT);
            unsigned sp = 0;
            while (__hip_atomic_load(cnt + pm, __ATOMIC_RELAXED, __HIP_MEMORY_SCOPE_AGENT) < 7u) { __builtin_amdgcn_s_sleep(2); if (++sp > (1u << 18)) break; }
            __builtin_amdgcn_fence(__ATOMIC_ACQUIRE, "agent");
            asm volatile("s_waitcnt vmcnt(0)" ::: "memory");
        }
        __syncthreads();
    }
    __device__ __forceinline__ bool unit(int u, Unit<EP>& o) const {
        if (u != u0) {
            const int wr = __builtin_amdgcn_readfirstlane((int)threadIdx.x >> 8);
            if (wr == 0) __builtin_amdgcn_s_barrier();
            chunk(u);
            if (wr == 1) __builtin_amdgcn_s_barrier();
        }
        const int pm = u / 7, pn = u - pm * 7;
        o.am = AMap{p.hbuf + (size_t)pm * 256 * DM, DM, nullptr, 256}; o.bt = p.WinT + (size_t)pn * 256 * DM; o.K = DM;
        o.ep = EpiZ{p.zu, p.zv, p.zq, p.zkv, p.krope, p.rope, pm * 256, pn * 256}; return true; } };

typedef const __attribute__((address_space(4))) Params* KParams;
__device__ __forceinline__ Params ldp() {
#if defined(__HIP_DEVICE_COMPILE__)
    KParams q = (KParams)__builtin_amdgcn_kernarg_segment_ptr(); asm volatile("" : "+s"(q)); return *q;
#else
    return Params{};
#endif
}
template <int LO, int HI>
__global__ __launch_bounds__(512, 2) void mega(Params p_arg_unused) {
    extern __shared__ __attribute__((aligned(16))) unsigned char lds_raw[];
    LAS unsigned char* shm = (LAS unsigned char*)lds_raw;
    char* smc = (char*)lds_raw;
    const int nblk = gridDim.x;
    const int vcu = (nblk % 8 == 0) ? (int)(blockIdx.x % 8) * (nblk / 8) + (int)(blockIdx.x / 8) : (int)blockIdx.x;
    #define PHASE_IDS int tid = threadIdx.x; asm volatile("" : "+v"(tid)); const int wid = __builtin_amdgcn_readfirstlane(tid >> 6), lane = tid & 63; (void)wid; (void)lane
    XcdBarrier xb;
    if (LO != HI) {
        if (threadIdx.x == 0) { ((volatile LAS unsigned*)(smc + LDS_XB))[0] = 0u; ((volatile LAS unsigned*)(smc + LDS_XB))[1] = 0u; }
        __syncthreads();
        { const Params p = ldp(); xb = xcd_barrier_post(p.bar, (volatile LAS unsigned*)(smc + LDS_XB)); }
    }
#ifndef TIMEPH
#define TIMEPH -1
#endif
    unsigned long long ts0_ = 0, ts1_ = 0;
    #define TSTAMP(k) do { if (TIMEPH >= 0) { if ((k) == TIMEPH) ts0_ = __builtin_amdgcn_s_memrealtime(); if ((k) == TIMEPH + 1) ts1_ = __builtin_amdgcn_s_memrealtime(); } } while (0)
    #define SEAM(ph) do { if (LO <= (ph) && HI > (ph)) xcd_barrier(xb); TSTAMP((ph) + 1); } while (0)
    TSTAMP(0);
#ifndef REPMASK
#define REPMASK 0
#endif
    #define NREP(k) ((((REPMASK) >> (k)) & 1) ? 2 : 1)
    #define REPEAT(k) for (int rep_ = 0; rep_ < NREP(k); ++rep_, (rep_ < NREP(k) ? xcd_barrier(xb) : (void)0))
    if (LO <= 0 && HI >= 0) REPEAT(0) {
        const Params p = ldp(); PHASE_IDS;
        { float* scr = (float*)(smc + wid * (64 * 33 * 4)); const int gw = blockIdx.x * 8 + wid, ngw = nblk * 8;
#ifndef P0REP
#define P0REP 0
#endif
          for (int rep = 0; rep < ((P0REP & 1) ? 2 : 1); ++rep)
          for (int it = gw; it < I_EARLY; it += ngw) prep_witem(p, it, scr, lane);
#if !JIT_LN0
          for (int t = gw; t < T_TOK / 4; t += ngw) ln0_row4<false>(p.x + (size_t)t * DM, (size_t)(T_TOK / 4) * DM, p.ln0_g, p.ln0_b, p.hbuf + (size_t)t * DM, lane);
#endif
          }
        for (int rep = 0; rep < ((P0REP & 4) ? 2 : 1); ++rep)
        { const int i0 = blockIdx.x * NTHR + tid; const float inv = powf(10000.f, -(float)(2 * (i0 & 31)) / 64.f);
          if (nblk * NTHR * 8 == T_TOK * 32) { int ps[8];
#pragma unroll
              for (int k = 0; k < 8; ++k) ps[k] = p.pos[(i0 + k * nblk * NTHR) >> 5];
#pragma unroll
              for (int k = 0; k < 8; ++k) { const float ang = (float)ps[k] * inv; p.rope[i0 + k * nblk * NTHR] = make_float2(cosf(ang), sinf(ang)); } }
          else for (int i = i0; i < T_TOK * 32; i += nblk * NTHR) { const float ang = (float)p.pos[i >> 5] * inv; p.rope[i] = make_float2(cosf(ang), sinf(ang)); } }
        for (int i = blockIdx.x * NTHR + tid; i < 36 * 1024; i += nblk * NTHR) { const int o = i >> 10, k = i & 1023; const float w = o < 4 ? p.w_rg[k * 4 + o] : p.w_re[k * 32 + (o - 4)];
            const bf16_t hi = f2bf(w); p.WrT[i] = hi; p.WrT[36864 + i] = f2bf(w - bf2f(hi)); }
    }
    SEAM(0);
    if (LO <= 1 && HI >= 1) REPEAT(1) {
#if GMLP_FUSED && KVCHAIN
        { { const Params p = ldp(); gemm_stream(PhZ2{p}, shm, vcu, nblk); }
          for (;;) {
              int t;
              { const Params p = ldp(); PHASE_IDS; volatile int* slot = (volatile int*)(smc + LDS_AID);
                if (tid == 0) slot[0] = (int)__hip_atomic_fetch_add(p.bar + 3584, 1u, __ATOMIC_RELAXED, __HIP_MEMORY_SCOPE_AGENT);
                __syncthreads();
                t = __builtin_amdgcn_readfirstlane(slot[0]);
                __syncthreads(); }
              if (t >= 128 + 512 + 128) break;
              if (t < 128) { const Params p = ldp(); const int pm = t; float* tab = (float*)(smc + LDS_PRE);
                  Unit<EpiZ> un; un.am = AMap{p.hbuf + (size_t)pm * 256 * DM, DM, nullptr, 256}; un.bt = p.WinT + (size_t)4 * 256 * DM; un.K = DM; un.ep = EpiZ{p.zu, p.zv, p.zq, p.zkv, p.krope, p.rope, pm * 256, 4 * 256};
                  const KvArgs kv{p.zkv, tab, pm * 256};
                  gemm256<EpiZ, 2>(un, shm, nullptr, &kv);
                  gemm_stream(PhKVc{p, tab, pm}, shm, 0, 1);
              } else if (t < 128 + 512) { const Params p = ldp(); const int w = t - 128, pm = w >> 2, h = w & 3;
                  Unit<EpiZ> un; un.am = AMap{p.hbuf + (size_t)pm * 256 * DM, DM, nullptr, 256}; un.bt = p.WinT + (size_t)h * 256 * DM; un.K = DM; un.ep = EpiZ{p.zu, p.zv, p.zq, p.zkv, p.krope, p.rope, pm * 256, h * 256};
                  const GmArgs gm{p.gm_g, p.gm_b, p.w_sp, p.b_sp, p.mix, pm * 256, h};
                  gemm256<EpiZ, 1>(un, shm, &gm);
              } else { const Params p = ldp(); PHASE_IDS; const int ch = t - 640; float* scr = (float*)(smc + wid * (64 * 33 * 4));
                  for (int k = wid; k < 96; k += 8) prep_witem(p, I_EARLY + ch * 96 + k, scr, lane);
                  __syncthreads(); }
          } }
#elif GMLP_FUSED && P1QUEUE
        { const bool xl = (nblk == 256); const int xq = vcu >> 5;
          { const Params p = ldp(); if (xl) gemm_stream(PhZ3x{p, xq}, shm, vcu & 31, 32); else gemm_stream(PhZ3{p}, shm, vcu, nblk); }
          const int nfu = xl ? 64 : 512, nch = xl ? 16 : 128;
          for (;;) {
              int t;
              { const Params p = ldp(); PHASE_IDS; volatile int* slot = (volatile int*)(smc + LDS_AID);
                if (tid == 0) slot[0] = (int)__hip_atomic_fetch_add(p.bar + 3584 + (xl ? 8 * xq : 0), 1u, __ATOMIC_RELAXED, __HIP_MEMORY_SCOPE_AGENT);
                __syncthreads();
                t = __builtin_amdgcn_readfirstlane(slot[0]);
                __syncthreads(); }
              if (t >= nfu + nch) break;
              if (t < nfu) { const Params p = ldp(); const int w = xl ? 64 * xq + t : t, pm = w >> 2, h = w & 3;
                  Unit<EpiZ> un; un.am = AMap{p.hbuf + (size_t)pm * 256 * DM, DM, nullptr, 256}; un.bt = p.WinT + (size_t)h * 256 * DM; un.K = DM; un.ep = EpiZ{p.zu, p.zv, p.zq, p.zkv, p.krope, p.rope, pm * 256, h * 256};
                  const GmArgs gm{p.gm_g, p.gm_b, p.w_sp, p.b_sp, p.mix, pm * 256, h};
                  gemm256<EpiZ, 1>(un, shm, &gm);
              } else { const Params p = ldp(); PHASE_IDS; const int ch = (xl ? 16 * xq : 0) + (t - nfu); float* scr = (float*)(smc + wid * (64 * 33 * 4));
                  for (int k = wid; k < 96; k += 8) prep_witem(p, I_EARLY + ch * 96 + k, scr, lane);
                  __syncthreads(); }
          } }
#elif GMLP_FUSED
        { const Params p = ldp(); PHASE_IDS;
          gemm_stream(PhZ3{p}, shm, vcu, nblk);
          if (PhZ3::NU % nblk != 0 && vcu >= PhZ3::NU % nblk) { float* scr = (float*)(smc + wid * (64 * 33 * 4)); const int nlate = nblk - (PhZ3::NU % nblk), gw = (vcu - PhZ3::NU % nblk) * 8 + wid, ngw = nlate * 8;
              for (int it = I_EARLY + gw; it < I_TOTAL; it += ngw) prep_witem(p, it, scr, lane); }
          else if (PhZ3::NU % nblk == 0) { float* scr = (float*)(smc + wid * (64 * 33 * 4)); for (int it = I_EARLY + vcu * 8 + wid; it < I_TOTAL; it += nblk * 8) prep_witem(p, it, scr, lane); }
          __syncthreads();
          for (int w = vcu; w < 512; w += nblk) { const int pm = w >> 2, h = w & 3;
              Unit<EpiZ> un; un.am = AMap{p.hbuf + (size_t)pm * 256 * DM, DM, nullptr, 256}; un.bt = p.WinT + (size_t)h * 256 * DM; un.K = DM; un.ep = EpiZ{p.zu, p.zv, p.zq, p.zkv, p.krope, p.rope, pm * 256, h * 256};
              const GmArgs gm{p.gm_g, p.gm_b, p.w_sp, p.b_sp, p.mix, pm * 256, h};
              gemm256<EpiZ, 1>(un, shm, &gm); } }
#else
#if JIT_LN0
        { const Params p = ldp(); PhZj ph{p, vcu, p.bar + 3520}; ph.chunk(vcu); gemm_stream(ph, shm, vcu, nblk); }
#else
        gemm_phase(PhZ{ldp()}, shm, vcu);
#endif
        { const Params p = ldp(); PHASE_IDS; const int nlate = nblk - (PhZ::NU % nblk);
          if (PhZ::NU % nblk != 0 && vcu >= PhZ::NU % nblk) { float* scr = (float*)(smc + wid * (64 * 33 * 4)); const int gw = (vcu - PhZ::NU % nblk) * 8 + wid, ngw = nlate * 8;
              for (int it = I_EARLY + gw; it < I_TOTAL; it += ngw) prep_witem(p, it, scr, lane); }
          else if (PhZ::NU % nblk == 0) { float* scr = (float*)(smc + wid * (64 * 33 * 4)); for (int it = I_EARLY + vcu * 8 + wid; it < I_TOTAL; it += nblk * 8) prep_witem(p, it, scr, lane); } }
#endif
    }
    SEAM(1);
    if (LO <= 2 && HI >= 2) REPEAT(2) {
        const Params p = ldp();
        float* tab = (float*)(smc + LDS_PRE);
#if KVCHAIN
        { int slot = 0;
          for (int u = vcu; u < PhQs::NU; u += nblk, ++slot) rs_table<384>(p.zq + (size_t)(u / 3) * 256 * 384, tab + slot * 256); }
        __syncthreads();
        gemm_stream(PhQs{p, tab, vcu, nblk}, shm, vcu, nblk);
#else
        if (nblk == 256) {
            const int nq = vcu < 128 ? 2 : 1, kbeg = vcu < 128 ? vcu : 128 + (vcu - 128) * 3, kend = vcu < 128 ? vcu + 1 : kbeg + 3;
            for (int i = 0; i < nq; ++i) rs_table<384>(p.zq + (size_t)((vcu + i * 256) / 3) * 256 * 384, tab + i * 256);
            for (int k = kbeg; k < kend; ++k) rs_table<256>(p.zkv + (size_t)(k >> 2) * 256 * 256, tab + (nq + k - kbeg) * 256);
            __syncthreads();
            gemm_stream(PhQs{p, tab, vcu, nblk}, shm, vcu, nblk);
            gemm_stream(PhKVb{p, tab, kbeg, kend, nq}, shm, kbeg, 1);
        } else {
        { int slot = 0;
          for (int u = vcu; u < PhKVs::NU; u += nblk, ++slot) {
              if (u < PhQs::NU) rs_table<384>(p.zq + (size_t)(u / 3) * 256 * 384, tab + slot * 256); else rs_table<256>(p.zkv + (size_t)((u - 384) >> 2) * 256 * 256, tab + slot * 256); } }
        __syncthreads();
        gemm_stream(PhQs{p, tab, vcu, nblk}, shm, vcu, nblk);
        { const int i0 = vcu >= PhQs::NU ? 0 : (PhQs::NU - vcu + nblk - 1) / nblk; gemm_stream(PhKVs{p, tab, vcu, nblk}, shm, vcu + i0 * nblk, nblk); }
        }
#endif
#if !GMLP_FUSED
        gmlp_phase(p, smc, vcu);
#endif
    }
    SEAM(2);
    if (LO <= 3 && HI >= 3) REPEAT(3) {
        const Params p = ldp();
#ifndef ATTPROBE
#define ATTPROBE 0
#endif
        for (int u = vcu; u < 256; u += nblk) { const int bh = u >> 2, pr = u & 3; attn_block<0>(p, smc, bh, 7 - pr, p.mix); attn_block<0>(p, smc, bh, pr, p.mix); }
    }
    SEAM(3);
    if (LO <= 4 && HI >= 4) {
#if XPROBE > 0
        gemm_phase(PhYp<XPROBE>{ldp()}, shm, vcu); xcd_barrier(xb);
#endif
#ifndef WARM4
#define WARM4 0
#endif
        if (WARM4) { const Params p = ldp(); PHASE_IDS;
            for (int u = vcu; u < 512; u += nblk) { const char* a = (const char*)(p.mix + (size_t)(u >> 2) * 256 * DM); unsigned acc_ = 0;
#pragma unroll
                for (int i = 0; i < 8; ++i) acc_ += *(const unsigned*)(a + ((size_t)(i * 512 + tid) << 7));
                asm volatile("" :: "v"(acc_)); } }
        gemm_phase(PhY{ldp()}, shm, vcu);
    }
    SEAM(4);
    if (LO <= 5 && HI >= 5) {
        const Params p = ldp();
        for (int tb = blockIdx.x; tb < T_TOK / 128; tb += nblk) router_tile(p, smc, tb);
    }
    SEAM(5);
    if (LO <= 6 && HI >= 6) REPEAT(6) {
        const Params p = ldp(); PHASE_IDS;
        moe_tables(p, smc);
        const int* tot = (const int*)(smc + LDS_TOT); int* aid_tab = (int*)(smc + LDS_AID); const unsigned short* pre = (const unsigned short*)(smc + LDS_PRE);
        if (blockIdx.x == 0 && tid < NEXP) p.cnt[tid] = tot[tid];
        { int slot = 0;
          for (int u = vcu; slot < 3; u += nblk, ++slot) {
              int e, rt, ct, pr; if (!moe_unit(tot, u, 2, e, rt, ct, pr)) break;
              const int te = tot[e];
              if (tid < 256) { const int g = rt * 256 + tid; int aid = 0;
                  if (g < te) { int lo = 0, hi = 256;
#pragma unroll
                      for (int it = 0; it < 8; ++it) { const int mid = (lo + hi) >> 1; if ((int)pre[e * 256 + mid] <= g) lo = mid; else hi = mid; }
                      aid = p.listb[((size_t)lo * NEXP + e) * 256 + (g - (int)pre[e * 256 + lo])];
                      if (ct == 0) { if (MERGE67) __hip_atomic_store(p.list + (size_t)e * LIST_CAP + g, aid, __ATOMIC_RELAXED, __HIP_MEMORY_SCOPE_AGENT); else p.list[(size_t)e * LIST_CAP + g] = aid; } }
                  aid_tab[slot * 256 + tid] = aid; } } }
        __syncthreads();
        gemm_stream(PhHs{p, tot, aid_tab, vcu, nblk, p.bar + 3712}, shm, vcu, nblk);
#if MERGE67
        { PhCs pc{p, tot, p.bar + 3712, 0, p.bar + 3648, (volatile int*)(smc + LDS_AID)}; pc.u0 = pc.take(false, 0); gemm_stream(pc, shm, pc.u0, nblk); }
#endif
    }
#if !MERGE67
    SEAM(6);
#else
    TSTAMP(7);
#endif
    if (!MERGE67 && LO <= 7 && HI >= 7) REPEAT(7) {
        Params p = ldp(); PHASE_IDS;
        int* tot = (int*)(smc + LDS_TOT);
        if (tid < NEXP) tot[tid] = p.cnt[tid];
        __syncthreads();
        p.cnt = tot;
        gemm_phase(PhC{p}, shm, vcu);
    }
    SEAM(7);
#ifndef WPROBE
#define WPROBE 0
#endif
    if (WPROBE > 0 && LO <= 8 && HI >= 8 && LO != HI) {
        const Params p = ldp(); PHASE_IDS;
        const int wr = wid >> 2, wc = wid & 3, fr = lane & 15, fq = lane >> 4;
        for (int u = vcu; u < 512; u += nblk) { const int pm = u >> 2, pn = u & 3;
            bf16_t* base = p.mix + (size_t)pm * 256 * DM + pn * 256;
#pragma unroll
            for (int ai = 0; ai < 2; ++ai)
#pragma unroll
                for (int m = 0; m < 4; ++m) { bf16_t* rowp = base + (size_t)(ai * 128 + wr * 64 + m * 16 + fr) * DM;
                    if (WPROBE == 1) { const u32x2 z = {0u, 0u};
                        *(u32x2*)(rowp + wc * 32 + 4 * fq) = z; *(u32x2*)(rowp + wc * 32 + 16 + 4 * fq) = z; *(u32x2*)(rowp + 128 + wc * 32 + 4 * fq) = z; *(u32x2*)(rowp + 128 + wc * 32 + 16 + 4 * fq) = z; }
                    else { const u32x4 z = {0u, 0u, 0u, 0u}; *(u32x4*)(rowp + wc * 64 + 16 * fq) = z; *(u32x4*)(rowp + wc * 64 + 16 * fq + 8) = z; } } }
        xcd_barrier(xb);
    }
    if (LO <= 8 && HI >= 8) REPEAT(8) { const Params p = ldp(); PHASE_IDS; for (int t = blockIdx.x * 8 + wid; t < T_TOK / 2; t += nblk * 8) final_token2(p, t, t + T_TOK / 2, lane); }
    if (TIMEPH >= 0 && LO != HI) {
        xcd_barrier(xb); TSTAMP(9);
        if (blockIdx.x == 0 && threadIdx.x < 64) { const Params p = ldp(); const float dv = (float)(ts1_ - ts0_) * 6.0e-5f; for (int i = threadIdx.x; i < 4096; i += 64) p.out[i] = dv; }
    }
    #undef SEAM
}

#if ATTPROBE > 0
__global__ __launch_bounds__(512, 2) void attn_probe_kernel(Params p) {
    extern __shared__ __attribute__((aligned(16))) unsigned char lds_raw[];
    char* smc = (char*)lds_raw; const int nblk = gridDim.x;
    const int vcu = (nblk % 8 == 0) ? (int)(blockIdx.x % 8) * (nblk / 8) + (int)(blockIdx.x / 8) : (int)blockIdx.x;
    for (int u = vcu; u < 256; u += nblk) { const int bh = u >> 2, pr = u & 3; attn_block<ATTPROBE>(p, smc, bh, 7 - pr, (bf16_t*)p.out); attn_block<ATTPROBE>(p, smc, bh, pr, (bf16_t*)p.out); }
}
#endif
#ifndef MODE
#ifndef MODE
#define MODE 1
#endif
#endif
#ifndef FASTMASK
#define FASTMASK 0x1ff
#endif
static size_t carve(size_t& off, size_t bytes) { const size_t o = off; off += (bytes + 255) & ~(size_t)255; return o; }
#ifndef DUPMASK
#define DUPMASK 0
#endif
template <int PH> static void launch_fast(const Params& p, int grid, hipStream_t stream) { hipLaunchKernelGGL((mega<PH, PH>), dim3(grid), dim3(NTHR), LDS_BYTES, stream, p);
    if ((DUPMASK >> PH) & 1) hipLaunchKernelGGL((mega<PH, PH>), dim3(grid), dim3(NTHR), LDS_BYTES, stream, p); }
extern "C" void kernel_launch(void* const* d_in, const int* in_sizes, int n_in, void* d_out, int out_size, void* d_ws, size_t ws_size, hipStream_t stream) {
    Params p{};
    p.x = (const float*)d_in[0]; p.pos = (const int*)d_in[1]; p.ln0_g = (const float*)d_in[2]; p.ln0_b = (const float*)d_in[3]; p.w_in = (const float*)d_in[4];
    p.gm_g = (const float*)d_in[5]; p.gm_b = (const float*)d_in[6]; p.w_sp = (const float*)d_in[7]; p.b_sp = (const float*)d_in[8]; p.qn_g = (const float*)d_in[9];
    p.w_uq = (const float*)d_in[10]; p.kvn_g = (const float*)d_in[11]; p.w_ukv = (const float*)d_in[12]; p.w_out = (const float*)d_in[13]; p.ln1_g = (const float*)d_in[14];
    p.ln1_b = (const float*)d_in[15]; p.w_rg = (const float*)d_in[16]; p.b_rg = (const float*)d_in[17]; p.w_re = (const float*)d_in[18]; p.b_re = (const float*)d_in[19];
    p.w_gate = (const float*)d_in[20]; p.w_up = (const float*)d_in[21]; p.w_down = (const float*)d_in[22]; p.ln2_g = (const float*)d_in[23]; p.ln2_b = (const float*)d_in[24];
    p.out = (float*)d_out;
    char* ws = (char*)d_ws; size_t off = 0;
    p.bar = (unsigned*)(ws + carve(off, 16384));
    p.cnt = (int*)(ws + carve(off, 1024));
    p.WinT = (bf16_t*)(ws + carve(off, (size_t)ZN * 1024 * 2)); p.WuqT = (bf16_t*)(ws + carve(off, 768 * 384 * 2)); p.WukvT = (bf16_t*)(ws + carve(off, 1024 * 256 * 2));
    p.WoutT = (bf16_t*)(ws + carve(off, 1024 * 1024 * 2)); p.WguT = (bf16_t*)(ws + carve(off, (size_t)32 * 512 * 1024 * 2)); p.WdT = (bf16_t*)(ws + carve(off, (size_t)32 * 1024 * 256 * 2));
    p.hbuf = (bf16_t*)(ws + carve(off, (size_t)T_TOK * DM * 2)); p.rope = (float2*)(ws + carve(off, (size_t)T_TOK * 32 * 8));
    p.list = (int*)(ws + carve(off, (size_t)NEXP * LIST_CAP * 4)); p.gates = (float*)(ws + carve(off, (size_t)T_TOK * 2 * 4));
    p.ystat = (float*)(ws + carve(off, (size_t)T_TOK * 32 * 4)); p.WrT = (bf16_t*)(ws + carve(off, 2 * 36 * 1024 * 2)); p.cntb = (int*)(ws + carve(off, 256 * NEXP * 4)); p.listb = (int*)(ws + carve(off, (size_t)256 * NEXP * 256 * 4));
    p.rsq = (float*)(ws + carve(off, T_TOK * 4)); p.rskv = (float*)(ws + carve(off, T_TOK * 4));
    const size_t stage0 = off;
    p.zu = (bf16_t*)(ws + carve(off, (size_t)T_TOK * 512 * 2)); p.zv = (bf16_t*)(ws + carve(off, (size_t)T_TOK * 512 * 2));
    p.zq = (bf16_t*)(ws + carve(off, (size_t)T_TOK * 384 * 2)); p.zkv = (bf16_t*)(ws + carve(off, (size_t)T_TOK * 256 * 2)); p.krope = (bf16_t*)(ws + carve(off, (size_t)T_TOK * 64 * 2));
    p.Q = (bf16_t*)(ws + carve(off, (size_t)T_TOK * 768 * 2)); p.Kn = (bf16_t*)(ws + carve(off, (size_t)T_TOK * 512 * 2)); p.Vt = (bf16_t*)(ws + carve(off, (size_t)T_TOK * 512 * 2));
    p.mix = (bf16_t*)(ws + carve(off, (size_t)T_TOK * DM * 2));
    const size_t stage_end = off;
    size_t o2 = stage0; p.contrib = (bf16_t*)(ws + carve(o2, (size_t)T_TOK * 2 * DM * 2)); p.H = (bf16_t*)(ws + carve(o2, (size_t)(65536 + 8192) * FF * 2));
    if (o2 > stage_end || stage_end > ws_size) { fprintf(stderr, "kernel_launch: workspace too small (%zu needed, %zu given)\n", stage_end, ws_size); return; }

    static int grid = 0;
    if (!grid) {
        int dev = 0, cus = 0; (void)hipGetDevice(&dev); (void)hipDeviceGetAttribute(&cus, hipDeviceAttributeMultiprocessorCount, dev);
        grid = cus > 0 ? (cus / 8) * 8 : 256;
        (void)hipFuncSetAttribute((const void*)nk_gmlp, hipFuncAttributeMaxDynamicSharedMemorySize, 128 * 129 * 4);
        (void)hipFuncSetAttribute((const void*)nk_attn, hipFuncAttributeMaxDynamicSharedMemorySize, (64 * 192 + 64 * 193 + 64 * 65 + 64 * 128) * 4);
        (void)hipFuncSetAttribute((const void*)mega<0, 8>, hipFuncAttributeMaxDynamicSharedMemorySize, LDS_BYTES);
#if MODE == 2
        (void)hipFuncSetAttribute((const void*)mega<0, 0>, hipFuncAttributeMaxDynamicSharedMemorySize, LDS_BYTES);
        (void)hipFuncSetAttribute((const void*)mega<1, 1>, hipFuncAttributeMaxDynamicSharedMemorySize, LDS_BYTES);
        (void)hipFuncSetAttribute((const void*)mega<2, 2>, hipFuncAttributeMaxDynamicSharedMemorySize, LDS_BYTES);
        (void)hipFuncSetAttribute((const void*)mega<3, 3>, hipFuncAttributeMaxDynamicSharedMemorySize, LDS_BYTES);
        (void)hipFuncSetAttribute((const void*)mega<4, 4>, hipFuncAttributeMaxDynamicSharedMemorySize, LDS_BYTES);
        (void)hipFuncSetAttribute((const void*)mega<5, 5>, hipFuncAttributeMaxDynamicSharedMemorySize, LDS_BYTES);
        (void)hipFuncSetAttribute((const void*)mega<6, 6>, hipFuncAttributeMaxDynamicSharedMemorySize, LDS_BYTES);
        (void)hipFuncSetAttribute((const void*)mega<7, 7>, hipFuncAttributeMaxDynamicSharedMemorySize, LDS_BYTES);
        (void)hipFuncSetAttribute((const void*)mega<8, 8>, hipFuncAttributeMaxDynamicSharedMemorySize, LDS_BYTES);
#endif
    }
#if MODE == 1
    (void)hipMemsetAsync(p.bar, 0, 16384, stream);
    hipLaunchKernelGGL((mega<0, 8>), dim3(grid), dim3(NTHR), LDS_BYTES, stream, p);
#else
    const unsigned fm = (MODE == 2) ? (unsigned)(FASTMASK) : 0u;
    if (fm & 1) launch_fast<0>(p, grid, stream); else { nk_prep_w<<<J_TOTAL, 256, 0, stream>>>(p); nk_ln0<<<T_TOK / 4, 256, 0, stream>>>(p); nk_rope<<<T_TOK * 32 / 256, 256, 0, stream>>>(p); }
    if (fm & 2) launch_fast<1>(p, grid, stream); else nk_gemm<PhZ><<<dim3(PhZ::NU, 32), 256, 0, stream>>>(PhZ{p});
#if defined(P2VAR) && P2VAR == 1
    launch_fast<2>(p, grid, stream); nk_gmlp<<<T_TOK / 128 * 4, 256, 128 * 129 * 4, stream>>>(p);
#elif defined(P2VAR) && P2VAR == 2
    nk_rowscale<<<T_TOK / 4, 256, 0, stream>>>(p); nk_gemm<PhQ><<<dim3(PhQ::NU, 32), 256, 0, stream>>>(PhQ{p, p.rsq});
    nk_gemm<PhKV><<<dim3(PhKV::NU, 32), 256, 0, stream>>>(PhKV{p, p.rskv}); launch_fast<2>(p, grid, stream);
#else
    if (fm & 4) launch_fast<2>(p, grid, stream); else { nk_rowscale<<<T_TOK / 4, 256, 0, stream>>>(p); nk_gemm<PhQ><<<dim3(PhQ::NU, 32), 256, 0, stream>>>(PhQ{p, p.rsq});
        nk_gemm<PhKV><<<dim3(PhKV::NU, 32), 256, 0, stream>>>(PhKV{p, p.rskv}); nk_gmlp<<<T_TOK / 128 * 4, 256, 128 * 129 * 4, stream>>>(p); }
#endif
#if ATTPROBE > 0
    { static bool a2 = false; if (!a2) { a2 = true; (void)hipFuncSetAttribute((const void*)attn_probe_kernel, hipFuncAttributeMaxDynamicSharedMemorySize, LDS_BYTES); }
      hipLaunchKernelGGL(attn_probe_kernel, dim3(grid), dim3(NTHR), LDS_BYTES, stream, p); }
#endif
    if (fm & 8) launch_fast<3>(p, grid, stream); else nk_attn<<<64 * 32, 256, (64 * 192 + 64 * 193 + 64 * 65 + 64 * 128) * 4, stream>>>(p);
    if (fm & 16) launch_fast<4>(p, grid, stream); else nk_gemm<PhY><<<dim3(PhY::NU, 32), 256, 0, stream>>>(PhY{p});
    if (fm & 32) launch_fast<5>(p, grid, stream); else { nk_router_prep<<<144, 256, 0, stream>>>(p); nk_router<<<T_TOK / 4, 256, 0, stream>>>(p); }
    if (fm & 64) launch_fast<6>(p, grid, stream); else nk_gemm<PhH><<<dim3(PhH::NU, 32), 256, 0, stream>>>(PhH{p});
    if (fm & 128) launch_fast<7>(p, grid, stream); else nk_gemm<PhC><<<dim3(PhC::NU, 32), 256, 0, stream>>>(PhC{p});
    if (fm & 256) launch_fast<8>(p, grid, stream); else nk_final<<<T_TOK / 4, 256, 0, stream>>>(p);
#endif
}
```

```cpp
#include <hip/hip_runtime.h>
#define P2VAR 0
#define REPMASK 0x0
#define DUPMASK 0x0
#define TIMEPH -1
#define KREP 1
#define XPROBE 0
#define P0REP 0
#define WPROBE 0
#define ATTPROBE 0
#define JIT_LN0 0
#define MERGE67 1
#define GMLP_FUSED 1
#define ZLAYOUT2 1
#define KVCHAIN 0
#define YSTAT 1
#define P1QUEUE 1
#define NT_IO 1
#include <stdint.h>
#include <cstdio>

#define LAS __attribute__((address_space(3)))
typedef unsigned short bf16_t;
typedef short bf16x8 __attribute__((ext_vector_type(8)));
typedef float f32x4 __attribute__((ext_vector_type(4)));
typedef float f32x16 __attribute__((ext_vector_type(16)));
typedef unsigned u32x2 __attribute__((ext_vector_type(2)));
typedef unsigned u32x4 __attribute__((ext_vector_type(4)));

constexpr int T_TOK = 32768, DM = 1024, SEQ = 2048, NBATCH = 16;
constexpr int ZN = 1792;
constexpr int NEXP = 32, FF = 256;
constexpr int LIST_CAP = 32768;
constexpr float ALPHA = 1.189207115002721f;
constexpr float QSCALE = 0.07216878364870322f * 1.4426950408889634f;

struct Params {
    const float* x; const int* pos; const float *ln0_g, *ln0_b, *w_in, *gm_g, *gm_b, *w_sp, *b_sp, *qn_g, *w_uq, *kvn_g, *w_ukv, *w_out, *ln1_g, *ln1_b,
        *w_rg, *b_rg, *w_re, *b_re, *w_gate, *w_up, *w_down, *ln2_g, *ln2_b;
    float* out;
    bf16_t *WinT, *WuqT, *WukvT, *WoutT, *WguT, *WdT;
    bf16_t* hbuf; float2* rope;
    bf16_t *zu, *zv, *zq, *zkv, *krope, *Q, *Kn, *Vt, *mix;
    float *rsq, *rskv;
    int* cnt; int* list; float* gates; bf16_t* H; bf16_t* contrib;
    float* ystat;
    bf16_t* WrT; int* cntb; int* listb;
    unsigned* bar;
};

__device__ __forceinline__ unsigned pk2(float lo, float hi) { unsigned r; asm volatile("v_cvt_pk_bf16_f32 %0, %1, %2" : "=v"(r) : "v"(lo), "v"(hi)); return r; }
__device__ __forceinline__ bf16_t f2bf(float f) { return (bf16_t)(pk2(f, 0.f) & 0xffffu); }
__device__ __forceinline__ float bf2f(bf16_t h) { return __uint_as_float(((unsigned)h) << 16); }
__device__ __forceinline__ float bflo(unsigned u) { return __uint_as_float(u << 16); }
__device__ __forceinline__ float bfhi(unsigned u) { return __uint_as_float(u & 0xffff0000u); }
__device__ __forceinline__ void st4(bf16_t* p, f32x4 v) { u32x2 w; w.x = pk2(v[0], v[1]); w.y = pk2(v[2], v[3]); *(u32x2*)p = w; }
__device__ __forceinline__ void st4wt(bf16_t* p, f32x4 v) { const unsigned lo = pk2(v[0], v[1]), hi = pk2(v[2], v[3]);
    __hip_atomic_store((unsigned long long*)p, ((unsigned long long)hi << 32) | lo, __ATOMIC_RELAXED, __HIP_MEMORY_SCOPE_AGENT); }
__device__ __forceinline__ float shx(float v, int mask) { int l = threadIdx.x; asm volatile("" : "+v"(l)); const int idx = ((l ^ mask) & 63) << 2; return __int_as_float(__builtin_amdgcn_ds_bpermute(idx, __float_as_int(v))); }
__device__ __forceinline__ float wave_sum(float v) {
#pragma unroll
    for (int o = 1; o < 64; o <<= 1) v += shx(v, o);
    return v;
}
__device__ __forceinline__ float gelu_tanh(float x) {
    const float u = x + 0.044715f * x * x * x;
    const float e = __builtin_amdgcn_exp2f(-2.f * 0.7978845608028654f * 1.4426950408889634f * u);
    return x * __builtin_amdgcn_rcpf(1.f + e);
}
__device__ __forceinline__ float silu_f(float x) { return x * __builtin_amdgcn_rcpf(1.f + __builtin_amdgcn_exp2f(-1.4426950408889634f * x)); }
__device__ __forceinline__ int perm16(int k) { return 8 * ((k >> 2) & 1) + (k & 3) + 4 * (k >> 3); }

struct AMap {
    const bf16_t* base; int ld; const int* list; int nvalid;
    __device__ __forceinline__ const bf16_t* row(int r) const {
        if (list) { const int a = list[r < nvalid ? r : 0]; return base + (size_t)(a >> 1) * ld; }
        return base + (size_t)r * ld;
    }
};

struct EpiZ {
    bf16_t *zu, *zv, *zq, *zkv, *krope; const float2* rope; int row0, col0;
    __device__ __forceinline__ void rope_store(int row, int c, f32x4 v, float2 cs0, float2 cs1) const {
        const int i0 = (c - 1664) >> 1; bf16_t* kr = krope + (size_t)row * 64;
        kr[i0] = f2bf(v[0] * cs0.x - v[1] * cs0.y); kr[i0 + 32] = f2bf(v[1] * cs0.x + v[0] * cs0.y);
        kr[i0 + 1] = f2bf(v[2] * cs1.x - v[3] * cs1.y); kr[i0 + 33] = f2bf(v[3] * cs1.x + v[2] * cs1.y);
    }
    __device__ __forceinline__ void plain(int row, int c, f32x4 v) const {
        if (c < 1024) {
            f32x4 g; g[0] = gelu_tanh(v[0]); g[1] = gelu_tanh(v[1]); g[2] = gelu_tanh(v[2]); g[3] = gelu_tanh(v[3]);
            if (c < 512) st4(zu + (size_t)row * 512 + c, g); else st4(zv + (size_t)row * 512 + (c - 512), g);
        }
#if ZLAYOUT2
        else if (c < 1280) st4(zkv + (size_t)row * 256 + (c - 1024), v);
        else if (c < 1536) st4(zq + (size_t)row * 384 + (c - 1280), v);
        else if (c < 1664) st4(zq + (size_t)row * 384 + 256 + (c - 1536), v);
#else
        else if (c < 1408) st4(zq + (size_t)row * 384 + (c - 1024), v);
        else if (c < 1664) st4(zkv + (size_t)row * 256 + (c - 1408), v);
#endif
    }
    __device__ __forceinline__ void half(int row, int c, f32x4 v) const {
        if (c < 1664) plain(row, c, v);
        else if (c < 1728) { const int i0 = (c - 1664) >> 1; rope_store(row, c, v, rope[(size_t)row * 32 + i0], rope[(size_t)row * 32 + i0 + 1]); }
    }
    __device__ __forceinline__ void operator()(int r, int c32, int fq, f32x4 a, f32x4 b) const { const int row = row0 + r, c = col0 + c32 + 4 * fq; half(row, c, a); half(row, c + 16, b); }
    struct Ctx { float2 cs[4]; }; static constexpr int BATCH4 = 1;
    __device__ __forceinline__ bool is_rope(int c32) const { const int c = col0 + c32 + HALF_COLS; return c >= 1664 && c < 1728; }
    static constexpr int HALF_COLS = 128;
    __device__ __forceinline__ Ctx pre(int r, int c32, int fq) const { Ctx x;
        if (is_rope(c32)) { const int i0 = (col0 + c32 + 128 + 4 * fq - 1664) >> 1; const float2* rp = rope + (size_t)(row0 + r) * 32 + i0; x.cs[0] = rp[0]; x.cs[1] = rp[1]; x.cs[2] = rp[8]; x.cs[3] = rp[9]; }
        else { x.cs[0] = x.cs[1] = x.cs[2] = x.cs[3] = make_float2(0.f, 0.f); }
        return x; }
    __device__ __forceinline__ void post(int r, int c32, int fq, const Ctx& x, f32x4 a0, f32x4 b0, f32x4 a1, f32x4 b1) const {
        const int row = row0 + r, c = col0 + c32 + 4 * fq;
        plain(row, c, a0); plain(row, c + 16, b0);
        if (is_rope(c32)) { rope_store(row, c + 128, a1, x.cs[0], x.cs[1]); rope_store(row, c + 144, b1, x.cs[2], x.cs[3]); }
        else if (c + 128 < 1664) { plain(row, c + 128, a1); plain(row, c + 144, b1); }
    }
};
struct EpiQ {
    bf16_t* Q; const float* rs; int rs0; int row0, col0;
    __device__ __forceinline__ void half(int row, int c, f32x4 v, float sc) const {
        const int h = c / 192, d = c - h * 192, b = row >> 11, s = row & 2047;
        st4(Q + ((size_t)((b * 4 + h) * SEQ + s)) * 192 + d, v * sc);
    }
    __device__ __forceinline__ void operator()(int r, int c32, int fq, f32x4 a, f32x4 b) const {
        const int row = row0 + r, c = col0 + c32 + 4 * fq; const float sc = rs[row - rs0] * QSCALE; half(row, c, a, sc); half(row, c + 16, b, sc); }
    struct Ctx { float sc; };
    __device__ __forceinline__ Ctx pre(int r, int c32, int fq) const { Ctx x; x.sc = rs[row0 + r - rs0] * QSCALE; return x; }
    __device__ __forceinline__ void post(int r, int c32, int fq, const Ctx& x, f32x4 a0, f32x4 b0, f32x4 a1, f32x4 b1) const {
        const int row = row0 + r, c = col0 + c32 + 4 * fq; half(row, c, a0, x.sc); half(row, c + 16, b0, x.sc); half(row, c + 128, a1, x.sc); half(row, c + 144, b1, x.sc); }
};
struct EpiKV {
    bf16_t *Kn, *Vt; const float* rs; int rs0; int row0, col0;
    __device__ __forceinline__ void half(int row, int c, f32x4 v, float sc) const {
        const int h = c >> 8, e = c & 255, b = row >> 11, s = row & 2047;
        v = v * sc;
        if (e < 128) st4(Kn + ((size_t)((b * 4 + h) * SEQ + s)) * 128 + e, v);
        else {
            bf16_t* vt = Vt + ((size_t)((b * 4 + h) * 128 + (e - 128))) * SEQ + (s & ~15) + perm16(s & 15);
            vt[0] = f2bf(v[0]); vt[SEQ] = f2bf(v[1]); vt[2 * SEQ] = f2bf(v[2]); vt[3 * SEQ] = f2bf(v[3]);
        }
    }
    __device__ __forceinline__ void operator()(int r, int c32, int fq, f32x4 a, f32x4 b) const {
        const int row = row0 + r, c = col0 + c32 + 4 * fq; const float sc = rs[row - rs0]; half(row, c, a, sc); half(row, c + 16, b, sc); }
    struct Ctx { float sc; };
    __device__ __forceinline__ Ctx pre(int r, int c32, int fq) const { Ctx x; x.sc = rs[row0 + r - rs0]; return x; }
    __device__ __forceinline__ void post(int r, int c32, int fq, const Ctx& x, f32x4 a0, f32x4 b0, f32x4 a1, f32x4 b1) const {
        const int row = row0 + r, c = col0 + c32 + 4 * fq; half(row, c, a0, x.sc); half(row, c + 16, b0, x.sc); half(row, c + 128, a1, x.sc); half(row, c + 144, b1, x.sc); }
};
struct EpiY {
    bf16_t* hb; int row0, col0; float* ystat;
    __device__ __forceinline__ void fin(bf16_t* p, u32x2 h, f32x4 v) const {
        v[0] += ALPHA * bflo(h.x); v[1] += ALPHA * bfhi(h.x); v[2] += ALPHA * bflo(h.y); v[3] += ALPHA * bfhi(h.y); st4(p, v); }
    __device__ __forceinline__ void fin2(bf16_t* p, u32x2 h, f32x4 v, float& s, float& q) const {
        v[0] += ALPHA * bflo(h.x); v[1] += ALPHA * bfhi(h.x); v[2] += ALPHA * bflo(h.y); v[3] += ALPHA * bfhi(h.y); st4(p, v);
        s += (v[0] + v[1]) + (v[2] + v[3]); q += (v[0] * v[0] + v[1] * v[1]) + (v[2] * v[2] + v[3] * v[3]); }
    __device__ __forceinline__ void half(int row, int c, f32x4 v) const { bf16_t* p = hb + (size_t)row * DM + c; fin(p, *(const u32x2*)p, v); }
    __device__ __forceinline__ void operator()(int r, int c32, int fq, f32x4 a, f32x4 b) const { const int row = row0 + r, c = col0 + c32 + 4 * fq; half(row, c, a); half(row, c + 16, b); }
    struct Ctx { u32x2 h[4]; }; static constexpr int BATCH4 = 1;
    __device__ __forceinline__ Ctx pre(int r, int c32, int fq) const { Ctx x; const bf16_t* p = hb + (size_t)(row0 + r) * DM + col0 + c32 + 4 * fq;
        x.h[0] = *(const u32x2*)p; x.h[1] = *(const u32x2*)(p + 16); x.h[2] = *(const u32x2*)(p + 128); x.h[3] = *(const u32x2*)(p + 144); return x; }
    __device__ __forceinline__ void post(int r, int c32, int fq, const Ctx& x, f32x4 a0, f32x4 b0, f32x4 a1, f32x4 b1) const {
        bf16_t* p = hb + (size_t)(row0 + r) * DM + col0 + c32 + 4 * fq;
        if (ystat) { float s = 0.f, q = 0.f; fin2(p, x.h[0], a0, s, q); fin2(p + 16, x.h[1], b0, s, q); fin2(p + 128, x.h[2], a1, s, q); fin2(p + 144, x.h[3], b1, s, q);
            s += shx(s, 16); s += shx(s, 32); q += shx(q, 16); q += shx(q, 32);
            if (fq == 0) { typedef float f32x2 __attribute__((ext_vector_type(2))); *(f32x2*)(ystat + ((size_t)(row0 + r) * 16 + (col0 >> 6) + (c32 >> 5)) * 2) = (f32x2){s, q}; } }
        else { fin(p, x.h[0], a0); fin(p + 16, x.h[1], b0); fin(p + 128, x.h[2], a1); fin(p + 144, x.h[3], b1); } }
};
struct EpiH {
    bf16_t* H; int hrow0, col0; bool wt;
    __device__ __forceinline__ void operator()(int r, int c32, int fq, f32x4 a, f32x4 b) const {
        const int hid = ((col0 + c32) >> 5) * 16 + 4 * fq;
        f32x4 o; o[0] = silu_f(a[0]) * b[0]; o[1] = silu_f(a[1]) * b[1]; o[2] = silu_f(a[2]) * b[2]; o[3] = silu_f(a[3]) * b[3];
        if (wt) st4wt(H + (size_t)(hrow0 + r) * FF + hid, o); else st4(H + (size_t)(hrow0 + r) * FF + hid, o);
    }
    struct Ctx { int dummy; };
    __device__ __forceinline__ Ctx pre(int, int, int) const { Ctx x; x.dummy = 0; return x; }
    __device__ __forceinline__ void post(int r, int c32, int fq, const Ctx&, f32x4 a0, f32x4 b0, f32x4 a1, f32x4 b1) const { (*this)(r, c32, fq, a0, b0); (*this)(r, c32 + 128, fq, a1, b1); }
};
struct EpiC {
    bf16_t* contrib; const int* list; const float* gates; int nvalid; int col0;
    __device__ __forceinline__ void operator()(int r, int c32, int fq, f32x4 a, f32x4 b) const {
        if (r >= nvalid) return;
        const int aid = list[r]; const float g = gates[aid];
        char* p = (char*)contrib + ((unsigned)aid * (unsigned)(DM * 2) + (unsigned)((col0 + c32 + 4 * fq) * 2));
        u32x2 w; w.x = pk2(a[0] * g, a[1] * g); w.y = pk2(a[2] * g, a[3] * g); *(u32x2*)p = w;
        w.x = pk2(b[0] * g, b[1] * g); w.y = pk2(b[2] * g, b[3] * g); *(u32x2*)(p + 32) = w;
    }
    struct Ctx { int aid; float g; };
    __device__ __forceinline__ Ctx pre(int r, int, int) const { Ctx x; x.aid = r < nvalid ? list[r] : -1; x.g = 0.f; return x; }
    __device__ __forceinline__ void pre2(Ctx& x) const { if (x.aid >= 0) x.g = gates[x.aid]; }
    __device__ __forceinline__ void post(int r, int c32, int fq, const Ctx& x, f32x4 a0, f32x4 b0, f32x4 a1, f32x4 b1) const {
        if (x.aid < 0) return;
        const float g = x.g;
        char* p = (char*)contrib + ((unsigned)x.aid * (unsigned)(DM * 2) + (unsigned)((col0 + c32 + 4 * fq) * 2));
        u32x2 w; w.x = pk2(a0[0] * g, a0[1] * g); w.y = pk2(a0[2] * g, a0[3] * g); *(u32x2*)p = w;
        w.x = pk2(b0[0] * g, b0[1] * g); w.y = pk2(b0[2] * g, b0[3] * g); *(u32x2*)(p + 32) = w;
        w.x = pk2(a1[0] * g, a1[1] * g); w.y = pk2(a1[2] * g, a1[3] * g); *(u32x2*)(p + 256) = w;
        w.x = pk2(b1[0] * g, b1[1] * g); w.y = pk2(b1[2] * g, b1[3] * g); *(u32x2*)(p + 288) = w;
    }
};

template <class EP> struct Unit { AMap am; const bf16_t* bt; int K; EP ep; };

__device__ __forceinline__ bool moe_unit(const int* cnt, int u, int ncol, int& e, int& rt, int& ct, int& padrow) {
    int acc = 0, fe = -1, facc = 0;
#pragma unroll 4
    for (int i = 0; i < NEXP; ++i) {
        const int t = (cnt[i] + 255) >> 8;
        if (fe < 0 && u < (acc + t) * ncol) { fe = i; facc = acc; }
        acc += t;
    }
    fe = __builtin_amdgcn_readfirstlane(fe); facc = __builtin_amdgcn_readfirstlane(facc);
    if (fe < 0) return false;
    const int w = u - facc * ncol; e = fe; rt = w / ncol; ct = w - rt * ncol; padrow = (facc + rt) * 256;
    return true;
}

struct PhZ { Params p; typedef EpiZ EP; static constexpr int NU = 128 * 7;
    __device__ __forceinline__ bool unit(int u, Unit<EP>& o) const { const int pm = u / 7, pn = u - pm * 7;
        o.am = AMap{p.hbuf + (size_t)pm * 256 * DM, DM, nullptr, 256}; o.bt = p.WinT + (size_t)pn * 256 * DM; o.K = DM;
        o.ep = EpiZ{p.zu, p.zv, p.zq, p.zkv, p.krope, p.rope, pm * 256, pn * 256}; return true; } };
struct PhQ { Params p; const float* rs; typedef EpiQ EP; static constexpr int NU = 128 * 3;
    __device__ __forceinline__ bool unit(int u, Unit<EP>& o) const { const int pm = u / 3, pn = u - pm * 3;
        o.am = AMap{p.zq + (size_t)pm * 256 * 384, 384, nullptr, 256}; o.bt = p.WuqT + (size_t)pn * 256 * 384; o.K = 384;
        o.ep = EpiQ{p.Q, rs, 0, pm * 256, pn * 256}; return true; } };
struct PhKV { Params p; const float* rs; typedef EpiKV EP; static constexpr int NU = 128 * 4;
    __device__ __forceinline__ bool unit(int u, Unit<EP>& o) const { const int pm = u >> 2, pn = u & 3;
        o.am = AMap{p.zkv + (size_t)pm * 256 * 256, 256, nullptr, 256}; o.bt = p.WukvT + (size_t)pn * 256 * 256; o.K = 256;
        o.ep = EpiKV{p.Kn, p.Vt, rs, 0, pm * 256, pn * 256}; return true; } };
struct PhY { Params p; typedef EpiY EP; static constexpr int NU = 128 * 4;
    __device__ __forceinline__ bool unit(int u, Unit<EP>& o) const { const int pm = u >> 2, pn = u & 3;
        o.am = AMap{p.mix + (size_t)pm * 256 * DM, DM, nullptr, 256}; o.bt = p.WoutT + (size_t)pn * 256 * DM; o.K = DM;
        o.ep = EpiY{p.hbuf, pm * 256, pn * 256, YSTAT ? p.ystat : nullptr}; return true; } };
struct PhH { Params p; typedef EpiH EP; static constexpr int NU = 288 * 2;
    __device__ __forceinline__ bool unit(int u, Unit<EP>& o) const { int e, rt, ct, pr; if (!moe_unit(p.cnt, u, 2, e, rt, ct, pr)) return false;
        const int nv = __builtin_amdgcn_readfirstlane(min(256, p.cnt[e] - rt * 256));
        o.am = AMap{p.hbuf, DM, p.list + (size_t)e * LIST_CAP + rt * 256, nv}; o.bt = p.WguT + ((size_t)e * 512 + ct * 256) * DM; o.K = DM;
        o.ep = EpiH{p.H, pr, ct * 256, false}; return true; } };
struct PhC { Params p; typedef EpiC EP; static constexpr int NU = 288 * 4;
    __device__ __forceinline__ bool unit(int u, Unit<EP>& o) const { int e, rt, ct, pr; if (!moe_unit(p.cnt, u, 4, e, rt, ct, pr)) return false;
        const int nv = __builtin_amdgcn_readfirstlane(min(256, p.cnt[e] - rt * 256));
        o.am = AMap{p.H + (size_t)pr * FF, FF, nullptr, 256}; o.bt = p.WdT + ((size_t)e * DM + ct * 256) * FF; o.K = FF;
        o.ep = EpiC{p.contrib, p.list + (size_t)e * LIST_CAP + rt * 256, p.gates, nv, ct * 256}; return true; } };


template <int XMODE> struct EpiProbe {
    const bf16_t* hb; bf16_t* ob; int row0, col0;
    __device__ __forceinline__ void operator()(int, int, int, f32x4, f32x4) const {}
    struct Ctx { u32x2 h[4]; };
    __device__ __forceinline__ Ctx pre(int r, int c32, int fq) const { Ctx x; const bf16_t* p = hb + (size_t)(row0 + r) * DM + col0 + c32 + 4 * fq;
        if (XMODE == 1) { x.h[0] = *(const u32x2*)p; x.h[1] = *(const u32x2*)(p + 16); x.h[2] = *(const u32x2*)(p + 128); x.h[3] = *(const u32x2*)(p + 144); }
        else { x.h[0] = x.h[1] = x.h[2] = x.h[3] = (u32x2){0u, 0u}; }
        return x; }
    __device__ __forceinline__ void fin(bf16_t* p, u32x2 h, f32x4 v) const {
        v[0] += ALPHA * bflo(h.x); v[1] += ALPHA * bfhi(h.x); v[2] += ALPHA * bflo(h.y); v[3] += ALPHA * bfhi(h.y); st4(p, v); }
    __device__ __forceinline__ void post(int r, int c32, int fq, const Ctx& x, f32x4 a0, f32x4 b0, f32x4 a1, f32x4 b1) const {
        if (XMODE == 2) { asm volatile("" :: "v"(a0), "v"(b0), "v"(a1), "v"(b1)); return; }
        if (XMODE == 4) {
            bf16_t* q = ob + (size_t)(row0 + r) * DM + col0 + (c32 >> 5) * 64 + 16 * fq; u32x4 w0, w1;
            w0.x = pk2(a0[0], a0[1]); w0.y = pk2(a0[2], a0[3]); w0.z = pk2(b0[0], b0[1]); w0.w = pk2(b0[2], b0[3]);
            w1.x = pk2(a1[0], a1[1]); w1.y = pk2(a1[2], a1[3]); w1.z = pk2(b1[0], b1[1]); w1.w = pk2(b1[2], b1[3]);
            *(u32x4*)q = w0; *(u32x4*)(q + 8) = w1; return; }
        bf16_t* p = ob + (size_t)(row0 + r) * DM + col0 + c32 + 4 * fq; fin(p, x.h[0], a0); fin(p + 16, x.h[1], b0); fin(p + 128, x.h[2], a1); fin(p + 144, x.h[3], b1); }
};
template <int XMODE> struct PhYp { Params p; typedef EpiProbe<XMODE> EP; static constexpr int NU = 128 * 4;
    __device__ __forceinline__ bool unit(int u, Unit<EP>& o) const { const int pm = u >> 2, pn = u & 3;
        o.am = AMap{p.mix + (size_t)pm * 256 * DM, DM, nullptr, 256}; o.bt = p.WoutT + (size_t)pn * 256 * DM; o.K = DM;
        o.ep = EP{p.hbuf, p.contrib, pm * 256, pn * 256}; return true; } };

__device__ __forceinline__ void wtile(const float* s0, const float* s1, int ldsrc, bf16_t* dst, int K, int k0, int n0, int mode, const float* kscale, float* tile, int tid, int nthr) {
    for (int idx = tid; idx < 4096; idx += nthr) {
        const int kk = idx >> 6, n = n0 + (idx & 63);
        const float* s = s0; int col = n;
        if (mode == 1) { if (n >= 1728) col = -1; else if (n >= 1664) { const int i = (n - 1664) >> 1, pp = (n - 1664) & 1; col = 1664 + i + 32 * pp; } }
        else if (mode == 2) { const int h = n / 192, d = n - h * 192; if (d >= 128) { const int i = (d - 128) >> 1, pp = (d - 128) & 1; col = h * 192 + 128 + i + 32 * pp; } }
        else if (mode == 3) { const int G = n >> 5, r = n & 31; col = 16 * G + (r & 15); s = (r < 16) ? s0 : s1; }
        float v = 0.f;
        if (col >= 0) { v = s[(size_t)(k0 + kk) * ldsrc + col]; if (kscale) v *= kscale[k0 + kk]; }
        tile[kk * 65 + (idx & 63)] = v;
    }
    __syncthreads();
    for (int idx = tid; idx < 4096; idx += nthr) {
        const int nn = idx >> 6, kk = idx & 63;
        dst[(size_t)(n0 + nn) * K + k0 + kk] = f2bf(tile[kk * 65 + nn]);
    }
    __syncthreads();
}
constexpr int J_IN = 28 * 16, J_UQ = 12 * 6, J_UKV = 16 * 4, J_OUT = 16 * 16, J_GU = 32 * 8 * 16, J_DN = 32 * 16 * 4;
constexpr int J_TOTAL = J_IN + J_UQ + J_UKV + J_OUT + J_GU + J_DN;
__device__ __forceinline__ void prep_wjob(const Params& p, int job, float* tile, int tid, int nthr) {
    if (job < J_IN) { const int nb = job >> 4, kb = job & 15; wtile(p.w_in, nullptr, 1728, p.WinT, 1024, kb * 64, nb * 64, 1, nullptr, tile, tid, nthr); return; } job -= J_IN;
    if (job < J_UQ) { const int nb = job / 6, kb = job - nb * 6; wtile(p.w_uq, nullptr, 768, p.WuqT, 384, kb * 64, nb * 64, 0, p.qn_g, tile, tid, nthr); return; } job -= J_UQ;
    if (job < J_UKV) { const int nb = job >> 2, kb = job & 3; wtile(p.w_ukv, nullptr, 1024, p.WukvT, 256, kb * 64, nb * 64, 0, p.kvn_g, tile, tid, nthr); return; } job -= J_UKV;
    if (job < J_OUT) { const int nb = job >> 4, kb = job & 15; wtile(p.w_out, nullptr, 1024, p.WoutT, 1024, kb * 64, nb * 64, 0, nullptr, tile, tid, nthr); return; } job -= J_OUT;
    if (job < J_GU) { const int e = job >> 7, r = job & 127, nb = r >> 4, kb = r & 15;
        wtile(p.w_gate + (size_t)e * 1024 * 256, p.w_up + (size_t)e * 1024 * 256, 256, p.WguT + (size_t)e * 512 * 1024, 1024, kb * 64, nb * 64, 3, nullptr, tile, tid, nthr); return; } job -= J_GU;
    { const int e = job >> 6, r = job & 63, nb = r >> 2, kb = r & 3;
        wtile(p.w_down + (size_t)e * 256 * 1024, nullptr, 1024, p.WdT + (size_t)e * 1024 * 256, 256, kb * 64, nb * 64, 0, nullptr, tile, tid, nthr); }
}
__device__ __forceinline__ void ln0_row(const float* xr, const float* g, const float* b, bf16_t* orow, int lane) {
    f32x4 v[4]; float s = 0.f;
#pragma unroll
    for (int j = 0; j < 4; ++j) { v[j] = *(const f32x4*)(xr + 256 * j + 4 * lane); s += (v[j][0] + v[j][1]) + (v[j][2] + v[j][3]); }
    const float mean = wave_sum(s) * (1.f / 1024.f); float s2 = 0.f;
#pragma unroll
    for (int j = 0; j < 4; ++j) { v[j] = v[j] - mean; s2 += (v[j][0] * v[j][0] + v[j][1] * v[j][1]) + (v[j][2] * v[j][2] + v[j][3] * v[j][3]); }
    const float rstd = 1.f / sqrtf(wave_sum(s2) * (1.f / 1024.f) + 1e-5f);
#pragma unroll
    for (int j = 0; j < 4; ++j) { const f32x4 gg = *(const f32x4*)(g + 256 * j + 4 * lane), bb = *(const f32x4*)(b + 256 * j + 4 * lane);
        st4(orow + 256 * j + 4 * lane, v[j] * rstd * gg + bb); }
}
__device__ __forceinline__ void rope_entry(const Params& p, int idx) {
    const int t = idx >> 5, i = idx & 31;
    const float inv = powf(10000.f, -(float)(2 * i) / 64.f);
    const float ang = (float)p.pos[t] * inv;
    p.rope[idx] = make_float2(cosf(ang), sinf(ang));
}

__device__ __forceinline__ void router_token(const Params& p, int t, int lane, const float* wr  , int wstride) {
    bf16_t* hr = p.hbuf + (size_t)t * DM;
    f32x4 v[4]; float s = 0.f;
#pragma unroll
    for (int j = 0; j < 4; ++j) { const u32x2 w = *(const u32x2*)(hr + 256 * j + 4 * lane); v[j][0] = bflo(w.x); v[j][1] = bfhi(w.x); v[j][2] = bflo(w.y); v[j][3] = bfhi(w.y);
        s += (v[j][0] + v[j][1]) + (v[j][2] + v[j][3]); }
    const float mean = wave_sum(s) * (1.f / 1024.f); float s2 = 0.f;
#pragma unroll
    for (int j = 0; j < 4; ++j) { v[j] = v[j] - mean; s2 += (v[j][0] * v[j][0] + v[j][1] * v[j][1]) + (v[j][2] * v[j][2] + v[j][3] * v[j][3]); }
    const float rstd = 1.f / sqrtf(wave_sum(s2) * (1.f / 1024.f) + 1e-5f);
#pragma unroll
    for (int j = 0; j < 4; ++j) { const f32x4 gg = *(const f32x4*)(p.ln1_g + 256 * j + 4 * lane), bb = *(const f32x4*)(p.ln1_b + 256 * j + 4 * lane);
        v[j] = v[j] * rstd * gg + bb; st4(hr + 256 * j + 4 * lane, v[j]); }
    float lg[36];
#pragma unroll
    for (int o = 0; o < 36; ++o) { float a = 0.f;
#pragma unroll
        for (int j = 0; j < 4; ++j) { const f32x4 w = *(const f32x4*)(wr + o * wstride + 256 * j + 4 * lane); a += (v[j][0] * w[0] + v[j][1] * w[1]) + (v[j][2] * w[2] + v[j][3] * w[3]); }
        lg[o] = wave_sum(a); }
#pragma unroll
    for (int o = 0; o < 4; ++o) lg[o] += p.b_rg[o];
#pragma unroll
    for (int o = 0; o < 32; ++o) lg[4 + o] += p.b_re[o];
    int g = 0; float gm = lg[0];
#pragma unroll
    for (int i = 1; i < 4; ++i) if (lg[i] > gm) { gm = lg[i]; g = i; }
    float se = 0.f;
#pragma unroll
    for (int i = 0; i < 4; ++i) se += expf(lg[i] - gm);
    const float pg = 1.f / se;
    float ev[8];
#pragma unroll
    for (int e = 0; e < 8; ++e) ev[e] = g == 0 ? lg[4 + e] : g == 1 ? lg[12 + e] : g == 2 ? lg[20 + e] : lg[28 + e];
    int i1 = 0; float v1 = ev[0];
#pragma unroll
    for (int e = 1; e < 8; ++e) if (ev[e] > v1) { v1 = ev[e]; i1 = e; }
    int i2 = -1; float v2 = -3.0e38f;
#pragma unroll
    for (int e = 0; e < 8; ++e) if (e != i1 && ev[e] > v2) { v2 = ev[e]; i2 = e; }
    const float d = expf(v2 - v1), g1 = pg / (1.f + d), g2 = pg * d / (1.f + d);
    if (lane < 2) {
        const int ex = g * 8 + (lane == 0 ? i1 : i2), aid = 2 * t + lane;
        const int slot = atomicAdd(p.cnt + ex, 1);
        p.list[(size_t)ex * LIST_CAP + slot] = aid;
        p.gates[aid] = lane == 0 ? g1 : g2;
    }
}
__device__ __forceinline__ void final_token(const Params& p, int t, int lane) {
    const bf16_t* hr = p.hbuf + (size_t)t * DM; const bf16_t* c0 = p.contrib + (size_t)(2 * t) * DM; const bf16_t* c1 = c0 + DM;
    f32x4 v[4]; float s = 0.f;
#pragma unroll
    for (int j = 0; j < 4; ++j) { const int o = 256 * j + 4 * lane; const u32x2 w = *(const u32x2*)(hr + o), a = *(const u32x2*)(c0 + o), b = *(const u32x2*)(c1 + o);
        v[j][0] = ALPHA * bflo(w.x) + bflo(a.x) + bflo(b.x); v[j][1] = ALPHA * bfhi(w.x) + bfhi(a.x) + bfhi(b.x);
        v[j][2] = ALPHA * bflo(w.y) + bflo(a.y) + bflo(b.y); v[j][3] = ALPHA * bfhi(w.y) + bfhi(a.y) + bfhi(b.y);
        s += (v[j][0] + v[j][1]) + (v[j][2] + v[j][3]); }
    const float mean = wave_sum(s) * (1.f / 1024.f); float s2 = 0.f;
#pragma unroll
    for (int j = 0; j < 4; ++j) { v[j] = v[j] - mean; s2 += (v[j][0] * v[j][0] + v[j][1] * v[j][1]) + (v[j][2] * v[j][2] + v[j][3] * v[j][3]); }
    const float rstd = 1.f / sqrtf(wave_sum(s2) * (1.f / 1024.f) + 1e-5f);
#pragma unroll
    for (int j = 0; j < 4; ++j) { const int o = 256 * j + 4 * lane; const f32x4 gg = *(const f32x4*)(p.ln2_g + o), bb = *(const f32x4*)(p.ln2_b + o);
        *(f32x4*)(p.out + (size_t)t * DM + o) = v[j] * rstd * gg + bb; }
}


__device__ __forceinline__ void final_token2(const Params& p, int t0, int t1, int lane) {
    f32x4 v[2][4]; float s[2] = {0.f, 0.f}, q[2] = {0.f, 0.f};
    u32x2 w[2][4], a[2][4], b[2][4];
#pragma unroll
    for (int k = 0; k < 2; ++k) { const int t = k ? t1 : t0; const bf16_t* hr = p.hbuf + (size_t)t * DM; const bf16_t* c0 = p.contrib + (size_t)(2 * t) * DM; const bf16_t* c1 = c0 + DM;
#pragma unroll
        for (int j = 0; j < 4; ++j) { const int o = 256 * j + 4 * lane;
            if (NT_IO) { w[k][j] = __builtin_nontemporal_load((const u32x2*)(hr + o)); a[k][j] = __builtin_nontemporal_load((const u32x2*)(c0 + o)); b[k][j] = __builtin_nontemporal_load((const u32x2*)(c1 + o)); }
            else { w[k][j] = *(const u32x2*)(hr + o); a[k][j] = *(const u32x2*)(c0 + o); b[k][j] = *(const u32x2*)(c1 + o); } } }
#pragma unroll
    for (int k = 0; k < 2; ++k)
#pragma unroll
        for (int j = 0; j < 4; ++j) {
            v[k][j][0] = ALPHA * bflo(w[k][j].x) + bflo(a[k][j].x) + bflo(b[k][j].x); v[k][j][1] = ALPHA * bfhi(w[k][j].x) + bfhi(a[k][j].x) + bfhi(b[k][j].x);
            v[k][j][2] = ALPHA * bflo(w[k][j].y) + bflo(a[k][j].y) + bflo(b[k][j].y); v[k][j][3] = ALPHA * bfhi(w[k][j].y) + bfhi(a[k][j].y) + bfhi(b[k][j].y);
            s[k] += (v[k][j][0] + v[k][j][1]) + (v[k][j][2] + v[k][j][3]);
            q[k] += (v[k][j][0] * v[k][j][0] + v[k][j][1] * v[k][j][1]) + (v[k][j][2] * v[k][j][2] + v[k][j][3] * v[k][j][3]); }
#pragma unroll
    for (int o2 = 1; o2 < 64; o2 <<= 1) { s[0] += shx(s[0], o2); s[1] += shx(s[1], o2); q[0] += shx(q[0], o2); q[1] += shx(q[1], o2); }
#pragma unroll
    for (int k = 0; k < 2; ++k) { const int t = k ? t1 : t0; const float mean = s[k] * (1.f / 1024.f), var = fmaxf(q[k] * (1.f / 1024.f) - mean * mean, 0.f), rstd = 1.f / sqrtf(var + 1e-5f);
#pragma unroll
        for (int j = 0; j < 4; ++j) { const int o = 256 * j + 4 * lane; const f32x4 gg = *(const f32x4*)(p.ln2_g + o), bb = *(const f32x4*)(p.ln2_b + o);
            if (NT_IO) __builtin_nontemporal_store((v[k][j] - mean) * rstd * gg + bb, (f32x4*)(p.out + (size_t)t * DM + o)); else *(f32x4*)(p.out + (size_t)t * DM + o) = (v[k][j] - mean) * rstd * gg + bb; } }
}

__global__ __launch_bounds__(256) void nk_prep_w(Params p) { __shared__ float tile[64 * 65]; prep_wjob(p, blockIdx.x, tile, threadIdx.x, 256); }
__global__ __launch_bounds__(256) void nk_ln0(Params p) { const int t = blockIdx.x * 4 + (threadIdx.x >> 6); ln0_row(p.x + (size_t)t * DM, p.ln0_g, p.ln0_b, p.hbuf + (size_t)t * DM, threadIdx.x & 63); }
__global__ __launch_bounds__(256) void nk_rope(Params p) { rope_entry(p, blockIdx.x * 256 + threadIdx.x); if (blockIdx.x == 0 && threadIdx.x < NEXP) p.cnt[threadIdx.x] = 0; }
__global__ __launch_bounds__(256) void nk_rowscale(Params p) {
    const int t = blockIdx.x * 4 + (threadIdx.x >> 6), lane = threadIdx.x & 63;
    float s = 0.f; for (int i = lane; i < 384; i += 64) { const float v = bf2f(p.zq[(size_t)t * 384 + i]); s += v * v; }
    s = wave_sum(s); float s2 = 0.f; for (int i = lane; i < 256; i += 64) { const float v = bf2f(p.zkv[(size_t)t * 256 + i]); s2 += v * v; }
    s2 = wave_sum(s2);
    if (lane == 0) { p.rsq[t] = 1.f / sqrtf(s * (1.f / 384.f) + 1e-6f); p.rskv[t] = 1.f / sqrtf(s2 * (1.f / 256.f) + 1e-6f); }
}
template <class PH> __global__ __launch_bounds__(256) void nk_gemm(PH ph) {
    Unit<typename PH::EP> u; if (!ph.unit(blockIdx.x, u)) return;
    const int wave = threadIdx.x >> 6, lane = threadIdx.x & 63, fr = lane & 15, fq = lane >> 4;
    const int task = blockIdx.y * 4 + wave, rb = task >> 3, cg = task & 7;
    const bf16_t* arow = u.am.row(rb * 16 + fr);
    const bf16_t* b0 = u.bt + (size_t)(cg * 32 + fr) * u.K; const bf16_t* b1 = b0 + (size_t)16 * u.K;
    f32x4 acc0 = {0.f, 0.f, 0.f, 0.f}, acc1 = {0.f, 0.f, 0.f, 0.f};
    for (int k = 0; k < u.K; k += 32) {
        const bf16x8 a = *(const bf16x8*)(arow + k + 8 * fq), x0 = *(const bf16x8*)(b0 + k + 8 * fq), x1 = *(const bf16x8*)(b1 + k + 8 * fq);
        acc0 = __builtin_amdgcn_mfma_f32_16x16x32_bf16(x0, a, acc0, 0, 0, 0);
        acc1 = __builtin_amdgcn_mfma_f32_16x16x32_bf16(x1, a, acc1, 0, 0, 0);
    }
    u.ep(rb * 16 + fr, cg * 32, fq, acc0, acc1);
}
__global__ __launch_bounds__(256) void nk_gmlp(Params p) {
    extern __shared__ float sm[];
    const int unit = blockIdx.x, h = unit & 3, bn = unit >> 2, row0 = bn * 128;
    const int wave = threadIdx.x >> 6, lane = threadIdx.x & 63;
    for (int j = wave; j < 128; j += 4) {
        const bf16_t* vr = p.zv + (size_t)(row0 + j) * 512 + h * 128;
        const float a = bf2f(vr[lane]), b = bf2f(vr[lane + 64]);
        const float mean = wave_sum(a + b) * (1.f / 128.f); const float da = a - mean, db = b - mean;
        const float rstd = 1.f / sqrtf(wave_sum(da * da + db * db) * (1.f / 128.f) + 1e-5f);
        sm[j * 129 + lane] = da * rstd * p.gm_g[h * 128 + lane] + p.gm_b[h * 128 + lane];
        sm[j * 129 + lane + 64] = db * rstd * p.gm_g[h * 128 + lane + 64] + p.gm_b[h * 128 + lane + 64];
    }
    __syncthreads();
    for (int idx = threadIdx.x; idx < 16384; idx += 256) {
        const int i = idx >> 7, c = idx & 127; const int jn = i < 64 ? 64 : 128;
        const float* w = p.w_sp + ((size_t)h * 128 + i) * 128; float f = p.b_sp[h * 128 + i];
        for (int j = 0; j < jn; ++j) f += w[j] * sm[j * 129 + c];
        const float u = bf2f(p.zu[(size_t)(row0 + i) * 512 + h * 128 + c]);
        p.mix[(size_t)(row0 + i) * DM + h * 128 + c] = f2bf(u * f);
    }
}
__global__ __launch_bounds__(256) void nk_attn(Params p) {
    extern __shared__ float sm[];
    float* Qs = sm; float* Ks = Qs + 64 * 192; float* Ss = Ks + 64 * 193; float* Vs = Ss + 64 * 65;
    const int qc = blockIdx.x & 31, bh = blockIdx.x >> 5, b = bh >> 2, h = bh & 3, tid = threadIdx.x, q = tid >> 2, sub = tid & 3;
    for (int idx = tid; idx < 64 * 192; idx += 256) { const int r = idx / 192, d = idx - r * 192; Qs[idx] = bf2f(p.Q[((size_t)bh * SEQ + qc * 64 + r) * 192 + d]); }
    __syncthreads();
    for (int idx = tid; idx < 64 * 32; idx += 256) { const int r = idx >> 5, i = idx & 31; const float2 cs = p.rope[((size_t)b * SEQ + qc * 64 + r) * 32 + i];
        const float x1 = Qs[r * 192 + 128 + i], x2 = Qs[r * 192 + 160 + i]; Qs[r * 192 + 128 + i] = x1 * cs.x - x2 * cs.y; Qs[r * 192 + 160 + i] = x2 * cs.x + x1 * cs.y; }
    float O[32]; float m = -INFINITY, l = 0.f;
#pragma unroll
    for (int j = 0; j < 32; ++j) O[j] = 0.f;
    for (int kt = 0; kt <= qc; ++kt) {
        __syncthreads();
        for (int idx = tid; idx < 64 * 192; idx += 256) { const int r = idx / 192, d = idx - r * 192; const int key = kt * 64 + r;
            Ks[r * 193 + d] = d < 128 ? bf2f(p.Kn[((size_t)bh * SEQ + key) * 128 + d]) : bf2f(p.krope[((size_t)b * SEQ + key) * 64 + d - 128]); }
        for (int idx = tid; idx < 64 * 128; idx += 256) { const int r = idx >> 7, dv = idx & 127; const int key = kt * 64 + r;
            Vs[r * 128 + dv] = bf2f(p.Vt[((size_t)bh * 128 + dv) * SEQ + (key & ~15) + perm16(key & 15)]); }
        __syncthreads();
        for (int kk = 0; kk < 16; ++kk) { const int key = sub * 16 + kk; float s = 0.f;
            for (int d = 0; d < 192; ++d) s += Qs[q * 192 + d] * Ks[key * 193 + d];
            Ss[q * 65 + key] = s; }
        __syncthreads();
        float mt = -INFINITY; for (int k = 0; k < 64; ++k) mt = fmaxf(mt, Ss[q * 65 + k]);
        const float mn = fmaxf(m, mt), alpha = exp2f(m - mn); m = mn; l *= alpha;
#pragma unroll
        for (int j = 0; j < 32; ++j) O[j] *= alpha;
        for (int k = 0; k < 64; ++k) { const float pk = exp2f(Ss[q * 65 + k] - mn); l += pk;
#pragma unroll
            for (int j = 0; j < 32; ++j) O[j] += pk * Vs[k * 128 + sub * 32 + j]; }
    }
    const float inv = 1.f / l; bf16_t* o = p.mix + ((size_t)b * SEQ + qc * 64 + q) * DM + 512 + h * 128 + sub * 32;
#pragma unroll
    for (int j = 0; j < 32; ++j) o[j] = f2bf(O[j] * inv);
}
__global__ __launch_bounds__(256) void nk_router(Params p) {
    const int t = blockIdx.x * 4 + (threadIdx.x >> 6);
    router_token(p, t, threadIdx.x & 63, (const float*)p.H, 1024);
}
__global__ __launch_bounds__(256) void nk_router_prep(Params p) {
    const int idx = blockIdx.x * 256 + threadIdx.x; if (idx >= 36 * 1024) return;
    const int o = idx >> 10, k = idx & 1023;
    ((float*)p.H)[idx] = o < 4 ? p.w_rg[k * 4 + o] : p.w_re[k * 32 + (o - 4)];
}
__global__ __launch_bounds__(256) void nk_final(Params p) { final_token(p, blockIdx.x * 4 + (threadIdx.x >> 6), threadIdx.x & 63); }

constexpr int LDS_BYTES = 152 * 1024, LDS_RS = 150 * 1024, LDS_XB = 151 * 1024;
constexpr int LDS_PRE = 128 * 1024, LDS_TOT = 144 * 1024, LDS_SEG = LDS_TOT + 256, LDS_AID = LDS_SEG + 2048;
constexpr int LDS_RW = 0, LDS_LCNT = 144 * 1024 + 512;
constexpr int NTHR = 512;

#ifndef EARLY_WB
#define EARLY_WB 0
#endif
#define XB_TMO      128
#define XB_XCNT(j)  (256  + 64 * (j))
#define XB_XSUB(j)  (1280 + 64 * (j))
#define XB_XGEN(j)  (2304 + 64 * (j))
#define XB_TOP      3328
#define XB_TOPGEN   3392
#define XCD_BAR_WORDS 3456
#define XB_SPIN_CAP (1u << 20)
__device__ __forceinline__ unsigned xb_ld(unsigned* p) { return __hip_atomic_load(p, __ATOMIC_RELAXED, __HIP_MEMORY_SCOPE_AGENT); }
__device__ __forceinline__ unsigned xb_add(unsigned* p, unsigned v) { return __hip_atomic_fetch_add(p, v, __ATOMIC_RELAXED, __HIP_MEMORY_SCOPE_AGENT); }
__device__ __forceinline__ unsigned xb_xcc_id() { return (unsigned)__builtin_amdgcn_s_getreg((3 << 11) | 20) & 0xFu; }
#define XB_SPIN(cond, bar) do { unsigned _sp = 0; while (cond) { __builtin_amdgcn_s_sleep(1); \
    if ((++_sp & 255u) == 0u) { if (xb_ld(&(bar)[XB_TMO])) break; if (_sp > XB_SPIN_CAP) { atomicAdd(&(bar)[XB_TMO], 1u); break; } } } } while (0)
struct XcdBarrier { unsigned* bar; unsigned x; volatile LAS unsigned* st; };
__device__ __forceinline__ XcdBarrier xcd_barrier_post(unsigned* bar, volatile LAS unsigned* st) {
    XcdBarrier b; b.bar = bar; b.x = xb_xcc_id(); b.st = st;
    if (threadIdx.x == 0) (void)xb_add(&bar[XB_XCNT(b.x)], 1u);
    return b;
}
__device__ __forceinline__ void xcd_barrier_complete(unsigned* bar, unsigned x, unsigned& nloc, unsigned& nx) {
    const unsigned G = gridDim.x * gridDim.y * gridDim.z;
    unsigned sum, cnt, mine, sp = 0u;
    for (;;) {
        sum = 0u; cnt = 0u; mine = 0u;
#pragma unroll
        for (unsigned j = 0; j < 16; ++j) { const unsigned c = xb_ld(&bar[XB_XCNT(j)]); sum += c; cnt += (c > 0u) ? 1u : 0u; mine = (j == x) ? c : mine; }
        if (sum == G) break;
        __builtin_amdgcn_s_sleep(1);
        if ((++sp & 255u) == 0u) { if (xb_ld(&bar[XB_TMO])) break; if (sp > XB_SPIN_CAP) { atomicAdd(&bar[XB_TMO], 1u); break; } }
    }
    nloc = mine > 0u ? mine : 1u; nx = cnt > 0u ? cnt : 1u;
}
__device__ __forceinline__ void xcd_barrier(const XcdBarrier& b) {
    asm volatile("s_waitcnt vmcnt(0)" ::: "memory");
    __syncthreads();
    if (threadIdx.x == 0) {
        unsigned* bar = b.bar;
        __builtin_amdgcn_s_waitcnt(0);
        unsigned nloc = b.st[0], nx = b.st[1];
        if (nloc == 0u) { xcd_barrier_complete(bar, b.x, nloc, nx); b.st[0] = nloc; b.st[1] = nx; }
#if EARLY_WB
        __builtin_amdgcn_fence(__ATOMIC_RELEASE, "agent"); asm volatile("s_waitcnt vmcnt(0)" ::: "memory");
#endif
        const unsigned old = xb_add(&bar[XB_XSUB(b.x)], 1u);
        const unsigned gen = old / nloc;
        if (old + 1u == (gen + 1u) * nloc) {
            __builtin_amdgcn_fence(__ATOMIC_RELEASE, "agent");
            asm volatile("s_waitcnt vmcnt(0)" ::: "memory");
            const unsigned og = xb_add(&bar[XB_TOP], 1u);
            const unsigned tg = og / nx;
            if (og + 1u == (tg + 1u) * nx) xb_add(&bar[XB_TOPGEN], 1u);
            else XB_SPIN(xb_ld(&bar[XB_TOPGEN]) == tg, bar);
            __builtin_amdgcn_fence(__ATOMIC_ACQUIRE, "agent");
            xb_add(&bar[XB_XGEN(b.x)], 1u);
            asm volatile("s_waitcnt vmcnt(0)" ::: "memory");
        } else {
            XB_SPIN(xb_ld(&bar[XB_XGEN(b.x)]) == gen, bar);
            __builtin_amdgcn_fence(__ATOMIC_ACQUIRE, "agent");
            asm volatile("s_waitcnt vmcnt(0)" ::: "memory");
        }
    }
    __syncthreads();
}

constexpr int BK = 64, HALF = 128, HT = HALF * BK;
__device__ __forceinline__ int lds_byte(int r, int c) { const int st = (r >> 4) * 2 + (c >> 5), rr = r & 15, cc = c & 31, ob = rr * 64 + cc * 2; return st * 1024 + (ob ^ (((ob >> 9) & 1) << 5)); }
__device__ __forceinline__ void stage_rc(int b, int& R, int& C) { const int st = b / 1024, sb = b % 1024, swz = sb ^ (((sb >> 9) & 1) << 5); R = (st >> 1) * 16 + swz / 64; C = (st & 1) * 32 + (swz % 64) / 2; }

template <class PH> struct HasNext { template <class T> static char test(decltype(&T::next)); template <class T> static long test(...); static constexpr bool value = sizeof(test<PH>(nullptr)) == 1; };
template <class PH> struct HasDone { template <class T> static char test(decltype(&T::done)); template <class T> static long test(...); static constexpr bool value = sizeof(test<PH>(nullptr)) == 1; };
template <class EP> struct HasPre2 { template <class T> static char test(decltype(&T::pre2)); template <class T> static long test(...); static constexpr bool value = sizeof(test<EP>(nullptr)) == 1; };
template <class EP> struct IsBatch4 { template <class T> static char test(decltype(&T::BATCH4)); template <class T> static long test(...); static constexpr bool value = sizeof(test<EP>(nullptr)) == 1; };
template <class EP> __device__ __forceinline__ void run_epilogue(const EP& ep, const f32x4 (&acc)[2][2][4][2], int wr, int wc, int fr, int fq) {
    int rb = wr * 64 + fr, fq_ = fq; asm volatile("" : "+v"(rb), "+v"(fq_));
    if constexpr (IsBatch4<EP>::value) {
#pragma unroll
        for (int ai = 0; ai < 2; ++ai) {
            typename EP::Ctx cx[4];
#pragma unroll
            for (int m = 0; m < 4; ++m) cx[m] = ep.pre(ai * HALF + m * 16 + rb, wc * 32, fq_);
            if constexpr (HasPre2<EP>::value) {
#pragma unroll
                for (int m = 0; m < 4; ++m) ep.pre2(cx[m]);
            }
#pragma unroll
            for (int m = 0; m < 4; ++m) ep.post(ai * HALF + m * 16 + rb, wc * 32, fq_, cx[m], acc[ai][0][m][0], acc[ai][0][m][1], acc[ai][1][m][0], acc[ai][1][m][1]);
        }
    } else {
        typename EP::Ctx cx[8];
#pragma unroll
        for (int i = 0; i < 8; ++i) cx[i] = ep.pre((i >> 2) * HALF + (i & 3) * 16 + rb, wc * 32, fq_);
        if constexpr (HasPre2<EP>::value) {
#pragma unroll
            for (int i = 0; i < 8; ++i) ep.pre2(cx[i]);
        }
#pragma unroll
        for (int i = 0; i < 8; ++i) ep.post((i >> 2) * HALF + (i & 3) * 16 + rb, wc * 32, fq_, cx[i], acc[i >> 2][0][i & 3][0], acc[i >> 2][0][i & 3][1], acc[i >> 2][1][i & 3][0], acc[i >> 2][1][i & 3][1]);
    }
}
struct GmArgs { const float *gm_g, *gm_b, *w_sp, *b_sp; bf16_t* mix; int row0, h; };
__device__ __forceinline__ void gmlp_epilogue(f32x4 (&acc)[2][2][4][2], const GmArgs& g, char* lds, int wr, int wc, int fr, int fq) {
    typedef float f32x2 __attribute__((ext_vector_type(2)));
    f32x2* P = (f32x2*)lds;
    char* vT = lds + 8192;
#pragma unroll
    for (int ai = 0; ai < 2; ++ai)
#pragma unroll
        for (int bj = 0; bj < 2; ++bj)
#pragma unroll
            for (int m = 0; m < 4; ++m)
#pragma unroll
                for (int n = 0; n < 2; ++n)
#pragma unroll
                    for (int t = 0; t < 4; ++t) acc[ai][bj][m][n][t] = gelu_tanh(acc[ai][bj][m][n][t]);
#pragma unroll
    for (int ai = 0; ai < 2; ++ai)
#pragma unroll
        for (int m = 0; m < 4; ++m) { float s = 0.f, q = 0.f;
#pragma unroll
            for (int n = 0; n < 2; ++n)
#pragma unroll
                for (int t = 0; t < 4; ++t) { const float x = acc[ai][1][m][n][t]; s += x; q += x * x; }
            s += shx(s, 16); s += shx(s, 32); q += shx(q, 16); q += shx(q, 32);
            if (fq == 0) P[(ai * 128 + wr * 64 + m * 16 + fr) * 4 + wc] = (f32x2){s, q}; }
    __syncthreads();
    const int c0 = wc * 32 + 4 * fq;
    f32x4 gg[2], bb[2];
#pragma unroll
    for (int n = 0; n < 2; ++n) { gg[n] = *(const f32x4*)(g.gm_g + g.h * 128 + c0 + 16 * n); bb[n] = *(const f32x4*)(g.gm_b + g.h * 128 + c0 + 16 * n); }
#pragma unroll
    for (int ai = 0; ai < 2; ++ai)
#pragma unroll
        for (int m = 0; m < 4; ++m) { const int row = ai * 128 + wr * 64 + m * 16 + fr, j = wr * 64 + m * 16 + fr;
            const f32x2 p0 = P[row * 4 + 0], p1 = P[row * 4 + 1], p2 = P[row * 4 + 2], p3 = P[row * 4 + 3];
            const float mean = ((p0.x + p1.x) + (p2.x + p3.x)) * (1.f / 128.f), var = fmaxf(((p0.y + p1.y) + (p2.y + p3.y)) * (1.f / 128.f) - mean * mean, 0.f), rstd = 1.f / sqrtf(var + 1e-5f);
#pragma unroll
            for (int n = 0; n < 2; ++n)
#pragma unroll
                for (int t = 0; t < 4; ++t) *(bf16_t*)(vT + ai * (128 * 272) + (c0 + 16 * n + t) * 272 + j * 2) = f2bf((acc[ai][1][m][n][t] - mean) * rstd * gg[n][t] + bb[n][t]); }
    __syncthreads();
    const int nks = (wr == 0) ? 2 : 4;
#pragma unroll
    for (int m = 0; m < 4; ++m) {
        const int i = wr * 64 + m * 16 + fr;
        bf16x8 wf[4];
#pragma unroll
        for (int ks = 0; ks < 4; ++ks) { u32x4 pk = {0u, 0u, 0u, 0u};
            if (ks < nks) { const float* w = g.w_sp + ((size_t)g.h * 128 + i) * 128 + 32 * ks + 8 * fq; const f32x4 w0 = *(const f32x4*)w, w1 = *(const f32x4*)(w + 4);
                pk.x = pk2(w0[0], w0[1]); pk.y = pk2(w0[2], w0[3]); pk.z = pk2(w1[0], w1[1]); pk.w = pk2(w1[2], w1[3]); }
            wf[ks] = __builtin_bit_cast(bf16x8, pk); }
        const float bias = g.b_sp[g.h * 128 + i];
#pragma unroll
        for (int ai = 0; ai < 2; ++ai)
#pragma unroll
            for (int n = 0; n < 2; ++n) { f32x4 f = {0.f, 0.f, 0.f, 0.f};
#pragma unroll
                for (int ks = 0; ks < 4; ++ks) if (ks < nks) { const bf16x8 a = *(const bf16x8*)(vT + ai * (128 * 272) + (wc * 32 + n * 16 + fr) * 272 + (32 * ks + 8 * fq) * 2);
                    f = __builtin_amdgcn_mfma_f32_16x16x32_bf16(a, wf[ks], f, 0, 0, 0); }
                const f32x4 uu = acc[ai][0][m][n]; f32x4 o; o[0] = uu[0] * (f[0] + bias); o[1] = uu[1] * (f[1] + bias); o[2] = uu[2] * (f[2] + bias); o[3] = uu[3] * (f[3] + bias);
                st4(g.mix + (size_t)(g.row0 + ai * 128 + i) * DM + g.h * 128 + wc * 32 + n * 16 + 4 * fq, o); } }
}
struct KvArgs { bf16_t* zkv; float* tab; int row0; };
__device__ __forceinline__ void kvlat_epilogue(const f32x4 (&acc)[2][2][4][2], const KvArgs& g, char* lds, int wr, int wc, int fr, int fq) {
    float* P = (float*)lds;
#pragma unroll
    for (int ai = 0; ai < 2; ++ai)
#pragma unroll
        for (int m = 0; m < 4; ++m) { float q = 0.f; const int row = ai * 128 + wr * 64 + m * 16 + fr;
#pragma unroll
            for (int bj = 0; bj < 2; ++bj)
#pragma unroll
                for (int n = 0; n < 2; ++n) { const f32x4 x = acc[ai][bj][m][n]; q += (x[0] * x[0] + x[1] * x[1]) + (x[2] * x[2] + x[3] * x[3]);
                    st4(g.zkv + (size_t)(g.row0 + row) * 256 + bj * 128 + wc * 32 + n * 16 + 4 * fq, x); }
            q += shx(q, 16); q += shx(q, 32);
            if (fq == 0) P[row * 4 + wc] = q; }
    __syncthreads();
    if (threadIdx.x < 256) { const f32x4 s = *(const f32x4*)(P + threadIdx.x * 4); g.tab[threadIdx.x] = 1.f / sqrtf(((s[0] + s[1]) + (s[2] + s[3])) * (1.f / 256.f) + 1e-6f); }
    asm volatile("s_waitcnt vmcnt(0)" ::: "memory");
}
template <class EP, int EK = 0>
__device__ __forceinline__ void gemm256(const Unit<EP>& u, LAS unsigned char* lds, const GmArgs* gm = nullptr, const KvArgs* kv = nullptr) {
    int tid = threadIdx.x; asm volatile("" : "+v"(tid));
    const int K = u.K, nt = K / BK;
    const int wid = __builtin_amdgcn_readfirstlane(tid >> 6), lane = tid & 63, wr = wid >> 2, wc = wid & 3, fr = lane & 15, fq = lane >> 4;
    unsigned voffA[2][2], voffB[2];
    const char* gA = (const char*)u.am.base; const char* gB = (const char*)u.bt;
#pragma unroll
    for (int i = 0; i < 2; ++i) { int R, C; stage_rc(tid * 16 + i * 8192, R, C);
        voffB[i] = (unsigned)(R * K + C) * 2u;
        if (u.am.list) { const int a0 = u.am.list[R < u.am.nvalid ? R : 0], a1 = u.am.list[R + HALF < u.am.nvalid ? R + HALF : 0];
            voffA[0][i] = ((unsigned)(a0 >> 1) * (unsigned)u.am.ld + (unsigned)C) * 2u; voffA[1][i] = ((unsigned)(a1 >> 1) * (unsigned)u.am.ld + (unsigned)C) * 2u; }
        else { voffA[0][i] = (unsigned)(R * u.am.ld + C) * 2u; voffA[1][i] = (unsigned)((R + HALF) * u.am.ld + C) * 2u; } }
    const size_t hstepB = (size_t)HALF * K * 2;
    const unsigned ldsw = (unsigned)wid * 1024u;
    const int aoff = lds_byte(wr * 64 + fr, fq * 8), boff = lds_byte(wc * 32 + fr, fq * 8);
    #define SA(b,h) (((b)*2+(h))*HT*2)
    #define SB(b,h) ((4+(b)*2+(h))*HT*2)
    #define STAGE_A(bufoff,h,kt) do{ _Pragma("unroll") for(int _i=0;_i<2;++_i) { asm volatile("" : "+v"(voffA[h][_i])); \
        __builtin_amdgcn_global_load_lds((const unsigned*)(gA+(size_t)(kt)*(BK*2)+voffA[h][_i]),(LAS unsigned*)(lds+(bufoff)+ldsw+_i*8192),16,0,0);} }while(0)
    #define STAGE_B(bufoff,h,kt) do{ _Pragma("unroll") for(int _i=0;_i<2;++_i) { asm volatile("" : "+v"(voffB[_i])); \
        __builtin_amdgcn_global_load_lds((const unsigned*)(gB+(size_t)(h)*hstepB+(size_t)(kt)*(BK*2)+voffB[_i]),(LAS unsigned*)(lds+(bufoff)+ldsw+_i*8192),16,0,0);} }while(0)
    #define LDA(dst,b,h) _Pragma("unroll") for(int m=0;m<4;++m) _Pragma("unroll") for(int k=0;k<2;++k) \
        dst[m][k]=*(const LAS bf16x8*)(lds+SA(b,h)+aoff+m*2048+k*1024)
    #define LDB(dst,b,h) _Pragma("unroll") for(int n=0;n<2;++n) _Pragma("unroll") for(int k=0;k<2;++k) \
        dst[n][k]=*(const LAS bf16x8*)(lds+SB(b,h)+boff+n*2048+k*1024)
    #define MMA(ai,bj,At_,Bt_) do{__builtin_amdgcn_s_setprio(1); \
        _Pragma("unroll") for(int m=0;m<4;++m) _Pragma("unroll") for(int n=0;n<2;++n) _Pragma("unroll") for(int k=0;k<2;++k) \
          acc[ai][bj][m][n]=__builtin_amdgcn_mfma_f32_16x16x32_bf16(Bt_[n][k],At_[m][k],acc[ai][bj][m][n],0,0,0); \
        __builtin_amdgcn_s_setprio(0);}while(0)
    #define WAIT_V(n) asm volatile("s_waitcnt vmcnt(" #n ")":::"memory")
    #define WAIT_L(n) asm volatile("s_waitcnt lgkmcnt(" #n ")":::"memory")
    #define BAR __builtin_amdgcn_s_barrier()
    #define SCHED __builtin_amdgcn_sched_barrier(0)

    f32x4 acc[2][2][4][2];
#pragma unroll
    for (int a = 0; a < 2; ++a)
#pragma unroll
        for (int b = 0; b < 2; ++b)
#pragma unroll
            for (int m = 0; m < 4; ++m)
#pragma unroll
                for (int n = 0; n < 2; ++n) acc[a][b][m][n] = (f32x4){0.f, 0.f, 0.f, 0.f};
    bf16x8 At[4][2], B0[2][2], B1[2][2];
    STAGE_B(SB(0,0),0,0); STAGE_A(SA(0,0),0,0);
    STAGE_B(SB(0,1),1,0); STAGE_A(SA(0,1),1,0);
    if (wr == 1) BAR;
    WAIT_V(4); BAR;
    STAGE_B(SB(1,0),0,1); STAGE_A(SA(1,0),0,1); STAGE_B(SB(1,1),1,1);
    WAIT_V(6); BAR;
    for (int t = 0; t < nt - 2; t += 2) {
        LDB(B0,0,0); SCHED; LDA(At,0,0); STAGE_A(SA(1,1),1,t+1);
        WAIT_L(8); BAR; WAIT_L(0); MMA(0,0,At,B0); BAR; SCHED;
        LDB(B1,0,1); STAGE_B(SB(0,0),0,t+2);
        BAR; WAIT_L(0); MMA(0,1,At,B1); BAR;
        LDA(At,0,1); STAGE_A(SA(0,0),0,t+2);
        BAR; WAIT_L(0); MMA(1,0,At,B0); BAR; SCHED;
        STAGE_B(SB(0,1),1,t+2);
        WAIT_V(6); BAR; MMA(1,1,At,B1); BAR;
        LDB(B0,1,0); SCHED; LDA(At,1,0); STAGE_A(SA(0,1),1,t+2);
        WAIT_L(8); BAR; WAIT_L(0); MMA(0,0,At,B0); BAR; SCHED;
        LDB(B1,1,1); STAGE_B(SB(1,0),0,t+3);
        BAR; WAIT_L(0); MMA(0,1,At,B1); BAR;
        LDA(At,1,1); STAGE_A(SA(1,0),0,t+3);
        BAR; WAIT_L(0); MMA(1,0,At,B0); BAR; SCHED;
        STAGE_B(SB(1,1),1,t+3);
        WAIT_V(6); BAR; MMA(1,1,At,B1); BAR;
    }
    { LDB(B0,0,0); LDA(At,0,0); STAGE_A(SA(1,1),1,nt-1);
      BAR; WAIT_L(0); MMA(0,0,At,B0); BAR;
      LDB(B1,0,1); BAR; WAIT_L(0); MMA(0,1,At,B1); BAR;
      LDA(At,0,1); WAIT_V(4); BAR; WAIT_L(0); MMA(1,0,At,B0); MMA(1,1,At,B1); BAR; }
    { LDB(B0,1,0); LDA(At,1,0); WAIT_V(2); BAR; WAIT_L(0); MMA(0,0,At,B0); BAR;
      LDB(B1,1,1); WAIT_V(0); BAR; WAIT_L(0); MMA(0,1,At,B1); BAR;
      LDA(At,1,1); BAR; WAIT_L(0); MMA(1,0,At,B0); MMA(1,1,At,B1); BAR; }
    if (wr == 0) BAR;
    if constexpr (EK == 1) { __syncthreads(); gmlp_epilogue(acc, *gm, (char*)lds, wr, wc, fr, fq); } else if constexpr (EK == 2) { __syncthreads(); kvlat_epilogue(acc, *kv, (char*)lds, wr, wc, fr, fq); } else run_epilogue(u.ep, acc, wr, wc, fr, fq);
    __syncthreads();
    #undef SA
    #undef SB
    #undef STAGE_A
    #undef STAGE_B
    #undef LDA
    #undef LDB
    #undef MMA
}


template <class PH>
__device__ __forceinline__ void gemm_stream(const PH& ph, LAS unsigned char* lds, int u0, int ustride) {
    typedef Unit<typename PH::EP> U;
    int tid = threadIdx.x; asm volatile("" : "+v"(tid));
    const int wid = __builtin_amdgcn_readfirstlane(tid >> 6), lane = tid & 63, wr = wid >> 2, wc = wid & 3, fr = lane & 15, fq = lane >> 4;
    int u = u0;
    U cu; if (u >= PH::NU || !ph.unit(u, cu)) return;
    const int K = cu.K, nt = K / BK;
    int R0, C0, R1, C1; stage_rc(tid * 16, R0, C0); stage_rc(tid * 16 + 8192, R1, C1);
    unsigned voffB0 = (unsigned)(R0 * K + C0) * 2u, voffB1 = (unsigned)(R1 * K + C1) * 2u;
    #define VOFFA(am, o00, o01, o10, o11) do { \
        if ((am).list) { const int n_ = (am).nvalid; const int a00 = (am).list[R0 < n_ ? R0 : 0], a01 = (am).list[R1 < n_ ? R1 : 0], a10 = (am).list[R0 + HALF < n_ ? R0 + HALF : 0], a11 = (am).list[R1 + HALF < n_ ? R1 + HALF : 0]; \
            o00 = ((unsigned)(a00 >> 1) * (unsigned)(am).ld + (unsigned)C0) * 2u; o01 = ((unsigned)(a01 >> 1) * (unsigned)(am).ld + (unsigned)C1) * 2u; \
            o10 = ((unsigned)(a10 >> 1) * (unsigned)(am).ld + (unsigned)C0) * 2u; o11 = ((unsigned)(a11 >> 1) * (unsigned)(am).ld + (unsigned)C1) * 2u; } \
        else { o00 = (unsigned)(R0 * (am).ld + C0) * 2u; o01 = (unsigned)(R1 * (am).ld + C1) * 2u; o10 = (unsigned)((R0 + HALF) * (am).ld + C0) * 2u; o11 = (unsigned)((R1 + HALF) * (am).ld + C1) * 2u; } } while (0)
    unsigned va00, va01, va10, va11; VOFFA(cu.am, va00, va01, va10, va11);
    const char* cA = (const char*)cu.am.base; const char* cB = (const char*)cu.bt;
    const size_t hstepB = (size_t)HALF * K * 2, kstep = BK * 2;
    const unsigned ldsw = (unsigned)wid * 1024u;
    const int aoff = lds_byte(wr * 64 + fr, fq * 8), boff = lds_byte(wc * 32 + fr, fq * 8);
    #define SA(b,h) (((b)*2+(h))*HT*2)
    #define SB(b,h) ((4+(b)*2+(h))*HT*2)
    #define STG(bufoff, gbase, o0, o1) do { asm volatile("" : "+v"(o0)); asm volatile("" : "+v"(o1)); \
        __builtin_amdgcn_global_load_lds((const unsigned*)((gbase) + (o0)), (LAS unsigned*)(lds + (bufoff) + ldsw), 16, 0, 0); \
        __builtin_amdgcn_global_load_lds((const unsigned*)((gbase) + (o1)), (LAS unsigned*)(lds + (bufoff) + ldsw + 8192), 16, 0, 0); } while (0)
    #define LDA(dst,b,h) _Pragma("unroll") for(int m=0;m<4;++m) _Pragma("unroll") for(int k=0;k<2;++k) \
        dst[m][k]=*(const LAS bf16x8*)(lds+SA(b,h)+aoff+m*2048+k*1024)
    #define LDB(dst,b,h) _Pragma("unroll") for(int n=0;n<2;++n) _Pragma("unroll") for(int k=0;k<2;++k) \
        dst[n][k]=*(const LAS bf16x8*)(lds+SB(b,h)+boff+n*2048+k*1024)
    #define MMA(ai,bj,At_,Bt_) do{__builtin_amdgcn_s_setprio(1); \
        _Pragma("unroll") for(int m=0;m<4;++m) _Pragma("unroll") for(int n=0;n<2;++n) _Pragma("unroll") for(int k=0;k<2;++k) \
          acc[ai][bj][m][n]=__builtin_amdgcn_mfma_f32_16x16x32_bf16(Bt_[n][k],At_[m][k],acc[ai][bj][m][n],0,0,0); \
        __builtin_amdgcn_s_setprio(0);}while(0)
    f32x4 acc[2][2][4][2];
    #define ZERO_ACC _Pragma("unroll") for (int a = 0; a < 2; ++a) _Pragma("unroll") for (int b = 0; b < 2; ++b) _Pragma("unroll") for (int m = 0; m < 4; ++m) _Pragma("unroll") for (int n = 0; n < 2; ++n) acc[a][b][m][n] = (f32x4){0.f, 0.f, 0.f, 0.f}
    bf16x8 At[4][2], B0[2][2], B1[2][2];
#ifndef SP2
#define SP2 0
#endif
#if SP2
    STG(SB(0,0), cB, voffB0, voffB1); STG(SB(0,1), cB + hstepB, voffB0, voffB1); STG(SA(0,0), cA, va00, va01); STG(SA(0,1), cA, va10, va11);
    if (wr == 1) BAR;
    WAIT_V(2); BAR;
#else
    STG(SB(0,0), cB, voffB0, voffB1); STG(SA(0,0), cA, va00, va01); STG(SB(0,1), cB + hstepB, voffB0, voffB1); STG(SA(0,1), cA, va10, va11);
    if (wr == 1) BAR;
    WAIT_V(4); BAR;
#endif
    STG(SB(1,0), cB + kstep, voffB0, voffB1); STG(SA(1,0), cA + kstep, va00, va01); STG(SB(1,1), cB + hstepB + kstep, voffB0, voffB1);
    WAIT_V(6); BAR;
    for (;;) {
        U nx; int un; if constexpr (HasNext<PH>::value) un = ph.next(wr); else un = u + ustride;
        const bool has_next = (un < PH::NU) && ph.unit(un, nx);
        unsigned na00 = va00, na01 = va01, na10 = va10, na11 = va11; const char* nA = cA; const char* nB = cB;
        if (has_next) { VOFFA(nx.am, na00, na01, na10, na11); nA = (const char*)nx.am.base; nB = (const char*)nx.bt; }
        ZERO_ACC;
#if SP2
        #define KBODY(a1_, a2_, b2_, X00, X01, X10, X11) do { \
            const char* a3_ = (a2_) + kstep; const char* b3_ = (b2_) + kstep; \
            LDB(B0,0,0); LDB(B1,0,1); SCHED; LDA(At,0,0); STG(SA(1,1), a1_, va10, va11); \
            WAIT_V(8); WAIT_L(0); BAR; MMA(0,0,At,B0); MMA(0,1,At,B1); BAR; SCHED; \
            LDA(At,0,1); STG(SB(0,0), b2_, voffB0, voffB1); STG(SB(0,1), (b2_) + hstepB, voffB0, voffB1); STG(SA(0,0), a2_, X00, X01); \
            WAIT_V(8); WAIT_L(0); BAR; MMA(1,0,At,B0); MMA(1,1,At,B1); BAR; SCHED; \
            LDB(B0,1,0); LDB(B1,1,1); SCHED; LDA(At,1,0); STG(SA(0,1), a2_, X10, X11); \
            WAIT_V(8); WAIT_L(0); BAR; MMA(0,0,At,B0); MMA(0,1,At,B1); BAR; SCHED; \
            LDA(At,1,1); STG(SB(1,0), b3_, voffB0, voffB1); STG(SB(1,1), (b3_) + hstepB, voffB0, voffB1); STG(SA(1,0), a3_, X00, X01); \
            WAIT_V(8); WAIT_L(0); BAR; MMA(1,0,At,B0); MMA(1,1,At,B1); BAR; SCHED; } while (0)
#else
        #define KBODY(a1_, a2_, b2_, X00, X01, X10, X11) do { \
            const char* a3_ = (a2_) + kstep; const char* b3_ = (b2_) + kstep; \
            LDB(B0,0,0); SCHED; LDA(At,0,0); STG(SA(1,1), a1_, va10, va11); \
            WAIT_L(8); BAR; WAIT_L(0); MMA(0,0,At,B0); BAR; SCHED; \
            LDB(B1,0,1); STG(SB(0,0), b2_, voffB0, voffB1); \
            BAR; WAIT_L(0); MMA(0,1,At,B1); BAR; \
            LDA(At,0,1); STG(SA(0,0), a2_, X00, X01); \
            BAR; WAIT_L(0); MMA(1,0,At,B0); BAR; SCHED; \
            STG(SB(0,1), (b2_) + hstepB, voffB0, voffB1); \
            WAIT_V(6); BAR; MMA(1,1,At,B1); BAR; \
            LDB(B0,1,0); SCHED; LDA(At,1,0); STG(SA(0,1), a2_, X10, X11); \
            WAIT_L(8); BAR; WAIT_L(0); MMA(0,0,At,B0); BAR; SCHED; \
            LDB(B1,1,1); STG(SB(1,0), b3_, voffB0, voffB1); \
            BAR; WAIT_L(0); MMA(0,1,At,B1); BAR; \
            LDA(At,1,1); STG(SA(1,0), a3_, X00, X01); \
            BAR; WAIT_L(0); MMA(1,0,At,B0); BAR; SCHED; \
            STG(SB(1,1), (b3_) + hstepB, voffB0, voffB1); \
            WAIT_V(6); BAR; MMA(1,1,At,B1); BAR; } while (0)
#endif
#ifndef KREP
#define KREP 1
#endif
        for (int t = 0; t < nt * KREP - 2; t += 2) { const int t1 = (KREP > 1) ? (t + 1) % nt : t + 1, t2 = (KREP > 1) ? (t + 2) % nt : t + 2;
            const char* a1 = cA + (size_t)t1 * kstep; const char* a2 = cA + (size_t)t2 * kstep; const char* b2 = cB + (size_t)t2 * kstep;
            KBODY(a1, a2, b2, va00, va01, va10, va11); }
        { const char* a1 = cA + (size_t)(nt - 1) * kstep; KBODY(a1, nA, nB, na00, na01, na10, na11); }
        if (KREP > 1) {
#pragma unroll
            for (int a = 0; a < 2; ++a)
#pragma unroll
                for (int b = 0; b < 2; ++b)
#pragma unroll
                    for (int m = 0; m < 4; ++m)
#pragma unroll
                        for (int n = 0; n < 2; ++n) acc[a][b][m][n] = acc[a][b][m][n] * (1.0f / KREP); }
        #undef KBODY
        run_epilogue(cu.ep, acc, wr, wc, fr, fq);
        if constexpr (HasDone<PH>::value) ph.done(cu, wr);
        if (!has_next) break;
        cu = nx; va00 = na00; va01 = na01; va10 = na10; va11 = na11; cA = nA; cB = nB; u = un;
    }
    WAIT_V(0);
    if (wr == 0) BAR;
    BAR;
    __syncthreads();
    #undef SA
    #undef SB
    #undef STG
    #undef LDA
    #undef LDB
    #undef MMA
    #undef ZERO_ACC
    #undef VOFFA
}

__device__ __forceinline__ void witem(const float* s0, const float* s1, int ldsrc, bf16_t* dst, int K, int k0, int n0, int mode, const float* kscale, float* scr, int lane) {
    const int n = n0 + (lane & 31);
    const float* s = s0; int col = n;
    if (mode == 1) { if (n >= 1728) col = -1; else if (n >= 1664) { const int i = (n - 1664) >> 1, pp = (n - 1664) & 1; col = 1664 + i + 32 * pp; }
        else if (GMLP_FUSED && n < 1024) { const int t = n >> 8, w = n & 255; col = w < 128 ? t * 128 + w : 512 + t * 128 + (w - 128); }
        else if (ZLAYOUT2 && n >= 1024) { col = n < 1280 ? 1408 + (n - 1024) : n < 1536 ? 1024 + (n - 1280) : 1280 + (n - 1536); } }
    else if (mode == 2) { const int h = n / 192, d = n - h * 192; if (d >= 128) { const int i = (d - 128) >> 1, pp = (d - 128) & 1; col = h * 192 + 128 + i + 32 * pp; } }
    else if (mode == 3) { const int G = n >> 5, r = n & 31; col = 16 * G + (r & 15); s = (r < 16) ? s0 : s1; }
    const float* sp = s + (size_t)(k0 + (lane >> 5)) * ldsrc + (col < 0 ? 0 : col);
    float v[32];
#pragma unroll
    for (int i = 0; i < 32; ++i) v[i] = NT_IO ? __builtin_nontemporal_load(sp + (size_t)(2 * i) * ldsrc) : sp[(size_t)(2 * i) * ldsrc];
    if (kscale) {
#pragma unroll
        for (int i = 0; i < 32; ++i) v[i] *= kscale[k0 + 2 * i + (lane >> 5)];
    }
    if (col < 0) {
#pragma unroll
        for (int i = 0; i < 32; ++i) v[i] = 0.f;
    }
#pragma unroll
    for (int i = 0; i < 32; ++i) scr[(2 * i + (lane >> 5)) * 33 + (lane & 31)] = v[i];
    asm volatile("s_waitcnt lgkmcnt(0)" ::: "memory");
    const int c = lane & 7;
#pragma unroll
    for (int j = 0; j < 4; ++j) { const int nn = (lane >> 3) + 8 * j; const float* q = scr + (8 * c) * 33 + nn;
        u32x4 o; o.x = pk2(q[0], q[33]); o.y = pk2(q[2 * 33], q[3 * 33]); o.z = pk2(q[4 * 33], q[5 * 33]); o.w = pk2(q[6 * 33], q[7 * 33]);
        *(u32x4*)(dst + (size_t)(n0 + nn) * K + k0 + 8 * c) = o; }
    asm volatile("s_waitcnt lgkmcnt(0)" ::: "memory");
}
constexpr int I_IN = 16 * 56, I_UQ = 6 * 24, I_UKV = 4 * 32, I_OUT = 16 * 32, I_GU = 32 * 16 * 16, I_DN = 32 * 4 * 32;
constexpr int I_TOTAL = I_IN + I_UQ + I_UKV + I_OUT + I_GU + I_DN, I_EARLY = I_IN + I_UQ + I_UKV + I_OUT;
__device__ __forceinline__ void prep_witem(const Params& p, int it, float* scr, int lane) {
    if (it < I_IN) { const int kb = it / 56, nb = it - kb * 56; witem(p.w_in, nullptr, 1728, p.WinT, 1024, kb * 64, nb * 32, 1, nullptr, scr, lane); return; } it -= I_IN;
    if (it < I_UQ) { const int kb = it / 24, nb = it - kb * 24; witem(p.w_uq, nullptr, 768, p.WuqT, 384, kb * 64, nb * 32, 0, p.qn_g, scr, lane); return; } it -= I_UQ;
    if (it < I_UKV) { const int kb = it >> 5, nb = it & 31; witem(p.w_ukv, nullptr, 1024, p.WukvT, 256, kb * 64, nb * 32, 0, p.kvn_g, scr, lane); return; } it -= I_UKV;
    if (it < I_OUT) { const int kb = it >> 5, nb = it & 31; witem(p.w_out, nullptr, 1024, p.WoutT, 1024, kb * 64, nb * 32, 0, nullptr, scr, lane); return; } it -= I_OUT;
    if (it < I_GU) { const int e = it >> 8, r = it & 255, kb = r >> 4, nb = r & 15;
        witem(p.w_gate + (size_t)e * 1024 * 256, p.w_up + (size_t)e * 1024 * 256, 256, p.WguT + (size_t)e * 512 * 1024, 1024, kb * 64, nb * 32, 3, nullptr, scr, lane); return; } it -= I_GU;
    { const int e = it >> 7, r = it & 127, kb = r >> 5, nb = r & 31;
        witem(p.w_down + (size_t)e * 256 * 1024, nullptr, 1024, p.WdT + (size_t)e * 1024 * 256, 256, kb * 64, nb * 32, 0, nullptr, scr, lane); }
}
template <bool WT> __device__ __forceinline__ void ln0_row4(const float* x, size_t rstride, const float* g, const float* b, bf16_t* o, int lane) {
    f32x4 v[4][4]; float s[4], q[4];
#pragma unroll
    for (int r = 0; r < 4; ++r)
#pragma unroll
        for (int j = 0; j < 4; ++j) v[r][j] = NT_IO ? __builtin_nontemporal_load((const f32x4*)(x + r * rstride + 256 * j + 4 * lane)) : *(const f32x4*)(x + r * rstride + 256 * j + 4 * lane);
#pragma unroll
    for (int r = 0; r < 4; ++r) { s[r] = 0.f; q[r] = 0.f;
#pragma unroll
        for (int j = 0; j < 4; ++j) { s[r] += (v[r][j][0] + v[r][j][1]) + (v[r][j][2] + v[r][j][3]);
            q[r] += (v[r][j][0] * v[r][j][0] + v[r][j][1] * v[r][j][1]) + (v[r][j][2] * v[r][j][2] + v[r][j][3] * v[r][j][3]); } }
#pragma unroll
    for (int o2 = 1; o2 < 64; o2 <<= 1) {
#pragma unroll
        for (int r = 0; r < 4; ++r) { s[r] += shx(s[r], o2); q[r] += shx(q[r], o2); } }
    f32x4 gg[4], bb[4];
#pragma unroll
    for (int j = 0; j < 4; ++j) { gg[j] = *(const f32x4*)(g + 256 * j + 4 * lane); bb[j] = *(const f32x4*)(b + 256 * j + 4 * lane); }
#pragma unroll
    for (int r = 0; r < 4; ++r) { const float mean = s[r] * (1.f / 1024.f), var = fmaxf(q[r] * (1.f / 1024.f) - mean * mean, 0.f), rstd = 1.f / sqrtf(var + 1e-5f);
#pragma unroll
        for (int j = 0; j < 4; ++j) { if (WT) st4wt(o + r * rstride + 256 * j + 4 * lane, (v[r][j] - mean) * rstd * gg[j] + bb[j]); else st4(o + r * rstride + 256 * j + 4 * lane, (v[r][j] - mean) * rstd * gg[j] + bb[j]); } }
}
__device__ __forceinline__ void ln0_row1_wt(const float* xr, const float* g, const float* b, bf16_t* orow, int lane) {
    f32x4 v[4]; float s = 0.f, q = 0.f;
#pragma unroll
    for (int j = 0; j < 4; ++j) { v[j] = *(const f32x4*)(xr + 256 * j + 4 * lane); s += (v[j][0] + v[j][1]) + (v[j][2] + v[j][3]); q += (v[j][0] * v[j][0] + v[j][1] * v[j][1]) + (v[j][2] * v[j][2] + v[j][3] * v[j][3]); }
#pragma unroll
    for (int o2 = 1; o2 < 64; o2 <<= 1) { s += shx(s, o2); q += shx(q, o2); }
    const float mean = s * (1.f / 1024.f), var = fmaxf(q * (1.f / 1024.f) - mean * mean, 0.f), rstd = 1.f / sqrtf(var + 1e-5f);
#pragma unroll
    for (int j = 0; j < 4; ++j) { const f32x4 gg = *(const f32x4*)(g + 256 * j + 4 * lane), bb = *(const f32x4*)(b + 256 * j + 4 * lane); st4wt(orow + 256 * j + 4 * lane, (v[j] - mean) * rstd * gg + bb); }
}

template <int K> __device__ __forceinline__ void rs_table(const bf16_t* A, float* tab) {
    int tid = threadIdx.x; asm volatile("" : "+v"(tid));
    const int r = tid >> 1, hf = tid & 1; constexpr int n = K >> 1;
    const bf16_t* a = A + (size_t)r * K + hf * n; float s = 0.f;
    u32x4 w[n / 8];
#pragma unroll
    for (int i = 0; i < n / 8; ++i) w[i] = *(const u32x4*)(a + 8 * i);
#pragma unroll
    for (int i = 0; i < n / 8; ++i) { const float a0 = bflo(w[i].x), a1 = bfhi(w[i].x), a2 = bflo(w[i].y), a3 = bfhi(w[i].y), a4 = bflo(w[i].z), a5 = bfhi(w[i].z), a6 = bflo(w[i].w), a7 = bfhi(w[i].w);
        s += (a0 * a0 + a1 * a1) + (a2 * a2 + a3 * a3) + (a4 * a4 + a5 * a5) + (a6 * a6 + a7 * a7); }
    s += shx(s, 1);
    if (hf == 0) tab[r] = 1.f / sqrtf(s / (float)K + 1e-6f);
}

__device__ __forceinline__ void gmlp_phase(const Params& p, char* shm, int vcu) {
    int tid = threadIdx.x; asm volatile("" : "+v"(tid));
    const int wid = __builtin_amdgcn_readfirstlane(tid >> 6), lane = tid & 63, fr = lane & 15, fq = lane >> 4;
    const int h = vcu & 3, iabs = 16 * wid + fr;
    bf16x8 wf[4];
#pragma unroll
    for (int ks = 0; ks < 4; ++ks) {
        const float* w = p.w_sp + ((size_t)h * 128 + iabs) * 128 + 32 * ks + 8 * fq;
        const f32x4 w0 = *(const f32x4*)w, w1 = *(const f32x4*)(w + 4);
        const bool ok = (ks >> 1) <= (iabs >> 6);
        u32x4 pk; pk.x = pk2(w0[0], w0[1]); pk.y = pk2(w0[2], w0[3]); pk.z = pk2(w1[0], w1[1]); pk.w = pk2(w1[2], w1[3]);
        if (!ok) pk = (u32x4){0u, 0u, 0u, 0u};
        wf[ks] = __builtin_bit_cast(bf16x8, pk);
    }
    const float bias = p.b_sp[h * 128 + iabs];
    const int nks = (wid < 4) ? 2 : 4;
    const int j = tid >> 2, part = tid & 3;
    const int nb_ = gridDim.x, nrem = 896 % nb_, ng = (nb_ == 256) ? ((vcu >= nrem) ? 5 : 3) : -1;
    for (int gi = 0;; ++gi) {
        int u;
        if (ng < 0) { u = vcu + gi * nb_; if (u >= (T_TOK / 128) * 4) break; }
        else { if (gi >= ng) break; u = gi < 3 ? vcu + gi * 256 : 768 + (vcu - 128) + 128 * (gi - 3); }
        const int bn = u >> 2, row0 = bn * 128;
        {
            const bf16_t* vr = p.zv + (size_t)(row0 + j) * 512 + h * 128 + part * 32;
            float v[32];
#pragma unroll
            for (int q = 0; q < 4; ++q) { const u32x4 w = *(const u32x4*)(vr + 8 * q);
                v[8 * q + 0] = bflo(w.x); v[8 * q + 1] = bfhi(w.x); v[8 * q + 2] = bflo(w.y); v[8 * q + 3] = bfhi(w.y);
                v[8 * q + 4] = bflo(w.z); v[8 * q + 5] = bfhi(w.z); v[8 * q + 6] = bflo(w.w); v[8 * q + 7] = bfhi(w.w); }
            float s = 0.f;
#pragma unroll
            for (int e = 0; e < 32; ++e) s += v[e];
            s += shx(s, 1); s += shx(s, 2);
            const float mean = s * (1.f / 128.f); float s2 = 0.f;
#pragma unroll
            for (int e = 0; e < 32; ++e) { v[e] -= mean; s2 += v[e] * v[e]; }
            s2 += shx(s2, 1); s2 += shx(s2, 2);
            const float rstd = 1.f / sqrtf(s2 * (1.f / 128.f) + 1e-5f);
            const float* gg = p.gm_g + h * 128 + part * 32; const float* bb = p.gm_b + h * 128 + part * 32;
#pragma unroll
            for (int e = 0; e < 32; ++e) *(bf16_t*)(shm + (part * 32 + e) * 272 + j * 2) = f2bf(v[e] * rstd * gg[e] + bb[e]);
        }
        __syncthreads();
        f32x4 acc[8];
#pragma unroll
        for (int cb = 0; cb < 8; ++cb) acc[cb] = (f32x4){0.f, 0.f, 0.f, 0.f};
#pragma unroll
        for (int ks = 0; ks < 4; ++ks) if (ks < nks) {
#pragma unroll
            for (int cb = 0; cb < 8; ++cb) { const bf16x8 a = *(const bf16x8*)(shm + (16 * cb + fr) * 272 + (32 * ks + 8 * fq) * 2);
                acc[cb] = __builtin_amdgcn_mfma_f32_16x16x32_bf16(a, wf[ks], acc[cb], 0, 0, 0); }
        }
        const bf16_t* ur = p.zu + (size_t)(row0 + iabs) * 512 + h * 128 + 4 * fq;
        bf16_t* orow = p.mix + (size_t)(row0 + iabs) * DM + h * 128 + 4 * fq;
#pragma unroll
        for (int cb = 0; cb < 8; ++cb) { const u32x2 uw = *(const u32x2*)(ur + 16 * cb); f32x4 o;
            o[0] = bflo(uw.x) * (acc[cb][0] + bias); o[1] = bfhi(uw.x) * (acc[cb][1] + bias); o[2] = bflo(uw.y) * (acc[cb][2] + bias); o[3] = bfhi(uw.y) * (acc[cb][3] + bias);
            st4(orow + 16 * cb, o); }
        __syncthreads();
    }
}

constexpr int KT_STRIDE = 400, VT_STRIDE = 144, KT_BYTES = 64 * KT_STRIDE, ATT_STAGE = KT_BYTES + 128 * VT_STRIDE;
template <int AMODE> __device__ __forceinline__ void attn_block(const Params& p, char* shm, int bh, int qb, bf16_t* outbuf) {
    int tid = threadIdx.x; asm volatile("" : "+v"(tid));
    const int wid = __builtin_amdgcn_readfirstlane(tid >> 6), lane = tid & 63, r = lane & 31, hh = lane >> 5;
    const int b = bh >> 2, h = bh & 3, q0 = qb * 256, ntile = 4 * qb + 4, nw = 4 * qb + (wid >> 1) + 1;
    bf16x8 qf[12];
    { const bf16_t* qp = p.Q + ((size_t)bh * SEQ + q0 + 32 * wid + r) * 192 + 8 * hh;
#pragma unroll
      for (int s = 0; s < 12; ++s) qf[s] = *(const bf16x8*)(qp + 16 * s);
      const float2* rp = p.rope + ((size_t)b * SEQ + q0 + 32 * wid + r) * 32 + 8 * hh;
#pragma unroll
      for (int s = 0; s < 2; ++s) { u32x4 x1 = __builtin_bit_cast(u32x4, qf[8 + s]), x2 = __builtin_bit_cast(u32x4, qf[10 + s]); float a[8], c2[8];
          a[0] = bflo(x1.x); a[1] = bfhi(x1.x); a[2] = bflo(x1.y); a[3] = bfhi(x1.y); a[4] = bflo(x1.z); a[5] = bfhi(x1.z); a[6] = bflo(x1.w); a[7] = bfhi(x1.w);
          c2[0] = bflo(x2.x); c2[1] = bfhi(x2.x); c2[2] = bflo(x2.y); c2[3] = bfhi(x2.y); c2[4] = bflo(x2.z); c2[5] = bfhi(x2.z); c2[6] = bflo(x2.w); c2[7] = bfhi(x2.w);
          float o1[8], o2[8];
#pragma unroll
          for (int j = 0; j < 8; ++j) { const float2 cs = rp[16 * s + j]; o1[j] = a[j] * cs.x - c2[j] * cs.y; o2[j] = c2[j] * cs.x + a[j] * cs.y; }
          x1.x = pk2(o1[0], o1[1]); x1.y = pk2(o1[2], o1[3]); x1.z = pk2(o1[4], o1[5]); x1.w = pk2(o1[6], o1[7]);
          x2.x = pk2(o2[0], o2[1]); x2.y = pk2(o2[2], o2[3]); x2.z = pk2(o2[4], o2[5]); x2.w = pk2(o2[6], o2[7]);
          qf[8 + s] = __builtin_bit_cast(bf16x8, x1); qf[10 + s] = __builtin_bit_cast(bf16x8, x2); } }
    f32x16 O[4];
#pragma unroll
    for (int d = 0; d < 4; ++d)
#pragma unroll
        for (int t = 0; t < 16; ++t) O[d][t] = 0.f;
    float m = -INFINITY, l = 0.f;
    const bf16_t* kn_src = p.Kn + ((size_t)bh * SEQ + (tid >> 4)) * 128 + (tid & 15) * 8;
    const bf16_t* kr_src = p.krope + ((size_t)b * SEQ + (tid >> 3)) * 64 + (tid & 7) * 8;
    const bf16_t* vt_src = p.Vt + ((size_t)bh * 128 + (tid >> 3)) * SEQ + (tid & 7) * 8;
    const int kn_dst = (tid >> 4) * KT_STRIDE + (tid & 15) * 16, kr_dst = (tid >> 3) * KT_STRIDE + 256 + (tid & 7) * 16, vt_dst = KT_BYTES + (tid >> 3) * VT_STRIDE + (tid & 7) * 16;
    u32x4 g0, g1, g2, g3, g4;
    #define ATT_LOAD(kt) do { g0 = *(const u32x4*)(kn_src + (size_t)(kt) * 64 * 128); g1 = *(const u32x4*)(kn_src + (size_t)((kt) * 64 + 32) * 128); \
        g2 = *(const u32x4*)(kr_src + (size_t)(kt) * 64 * 64); g3 = *(const u32x4*)(vt_src + (kt) * 64); g4 = *(const u32x4*)(vt_src + (size_t)64 * SEQ + (kt) * 64); } while (0)
    #define ATT_WRITE(buf) do { char* _s = shm + (buf) * ATT_STAGE; *(u32x4*)(_s + kn_dst) = g0; *(u32x4*)(_s + kn_dst + 32 * KT_STRIDE) = g1; *(u32x4*)(_s + kr_dst) = g2; \
        *(u32x4*)(_s + vt_dst) = g3; *(u32x4*)(_s + vt_dst + 64 * VT_STRIDE) = g4; } while (0)
    ATT_LOAD(0); ATT_WRITE(0);
    __syncthreads();
    for (int kt = 0; kt < ntile; ++kt) {
        const bool more = kt + 1 < ntile;
        if (more) ATT_LOAD(kt + 1);
        if (kt < nw) {
            const char* ks = shm + (kt & 1) * ATT_STAGE; const char* vs = ks + KT_BYTES;
            f32x16 S0, S1;
#pragma unroll
            for (int t = 0; t < 16; ++t) { S0[t] = 0.f; S1[t] = 0.f; }
            if (AMODE != 4 && AMODE != 5) {
            __builtin_amdgcn_s_setprio(1);
#pragma unroll
            for (int s = 0; s < 12; ++s) {
                const bf16x8 k0 = *(const bf16x8*)(ks + r * KT_STRIDE + (16 * s + 8 * hh) * 2), k1 = *(const bf16x8*)(ks + (32 + r) * KT_STRIDE + (16 * s + 8 * hh) * 2);
                S0 = __builtin_amdgcn_mfma_f32_32x32x16_bf16(k0, qf[s], S0, 0, 0, 0);
                S1 = __builtin_amdgcn_mfma_f32_32x32x16_bf16(k1, qf[s], S1, 0, 0, 0);
            }
            __builtin_amdgcn_s_setprio(0);
            } else { asm volatile("" : "+v"(S0), "+v"(S1)); }
            float mt = fmaxf(S0[0], S1[0]);
#pragma unroll
            for (int t = 1; t < 16; ++t) mt = fmaxf(mt, fmaxf(S0[t], S1[t]));
            mt = fmaxf(mt, shx(mt, 32));
            if (AMODE == 2 || AMODE == 5) { m = 0.f; l = 1.f; asm volatile("" : "+v"(S0), "+v"(S1)); } else {
            if (!__all(mt - m <= 8.0f)) {
                const float mn = fmaxf(m, mt), alpha = __builtin_amdgcn_exp2f(m - mn); m = mn; l *= alpha;
#pragma unroll
                for (int d = 0; d < 4; ++d)
#pragma unroll
                    for (int t = 0; t < 16; ++t) O[d][t] *= alpha;
            }
            float ls = 0.f;
#pragma unroll
            for (int t = 0; t < 16; ++t) { S0[t] = __builtin_amdgcn_exp2f(S0[t] - m); S1[t] = __builtin_amdgcn_exp2f(S1[t] - m); ls += S0[t] + S1[t]; }
            l += ls; }
            bf16x8 pf[4];
#pragma unroll
            for (int s = 0; s < 2; ++s) {
                u32x4 a, c; a.x = pk2(S0[8 * s + 0], S0[8 * s + 1]); a.y = pk2(S0[8 * s + 2], S0[8 * s + 3]); a.z = pk2(S0[8 * s + 4], S0[8 * s + 5]); a.w = pk2(S0[8 * s + 6], S0[8 * s + 7]);
                c.x = pk2(S1[8 * s + 0], S1[8 * s + 1]); c.y = pk2(S1[8 * s + 2], S1[8 * s + 3]); c.z = pk2(S1[8 * s + 4], S1[8 * s + 5]); c.w = pk2(S1[8 * s + 6], S1[8 * s + 7]);
                pf[s] = __builtin_bit_cast(bf16x8, a); pf[2 + s] = __builtin_bit_cast(bf16x8, c);
            }
            if (AMODE == 3 || AMODE == 5) { asm volatile("" :: "v"(pf[0]), "v"(pf[1]), "v"(pf[2]), "v"(pf[3])); } else {
            __builtin_amdgcn_s_setprio(1);
#pragma unroll
            for (int k4 = 0; k4 < 4; ++k4)
#pragma unroll
                for (int d = 0; d < 4; ++d) { const bf16x8 vf = *(const bf16x8*)(vs + (32 * d + r) * VT_STRIDE + (16 * k4 + 8 * hh) * 2);
                    O[d] = __builtin_amdgcn_mfma_f32_32x32x16_bf16(vf, pf[k4], O[d], 0, 0, 0); }
            __builtin_amdgcn_s_setprio(0); }
        }
        if (more) ATT_WRITE((kt + 1) & 1);
        __syncthreads();
    }
    #undef ATT_LOAD
    #undef ATT_WRITE
    l += shx(l, 32);
    const float inv = 1.f / l;
    bf16_t* o = outbuf + ((size_t)b * SEQ + q0 + 32 * wid + r) * DM + 512 + h * 128 + 4 * hh;
#pragma unroll
    for (int d = 0; d < 4; ++d)
#pragma unroll
        for (int g = 0; g < 4; ++g) { f32x4 v; v[0] = O[d][4 * g] * inv; v[1] = O[d][4 * g + 1] * inv; v[2] = O[d][4 * g + 2] * inv; v[3] = O[d][4 * g + 3] * inv; st4(o + 32 * d + 8 * g, v); }
}


__device__ __forceinline__ void router_tile(const Params& p, char* smc, int tb) {
    int tid = threadIdx.x; asm volatile("" : "+v"(tid));
    const int wid = __builtin_amdgcn_readfirstlane(tid >> 6), lane = tid & 63, fr = lane & 15, fq = lane >> 4;
    int* lcnt = (int*)(smc + LDS_LCNT);
    { u32x4 wreg[18];
#pragma unroll
      for (int k = 0; k < 18; ++k) { const int i = tid + k * NTHR; wreg[k] = *(const u32x4*)(p.WrT + (size_t)i * 8); }
#pragma unroll
      for (int k = 0; k < 18; ++k) { const int i = tid + k * NTHR, img = i / (36 * 128), rem = i - img * 36 * 128, o = rem >> 7, ch = rem & 127;
          *(u32x4*)(smc + LDS_RW + img * 73728 + o * 2048 + ((ch ^ (o & 15)) << 4)) = wreg[k]; } }
    if (tid < NEXP) lcnt[tid] = 0;
    __syncthreads();
    const int tok = tb * 128 + wid * 16 + fr;
    bf16_t* hr = p.hbuf + (size_t)tok * DM + 8 * fq;
    float s = 0.f, s2 = 0.f;
#if YSTAT
    { const f32x4 a = *(const f32x4*)(p.ystat + (size_t)tok * 32 + 8 * fq), b = *(const f32x4*)(p.ystat + (size_t)tok * 32 + 8 * fq + 4); s = (a[0] + a[2]) + (b[0] + b[2]); s2 = (a[1] + a[3]) + (b[1] + b[3]); }
    s += shx(s, 16); s += shx(s, 32); s2 += shx(s2, 16); s2 += shx(s2, 32);
#else
#pragma unroll 8
    for (int ks = 0; ks < 32; ++ks) { const u32x4 y = *(const u32x4*)(hr + 32 * ks);
        const float a0 = bflo(y.x), a1 = bfhi(y.x), a2 = bflo(y.y), a3 = bfhi(y.y), a4 = bflo(y.z), a5 = bfhi(y.z), a6 = bflo(y.w), a7 = bfhi(y.w);
        s += ((a0 + a1) + (a2 + a3)) + ((a4 + a5) + (a6 + a7)); s2 += ((a0 * a0 + a1 * a1) + (a2 * a2 + a3 * a3)) + ((a4 * a4 + a5 * a5) + (a6 * a6 + a7 * a7)); }
    s += shx(s, 16); s += shx(s, 32); s2 += shx(s2, 16); s2 += shx(s2, 32);
#endif
    const float mean = s * (1.f / 1024.f), var = fmaxf(s2 * (1.f / 1024.f) - mean * mean, 0.f), rstd = 1.f / sqrtf(var + 1e-5f);
    const int o0 = fr < 4 ? fr : 3, o1 = 4 + fr, o2 = 20 + fr;
    const int w0 = o0 * 2048, w1 = o1 * 2048, w2 = o2 * 2048, x0 = o0 & 15, x1 = o1 & 15, x2 = o2 & 15;
    f32x4 acc0 = {0.f, 0.f, 0.f, 0.f}, acc1 = acc0, acc2 = acc0;
    const float* lg_ = p.ln1_g + 8 * fq; const float* lb_ = p.ln1_b + 8 * fq;
#pragma unroll 8
    for (int ks = 0; ks < 32; ++ks) {
        const f32x4 g0 = *(const f32x4*)(lg_ + 32 * ks), g1 = *(const f32x4*)(lg_ + 32 * ks + 4), b0 = *(const f32x4*)(lb_ + 32 * ks), b1 = *(const f32x4*)(lb_ + 32 * ks + 4);
        const u32x4 yy = *(const u32x4*)(hr + 32 * ks);
        float h[8];
        h[0] = (bflo(yy.x) - mean) * rstd * g0[0] + b0[0]; h[1] = (bfhi(yy.x) - mean) * rstd * g0[1] + b0[1]; h[2] = (bflo(yy.y) - mean) * rstd * g0[2] + b0[2]; h[3] = (bfhi(yy.y) - mean) * rstd * g0[3] + b0[3];
        h[4] = (bflo(yy.z) - mean) * rstd * g1[0] + b1[0]; h[5] = (bfhi(yy.z) - mean) * rstd * g1[1] + b1[1]; h[6] = (bflo(yy.w) - mean) * rstd * g1[2] + b1[2]; h[7] = (bfhi(yy.w) - mean) * rstd * g1[3] + b1[3];
        u32x4 hi, lo; hi.x = pk2(h[0], h[1]); hi.y = pk2(h[2], h[3]); hi.z = pk2(h[4], h[5]); hi.w = pk2(h[6], h[7]);
        *(u32x4*)(hr + 32 * ks) = hi;
        lo.x = pk2(h[0] - bflo(hi.x), h[1] - bfhi(hi.x)); lo.y = pk2(h[2] - bflo(hi.y), h[3] - bfhi(hi.y)); lo.z = pk2(h[4] - bflo(hi.z), h[5] - bfhi(hi.z)); lo.w = pk2(h[6] - bflo(hi.w), h[7] - bfhi(hi.w));
        const bf16x8 hh = __builtin_bit_cast(bf16x8, hi), hl = __builtin_bit_cast(bf16x8, lo);
        const int ch = 4 * ks + fq;
        const bf16x8 a0h = *(const bf16x8*)(smc + LDS_RW + w0 + ((ch ^ x0) << 4)), a0l = *(const bf16x8*)(smc + LDS_RW + 73728 + w0 + ((ch ^ x0) << 4));
        const bf16x8 a1h = *(const bf16x8*)(smc + LDS_RW + w1 + ((ch ^ x1) << 4)), a1l = *(const bf16x8*)(smc + LDS_RW + 73728 + w1 + ((ch ^ x1) << 4));
        const bf16x8 a2h = *(const bf16x8*)(smc + LDS_RW + w2 + ((ch ^ x2) << 4)), a2l = *(const bf16x8*)(smc + LDS_RW + 73728 + w2 + ((ch ^ x2) << 4));
        acc0 = __builtin_amdgcn_mfma_f32_16x16x32_bf16(a0h, hh, acc0, 0, 0, 0); acc0 = __builtin_amdgcn_mfma_f32_16x16x32_bf16(a0h, hl, acc0, 0, 0, 0); acc0 = __builtin_amdgcn_mfma_f32_16x16x32_bf16(a0l, hh, acc0, 0, 0, 0);
        acc1 = __builtin_amdgcn_mfma_f32_16x16x32_bf16(a1h, hh, acc1, 0, 0, 0); acc1 = __builtin_amdgcn_mfma_f32_16x16x32_bf16(a1h, hl, acc1, 0, 0, 0); acc1 = __builtin_amdgcn_mfma_f32_16x16x32_bf16(a1l, hh, acc1, 0, 0, 0);
        acc2 = __builtin_amdgcn_mfma_f32_16x16x32_bf16(a2h, hh, acc2, 0, 0, 0); acc2 = __builtin_amdgcn_mfma_f32_16x16x32_bf16(a2h, hl, acc2, 0, 0, 0); acc2 = __builtin_amdgcn_mfma_f32_16x16x32_bf16(a2l, hh, acc2, 0, 0, 0);
    }
    __syncthreads();
    float* sc = (float*)(smc + LDS_RW) + wid * (16 * 40) + fr * 40;
    if (fq == 0) { sc[0] = acc0[0]; sc[1] = acc0[1]; sc[2] = acc0[2]; sc[3] = acc0[3]; }
    *(f32x4*)(sc + 4 + 4 * fq) = acc1; *(f32x4*)(sc + 20 + 4 * fq) = acc2;
    __syncthreads();
    if (lane < 16) {
        const float* lr = (const float*)(smc + LDS_RW) + wid * (16 * 40) + lane * 40;
        float lg[36];
#pragma unroll
        for (int o = 0; o < 36; o += 4) { const f32x4 v = *(const f32x4*)(lr + o); lg[o] = v[0]; lg[o + 1] = v[1]; lg[o + 2] = v[2]; lg[o + 3] = v[3]; }
#pragma unroll
        for (int o = 0; o < 4; ++o) lg[o] += p.b_rg[o];
#pragma unroll
        for (int o = 0; o < 32; ++o) lg[4 + o] += p.b_re[o];
        int g = 0; float gm = lg[0];
#pragma unroll
        for (int i = 1; i < 4; ++i) if (lg[i] > gm) { gm = lg[i]; g = i; }
        float se = 0.f;
#pragma unroll
        for (int i = 0; i < 4; ++i) se += expf(lg[i] - gm);
        const float pg = 1.f / se;
        float ev[8];
#pragma unroll
        for (int e = 0; e < 8; ++e) ev[e] = g == 0 ? lg[4 + e] : g == 1 ? lg[12 + e] : g == 2 ? lg[20 + e] : lg[28 + e];
        int i1 = 0; float v1 = ev[0];
#pragma unroll
        for (int e = 1; e < 8; ++e) if (ev[e] > v1) { v1 = ev[e]; i1 = e; }
        int i2 = -1; float v2 = -3.0e38f;
#pragma unroll
        for (int e = 0; e < 8; ++e) if (e != i1 && ev[e] > v2) { v2 = ev[e]; i2 = e; }
        const float d = expf(v2 - v1), g1 = pg / (1.f + d), g2 = pg * d / (1.f + d);
        const int t = tb * 128 + wid * 16 + lane, e1 = g * 8 + i1, e2 = g * 8 + i2;
        const int s1 = atomicAdd(lcnt + e1, 1), s2_ = atomicAdd(lcnt + e2, 1);
        p.listb[((size_t)tb * NEXP + e1) * 256 + s1] = 2 * t; p.listb[((size_t)tb * NEXP + e2) * 256 + s2_] = 2 * t + 1;
        p.gates[2 * t] = g1; p.gates[2 * t + 1] = g2;
    }
    __syncthreads();
    if (tid < NEXP) p.cntb[tb * NEXP + tid] = lcnt[tid];
    __syncthreads();
}
__device__ __forceinline__ void moe_tables(const Params& p, char* smc) {
    int tid = threadIdx.x; asm volatile("" : "+v"(tid));
    const int e = tid & 31, seg = tid >> 5;
    unsigned short* pre = (unsigned short*)(smc + LDS_PRE); int* tot = (int*)(smc + LDS_TOT); int* segtot = (int*)(smc + LDS_SEG);
    int c[16]; int run = 0;
#pragma unroll
    for (int i = 0; i < 16; ++i) c[i] = p.cntb[(16 * seg + i) * NEXP + e];
#pragma unroll
    for (int i = 0; i < 16; ++i) { const int v = c[i]; c[i] = run; run += v; }
    segtot[seg * 32 + e] = run;
    __syncthreads();
    int base = 0, all = 0;
#pragma unroll
    for (int s = 0; s < 16; ++s) { const int v = segtot[s * 32 + e]; base += (s < seg) ? v : 0; all += v; }
#pragma unroll
    for (int i = 0; i < 16; ++i) pre[e * 256 + 16 * seg + i] = (unsigned short)(base + c[i]);
    if (seg == 0) tot[e] = all;
    __syncthreads();
}

template <class PH> __device__ __forceinline__ void gemm_phase(const PH& ph, LAS unsigned char* shm, int vcu) {
#if defined(NOSTREAM)
    for (int u = vcu;; u += gridDim.x) { Unit<typename PH::EP> un; if (u >= PH::NU || !ph.unit(u, un)) break; gemm256(un, shm); }
#else
    gemm_stream(ph, shm, vcu, gridDim.x);
#endif
}

struct PhKVc { Params p; const float* tab; int pm; typedef EpiKV EP; static constexpr int NU = 4;
    __device__ __forceinline__ bool unit(int pn, Unit<EP>& o) const {
        o.am = AMap{p.zkv + (size_t)pm * 256 * 256, 256, nullptr, 256}; o.bt = p.WukvT + (size_t)pn * 256 * 256; o.K = 256;
        o.ep = EpiKV{p.Kn, p.Vt, tab, pm * 256, pm * 256, pn * 256}; return true; } };
struct PhZ2 { Params p; typedef EpiZ EP; static constexpr int NU = 128 * 2;
    __device__ __forceinline__ bool unit(int v, Unit<EP>& o) const { const int pm = v >> 1, pn = 5 + (v & 1);
        o.am = AMap{p.hbuf + (size_t)pm * 256 * DM, DM, nullptr, 256}; o.bt = p.WinT + (size_t)pn * 256 * DM; o.K = DM;
        o.ep = EpiZ{p.zu, p.zv, p.zq, p.zkv, p.krope, p.rope, pm * 256, pn * 256}; return true; } };
struct PhZ3x { Params p; int xq; typedef EpiZ EP; static constexpr int NU = 48;
    __device__ __forceinline__ bool unit(int v, Unit<EP>& o) const { const int pm = 16 * xq + v / 3, pn = 4 + v % 3;
        o.am = AMap{p.hbuf + (size_t)pm * 256 * DM, DM, nullptr, 256}; o.bt = p.WinT + (size_t)pn * 256 * DM; o.K = DM;
        o.ep = EpiZ{p.zu, p.zv, p.zq, p.zkv, p.krope, p.rope, pm * 256, pn * 256}; return true; } };
struct PhZ3 { Params p; typedef EpiZ EP; static constexpr int NU = 128 * 3;
    __device__ __forceinline__ bool unit(int v, Unit<EP>& o) const { const int pm = v / 3, pn = 4 + (v - pm * 3);
        o.am = AMap{p.hbuf + (size_t)pm * 256 * DM, DM, nullptr, 256}; o.bt = p.WinT + (size_t)pn * 256 * DM; o.K = DM;
        o.ep = EpiZ{p.zu, p.zv, p.zq, p.zkv, p.krope, p.rope, pm * 256, pn * 256}; return true; } };
struct PhQs { Params p; const float* tab; int u0, ustride; typedef EpiQ EP; static constexpr int NU = 128 * 3;
    __device__ __forceinline__ bool unit(int u, Unit<EP>& o) const { const int pm = u / 3, pn = u - pm * 3, slot = (u - u0) / ustride;
        o.am = AMap{p.zq + (size_t)pm * 256 * 384, 384, nullptr, 256}; o.bt = p.WuqT + (size_t)pn * 256 * 384; o.K = 384;
        o.ep = EpiQ{p.Q, tab + slot * 256, pm * 256, pm * 256, pn * 256}; return true; } };
struct PhKVs { Params p; const float* tab; int u0, ustride; typedef EpiKV EP; static constexpr int NU = 128 * 3 + 128 * 4;
    __device__ __forceinline__ bool unit(int u, Unit<EP>& o) const { const int v = u - 384, pm = v >> 2, pn = v & 3, slot = (u - u0) / ustride;
        o.am = AMap{p.zkv + (size_t)pm * 256 * 256, 256, nullptr, 256}; o.bt = p.WukvT + (size_t)pn * 256 * 256; o.K = 256;
        o.ep = EpiKV{p.Kn, p.Vt, tab + slot * 256, pm * 256, pm * 256, pn * 256}; return true; } };
struct PhKVb { Params p; const float* tab; int kbeg, kend, slot0; typedef EpiKV EP; static constexpr int NU = 128 * 4;
    __device__ __forceinline__ bool unit(int k, Unit<EP>& o) const { if (k >= kend) return false; const int pm = k >> 2, pn = k & 3, slot = slot0 + (k - kbeg);
        o.am = AMap{p.zkv + (size_t)pm * 256 * 256, 256, nullptr, 256}; o.bt = p.WukvT + (size_t)pn * 256 * 256; o.K = 256;
        o.ep = EpiKV{p.Kn, p.Vt, tab + slot * 256, pm * 256, pm * 256, pn * 256}; return true; } };
struct PhHs { Params p; const int* tot; const int* aid_tab; int u0, ustride; typedef EpiH EP; static constexpr int NU = 288 * 2;
    __device__ __forceinline__ bool unit(int u, Unit<EP>& o) const { int e, rt, ct, pr; if (!moe_unit(tot, u, 2, e, rt, ct, pr)) return false;
        const int nv = __builtin_amdgcn_readfirstlane(min(256, tot[e] - rt * 256)), slot = (u - u0) / ustride;
        o.am = AMap{p.hbuf, DM, aid_tab + slot * 256, nv}; o.bt = p.WguT + ((size_t)e * 512 + ct * 256) * DM; o.K = DM;
        o.ep = EpiH{p.H, pr, ct * 256, MERGE67 != 0}; return true; }
    __device__ __forceinline__ void done(const Unit<EP>& cu, int wr) const {
        asm volatile("s_waitcnt vmcnt(0)" ::: "memory");
        if (wr == 0) __builtin_amdgcn_s_barrier();
        __builtin_amdgcn_s_barrier();
        if (threadIdx.x == 0) __hip_atomic_fetch_add(hready + (cu.ep.hrow0 >> 8), 1u, __ATOMIC_RELAXED, __HIP_MEMORY_SCOPE_AGENT);
        if (wr == 1) __builtin_amdgcn_s_barrier();
    }
    unsigned* hready; };
struct PhCs { Params p; const int* tot; unsigned* hready; int u0; unsigned* queue; volatile int* slot; typedef EpiC EP; static constexpr int NU = 288 * 4;
    __device__ __forceinline__ int take(bool stagger, int wr) const {
        if (stagger && wr == 0) __builtin_amdgcn_s_barrier();
        if (threadIdx.x == 0) slot[0] = (int)__hip_atomic_fetch_add(queue, 1u, __ATOMIC_RELAXED, __HIP_MEMORY_SCOPE_AGENT);
        __builtin_amdgcn_s_barrier();
        const int t = __builtin_amdgcn_readfirstlane(slot[0]);
        __builtin_amdgcn_s_barrier();
        if (stagger && wr == 1) __builtin_amdgcn_s_barrier();
        return t;
    }
    __device__ __forceinline__ int next(int wr) const { return take(true, wr); }
    __device__ __forceinline__ bool unit(int u, Unit<EP>& o) const { int e, rt, ct, pr; if (!moe_unit(tot, u, 4, e, rt, ct, pr)) return false;
        const int wr = __builtin_amdgcn_readfirstlane((int)threadIdx.x >> 8);
        if (u != u0 && wr == 0) __builtin_amdgcn_s_barrier();
        if (threadIdx.x == 0) { unsigned sp = 0; unsigned* w = hready + (pr >> 8);
            while (__hip_atomic_load(w, __ATOMIC_RELAXED, __HIP_MEMORY_SCOPE_AGENT) < 2u) { __builtin_amdgcn_s_sleep(2); if (++sp > (1u << 20)) break; }
            __builtin_amdgcn_fence(__ATOMIC_ACQUIRE, "agent");
            asm volatile("s_waitcnt vmcnt(0)" ::: "memory"); }
        __builtin_amdgcn_s_barrier();
        if (u != u0 && wr == 1) __builtin_amdgcn_s_barrier();
        const int nv = __builtin_amdgcn_readfirstlane(min(256, tot[e] - rt * 256));
        o.am = AMap{p.H + (size_t)pr * FF, FF, nullptr, 256}; o.bt = p.WdT + ((size_t)e * DM + ct * 256) * FF; o.K = FF;
        o.ep = EpiC{p.contrib, p.list + (size_t)e * LIST_CAP + rt * 256, p.gates, nv, ct * 256}; return true; } };


struct PhZj { Params p; int u0; unsigned* cnt; typedef EpiZ EP; static constexpr int NU = 128 * 7;
    __device__ __forceinline__ void chunk(int u) const {
        int tid = threadIdx.x; asm volatile("" : "+v"(tid));
        const int wid = __builtin_amdgcn_readfirstlane(tid >> 6), lane = tid & 63;
        const int pm = u / 7, pn = u - pm * 7, r0 = pm * 256 + pn * 36 + (pn < 4 ? pn : 4), n = pn < 4 ? 37 : 36;
        ln0_row4<true>(p.x + (size_t)(r0 + wid) * DM, (size_t)8 * DM, p.ln0_g, p.ln0_b, p.hbuf + (size_t)(r0 + wid) * DM, lane);
        if (32 + wid < n) ln0_row1_wt(p.x + (size_t)(r0 + 32 + wid) * DM, p.ln0_g, p.ln0_b, p.hbuf + (size_t)(r0 + 32 + wid) * DM, lane);
        asm volatile("s_waitcnt vmcnt(0)" ::: "memory");
        __syncthreads();
        if (tid == 0) {
            __hip_atomic_fetch_add(cnt + pm, 1u, __ATOMIC_RELAXED, __HIP_MEMORY_SCOPE_AGENT);
            unsigned sp = 0;
            while (__hip_atomic_load(cnt + pm, __ATOMIC_RELAXED, __HIP_MEMORY_SCOPE_AGENT) < 7u) { __builtin_amdgcn_s_sleep(2); if (++sp > (1u << 18)) break; }
            __builtin_amdgcn_fence(__ATOMIC_ACQUIRE, "agent");
            asm volatile("s_waitcnt vmcnt(0)" ::: "memory");
        }
        __syncthreads();
    }
    __device__ __forceinline__ bool unit(int u, Unit<EP>& o) const {
        if (u != u0) {
            const int wr = __builtin_amdgcn_readfirstlane((int)threadIdx.x >> 8);
            if (wr == 0) __builtin_amdgcn_s_barrier();
            chunk(u);
            if (wr == 1) __builtin_amdgcn_s_barrier();
        }
        const int pm = u / 7, pn = u - pm * 7;
        o.am = AMap{p.hbuf + (size_t)pm * 256 * DM, DM, nullptr, 256}; o.bt = p.WinT + (size_t)pn * 256 * DM; o.K = DM;
        o.ep = EpiZ{p.zu, p.zv, p.zq, p.zkv, p.krope, p.rope, pm * 256, pn * 256}; return true; } };

typedef const __attribute__((address_space(4))) Params* KParams;
__device__ __forceinline__ Params ldp() {
#if defined(__HIP_DEVICE_COMPILE__)
    KParams q = (KParams)__builtin_amdgcn_kernarg_segment_ptr(); asm volatile("" : "+s"(q)); return *q;
#else
    return Params{};
#endif
}
template <int LO, int HI>
__global__ __launch_bounds__(512, 2) void mega(Params p_arg_unused) {
    extern __shared__ __attribute__((aligned(16))) unsigned char lds_raw[];
    LAS unsigned char* shm = (LAS unsigned char*)lds_raw;
    char* smc = (char*)lds_raw;
    const int nblk = gridDim.x;
    const int vcu = (nblk % 8 == 0) ? (int)(blockIdx.x % 8) * (nblk / 8) + (int)(blockIdx.x / 8) : (int)blockIdx.x;
    #define PHASE_IDS int tid = threadIdx.x; asm volatile("" : "+v"(tid)); const int wid = __builtin_amdgcn_readfirstlane(tid >> 6), lane = tid & 63; (void)wid; (void)lane
    XcdBarrier xb;
    if (LO != HI) {
        if (threadIdx.x == 0) { ((volatile LAS unsigned*)(smc + LDS_XB))[0] = 0u; ((volatile LAS unsigned*)(smc + LDS_XB))[1] = 0u; }
        __syncthreads();
        { const Params p = ldp(); xb = xcd_barrier_post(p.bar, (volatile LAS unsigned*)(smc + LDS_XB)); }
    }
#ifndef TIMEPH
#define TIMEPH -1
#endif
    unsigned long long ts0_ = 0, ts1_ = 0;
    #define TSTAMP(k) do { if (TIMEPH >= 0) { if ((k) == TIMEPH) ts0_ = __builtin_amdgcn_s_memrealtime(); if ((k) == TIMEPH + 1) ts1_ = __builtin_amdgcn_s_memrealtime(); } } while (0)
    #define SEAM(ph) do { if (LO <= (ph) && HI > (ph)) xcd_barrier(xb); TSTAMP((ph) + 1); } while (0)
    TSTAMP(0);
#ifndef REPMASK
#define REPMASK 0
#endif
    #define NREP(k) ((((REPMASK) >> (k)) & 1) ? 2 : 1)
    #define REPEAT(k) for (int rep_ = 0; rep_ < NREP(k); ++rep_, (rep_ < NREP(k) ? xcd_barrier(xb) : (void)0))
    if (LO <= 0 && HI >= 0) REPEAT(0) {
        const Params p = ldp(); PHASE_IDS;
        { float* scr = (float*)(smc + wid * (64 * 33 * 4)); const int gw = blockIdx.x * 8 + wid, ngw = nblk * 8;
#ifndef P0REP
#define P0REP 0
#endif
          for (int rep = 0; rep < ((P0REP & 1) ? 2 : 1); ++rep)
          for (int it = gw; it < I_EARLY; it += ngw) prep_witem(p, it, scr, lane);
#if !JIT_LN0
          for (int t = gw; t < T_TOK / 4; t += ngw) ln0_row4<false>(p.x + (size_t)t * DM, (size_t)(T_TOK / 4) * DM, p.ln0_g, p.ln0_b, p.hbuf + (size_t)t * DM, lane);
#endif
          }
        for (int rep = 0; rep < ((P0REP & 4) ? 2 : 1); ++rep)
        { const int i0 = blockIdx.x * NTHR + tid; const float inv = powf(10000.f, -(float)(2 * (i0 & 31)) / 64.f);
          if (nblk * NTHR * 8 == T_TOK * 32) { int ps[8];
#pragma unroll
              for (int k = 0; k < 8; ++k) ps[k] = p.pos[(i0 + k * nblk * NTHR) >> 5];
#pragma unroll
              for (int k = 0; k < 8; ++k) { const float ang = (float)ps[k] * inv; p.rope[i0 + k * nblk * NTHR] = make_float2(cosf(ang), sinf(ang)); } }
          else for (int i = i0; i < T_TOK * 32; i += nblk * NTHR) { const float ang = (float)p.pos[i >> 5] * inv; p.rope[i] = make_float2(cosf(ang), sinf(ang)); } }
        for (int i = blockIdx.x * NTHR + tid; i < 36 * 1024; i += nblk * NTHR) { const int o = i >> 10, k = i & 1023; const float w = o < 4 ? p.w_rg[k * 4 + o] : p.w_re[k * 32 + (o - 4)];
            const bf16_t hi = f2bf(w); p.WrT[i] = hi; p.WrT[36864 + i] = f2bf(w - bf2f(hi)); }
    }
    SEAM(0);
    if (LO <= 1 && HI >= 1) REPEAT(1) {
#if GMLP_FUSED && KVCHAIN
        { { const Params p = ldp(); gemm_stream(PhZ2{p}, shm, vcu, nblk); }
          for (;;) {
              int t;
              { const Params p = ldp(); PHASE_IDS; volatile int* slot = (volatile int*)(smc + LDS_AID);
                if (tid == 0) slot[0] = (int)__hip_atomic_fetch_add(p.bar + 3584, 1u, __ATOMIC_RELAXED, __HIP_MEMORY_SCOPE_AGENT);
                __syncthreads();
                t = __builtin_amdgcn_readfirstlane(slot[0]);
                __syncthreads(); }
              if (t >= 128 + 512 + 128) break;
              if (t < 128) { const Params p = ldp(); const int pm = t; float* tab = (float*)(smc + LDS_PRE);
                  Unit<EpiZ> un; un.am = AMap{p.hbuf + (size_t)pm * 256 * DM, DM, nullptr, 256}; un.bt = p.WinT + (size_t)4 * 256 * DM; un.K = DM; un.ep = EpiZ{p.zu, p.zv, p.zq, p.zkv, p.krope, p.rope, pm * 256, 4 * 256};
                  const KvArgs kv{p.zkv, tab, pm * 256};
                  gemm256<EpiZ, 2>(un, shm, nullptr, &kv);
                  gemm_stream(PhKVc{p, tab, pm}, shm, 0, 1);
              } else if (t < 128 + 512) { const Params p = ldp(); const int w = t - 128, pm = w >> 2, h = w & 3;
                  Unit<EpiZ> un; un.am = AMap{p.hbuf + (size_t)pm * 256 * DM, DM, nullptr, 256}; un.bt = p.WinT + (size_t)h * 256 * DM; un.K = DM; un.ep = EpiZ{p.zu, p.zv, p.zq, p.zkv, p.krope, p.rope, pm * 256, h * 256};
                  const GmArgs gm{p.gm_g, p.gm_b, p.w_sp, p.b_sp, p.mix, pm * 256, h};
                  gemm256<EpiZ, 1>(un, shm, &gm);
              } else { const Params p = ldp(); PHASE_IDS; const int ch = t - 640; float* scr = (float*)(smc + wid * (64 * 33 * 4));
                  for (int k = wid; k < 96; k += 8) prep_witem(p, I_EARLY + ch * 96 + k, scr, lane);
                  __syncthreads(); }
          } }
#elif GMLP_FUSED && P1QUEUE
        { const bool xl = (nblk == 256); const int xq = vcu >> 5;
          { const Params p = ldp(); if (xl) gemm_stream(PhZ3x{p, xq}, shm, vcu & 31, 32); else gemm_stream(PhZ3{p}, shm, vcu, nblk); }
          const int nfu = xl ? 64 : 512, nch = xl ? 16 : 128;
          for (;;) {
              int t;
              { const Params p = ldp(); PHASE_IDS; volatile int* slot = (volatile int*)(smc + LDS_AID);
                if (tid == 0) slot[0] = (int)__hip_atomic_fetch_add(p.bar + 3584 + (xl ? 8 * xq : 0), 1u, __ATOMIC_RELAXED, __HIP_MEMORY_SCOPE_AGENT);
                __syncthreads();
                t = __builtin_amdgcn_readfirstlane(slot[0]);
                __syncthreads(); }
              if (t >= nfu + nch) break;
              if (t < nfu) { const Params p = ldp(); const int w = xl ? 64 * xq + t : t, pm = w >> 2, h = w & 3;
                  Unit<EpiZ> un; un.am = AMap{p.hbuf + (size_t)pm * 256 * DM, DM, nullptr, 256}; un.bt = p.WinT + (size_t)h * 256 * DM; un.K = DM; un.ep = EpiZ{p.zu, p.zv, p.zq, p.zkv, p.krope, p.rope, pm * 256, h * 256};
                  const GmArgs gm{p.gm_g, p.gm_b, p.w_sp, p.b_sp, p.mix, pm * 256, h};
                  gemm256<EpiZ, 1>(un, shm, &gm);
              } else { const Params p = ldp(); PHASE_IDS; const int ch = (xl ? 16 * xq : 0) + (t - nfu); float* scr = (float*)(smc + wid * (64 * 33 * 4));
                  for (int k = wid; k < 96; k += 8) prep_witem(p, I_EARLY + ch * 96 + k, scr, lane);
                  __syncthreads(); }
          } }
#elif GMLP_FUSED
        { const Params p = ldp(); PHASE_IDS;
          gemm_stream(PhZ3{p}, shm, vcu, nblk);
          if (PhZ3::NU % nblk != 0 && vcu >= PhZ3::NU % nblk) { float* scr = (float*)(smc + wid * (64 * 33 * 4)); const int nlate = nblk - (PhZ3::NU % nblk), gw = (vcu - PhZ3::NU % nblk) * 8 + wid, ngw = nlate * 8;
              for (int it = I_EARLY + gw; it < I_TOTAL; it += ngw) prep_witem(p, it, scr, lane); }
          else if (PhZ3::NU % nblk == 0) { float* scr = (float*)(smc + wid * (64 * 33 * 4)); for (int it = I_EARLY + vcu * 8 + wid; it < I_TOTAL; it += nblk * 8) prep_witem(p, it, scr, lane); }
          __syncthreads();
          for (int w = vcu; w < 512; w += nblk) { const int pm = w >> 2, h = w & 3;
              Unit<EpiZ> un; un.am = AMap{p.hbuf + (size_t)pm * 256 * DM, DM, nullptr, 256}; un.bt = p.WinT + (size_t)h * 256 * DM; un.K = DM; un.ep = EpiZ{p.zu, p.zv, p.zq, p.zkv, p.krope, p.rope, pm * 256, h * 256};
              const GmArgs gm{p.gm_g, p.gm_b, p.w_sp, p.b_sp, p.mix, pm * 256, h};
              gemm256<EpiZ, 1>(un, shm, &gm); } }
#else
#if JIT_LN0
        { const Params p = ldp(); PhZj ph{p, vcu, p.bar + 3520}; ph.chunk(vcu); gemm_stream(ph, shm, vcu, nblk); }
#else
        gemm_phase(PhZ{ldp()}, shm, vcu);
#endif
        { const Params p = ldp(); PHASE_IDS; const int nlate = nblk - (PhZ::NU % nblk);
          if (PhZ::NU % nblk != 0 && vcu >= PhZ::NU % nblk) { float* scr = (float*)(smc + wid * (64 * 33 * 4)); const int gw = (vcu - PhZ::NU % nblk) * 8 + wid, ngw = nlate * 8;
              for (int it = I_EARLY + gw; it < I_TOTAL; it += ngw) prep_witem(p, it, scr, lane); }
          else if (PhZ::NU % nblk == 0) { float* scr = (float*)(smc + wid * (64 * 33 * 4)); for (int it = I_EARLY + vcu * 8 + wid; it < I_TOTAL; it += nblk * 8) prep_witem(p, it, scr, lane); } }
#endif
    }
    SEAM(1);
    if (LO <= 2 && HI >= 2) REPEAT(2) {
        const Params p = ldp();
        float* tab = (float*)(smc + LDS_PRE);
#if KVCHAIN
        { int slot = 0;
          for (int u = vcu; u < PhQs::NU; u += nblk, ++slot) rs_table<384>(p.zq + (size_t)(u / 3) * 256 * 384, tab + slot * 256); }
        __syncthreads();
        gemm_stream(PhQs{p, tab, vcu, nblk}, shm, vcu, nblk);
#else
        if (nblk == 256) {
            const int nq = vcu < 128 ? 2 : 1, kbeg = vcu < 128 ? vcu : 128 + (vcu - 128) * 3, kend = vcu < 128 ? vcu + 1 : kbeg + 3;
            for (int i = 0; i < nq; ++i) rs_table<384>(p.zq + (size_t)((vcu + i * 256) / 3) * 256 * 384, tab + i * 256);
            for (int k = kbeg; k < kend; ++k) rs_table<256>(p.zkv + (size_t)(k >> 2) * 256 * 256, tab + (nq + k - kbeg) * 256);
            __syncthreads();
            gemm_stream(PhQs{p, tab, vcu, nblk}, shm, vcu, nblk);
            gemm_stream(PhKVb{p, tab, kbeg, kend, nq}, shm, kbeg, 1);
        } else {
        { int slot = 0;
          for (int u = vcu; u < PhKVs::NU; u += nblk, ++slot) {
              if (u < PhQs::NU) rs_table<384>(p.zq + (size_t)(u / 3) * 256 * 384, tab + slot * 256); else rs_table<256>(p.zkv + (size_t)((u - 384) >> 2) * 256 * 256, tab + slot * 256); } }
        __syncthreads();
        gemm_stream(PhQs{p, tab, vcu, nblk}, shm, vcu, nblk);
        { const int i0 = vcu >= PhQs::NU ? 0 : (PhQs::NU - vcu + nblk - 1) / nblk; gemm_stream(PhKVs{p, tab, vcu, nblk}, shm, vcu + i0 * nblk, nblk); }
        }
#endif
#if !GMLP_FUSED
        gmlp_phase(p, smc, vcu);
#endif
    }
    SEAM(2);
    if (LO <= 3 && HI >= 3) REPEAT(3) {
        const Params p = ldp();
#ifndef ATTPROBE
#define ATTPROBE 0
#endif
        for (int u = vcu; u < 256; u += nblk) { const int bh = u >> 2, pr = u & 3; attn_block<0>(p, smc, bh, 7 - pr, p.mix); attn_block<0>(p, smc, bh, pr, p.mix); }
    }
    SEAM(3);
    if (LO <= 4 && HI >= 4) {
#if XPROBE > 0
        gemm_phase(PhYp<XPROBE>{ldp()}, shm, vcu); xcd_barrier(xb);
#endif
#ifndef WARM4
#define WARM4 0
#endif
        if (WARM4) { const Params p = ldp(); PHASE_IDS;
            for (int u = vcu; u < 512; u += nblk) { const char* a = (const char*)(p.mix + (size_t)(u >> 2) * 256 * DM); unsigned acc_ = 0;
#pragma unroll
                for (int i = 0; i < 8; ++i) acc_ += *(const unsigned*)(a + ((size_t)(i * 512 + tid) << 7));
                asm volatile("" :: "v"(acc_)); } }
        gemm_phase(PhY{ldp()}, shm, vcu);
    }
    SEAM(4);
    if (LO <= 5 && HI >= 5) {
        const Params p = ldp();
        for (int tb = blockIdx.x; tb < T_TOK / 128; tb += nblk) router_tile(p, smc, tb);
    }
    SEAM(5);
    if (LO <= 6 && HI >= 6) REPEAT(6) {
        const Params p = ldp(); PHASE_IDS;
        moe_tables(p, smc);
        const int* tot = (const int*)(smc + LDS_TOT); int* aid_tab = (int*)(smc + LDS_AID); const unsigned short* pre = (const unsigned short*)(smc + LDS_PRE);
        if (blockIdx.x == 0 && tid < NEXP) p.cnt[tid] = tot[tid];
        { int slot = 0;
          for (int u = vcu; slot < 3; u += nblk, ++slot) {
              int e, rt, ct, pr; if (!moe_unit(tot, u, 2, e, rt, ct, pr)) break;
              const int te = tot[e];
              if (tid < 256) { const int g = rt * 256 + tid; int aid = 0;
                  if (g < te) { int lo = 0, hi = 256;
#pragma unroll
                      for (int it = 0; it < 8; ++it) { const int mid = (lo + hi) >> 1; if ((int)pre[e * 256 + mid] <= g) lo = mid; else hi = mid; }
                      aid = p.listb[((size_t)lo * NEXP + e) * 256 + (g - (int)pre[e * 256 + lo])];
                      if (ct == 0) { if (MERGE67) __hip_atomic_store(p.list + (size_t)e * LIST_CAP + g, aid, __ATOMIC_RELAXED, __HIP_MEMORY_SCOPE_AGENT); else p.list[(size_t)e * LIST_CAP + g] = aid; } }
                  aid_tab[slot * 256 + tid] = aid; } } }
        __syncthreads();
        gemm_stream(PhHs{p, tot, aid_tab, vcu, nblk, p.bar + 3712}, shm, vcu, nblk);
#if MERGE67
        { PhCs pc{p, tot, p.bar + 3712, 0, p.bar + 3648, (volatile int*)(smc + LDS_AID)}; pc.u0 = pc.take(false, 0); gemm_stream(pc, shm, pc.u0, nblk); }
#endif
    }
#if !MERGE67
    SEAM(6);
#else
    TSTAMP(7);
#endif
    if (!MERGE67 && LO <= 7 && HI >= 7) REPEAT(7) {
        Params p = ldp(); PHASE_IDS;
        int* tot = (int*)(smc + LDS_TOT);
        if (tid < NEXP) tot[tid] = p.cnt[tid];
        __syncthreads();
        p.cnt = tot;
        gemm_phase(PhC{p}, shm, vcu);
    }
    SEAM(7);
#ifndef WPROBE
#define WPROBE 0
#endif
    if (WPROBE > 0 && LO <= 8 && HI >= 8 && LO != HI) {
        const Params p = ldp(); PHASE_IDS;
        const int wr = wid >> 2, wc = wid & 3, fr = lane & 15, fq = lane >> 4;
        for (int u = vcu; u < 512; u += nblk) { const int pm = u >> 2, pn = u & 3;
            bf16_t* base = p.mix + (size_t)pm * 256 * DM + pn * 256;
#pragma unroll
            for (int ai = 0; ai < 2; ++ai)
#pragma unroll
                for (int m = 0; m < 4; ++m) { bf16_t* rowp = base + (size_t)(ai * 128 + wr * 64 + m * 16 + fr) * DM;
                    if (WPROBE == 1) { const u32x2 z = {0u, 0u};
                        *(u32x2*)(rowp + wc * 32 + 4 * fq) = z; *(u32x2*)(rowp + wc * 32 + 16 + 4 * fq) = z; *(u32x2*)(rowp + 128 + wc * 32 + 4 * fq) = z; *(u32x2*)(rowp + 128 + wc * 32 + 16 + 4 * fq) = z; }
                    else { const u32x4 z = {0u, 0u, 0u, 0u}; *(u32x4*)(rowp + wc * 64 + 16 * fq) = z; *(u32x4*)(rowp + wc * 64 + 16 * fq + 8) = z; } } }
        xcd_barrier(xb);
    }
    if (LO <= 8 && HI >= 8) REPEAT(8) { const Params p = ldp(); PHASE_IDS; for (int t = blockIdx.x * 8 + wid; t < T_TOK / 2; t += nblk * 8) final_token2(p, t, t + T_TOK / 2, lane); }
    if (TIMEPH >= 0 && LO != HI) {
        xcd_barrier(xb); TSTAMP(9);
        if (blockIdx.x == 0 && threadIdx.x < 64) { const Params p = ldp(); const float dv = (float)(ts1_ - ts0_) * 6.0e-5f; for (int i = threadIdx.x; i < 4096; i += 64) p.out[i] = dv; }
    }
    #undef SEAM
}

#if ATTPROBE > 0
__global__ __launch_bounds__(512, 2) void attn_probe_kernel(Params p) {
    extern __shared__ __attribute__((aligned(16))) unsigned char lds_raw[];
    char* smc = (char*)lds_raw; const int nblk = gridDim.x;
    const int vcu = (nblk % 8 == 0) ? (int)(blockIdx.x % 8) * (nblk / 8) + (int)(blockIdx.x / 8) : (int)blockIdx.x;
    for (int u = vcu; u < 256; u += nblk) { const int bh = u >> 2, pr = u & 3; attn_block<ATTPROBE>(p, smc, bh, 7 - pr, (bf16_t*)p.out); attn_block<ATTPROBE>(p, smc, bh, pr, (bf16_t*)p.out); }
}
#endif
#ifndef MODE
#ifndef MODE
#define MODE 1
#endif
#endif
#ifndef FASTMASK
#define FASTMASK 0x1ff
#endif
static size_t carve(size_t& off, size_t bytes) { const size_t o = off; off += (bytes + 255) & ~(size_t)255; return o; }
#ifndef DUPMASK
#define DUPMASK 0
#endif
template <int PH> static void launch_fast(const Params& p, int grid, hipStream_t stream) { hipLaunchKernelGGL((mega<PH, PH>), dim3(grid), dim3(NTHR), LDS_BYTES, stream, p);
    if ((DUPMASK >> PH) & 1) hipLaunchKernelGGL((mega<PH, PH>), dim3(grid), dim3(NTHR), LDS_BYTES, stream, p); }
extern "C" void kernel_launch(void* const* d_in, const int* in_sizes, int n_in, void* d_out, int out_size, void* d_ws, size_t ws_size, hipStream_t stream) {
    Params p{};
    p.x = (const float*)d_in[0]; p.pos = (const int*)d_in[1]; p.ln0_g = (const float*)d_in[2]; p.ln0_b = (const float*)d_in[3]; p.w_in = (const float*)d_in[4];
    p.gm_g = (const float*)d_in[5]; p.gm_b = (const float*)d_in[6]; p.w_sp = (const float*)d_in[7]; p.b_sp = (const float*)d_in[8]; p.qn_g = (const float*)d_in[9];
    p.w_uq = (const float*)d_in[10]; p.kvn_g = (const float*)d_in[11]; p.w_ukv = (const float*)d_in[12]; p.w_out = (const float*)d_in[13]; p.ln1_g = (const float*)d_in[14];
    p.ln1_b = (const float*)d_in[15]; p.w_rg = (const float*)d_in[16]; p.b_rg = (const float*)d_in[17]; p.w_re = (const float*)d_in[18]; p.b_re = (const float*)d_in[19];
    p.w_gate = (const float*)d_in[20]; p.w_up = (const float*)d_in[21]; p.w_down = (const float*)d_in[22]; p.ln2_g = (const float*)d_in[23]; p.ln2_b = (const float*)d_in[24];
    p.out = (float*)d_out;
    char* ws = (char*)d_ws; size_t off = 0;
    p.bar = (unsigned*)(ws + carve(off, 16384));
    p.cnt = (int*)(ws + carve(off, 1024));
    p.WinT = (bf16_t*)(ws + carve(off, (size_t)ZN * 1024 * 2)); p.WuqT = (bf16_t*)(ws + carve(off, 768 * 384 * 2)); p.WukvT = (bf16_t*)(ws + carve(off, 1024 * 256 * 2));
    p.WoutT = (bf16_t*)(ws + carve(off, 1024 * 1024 * 2)); p.WguT = (bf16_t*)(ws + carve(off, (size_t)32 * 512 * 1024 * 2)); p.WdT = (bf16_t*)(ws + carve(off, (size_t)32 * 1024 * 256 * 2));
    p.hbuf = (bf16_t*)(ws + carve(off, (size_t)T_TOK * DM * 2)); p.rope = (float2*)(ws + carve(off, (size_t)T_TOK * 32 * 8));
    p.list = (int*)(ws + carve(off, (size_t)NEXP * LIST_CAP * 4)); p.gates = (float*)(ws + carve(off, (size_t)T_TOK * 2 * 4));
    p.ystat = (float*)(ws + carve(off, (size_t)T_TOK * 32 * 4)); p.WrT = (bf16_t*)(ws + carve(off, 2 * 36 * 1024 * 2)); p.cntb = (int*)(ws + carve(off, 256 * NEXP * 4)); p.listb = (int*)(ws + carve(off, (size_t)256 * NEXP * 256 * 4));
    p.rsq = (float*)(ws + carve(off, T_TOK * 4)); p.rskv = (float*)(ws + carve(off, T_TOK * 4));
    const size_t stage0 = off;
    p.zu = (bf16_t*)(ws + carve(off, (size_t)T_TOK * 512 * 2)); p.zv = (bf16_t*)(ws + carve(off, (size_t)T_TOK * 512 * 2));
    p.zq = (bf16_t*)(ws + carve(off, (size_t)T_TOK * 384 * 2)); p.zkv = (bf16_t*)(ws + carve(off, (size_t)T_TOK * 256 * 2)); p.krope = (bf16_t*)(ws + carve(off, (size_t)T_TOK * 64 * 2));
    p.Q = (bf16_t*)(ws + carve(off, (size_t)T_TOK * 768 * 2)); p.Kn = (bf16_t*)(ws + carve(off, (size_t)T_TOK * 512 * 2)); p.Vt = (bf16_t*)(ws + carve(off, (size_t)T_TOK * 512 * 2));
    p.mix = (bf16_t*)(ws + carve(off, (size_t)T_TOK * DM * 2));
    const size_t stage_end = off;
    size_t o2 = stage0; p.contrib = (bf16_t*)(ws + carve(o2, (size_t)T_TOK * 2 * DM * 2)); p.H = (bf16_t*)(ws + carve(o2, (size_t)(65536 + 8192) * FF * 2));
    if (o2 > stage_end || stage_end > ws_size) { fprintf(stderr, "kernel_launch: workspace too small (%zu needed, %zu given)\n", stage_end, ws_size); return; }

    static int grid = 0;
    if (!grid) {
        int dev = 0, cus = 0; (void)hipGetDevice(&dev); (void)hipDeviceGetAttribute(&cus, hipDeviceAttributeMultiprocessorCount, dev);
        grid = cus > 0 ? (cus / 8) * 8 : 256;
        (void)hipFuncSetAttribute((const void*)nk_gmlp, hipFuncAttributeMaxDynamicSharedMemorySize, 128 * 129 * 4);
        (void)hipFuncSetAttribute((const void*)nk_attn, hipFuncAttributeMaxDynamicSharedMemorySize, (64 * 192 + 64 * 193 + 64 * 65 + 64 * 128) * 4);
        (void)hipFuncSetAttribute((const void*)mega<0, 8>, hipFuncAttributeMaxDynamicSharedMemorySize, LDS_BYTES);
#if MODE == 2
        (void)hipFuncSetAttribute((const void*)mega<0, 0>, hipFuncAttributeMaxDynamicSharedMemorySize, LDS_BYTES);
        (void)hipFuncSetAttribute((const void*)mega<1, 1>, hipFuncAttributeMaxDynamicSharedMemorySize, LDS_BYTES);
        (void)hipFuncSetAttribute((const void*)mega<2, 2>, hipFuncAttributeMaxDynamicSharedMemorySize, LDS_BYTES);
        (void)hipFuncSetAttribute((const void*)mega<3, 3>, hipFuncAttributeMaxDynamicSharedMemorySize, LDS_BYTES);
        (void)hipFuncSetAttribute((const void*)mega<4, 4>, hipFuncAttributeMaxDynamicSharedMemorySize, LDS_BYTES);
        (void)hipFuncSetAttribute((const void*)mega<5, 5>, hipFuncAttributeMaxDynamicSharedMemorySize, LDS_BYTES);
        (void)hipFuncSetAttribute((const void*)mega<6, 6>, hipFuncAttributeMaxDynamicSharedMemorySize, LDS_BYTES);
        (void)hipFuncSetAttribute((const void*)mega<7, 7>, hipFuncAttributeMaxDynamicSharedMemorySize, LDS_BYTES);
        (void)hipFuncSetAttribute((const void*)mega<8, 8>, hipFuncAttributeMaxDynamicSharedMemorySize, LDS_BYTES);
#endif
    }
#if MODE == 1
    (void)hipMemsetAsync(p.bar, 0, 16384, stream);
    hipLaunchKernelGGL((mega<0, 8>), dim3(grid), dim3(NTHR), LDS_BYTES, stream, p);
#else
    const unsigned fm = (MODE == 2) ? (unsigned)(FASTMASK) : 0u;
    if (fm & 1) launch_fast<0>(p, grid, stream); else { nk_prep_w<<<J_TOTAL, 256, 0, stream>>>(p); nk_ln0<<<T_TOK / 4, 256, 0, stream>>>(p); nk_rope<<<T_TOK * 32 / 256, 256, 0, stream>>>(p); }
    if (fm & 2) launch_fast<1>(p, grid, stream); else nk_gemm<PhZ><<<dim3(PhZ::NU, 32), 256, 0, stream>>>(PhZ{p});
#if defined(P2VAR) && P2VAR == 1
    launch_fast<2>(p, grid, stream); nk_gmlp<<<T_TOK / 128 * 4, 256, 128 * 129 * 4, stream>>>(p);
#elif defined(P2VAR) && P2VAR == 2
    nk_rowscale<<<T_TOK / 4, 256, 0, stream>>>(p); nk_gemm<PhQ><<<dim3(PhQ::NU, 32), 256, 0, stream>>>(PhQ{p, p.rsq});
    nk_gemm<PhKV><<<dim3(PhKV::NU, 32), 256, 0, stream>>>(PhKV{p, p.rskv}); launch_fast<2>(p, grid, stream);
#else
    if (fm & 4) launch_fast<2>(p, grid, stream); else { nk_rowscale<<<T_TOK / 4, 256, 0, stream>>>(p); nk_gemm<PhQ><<<dim3(PhQ::NU, 32), 256, 0, stream>>>(PhQ{p, p.rsq});
        nk_gemm<PhKV><<<dim3(PhKV::NU, 32), 256, 0, stream>>>(PhKV{p, p.rskv}); nk_gmlp<<<T_TOK / 128 * 4, 256, 128 * 129 * 4, stream>>>(p); }
#endif
#if ATTPROBE > 0
    { static bool a2 = false; if (!a2) { a2 = true; (void)hipFuncSetAttribute((const void*)attn_probe_kernel, hipFuncAttributeMaxDynamicSharedMemorySize, LDS_BYTES); }
      hipLaunchKernelGGL(attn_probe_kernel, dim3(grid), dim3(NTHR), LDS_BYTES, stream, p); }
#endif
    if (fm & 8) launch_fast<3>(p, grid, stream); else nk_attn<<<64 * 32, 256, (64 * 192 + 64 * 193 + 64 * 65 + 64 * 128) * 4, stream>>>(p);
    if (fm & 16) launch_fast<4>(p, grid, stream); else nk_gemm<PhY><<<dim3(PhY::NU, 32), 256, 0, stream>>>(PhY{p});
    if (fm & 32) launch_fast<5>(p, grid, stream); else { nk_router_prep<<<144, 256, 0, stream>>>(p); nk_router<<<T_TOK / 4, 256, 0, stream>>>(p); }
    if (fm & 64) launch_fast<6>(p, grid, stream); else nk_gemm<PhH><<<dim3(PhH::NU, 32), 256, 0, stream>>>(PhH{p});
    if (fm & 128) launch_fast<7>(p, grid, stream); else nk_gemm<PhC><<<dim3(PhC::NU, 32), 256, 0, stream>>>(PhC{p});
    if (fm & 256) launch_fast<8>(p, grid, stream); else nk_final<<<T_TOK / 4, 256, 0, stream>>>(p);
#endif
}
```

```cpp
#include <hip/hip_runtime.h>
#define P2VAR 0
#define REPMASK 0x0
#define DUPMASK 0x0
#define TIMEPH -1
#define TSCALE 1.0f
#define CHUNK_ITEMS 24
#define SELFRESET 0
#define PF_TICKET 0
#define P2_ROWTILE 1
#define P5_LOCAL 1
#define WI_MLP 1
#define P1_MIX 0
#define KREP 1
#define XPROBE 0
#define P0REP 0
#define EPIDUP 0
#define VT_WIDE 0
#define ATT_OWIDE 1
#define EPIY_LWIDE 1
#define WITEM_WIDE 0
#define LN0_CONTIG 0
#define ST_MASK 0x7f
#define LN1FOLD 1
#define WPROBE 0
#define ATTPROBE 0
#define JIT_LN0 0
#define MERGE67 1
#define GMLP_FUSED 1
#define ZLAYOUT2 1
#define KVCHAIN 0
#define YSTAT 1
#define P1QUEUE 1
#define NT_IO 1
#include <stdint.h>
#include <cstdio>

#define LAS __attribute__((address_space(3)))
typedef unsigned short bf16_t;
typedef short bf16x8 __attribute__((ext_vector_type(8)));
typedef float f32x4 __attribute__((ext_vector_type(4)));
typedef float f32x16 __attribute__((ext_vector_type(16)));
typedef unsigned u32x2 __attribute__((ext_vector_type(2)));
typedef unsigned u32x4 __attribute__((ext_vector_type(4)));

constexpr int T_TOK = 32768, DM = 1024, SEQ = 2048, NBATCH = 16;
constexpr int ZN = 1792;
constexpr int NEXP = 32, FF = 256;
constexpr int LIST_CAP = 32768;
constexpr int LNF_CFIN = 65536, LNF_CPART = 65536 + 32768, LNF_CR = LNF_CPART + 32 * 16 * 1024;
constexpr float ALPHA = 1.189207115002721f;
constexpr float QSCALE = 0.07216878364870322f * 1.4426950408889634f;

struct Params {
    const float* x; const int* pos; const float *ln0_g, *ln0_b, *w_in, *gm_g, *gm_b, *w_sp, *b_sp, *qn_g, *w_uq, *kvn_g, *w_ukv, *w_out, *ln1_g, *ln1_b,
        *w_rg, *b_rg, *w_re, *b_re, *w_gate, *w_up, *w_down, *ln2_g, *ln2_b;
    float* out;
    bf16_t *WinT, *WuqT, *WukvT, *WoutT, *WguT, *WdT;
    bf16_t* hbuf; float2* rope;
    bf16_t *zu, *zv, *zq, *zkv, *krope, *Q, *Kn, *Vt, *mix;
    float *rsq, *rskv;
    int* cnt; int* list; float* gates; bf16_t* H; bf16_t* contrib;
    bf16_t* WspT;
    float* ystat;
    bf16_t* WrT; int* cntb; int* listb;
    float* lnf;
    unsigned* bar;
};

__device__ __forceinline__ unsigned pk2(float lo, float hi) { unsigned r; asm volatile("v_cvt_pk_bf16_f32 %0, %1, %2" : "=v"(r) : "v"(lo), "v"(hi)); return r; }
__device__ __forceinline__ bf16_t f2bf(float f) { return (bf16_t)(pk2(f, 0.f) & 0xffffu); }
__device__ __forceinline__ float bf2f(bf16_t h) { return __uint_as_float(((unsigned)h) << 16); }
__device__ __forceinline__ float bflo(unsigned u) { return __uint_as_float(u << 16); }
__device__ __forceinline__ float bfhi(unsigned u) { return __uint_as_float(u & 0xffff0000u); }
__device__ __forceinline__ void st4(bf16_t* p, f32x4 v) { u32x2 w; w.x = pk2(v[0], v[1]); w.y = pk2(v[2], v[3]); *(u32x2*)p = w; }
#ifndef ST_WIDE
#define ST_WIDE 1
#endif
__device__ __forceinline__ u32x4 pair_swap(f32x4 a, f32x4 b) {
    unsigned ax = pk2(a[0], a[1]), ay = pk2(a[2], a[3]), bx = pk2(b[0], b[1]), by = pk2(b[2], b[3]);
    asm volatile("s_nop 1" : "+v"(ax), "+v"(ay), "+v"(bx), "+v"(by));
    const auto r0 = __builtin_amdgcn_permlane16_swap(ax, bx, false, false); const auto r1 = __builtin_amdgcn_permlane16_swap(ay, by, false, false);
    u32x4 w; w.x = r0[0]; w.y = r1[0]; w.z = r0[1]; w.w = r1[1]; return w;
}
#ifndef ST_MASK
#define ST_MASK 0x7f
#endif
template <int BIT = 0x7f> __device__ __forceinline__ void st4pair(bf16_t* pa, bf16_t* pb, f32x4 a, f32x4 b, int fq) {
    if constexpr ((ST_MASK & BIT) != 0) { const u32x4 w = pair_swap(a, b); *(u32x4*)((fq & 1) ? pb - 4 : pa) = w; }
    else { u32x2 w; w.x = pk2(a[0], a[1]); w.y = pk2(a[2], a[3]); *(u32x2*)pa = w; w.x = pk2(b[0], b[1]); w.y = pk2(b[2], b[3]); *(u32x2*)pb = w; }
}
__device__ __forceinline__ void st4pair_wt(bf16_t* pa, bf16_t* pb, f32x4 a, f32x4 b, int fq) {
    const u32x4 w = pair_swap(a, b); bf16_t* p = (fq & 1) ? pb - 4 : pa;
    asm volatile("global_store_dwordx4 %0, %1, off sc1\n\ts_nop 1" :: "v"(p), "v"(w) : "memory");
}
__device__ __forceinline__ void st4wt(bf16_t* p, f32x4 v) { const unsigned lo = pk2(v[0], v[1]), hi = pk2(v[2], v[3]);
    __hip_atomic_store((unsigned long long*)p, ((unsigned long long)hi << 32) | lo, __ATOMIC_RELAXED, __HIP_MEMORY_SCOPE_AGENT); }
__device__ __forceinline__ float shx(float v, int mask) { int l = threadIdx.x; asm volatile("" : "+v"(l)); const int idx = ((l ^ mask) & 63) << 2; return __int_as_float(__builtin_amdgcn_ds_bpermute(idx, __float_as_int(v))); }
__device__ __forceinline__ float xhalf_max(float x) { const auto t = __builtin_amdgcn_permlane32_swap(__float_as_uint(x), __float_as_uint(x), false, false); return fmaxf(__uint_as_float(t[0]), __uint_as_float(t[1])); }
__device__ __forceinline__ float xhalf_sum(float x) { const auto t = __builtin_amdgcn_permlane32_swap(__float_as_uint(x), __float_as_uint(x), false, false); return __uint_as_float(t[0]) + __uint_as_float(t[1]); }
__device__ __forceinline__ float xrow16_sum(float x) { const auto s = __builtin_amdgcn_permlane16_swap(__float_as_uint(x), __float_as_uint(x), false, false); return xhalf_sum(__uint_as_float(s[0]) + __uint_as_float(s[1])); }
__device__ __forceinline__ float wave_sum(float v) {
#pragma unroll
    for (int o = 1; o < 64; o <<= 1) v += shx(v, o);
    return v;
}
__device__ __forceinline__ float gelu_tanh(float x) {
    const float A = -2.f * 0.7978845608028654f * 1.4426950408889634f, B = A * 0.044715f;
    const float e = __builtin_amdgcn_exp2f(x * __builtin_fmaf(x * x, B, A));
    return x * __builtin_amdgcn_rcpf(1.f + e);
}
__device__ __forceinline__ float silu_f(float x) { return x * __builtin_amdgcn_rcpf(1.f + __builtin_amdgcn_exp2f(-1.4426950408889634f * x)); }
__device__ __forceinline__ int perm16(int k) { return 8 * ((k >> 2) & 1) + (k & 3) + 4 * (k >> 3); }

struct AMap {
    const bf16_t* base; int ld; const int* list; int nvalid;
    __device__ __forceinline__ const bf16_t* row(int r) const {
        if (list) { const int a = list[r < nvalid ? r : 0]; return base + (size_t)(a >> 1) * ld; }
        return base + (size_t)r * ld;
    }
};

struct EpiZ {
    bf16_t *zu, *zv, *zq, *zkv, *krope; const float2* rope; int row0, col0;
    __device__ __forceinline__ void rope_store(int row, int c, f32x4 v, float2 cs0, float2 cs1) const {
        const int i0 = (c - 1664) >> 1; bf16_t* kr = krope + (size_t)row * 64;
        kr[i0] = f2bf(v[0] * cs0.x - v[1] * cs0.y); kr[i0 + 32] = f2bf(v[1] * cs0.x + v[0] * cs0.y);
        kr[i0 + 1] = f2bf(v[2] * cs1.x - v[3] * cs1.y); kr[i0 + 33] = f2bf(v[3] * cs1.x + v[2] * cs1.y);
    }
    __device__ __forceinline__ void plain(int row, int c, f32x4 v) const {
        if (c < 1024) {
            f32x4 g; g[0] = gelu_tanh(v[0]); g[1] = gelu_tanh(v[1]); g[2] = gelu_tanh(v[2]); g[3] = gelu_tanh(v[3]);
            if (c < 512) st4(zu + (size_t)row * 512 + c, g); else st4(zv + (size_t)row * 512 + (c - 512), g);
        }
#if ZLAYOUT2
        else if (c < 1280) st4(zkv + (size_t)row * 256 + (c - 1024), v);
        else if (c < 1536) st4(zq + (size_t)row * 384 + (c - 1280), v);
        else if (c < 1664) st4(zq + (size_t)row * 384 + 256 + (c - 1536), v);
#else
        else if (c < 1408) st4(zq + (size_t)row * 384 + (c - 1024), v);
        else if (c < 1664) st4(zkv + (size_t)row * 256 + (c - 1408), v);
#endif
    }
    __device__ __forceinline__ bf16_t* dest(int row, int c) const {
        if (c < 512) return zu + (size_t)row * 512 + c;
        if (c < 1024) return zv + (size_t)row * 512 + (c - 512);
#if ZLAYOUT2
        if (c < 1280) return zkv + (size_t)row * 256 + (c - 1024);
        if (c < 1536) return zq + (size_t)row * 384 + (c - 1280);
        return zq + (size_t)row * 384 + 256 + (c - 1536);
#else
        if (c < 1408) return zq + (size_t)row * 384 + (c - 1024);
        return zkv + (size_t)row * 256 + (c - 1408);
#endif
    }
    __device__ __forceinline__ void plain2(int row, int c, f32x4 a, f32x4 b, int fq) const {
        if (c < 1024) {
#pragma unroll
            for (int t = 0; t < 4; ++t) { a[t] = gelu_tanh(a[t]); b[t] = gelu_tanh(b[t]); } }
        bf16_t* pa = dest(row, c); st4pair<1>(pa, pa + 16, a, b, fq);
    }
    __device__ __forceinline__ void half(int row, int c, f32x4 v) const {
        if (c < 1664) plain(row, c, v);
        else if (c < 1728) { const int i0 = (c - 1664) >> 1; rope_store(row, c, v, rope[(size_t)row * 32 + i0], rope[(size_t)row * 32 + i0 + 1]); }
    }
    __device__ __forceinline__ void operator()(int r, int c32, int fq, f32x4 a, f32x4 b) const { const int row = row0 + r, c = col0 + c32 + 4 * fq; half(row, c, a); half(row, c + 16, b); }
    struct Ctx { float2 cs[4]; }; static constexpr int BATCH4 = 1;
    __device__ __forceinline__ bool is_rope(int c32) const { const int c = col0 + c32 + HALF_COLS; return c >= 1664 && c < 1728; }
    static constexpr int HALF_COLS = 128;
    __device__ __forceinline__ Ctx pre(int r, int c32, int fq) const { Ctx x;
        if (is_rope(c32)) { const int i0 = (col0 + c32 + 128 + 4 * fq - 1664) >> 1; const float2* rp = rope + (size_t)(row0 + r) * 32 + i0; x.cs[0] = rp[0]; x.cs[1] = rp[1]; x.cs[2] = rp[8]; x.cs[3] = rp[9]; }
        else { x.cs[0] = x.cs[1] = x.cs[2] = x.cs[3] = make_float2(0.f, 0.f); }
        return x; }
    __device__ __forceinline__ void post(int r, int c32, int fq, const Ctx& x, f32x4 a0, f32x4 b0, f32x4 a1, f32x4 b1) const {
        const int row = row0 + r, c = col0 + c32 + 4 * fq;
        plain2(row, c, a0, b0, fq);
        if (is_rope(c32)) { rope_store(row, c + 128, a1, x.cs[0], x.cs[1]); rope_store(row, c + 144, b1, x.cs[2], x.cs[3]); }
        else if (c + 128 < 1664) plain2(row, c + 128, a1, b1, fq);
    }
};
struct EpiQ {
    bf16_t* Q; const float* rs; int rs0; int row0, col0;
    __device__ __forceinline__ void half(int row, int c, f32x4 v, float sc) const {
        const int h = c / 192, d = c - h * 192, b = row >> 11, s = row & 2047;
        st4(Q + ((size_t)((b * 4 + h) * SEQ + s)) * 192 + d, v * sc);
    }
    __device__ __forceinline__ void operator()(int r, int c32, int fq, f32x4 a, f32x4 b) const {
        const int row = row0 + r, c = col0 + c32 + 4 * fq; const float sc = rs[row - rs0] * QSCALE; half(row, c, a, sc); half(row, c + 16, b, sc); }
    static constexpr int DUPOK = 1;
    struct Ctx { float sc; };
    __device__ __forceinline__ Ctx pre(int r, int c32, int fq) const { Ctx x; x.sc = rs[row0 + r - rs0] * QSCALE; return x; }
    __device__ __forceinline__ void post(int r, int c32, int fq, const Ctx& x, f32x4 a0, f32x4 b0, f32x4 a1, f32x4 b1) const {
        const int row = row0 + r, c = col0 + c32 + 4 * fq, b = row >> 11, s = row & 2047;
        { const int h = c / 192, d = c - h * 192, h2 = (c + 16) / 192, d2 = c + 16 - h2 * 192;
          st4pair<2>(Q + ((size_t)((b * 4 + h) * SEQ + s)) * 192 + d, Q + ((size_t)((b * 4 + h2) * SEQ + s)) * 192 + d2, a0 * x.sc, b0 * x.sc, fq); }
        { const int h = (c + 128) / 192, d = c + 128 - h * 192, h2 = (c + 144) / 192, d2 = c + 144 - h2 * 192;
          st4pair<2>(Q + ((size_t)((b * 4 + h) * SEQ + s)) * 192 + d, Q + ((size_t)((b * 4 + h2) * SEQ + s)) * 192 + d2, a1 * x.sc, b1 * x.sc, fq); } }
};
struct EpiKV {
    bf16_t *Kn, *Vt; const float* rs; int rs0; int row0, col0;
    __device__ __forceinline__ void half(int row, int c, f32x4 v, float sc) const {
        const int h = c >> 8, e = c & 255, b = row >> 11, s = row & 2047;
        v = v * sc;
        if (e < 128) st4(Kn + ((size_t)((b * 4 + h) * SEQ + s)) * 128 + e, v);
        else {
            bf16_t* vt = Vt + ((size_t)((b * 4 + h) * 128 + (e - 128))) * SEQ + (s & ~15) + perm16(s & 15);
            vt[0] = f2bf(v[0]); vt[SEQ] = f2bf(v[1]); vt[2 * SEQ] = f2bf(v[2]); vt[3 * SEQ] = f2bf(v[3]);
        }
    }
    __device__ __forceinline__ void operator()(int r, int c32, int fq, f32x4 a, f32x4 b) const {
        const int row = row0 + r, c = col0 + c32 + 4 * fq; const float sc = rs[row - rs0]; half(row, c, a, sc); half(row, c + 16, b, sc); }
    static constexpr int DUPOK = 1;
    struct Ctx { float sc; };
    __device__ __forceinline__ Ctx pre(int r, int c32, int fq) const { Ctx x; x.sc = rs[row0 + r - rs0]; return x; }
    __device__ __forceinline__ void post(int r, int c32, int fq, const Ctx& x, f32x4 a0, f32x4 b0, f32x4 a1, f32x4 b1) const {
        const int row = row0 + r, c = col0 + c32 + 4 * fq;
        { const int h = c >> 8, e = c & 255, b = row >> 11, s = row & 2047;
          bf16_t* kp = Kn + ((size_t)((b * 4 + h) * SEQ + s)) * 128 + e; st4pair<4>(kp, kp + 16, a0 * x.sc, b0 * x.sc, fq); }
        if (VT_WIDE) { vstore(row, c + 128, a1 * x.sc, r & 15); vstore(row, c + 144, b1 * x.sc, r & 15); }
        else { half(row, c + 128, a1, x.sc); half(row, c + 144, b1, x.sc); } }
    __device__ __forceinline__ void vstore(int row, int c, f32x4 v, int fr) const {
        const int h = c >> 8, e = (c & 255) - 128, b = row >> 11, s = row & 2047, j = fr >> 2, tq = fr & 3;
        const bool od = fr & 1, hi2 = fr & 2;
        const float s0 = od ? v[0] : v[1], s1 = od ? v[2] : v[3];
        const float r0 = __int_as_float(__builtin_amdgcn_mov_dpp(__float_as_int(s0), 0xB1, 0xf, 0xf, true)), r1 = __int_as_float(__builtin_amdgcn_mov_dpp(__float_as_int(s1), 0xB1, 0xf, 0xf, true));
        const unsigned P = pk2(od ? r0 : v[0], od ? v[1] : r0), Q = pk2(od ? r1 : v[2], od ? v[3] : r1);
        const unsigned snd = hi2 ? P : Q;
        const unsigned rcv = (unsigned)__builtin_amdgcn_mov_dpp((int)snd, 0x4E, 0xf, 0xf, true);
        u32x2 w; w.x = hi2 ? rcv : P; w.y = hi2 ? Q : rcv;
        *(u32x2*)(Vt + ((size_t)((b * 4 + h) * 128 + e + tq)) * SEQ + (s & ~15) + 8 * (j & 1) + 4 * (j >> 1)) = w;
    }
};
struct EpiY {
    bf16_t* hb; int row0, col0; float* ystat;
    __device__ __forceinline__ void fin(bf16_t* p, u32x2 h, f32x4 v) const {
        v[0] += ALPHA * bflo(h.x); v[1] += ALPHA * bfhi(h.x); v[2] += ALPHA * bflo(h.y); v[3] += ALPHA * bfhi(h.y); st4(p, v); }
    __device__ __forceinline__ void fin2(bf16_t* p, u32x2 h, f32x4 v, float& s, float& q) const {
        v[0] += ALPHA * bflo(h.x); v[1] += ALPHA * bfhi(h.x); v[2] += ALPHA * bflo(h.y); v[3] += ALPHA * bfhi(h.y); st4(p, v);
        s += (v[0] + v[1]) + (v[2] + v[3]); q += (v[0] * v[0] + v[1] * v[1]) + (v[2] * v[2] + v[3] * v[3]); }
    __device__ __forceinline__ void half(int row, int c, f32x4 v) const { bf16_t* p = hb + (size_t)row * DM + c; fin(p, *(const u32x2*)p, v); }
    __device__ __forceinline__ void operator()(int r, int c32, int fq, f32x4 a, f32x4 b) const { const int row = row0 + r, c = col0 + c32 + 4 * fq; half(row, c, a); half(row, c + 16, b); }
#if EPIY_LWIDE
    struct Ctx { u32x4 L[2]; }; static constexpr int BATCH4 = 1;
    __device__ __forceinline__ Ctx pre(int r, int c32, int fq) const { Ctx x; const bf16_t* p = hb + (size_t)(row0 + r) * DM + col0 + c32 + 4 * fq; const bf16_t* q = (fq & 1) ? p + 12 : p;
        x.L[0] = *(const u32x4*)q; x.L[1] = *(const u32x4*)(q + 128); return x; }
    static __device__ __forceinline__ void unswap(const u32x4& L, u32x2& ha, u32x2& hb_) {
        const auto r0 = __builtin_amdgcn_permlane16_swap(L.x, L.z, false, false); const auto r1 = __builtin_amdgcn_permlane16_swap(L.y, L.w, false, false);
        ha.x = r0[0]; ha.y = r1[0]; hb_.x = r0[1]; hb_.y = r1[1]; }
    __device__ __forceinline__ void post(int r, int c32, int fq, const Ctx& x, f32x4 a0, f32x4 b0, f32x4 a1, f32x4 b1) const {
        bf16_t* p = hb + (size_t)(row0 + r) * DM + col0 + c32 + 4 * fq;
        { u32x2 h0, h1, h2, h3; unswap(x.L[0], h0, h1); unswap(x.L[1], h2, h3); add_res(a0, h0); add_res(b0, h1); add_res(a1, h2); add_res(b1, h3); }
#else
    struct Ctx { u32x2 h[4]; }; static constexpr int BATCH4 = 1;
    __device__ __forceinline__ Ctx pre(int r, int c32, int fq) const { Ctx x; const bf16_t* p = hb + (size_t)(row0 + r) * DM + col0 + c32 + 4 * fq;
        x.h[0] = *(const u32x2*)p; x.h[1] = *(const u32x2*)(p + 16); x.h[2] = *(const u32x2*)(p + 128); x.h[3] = *(const u32x2*)(p + 144); return x; }
    __device__ __forceinline__ void post(int r, int c32, int fq, const Ctx& x, f32x4 a0, f32x4 b0, f32x4 a1, f32x4 b1) const {
        bf16_t* p = hb + (size_t)(row0 + r) * DM + col0 + c32 + 4 * fq;
        add_res(a0, x.h[0]); add_res(b0, x.h[1]); add_res(a1, x.h[2]); add_res(b1, x.h[3]);
#endif
        if (ystat) { float s = ((a0[0] + a0[1]) + (a0[2] + a0[3])) + ((b0[0] + b0[1]) + (b0[2] + b0[3])) + ((a1[0] + a1[1]) + (a1[2] + a1[3])) + ((b1[0] + b1[1]) + (b1[2] + b1[3]));
            float q = ((a0[0] * a0[0] + a0[1] * a0[1]) + (a0[2] * a0[2] + a0[3] * a0[3])) + ((b0[0] * b0[0] + b0[1] * b0[1]) + (b0[2] * b0[2] + b0[3] * b0[3]))
                    + ((a1[0] * a1[0] + a1[1] * a1[1]) + (a1[2] * a1[2] + a1[3] * a1[3])) + ((b1[0] * b1[0] + b1[1] * b1[1]) + (b1[2] * b1[2] + b1[3] * b1[3]));
            s = xrow16_sum(s); q = xrow16_sum(q);
            if (fq == 0) { typedef float f32x2 __attribute__((ext_vector_type(2))); *(f32x2*)(ystat + ((size_t)(row0 + r) * 16 + (col0 >> 6) + (c32 >> 5)) * 2) = (f32x2){s, q}; } }
        st4pair<8>(p, p + 16, a0, b0, fq); st4pair<8>(p + 128, p + 144, a1, b1, fq); }
    static __device__ __forceinline__ void add_res(f32x4& v, u32x2 h) { v[0] += ALPHA * bflo(h.x); v[1] += ALPHA * bfhi(h.x); v[2] += ALPHA * bflo(h.y); v[3] += ALPHA * bfhi(h.y); }
};
struct EpiH {
    bf16_t* H; int hrow0, col0; bool wt;
    const int* lst = nullptr; int nv = 0; const float2* stats = nullptr; const float* cf = nullptr;
    __device__ __forceinline__ void operator()(int r, int c32, int fq, f32x4 a, f32x4 b) const {
        const int hid = ((col0 + c32) >> 5) * 16 + 4 * fq;
        f32x4 o; o[0] = silu_f(a[0]) * b[0]; o[1] = silu_f(a[1]) * b[1]; o[2] = silu_f(a[2]) * b[2]; o[3] = silu_f(a[3]) * b[3];
        if (wt) st4wt(H + (size_t)(hrow0 + r) * FF + hid, o); else st4(H + (size_t)(hrow0 + r) * FF + hid, o);
    }
#if LN1FOLD
    struct Ctx { float rs, rm; }; static constexpr int BATCH4 = 1;
    struct Pro { f32x4 g[4], h[4]; };
    __device__ __forceinline__ Pro pro(int c32, int fq) const { Pro q; const float* c1 = cf + c32 + 4 * fq; const float* c2 = c1 + 512;
        q.g[0] = *(const f32x4*)c1; q.g[1] = *(const f32x4*)(c1 + 16); q.g[2] = *(const f32x4*)(c1 + 128); q.g[3] = *(const f32x4*)(c1 + 144);
        q.h[0] = *(const f32x4*)c2; q.h[1] = *(const f32x4*)(c2 + 16); q.h[2] = *(const f32x4*)(c2 + 128); q.h[3] = *(const f32x4*)(c2 + 144); return q; }
    __device__ __forceinline__ Ctx pre(int r, int, int) const { Ctx x; const int a = lst[r < nv ? r : 0]; const float2 st = stats[a >> 1]; x.rs = st.x; x.rm = st.y; return x; }
    __device__ __forceinline__ void post(int r, int c32, int fq, const Ctx& x, const Pro& q, f32x4 a0, f32x4 b0, f32x4 a1, f32x4 b1) const {
        const f32x4 ga = a0 * x.rs - q.g[0] * x.rm + q.h[0], ua = b0 * x.rs - q.g[1] * x.rm + q.h[1], gb = a1 * x.rs - q.g[2] * x.rm + q.h[2], ub = b1 * x.rs - q.g[3] * x.rm + q.h[3];
        f32x4 o0, o1; o0[0] = silu_f(ga[0]) * ua[0]; o0[1] = silu_f(ga[1]) * ua[1]; o0[2] = silu_f(ga[2]) * ua[2]; o0[3] = silu_f(ga[3]) * ua[3];
        o1[0] = silu_f(gb[0]) * ub[0]; o1[1] = silu_f(gb[1]) * ub[1]; o1[2] = silu_f(gb[2]) * ub[2]; o1[3] = silu_f(gb[3]) * ub[3];
        bf16_t* hp = H + (size_t)(hrow0 + r) * FF + ((col0 + c32) >> 5) * 16 + 4 * fq;
        if (ST_MASK & 16) { if (wt) st4pair_wt(hp, hp + 64, o0, o1, fq); else st4pair(hp, hp + 64, o0, o1, fq); }
        else { if (wt) { st4wt(hp, o0); st4wt(hp + 64, o1); } else { st4(hp, o0); st4(hp + 64, o1); } }
    }
#else
    struct Ctx { int dummy; };
    __device__ __forceinline__ Ctx pre(int, int, int) const { Ctx x; x.dummy = 0; return x; }
    __device__ __forceinline__ void post(int r, int c32, int fq, const Ctx&, f32x4 a0, f32x4 b0, f32x4 a1, f32x4 b1) const { (*this)(r, c32, fq, a0, b0); (*this)(r, c32 + 128, fq, a1, b1); }
#endif
};
struct EpiC {
    bf16_t* contrib; const int* list; const float* gates; int nvalid; int col0;
    __device__ __forceinline__ void operator()(int r, int c32, int fq, f32x4 a, f32x4 b) const {
        if (r >= nvalid) return;
        const int aid = list[r]; const float g = gates[aid];
        char* p = (char*)contrib + ((unsigned)aid * (unsigned)(DM * 2) + (unsigned)((col0 + c32 + 4 * fq) * 2));
        u32x2 w; w.x = pk2(a[0] * g, a[1] * g); w.y = pk2(a[2] * g, a[3] * g); *(u32x2*)p = w;
        w.x = pk2(b[0] * g, b[1] * g); w.y = pk2(b[2] * g, b[3] * g); *(u32x2*)(p + 32) = w;
    }
    struct Ctx { int aid; float g; };
    __device__ __forceinline__ Ctx pre(int r, int, int) const { Ctx x; x.aid = r < nvalid ? list[r] : -1; x.g = 0.f; return x; }
    __device__ __forceinline__ void pre2(Ctx& x) const { if (x.aid >= 0) x.g = gates[x.aid]; }
    __device__ __forceinline__ void post(int r, int c32, int fq, const Ctx& x, f32x4 a0, f32x4 b0, f32x4 a1, f32x4 b1) const {
        if (x.aid < 0) return;
        const float g = x.g;
        char* p = (char*)contrib + ((unsigned)x.aid * (unsigned)(DM * 2) + (unsigned)((col0 + c32 + 4 * fq) * 2));
        st4pair<32>((bf16_t*)p, (bf16_t*)(p + 32), a0 * g, b0 * g, fq); st4pair<32>((bf16_t*)(p + 256), (bf16_t*)(p + 288), a1 * g, b1 * g, fq);
    }
};

template <class EP> struct Unit { AMap am; const bf16_t* bt; int K; EP ep; };

__device__ __forceinline__ bool moe_unit(const int* cnt, int u, int ncol, int& e, int& rt, int& ct, int& padrow) {
    int acc = 0, fe = -1, facc = 0;
#pragma unroll 4
    for (int i = 0; i < NEXP; ++i) {
        const int t = (cnt[i] + 255) >> 8;
        if (fe < 0 && u < (acc + t) * ncol) { fe = i; facc = acc; }
        acc += t;
    }
    fe = __builtin_amdgcn_readfirstlane(fe); facc = __builtin_amdgcn_readfirstlane(facc);
    if (fe < 0) return false;
    const int w = u - facc * ncol; e = fe; rt = w / ncol; ct = w - rt * ncol; padrow = (facc + rt) * 256;
    return true;
}

struct PhZ { Params p; typedef EpiZ EP; static constexpr int NU = 128 * 7;
    __device__ __forceinline__ bool unit(int u, Unit<EP>& o) const { const int pm = u / 7, pn = u - pm * 7;
        o.am = AMap{p.hbuf + (size_t)pm * 256 * DM, DM, nullptr, 256}; o.bt = p.WinT + (size_t)pn * 256 * DM; o.K = DM;
        o.ep = EpiZ{p.zu, p.zv, p.zq, p.zkv, p.krope, p.rope, pm * 256, pn * 256}; return true; } };
struct PhQ { Params p; const float* rs; typedef EpiQ EP; static constexpr int NU = 128 * 3;
    __device__ __forceinline__ bool unit(int u, Unit<EP>& o) const { const int pm = u / 3, pn = u - pm * 3;
        o.am = AMap{p.zq + (size_t)pm * 256 * 384, 384, nullptr, 256}; o.bt = p.WuqT + (size_t)pn * 256 * 384; o.K = 384;
        o.ep = EpiQ{p.Q, rs, 0, pm * 256, pn * 256}; return true; } };
struct PhKV { Params p; const float* rs; typedef EpiKV EP; static constexpr int NU = 128 * 4;
    __device__ __forceinline__ bool unit(int u, Unit<EP>& o) const { const int pm = u >> 2, pn = u & 3;
        o.am = AMap{p.zkv + (size_t)pm * 256 * 256, 256, nullptr, 256}; o.bt = p.WukvT + (size_t)pn * 256 * 256; o.K = 256;
        o.ep = EpiKV{p.Kn, p.Vt, rs, 0, pm * 256, pn * 256}; return true; } };
struct PhY { Params p; typedef EpiY EP; static constexpr int NU = 128 * 4;
    __device__ __forceinline__ bool unit(int u, Unit<EP>& o) const { const int pm = u >> 2, pn = u & 3;
        o.am = AMap{p.mix + (size_t)pm * 256 * DM, DM, nullptr, 256}; o.bt = p.WoutT + (size_t)pn * 256 * DM; o.K = DM;
        o.ep = EpiY{p.hbuf, pm * 256, pn * 256, YSTAT ? p.ystat : nullptr}; return true; } };
struct PhH { Params p; typedef EpiH EP; static constexpr int NU = 288 * 2;
    __device__ __forceinline__ bool unit(int u, Unit<EP>& o) const { int e, rt, ct, pr; if (!moe_unit(p.cnt, u, 2, e, rt, ct, pr)) return false;
        const int nv = __builtin_amdgcn_readfirstlane(min(256, p.cnt[e] - rt * 256));
        o.am = AMap{p.hbuf, DM, p.list + (size_t)e * LIST_CAP + rt * 256, nv}; o.bt = p.WguT + ((size_t)e * 512 + ct * 256) * DM; o.K = DM;
        o.ep = EpiH{p.H, pr, ct * 256, false}; return true; } };
struct PhC { Params p; typedef EpiC EP; static constexpr int NU = 288 * 4;
    __device__ __forceinline__ bool unit(int u, Unit<EP>& o) const { int e, rt, ct, pr; if (!moe_unit(p.cnt, u, 4, e, rt, ct, pr)) return false;
        const int nv = __builtin_amdgcn_readfirstlane(min(256, p.cnt[e] - rt * 256));
        o.am = AMap{p.H + (size_t)pr * FF, FF, nullptr, 256}; o.bt = p.WdT + ((size_t)e * DM + ct * 256) * FF; o.K = FF;
        o.ep = EpiC{p.contrib, p.list + (size_t)e * LIST_CAP + rt * 256, p.gates, nv, ct * 256}; return true; } };


template <int XMODE> struct EpiProbe {
    const bf16_t* hb; bf16_t* ob; int row0, col0;
    __device__ __forceinline__ void operator()(int, int, int, f32x4, f32x4) const {}
    struct Ctx { u32x2 h[4]; };
    __device__ __forceinline__ Ctx pre(int r, int c32, int fq) const { Ctx x; const bf16_t* p = hb + (size_t)(row0 + r) * DM + col0 + c32 + 4 * fq;
        if (XMODE == 1) { x.h[0] = *(const u32x2*)p; x.h[1] = *(const u32x2*)(p + 16); x.h[2] = *(const u32x2*)(p + 128); x.h[3] = *(const u32x2*)(p + 144); }
        else { x.h[0] = x.h[1] = x.h[2] = x.h[3] = (u32x2){0u, 0u}; }
        return x; }
    __device__ __forceinline__ void fin(bf16_t* p, u32x2 h, f32x4 v) const {
        v[0] += ALPHA * bflo(h.x); v[1] += ALPHA * bfhi(h.x); v[2] += ALPHA * bflo(h.y); v[3] += ALPHA * bfhi(h.y); st4(p, v); }
    __device__ __forceinline__ void post(int r, int c32, int fq, const Ctx& x, f32x4 a0, f32x4 b0, f32x4 a1, f32x4 b1) const {
        if (XMODE == 2) { asm volatile("" :: "v"(a0), "v"(b0), "v"(a1), "v"(b1)); return; }
        if (XMODE == 4) {
            bf16_t* q = ob + (size_t)(row0 + r) * DM + col0 + (c32 >> 5) * 64 + 16 * fq; u32x4 w0, w1;
            w0.x = pk2(a0[0], a0[1]); w0.y = pk2(a0[2], a0[3]); w0.z = pk2(b0[0], b0[1]); w0.w = pk2(b0[2], b0[3]);
            w1.x = pk2(a1[0], a1[1]); w1.y = pk2(a1[2], a1[3]); w1.z = pk2(b1[0], b1[1]); w1.w = pk2(b1[2], b1[3]);
            *(u32x4*)q = w0; *(u32x4*)(q + 8) = w1; return; }
        bf16_t* p = ob + (size_t)(row0 + r) * DM + col0 + c32 + 4 * fq; fin(p, x.h[0], a0); fin(p + 16, x.h[1], b0); fin(p + 128, x.h[2], a1); fin(p + 144, x.h[3], b1); }
};
template <int XMODE> struct PhYp { Params p; typedef EpiProbe<XMODE> EP; static constexpr int NU = 128 * 4;
    __device__ __forceinline__ bool unit(int u, Unit<EP>& o) const { const int pm = u >> 2, pn = u & 3;
        o.am = AMap{p.mix + (size_t)pm * 256 * DM, DM, nullptr, 256}; o.bt = p.WoutT + (size_t)pn * 256 * DM; o.K = DM;
        o.ep = EP{p.hbuf, p.contrib, pm * 256, pn * 256}; return true; } };

__device__ __forceinline__ void wtile(const float* s0, const float* s1, int ldsrc, bf16_t* dst, int K, int k0, int n0, int mode, const float* kscale, float* tile, int tid, int nthr) {
    for (int idx = tid; idx < 4096; idx += nthr) {
        const int kk = idx >> 6, n = n0 + (idx & 63);
        const float* s = s0; int col = n;
        if (mode == 1) { if (n >= 1728) col = -1; else if (n >= 1664) { const int i = (n - 1664) >> 1, pp = (n - 1664) & 1; col = 1664 + i + 32 * pp; } }
        else if (mode == 2) { const int h = n / 192, d = n - h * 192; if (d >= 128) { const int i = (d - 128) >> 1, pp = (d - 128) & 1; col = h * 192 + 128 + i + 32 * pp; } }
        else if (mode == 3) { const int G = n >> 5, r = n & 31; col = 16 * G + (r & 15); s = (r < 16) ? s0 : s1; }
        float v = 0.f;
        if (col >= 0) { v = s[(size_t)(k0 + kk) * ldsrc + col]; if (kscale) v *= kscale[k0 + kk]; }
        tile[kk * 65 + (idx & 63)] = v;
    }
    __syncthreads();
    for (int idx = tid; idx < 4096; idx += nthr) {
        const int nn = idx >> 6, kk = idx & 63;
        dst[(size_t)(n0 + nn) * K + k0 + kk] = f2bf(tile[kk * 65 + nn]);
    }
    __syncthreads();
}
constexpr int J_IN = 28 * 16, J_UQ = 12 * 6, J_UKV = 16 * 4, J_OUT = 16 * 16, J_GU = 32 * 8 * 16, J_DN = 32 * 16 * 4;
constexpr int J_TOTAL = J_IN + J_UQ + J_UKV + J_OUT + J_GU + J_DN;
__device__ __forceinline__ void prep_wjob(const Params& p, int job, float* tile, int tid, int nthr) {
    if (job < J_IN) { const int nb = job >> 4, kb = job & 15; wtile(p.w_in, nullptr, 1728, p.WinT, 1024, kb * 64, nb * 64, 1, nullptr, tile, tid, nthr); return; } job -= J_IN;
    if (job < J_UQ) { const int nb = job / 6, kb = job - nb * 6; wtile(p.w_uq, nullptr, 768, p.WuqT, 384, kb * 64, nb * 64, 0, p.qn_g, tile, tid, nthr); return; } job -= J_UQ;
    if (job < J_UKV) { const int nb = job >> 2, kb = job & 3; wtile(p.w_ukv, nullptr, 1024, p.WukvT, 256, kb * 64, nb * 64, 0, p.kvn_g, tile, tid, nthr); return; } job -= J_UKV;
    if (job < J_OUT) { const int nb = job >> 4, kb = job & 15; wtile(p.w_out, nullptr, 1024, p.WoutT, 1024, kb * 64, nb * 64, 0, nullptr, tile, tid, nthr); return; } job -= J_OUT;
    if (job < J_GU) { const int e = job >> 7, r = job & 127, nb = r >> 4, kb = r & 15;
        wtile(p.w_gate + (size_t)e * 1024 * 256, p.w_up + (size_t)e * 1024 * 256, 256, p.WguT + (size_t)e * 512 * 1024, 1024, kb * 64, nb * 64, 3, nullptr, tile, tid, nthr); return; } job -= J_GU;
    { const int e = job >> 6, r = job & 63, nb = r >> 2, kb = r & 3;
        wtile(p.w_down + (size_t)e * 256 * 1024, nullptr, 1024, p.WdT + (size_t)e * 1024 * 256, 256, kb * 64, nb * 64, 0, nullptr, tile, tid, nthr); }
}
__device__ __forceinline__ void ln0_row(const float* xr, const float* g, const float* b, bf16_t* orow, int lane) {
    f32x4 v[4]; float s = 0.f;
#pragma unroll
    for (int j = 0; j < 4; ++j) { v[j] = *(const f32x4*)(xr + 256 * j + 4 * lane); s += (v[j][0] + v[j][1]) + (v[j][2] + v[j][3]); }
    const float mean = wave_sum(s) * (1.f / 1024.f); float s2 = 0.f;
#pragma unroll
    for (int j = 0; j < 4; ++j) { v[j] = v[j] - mean; s2 += (v[j][0] * v[j][0] + v[j][1] * v[j][1]) + (v[j][2] * v[j][2] + v[j][3] * v[j][3]); }
    const float rstd = 1.f / sqrtf(wave_sum(s2) * (1.f / 1024.f) + 1e-5f);
#pragma unroll
    for (int j = 0; j < 4; ++j) { const f32x4 gg = *(const f32x4*)(g + 256 * j + 4 * lane), bb = *(const f32x4*)(b + 256 * j + 4 * lane);
        st4(orow + 256 * j + 4 * lane, v[j] * rstd * gg + bb); }
}
__device__ __forceinline__ void rope_entry(const Params& p, int idx) {
    const int t = idx >> 5, i = idx & 31;
    const float inv = powf(10000.f, -(float)(2 * i) / 64.f);
    const float ang = (float)p.pos[t] * inv;
    p.rope[idx] = make_float2(cosf(ang), sinf(ang));
}

__device__ __forceinline__ void router_token(const Params& p, int t, int lane, const float* wr  , int wstride) {
    bf16_t* hr = p.hbuf + (size_t)t * DM;
    f32x4 v[4]; float s = 0.f;
#pragma unroll
    for (int j = 0; j < 4; ++j) { const u32x2 w = *(const u32x2*)(hr + 256 * j + 4 * lane); v[j][0] = bflo(w.x); v[j][1] = bfhi(w.x); v[j][2] = bflo(w.y); v[j][3] = bfhi(w.y);
        s += (v[j][0] + v[j][1]) + (v[j][2] + v[j][3]); }
    const float mean = wave_sum(s) * (1.f / 1024.f); float s2 = 0.f;
#pragma unroll
    for (int j = 0; j < 4; ++j) { v[j] = v[j] - mean; s2 += (v[j][0] * v[j][0] + v[j][1] * v[j][1]) + (v[j][2] * v[j][2] + v[j][3] * v[j][3]); }
    const float rstd = 1.f / sqrtf(wave_sum(s2) * (1.f / 1024.f) + 1e-5f);
#pragma unroll
    for (int j = 0; j < 4; ++j) { const f32x4 gg = *(const f32x4*)(p.ln1_g + 256 * j + 4 * lane), bb = *(const f32x4*)(p.ln1_b + 256 * j + 4 * lane);
        v[j] = v[j] * rstd * gg + bb; st4(hr + 256 * j + 4 * lane, v[j]); }
    float lg[36];
#pragma unroll
    for (int o = 0; o < 36; ++o) { float a = 0.f;
#pragma unroll
        for (int j = 0; j < 4; ++j) { const f32x4 w = *(const f32x4*)(wr + o * wstride + 256 * j + 4 * lane); a += (v[j][0] * w[0] + v[j][1] * w[1]) + (v[j][2] * w[2] + v[j][3] * w[3]); }
        lg[o] = wave_sum(a); }
#pragma unroll
    for (int o = 0; o < 4; ++o) lg[o] += p.b_rg[o];
#pragma unroll
    for (int o = 0; o < 32; ++o) lg[4 + o] += p.b_re[o];
    int g = 0; float gm = lg[0];
#pragma unroll
    for (int i = 1; i < 4; ++i) if (lg[i] > gm) { gm = lg[i]; g = i; }
    float se = 0.f;
#pragma unroll
    for (int i = 0; i < 4; ++i) se += expf(lg[i] - gm);
    const float pg = 1.f / se;
    float ev[8];
#pragma unroll
    for (int e = 0; e < 8; ++e) ev[e] = g == 0 ? lg[4 + e] : g == 1 ? lg[12 + e] : g == 2 ? lg[20 + e] : lg[28 + e];
    int i1 = 0; float v1 = ev[0];
#pragma unroll
    for (int e = 1; e < 8; ++e) if (ev[e] > v1) { v1 = ev[e]; i1 = e; }
    int i2 = -1; float v2 = -3.0e38f;
#pragma unroll
    for (int e = 0; e < 8; ++e) if (e != i1 && ev[e] > v2) { v2 = ev[e]; i2 = e; }
    const float d = expf(v2 - v1), g1 = pg / (1.f + d), g2 = pg * d / (1.f + d);
    if (lane < 2) {
        const int ex = g * 8 + (lane == 0 ? i1 : i2), aid = 2 * t + lane;
        const int slot = atomicAdd(p.cnt + ex, 1);
        p.list[(size_t)ex * LIST_CAP + slot] = aid;
        p.gates[aid] = lane == 0 ? g1 : g2;
    }
}
__device__ __forceinline__ void final_token(const Params& p, int t, int lane) {
    const bf16_t* hr = p.hbuf + (size_t)t * DM; const bf16_t* c0 = p.contrib + (size_t)(2 * t) * DM; const bf16_t* c1 = c0 + DM;
    f32x4 v[4]; float s = 0.f;
#pragma unroll
    for (int j = 0; j < 4; ++j) { const int o = 256 * j + 4 * lane; const u32x2 w = *(const u32x2*)(hr + o), a = *(const u32x2*)(c0 + o), b = *(const u32x2*)(c1 + o);
        v[j][0] = ALPHA * bflo(w.x) + bflo(a.x) + bflo(b.x); v[j][1] = ALPHA * bfhi(w.x) + bfhi(a.x) + bfhi(b.x);
        v[j][2] = ALPHA * bflo(w.y) + bflo(a.y) + bflo(b.y); v[j][3] = ALPHA * bfhi(w.y) + bfhi(a.y) + bfhi(b.y);
        s += (v[j][0] + v[j][1]) + (v[j][2] + v[j][3]); }
    const float mean = wave_sum(s) * (1.f / 1024.f); float s2 = 0.f;
#pragma unroll
    for (int j = 0; j < 4; ++j) { v[j] = v[j] - mean; s2 += (v[j][0] * v[j][0] + v[j][1] * v[j][1]) + (v[j][2] * v[j][2] + v[j][3] * v[j][3]); }
    const float rstd = 1.f / sqrtf(wave_sum(s2) * (1.f / 1024.f) + 1e-5f);
#pragma unroll
    for (int j = 0; j < 4; ++j) { const int o = 256 * j + 4 * lane; const f32x4 gg = *(const f32x4*)(p.ln2_g + o), bb = *(const f32x4*)(p.ln2_b + o);
        *(f32x4*)(p.out + (size_t)t * DM + o) = v[j] * rstd * gg + bb; }
}


__device__ __forceinline__ void final_token2(const Params& p, int t0, int t1, int lane) {
    f32x4 v[2][4]; float s[2] = {0.f, 0.f}, q[2] = {0.f, 0.f};
    u32x2 w[2][4], a[2][4], b[2][4];
#pragma unroll
    for (int k = 0; k < 2; ++k) { const int t = k ? t1 : t0; const bf16_t* hr = p.hbuf + (size_t)t * DM; const bf16_t* c0 = p.contrib + (size_t)(2 * t) * DM; const bf16_t* c1 = c0 + DM;
#pragma unroll
        for (int j = 0; j < 4; ++j) { const int o = 256 * j + 4 * lane;
            if (NT_IO) { w[k][j] = __builtin_nontemporal_load((const u32x2*)(hr + o)); a[k][j] = __builtin_nontemporal_load((const u32x2*)(c0 + o)); b[k][j] = __builtin_nontemporal_load((const u32x2*)(c1 + o)); }
            else { w[k][j] = *(const u32x2*)(hr + o); a[k][j] = *(const u32x2*)(c0 + o); b[k][j] = *(const u32x2*)(c1 + o); } } }
#pragma unroll
    for (int k = 0; k < 2; ++k)
#pragma unroll
        for (int j = 0; j < 4; ++j) {
            v[k][j][0] = ALPHA * bflo(w[k][j].x) + bflo(a[k][j].x) + bflo(b[k][j].x); v[k][j][1] = ALPHA * bfhi(w[k][j].x) + bfhi(a[k][j].x) + bfhi(b[k][j].x);
            v[k][j][2] = ALPHA * bflo(w[k][j].y) + bflo(a[k][j].y) + bflo(b[k][j].y); v[k][j][3] = ALPHA * bfhi(w[k][j].y) + bfhi(a[k][j].y) + bfhi(b[k][j].y);
            s[k] += (v[k][j][0] + v[k][j][1]) + (v[k][j][2] + v[k][j][3]);
            q[k] += (v[k][j][0] * v[k][j][0] + v[k][j][1] * v[k][j][1]) + (v[k][j][2] * v[k][j][2] + v[k][j][3] * v[k][j][3]); }
#pragma unroll
    for (int o2 = 1; o2 < 64; o2 <<= 1) { s[0] += shx(s[0], o2); s[1] += shx(s[1], o2); q[0] += shx(q[0], o2); q[1] += shx(q[1], o2); }
#pragma unroll
    for (int k = 0; k < 2; ++k) { const int t = k ? t1 : t0; const float mean = s[k] * (1.f / 1024.f), var = fmaxf(q[k] * (1.f / 1024.f) - mean * mean, 0.f), rstd = 1.f / sqrtf(var + 1e-5f);
#pragma unroll
        for (int j = 0; j < 4; ++j) { const int o = 256 * j + 4 * lane; const f32x4 gg = *(const f32x4*)(p.ln2_g + o), bb = *(const f32x4*)(p.ln2_b + o);
            if (NT_IO) __builtin_nontemporal_store((v[k][j] - mean) * rstd * gg + bb, (f32x4*)(p.out + (size_t)t * DM + o)); else *(f32x4*)(p.out + (size_t)t * DM + o) = (v[k][j] - mean) * rstd * gg + bb; } }
}

#if LN1FOLD
#ifndef P8_WIDE
#define P8_WIDE 0
#endif
#if P8_WIDE
__device__ __forceinline__ void final_tokens_fold(const Params& p, int tbeg, int tstride, int lane) {
    f32x4 g1[4], b1[4], g2[4], b2[4];
#pragma unroll
    for (int i = 0; i < 4; ++i) { const int o = 512 * (i >> 1) + 8 * lane + 4 * (i & 1); g1[i] = *(const f32x4*)(p.ln1_g + o) * ALPHA; b1[i] = *(const f32x4*)(p.ln1_b + o) * ALPHA; g2[i] = *(const f32x4*)(p.ln2_g + o); b2[i] = *(const f32x4*)(p.ln2_b + o); }
    for (int t0 = tbeg; t0 < T_TOK / 2; t0 += tstride) { const int t1 = t0 + T_TOK / 2;
        f32x4 v[2][4]; float s[2] = {0.f, 0.f}, q[2] = {0.f, 0.f};
        u32x4 w[2][2], a[2][2], b[2][2]; float2 st[2];
#pragma unroll
        for (int k = 0; k < 2; ++k) { const int t = k ? t1 : t0; const bf16_t* hr = p.hbuf + (size_t)t * DM; const bf16_t* c0 = p.contrib + (size_t)(2 * t) * DM; const bf16_t* c1 = c0 + DM;
            st[k] = ((const float2*)p.lnf)[t];
#pragma unroll
            for (int j = 0; j < 2; ++j) { const int o = 512 * j + 8 * lane;
                w[k][j] = __builtin_nontemporal_load((const u32x4*)(hr + o)); a[k][j] = __builtin_nontemporal_load((const u32x4*)(c0 + o)); b[k][j] = __builtin_nontemporal_load((const u32x4*)(c1 + o)); } }
#pragma unroll
        for (int k = 0; k < 2; ++k)
#pragma unroll
            for (int j = 0; j < 2; ++j)
#pragma unroll
                for (int hq = 0; hq < 2; ++hq) { const int i = 2 * j + hq;
                    const unsigned wx = hq ? w[k][j].z : w[k][j].x, wy = hq ? w[k][j].w : w[k][j].y, ax = hq ? a[k][j].z : a[k][j].x, ay = hq ? a[k][j].w : a[k][j].y, bx = hq ? b[k][j].z : b[k][j].x, by = hq ? b[k][j].w : b[k][j].y;
                    v[k][i][0] = (bflo(wx) * st[k].x - st[k].y) * g1[i][0] + b1[i][0] + bflo(ax) + bflo(bx); v[k][i][1] = (bfhi(wx) * st[k].x - st[k].y) * g1[i][1] + b1[i][1] + bfhi(ax) + bfhi(bx);
                    v[k][i][2] = (bflo(wy) * st[k].x - st[k].y) * g1[i][2] + b1[i][2] + bflo(ay) + bflo(by); v[k][i][3] = (bfhi(wy) * st[k].x - st[k].y) * g1[i][3] + b1[i][3] + bfhi(ay) + bfhi(by);
                    s[k] += (v[k][i][0] + v[k][i][1]) + (v[k][i][2] + v[k][i][3]);
                    q[k] += (v[k][i][0] * v[k][i][0] + v[k][i][1] * v[k][i][1]) + (v[k][i][2] * v[k][i][2] + v[k][i][3] * v[k][i][3]); }
#pragma unroll
        for (int o2 = 1; o2 < 64; o2 <<= 1) { s[0] += shx(s[0], o2); s[1] += shx(s[1], o2); q[0] += shx(q[0], o2); q[1] += shx(q[1], o2); }
#pragma unroll
        for (int k = 0; k < 2; ++k) { const int t = k ? t1 : t0; const float mean = s[k] * (1.f / 1024.f), var = fmaxf(q[k] * (1.f / 1024.f) - mean * mean, 0.f), rstd = 1.f / sqrtf(var + 1e-5f);
#pragma unroll
            for (int i = 0; i < 4; ++i) { const int o = 512 * (i >> 1) + 8 * lane + 4 * (i & 1); __builtin_nontemporal_store((v[k][i] - mean) * rstd * g2[i] + b2[i], (f32x4*)(p.out + (size_t)t * DM + o)); } }
    }
}
#else
__device__ __forceinline__ void final_tokens_fold(const Params& p, int tbeg, int tstride, int lane) {
    f32x4 g1[4], b1[4], g2[4], b2[4];
#pragma unroll
    for (int j = 0; j < 4; ++j) { const int o = 256 * j + 4 * lane; g1[j] = *(const f32x4*)(p.ln1_g + o) * ALPHA; b1[j] = *(const f32x4*)(p.ln1_b + o) * ALPHA; g2[j] = *(const f32x4*)(p.ln2_g + o); b2[j] = *(const f32x4*)(p.ln2_b + o); }
    for (int t0 = tbeg; t0 < T_TOK / 2; t0 += tstride) { const int t1 = t0 + T_TOK / 2;
        f32x4 v[2][4]; float s[2] = {0.f, 0.f}, q[2] = {0.f, 0.f};
        u32x2 w[2][4], a[2][4], b[2][4]; float2 st[2];
#pragma unroll
        for (int k = 0; k < 2; ++k) { const int t = k ? t1 : t0; const bf16_t* hr = p.hbuf + (size_t)t * DM; const bf16_t* c0 = p.contrib + (size_t)(2 * t) * DM; const bf16_t* c1 = c0 + DM;
            st[k] = ((const float2*)p.lnf)[t];
#pragma unroll
            for (int j = 0; j < 4; ++j) { const int o = 256 * j + 4 * lane;
                w[k][j] = __builtin_nontemporal_load((const u32x2*)(hr + o)); a[k][j] = __builtin_nontemporal_load((const u32x2*)(c0 + o)); b[k][j] = __builtin_nontemporal_load((const u32x2*)(c1 + o)); } }
#pragma unroll
        for (int k = 0; k < 2; ++k)
#pragma unroll
            for (int j = 0; j < 4; ++j) {
                v[k][j][0] = (bflo(w[k][j].x) * st[k].x - st[k].y) * g1[j][0] + b1[j][0] + bflo(a[k][j].x) + bflo(b[k][j].x); v[k][j][1] = (bfhi(w[k][j].x) * st[k].x - st[k].y) * g1[j][1] + b1[j][1] + bfhi(a[k][j].x) + bfhi(b[k][j].x);
                v[k][j][2] = (bflo(w[k][j].y) * st[k].x - st[k].y) * g1[j][2] + b1[j][2] + bflo(a[k][j].y) + bflo(b[k][j].y); v[k][j][3] = (bfhi(w[k][j].y) * st[k].x - st[k].y) * g1[j][3] + b1[j][3] + bfhi(a[k][j].y) + bfhi(b[k][j].y);
                s[k] += (v[k][j][0] + v[k][j][1]) + (v[k][j][2] + v[k][j][3]);
                q[k] += (v[k][j][0] * v[k][j][0] + v[k][j][1] * v[k][j][1]) + (v[k][j][2] * v[k][j][2] + v[k][j][3] * v[k][j][3]); }
#pragma unroll
        for (int o2 = 1; o2 < 64; o2 <<= 1) { s[0] += shx(s[0], o2); s[1] += shx(s[1], o2); q[0] += shx(q[0], o2); q[1] += shx(q[1], o2); }
#pragma unroll
        for (int k = 0; k < 2; ++k) { const int t = k ? t1 : t0; const float mean = s[k] * (1.f / 1024.f), var = fmaxf(q[k] * (1.f / 1024.f) - mean * mean, 0.f), rstd = 1.f / sqrtf(var + 1e-5f);
#pragma unroll
            for (int j = 0; j < 4; ++j) { const int o = 256 * j + 4 * lane; __builtin_nontemporal_store((v[k][j] - mean) * rstd * g2[j] + b2[j], (f32x4*)(p.out + (size_t)t * DM + o)); } }
    }
}
#endif
#endif

__global__ __launch_bounds__(256) void nk_prep_w(Params p) { __shared__ float tile[64 * 65]; prep_wjob(p, blockIdx.x, tile, threadIdx.x, 256); }
__global__ __launch_bounds__(256) void nk_ln0(Params p) { const int t = blockIdx.x * 4 + (threadIdx.x >> 6); ln0_row(p.x + (size_t)t * DM, p.ln0_g, p.ln0_b, p.hbuf + (size_t)t * DM, threadIdx.x & 63); }
__global__ __launch_bounds__(256) void nk_rope(Params p) { rope_entry(p, blockIdx.x * 256 + threadIdx.x); if (blockIdx.x == 0 && threadIdx.x < NEXP) p.cnt[threadIdx.x] = 0; }
__global__ __launch_bounds__(256) void nk_rowscale(Params p) {
    const int t = blockIdx.x * 4 + (threadIdx.x >> 6), lane = threadIdx.x & 63;
    float s = 0.f; for (int i = lane; i < 384; i += 64) { const float v = bf2f(p.zq[(size_t)t * 384 + i]); s += v * v; }
    s = wave_sum(s); float s2 = 0.f; for (int i = lane; i < 256; i += 64) { const float v = bf2f(p.zkv[(size_t)t * 256 + i]); s2 += v * v; }
    s2 = wave_sum(s2);
    if (lane == 0) { p.rsq[t] = 1.f / sqrtf(s * (1.f / 384.f) + 1e-6f); p.rskv[t] = 1.f / sqrtf(s2 * (1.f / 256.f) + 1e-6f); }
}
template <class PH> __global__ __launch_bounds__(256) void nk_gemm(PH ph) {
    Unit<typename PH::EP> u; if (!ph.unit(blockIdx.x, u)) return;
    const int wave = threadIdx.x >> 6, lane = threadIdx.x & 63, fr = lane & 15, fq = lane >> 4;
    const int task = blockIdx.y * 4 + wave, rb = task >> 3, cg = task & 7;
    const bf16_t* arow = u.am.row(rb * 16 + fr);
    const bf16_t* b0 = u.bt + (size_t)(cg * 32 + fr) * u.K; const bf16_t* b1 = b0 + (size_t)16 * u.K;
    f32x4 acc0 = {0.f, 0.f, 0.f, 0.f}, acc1 = {0.f, 0.f, 0.f, 0.f};
    for (int k = 0; k < u.K; k += 32) {
        const bf16x8 a = *(const bf16x8*)(arow + k + 8 * fq), x0 = *(const bf16x8*)(b0 + k + 8 * fq), x1 = *(const bf16x8*)(b1 + k + 8 * fq);
        acc0 = __builtin_amdgcn_mfma_f32_16x16x32_bf16(x0, a, acc0, 0, 0, 0);
        acc1 = __builtin_amdgcn_mfma_f32_16x16x32_bf16(x1, a, acc1, 0, 0, 0);
    }
    u.ep(rb * 16 + fr, cg * 32, fq, acc0, acc1);
}
__global__ __launch_bounds__(256) void nk_gmlp(Params p) {
    extern __shared__ float sm[];
    const int unit = blockIdx.x, h = unit & 3, bn = unit >> 2, row0 = bn * 128;
    const int wave = threadIdx.x >> 6, lane = threadIdx.x & 63;
    for (int j = wave; j < 128; j += 4) {
        const bf16_t* vr = p.zv + (size_t)(row0 + j) * 512 + h * 128;
        const float a = bf2f(vr[lane]), b = bf2f(vr[lane + 64]);
        const float mean = wave_sum(a + b) * (1.f / 128.f); const float da = a - mean, db = b - mean;
        const float rstd = 1.f / sqrtf(wave_sum(da * da + db * db) * (1.f / 128.f) + 1e-5f);
        sm[j * 129 + lane] = da * rstd * p.gm_g[h * 128 + lane] + p.gm_b[h * 128 + lane];
        sm[j * 129 + lane + 64] = db * rstd * p.gm_g[h * 128 + lane + 64] + p.gm_b[h * 128 + lane + 64];
    }
    __syncthreads();
    for (int idx = threadIdx.x; idx < 16384; idx += 256) {
        const int i = idx >> 7, c = idx & 127; const int jn = i < 64 ? 64 : 128;
        const float* w = p.w_sp + ((size_t)h * 128 + i) * 128; float f = p.b_sp[h * 128 + i];
        for (int j = 0; j < jn; ++j) f += w[j] * sm[j * 129 + c];
        const float u = bf2f(p.zu[(size_t)(row0 + i) * 512 + h * 128 + c]);
        p.mix[(size_t)(row0 + i) * DM + h * 128 + c] = f2bf(u * f);
    }
}
__global__ __launch_bounds__(256) void nk_attn(Params p) {
    extern __shared__ float sm[];
    float* Qs = sm; float* Ks = Qs + 64 * 192; float* Ss = Ks + 64 * 193; float* Vs = Ss + 64 * 65;
    const int qc = blockIdx.x & 31, bh = blockIdx.x >> 5, b = bh >> 2, h = bh & 3, tid = threadIdx.x, q = tid >> 2, sub = tid & 3;
    for (int idx = tid; idx < 64 * 192; idx += 256) { const int r = idx / 192, d = idx - r * 192; Qs[idx] = bf2f(p.Q[((size_t)bh * SEQ + qc * 64 + r) * 192 + d]); }
    __syncthreads();
    for (int idx = tid; idx < 64 * 32; idx += 256) { const int r = idx >> 5, i = idx & 31; const float2 cs = p.rope[((size_t)b * SEQ + qc * 64 + r) * 32 + i];
        const float x1 = Qs[r * 192 + 128 + i], x2 = Qs[r * 192 + 160 + i]; Qs[r * 192 + 128 + i] = x1 * cs.x - x2 * cs.y; Qs[r * 192 + 160 + i] = x2 * cs.x + x1 * cs.y; }
    float O[32]; float m = -INFINITY, l = 0.f;
#pragma unroll
    for (int j = 0; j < 32; ++j) O[j] = 0.f;
    for (int kt = 0; kt <= qc; ++kt) {
        __syncthreads();
        for (int idx = tid; idx < 64 * 192; idx += 256) { const int r = idx / 192, d = idx - r * 192; const int key = kt * 64 + r;
            Ks[r * 193 + d] = d < 128 ? bf2f(p.Kn[((size_t)bh * SEQ + key) * 128 + d]) : bf2f(p.krope[((size_t)b * SEQ + key) * 64 + d - 128]); }
        for (int idx = tid; idx < 64 * 128; idx += 256) { const int r = idx >> 7, dv = idx & 127; const int key = kt * 64 + r;
            Vs[r * 128 + dv] = bf2f(p.Vt[((size_t)bh * 128 + dv) * SEQ + (key & ~15) + perm16(key & 15)]); }
        __syncthreads();
        for (int kk = 0; kk < 16; ++kk) { const int key = sub * 16 + kk; float s = 0.f;
            for (int d = 0; d < 192; ++d) s += Qs[q * 192 + d] * Ks[key * 193 + d];
            Ss[q * 65 + key] = s; }
        __syncthreads();
        float mt = -INFINITY; for (int k = 0; k < 64; ++k) mt = fmaxf(mt, Ss[q * 65 + k]);
        const float mn = fmaxf(m, mt), alpha = exp2f(m - mn); m = mn; l *= alpha;
#pragma unroll
        for (int j = 0; j < 32; ++j) O[j] *= alpha;
        for (int k = 0; k < 64; ++k) { const float pk = exp2f(Ss[q * 65 + k] - mn); l += pk;
#pragma unroll
            for (int j = 0; j < 32; ++j) O[j] += pk * Vs[k * 128 + sub * 32 + j]; }
    }
    const float inv = 1.f / l; bf16_t* o = p.mix + ((size_t)b * SEQ + qc * 64 + q) * DM + 512 + h * 128 + sub * 32;
#pragma unroll
    for (int j = 0; j < 32; ++j) o[j] = f2bf(O[j] * inv);
}
__global__ __launch_bounds__(256) void nk_router(Params p) {
    const int t = blockIdx.x * 4 + (threadIdx.x >> 6);
    router_token(p, t, threadIdx.x & 63, (const float*)p.H, 1024);
}
__global__ __launch_bounds__(256) void nk_router_prep(Params p) {
    const int idx = blockIdx.x * 256 + threadIdx.x; if (idx >= 36 * 1024) return;
    const int o = idx >> 10, k = idx & 1023;
    ((float*)p.H)[idx] = o < 4 ? p.w_rg[k * 4 + o] : p.w_re[k * 32 + (o - 4)];
}
__global__ __launch_bounds__(256) void nk_final(Params p) { final_token(p, blockIdx.x * 4 + (threadIdx.x >> 6), threadIdx.x & 63); }

constexpr int LDS_BYTES = 152 * 1024, LDS_RS = 150 * 1024, LDS_XB = 151 * 1024;
constexpr int LDS_PRE = 128 * 1024, LDS_TOT = 144 * 1024, LDS_SEG = LDS_TOT + 256, LDS_AID = LDS_SEG + 2048;
constexpr int LDS_RW = 0, LDS_LCNT = 144 * 1024 + 512;
constexpr int NTHR = 512;

#ifndef EARLY_WB
#define EARLY_WB 0
#endif
#define XB_TMO      128
#define XB_XCNT(j)  (256  + 64 * (j))
#define XB_XSUB(j)  (1280 + 64 * (j))
#define XB_XGEN(j)  (2304 + 64 * (j))
#define XB_TOP      3328
#define XB_TOPGEN   3392
#define XCD_BAR_WORDS 3456
#define XB_SPIN_CAP (1u << 20)
__device__ __forceinline__ unsigned xb_ld(unsigned* p) { return __hip_atomic_load(p, __ATOMIC_RELAXED, __HIP_MEMORY_SCOPE_AGENT); }
__device__ __forceinline__ unsigned xb_add(unsigned* p, unsigned v) { return __hip_atomic_fetch_add(p, v, __ATOMIC_RELAXED, __HIP_MEMORY_SCOPE_AGENT); }
__device__ __forceinline__ unsigned xb_xcc_id() { return (unsigned)__builtin_amdgcn_s_getreg((3 << 11) | 20) & 0xFu; }
#define XB_SPIN(cond, bar) do { unsigned _sp = 0; while (cond) { __builtin_amdgcn_s_sleep(1); \
    if ((++_sp & 255u) == 0u) { if (xb_ld(&(bar)[XB_TMO])) break; if (_sp > XB_SPIN_CAP) { atomicAdd(&(bar)[XB_TMO], 1u); break; } } } } while (0)
struct XcdBarrier { unsigned* bar; unsigned x; volatile LAS unsigned* st; };
__device__ __forceinline__ XcdBarrier xcd_barrier_post(unsigned* bar, volatile LAS unsigned* st) {
    XcdBarrier b; b.bar = bar; b.x = xb_xcc_id(); b.st = st;
    if (threadIdx.x == 0) (void)xb_add(&bar[XB_XCNT(b.x)], 1u);
    return b;
}
__device__ __forceinline__ void xcd_barrier_complete(unsigned* bar, unsigned x, unsigned& nloc, unsigned& nx) {
    const unsigned G = gridDim.x * gridDim.y * gridDim.z;
    unsigned sum, cnt, mine, sp = 0u;
    for (;;) {
        sum = 0u; cnt = 0u; mine = 0u;
#pragma unroll
        for (unsigned j = 0; j < 16; ++j) { const unsigned c = xb_ld(&bar[XB_XCNT(j)]); sum += c; cnt += (c > 0u) ? 1u : 0u; mine = (j == x) ? c : mine; }
        if (sum == G) break;
        __builtin_amdgcn_s_sleep(1);
        if ((++sp & 255u) == 0u) { if (xb_ld(&bar[XB_TMO])) break; if (sp > XB_SPIN_CAP) { atomicAdd(&bar[XB_TMO], 1u); break; } }
    }
    nloc = mine > 0u ? mine : 1u; nx = cnt > 0u ? cnt : 1u;
}
__device__ __forceinline__ void xcd_barrier(const XcdBarrier& b) {
    asm volatile("s_waitcnt vmcnt(0)" ::: "memory");
    __syncthreads();
    if (threadIdx.x == 0) {
        unsigned* bar = b.bar;
        __builtin_amdgcn_s_waitcnt(0);
        unsigned nloc = b.st[0], nx = b.st[1];
        if (nloc == 0u) { xcd_barrier_complete(bar, b.x, nloc, nx); b.st[0] = nloc; b.st[1] = nx; }
#if EARLY_WB
        __builtin_amdgcn_fence(__ATOMIC_RELEASE, "agent"); asm volatile("s_waitcnt vmcnt(0)" ::: "memory");
#endif
        const unsigned old = xb_add(&bar[XB_XSUB(b.x)], 1u);
        const unsigned gen = old / nloc;
        if (old + 1u == (gen + 1u) * nloc) {
            __builtin_amdgcn_fence(__ATOMIC_RELEASE, "agent");
            asm volatile("s_waitcnt vmcnt(0)" ::: "memory");
            const unsigned og = xb_add(&bar[XB_TOP], 1u);
            const unsigned tg = og / nx;
            if (og + 1u == (tg + 1u) * nx) xb_add(&bar[XB_TOPGEN], 1u);
            else XB_SPIN(xb_ld(&bar[XB_TOPGEN]) == tg, bar);
            __builtin_amdgcn_fence(__ATOMIC_ACQUIRE, "agent");
            xb_add(&bar[XB_XGEN(b.x)], 1u);
            asm volatile("s_waitcnt vmcnt(0)" ::: "memory");
        } else {
            XB_SPIN(xb_ld(&bar[XB_XGEN(b.x)]) == gen, bar);
            __builtin_amdgcn_fence(__ATOMIC_ACQUIRE, "agent");
            asm volatile("s_waitcnt vmcnt(0)" ::: "memory");
        }
    }
    __syncthreads();
}

constexpr int BK = 64, HALF = 128, HT = HALF * BK;
__device__ __forceinline__ int lds_byte(int r, int c) { const int st = (r >> 4) * 2 + (c >> 5), rr = r & 15, cc = c & 31, ob = rr * 64 + cc * 2; return st * 1024 + (ob ^ (((ob >> 9) & 1) << 5)); }
__device__ __forceinline__ void stage_rc(int b, int& R, int& C) { const int st = b / 1024, sb = b % 1024, swz = sb ^ (((sb >> 9) & 1) << 5); R = (st >> 1) * 16 + swz / 64; C = (st & 1) * 32 + (swz % 64) / 2; }

template <class PH> struct HasNext { template <class T> static char test(decltype(&T::next)); template <class T> static long test(...); static constexpr bool value = sizeof(test<PH>(nullptr)) == 1; };
template <class PH> struct HasPrefetch { template <class T> static char test(decltype(&T::prefetch)); template <class T> static long test(...); static constexpr bool value = sizeof(test<PH>(nullptr)) == 1; };
template <class PH> struct HasDone { template <class T> static char test(decltype(&T::done)); template <class T> static long test(...); static constexpr bool value = sizeof(test<PH>(nullptr)) == 1; };
template <class EP> struct HasPro { template <class T> static char test(decltype(&T::pro)); template <class T> static long test(...); static constexpr bool value = sizeof(test<EP>(nullptr)) == 1; };
template <class EP> struct HasDupOk { template <class T> static char test(decltype(&T::DUPOK)); template <class T> static long test(...); static constexpr bool value = sizeof(test<EP>(nullptr)) == 1; };
template <class EP> struct HasPre2 { template <class T> static char test(decltype(&T::pre2)); template <class T> static long test(...); static constexpr bool value = sizeof(test<EP>(nullptr)) == 1; };
template <class EP> struct IsBatch4 { template <class T> static char test(decltype(&T::BATCH4)); template <class T> static long test(...); static constexpr bool value = sizeof(test<EP>(nullptr)) == 1; };
template <class EP> __device__ __forceinline__ void run_epilogue(const EP& ep, const f32x4 (&acc)[2][2][4][2], int wr, int wc, int fr, int fq) {
    int rb = wr * 64 + fr, fq_ = fq; asm volatile("" : "+v"(rb), "+v"(fq_));
    if constexpr (IsBatch4<EP>::value) {
#pragma unroll
        for (int ai = 0; ai < 2; ++ai) {
            typename EP::Ctx cx[4];
#pragma unroll
            for (int m = 0; m < 4; ++m) cx[m] = ep.pre(ai * HALF + m * 16 + rb, wc * 32, fq_);
            if constexpr (HasPre2<EP>::value) {
#pragma unroll
                for (int m = 0; m < 4; ++m) ep.pre2(cx[m]);
            }
            if constexpr (HasPro<EP>::value) { const typename EP::Pro pq = ep.pro(wc * 32, fq_);
#pragma unroll
                for (int m = 0; m < 4; ++m) ep.post(ai * HALF + m * 16 + rb, wc * 32, fq_, cx[m], pq, acc[ai][0][m][0], acc[ai][0][m][1], acc[ai][1][m][0], acc[ai][1][m][1]);
            } else {
#pragma unroll
            for (int m = 0; m < 4; ++m) ep.post(ai * HALF + m * 16 + rb, wc * 32, fq_, cx[m], acc[ai][0][m][0], acc[ai][0][m][1], acc[ai][1][m][0], acc[ai][1][m][1]);
            }
        }
    } else {
        typename EP::Ctx cx[8];
#pragma unroll
        for (int i = 0; i < 8; ++i) cx[i] = ep.pre((i >> 2) * HALF + (i & 3) * 16 + rb, wc * 32, fq_);
        if constexpr (HasPre2<EP>::value) {
#pragma unroll
            for (int i = 0; i < 8; ++i) ep.pre2(cx[i]);
        }
        if constexpr (HasPro<EP>::value) { const typename EP::Pro pq = ep.pro(wc * 32, fq_);
#pragma unroll
            for (int i = 0; i < 8; ++i) ep.post((i >> 2) * HALF + (i & 3) * 16 + rb, wc * 32, fq_, cx[i], pq, acc[i >> 2][0][i & 3][0], acc[i >> 2][0][i & 3][1], acc[i >> 2][1][i & 3][0], acc[i >> 2][1][i & 3][1]);
        } else {
#pragma unroll
        for (int i = 0; i < 8; ++i) ep.post((i >> 2) * HALF + (i & 3) * 16 + rb, wc * 32, fq_, cx[i], acc[i >> 2][0][i & 3][0], acc[i >> 2][0][i & 3][1], acc[i >> 2][1][i & 3][0], acc[i >> 2][1][i & 3][1]);
        }
    }
}
struct GmArgs { const float *gm_g, *gm_b, *w_sp, *b_sp; bf16_t* mix; int row0, h; const bf16_t* wsp16; };
__device__ __forceinline__ void gmlp_epilogue(f32x4 (&acc)[2][2][4][2], const GmArgs& g, char* lds, int wr, int wc, int fr, int fq) {
    typedef float f32x2 __attribute__((ext_vector_type(2)));
    bf16x8 wall[4][4]; float ball[4];
    { const int nks0 = (wr == 0) ? 2 : 4;
#pragma unroll
      for (int m = 0; m < 2; ++m) { const int i = wr * 64 + m * 16 + fr; ball[m] = g.b_sp[g.h * 128 + i];
#pragma unroll
        for (int ks = 0; ks < 4; ++ks) { u32x4 pk = {0u, 0u, 0u, 0u};
            if (ks < nks0) pk = *(const u32x4*)(g.wsp16 + ((size_t)g.h * 128 + i) * 128 + 32 * ks + 8 * fq);
            wall[m][ks] = __builtin_bit_cast(bf16x8, pk); } } }
    f32x2* P = (f32x2*)lds;
    char* vT = lds + 8192;
#pragma unroll
    for (int ai = 0; ai < 2; ++ai)
#pragma unroll
        for (int bj = 0; bj < 2; ++bj)
#pragma unroll
            for (int m = 0; m < 4; ++m)
#pragma unroll
                for (int n = 0; n < 2; ++n)
#pragma unroll
                    for (int t = 0; t < 4; ++t) acc[ai][bj][m][n][t] = gelu_tanh(acc[ai][bj][m][n][t]);
#pragma unroll
    for (int ai = 0; ai < 2; ++ai)
#pragma unroll
        for (int m = 0; m < 4; ++m) { float s = 0.f, q = 0.f;
#pragma unroll
            for (int n = 0; n < 2; ++n)
#pragma unroll
                for (int t = 0; t < 4; ++t) { const float x = acc[ai][1][m][n][t]; s += x; q += x * x; }
            s = xrow16_sum(s); q = xrow16_sum(q);
            if (fq == 0) P[(ai * 128 + wr * 64 + m * 16 + fr) * 4 + wc] = (f32x2){s, q}; }
    __syncthreads();
    const int c0 = wc * 32 + 4 * fq;
    f32x4 gg[2], bb[2];
#pragma unroll
    for (int n = 0; n < 2; ++n) { gg[n] = *(const f32x4*)(g.gm_g + g.h * 128 + c0 + 16 * n); bb[n] = *(const f32x4*)(g.gm_b + g.h * 128 + c0 + 16 * n); }
#pragma unroll
    for (int ai = 0; ai < 2; ++ai)
#pragma unroll
        for (int m = 0; m < 4; ++m) { const int row = ai * 128 + wr * 64 + m * 16 + fr, j = wr * 64 + m * 16 + fr;
            const f32x2 p0 = P[row * 4 + 0], p1 = P[row * 4 + 1], p2 = P[row * 4 + 2], p3 = P[row * 4 + 3];
            const float mean = ((p0.x + p1.x) + (p2.x + p3.x)) * (1.f / 128.f), var = fmaxf(((p0.y + p1.y) + (p2.y + p3.y)) * (1.f / 128.f) - mean * mean, 0.f), rstd = 1.f / sqrtf(var + 1e-5f);
#pragma unroll
            for (int n = 0; n < 2; ++n)
#pragma unroll
                for (int t = 0; t < 4; ++t) *(bf16_t*)(vT + ai * (128 * 272) + (c0 + 16 * n + t) * 272 + j * 2) = f2bf((acc[ai][1][m][n][t] - mean) * rstd * gg[n][t] + bb[n][t]); }
    __syncthreads();
    const int nks = (wr == 0) ? 2 : 4;
#pragma unroll
    for (int m = 2; m < 4; ++m) { const int i = wr * 64 + m * 16 + fr; ball[m] = g.b_sp[g.h * 128 + i];
#pragma unroll
        for (int ks = 0; ks < 4; ++ks) { u32x4 pk = {0u, 0u, 0u, 0u};
            if (ks < nks) pk = *(const u32x4*)(g.wsp16 + ((size_t)g.h * 128 + i) * 128 + 32 * ks + 8 * fq);
            wall[m][ks] = __builtin_bit_cast(bf16x8, pk); } }
#pragma unroll
    for (int m = 0; m < 4; ++m) {
        const int i = wr * 64 + m * 16 + fr;
        bf16x8 wf[4];
#pragma unroll
        for (int ks = 0; ks < 4; ++ks) wf[ks] = wall[m][ks];
        const float bias = ball[m];
#pragma unroll
        for (int ai = 0; ai < 2; ++ai)
            { f32x4 on[2];
#pragma unroll
              for (int n = 0; n < 2; ++n) { f32x4 f = {0.f, 0.f, 0.f, 0.f};
#pragma unroll
                for (int ks = 0; ks < 4; ++ks) if (ks < nks) { const bf16x8 a = *(const bf16x8*)(vT + ai * (128 * 272) + (wc * 32 + n * 16 + fr) * 272 + (32 * ks + 8 * fq) * 2);
                    f = __builtin_amdgcn_mfma_f32_16x16x32_bf16(a, wf[ks], f, 0, 0, 0); }
                const f32x4 uu = acc[ai][0][m][n]; on[n][0] = uu[0] * (f[0] + bias); on[n][1] = uu[1] * (f[1] + bias); on[n][2] = uu[2] * (f[2] + bias); on[n][3] = uu[3] * (f[3] + bias); }
              bf16_t* mp = g.mix + (size_t)(g.row0 + ai * 128 + i) * DM + g.h * 128 + wc * 32 + 4 * fq; st4pair<64>(mp, mp + 16, on[0], on[1], fq); } }
}
struct KvArgs { bf16_t* zkv; float* tab; int row0; };
__device__ __forceinline__ void kvlat_epilogue(const f32x4 (&acc)[2][2][4][2], const KvArgs& g, char* lds, int wr, int wc, int fr, int fq) {
    float* P = (float*)lds;
#pragma unroll
    for (int ai = 0; ai < 2; ++ai)
#pragma unroll
        for (int m = 0; m < 4; ++m) { float q = 0.f; const int row = ai * 128 + wr * 64 + m * 16 + fr;
#pragma unroll
            for (int bj = 0; bj < 2; ++bj)
#pragma unroll
                for (int n = 0; n < 2; ++n) { const f32x4 x = acc[ai][bj][m][n]; q += (x[0] * x[0] + x[1] * x[1]) + (x[2] * x[2] + x[3] * x[3]);
                    st4(g.zkv + (size_t)(g.row0 + row) * 256 + bj * 128 + wc * 32 + n * 16 + 4 * fq, x); }
            q += shx(q, 16); q += shx(q, 32);
            if (fq == 0) P[row * 4 + wc] = q; }
    __syncthreads();
    if (threadIdx.x < 256) { const f32x4 s = *(const f32x4*)(P + threadIdx.x * 4); g.tab[threadIdx.x] = 1.f / sqrtf(((s[0] + s[1]) + (s[2] + s[3])) * (1.f / 256.f) + 1e-6f); }
    asm volatile("s_waitcnt vmcnt(0)" ::: "memory");
}
template <class EP, int EK = 0>
__device__ __forceinline__ void gemm256(const Unit<EP>& u, LAS unsigned char* lds, const GmArgs* gm = nullptr, const KvArgs* kv = nullptr) {
    int tid = threadIdx.x; asm volatile("" : "+v"(tid));
    const int K = u.K, nt = K / BK;
    const int wid = __builtin_amdgcn_readfirstlane(tid >> 6), lane = tid & 63, wr = wid >> 2, wc = wid & 3, fr = lane & 15, fq = lane >> 4;
    unsigned voffA[2][2], voffB[2];
    const char* gA = (const char*)u.am.base; const char* gB = (const char*)u.bt;
#pragma unroll
    for (int i = 0; i < 2; ++i) { int R, C; stage_rc(tid * 16 + i * 8192, R, C);
        voffB[i] = (unsigned)(R * K + C) * 2u;
        if (u.am.list) { const int a0 = u.am.list[R < u.am.nvalid ? R : 0], a1 = u.am.list[R + HALF < u.am.nvalid ? R + HALF : 0];
            voffA[0][i] = ((unsigned)(a0 >> 1) * (unsigned)u.am.ld + (unsigned)C) * 2u; voffA[1][i] = ((unsigned)(a1 >> 1) * (unsigned)u.am.ld + (unsigned)C) * 2u; }
        else { voffA[0][i] = (unsigned)(R * u.am.ld + C) * 2u; voffA[1][i] = (unsigned)((R + HALF) * u.am.ld + C) * 2u; } }
    const size_t hstepB = (size_t)HALF * K * 2;
    const unsigned ldsw = (unsigned)wid * 1024u;
    const int aoff = lds_byte(wr * 64 + fr, fq * 8), boff = lds_byte(wc * 32 + fr, fq * 8);
    #define SA(b,h) (((b)*2+(h))*HT*2)
    #define SB(b,h) ((4+(b)*2+(h))*HT*2)
    #define STAGE_A(bufoff,h,kt) do{ _Pragma("unroll") for(int _i=0;_i<2;++_i) { asm volatile("" : "+v"(voffA[h][_i])); \
        __builtin_amdgcn_global_load_lds((const unsigned*)(gA+(size_t)(kt)*(BK*2)+voffA[h][_i]),(LAS unsigned*)(lds+(bufoff)+ldsw+_i*8192),16,0,0);} }while(0)
    #define STAGE_B(bufoff,h,kt) do{ _Pragma("unroll") for(int _i=0;_i<2;++_i) { asm volatile("" : "+v"(voffB[_i])); \
        __builtin_amdgcn_global_load_lds((const unsigned*)(gB+(size_t)(h)*hstepB+(size_t)(kt)*(BK*2)+voffB[_i]),(LAS unsigned*)(lds+(bufoff)+ldsw+_i*8192),16,0,0);} }while(0)
    #define LDA(dst,b,h) _Pragma("unroll") for(int m=0;m<4;++m) _Pragma("unroll") for(int k=0;k<2;++k) \
        dst[m][k]=*(const LAS bf16x8*)(lds+SA(b,h)+aoff+m*2048+k*1024)
    #define LDB(dst,b,h) _Pragma("unroll") for(int n=0;n<2;++n) _Pragma("unroll") for(int k=0;k<2;++k) \
        dst[n][k]=*(const LAS bf16x8*)(lds+SB(b,h)+boff+n*2048+k*1024)
    #define MMA(ai,bj,At_,Bt_) do{__builtin_amdgcn_s_setprio(1); \
        _Pragma("unroll") for(int m=0;m<4;++m) _Pragma("unroll") for(int n=0;n<2;++n) _Pragma("unroll") for(int k=0;k<2;++k) \
          acc[ai][bj][m][n]=__builtin_amdgcn_mfma_f32_16x16x32_bf16(Bt_[n][k],At_[m][k],acc[ai][bj][m][n],0,0,0); \
        __builtin_amdgcn_s_setprio(0);}while(0)
    #define WAIT_V(n) asm volatile("s_waitcnt vmcnt(" #n ")":::"memory")
    #define WAIT_L(n) asm volatile("s_waitcnt lgkmcnt(" #n ")":::"memory")
    #define BAR __builtin_amdgcn_s_barrier()
    #define SCHED __builtin_amdgcn_sched_barrier(0)

    f32x4 acc[2][2][4][2];
#pragma unroll
    for (int a = 0; a < 2; ++a)
#pragma unroll
        for (int b = 0; b < 2; ++b)
#pragma unroll
            for (int m = 0; m < 4; ++m)
#pragma unroll
                for (int n = 0; n < 2; ++n) acc[a][b][m][n] = (f32x4){0.f, 0.f, 0.f, 0.f};
    bf16x8 At[4][2], B0[2][2], B1[2][2];
    STAGE_B(SB(0,0),0,0); STAGE_A(SA(0,0),0,0);
    STAGE_B(SB(0,1),1,0); STAGE_A(SA(0,1),1,0);
    if (wr == 1) BAR;
    WAIT_V(4); BAR;
    STAGE_B(SB(1,0),0,1); STAGE_A(SA(1,0),0,1); STAGE_B(SB(1,1),1,1);
    WAIT_V(6); BAR;
    for (int t = 0; t < nt - 2; t += 2) {
        LDB(B0,0,0); SCHED; LDA(At,0,0); STAGE_A(SA(1,1),1,t+1);
        WAIT_L(8); BAR; WAIT_L(0); MMA(0,0,At,B0); BAR; SCHED;
        LDB(B1,0,1); STAGE_B(SB(0,0),0,t+2);
        BAR; WAIT_L(0); MMA(0,1,At,B1); BAR;
        LDA(At,0,1); STAGE_A(SA(0,0),0,t+2);
        BAR; WAIT_L(0); MMA(1,0,At,B0); BAR; SCHED;
        STAGE_B(SB(0,1),1,t+2);
        WAIT_V(6); BAR; MMA(1,1,At,B1); BAR;
        LDB(B0,1,0); SCHED; LDA(At,1,0); STAGE_A(SA(0,1),1,t+2);
        WAIT_L(8); BAR; WAIT_L(0); MMA(0,0,At,B0); BAR; SCHED;
        LDB(B1,1,1); STAGE_B(SB(1,0),0,t+3);
        BAR; WAIT_L(0); MMA(0,1,At,B1); BAR;
        LDA(At,1,1); STAGE_A(SA(1,0),0,t+3);
        BAR; WAIT_L(0); MMA(1,0,At,B0); BAR; SCHED;
        STAGE_B(SB(1,1),1,t+3);
        WAIT_V(6); BAR; MMA(1,1,At,B1); BAR;
    }
    { LDB(B0,0,0); LDA(At,0,0); STAGE_A(SA(1,1),1,nt-1);
      BAR; WAIT_L(0); MMA(0,0,At,B0); BAR;
      LDB(B1,0,1); BAR; WAIT_L(0); MMA(0,1,At,B1); BAR;
      LDA(At,0,1); WAIT_V(4); BAR; WAIT_L(0); MMA(1,0,At,B0); MMA(1,1,At,B1); BAR; }
    { LDB(B0,1,0); LDA(At,1,0); WAIT_V(2); BAR; WAIT_L(0); MMA(0,0,At,B0); BAR;
      LDB(B1,1,1); WAIT_V(0); BAR; WAIT_L(0); MMA(0,1,At,B1); BAR;
      LDA(At,1,1); BAR; WAIT_L(0); MMA(1,0,At,B0); MMA(1,1,At,B1); BAR; }
    if (wr == 0) BAR;
    if constexpr (EK == 1) { __syncthreads(); gmlp_epilogue(acc, *gm, (char*)lds, wr, wc, fr, fq); } else if constexpr (EK == 2) { __syncthreads(); kvlat_epilogue(acc, *kv, (char*)lds, wr, wc, fr, fq); } else run_epilogue(u.ep, acc, wr, wc, fr, fq);
    __syncthreads();
    #undef SA
    #undef SB
    #undef STAGE_A
    #undef STAGE_B
    #undef LDA
    #undef LDB
    #undef MMA
}


template <class PH>
__device__ __forceinline__ void gemm_stream(const PH& ph, LAS unsigned char* lds, int u0, int ustride) {
    typedef Unit<typename PH::EP> U;
    int tid = threadIdx.x; asm volatile("" : "+v"(tid));
    const int wid = __builtin_amdgcn_readfirstlane(tid >> 6), lane = tid & 63, wr = wid >> 2, wc = wid & 3, fr = lane & 15, fq = lane >> 4;
    int u = u0;
    U cu; if (u >= PH::NU || !ph.unit(u, cu)) return;
    const int K = cu.K, nt = K / BK;
    int R0, C0, R1, C1; stage_rc(tid * 16, R0, C0); stage_rc(tid * 16 + 8192, R1, C1);
    unsigned voffB0 = (unsigned)(R0 * K + C0) * 2u, voffB1 = (unsigned)(R1 * K + C1) * 2u;
    #define VOFFA(am, o00, o01, o10, o11) do { \
        if ((am).list) { const int n_ = (am).nvalid; const int a00 = (am).list[R0 < n_ ? R0 : 0], a01 = (am).list[R1 < n_ ? R1 : 0], a10 = (am).list[R0 + HALF < n_ ? R0 + HALF : 0], a11 = (am).list[R1 + HALF < n_ ? R1 + HALF : 0]; \
            o00 = ((unsigned)(a00 >> 1) * (unsigned)(am).ld + (unsigned)C0) * 2u; o01 = ((unsigned)(a01 >> 1) * (unsigned)(am).ld + (unsigned)C1) * 2u; \
            o10 = ((unsigned)(a10 >> 1) * (unsigned)(am).ld + (unsigned)C0) * 2u; o11 = ((unsigned)(a11 >> 1) * (unsigned)(am).ld + (unsigned)C1) * 2u; } \
        else { o00 = (unsigned)(R0 * (am).ld + C0) * 2u; o01 = (unsigned)(R1 * (am).ld + C1) * 2u; o10 = (unsigned)((R0 + HALF) * (am).ld + C0) * 2u; o11 = (unsigned)((R1 + HALF) * (am).ld + C1) * 2u; } } while (0)
    unsigned va00, va01, va10, va11; VOFFA(cu.am, va00, va01, va10, va11);
    const char* cA = (const char*)cu.am.base; const char* cB = (const char*)cu.bt;
    const size_t hstepB = (size_t)HALF * K * 2, kstep = BK * 2;
    const unsigned ldsw = (unsigned)wid * 1024u;
    const int aoff = lds_byte(wr * 64 + fr, fq * 8), boff = lds_byte(wc * 32 + fr, fq * 8);
    #define SA(b,h) (((b)*2+(h))*HT*2)
    #define SB(b,h) ((4+(b)*2+(h))*HT*2)
    #define STG(bufoff, gbase, o0, o1) do { asm volatile("" : "+v"(o0)); asm volatile("" : "+v"(o1)); \
        __builtin_amdgcn_global_load_lds((const unsigned*)((gbase) + (o0)), (LAS unsigned*)(lds + (bufoff) + ldsw), 16, 0, 0); \
        __builtin_amdgcn_global_load_lds((const unsigned*)((gbase) + (o1)), (LAS unsigned*)(lds + (bufoff) + ldsw + 8192), 16, 0, 0); } while (0)
    #define LDA(dst,b,h) _Pragma("unroll") for(int m=0;m<4;++m) _Pragma("unroll") for(int k=0;k<2;++k) \
        dst[m][k]=*(const LAS bf16x8*)(lds+SA(b,h)+aoff+m*2048+k*1024)
    #define LDB(dst,b,h) _Pragma("unroll") for(int n=0;n<2;++n) _Pragma("unroll") for(int k=0;k<2;++k) \
        dst[n][k]=*(const LAS bf16x8*)(lds+SB(b,h)+boff+n*2048+k*1024)
    #define MMA(ai,bj,At_,Bt_) do{__builtin_amdgcn_s_setprio(1); \
        _Pragma("unroll") for(int m=0;m<4;++m) _Pragma("unroll") for(int n=0;n<2;++n) _Pragma("unroll") for(int k=0;k<2;++k) \
          acc[ai][bj][m][n]=__builtin_amdgcn_mfma_f32_16x16x32_bf16(Bt_[n][k],At_[m][k],acc[ai][bj][m][n],0,0,0); \
        __builtin_amdgcn_s_setprio(0);}while(0)
    f32x4 acc[2][2][4][2];
    #define ZERO_ACC _Pragma("unroll") for (int a = 0; a < 2; ++a) _Pragma("unroll") for (int b = 0; b < 2; ++b) _Pragma("unroll") for (int m = 0; m < 4; ++m) _Pragma("unroll") for (int n = 0; n < 2; ++n) acc[a][b][m][n] = (f32x4){0.f, 0.f, 0.f, 0.f}
    bf16x8 At[4][2], B0[2][2], B1[2][2];
#ifndef SP2
#define SP2 0
#endif
#if SP2
    STG(SB(0,0), cB, voffB0, voffB1); STG(SB(0,1), cB + hstepB, voffB0, voffB1); STG(SA(0,0), cA, va00, va01); STG(SA(0,1), cA, va10, va11);
    if (wr == 1) BAR;
    WAIT_V(2); BAR;
#else
    STG(SB(0,0), cB, voffB0, voffB1); STG(SA(0,0), cA, va00, va01); STG(SB(0,1), cB + hstepB, voffB0, voffB1); STG(SA(0,1), cA, va10, va11);
    if (wr == 1) BAR;
    WAIT_V(4); BAR;
#endif
    STG(SB(1,0), cB + kstep, voffB0, voffB1); STG(SA(1,0), cA + kstep, va00, va01); STG(SB(1,1), cB + hstepB + kstep, voffB0, voffB1);
    WAIT_V(6); BAR;
    for (;;) {
        U nx; int un; if constexpr (HasNext<PH>::value) un = ph.next(wr); else un = u + ustride;
        const bool has_next = (un < PH::NU) && ph.unit(un, nx);
        unsigned na00 = va00, na01 = va01, na10 = va10, na11 = va11; const char* nA = cA; const char* nB = cB;
        if (has_next) { VOFFA(nx.am, na00, na01, na10, na11); nA = (const char*)nx.am.base; nB = (const char*)nx.bt; }
        ZERO_ACC;
#if SP2
        #define KBODY(a1_, a2_, b2_, X00, X01, X10, X11) do { \
            const char* a3_ = (a2_) + kstep; const char* b3_ = (b2_) + kstep; \
            LDB(B0,0,0); LDB(B1,0,1); SCHED; LDA(At,0,0); STG(SA(1,1), a1_, va10, va11); \
            WAIT_V(8); WAIT_L(0); BAR; MMA(0,0,At,B0); MMA(0,1,At,B1); BAR; SCHED; \
            LDA(At,0,1); STG(SB(0,0), b2_, voffB0, voffB1); STG(SB(0,1), (b2_) + hstepB, voffB0, voffB1); STG(SA(0,0), a2_, X00, X01); \
            WAIT_V(8); WAIT_L(0); BAR; MMA(1,0,At,B0); MMA(1,1,At,B1); BAR; SCHED; \
            LDB(B0,1,0); LDB(B1,1,1); SCHED; LDA(At,1,0); STG(SA(0,1), a2_, X10, X11); \
            WAIT_V(8); WAIT_L(0); BAR; MMA(0,0,At,B0); MMA(0,1,At,B1); BAR; SCHED; \
            LDA(At,1,1); STG(SB(1,0), b3_, voffB0, voffB1); STG(SB(1,1), (b3_) + hstepB, voffB0, voffB1); STG(SA(1,0), a3_, X00, X01); \
            WAIT_V(8); WAIT_L(0); BAR; MMA(1,0,At,B0); MMA(1,1,At,B1); BAR; SCHED; } while (0)
#else
        #define KBODY(a1_, a2_, b2_, X00, X01, X10, X11) do { \
            const char* a3_ = (a2_) + kstep; const char* b3_ = (b2_) + kstep; \
            LDB(B0,0,0); SCHED; LDA(At,0,0); STG(SA(1,1), a1_, va10, va11); \
            WAIT_L(8); BAR; WAIT_L(0); MMA(0,0,At,B0); BAR; SCHED; \
            LDB(B1,0,1); STG(SB(0,0), b2_, voffB0, voffB1); \
            BAR; WAIT_L(0); MMA(0,1,At,B1); BAR; \
            LDA(At,0,1); STG(SA(0,0), a2_, X00, X01); \
            BAR; WAIT_L(0); MMA(1,0,At,B0); BAR; SCHED; \
            STG(SB(0,1), (b2_) + hstepB, voffB0, voffB1); \
            WAIT_V(6); BAR; MMA(1,1,At,B1); BAR; \
            LDB(B0,1,0); SCHED; LDA(At,1,0); STG(SA(0,1), a2_, X10, X11); \
            WAIT_L(8); BAR; WAIT_L(0); MMA(0,0,At,B0); BAR; SCHED; \
            LDB(B1,1,1); STG(SB(1,0), b3_, voffB0, voffB1); \
            BAR; WAIT_L(0); MMA(0,1,At,B1); BAR; \
            LDA(At,1,1); STG(SA(1,0), a3_, X00, X01); \
            BAR; WAIT_L(0); MMA(1,0,At,B0); BAR; SCHED; \
            STG(SB(1,1), (b3_) + hstepB, voffB0, voffB1); \
            WAIT_V(6); BAR; MMA(1,1,At,B1); BAR; } while (0)
#endif
#ifndef KREP
#define KREP 1
#endif
        for (int t = 0; t < nt * KREP - 2; t += 2) { const int t1 = (KREP > 1) ? (t + 1) % nt : t + 1, t2 = (KREP > 1) ? (t + 2) % nt : t + 2;
            const char* a1 = cA + (size_t)t1 * kstep; const char* a2 = cA + (size_t)t2 * kstep; const char* b2 = cB + (size_t)t2 * kstep;
            KBODY(a1, a2, b2, va00, va01, va10, va11); }
        { const char* a1 = cA + (size_t)(nt - 1) * kstep; KBODY(a1, nA, nB, na00, na01, na10, na11); }
        if (KREP > 1) {
#pragma unroll
            for (int a = 0; a < 2; ++a)
#pragma unroll
                for (int b = 0; b < 2; ++b)
#pragma unroll
                    for (int m = 0; m < 4; ++m)
#pragma unroll
                        for (int n = 0; n < 2; ++n) acc[a][b][m][n] = acc[a][b][m][n] * (1.0f / KREP); }
        #undef KBODY
        if constexpr (HasPrefetch<PH>::value) { if (has_next) ph.prefetch(); }
        run_epilogue(cu.ep, acc, wr, wc, fr, fq);
        if constexpr (EPIDUP && HasDupOk<typename PH::EP>::value) { asm volatile("" ::: "memory"); run_epilogue(cu.ep, acc, wr, wc, fr, fq); }
        if constexpr (HasDone<PH>::value) ph.done(cu, wr);
        if (!has_next) break;
        cu = nx; va00 = na00; va01 = na01; va10 = na10; va11 = na11; cA = nA; cB = nB; u = un;
    }
    WAIT_V(0);
    if (wr == 0) BAR;
    BAR;
    __syncthreads();
    #undef SA
    #undef SB
    #undef STG
    #undef LDA
    #undef LDB
    #undef MMA
    #undef ZERO_ACC
    #undef VOFFA
}

__device__ __forceinline__ void witem(const float* s0, const float* s1, int ldsrc, bf16_t* dst, int K, int k0, int n0, int mode, const float* kscale, float* scr, int lane, float* cpart = nullptr, const float* cbias = nullptr) {
    const int n = n0 + (lane & 31);
    const float* s = s0; int col = n;
    if (mode == 1) { if (n >= 1728) col = -1; else if (n >= 1664) { const int i = (n - 1664) >> 1, pp = (n - 1664) & 1; col = 1664 + i + 32 * pp; }
        else if (GMLP_FUSED && n < 1024) { const int t = n >> 8, w = n & 255; col = w < 128 ? t * 128 + w : 512 + t * 128 + (w - 128); }
        else if (ZLAYOUT2 && n >= 1024) { col = n < 1280 ? 1408 + (n - 1024) : n < 1536 ? 1024 + (n - 1280) : 1280 + (n - 1536); } }
    else if (mode == 2) { const int h = n / 192, d = n - h * 192; if (d >= 128) { const int i = (d - 128) >> 1, pp = (d - 128) & 1; col = h * 192 + 128 + i + 32 * pp; } }
    else if (mode == 3) { const int G = n >> 5, r = n & 31; col = 16 * G + (r & 15); s = (r < 16) ? s0 : s1; }
    if (WITEM_WIDE && (mode == 0 || mode == 3)) {
        const int kr = lane >> 3, nq = lane & 7, nw = n0 + 4 * nq;
        const float* sw = s0; int cw = nw;
        if (mode == 3) { const int G = nw >> 5, r = nw & 31; cw = 16 * G + (r & 15); sw = (r < 16) ? s0 : s1; }
        const float* spw = sw + (size_t)(k0 + kr) * ldsrc + cw;
        f32x4 vv[8];
#pragma unroll
        for (int i = 0; i < 8; ++i) vv[i] = NT_IO ? __builtin_nontemporal_load((const f32x4*)(spw + (size_t)(8 * i) * ldsrc)) : *(const f32x4*)(spw + (size_t)(8 * i) * ldsrc);
#pragma unroll
        for (int i = 0; i < 8; ++i) { float* d = scr + (8 * i + kr) * 33 + 4 * nq; d[0] = vv[i][0]; d[1] = vv[i][1]; d[2] = vv[i][2]; d[3] = vv[i][3]; }
    } else {
    const float* sp = s + (size_t)(k0 + (lane >> 5)) * ldsrc + (col < 0 ? 0 : col);
    float v[32];
#pragma unroll
    for (int i = 0; i < 32; ++i) v[i] = NT_IO ? __builtin_nontemporal_load(sp + (size_t)(2 * i) * ldsrc) : sp[(size_t)(2 * i) * ldsrc];
    if (col < 0) {
#pragma unroll
        for (int i = 0; i < 32; ++i) v[i] = 0.f;
    }
#pragma unroll
    for (int i = 0; i < 32; ++i) scr[(2 * i + (lane >> 5)) * 33 + (lane & 31)] = v[i];
    }
    asm volatile("s_waitcnt lgkmcnt(0)" ::: "memory");
    const int c = lane & 7;
    f32x4 ks0 = {1.f, 1.f, 1.f, 1.f}, ks1 = ks0, kb0 = {0.f, 0.f, 0.f, 0.f}, kb1 = kb0;
    if (kscale) { ks0 = *(const f32x4*)(kscale + k0 + 8 * c); ks1 = *(const f32x4*)(kscale + k0 + 8 * c + 4); }
    if (cpart) { kb0 = *(const f32x4*)(cbias + k0 + 8 * c); kb1 = *(const f32x4*)(cbias + k0 + 8 * c + 4); }
#pragma unroll
    for (int j = 0; j < 4; ++j) { const int nn = (lane >> 3) + 8 * j; const float* q = scr + (8 * c) * 33 + nn;
        const float w0 = q[0], w1 = q[33], w2 = q[2 * 33], w3 = q[3 * 33], w4 = q[4 * 33], w5 = q[5 * 33], w6 = q[6 * 33], w7 = q[7 * 33];
        u32x4 o; o.x = pk2(w0 * ks0[0], w1 * ks0[1]); o.y = pk2(w2 * ks0[2], w3 * ks0[3]); o.z = pk2(w4 * ks1[0], w5 * ks1[1]); o.w = pk2(w6 * ks1[2], w7 * ks1[3]);
        *(u32x4*)(dst + (size_t)(n0 + nn) * K + k0 + 8 * c) = o;
        if (cpart) {
            float cs1 = ((bflo(o.x) + bfhi(o.x)) + (bflo(o.y) + bfhi(o.y))) + ((bflo(o.z) + bfhi(o.z)) + (bflo(o.w) + bfhi(o.w)));
            float cs2 = ((w0 * kb0[0] + w1 * kb0[1]) + (w2 * kb0[2] + w3 * kb0[3])) + ((w4 * kb1[0] + w5 * kb1[1]) + (w6 * kb1[2] + w7 * kb1[3]));
            cs1 += shx(cs1, 1); cs2 += shx(cs2, 1); cs1 += shx(cs1, 2); cs2 += shx(cs2, 2); cs1 += shx(cs1, 4); cs2 += shx(cs2, 4);
            if (c == 0) { cpart[n0 + nn] = cs1; cpart[512 + n0 + nn] = cs2; } } }
    asm volatile("s_waitcnt lgkmcnt(0)" ::: "memory");
}
constexpr int I_IN = 16 * 56, I_UQ = 6 * 24, I_UKV = 4 * 32, I_OUT = 16 * 32, I_GU = 32 * 16 * 16, I_DN = 32 * 4 * 32;
constexpr int I_TOTAL = I_IN + I_UQ + I_UKV + I_OUT + I_GU + I_DN, I_EARLY = I_IN + I_UQ + I_UKV + I_OUT;
template <int CTRL> __device__ __forceinline__ float dppf(float x) { return __int_as_float(__builtin_amdgcn_mov_dpp(__float_as_int(x), CTRL, 0xf, 0xf, true)); }
struct WItem { const float *s0, *s1; int ldsrc; bf16_t* dst; int K, k0, n0, mode; const float* kscale; float* cpart; const float* cbias; };
__device__ __forceinline__ WItem wi_moe(const Params& p, int it) {
    WItem w;
    if (it < I_GU) { const int e = it >> 8, r = it & 255, kb = r >> 4, nb = r & 15;
        w.s0 = p.w_gate + (size_t)e * 1024 * 256; w.s1 = p.w_up + (size_t)e * 1024 * 256; w.ldsrc = 256; w.dst = p.WguT + (size_t)e * 512 * 1024; w.K = 1024; w.k0 = kb * 64; w.n0 = nb * 32; w.mode = 3;
        w.kscale = LN1FOLD ? p.ln1_g : nullptr; w.cpart = LN1FOLD ? p.lnf + LNF_CPART + (size_t)(e * 16 + kb) * 1024 : nullptr; w.cbias = LN1FOLD ? p.ln1_b : nullptr; }
    else { it -= I_GU; const int e = it >> 7, r = it & 127, kb = r >> 5, nb = r & 31;
        w.s0 = p.w_down + (size_t)e * 256 * 1024; w.s1 = nullptr; w.ldsrc = 1024; w.dst = p.WdT + (size_t)e * 1024 * 256; w.K = 256; w.k0 = kb * 64; w.n0 = nb * 32; w.mode = 0;
        w.kscale = nullptr; w.cpart = nullptr; w.cbias = nullptr; }
    return w;
}
__device__ __forceinline__ void wi_load(const WItem& w, float (&v)[32], int lane) {
    const int n = w.n0 + (lane & 31);
    const float* s = w.s0; int col = n;
    if (w.mode == 3) { const int G = n >> 5, r = n & 31; col = 16 * G + (r & 15); s = (r < 16) ? w.s0 : w.s1; }
    const float* sp = s + (size_t)(w.k0 + (lane >> 5)) * w.ldsrc + col;
#pragma unroll
    for (int i = 0; i < 32; ++i) v[i] = __builtin_nontemporal_load(sp + (size_t)(2 * i) * w.ldsrc);
}
__device__ __forceinline__ void wi_finish(const WItem& w, const float (&v)[32], float* scr, int lane) {
#pragma unroll
    for (int i = 0; i < 32; ++i) scr[(2 * i + (lane >> 5)) * 33 + (lane & 31)] = v[i];
    asm volatile("s_waitcnt lgkmcnt(0)" ::: "memory");
    const int c = lane & 7;
    f32x4 ks0 = {1.f, 1.f, 1.f, 1.f}, ks1 = ks0, kb0 = {0.f, 0.f, 0.f, 0.f}, kb1 = kb0;
    if (w.kscale) { ks0 = *(const f32x4*)(w.kscale + w.k0 + 8 * c); ks1 = *(const f32x4*)(w.kscale + w.k0 + 8 * c + 4); }
    if (w.cpart) { kb0 = *(const f32x4*)(w.cbias + w.k0 + 8 * c); kb1 = *(const f32x4*)(w.cbias + w.k0 + 8 * c + 4); }
#pragma unroll
    for (int j = 0; j < 4; ++j) { const int nn = (lane >> 3) + 8 * j; const float* q = scr + (8 * c) * 33 + nn;
        const float w0 = q[0], w1 = q[33], w2 = q[2 * 33], w3 = q[3 * 33], w4 = q[4 * 33], w5 = q[5 * 33], w6 = q[6 * 33], w7 = q[7 * 33];
        u32x4 o; o.x = pk2(w0 * ks0[0], w1 * ks0[1]); o.y = pk2(w2 * ks0[2], w3 * ks0[3]); o.z = pk2(w4 * ks1[0], w5 * ks1[1]); o.w = pk2(w6 * ks1[2], w7 * ks1[3]);
        *(u32x4*)(w.dst + (size_t)(w.n0 + nn) * w.K + w.k0 + 8 * c) = o;
        if (w.cpart) {
            float cs1 = ((bflo(o.x) + bfhi(o.x)) + (bflo(o.y) + bfhi(o.y))) + ((bflo(o.z) + bfhi(o.z)) + (bflo(o.w) + bfhi(o.w)));
            float cs2 = ((w0 * kb0[0] + w1 * kb0[1]) + (w2 * kb0[2] + w3 * kb0[3])) + ((w4 * kb1[0] + w5 * kb1[1]) + (w6 * kb1[2] + w7 * kb1[3]));
            cs1 += dppf<0xB1>(cs1); cs2 += dppf<0xB1>(cs2); cs1 += dppf<0x4E>(cs1); cs2 += dppf<0x4E>(cs2); cs1 += dppf<0x141>(cs1); cs2 += dppf<0x141>(cs2);
            if (c == 0) { w.cpart[w.n0 + nn] = cs1; w.cpart[512 + w.n0 + nn] = cs2; } } }
    asm volatile("s_waitcnt lgkmcnt(0)" ::: "memory");
}
__device__ __forceinline__ void prep_witem(const Params& p, int it, float* scr, int lane) {
    if (it < I_IN) { const int kb = it / 56, nb = it - kb * 56; witem(p.w_in, nullptr, 1728, p.WinT, 1024, kb * 64, nb * 32, 1, nullptr, scr, lane); return; } it -= I_IN;
    if (it < I_UQ) { const int kb = it / 24, nb = it - kb * 24; witem(p.w_uq, nullptr, 768, p.WuqT, 384, kb * 64, nb * 32, 0, p.qn_g, scr, lane); return; } it -= I_UQ;
    if (it < I_UKV) { const int kb = it >> 5, nb = it & 31; witem(p.w_ukv, nullptr, 1024, p.WukvT, 256, kb * 64, nb * 32, 0, p.kvn_g, scr, lane); return; } it -= I_UKV;
    if (it < I_OUT) { const int kb = it >> 5, nb = it & 31; witem(p.w_out, nullptr, 1024, p.WoutT, 1024, kb * 64, nb * 32, 0, nullptr, scr, lane); return; } it -= I_OUT;
    if (it < I_GU) { const int e = it >> 8, r = it & 255, kb = r >> 4, nb = r & 15;
#if LN1FOLD
        witem(p.w_gate + (size_t)e * 1024 * 256, p.w_up + (size_t)e * 1024 * 256, 256, p.WguT + (size_t)e * 512 * 1024, 1024, kb * 64, nb * 32, 3, p.ln1_g, scr, lane, p.lnf + LNF_CPART + (size_t)(e * 16 + kb) * 1024, p.ln1_b); return; } it -= I_GU;
#else
        witem(p.w_gate + (size_t)e * 1024 * 256, p.w_up + (size_t)e * 1024 * 256, 256, p.WguT + (size_t)e * 512 * 1024, 1024, kb * 64, nb * 32, 3, nullptr, scr, lane); return; } it -= I_GU;
#endif
    { const int e = it >> 7, r = it & 127, kb = r >> 5, nb = r & 31;
        witem(p.w_down + (size_t)e * 256 * 1024, nullptr, 1024, p.WdT + (size_t)e * 1024 * 256, 256, kb * 64, nb * 32, 0, nullptr, scr, lane); }
}
template <bool WT> __device__ __forceinline__ void ln0_row4(const float* x, size_t rstride, const float* g, const float* b, bf16_t* o, int lane) {
    f32x4 v[4][4]; float s[4], q[4];
#pragma unroll
    for (int r = 0; r < 4; ++r)
#pragma unroll
        for (int j = 0; j < 4; ++j) v[r][j] = NT_IO ? __builtin_nontemporal_load((const f32x4*)(x + r * rstride + 256 * j + 4 * lane)) : *(const f32x4*)(x + r * rstride + 256 * j + 4 * lane);
#pragma unroll
    for (int r = 0; r < 4; ++r) { s[r] = 0.f; q[r] = 0.f;
#pragma unroll
        for (int j = 0; j < 4; ++j) { s[r] += (v[r][j][0] + v[r][j][1]) + (v[r][j][2] + v[r][j][3]);
            q[r] += (v[r][j][0] * v[r][j][0] + v[r][j][1] * v[r][j][1]) + (v[r][j][2] * v[r][j][2] + v[r][j][3] * v[r][j][3]); } }
#pragma unroll
    for (int o2 = 1; o2 < 64; o2 <<= 1) {
#pragma unroll
        for (int r = 0; r < 4; ++r) { s[r] += shx(s[r], o2); q[r] += shx(q[r], o2); } }
    f32x4 gg[4], bb[4];
#pragma unroll
    for (int j = 0; j < 4; ++j) { gg[j] = *(const f32x4*)(g + 256 * j + 4 * lane); bb[j] = *(const f32x4*)(b + 256 * j + 4 * lane); }
#pragma unroll
    for (int r = 0; r < 4; ++r) { const float mean = s[r] * (1.f / 1024.f), var = fmaxf(q[r] * (1.f / 1024.f) - mean * mean, 0.f), rstd = 1.f / sqrtf(var + 1e-5f);
#pragma unroll
        for (int j = 0; j < 4; ++j) { if (WT) st4wt(o + r * rstride + 256 * j + 4 * lane, (v[r][j] - mean) * rstd * gg[j] + bb[j]); else st4(o + r * rstride + 256 * j + 4 * lane, (v[r][j] - mean) * rstd * gg[j] + bb[j]); } }
}
__device__ __forceinline__ void ln0_row1_wt(const float* xr, const float* g, const float* b, bf16_t* orow, int lane) {
    f32x4 v[4]; float s = 0.f, q = 0.f;
#pragma unroll
    for (int j = 0; j < 4; ++j) { v[j] = *(const f32x4*)(xr + 256 * j + 4 * lane); s += (v[j][0] + v[j][1]) + (v[j][2] + v[j][3]); q += (v[j][0] * v[j][0] + v[j][1] * v[j][1]) + (v[j][2] * v[j][2] + v[j][3] * v[j][3]); }
#pragma unroll
    for (int o2 = 1; o2 < 64; o2 <<= 1) { s += shx(s, o2); q += shx(q, o2); }
    const float mean = s * (1.f / 1024.f), var = fmaxf(q * (1.f / 1024.f) - mean * mean, 0.f), rstd = 1.f / sqrtf(var + 1e-5f);
#pragma unroll
    for (int j = 0; j < 4; ++j) { const f32x4 gg = *(const f32x4*)(g + 256 * j + 4 * lane), bb = *(const f32x4*)(b + 256 * j + 4 * lane); st4wt(orow + 256 * j + 4 * lane, (v[j] - mean) * rstd * gg + bb); }
}

template <int K> __device__ __forceinline__ void rs_table(const bf16_t* A, float* tab) {
    int tid = threadIdx.x; asm volatile("" : "+v"(tid));
    const int r = tid >> 1, hf = tid & 1; constexpr int n = K >> 1;
    const bf16_t* a = A + (size_t)r * K + hf * n; float s = 0.f;
    u32x4 w[n / 8];
#pragma unroll
    for (int i = 0; i < n / 8; ++i) w[i] = *(const u32x4*)(a + 8 * i);
#pragma unroll
    for (int i = 0; i < n / 8; ++i) { const float a0 = bflo(w[i].x), a1 = bfhi(w[i].x), a2 = bflo(w[i].y), a3 = bfhi(w[i].y), a4 = bflo(w[i].z), a5 = bfhi(w[i].z), a6 = bflo(w[i].w), a7 = bfhi(w[i].w);
        s += (a0 * a0 + a1 * a1) + (a2 * a2 + a3 * a3) + (a4 * a4 + a5 * a5) + (a6 * a6 + a7 * a7); }
    s += shx(s, 1);
    if (hf == 0) tab[r] = 1.f / sqrtf(s / (float)K + 1e-6f);
}

__device__ __forceinline__ void gmlp_phase(const Params& p, char* shm, int vcu) {
    int tid = threadIdx.x; asm volatile("" : "+v"(tid));
    const int wid = __builtin_amdgcn_readfirstlane(tid >> 6), lane = tid & 63, fr = lane & 15, fq = lane >> 4;
    const int h = vcu & 3, iabs = 16 * wid + fr;
    bf16x8 wf[4];
#pragma unroll
    for (int ks = 0; ks < 4; ++ks) {
        const float* w = p.w_sp + ((size_t)h * 128 + iabs) * 128 + 32 * ks + 8 * fq;
        const f32x4 w0 = *(const f32x4*)w, w1 = *(const f32x4*)(w + 4);
        const bool ok = (ks >> 1) <= (iabs >> 6);
        u32x4 pk; pk.x = pk2(w0[0], w0[1]); pk.y = pk2(w0[2], w0[3]); pk.z = pk2(w1[0], w1[1]); pk.w = pk2(w1[2], w1[3]);
        if (!ok) pk = (u32x4){0u, 0u, 0u, 0u};
        wf[ks] = __builtin_bit_cast(bf16x8, pk);
    }
    const float bias = p.b_sp[h * 128 + iabs];
    const int nks = (wid < 4) ? 2 : 4;
    const int j = tid >> 2, part = tid & 3;
    const int nb_ = gridDim.x, nrem = 896 % nb_, ng = (nb_ == 256) ? ((vcu >= nrem) ? 5 : 3) : -1;
    for (int gi = 0;; ++gi) {
        int u;
        if (ng < 0) { u = vcu + gi * nb_; if (u >= (T_TOK / 128) * 4) break; }
        else { if (gi >= ng) break; u = gi < 3 ? vcu + gi * 256 : 768 + (vcu - 128) + 128 * (gi - 3); }
        const int bn = u >> 2, row0 = bn * 128;
        {
            const bf16_t* vr = p.zv + (size_t)(row0 + j) * 512 + h * 128 + part * 32;
            float v[32];
#pragma unroll
            for (int q = 0; q < 4; ++q) { const u32x4 w = *(const u32x4*)(vr + 8 * q);
                v[8 * q + 0] = bflo(w.x); v[8 * q + 1] = bfhi(w.x); v[8 * q + 2] = bflo(w.y); v[8 * q + 3] = bfhi(w.y);
                v[8 * q + 4] = bflo(w.z); v[8 * q + 5] = bfhi(w.z); v[8 * q + 6] = bflo(w.w); v[8 * q + 7] = bfhi(w.w); }
            float s = 0.f;
#pragma unroll
            for (int e = 0; e < 32; ++e) s += v[e];
            s += shx(s, 1); s += shx(s, 2);
            const float mean = s * (1.f / 128.f); float s2 = 0.f;
#pragma unroll
            for (int e = 0; e < 32; ++e) { v[e] -= mean; s2 += v[e] * v[e]; }
            s2 += shx(s2, 1); s2 += shx(s2, 2);
            const float rstd = 1.f / sqrtf(s2 * (1.f / 128.f) + 1e-5f);
            const float* gg = p.gm_g + h * 128 + part * 32; const float* bb = p.gm_b + h * 128 + part * 32;
#pragma unroll
            for (int e = 0; e < 32; ++e) *(bf16_t*)(shm + (part * 32 + e) * 272 + j * 2) = f2bf(v[e] * rstd * gg[e] + bb[e]);
        }
        __syncthreads();
        f32x4 acc[8];
#pragma unroll
        for (int cb = 0; cb < 8; ++cb) acc[cb] = (f32x4){0.f, 0.f, 0.f, 0.f};
#pragma unroll
        for (int ks = 0; ks < 4; ++ks) if (ks < nks) {
#pragma unroll
            for (int cb = 0; cb < 8; ++cb) { const bf16x8 a = *(const bf16x8*)(shm + (16 * cb + fr) * 272 + (32 * ks + 8 * fq) * 2);
                acc[cb] = __builtin_amdgcn_mfma_f32_16x16x32_bf16(a, wf[ks], acc[cb], 0, 0, 0); }
        }
        const bf16_t* ur = p.zu + (size_t)(row0 + iabs) * 512 + h * 128 + 4 * fq;
        bf16_t* orow = p.mix + (size_t)(row0 + iabs) * DM + h * 128 + 4 * fq;
#pragma unroll
        for (int cb = 0; cb < 8; ++cb) { const u32x2 uw = *(const u32x2*)(ur + 16 * cb); f32x4 o;
            o[0] = bflo(uw.x) * (acc[cb][0] + bias); o[1] = bfhi(uw.x) * (acc[cb][1] + bias); o[2] = bflo(uw.y) * (acc[cb][2] + bias); o[3] = bfhi(uw.y) * (acc[cb][3] + bias);
            st4(orow + 16 * cb, o); }
        __syncthreads();
    }
}

#ifndef ATTPIPE
#define ATTPIPE 1
#endif
#ifndef ATTSCHED
#define ATTSCHED 0
#endif
#ifndef QLDS
#define QLDS 0
#endif
#ifndef ATTSBMASK
#define ATTSBMASK 7
#endif
#define ATT_SB(b) do { if ((ATTSBMASK) & (b)) __builtin_amdgcn_sched_barrier(0); } while (0)
#if ATTSCHED
#define ATT_SCHED() do { _Pragma("unroll") for (int _i = 0; _i < 8; ++_i) { __builtin_amdgcn_sched_group_barrier(0x100, 1, 0); __builtin_amdgcn_sched_group_barrier(0x008, 1, 0); __builtin_amdgcn_sched_group_barrier(0x002, ATTSCHED, 0); } } while (0)
#else
#define ATT_SCHED() do { } while (0)
#endif
__device__ __forceinline__ unsigned pk2nv(float lo, float hi) { unsigned r; asm("v_cvt_pk_bf16_f32 %0, %1, %2" : "=v"(r) : "v"(lo), "v"(hi)); return r; }
constexpr int KT_STRIDE = 400, VT_STRIDE = 144, KT_BYTES = 64 * KT_STRIDE, ATT_STAGE = KT_BYTES + 128 * VT_STRIDE;
template <int AMODE> __device__ __forceinline__ void attn_block(const Params& p, char* shm, int bh, int qb, bf16_t* outbuf) {
    int tid = threadIdx.x; asm volatile("" : "+v"(tid));
    const int wid = __builtin_amdgcn_readfirstlane(tid >> 6), lane = tid & 63, r = lane & 31, hh = lane >> 5;
    const int b = bh >> 2, h = bh & 3, q0 = qb * 256, ntile = 4 * qb + 4, nw = 4 * qb + (wid >> 1) + 1;
    bf16x8 qf[12];
    { const bf16_t* qp = p.Q + ((size_t)bh * SEQ + q0 + 32 * wid + r) * 192 + 8 * hh;
#pragma unroll
      for (int s = 0; s < 12; ++s) qf[s] = *(const bf16x8*)(qp + 16 * s);
      const float2* rp = p.rope + ((size_t)b * SEQ + q0 + 32 * wid + r) * 32 + 8 * hh;
#pragma unroll
      for (int s = 0; s < 2; ++s) { u32x4 x1 = __builtin_bit_cast(u32x4, qf[8 + s]), x2 = __builtin_bit_cast(u32x4, qf[10 + s]); float a[8], c2[8];
          a[0] = bflo(x1.x); a[1] = bfhi(x1.x); a[2] = bflo(x1.y); a[3] = bfhi(x1.y); a[4] = bflo(x1.z); a[5] = bfhi(x1.z); a[6] = bflo(x1.w); a[7] = bfhi(x1.w);
          c2[0] = bflo(x2.x); c2[1] = bfhi(x2.x); c2[2] = bflo(x2.y); c2[3] = bfhi(x2.y); c2[4] = bflo(x2.z); c2[5] = bfhi(x2.z); c2[6] = bflo(x2.w); c2[7] = bfhi(x2.w);
          float o1[8], o2[8];
#pragma unroll
          for (int j = 0; j < 8; ++j) { const float2 cs = rp[16 * s + j]; o1[j] = a[j] * cs.x - c2[j] * cs.y; o2[j] = c2[j] * cs.x + a[j] * cs.y; }
          x1.x = pk2(o1[0], o1[1]); x1.y = pk2(o1[2], o1[3]); x1.z = pk2(o1[4], o1[5]); x1.w = pk2(o1[6], o1[7]);
          x2.x = pk2(o2[0], o2[1]); x2.y = pk2(o2[2], o2[3]); x2.z = pk2(o2[4], o2[5]); x2.w = pk2(o2[6], o2[7]);
          qf[8 + s] = __builtin_bit_cast(bf16x8, x1); qf[10 + s] = __builtin_bit_cast(bf16x8, x2); } }
    f32x16 O[4];
#pragma unroll
    for (int d = 0; d < 4; ++d)
#pragma unroll
        for (int t = 0; t < 16; ++t) O[d][t] = 0.f;
    float m = -INFINITY, l = 0.f;
    const bf16_t* kn_src = p.Kn + ((size_t)bh * SEQ + (tid >> 4)) * 128 + (tid & 15) * 8;
    const bf16_t* kr_src = p.krope + ((size_t)b * SEQ + (tid >> 3)) * 64 + (tid & 7) * 8;
    const bf16_t* vt_src = p.Vt + ((size_t)bh * 128 + (tid >> 3)) * SEQ + (tid & 7) * 8;
    const int kn_dst = (tid >> 4) * KT_STRIDE + (tid & 15) * 16, kr_dst = (tid >> 3) * KT_STRIDE + 256 + (tid & 7) * 16, vt_dst = KT_BYTES + (tid >> 3) * VT_STRIDE + (tid & 7) * 16;
#if ATTPIPE
    u32x4 g0, g1, g2, g3, g4;
    constexpr int VT_BYTES = 128 * VT_STRIDE;
    const int vt_d2 = vt_dst - KT_BYTES;
    #define ATT_LOAD(kt) do { g0 = *(const u32x4*)(kn_src + (size_t)(kt) * 64 * 128); g1 = *(const u32x4*)(kn_src + (size_t)((kt) * 64 + 32) * 128); \
        g2 = *(const u32x4*)(kr_src + (size_t)(kt) * 64 * 64); g3 = *(const u32x4*)(vt_src + (kt) * 64); g4 = *(const u32x4*)(vt_src + (size_t)64 * SEQ + (kt) * 64); } while (0)
    #define ATT_WRITE(kb, vb) do { char* _s = shm + (kb) * KT_BYTES; char* _v = shm + 2 * KT_BYTES + (vb) * VT_BYTES; *(u32x4*)(_s + kn_dst) = g0; *(u32x4*)(_s + kn_dst + 32 * KT_STRIDE) = g1; \
        *(u32x4*)(_s + kr_dst) = g2; *(u32x4*)(_v + vt_d2) = g3; *(u32x4*)(_v + vt_d2 + 64 * VT_STRIDE) = g4; } while (0)
    char* const qlds = shm + 2 * KT_BYTES + 3 * VT_BYTES + wid * 4096 + lane * 16;
    #define ATT_QK(hs) do { _Pragma("unroll") for (int t = 0; t < 16; ++t) S[t] = 0.f; \
        _Pragma("unroll") for (int s = 0; s < 12; ++s) { const bf16x8 kf = *(const bf16x8*)(ks + (32 * (hs) + r) * KT_STRIDE + (16 * s + 8 * hh) * 2); \
            const bf16x8 qv = (QLDS == 0 || s < 8) ? qf[s] : *(const bf16x8*)(qlds + (s - 8) * 1024); \
            S = __builtin_amdgcn_mfma_f32_32x32x16_bf16(kf, qv, S, 0, 0, 0); } } while (0)
    #define ATT_PV(vb, hs) do { const char* _vs = shm + 2 * KT_BYTES + (vb) * VT_BYTES; \
        _Pragma("unroll") for (int k2 = 0; k2 < 2; ++k2) _Pragma("unroll") for (int d = 0; d < 4; ++d) { \
            const bf16x8 vf = *(const bf16x8*)(_vs + (32 * d + r) * VT_STRIDE + (16 * (2 * (hs) + k2) + 8 * hh) * 2); \
            O[d] = __builtin_amdgcn_mfma_f32_32x32x16_bf16(vf, pp[k2], O[d], 0, 0, 0); } } while (0)
    #define ATT_SOFTMAX() do { float mt = fmaxf(S[0], S[1]); \
        _Pragma("unroll") for (int t = 2; t < 16; ++t) mt = fmaxf(mt, S[t]); \
        mt = xhalf_max(mt); \
        need = !__all(mt - m <= 8.0f); \
        const float mn = need ? fmaxf(m, mt) : m; alpha = __builtin_amdgcn_exp2f(m - mn); m = mn; \
        float ls = 0.f; \
        _Pragma("unroll") for (int t = 0; t < 16; ++t) { S[t] = __builtin_amdgcn_exp2f(S[t] - m); ls += S[t]; } \
        l = l * alpha + ls; \
        _Pragma("unroll") for (int s = 0; s < 2; ++s) { u32x4 a; \
            a.x = pk2nv(S[8 * s + 0], S[8 * s + 1]); a.y = pk2nv(S[8 * s + 2], S[8 * s + 3]); a.z = pk2nv(S[8 * s + 4], S[8 * s + 5]); a.w = pk2nv(S[8 * s + 6], S[8 * s + 7]); \
            pc[s] = __builtin_bit_cast(bf16x8, a); } } while (0)
    #define ATT_RESCALE() do { if (need) { _Pragma("unroll") for (int d = 0; d < 4; ++d) _Pragma("unroll") for (int t = 0; t < 16; ++t) O[d][t] *= alpha; } pp[0] = pc[0]; pp[1] = pc[1]; } while (0)
    #define ATT_PIN() asm volatile("" : "+{v[64:79]}"(O[0]), "+{v[80:95]}"(O[1]), "+{v[96:111]}"(O[2]), "+{v[112:127]}"(O[3]))
    if (QLDS) {
#pragma unroll
    for (int s = 0; s < 4; ++s) *(bf16x8*)(qlds + s * 1024) = qf[8 + s]; }
    ATT_LOAD(0); ATT_WRITE(0, 0);
    __syncthreads();
    bf16x8 pp[2];
#pragma unroll
    for (int s = 0; s < 2; ++s)
#pragma unroll
        for (int j = 0; j < 8; ++j) pp[s][j] = 0;
    int vprev = 0, vcur = 0;
    for (int kt = 0; kt < ntile; ++kt) {
        const bool more = kt + 1 < ntile;
        const int vnext = vcur == 2 ? 0 : vcur + 1;
        if (more) ATT_LOAD(kt + 1);
        if (kt < nw) {
            const char* ks = shm + (kt & 1) * KT_BYTES;
            f32x16 S; bf16x8 pc[2]; bool need; float alpha;
            ATT_QK(0);
            ATT_SB(1);
            ATT_PV(vprev, 1);
            ATT_SOFTMAX();
            ATT_SCHED();
            ATT_RESCALE();
            ATT_SB(2);
            ATT_QK(1);
            ATT_SB(1);
            ATT_PV(vcur, 0);
            ATT_SOFTMAX();
            ATT_SCHED();
            ATT_RESCALE();
            ATT_SB(4);
            if (kt == nw - 1) ATT_PV(vcur, 1);
        }
        if (more) ATT_WRITE((kt + 1) & 1, vnext);
        vprev = vcur; vcur = vnext;
        __syncthreads();
    }
    #undef ATT_PIN
    #undef ATT_LOAD
    #undef ATT_WRITE
    #undef ATT_QK
    #undef ATT_PV
    #undef ATT_SOFTMAX
    #undef ATT_RESCALE
#else
    u32x4 g0, g1, g2, g3, g4;
    #define ATT_LOAD(kt) do { g0 = *(const u32x4*)(kn_src + (size_t)(kt) * 64 * 128); g1 = *(const u32x4*)(kn_src + (size_t)((kt) * 64 + 32) * 128); \
        g2 = *(const u32x4*)(kr_src + (size_t)(kt) * 64 * 64); g3 = *(const u32x4*)(vt_src + (kt) * 64); g4 = *(const u32x4*)(vt_src + (size_t)64 * SEQ + (kt) * 64); } while (0)
    #define ATT_WRITE(buf) do { char* _s = shm + (buf) * ATT_STAGE; *(u32x4*)(_s + kn_dst) = g0; *(u32x4*)(_s + kn_dst + 32 * KT_STRIDE) = g1; *(u32x4*)(_s + kr_dst) = g2; \
        *(u32x4*)(_s + vt_dst) = g3; *(u32x4*)(_s + vt_dst + 64 * VT_STRIDE) = g4; } while (0)
    ATT_LOAD(0); ATT_WRITE(0);
    __syncthreads();
    for (int kt = 0; kt < ntile; ++kt) {
        const bool more = kt + 1 < ntile;
        if (more) ATT_LOAD(kt + 1);
        if (kt < nw) {
            const char* ks = shm + (kt & 1) * ATT_STAGE; const char* vs = ks + KT_BYTES;
            f32x16 S0, S1;
#pragma unroll
            for (int t = 0; t < 16; ++t) { S0[t] = 0.f; S1[t] = 0.f; }
            if (AMODE != 4 && AMODE != 5) {
            __builtin_amdgcn_s_setprio(1);
#pragma unroll
            for (int s = 0; s < 12; ++s) {
                const bf16x8 k0 = *(const bf16x8*)(ks + r * KT_STRIDE + (16 * s + 8 * hh) * 2), k1 = *(const bf16x8*)(ks + (32 + r) * KT_STRIDE + (16 * s + 8 * hh) * 2);
                S0 = __builtin_amdgcn_mfma_f32_32x32x16_bf16(k0, qf[s], S0, 0, 0, 0);
                S1 = __builtin_amdgcn_mfma_f32_32x32x16_bf16(k1, qf[s], S1, 0, 0, 0);
            }
            __builtin_amdgcn_s_setprio(0);
            } else { asm volatile("" : "+v"(S0), "+v"(S1)); }
            float mt = fmaxf(S0[0], S1[0]);
#pragma unroll
            for (int t = 1; t < 16; ++t) mt = fmaxf(mt, fmaxf(S0[t], S1[t]));
            mt = xhalf_max(mt);
            if (AMODE == 2 || AMODE == 5) { m = 0.f; l = 1.f; asm volatile("" : "+v"(S0), "+v"(S1)); } else {
            if (!__all(mt - m <= 8.0f)) {
                const float mn = fmaxf(m, mt), alpha = __builtin_amdgcn_exp2f(m - mn); m = mn; l *= alpha;
#pragma unroll
                for (int d = 0; d < 4; ++d)
#pragma unroll
                    for (int t = 0; t < 16; ++t) O[d][t] *= alpha;
            }
            float ls = 0.f;
#pragma unroll
            for (int t = 0; t < 16; ++t) { S0[t] = __builtin_amdgcn_exp2f(S0[t] - m); S1[t] = __builtin_amdgcn_exp2f(S1[t] - m); ls += S0[t] + S1[t]; }
            l += ls; }
            bf16x8 pf[4];
#pragma unroll
            for (int s = 0; s < 2; ++s) {
                u32x4 a, c; a.x = pk2(S0[8 * s + 0], S0[8 * s + 1]); a.y = pk2(S0[8 * s + 2], S0[8 * s + 3]); a.z = pk2(S0[8 * s + 4], S0[8 * s + 5]); a.w = pk2(S0[8 * s + 6], S0[8 * s + 7]);
                c.x = pk2(S1[8 * s + 0], S1[8 * s + 1]); c.y = pk2(S1[8 * s + 2], S1[8 * s + 3]); c.z = pk2(S1[8 * s + 4], S1[8 * s + 5]); c.w = pk2(S1[8 * s + 6], S1[8 * s + 7]);
                pf[s] = __builtin_bit_cast(bf16x8, a); pf[2 + s] = __builtin_bit_cast(bf16x8, c);
            }
            if (AMODE == 3 || AMODE == 5) { asm volatile("" :: "v"(pf[0]), "v"(pf[1]), "v"(pf[2]), "v"(pf[3])); } else {
            __builtin_amdgcn_s_setprio(1);
#pragma unroll
            for (int k4 = 0; k4 < 4; ++k4)
#pragma unroll
                for (int d = 0; d < 4; ++d) { const bf16x8 vf = *(const bf16x8*)(vs + (32 * d + r) * VT_STRIDE + (16 * k4 + 8 * hh) * 2);
                    O[d] = __builtin_amdgcn_mfma_f32_32x32x16_bf16(vf, pf[k4], O[d], 0, 0, 0); }
            __builtin_amdgcn_s_setprio(0); }
        }
        if (more) ATT_WRITE((kt + 1) & 1);
        __syncthreads();
    }
    #undef ATT_LOAD
    #undef ATT_WRITE
#endif
    l = xhalf_sum(l);
    const float inv = 1.f / l;
#if ATT_OWIDE
    bf16_t* o = outbuf + ((size_t)b * SEQ + q0 + 32 * wid + r) * DM + 512 + h * 128 + 8 * hh;
#pragma unroll
    for (int d = 0; d < 4; ++d)
#pragma unroll
        for (int g = 0; g < 4; g += 2) {
            unsigned ax = pk2(O[d][4 * g] * inv, O[d][4 * g + 1] * inv), ay = pk2(O[d][4 * g + 2] * inv, O[d][4 * g + 3] * inv);
            unsigned bx = pk2(O[d][4 * g + 4] * inv, O[d][4 * g + 5] * inv), by = pk2(O[d][4 * g + 6] * inv, O[d][4 * g + 7] * inv);
            asm volatile("s_nop 1" : "+v"(ax), "+v"(ay), "+v"(bx), "+v"(by));
            const auto r0 = __builtin_amdgcn_permlane32_swap(ax, bx, false, false); const auto r1 = __builtin_amdgcn_permlane32_swap(ay, by, false, false);
            u32x4 w; w.x = r0[0]; w.y = r1[0]; w.z = r0[1]; w.w = r1[1];
            *(u32x4*)(o + 32 * d + 8 * g) = w; }
#else
    bf16_t* o = outbuf + ((size_t)b * SEQ + q0 + 32 * wid + r) * DM + 512 + h * 128 + 4 * hh;
#pragma unroll
    for (int d = 0; d < 4; ++d)
#pragma unroll
        for (int g = 0; g < 4; ++g) { f32x4 v; v[0] = O[d][4 * g] * inv; v[1] = O[d][4 * g + 1] * inv; v[2] = O[d][4 * g + 2] * inv; v[3] = O[d][4 * g + 3] * inv; st4(o + 32 * d + 8 * g, v); }
#endif
}


__device__ __forceinline__ void router_tile(const Params& p, char* smc, int tb) {
    int tid = threadIdx.x; asm volatile("" : "+v"(tid));
    const int wid = __builtin_amdgcn_readfirstlane(tid >> 6), lane = tid & 63, fr = lane & 15, fq = lane >> 4;
    int* lcnt = (int*)(smc + LDS_LCNT);
    { u32x4 wreg[18];
#pragma unroll
      for (int k = 0; k < 18; ++k) { const int i = tid + k * NTHR; wreg[k] = *(const u32x4*)(p.WrT + (size_t)i * 8); }
#pragma unroll
      for (int k = 0; k < 18; ++k) { const int i = tid + k * NTHR, img = i / (36 * 128), rem = i - img * 36 * 128, o = rem >> 7, ch = rem & 127;
          *(u32x4*)(smc + LDS_RW + img * 73728 + o * 2048 + ((ch ^ (o & 15)) << 4)) = wreg[k]; } }
    if (tid < NEXP) lcnt[tid] = 0;
    __syncthreads();
    const int tok = tb * 128 + wid * 16 + fr;
    bf16_t* hr = p.hbuf + (size_t)tok * DM + 8 * fq;
    float s = 0.f, s2 = 0.f;
#if YSTAT
    { const f32x4 a = *(const f32x4*)(p.ystat + (size_t)tok * 32 + 8 * fq), b = *(const f32x4*)(p.ystat + (size_t)tok * 32 + 8 * fq + 4); s = (a[0] + a[2]) + (b[0] + b[2]); s2 = (a[1] + a[3]) + (b[1] + b[3]); }
    s = xrow16_sum(s); s2 = xrow16_sum(s2);
#else
#pragma unroll 8
    for (int ks = 0; ks < 32; ++ks) { const u32x4 y = *(const u32x4*)(hr + 32 * ks);
        const float a0 = bflo(y.x), a1 = bfhi(y.x), a2 = bflo(y.y), a3 = bfhi(y.y), a4 = bflo(y.z), a5 = bfhi(y.z), a6 = bflo(y.w), a7 = bfhi(y.w);
        s += ((a0 + a1) + (a2 + a3)) + ((a4 + a5) + (a6 + a7)); s2 += ((a0 * a0 + a1 * a1) + (a2 * a2 + a3 * a3)) + ((a4 * a4 + a5 * a5) + (a6 * a6 + a7 * a7)); }
    s = xrow16_sum(s); s2 = xrow16_sum(s2);
#endif
    const float mean = s * (1.f / 1024.f), var = fmaxf(s2 * (1.f / 1024.f) - mean * mean, 0.f), rstd = 1.f / sqrtf(var + 1e-5f);
    if (LN1FOLD && fq == 0) ((float2*)p.lnf)[tok] = make_float2(rstd, rstd * mean);
    const int o0 = fr < 4 ? fr : 3, o1 = 4 + fr, o2 = 20 + fr;
    const int w0 = o0 * 2048, w1 = o1 * 2048, w2 = o2 * 2048, x0 = o0 & 15, x1 = o1 & 15, x2 = o2 & 15;
    f32x4 acc0 = {0.f, 0.f, 0.f, 0.f}, acc1 = acc0, acc2 = acc0;
#if LN1FOLD
#pragma unroll 8
    for (int ks = 0; ks < 32; ++ks) {
        const u32x4 yy = *(const u32x4*)(hr + 32 * ks);
        const bf16x8 hh = __builtin_bit_cast(bf16x8, yy);
        const int ch = 4 * ks + fq;
        const bf16x8 a0h = *(const bf16x8*)(smc + LDS_RW + w0 + ((ch ^ x0) << 4)), a0l = *(const bf16x8*)(smc + LDS_RW + 73728 + w0 + ((ch ^ x0) << 4));
        const bf16x8 a1h = *(const bf16x8*)(smc + LDS_RW + w1 + ((ch ^ x1) << 4)), a1l = *(const bf16x8*)(smc + LDS_RW + 73728 + w1 + ((ch ^ x1) << 4));
        const bf16x8 a2h = *(const bf16x8*)(smc + LDS_RW + w2 + ((ch ^ x2) << 4)), a2l = *(const bf16x8*)(smc + LDS_RW + 73728 + w2 + ((ch ^ x2) << 4));
        acc0 = __builtin_amdgcn_mfma_f32_16x16x32_bf16(a0h, hh, acc0, 0, 0, 0); acc0 = __builtin_amdgcn_mfma_f32_16x16x32_bf16(a0l, hh, acc0, 0, 0, 0);
        acc1 = __builtin_amdgcn_mfma_f32_16x16x32_bf16(a1h, hh, acc1, 0, 0, 0); acc1 = __builtin_amdgcn_mfma_f32_16x16x32_bf16(a1l, hh, acc1, 0, 0, 0);
        acc2 = __builtin_amdgcn_mfma_f32_16x16x32_bf16(a2h, hh, acc2, 0, 0, 0); acc2 = __builtin_amdgcn_mfma_f32_16x16x32_bf16(a2l, hh, acc2, 0, 0, 0);
    }
#else
    const float* lg_ = p.ln1_g + 8 * fq; const float* lb_ = p.ln1_b + 8 * fq;
#pragma unroll 8
    for (int ks = 0; ks < 32; ++ks) {
        const f32x4 g0 = *(const f32x4*)(lg_ + 32 * ks), g1 = *(const f32x4*)(lg_ + 32 * ks + 4), b0 = *(const f32x4*)(lb_ + 32 * ks), b1 = *(const f32x4*)(lb_ + 32 * ks + 4);
        const u32x4 yy = *(const u32x4*)(hr + 32 * ks);
        float h[8];
        h[0] = (bflo(yy.x) - mean) * rstd * g0[0] + b0[0]; h[1] = (bfhi(yy.x) - mean) * rstd * g0[1] + b0[1]; h[2] = (bflo(yy.y) - mean) * rstd * g0[2] + b0[2]; h[3] = (bfhi(yy.y) - mean) * rstd * g0[3] + b0[3];
        h[4] = (bflo(yy.z) - mean) * rstd * g1[0] + b1[0]; h[5] = (bfhi(yy.z) - mean) * rstd * g1[1] + b1[1]; h[6] = (bflo(yy.w) - mean) * rstd * g1[2] + b1[2]; h[7] = (bfhi(yy.w) - mean) * rstd * g1[3] + b1[3];
        u32x4 hi, lo; hi.x = pk2(h[0], h[1]); hi.y = pk2(h[2], h[3]); hi.z = pk2(h[4], h[5]); hi.w = pk2(h[6], h[7]);
        if (!LN1FOLD) *(u32x4*)(hr + 32 * ks) = hi;
        lo.x = pk2(h[0] - bflo(hi.x), h[1] - bfhi(hi.x)); lo.y = pk2(h[2] - bflo(hi.y), h[3] - bfhi(hi.y)); lo.z = pk2(h[4] - bflo(hi.z), h[5] - bfhi(hi.z)); lo.w = pk2(h[6] - bflo(hi.w), h[7] - bfhi(hi.w));
        const bf16x8 hh = __builtin_bit_cast(bf16x8, hi), hl = __builtin_bit_cast(bf16x8, lo);
        const int ch = 4 * ks + fq;
        const bf16x8 a0h = *(const bf16x8*)(smc + LDS_RW + w0 + ((ch ^ x0) << 4)), a0l = *(const bf16x8*)(smc + LDS_RW + 73728 + w0 + ((ch ^ x0) << 4));
        const bf16x8 a1h = *(const bf16x8*)(smc + LDS_RW + w1 + ((ch ^ x1) << 4)), a1l = *(const bf16x8*)(smc + LDS_RW + 73728 + w1 + ((ch ^ x1) << 4));
        const bf16x8 a2h = *(const bf16x8*)(smc + LDS_RW + w2 + ((ch ^ x2) << 4)), a2l = *(const bf16x8*)(smc + LDS_RW + 73728 + w2 + ((ch ^ x2) << 4));
        acc0 = __builtin_amdgcn_mfma_f32_16x16x32_bf16(a0h, hh, acc0, 0, 0, 0); acc0 = __builtin_amdgcn_mfma_f32_16x16x32_bf16(a0h, hl, acc0, 0, 0, 0); acc0 = __builtin_amdgcn_mfma_f32_16x16x32_bf16(a0l, hh, acc0, 0, 0, 0);
        acc1 = __builtin_amdgcn_mfma_f32_16x16x32_bf16(a1h, hh, acc1, 0, 0, 0); acc1 = __builtin_amdgcn_mfma_f32_16x16x32_bf16(a1h, hl, acc1, 0, 0, 0); acc1 = __builtin_amdgcn_mfma_f32_16x16x32_bf16(a1l, hh, acc1, 0, 0, 0);
        acc2 = __builtin_amdgcn_mfma_f32_16x16x32_bf16(a2h, hh, acc2, 0, 0, 0); acc2 = __builtin_amdgcn_mfma_f32_16x16x32_bf16(a2h, hl, acc2, 0, 0, 0); acc2 = __builtin_amdgcn_mfma_f32_16x16x32_bf16(a2l, hh, acc2, 0, 0, 0);
    }
#endif
    __syncthreads();
    float* sc = (float*)(smc + LDS_RW) + wid * (16 * 40) + fr * 40;
    if (fq == 0) { sc[0] = acc0[0]; sc[1] = acc0[1]; sc[2] = acc0[2]; sc[3] = acc0[3]; }
    *(f32x4*)(sc + 4 + 4 * fq) = acc1; *(f32x4*)(sc + 20 + 4 * fq) = acc2;
    __syncthreads();
    if (lane < 16) {
        const float* lr = (const float*)(smc + LDS_RW) + wid * (16 * 40) + lane * 40;
        float lg[36];
#pragma unroll
        for (int o = 0; o < 36; o += 4) { const f32x4 v = *(const f32x4*)(lr + o); lg[o] = v[0]; lg[o + 1] = v[1]; lg[o + 2] = v[2]; lg[o + 3] = v[3]; }
#if LN1FOLD
        { const float rs_ = rstd, rm_ = rstd * mean; const float* cr = p.lnf + LNF_CR;
#pragma unroll
          for (int o = 0; o < 36; ++o) lg[o] = lg[o] * rs_ - rm_ * cr[o] + cr[36 + o]; }
#endif
#pragma unroll
        for (int o = 0; o < 4; ++o) lg[o] += p.b_rg[o];
#pragma unroll
        for (int o = 0; o < 32; ++o) lg[4 + o] += p.b_re[o];
        int g = 0; float gm = lg[0];
#pragma unroll
        for (int i = 1; i < 4; ++i) if (lg[i] > gm) { gm = lg[i]; g = i; }
        float se = 0.f;
#pragma unroll
        for (int i = 0; i < 4; ++i) se += expf(lg[i] - gm);
        const float pg = 1.f / se;
        float ev[8];
#pragma unroll
        for (int e = 0; e < 8; ++e) ev[e] = g == 0 ? lg[4 + e] : g == 1 ? lg[12 + e] : g == 2 ? lg[20 + e] : lg[28 + e];
        int i1 = 0; float v1 = ev[0];
#pragma unroll
        for (int e = 1; e < 8; ++e) if (ev[e] > v1) { v1 = ev[e]; i1 = e; }
        int i2 = -1; float v2 = -3.0e38f;
#pragma unroll
        for (int e = 0; e < 8; ++e) if (e != i1 && ev[e] > v2) { v2 = ev[e]; i2 = e; }
        const float d = expf(v2 - v1), g1 = pg / (1.f + d), g2 = pg * d / (1.f + d);
        const int t = tb * 128 + wid * 16 + lane, e1 = g * 8 + i1, e2 = g * 8 + i2;
        const int s1 = atomicAdd(lcnt + e1, 1), s2_ = atomicAdd(lcnt + e2, 1);
        p.listb[((size_t)tb * NEXP + e1) * 256 + s1] = 2 * t; p.listb[((size_t)tb * NEXP + e2) * 256 + s2_] = 2 * t + 1;
        p.gates[2 * t] = g1; p.gates[2 * t + 1] = g2;
    }
    __syncthreads();
    if (tid < NEXP) p.cntb[tb * NEXP + tid] = lcnt[tid];
    __syncthreads();
}
__device__ __forceinline__ void moe_tables(const Params& p, char* smc) {
    int tid = threadIdx.x; asm volatile("" : "+v"(tid));
    const int e = tid & 31, seg = tid >> 5;
    unsigned short* pre = (unsigned short*)(smc + LDS_PRE); int* tot = (int*)(smc + LDS_TOT); int* segtot = (int*)(smc + LDS_SEG);
    int c[16]; int run = 0;
#pragma unroll
    for (int i = 0; i < 16; ++i) c[i] = p.cntb[(16 * seg + i) * NEXP + e];
#pragma unroll
    for (int i = 0; i < 16; ++i) { const int v = c[i]; c[i] = run; run += v; }
    segtot[seg * 32 + e] = run;
    __syncthreads();
    int base = 0, all = 0;
#pragma unroll
    for (int s = 0; s < 16; ++s) { const int v = segtot[s * 32 + e]; base += (s < seg) ? v : 0; all += v; }
#pragma unroll
    for (int i = 0; i < 16; ++i) pre[e * 256 + 16 * seg + i] = (unsigned short)(base + c[i]);
    if (seg == 0) tot[e] = all;
    __syncthreads();
    if (tid < 33) { int acc = 0; for (int i = 0; i < tid; ++i) acc += (tot[i] + 255) >> 8; segtot[tid] = acc; }
    __syncthreads();
}

template <class PH> __device__ __forceinline__ void gemm_phase(const PH& ph, LAS unsigned char* shm, int vcu) {
#if defined(NOSTREAM)
    for (int u = vcu;; u += gridDim.x) { Unit<typename PH::EP> un; if (u >= PH::NU || !ph.unit(u, un)) break; gemm256(un, shm); }
#else
    gemm_stream(ph, shm, vcu, gridDim.x);
#endif
}

struct PhKVc { Params p; const float* tab; int pm; typedef EpiKV EP; static constexpr int NU = 4;
    __device__ __forceinline__ bool unit(int pn, Unit<EP>& o) const {
        o.am = AMap{p.zkv + (size_t)pm * 256 * 256, 256, nullptr, 256}; o.bt = p.WukvT + (size_t)pn * 256 * 256; o.K = 256;
        o.ep = EpiKV{p.Kn, p.Vt, tab, pm * 256, pm * 256, pn * 256}; return true; } };
struct PhZ2 { Params p; typedef EpiZ EP; static constexpr int NU = 128 * 2;
    __device__ __forceinline__ bool unit(int v, Unit<EP>& o) const { const int pm = v >> 1, pn = 5 + (v & 1);
        o.am = AMap{p.hbuf + (size_t)pm * 256 * DM, DM, nullptr, 256}; o.bt = p.WinT + (size_t)pn * 256 * DM; o.K = DM;
        o.ep = EpiZ{p.zu, p.zv, p.zq, p.zkv, p.krope, p.rope, pm * 256, pn * 256}; return true; } };
struct PhZ3x { Params p; int xq; typedef EpiZ EP; static constexpr int NU = 48;
    __device__ __forceinline__ bool unit(int v, Unit<EP>& o) const { const int pm = 16 * xq + v / 3, pn = 4 + v % 3;
        o.am = AMap{p.hbuf + (size_t)pm * 256 * DM, DM, nullptr, 256}; o.bt = p.WinT + (size_t)pn * 256 * DM; o.K = DM;
        o.ep = EpiZ{p.zu, p.zv, p.zq, p.zkv, p.krope, p.rope, pm * 256, pn * 256}; return true; } };
struct PhZ3 { Params p; typedef EpiZ EP; static constexpr int NU = 128 * 3;
    __device__ __forceinline__ bool unit(int v, Unit<EP>& o) const { const int pm = v / 3, pn = 4 + (v - pm * 3);
        o.am = AMap{p.hbuf + (size_t)pm * 256 * DM, DM, nullptr, 256}; o.bt = p.WinT + (size_t)pn * 256 * DM; o.K = DM;
        o.ep = EpiZ{p.zu, p.zv, p.zq, p.zkv, p.krope, p.rope, pm * 256, pn * 256}; return true; } };
struct PhQs { Params p; const float* tab; int u0, ustride; typedef EpiQ EP; static constexpr int NU = 128 * 3;
    __device__ __forceinline__ bool unit(int u, Unit<EP>& o) const { const int pm = u / 3, pn = u - pm * 3, slot = (u - u0) / ustride;
        o.am = AMap{p.zq + (size_t)pm * 256 * 384, 384, nullptr, 256}; o.bt = p.WuqT + (size_t)pn * 256 * 384; o.K = 384;
        o.ep = EpiQ{p.Q, tab + slot * 256, pm * 256, pm * 256, pn * 256}; return true; } };
struct PhKVs { Params p; const float* tab; int u0, ustride; typedef EpiKV EP; static constexpr int NU = 128 * 3 + 128 * 4;
    __device__ __forceinline__ bool unit(int u, Unit<EP>& o) const { const int v = u - 384, pm = v >> 2, pn = v & 3, slot = (u - u0) / ustride;
        o.am = AMap{p.zkv + (size_t)pm * 256 * 256, 256, nullptr, 256}; o.bt = p.WukvT + (size_t)pn * 256 * 256; o.K = 256;
        o.ep = EpiKV{p.Kn, p.Vt, tab + slot * 256, pm * 256, pm * 256, pn * 256}; return true; } };
struct PhQb { Params p; const float* tab; int ubeg, uend; typedef EpiQ EP; static constexpr int NU = 128 * 3;
    __device__ __forceinline__ bool unit(int u, Unit<EP>& o) const { if (u >= uend) return false; const int pm = u / 3, pn = u - pm * 3;
        o.am = AMap{p.zq + (size_t)pm * 256 * 384, 384, nullptr, 256}; o.bt = p.WuqT + (size_t)pn * 256 * 384; o.K = 384;
        o.ep = EpiQ{p.Q, tab, pm * 256, pm * 256, pn * 256}; return true; } };
struct PhKVb { Params p; const float* tab; int kbeg, kend, slot0; int sstep = 1; typedef EpiKV EP; static constexpr int NU = 128 * 4;
    __device__ __forceinline__ bool unit(int k, Unit<EP>& o) const { if (k >= kend) return false; const int pm = k >> 2, pn = k & 3, slot = slot0 + (k - kbeg) * sstep;
        o.am = AMap{p.zkv + (size_t)pm * 256 * 256, 256, nullptr, 256}; o.bt = p.WukvT + (size_t)pn * 256 * 256; o.K = 256;
        o.ep = EpiKV{p.Kn, p.Vt, tab + slot * 256, pm * 256, pm * 256, pn * 256}; return true; } };
__device__ __forceinline__ Params ldp();
__device__ __forceinline__ bool moe_unit_t(const int* tot, int u, int ncol, int& e, int& rt, int& ct, int& padrow) {
    const int* tpre = tot + 64; const int q = (ncol == 4) ? (u >> 2) : (u >> 1);
    if (q >= __builtin_amdgcn_readfirstlane(tpre[32])) return false;
    int lo = 0;
#pragma unroll
    for (int s = 16; s >= 1; s >>= 1) { const int v = __builtin_amdgcn_readfirstlane(tpre[lo + s]); lo = (v <= q) ? lo + s : lo; }
    const int facc = __builtin_amdgcn_readfirstlane(tpre[lo]);
    e = lo; rt = q - facc; ct = u - q * ncol; padrow = (facc + rt) * 256; return true;
}
struct PhHs { Params p; const int* tot; const int* aid_tab; int u0, ustride; typedef EpiH EP; static constexpr int NU = 288 * 2;
    __device__ __forceinline__ bool unit(int u, Unit<EP>& o) const { int e, rt, ct, pr; if (!moe_unit_t(tot, u, 2, e, rt, ct, pr)) return false;
        const int nv = __builtin_amdgcn_readfirstlane(min(256, tot[e] - rt * 256)), slot = (u - u0) / ustride;
        o.am = AMap{p.hbuf, DM, aid_tab + slot * 256, nv}; o.bt = p.WguT + ((size_t)e * 512 + ct * 256) * DM; o.K = DM;
        o.ep = EpiH{p.H, pr, ct * 256, MERGE67 != 0, aid_tab + slot * 256, nv, (const float2*)p.lnf, p.lnf + LNF_CFIN + e * 1024 + ct * 256}; return true; }
    __device__ __forceinline__ void done(const Unit<EP>& cu, int wr) const {
        asm volatile("s_waitcnt vmcnt(0)" ::: "memory");
        if (wr == 0) __builtin_amdgcn_s_barrier();
        __builtin_amdgcn_s_barrier();
        if (threadIdx.x == 0) __hip_atomic_fetch_add(hready + (cu.ep.hrow0 >> 8), 1u, __ATOMIC_RELAXED, __HIP_MEMORY_SCOPE_AGENT);
        if (wr == 1) __builtin_amdgcn_s_barrier();
    }
    unsigned* hready; };
struct PhCs { Params p; const int* tot; unsigned* hready; int u0; unsigned* queue; volatile int* slot; typedef EpiC EP; static constexpr int NU = 288 * 4;
    __device__ __forceinline__ int take(bool stagger, int wr) const {
        if (stagger && wr == 0) __builtin_amdgcn_s_barrier();
        if (threadIdx.x == 0) slot[0] = (int)__hip_atomic_fetch_add(queue, 1u, __ATOMIC_RELAXED, __HIP_MEMORY_SCOPE_AGENT);
        __builtin_amdgcn_s_barrier();
        const int t = __builtin_amdgcn_readfirstlane(slot[0]);
        __builtin_amdgcn_s_barrier();
        if (stagger && wr == 1) __builtin_amdgcn_s_barrier();
        return t;
    }
#if PF_TICKET
    mutable int pf_valid = 0, pf_tick = -1;
    __device__ __forceinline__ void prefetch() const {
        if (threadIdx.x == 0) {
            extern __shared__ __attribute__((aligned(16))) unsigned char lds_pf_[]; char* sm = (char*)lds_pf_;
            const Params pp = ldp();
            const int t = (int)__hip_atomic_fetch_add(pp.bar + 3648, 1u, __ATOMIC_RELAXED, __HIP_MEMORY_SCOPE_AGENT); ((volatile int*)(sm + LDS_AID))[1] = t;
            int e, rt, ct, pr;
            if (t < NU && moe_unit_t((const int*)(sm + LDS_TOT), t, 4, e, rt, ct, pr)) { unsigned sp = 0; unsigned* w = pp.bar + 3712 + (pr >> 8);
                while (__hip_atomic_load(w, __ATOMIC_RELAXED, __HIP_MEMORY_SCOPE_AGENT) < 2u) { __builtin_amdgcn_s_sleep(2); if (++sp > (1u << 20)) break; }
                __builtin_amdgcn_fence(__ATOMIC_ACQUIRE, "agent");
                asm volatile("s_waitcnt vmcnt(0)" ::: "memory"); } }
        pf_valid = 1;
    }
    __device__ __forceinline__ int next(int wr) const {
        if (!pf_valid) return take(true, wr);
        if (wr == 0) __builtin_amdgcn_s_barrier();
        __builtin_amdgcn_s_barrier();
        const int t = __builtin_amdgcn_readfirstlane(slot[1]);
        __builtin_amdgcn_s_barrier();
        if (wr == 1) __builtin_amdgcn_s_barrier();
        pf_tick = t; return t;
    }
#else
    static constexpr int pf_tick = -2;
    __device__ __forceinline__ int next(int wr) const { return take(true, wr); }
#endif
    __device__ __forceinline__ bool unit(int u, Unit<EP>& o) const { int e, rt, ct, pr; if (!moe_unit_t(tot, u, 4, e, rt, ct, pr)) return false;
        const int wr = __builtin_amdgcn_readfirstlane((int)threadIdx.x >> 8);
        if (PF_TICKET && u == pf_tick) {
            const int nv = __builtin_amdgcn_readfirstlane(min(256, tot[e] - rt * 256));
            o.am = AMap{p.H + (size_t)pr * FF, FF, nullptr, 256}; o.bt = p.WdT + ((size_t)e * DM + ct * 256) * FF; o.K = FF;
            o.ep = EpiC{p.contrib, p.list + (size_t)e * LIST_CAP + rt * 256, p.gates, nv, ct * 256}; return true; }
        if (u != u0 && wr == 0) __builtin_amdgcn_s_barrier();
        if (threadIdx.x == 0) { unsigned sp = 0; unsigned* w = hready + (pr >> 8);
            while (__hip_atomic_load(w, __ATOMIC_RELAXED, __HIP_MEMORY_SCOPE_AGENT) < 2u) { __builtin_amdgcn_s_sleep(2); if (++sp > (1u << 20)) break; }
            __builtin_amdgcn_fence(__ATOMIC_ACQUIRE, "agent");
            asm volatile("s_waitcnt vmcnt(0)" ::: "memory"); }
        __builtin_amdgcn_s_barrier();
        if (u != u0 && wr == 1) __builtin_amdgcn_s_barrier();
        const int nv = __builtin_amdgcn_readfirstlane(min(256, tot[e] - rt * 256));
        o.am = AMap{p.H + (size_t)pr * FF, FF, nullptr, 256}; o.bt = p.WdT + ((size_t)e * DM + ct * 256) * FF; o.K = FF;
        o.ep = EpiC{p.contrib, p.list + (size_t)e * LIST_CAP + rt * 256, p.gates, nv, ct * 256}; return true; } };


struct PhZj { Params p; int u0; unsigned* cnt; typedef EpiZ EP; static constexpr int NU = 128 * 7;
    __device__ __forceinline__ void chunk(int u) const {
        int tid = threadIdx.x; asm volatile("" : "+v"(tid));
        const int wid = __builtin_amdgcn_readfirstlane(tid >> 6), lane = tid & 63;
        const int pm = u / 7, pn = u - pm * 7, r0 = pm * 256 + pn * 36 + (pn < 4 ? pn : 4), n = pn < 4 ? 37 : 36;
        ln0_row4<true>(p.x + (size_t)(r0 + wid) * DM, (size_t)8 * DM, p.ln0_g, p.ln0_b, p.hbuf + (size_t)(r0 + wid) * DM, lane);
        if (32 + wid < n) ln0_row1_wt(p.x + (size_t)(r0 + 32 + wid) * DM, p.ln0_g, p.ln0_b, p.hbuf + (size_t)(r0 + 32 + wid) * DM, lane);
        asm volatile("s_waitcnt vmcnt(0)" ::: "memory");
        __syncthreads();
        if (tid == 0) {
            __hip_atomic_fetch_add(cnt + pm, 1u, __ATOMIC_RELAXED, __HIP_MEMORY_SCOPE_AGENT);
            unsigned sp = 0;
            while (__hip_atomic_load(cnt + pm, __ATOMIC_RELAXED, __HIP_MEMORY_SCOPE_AGENT) < 7u) { __builtin_amdgcn_s_sleep(2); if (++sp > (1u << 18)) break; }
            __builtin_amdgcn_fence(__ATOMIC_ACQUIRE, "agent");
            asm volatile("s_waitcnt vmcnt(0)" ::: "memory");
        }
        __syncthreads();
    }
    __device__ __forceinline__ bool unit(int u, Unit<EP>& o) const {
        if (u != u0) {
            const int wr = __builtin_amdgcn_readfirstlane((int)threadIdx.x >> 8);
            if (wr == 0) __builtin_amdgcn_s_barrier();
            chunk(u);
            if (wr == 1) __builtin_amdgcn_s_barrier();
        }
        const int pm = u / 7, pn = u - pm * 7;
        o.am = AMap{p.hbuf + (size_t)pm * 256 * DM, DM, nullptr, 256}; o.bt = p.WinT + (size_t)pn * 256 * DM; o.K = DM;
        o.ep = EpiZ{p.zu, p.zv, p.zq, p.zkv, p.krope, p.rope, pm * 256, pn * 256}; return true; } };

typedef const __attribute__((address_space(4))) Params* KParams;
#if SELFRESET
__device__ unsigned g_sync_words[4096];
#endif
__device__ __forceinline__ Params ldp() {
#if defined(__HIP_DEVICE_COMPILE__)
    KParams q = (KParams)__builtin_amdgcn_kernarg_segment_ptr(); asm volatile("" : "+s"(q));
#if SELFRESET
    Params r = *q; r.bar = g_sync_words; return r;
#else
    return *q;
#endif
#else
    return Params{};
#endif
}
template <int LO, int HI>
__global__ __launch_bounds__(512, 2) void mega(Params p_arg_unused) {
    extern __shared__ __attribute__((aligned(16))) unsigned char lds_raw[];
    LAS unsigned char* shm = (LAS unsigned char*)lds_raw;
    char* smc = (char*)lds_raw;
    const int nblk = gridDim.x;
    const int vcu = (nblk % 8 == 0) ? (int)(blockIdx.x % 8) * (nblk / 8) + (int)(blockIdx.x / 8) : (int)blockIdx.x;
    #define PHASE_IDS int tid = threadIdx.x; asm volatile("" : "+v"(tid)); const int wid = __builtin_amdgcn_readfirstlane(tid >> 6), lane = tid & 63; (void)wid; (void)lane
    XcdBarrier xb;
    if (LO != HI) {
        if (threadIdx.x == 0) { ((volatile LAS unsigned*)(smc + LDS_XB))[0] = 0u; ((volatile LAS unsigned*)(smc + LDS_XB))[1] = 0u; }
        __syncthreads();
        { const Params p = ldp(); xb = xcd_barrier_post(p.bar, (volatile LAS unsigned*)(smc + LDS_XB)); }
    }
#ifndef TIMEPH
#define TIMEPH -1
#endif
#ifndef P1PROBE
#define P1PROBE 0
#endif
#ifndef TIMEEND
#define TIMEEND (TIMEPH + 1)
#endif
    unsigned long long ts0_ = 0, ts1_ = 0, pacc_ = 0; unsigned pcnt_ = 0; (void)pacc_; (void)pcnt_;
    #define TSTAMP(k) do { if (TIMEPH >= 0) { if ((k) == TIMEPH) ts0_ = __builtin_amdgcn_s_memrealtime(); if ((k) == TIMEEND) ts1_ = __builtin_amdgcn_s_memrealtime(); } } while (0)
    #define SEAM(ph) do { if (LO <= (ph) && HI > (ph)) xcd_barrier(xb); TSTAMP((ph) + 1); } while (0)
    TSTAMP(0);
#ifndef REPMASK
#define REPMASK 0
#endif
    #define NREP(k) ((((REPMASK) >> (k)) & 1) ? 2 : 1)
    #define REPEAT(k) for (int rep_ = 0; rep_ < NREP(k); ++rep_, (rep_ < NREP(k) ? xcd_barrier(xb) : (void)0))
    if (LO <= 0 && HI >= 0) REPEAT(0) {
        const Params p = ldp(); PHASE_IDS;
        { float* scr = (float*)(smc + wid * (64 * 33 * 4)); const int gw = blockIdx.x * 8 + wid, ngw = nblk * 8;
#ifndef P0REP
#define P0REP 0
#endif
          for (int rep = 0; rep < ((P0REP & 1) ? 2 : 1); ++rep)
          for (int it = gw; it < I_EARLY; it += ngw) prep_witem(p, it, scr, lane);
#if !JIT_LN0
#if LN0_CONTIG
          for (int t = gw; t < T_TOK / 4; t += ngw) ln0_row4<false>(p.x + (size_t)(4 * t) * DM, (size_t)DM, p.ln0_g, p.ln0_b, p.hbuf + (size_t)(4 * t) * DM, lane);
#else
          for (int t = gw; t < T_TOK / 4; t += ngw) ln0_row4<false>(p.x + (size_t)t * DM, (size_t)(T_TOK / 4) * DM, p.ln0_g, p.ln0_b, p.hbuf + (size_t)t * DM, lane);
#endif
#endif
          }
        for (int rep = 0; rep < ((P0REP & 4) ? 2 : 1); ++rep)
        { const int i0 = blockIdx.x * NTHR + tid; const float inv = powf(10000.f, -(float)(2 * (i0 & 31)) / 64.f);
          if (nblk * NTHR * 8 == T_TOK * 32) { int ps[8];
#pragma unroll
              for (int k = 0; k < 8; ++k) ps[k] = p.pos[(i0 + k * nblk * NTHR) >> 5];
#pragma unroll
              for (int k = 0; k < 8; ++k) { const float ang = (float)ps[k] * inv; p.rope[i0 + k * nblk * NTHR] = make_float2(cosf(ang), sinf(ang)); } }
          else for (int i = i0; i < T_TOK * 32; i += nblk * NTHR) { const float ang = (float)p.pos[i >> 5] * inv; p.rope[i] = make_float2(cosf(ang), sinf(ang)); } }
        for (int i = blockIdx.x * NTHR + tid; i < 4 * 128 * 128; i += nblk * NTHR) { const int ii = (i >> 7) & 127, jj = i & 127; p.WspT[i] = ((jj >> 6) <= (ii >> 6)) ? f2bf(p.w_sp[i]) : (bf16_t)0; }
#if LN1FOLD
        for (int o = blockIdx.x; o < 36; o += nblk) { float s1 = 0.f, s2 = 0.f;
            for (int k = tid; k < 1024; k += NTHR) { const float w0 = o < 4 ? p.w_rg[k * 4 + o] : p.w_re[k * 32 + (o - 4)]; const float w = w0 * p.ln1_g[k];
                const bf16_t hi = f2bf(w); const bf16_t lo = f2bf(w - bf2f(hi)); p.WrT[o * 1024 + k] = hi; p.WrT[36864 + o * 1024 + k] = lo; s1 += bf2f(hi) + bf2f(lo); s2 += w0 * p.ln1_b[k]; }
            s1 = wave_sum(s1); s2 = wave_sum(s2);
            float* red = (float*)(smc + 64 * 33 * 4 * 8);
            __syncthreads();
            if (lane == 0) { red[wid] = s1; red[8 + wid] = s2; }
            __syncthreads();
            if (tid == 0) { float a = 0.f, b = 0.f; for (int w8 = 0; w8 < 8; ++w8) { a += red[w8]; b += red[8 + w8]; } p.lnf[LNF_CR + o] = a; p.lnf[LNF_CR + 36 + o] = b; }
            __syncthreads(); }
#else
        for (int i = blockIdx.x * NTHR + tid; i < 36 * 1024; i += nblk * NTHR) { const int o = i >> 10, k = i & 1023; const float w = o < 4 ? p.w_rg[k * 4 + o] : p.w_re[k * 32 + (o - 4)];
            const bf16_t hi = f2bf(w); p.WrT[i] = hi; p.WrT[36864 + i] = f2bf(w - bf2f(hi)); }
#endif
    }
    SEAM(0);
    if (LO <= 1 && HI >= 1) REPEAT(1) {
#if GMLP_FUSED && KVCHAIN
        { { const Params p = ldp(); gemm_stream(PhZ2{p}, shm, vcu, nblk); }
          for (;;) {
              int t;
              { const Params p = ldp(); PHASE_IDS; volatile int* slot = (volatile int*)(smc + LDS_AID);
                if (tid == 0) slot[0] = (int)__hip_atomic_fetch_add(p.bar + 3584, 1u, __ATOMIC_RELAXED, __HIP_MEMORY_SCOPE_AGENT);
                __syncthreads();
                t = __builtin_amdgcn_readfirstlane(slot[0]);
                __syncthreads(); }
              if (t >= 128 + 512 + 128) break;
              if (t < 128) { const Params p = ldp(); const int pm = t; float* tab = (float*)(smc + LDS_PRE);
                  Unit<EpiZ> un; un.am = AMap{p.hbuf + (size_t)pm * 256 * DM, DM, nullptr, 256}; un.bt = p.WinT + (size_t)4 * 256 * DM; un.K = DM; un.ep = EpiZ{p.zu, p.zv, p.zq, p.zkv, p.krope, p.rope, pm * 256, 4 * 256};
                  const KvArgs kv{p.zkv, tab, pm * 256};
                  gemm256<EpiZ, 2>(un, shm, nullptr, &kv);
                  gemm_stream(PhKVc{p, tab, pm}, shm, 0, 1);
              } else if (t < 128 + 512) { const Params p = ldp(); const int w = t - 128, pm = w >> 2, h = w & 3;
                  Unit<EpiZ> un; un.am = AMap{p.hbuf + (size_t)pm * 256 * DM, DM, nullptr, 256}; un.bt = p.WinT + (size_t)h * 256 * DM; un.K = DM; un.ep = EpiZ{p.zu, p.zv, p.zq, p.zkv, p.krope, p.rope, pm * 256, h * 256};
                  const GmArgs gm{p.gm_g, p.gm_b, p.w_sp, p.b_sp, p.mix, pm * 256, h, p.WspT};
                  gemm256<EpiZ, 1>(un, shm, &gm);
              } else { const Params p = ldp(); PHASE_IDS; const int ch = t - 640; float* scr = (float*)(smc + wid * (64 * 33 * 4));
                  for (int k = wid; k < 96; k += 8) prep_witem(p, I_EARLY + ch * 96 + k, scr, lane);
                  __syncthreads(); }
          } }
#elif GMLP_FUSED && P1QUEUE
        { const bool xl = (nblk == 256); const int xq = vcu >> 5;
          { const unsigned long long q0_ = (P1PROBE == 3) ? __builtin_amdgcn_s_memrealtime() : 0ull;
            { const Params p = ldp(); if (xl) gemm_stream(PhZ3x{p, xq}, shm, vcu & 31, 32); else gemm_stream(PhZ3{p}, shm, vcu, nblk); }
            if (P1PROBE == 3) { pacc_ += __builtin_amdgcn_s_memrealtime() - q0_; pcnt_ = 2; } }
          constexpr int CHI = CHUNK_ITEMS;
          const int nfu = xl ? 64 : 512, nch = (xl ? 16 : 128) * (96 / CHI);
          for (;;) {
              int t;
              { const Params p = ldp(); PHASE_IDS; volatile int* slot = (volatile int*)(smc + LDS_AID);
                if (tid == 0) slot[0] = (int)__hip_atomic_fetch_add(p.bar + 3584 + (xl ? 8 * xq : 0), 1u, __ATOMIC_RELAXED, __HIP_MEMORY_SCOPE_AGENT);
                __syncthreads();
                t = __builtin_amdgcn_readfirstlane(slot[0]);
                __syncthreads(); }
              if (t >= nfu + nch) break;
#if P1_MIX
              if (xl && nch == 64) { if (t >= 16 && t < 112) { const int i = t - 16; t = (i & 1) ? 16 + (i >> 1) : nfu + (i >> 1); } else if (t >= 112) t = nfu + 48 + (t - 112); }
#endif
              if (t < nfu) { const Params p = ldp(); const int w = xl ? 64 * xq + t : t, pm = w >> 2, h = w & 3;
                  Unit<EpiZ> un; un.am = AMap{p.hbuf + (size_t)pm * 256 * DM, DM, nullptr, 256}; un.bt = p.WinT + (size_t)h * 256 * DM; un.K = DM; un.ep = EpiZ{p.zu, p.zv, p.zq, p.zkv, p.krope, p.rope, pm * 256, h * 256};
                  const GmArgs gm{p.gm_g, p.gm_b, p.w_sp, p.b_sp, p.mix, pm * 256, h, p.WspT};
                  const unsigned long long q0_ = (P1PROBE == 1) ? __builtin_amdgcn_s_memrealtime() : 0ull;
                  gemm256<EpiZ, 1>(un, shm, &gm);
                  if (P1PROBE == 1) { pacc_ += __builtin_amdgcn_s_memrealtime() - q0_; ++pcnt_; }
              } else { const Params p = ldp(); PHASE_IDS; const int ch = (xl ? 16 * (96 / CHI) * xq : 0) + (t - nfu);
                  const unsigned long long q0_ = (P1PROBE == 2) ? __builtin_amdgcn_s_memrealtime() : 0ull; float* scr = (float*)(smc + wid * (64 * 33 * 4));
                  if (WI_MLP && CHI == 24) {
                      const WItem wa = wi_moe(p, ch * CHI + wid), wb = wi_moe(p, ch * CHI + 8 + wid), wc = wi_moe(p, ch * CHI + 16 + wid);
                      float va[32], vb[32], vc[32];
                      wi_load(wa, va, lane); wi_load(wb, vb, lane); wi_load(wc, vc, lane);
                      wi_finish(wa, va, scr, lane); wi_finish(wb, vb, scr, lane); wi_finish(wc, vc, scr, lane);
                  } else
                  for (int k = wid; k < CHI; k += 8) prep_witem(p, I_EARLY + ch * CHI + k, scr, lane);
                  __syncthreads();
                  if (P1PROBE == 2) { pacc_ += __builtin_amdgcn_s_memrealtime() - q0_; ++pcnt_; } }
          } }
#elif GMLP_FUSED
        { const Params p = ldp(); PHASE_IDS;
          gemm_stream(PhZ3{p}, shm, vcu, nblk);
          if (PhZ3::NU % nblk != 0 && vcu >= PhZ3::NU % nblk) { float* scr = (float*)(smc + wid * (64 * 33 * 4)); const int nlate = nblk - (PhZ3::NU % nblk), gw = (vcu - PhZ3::NU % nblk) * 8 + wid, ngw = nlate * 8;
              for (int it = I_EARLY + gw; it < I_TOTAL; it += ngw) prep_witem(p, it, scr, lane); }
          else if (PhZ3::NU % nblk == 0) { float* scr = (float*)(smc + wid * (64 * 33 * 4)); for (int it = I_EARLY + vcu * 8 + wid; it < I_TOTAL; it += nblk * 8) prep_witem(p, it, scr, lane); }
          __syncthreads();
          for (int w = vcu; w < 512; w += nblk) { const int pm = w >> 2, h = w & 3;
              Unit<EpiZ> un; un.am = AMap{p.hbuf + (size_t)pm * 256 * DM, DM, nullptr, 256}; un.bt = p.WinT + (size_t)h * 256 * DM; un.K = DM; un.ep = EpiZ{p.zu, p.zv, p.zq, p.zkv, p.krope, p.rope, pm * 256, h * 256};
              const GmArgs gm{p.gm_g, p.gm_b, p.w_sp, p.b_sp, p.mix, pm * 256, h, p.WspT};
              gemm256<EpiZ, 1>(un, shm, &gm); } }
#else
#if JIT_LN0
        { const Params p = ldp(); PhZj ph{p, vcu, p.bar + 3520}; ph.chunk(vcu); gemm_stream(ph, shm, vcu, nblk); }
#else
        gemm_phase(PhZ{ldp()}, shm, vcu);
#endif
        { const Params p = ldp(); PHASE_IDS; const int nlate = nblk - (PhZ::NU % nblk);
          if (PhZ::NU % nblk != 0 && vcu >= PhZ::NU % nblk) { float* scr = (float*)(smc + wid * (64 * 33 * 4)); const int gw = (vcu - PhZ::NU % nblk) * 8 + wid, ngw = nlate * 8;
              for (int it = I_EARLY + gw; it < I_TOTAL; it += ngw) prep_witem(p, it, scr, lane); }
          else if (PhZ::NU % nblk == 0) { float* scr = (float*)(smc + wid * (64 * 33 * 4)); for (int it = I_EARLY + vcu * 8 + wid; it < I_TOTAL; it += nblk * 8) prep_witem(p, it, scr, lane); } }
#endif
    }
    SEAM(1);
    if (LO <= 2 && HI >= 2) REPEAT(2) {
        const Params p = ldp();
        float* tab = (float*)(smc + LDS_PRE);
#if KVCHAIN
        { int slot = 0;
          for (int u = vcu; u < PhQs::NU; u += nblk, ++slot) rs_table<384>(p.zq + (size_t)(u / 3) * 256 * 384, tab + slot * 256); }
        __syncthreads();
        gemm_stream(PhQs{p, tab, vcu, nblk}, shm, vcu, nblk);
#else
        if (nblk == 256) {
#if P2_ROWTILE
            const int pm = vcu >> 1;
            if ((vcu & 1) == 0) { rs_table<384>(p.zq + (size_t)pm * 256 * 384, tab); __syncthreads(); gemm_stream(PhQb{p, tab, 3 * pm, 3 * pm + 3}, shm, 3 * pm, 1); }
            else { rs_table<256>(p.zkv + (size_t)pm * 256 * 256, tab); __syncthreads(); gemm_stream(PhKVb{p, tab, 4 * pm, 4 * pm + 4, 0, 0}, shm, 4 * pm, 1); }
#else
            const int nq = vcu < 128 ? 2 : 1, kbeg = vcu < 128 ? vcu : 128 + (vcu - 128) * 3, kend = vcu < 128 ? vcu + 1 : kbeg + 3;
            for (int i = 0; i < nq; ++i) rs_table<384>(p.zq + (size_t)((vcu + i * 256) / 3) * 256 * 384, tab + i * 256);
            for (int k = kbeg; k < kend; ++k) rs_table<256>(p.zkv + (size_t)(k >> 2) * 256 * 256, tab + (nq + k - kbeg) * 256);
            __syncthreads();
            gemm_stream(PhQs{p, tab, vcu, nblk}, shm, vcu, nblk);
            gemm_stream(PhKVb{p, tab, kbeg, kend, nq}, shm, kbeg, 1);
#endif
        } else {
        { int slot = 0;
          for (int u = vcu; u < PhKVs::NU; u += nblk, ++slot) {
              if (u < PhQs::NU) rs_table<384>(p.zq + (size_t)(u / 3) * 256 * 384, tab + slot * 256); else rs_table<256>(p.zkv + (size_t)((u - 384) >> 2) * 256 * 256, tab + slot * 256); } }
        __syncthreads();
        gemm_stream(PhQs{p, tab, vcu, nblk}, shm, vcu, nblk);
        { const int i0 = vcu >= PhQs::NU ? 0 : (PhQs::NU - vcu + nblk - 1) / nblk; gemm_stream(PhKVs{p, tab, vcu, nblk}, shm, vcu + i0 * nblk, nblk); }
        }
#endif
#if !GMLP_FUSED
        gmlp_phase(p, smc, vcu);
#endif
    }
    SEAM(2);
    if (LO <= 3 && HI >= 3) REPEAT(3) {
        const Params p = ldp();
#ifndef ATTPROBE
#define ATTPROBE 0
#endif
#ifndef ATTDUP
#define ATTDUP 0
#endif
        for (int rep = 0; rep < 1 + ATTDUP; ++rep)
        for (int u = vcu; u < 256; u += nblk) { const int bh = u >> 2, pr = u & 3; attn_block<0>(p, smc, bh, 7 - pr, p.mix); attn_block<0>(p, smc, bh, pr, p.mix); }
    }
    SEAM(3);
    if (LO <= 4 && HI >= 4) {
#if XPROBE > 0
        gemm_phase(PhYp<XPROBE>{ldp()}, shm, vcu); xcd_barrier(xb);
#endif
#ifndef WARM4
#define WARM4 0
#endif
        if (WARM4) { const Params p = ldp(); PHASE_IDS;
            for (int u = vcu; u < 512; u += nblk) { const char* a = (const char*)(p.mix + (size_t)(u >> 2) * 256 * DM); unsigned acc_ = 0;
#pragma unroll
                for (int i = 0; i < 8; ++i) acc_ += *(const unsigned*)(a + ((size_t)(i * 512 + tid) << 7));
                asm volatile("" :: "v"(acc_)); } }
        gemm_phase(PhY{ldp()}, shm, vcu);
    }
    SEAM(4);
    if (LO <= 5 && HI >= 5) {
        const Params p = ldp();
#if LN1FOLD
        for (int i = blockIdx.x * NTHR + (int)threadIdx.x; i < 32 * 1024; i += nblk * NTHR) { const int e = i >> 10, w = i & 1023; float s = 0.f;
#pragma unroll
            for (int kb = 0; kb < 16; ++kb) s += p.lnf[LNF_CPART + (size_t)(e * 16 + kb) * 1024 + w];
            p.lnf[LNF_CFIN + i] = s; }
#endif
#if P5_LOCAL
        if (nblk == 256) { const int x = vcu >> 5, li = vcu & 31, pm = (li < 16) ? 8 * x + (li >> 1) : 64 + 8 * x + ((li - 16) >> 1); router_tile(p, smc, 2 * pm + (li & 1)); } else
#endif
        for (int tb = blockIdx.x; tb < T_TOK / 128; tb += nblk) router_tile(p, smc, tb);
    }
    SEAM(5);
    if (LO <= 6 && HI >= 6) REPEAT(6) {
        const Params p = ldp(); PHASE_IDS;
        moe_tables(p, smc);
        const int* tot = (const int*)(smc + LDS_TOT); int* aid_tab = (int*)(smc + LDS_AID); const unsigned short* pre = (const unsigned short*)(smc + LDS_PRE);
        if (blockIdx.x == 0 && tid < NEXP) p.cnt[tid] = tot[tid];
        { int slot = 0;
          for (int u = vcu; slot < 3; u += nblk, ++slot) {
              int e, rt, ct, pr; if (!moe_unit_t(tot, u, 2, e, rt, ct, pr)) break;
              const int te = tot[e];
              if (tid < 256) { const int g = rt * 256 + tid; int aid = 0;
                  if (g < te) { int lo = 0, hi = 256;
#pragma unroll
                      for (int it = 0; it < 8; ++it) { const int mid = (lo + hi) >> 1; if ((int)pre[e * 256 + mid] <= g) lo = mid; else hi = mid; }
                      aid = p.listb[((size_t)lo * NEXP + e) * 256 + (g - (int)pre[e * 256 + lo])];
                      if (ct == 0) { if (MERGE67) __hip_atomic_store(p.list + (size_t)e * LIST_CAP + g, aid, __ATOMIC_RELAXED, __HIP_MEMORY_SCOPE_AGENT); else p.list[(size_t)e * LIST_CAP + g] = aid; } }
                  aid_tab[slot * 256 + tid] = aid; } } }
        __syncthreads();
        gemm_stream(PhHs{p, tot, aid_tab, vcu, nblk, p.bar + 3712}, shm, vcu, nblk);
#if MERGE67
        { PhCs pc{p, tot, p.bar + 3712, 0, p.bar + 3648, (volatile int*)(smc + LDS_AID)}; pc.u0 = pc.take(false, 0); gemm_stream(pc, shm, pc.u0, nblk); }
#endif
    }
#if !MERGE67
    SEAM(6);
#else
    TSTAMP(7);
#endif
    if (!MERGE67 && LO <= 7 && HI >= 7) REPEAT(7) {
        Params p = ldp(); PHASE_IDS;
        int* tot = (int*)(smc + LDS_TOT);
        if (tid < NEXP) tot[tid] = p.cnt[tid];
        __syncthreads();
        p.cnt = tot;
        gemm_phase(PhC{p}, shm, vcu);
    }
    SEAM(7);
#ifndef WPROBE
#define WPROBE 0
#endif
    if (WPROBE > 0 && LO <= 8 && HI >= 8 && LO != HI) {
        const Params p = ldp(); PHASE_IDS;
        const int wr = wid >> 2, wc = wid & 3, fr = lane & 15, fq = lane >> 4;
        for (int u = vcu; u < 512; u += nblk) { const int pm = u >> 2, pn = u & 3;
            bf16_t* base = p.mix + (size_t)pm * 256 * DM + pn * 256;
#pragma unroll
            for (int ai = 0; ai < 2; ++ai)
#pragma unroll
                for (int m = 0; m < 4; ++m) { bf16_t* rowp = base + (size_t)(ai * 128 + wr * 64 + m * 16 + fr) * DM;
                    if (WPROBE == 1) { const u32x2 z = {0u, 0u};
                        *(u32x2*)(rowp + wc * 32 + 4 * fq) = z; *(u32x2*)(rowp + wc * 32 + 16 + 4 * fq) = z; *(u32x2*)(rowp + 128 + wc * 32 + 4 * fq) = z; *(u32x2*)(rowp + 128 + wc * 32 + 16 + 4 * fq) = z; }
                    else { const u32x4 z = {0u, 0u, 0u, 0u}; *(u32x4*)(rowp + wc * 64 + 16 * fq) = z; *(u32x4*)(rowp + wc * 64 + 16 * fq + 8) = z; } } }
        xcd_barrier(xb);
    }
#if LN1FOLD
    if (LO <= 8 && HI >= 8) REPEAT(8) { const Params p = ldp(); PHASE_IDS; final_tokens_fold(p, blockIdx.x * 8 + wid, nblk * 8, lane); }
#else
    if (LO <= 8 && HI >= 8) REPEAT(8) { const Params p = ldp(); PHASE_IDS; for (int t = blockIdx.x * 8 + wid; t < T_TOK / 2; t += nblk * 8) final_token2(p, t, t + T_TOK / 2, lane); }
#endif
    if (TIMEPH >= 0 && LO != HI) {
        xcd_barrier(xb); TSTAMP(9);
        if (P1PROBE) { ts0_ = 0; ts1_ = pcnt_ ? pacc_ / pcnt_ : 0; }
        if (blockIdx.x == 0 && threadIdx.x < 64) { const Params p = ldp(); const float dv = (float)(ts1_ - ts0_) * 6.0e-5f * TSCALE; for (int i = threadIdx.x; i < 4096; i += 64) p.out[i] = dv; }
    }
    #undef SEAM
#if SELFRESET
    if (LO == 0 && HI == 8) {
        volatile int* lastf = (volatile int*)(smc + LDS_XB + 128);
        __syncthreads();
        if (threadIdx.x == 0) { const unsigned old = __hip_atomic_fetch_add(g_sync_words + 4095, 1u, __ATOMIC_ACQ_REL, __HIP_MEMORY_SCOPE_AGENT); lastf[0] = (old == (unsigned)nblk - 1u) ? 1 : 0; }
        __syncthreads();
        if (lastf[0]) { for (int i = threadIdx.x; i < 4096; i += NTHR) __hip_atomic_store(g_sync_words + i, 0u, __ATOMIC_RELAXED, __HIP_MEMORY_SCOPE_AGENT); }
    }
#endif
}

#if ATTPROBE > 0
__global__ __launch_bounds__(512, 2) void attn_probe_kernel(Params p) {
    extern __shared__ __attribute__((aligned(16))) unsigned char lds_raw[];
    char* smc = (char*)lds_raw; const int nblk = gridDim.x;
    const int vcu = (nblk % 8 == 0) ? (int)(blockIdx.x % 8) * (nblk / 8) + (int)(blockIdx.x / 8) : (int)blockIdx.x;
    for (int u = vcu; u < 256; u += nblk) { const int bh = u >> 2, pr = u & 3; attn_block<ATTPROBE>(p, smc, bh, 7 - pr, (bf16_t*)p.out); attn_block<ATTPROBE>(p, smc, bh, pr, (bf16_t*)p.out); }
}
#endif
#ifndef MODE
#ifndef MODE
#define MODE 1
#endif
#endif
#ifndef FASTMASK
#define FASTMASK 0x1ff
#endif
static size_t carve(size_t& off, size_t bytes) { const size_t o = off; off += (bytes + 255) & ~(size_t)255; return o; }
#ifndef DUPMASK
#define DUPMASK 0
#endif
template <int PH> static void launch_fast(const Params& p, int grid, hipStream_t stream) { hipLaunchKernelGGL((mega<PH, PH>), dim3(grid), dim3(NTHR), LDS_BYTES, stream, p);
    if ((DUPMASK >> PH) & 1) hipLaunchKernelGGL((mega<PH, PH>), dim3(grid), dim3(NTHR), LDS_BYTES, stream, p); }
extern "C" void kernel_launch(void* const* d_in, const int* in_sizes, int n_in, void* d_out, int out_size, void* d_ws, size_t ws_size, hipStream_t stream) {
    Params p{};
    p.x = (const float*)d_in[0]; p.pos = (const int*)d_in[1]; p.ln0_g = (const float*)d_in[2]; p.ln0_b = (const float*)d_in[3]; p.w_in = (const float*)d_in[4];
    p.gm_g = (const float*)d_in[5]; p.gm_b = (const float*)d_in[6]; p.w_sp = (const float*)d_in[7]; p.b_sp = (const float*)d_in[8]; p.qn_g = (const float*)d_in[9];
    p.w_uq = (const float*)d_in[10]; p.kvn_g = (const float*)d_in[11]; p.w_ukv = (const float*)d_in[12]; p.w_out = (const float*)d_in[13]; p.ln1_g = (const float*)d_in[14];
    p.ln1_b = (const float*)d_in[15]; p.w_rg = (const float*)d_in[16]; p.b_rg = (const float*)d_in[17]; p.w_re = (const float*)d_in[18]; p.b_re = (const float*)d_in[19];
    p.w_gate = (const float*)d_in[20]; p.w_up = (const float*)d_in[21]; p.w_down = (const float*)d_in[22]; p.ln2_g = (const float*)d_in[23]; p.ln2_b = (const float*)d_in[24];
    p.out = (float*)d_out;
    char* ws = (char*)d_ws; size_t off = 0;
    p.bar = (unsigned*)(ws + carve(off, 16384));
    p.cnt = (int*)(ws + carve(off, 1024));
    p.WinT = (bf16_t*)(ws + carve(off, (size_t)ZN * 1024 * 2)); p.WuqT = (bf16_t*)(ws + carve(off, 768 * 384 * 2)); p.WukvT = (bf16_t*)(ws + carve(off, 1024 * 256 * 2));
    p.WoutT = (bf16_t*)(ws + carve(off, 1024 * 1024 * 2)); p.WguT = (bf16_t*)(ws + carve(off, (size_t)32 * 512 * 1024 * 2)); p.WdT = (bf16_t*)(ws + carve(off, (size_t)32 * 1024 * 256 * 2));
    p.hbuf = (bf16_t*)(ws + carve(off, (size_t)T_TOK * DM * 2)); p.rope = (float2*)(ws + carve(off, (size_t)T_TOK * 32 * 8));
    p.list = (int*)(ws + carve(off, (size_t)NEXP * LIST_CAP * 4)); p.gates = (float*)(ws + carve(off, (size_t)T_TOK * 2 * 4));
    p.WspT = (bf16_t*)(ws + carve(off, 4 * 128 * 128 * 2)); p.ystat = (float*)(ws + carve(off, (size_t)T_TOK * 32 * 4)); p.WrT = (bf16_t*)(ws + carve(off, 2 * 36 * 1024 * 2)); p.cntb = (int*)(ws + carve(off, 256 * NEXP * 4)); p.listb = (int*)(ws + carve(off, (size_t)256 * NEXP * 256 * 4));
    p.rsq = (float*)(ws + carve(off, T_TOK * 4)); p.rskv = (float*)(ws + carve(off, T_TOK * 4));
    p.lnf = (float*)(ws + carve(off, (size_t)(LNF_CR + 128) * 4));
    const size_t stage0 = off;
    p.zu = (bf16_t*)(ws + carve(off, (size_t)T_TOK * 512 * 2)); p.zv = (bf16_t*)(ws + carve(off, (size_t)T_TOK * 512 * 2));
    p.zq = (bf16_t*)(ws + carve(off, (size_t)T_TOK * 384 * 2)); p.zkv = (bf16_t*)(ws + carve(off, (size_t)T_TOK * 256 * 2)); p.krope = (bf16_t*)(ws + carve(off, (size_t)T_TOK * 64 * 2));
    p.Q = (bf16_t*)(ws + carve(off, (size_t)T_TOK * 768 * 2)); p.Kn = (bf16_t*)(ws + carve(off, (size_t)T_TOK * 512 * 2)); p.Vt = (bf16_t*)(ws + carve(off, (size_t)T_TOK * 512 * 2));
    p.mix = (bf16_t*)(ws + carve(off, (size_t)T_TOK * DM * 2));
    const size_t stage_end = off;
    size_t o2 = stage0; p.contrib = (bf16_t*)(ws + carve(o2, (size_t)T_TOK * 2 * DM * 2)); p.H = (bf16_t*)(ws + carve(o2, (size_t)(65536 + 8192) * FF * 2));
    if (o2 > stage_end || stage_end > ws_size) { fprintf(stderr, "kernel_launch: workspace too small (%zu needed, %zu given)\n", stage_end, ws_size); return; }

    static int grid = 0;
    if (!grid) {
        int dev = 0, cus = 0; (void)hipGetDevice(&dev); (void)hipDeviceGetAttribute(&cus, hipDeviceAttributeMultiprocessorCount, dev);
        grid = cus > 0 ? (cus / 8) * 8 : 256;
        (void)hipFuncSetAttribute((const void*)nk_gmlp, hipFuncAttributeMaxDynamicSharedMemorySize, 128 * 129 * 4);
        (void)hipFuncSetAttribute((const void*)nk_attn, hipFuncAttributeMaxDynamicSharedMemorySize, (64 * 192 + 64 * 193 + 64 * 65 + 64 * 128) * 4);
        (void)hipFuncSetAttribute((const void*)mega<0, 8>, hipFuncAttributeMaxDynamicSharedMemorySize, LDS_BYTES);
#if MODE == 2
        (void)hipFuncSetAttribute((const void*)mega<0, 0>, hipFuncAttributeMaxDynamicSharedMemorySize, LDS_BYTES);
        (void)hipFuncSetAttribute((const void*)mega<1, 1>, hipFuncAttributeMaxDynamicSharedMemorySize, LDS_BYTES);
        (void)hipFuncSetAttribute((const void*)mega<2, 2>, hipFuncAttributeMaxDynamicSharedMemorySize, LDS_BYTES);
        (void)hipFuncSetAttribute((const void*)mega<3, 3>, hipFuncAttributeMaxDynamicSharedMemorySize, LDS_BYTES);
        (void)hipFuncSetAttribute((const void*)mega<4, 4>, hipFuncAttributeMaxDynamicSharedMemorySize, LDS_BYTES);
        (void)hipFuncSetAttribute((const void*)mega<5, 5>, hipFuncAttributeMaxDynamicSharedMemorySize, LDS_BYTES);
        (void)hipFuncSetAttribute((const void*)mega<6, 6>, hipFuncAttributeMaxDynamicSharedMemorySize, LDS_BYTES);
        (void)hipFuncSetAttribute((const void*)mega<7, 7>, hipFuncAttributeMaxDynamicSharedMemorySize, LDS_BYTES);
        (void)hipFuncSetAttribute((const void*)mega<8, 8>, hipFuncAttributeMaxDynamicSharedMemorySize, LDS_BYTES);
#endif
    }
#if MODE == 1
    if (!(SELFRESET && MODE == 1)) (void)hipMemsetAsync(p.bar, 0, 16384, stream);
    hipLaunchKernelGGL((mega<0, 8>), dim3(grid), dim3(NTHR), LDS_BYTES, stream, p);
#else
    const unsigned fm = (MODE == 2) ? (unsigned)(FASTMASK) : 0u;
    if (fm & 1) launch_fast<0>(p, grid, stream); else { nk_prep_w<<<J_TOTAL, 256, 0, stream>>>(p); nk_ln0<<<T_TOK / 4, 256, 0, stream>>>(p); nk_rope<<<T_TOK * 32 / 256, 256, 0, stream>>>(p); }
    if (fm & 2) launch_fast<1>(p, grid, stream); else nk_gemm<PhZ><<<dim3(PhZ::NU, 32), 256, 0, stream>>>(PhZ{p});
#if defined(P2VAR) && P2VAR == 1
    launch_fast<2>(p, grid, stream); nk_gmlp<<<T_TOK / 128 * 4, 256, 128 * 129 * 4, stream>>>(p);
#elif defined(P2VAR) && P2VAR == 2
    nk_rowscale<<<T_TOK / 4, 256, 0, stream>>>(p); nk_gemm<PhQ><<<dim3(PhQ::NU, 32), 256, 0, stream>>>(PhQ{p, p.rsq});
    nk_gemm<PhKV><<<dim3(PhKV::NU, 32), 256, 0, stream>>>(PhKV{p, p.rskv}); launch_fast<2>(p, grid, stream);
#else
    if (fm & 4) launch_fast<2>(p, grid, stream); else { nk_rowscale<<<T_TOK / 4, 256, 0, stream>>>(p); nk_gemm<PhQ><<<dim3(PhQ::NU, 32), 256, 0, stream>>>(PhQ{p, p.rsq});
        nk_gemm<PhKV><<<dim3(PhKV::NU, 32), 256, 0, stream>>>(PhKV{p, p.rskv}); nk_gmlp<<<T_TOK / 128 * 4, 256, 128 * 129 * 4, stream>>>(p); }
#endif
#if ATTPROBE > 0
    { static bool a2 = false; if (!a2) { a2 = true; (void)hipFuncSetAttribute((const void*)attn_probe_kernel, hipFuncAttributeMaxDynamicSharedMemorySize, LDS_BYTES); }
      hipLaunchKernelGGL(attn_probe_kernel, dim3(grid), dim3(NTHR), LDS_BYTES, stream, p); }
#endif
    if (fm & 8) launch_fast<3>(p, grid, stream); else nk_attn<<<64 * 32, 256, (64 * 192 + 64 * 193 + 64 * 65 + 64 * 128) * 4, stream>>>(p);
    if (fm & 16) launch_fast<4>(p, grid, stream); else nk_gemm<PhY><<<dim3(PhY::NU, 32), 256, 0, stream>>>(PhY{p});
    if (fm & 32) launch_fast<5>(p, grid, stream); else { nk_router_prep<<<144, 256, 0, stream>>>(p); nk_router<<<T_TOK / 4, 256, 0, stream>>>(p); }
    if (fm & 64) launch_fast<6>(p, grid, stream); else nk_gemm<PhH><<<dim3(PhH::NU, 32), 256, 0, stream>>>(PhH{p});
    if (fm & 128) launch_fast<7>(p, grid, stream); else nk_gemm<PhC><<<dim3(PhC::NU, 32), 256, 0, stream>>>(PhC{p});
    if (fm & 256) launch_fast<8>(p, grid, stream); else nk_final<<<T_TOK / 4, 256, 0, stream>>>(p);
#endif
}
```
